# Optimizing an MI355X kernel written in HIP

```python
import math
import jax, jax.numpy as jnp
from jax import lax
import numpy as np

D_MODEL = 1024
BATCH = 1
SEQ = 16384
DEPTH = 1

N_HEADS = 8
N_KV_HEADS = 2
HEAD_DIM = 64
Q_PER_KV = N_HEADS // N_KV_HEADS
ROT_DIM = HEAD_DIM // 4
ROPE_THETA = 500000.0
CMP_LEN = 32
CMP_STRIDE = 16
CMP_HIDDEN = 256
SLC_LEN = 64
SLC_TOPK = 16
WINDOW = 512
Q_BLOCK = 128
ATTN_WIDTH = N_HEADS * HEAD_DIM
KV_WIDTH = N_KV_HEADS * HEAD_DIM
SSM_WIDTH = 512
SSM_GROUP = 16
SSM_GROUPS = SSM_WIDTH // SSM_GROUP
SSM_STATE = 64
SSM_CHUNK = 128
D_FF = 2816
CONV_WIDTH = 3
EPS = 1e-6
NEG_INF = -1e30
FORCE_SCORE = 1e4

IN_SIZES = (ATTN_WIDTH, KV_WIDTH, KV_WIDTH, KV_WIDTH, KV_WIDTH, KV_WIDTH, KV_WIDTH,
            3 * N_HEADS, SSM_WIDTH, D_MODEL, D_MODEL)
IN_OFFSETS = tuple(int(v) for v in np.cumsum(IN_SIZES)[:-1])
D_IN = int(sum(IN_SIZES))

kernel_name = "hybrid_nsa_s5_convffn_block"


def rmsnorm(x, g):
    xf = x.astype(jnp.float32)
    r = xf * lax.rsqrt(jnp.mean(xf * xf, axis=-1, keepdims=True) + EPS)
    return (r * g.astype(jnp.float32)).astype(x.dtype)


def partial_rope(x, pos):
    half = ROT_DIM // 2
    inv_freq = ROPE_THETA ** (-jnp.arange(0, ROT_DIM, 2, dtype=jnp.float32) / ROT_DIM)
    ang = pos.astype(jnp.float32)[..., None] * inv_freq
    cos = jnp.cos(ang)[:, :, None, :].astype(x.dtype)
    sin = jnp.sin(ang)[:, :, None, :].astype(x.dtype)
    x1, x2, rest = x[..., :half], x[..., half:ROT_DIM], x[..., ROT_DIM:]
    return jnp.concatenate([x1 * cos - x2 * sin, x2 * cos + x1 * sin, rest], axis=-1)


def masked_softmax(s, mask, axis):
    s = jnp.where(mask, s.astype(jnp.float32), NEG_INF)
    m = jnp.max(s, axis=axis, keepdims=True)
    e = jnp.where(mask, jnp.exp(s - m), 0.0)
    return e / jnp.maximum(jnp.sum(e, axis=axis, keepdims=True), 1e-30)


def cmp_block_ends(seq):
    n_cmp = (seq - CMP_LEN) // CMP_STRIDE + 1
    return jnp.arange(n_cmp, dtype=jnp.int32) * CMP_STRIDE + CMP_LEN - 1, n_cmp


def compress(kraw, pe, w1, w2, n_cmp):
    idx = jnp.arange(n_cmp)[:, None] * CMP_STRIDE + jnp.arange(CMP_LEN)[None, :]
    blocks = kraw[:, idx] + pe[None, None, :, None, :]
    b, n, l, kh, d = blocks.shape
    flat = blocks.transpose(0, 1, 3, 2, 4).reshape(b, n, kh, l * d)
    return jax.nn.gelu(flat @ w1) @ w2


def nsa_attention(q, k_cmp, v_cmp, k_slc, v_slc, k_win, v_win, gates, cmp_end):
    bsz, seq = q.shape[0], q.shape[1]
    nb = seq // Q_BLOCK
    n_slc = seq // SLC_LEN
    topk = min(SLC_TOPK, n_slc)
    c_start = cmp_end - (CMP_LEN - 1)
    s_start = jnp.arange(n_slc, dtype=jnp.int32) * SLC_LEN
    ov = jnp.minimum(c_start[:, None] + CMP_LEN, s_start[None, :] + SLC_LEN) - jnp.maximum(c_start[:, None], s_start[None, :])
    overlap = jnp.clip(ov, 0, None).astype(jnp.float32) / CMP_LEN
    ks_blocks = k_slc.reshape(bsz, n_slc, SLC_LEN, N_KV_HEADS, HEAD_DIM).transpose(0, 3, 1, 2, 4)
    vs_blocks = v_slc.reshape(bsz, n_slc, SLC_LEN, N_KV_HEADS, HEAD_DIM).transpose(0, 3, 1, 2, 4)
    pad = ((0, 0), (WINDOW, 0), (0, 0), (0, 0))
    kw_p, vw_p = jnp.pad(k_win, pad), jnp.pad(v_win, pad)
    q_blocks = q.reshape(bsz, nb, Q_BLOCK, N_KV_HEADS, Q_PER_KV, HEAD_DIM).transpose(1, 0, 2, 3, 4, 5)
    g_blocks = gates.reshape(bsz, nb, Q_BLOCK, N_KV_HEADS, Q_PER_KV, 3).transpose(1, 0, 2, 3, 4, 5)
    b_idx = jnp.arange(bsz)[:, None, None, None]
    h_idx = jnp.arange(N_KV_HEADS)[None, :, None, None]
    j_idx = jnp.arange(n_slc, dtype=jnp.int32)

    def block(args):
        c, qb, gb = args
        t = c * Q_BLOCK + jnp.arange(Q_BLOCK, dtype=jnp.int32)
        s_c = jnp.einsum('bqkgd,bnkd->bkgqn', qb, k_cmp)
        mask_c = (cmp_end[None, :] <= t[:, None])[None, None, None]
        p_c = masked_softmax(s_c, mask_c, axis=-1)
        o_c = jnp.einsum('bkgqn,bnkd->bqkgd', p_c.astype(v_cmp.dtype), v_cmp)
        imp = jnp.einsum('bkgqn,nj->bqkj', p_c, overlap)
        forced = (j_idx[None, :] == 0) | (j_idx[None, :] == (t // SLC_LEN)[:, None])
        valid = (j_idx[None, :] * SLC_LEN) <= t[:, None]
        score = jnp.where(forced[None, :, None, :], FORCE_SCORE, imp)
        score = jnp.where(valid[None, :, None, :], score, NEG_INF)
        top_val, top_idx = lax.top_k(score, topk)
        sel_ok = (top_val > 0.5 * NEG_INF).transpose(0, 2, 1, 3)
        top_idx_t = top_idx.transpose(0, 2, 1, 3)
        ks = ks_blocks[b_idx, h_idx, top_idx_t]
        vs = vs_blocks[b_idx, h_idx, top_idx_t]
        s_s = jnp.einsum('bkgqd,bkqnsd->bkgqns', qb.transpose(0, 2, 3, 1, 4), ks)
        tok = top_idx_t[..., None] * SLC_LEN + jnp.arange(SLC_LEN, dtype=jnp.int32)
        mask_s = (sel_ok[..., None] & (tok <= t[None, None, :, None, None]))[:, :, None]
        p_s = masked_softmax(s_s, mask_s, axis=(-2, -1))
        o_s = jnp.einsum('bkgqns,bkqnsd->bqkgd', p_s.astype(vs.dtype), vs)
        kw = lax.dynamic_slice_in_dim(kw_p, c * Q_BLOCK, Q_BLOCK + WINDOW, axis=1)
        vw = lax.dynamic_slice_in_dim(vw_p, c * Q_BLOCK, Q_BLOCK + WINDOW, axis=1)
        s_w = jnp.einsum('bqkgd,bjkd->bkgqj', qb, kw)
        kpos = c * Q_BLOCK - WINDOW + jnp.arange(Q_BLOCK + WINDOW, dtype=jnp.int32)
        diff = t[:, None] - kpos[None, :]
        mask_w = ((kpos[None, :] >= 0) & (diff >= 0) & (diff < WINDOW))[None, None, None]
        p_w = masked_softmax(s_w, mask_w, axis=-1)
        o_w = jnp.einsum('bkgqj,bjkd->bqkgd', p_w.astype(vw.dtype), vw)
        o = gb[..., 0:1] * o_c + gb[..., 1:2] * o_s + gb[..., 2:3] * o_w
        return o.reshape(bsz, Q_BLOCK, ATTN_WIDTH).astype(q.dtype)

    out = lax.map(block, (jnp.arange(nb, dtype=jnp.int32), q_blocks, g_blocks))
    return out.transpose(1, 0, 2, 3).reshape(bsz, seq, ATTN_WIDTH)


def s5_layer(u, a_re, a_im, b_re, b_im, c_re, c_im, d_skip, log_dt, w_glu):
    bsz, seq = u.shape[0], u.shape[1]
    nc = seq // SSM_CHUNK
    f32 = jnp.float32
    A = lax.complex(a_re.astype(f32), a_im.astype(f32))
    dt = jnp.exp(log_dt.astype(f32))[:, None]
    A_bar = jnp.exp(A * dt)
    B_bar = ((A_bar - 1.0) / A)[..., None] * lax.complex(b_re.astype(f32), b_im.astype(f32))
    Cm = lax.complex(c_re.astype(f32), c_im.astype(f32))
    uf = u.astype(f32)
    uc = uf.reshape(bsz, nc, SSM_CHUNK, SSM_GROUPS, SSM_GROUP).transpose(1, 2, 0, 3, 4)
    a_chunk = jnp.broadcast_to(A_bar, (SSM_CHUNK, bsz, SSM_GROUPS, SSM_STATE))

    def op(e1, e2):
        a1, b1 = e1
        a2, b2 = e2
        return a1 * a2, a2 * b1 + b2

    def step(carry, u_c):
        bu = jnp.einsum('cbgh,gph->cbgp', u_c.astype(jnp.complex64), B_bar)
        a_cum, x_loc = lax.associative_scan(op, (a_chunk, bu), axis=0)
        xs = x_loc + a_cum * carry[None]
        y = jnp.real(jnp.einsum('ghp,cbgp->cbgh', Cm, xs))
        return xs[-1], y

    carry0 = jnp.zeros((bsz, SSM_GROUPS, SSM_STATE), jnp.complex64)
    _, ys = lax.scan(step, carry0, uc)
    y = ys.transpose(2, 0, 1, 3, 4).reshape(bsz, seq, SSM_WIDTH) + d_skip.astype(f32) * uf
    y = jax.nn.gelu(y)
    y = y * jax.nn.sigmoid(y @ w_glu.astype(f32))
    return y.astype(u.dtype)


def causal_dwconv(x, w, b):
    seq = x.shape[1]
    xp = jnp.pad(x, ((0, 0), (CONV_WIDTH - 1, 0), (0, 0)))
    out = b
    for k in range(CONV_WIDTH):
        out = out + w[k] * xp[:, k:k + seq]
    return out


def setup_inputs(seed: int = 0) -> dict:
    key = jax.random.key(seed)
    ks = jax.random.split(key, 32)
    nrm = lambda k, shape, s: jax.random.normal(k, shape, jnp.float32) * s
    L = DEPTH
    n_idx = jnp.arange(SSM_STATE, dtype=jnp.float32)
    return {
        "x": nrm(ks[0], (BATCH, SEQ, D_MODEL), 1.0),
        "positions": jnp.broadcast_to(jnp.arange(SEQ, dtype=jnp.int32), (BATCH, SEQ)),
        "norm_mix": 1.0 + nrm(ks[1], (L, D_MODEL), 0.02),
        "w_in": nrm(ks[2], (L, D_MODEL, D_IN), D_MODEL ** -0.5),
        "cmp_k_pe": nrm(ks[3], (L, CMP_LEN, HEAD_DIM), 0.02),
        "cmp_k_w1": nrm(ks[4], (L, CMP_LEN * HEAD_DIM, CMP_HIDDEN), (CMP_LEN * HEAD_DIM) ** -0.5),
        "cmp_k_w2": nrm(ks[5], (L, CMP_HIDDEN, HEAD_DIM), CMP_HIDDEN ** -0.5),
        "cmp_v_pe": nrm(ks[6], (L, CMP_LEN, HEAD_DIM), 0.02),
        "cmp_v_w1": nrm(ks[7], (L, CMP_LEN * HEAD_DIM, CMP_HIDDEN), (CMP_LEN * HEAD_DIM) ** -0.5),
        "cmp_v_w2": nrm(ks[8], (L, CMP_HIDDEN, HEAD_DIM), CMP_HIDDEN ** -0.5),
        "ssm_a_re": -0.5 + nrm(ks[9], (L, SSM_GROUPS, SSM_STATE), 0.01),
        "ssm_a_im": math.pi * n_idx + nrm(ks[10], (L, SSM_GROUPS, SSM_STATE), 0.01),
        "ssm_b_re": nrm(ks[11], (L, SSM_GROUPS, SSM_STATE, SSM_GROUP), (2.0 * SSM_GROUP) ** -0.5),
        "ssm_b_im": nrm(ks[12], (L, SSM_GROUPS, SSM_STATE, SSM_GROUP), (2.0 * SSM_GROUP) ** -0.5),
        "ssm_c_re": nrm(ks[13], (L, SSM_GROUPS, SSM_GROUP, SSM_STATE), (2.0 * SSM_STATE) ** -0.5),
        "ssm_c_im": nrm(ks[14], (L, SSM_GROUPS, SSM_GROUP, SSM_STATE), (2.0 * SSM_STATE) ** -0.5),
        "ssm_d": nrm(ks[15], (L, SSM_WIDTH), 0.5),
        "ssm_log_dt": jax.random.uniform(ks[16], (L, SSM_GROUPS), jnp.float32, math.log(1e-3), math.log(1e-1)),
        "ssm_w_glu": nrm(ks[17], (L, SSM_WIDTH, SSM_WIDTH), SSM_WIDTH ** -0.5),
        "w_proj_a": nrm(ks[18], (L, ATTN_WIDTH, D_MODEL), ATTN_WIDTH ** -0.5),
        "w_proj_b": nrm(ks[19], (L, SSM_WIDTH, D_MODEL), SSM_WIDTH ** -0.5),
        "w_out": nrm(ks[20], (L, D_MODEL, D_MODEL), D_MODEL ** -0.5),
        "norm_ffn": 1.0 + nrm(ks[21], (L, D_MODEL), 0.02),
        "w_up": nrm(ks[22], (L, D_MODEL, 2 * D_FF), D_MODEL ** -0.5),
        "conv_w": nrm(ks[23], (L, CONV_WIDTH, 2 * D_FF), CONV_WIDTH ** -0.5),
        "conv_b": nrm(ks[24], (L, 2 * D_FF), 0.01),
        "w_down": nrm(ks[25], (L, D_FF, D_MODEL), D_FF ** -0.5),
        "norm_final": 1.0 + nrm(ks[26], (D_MODEL,), 0.02),
    }


def reference(x, positions, norm_mix, w_in, cmp_k_pe, cmp_k_w1, cmp_k_w2, cmp_v_pe, cmp_v_w1, cmp_v_w2,
              ssm_a_re, ssm_a_im, ssm_b_re, ssm_b_im, ssm_c_re, ssm_c_im, ssm_d, ssm_log_dt, ssm_w_glu,
              w_proj_a, w_proj_b, w_out, norm_ffn, w_up, conv_w, conv_b, w_down, norm_final):
    bsz, seq = x.shape[0], x.shape[1]
    cmp_end, n_cmp = cmp_block_ends(seq)
    cmp_pos = positions[:, cmp_end]
    kv_shape = (bsz, seq, N_KV_HEADS, HEAD_DIM)
    for l in range(DEPTH):
        h = rmsnorm(x, norm_mix[l])
        proj = h @ w_in[l]
        q, kc, vc, ksl, vsl, kwn, vwn, ng, u, ga, gb = jnp.split(proj, IN_OFFSETS, axis=-1)
        q = partial_rope(q.reshape(bsz, seq, N_HEADS, HEAD_DIM), positions) * (HEAD_DIM ** -0.5)
        k_cmp = partial_rope(compress(kc.reshape(kv_shape), cmp_k_pe[l], cmp_k_w1[l], cmp_k_w2[l], n_cmp), cmp_pos)
        v_cmp = compress(vc.reshape(kv_shape), cmp_v_pe[l], cmp_v_w1[l], cmp_v_w2[l], n_cmp)
        k_slc = partial_rope(ksl.reshape(kv_shape), positions)
        k_win = partial_rope(kwn.reshape(kv_shape), positions)
        nsa_gates = jax.nn.sigmoid(ng.reshape(bsz, seq, N_HEADS, 3))
        y_a = nsa_attention(q, k_cmp, v_cmp, k_slc, vsl.reshape(kv_shape), k_win, vwn.reshape(kv_shape),
                            nsa_gates, cmp_end)
        y_b = s5_layer(u, ssm_a_re[l], ssm_a_im[l], ssm_b_re[l], ssm_b_im[l], ssm_c_re[l], ssm_c_im[l],
                       ssm_d[l], ssm_log_dt[l], ssm_w_glu[l])
        merged = jax.nn.sigmoid(ga) * (y_a @ w_proj_a[l]) + jax.nn.sigmoid(gb) * (y_b @ w_proj_b[l])
        x = x + merged @ w_out[l]
        h2 = rmsnorm(x, norm_ffn[l])
        up = causal_dwconv(h2 @ w_up[l], conv_w[l], conv_b[l])
        gate, val = jnp.split(up, 2, axis=-1)
        x = x + (jax.nn.silu(gate) * val) @ w_down[l]
    return rmsnorm(x, norm_final)
```

```cpp
#include <hip/hip_runtime.h>
#include <hip/hip_cooperative_groups.h>
#include <cstdio>
#include <cstdint>
namespace cg = cooperative_groups;
#ifndef PROBE_REP
#define PROBE_REP -1
#endif
#define REPS(k) _Pragma("nounroll") for (int rep_ = 0; rep_ < ((PROBE_REP) == (k) ? 2 : 1); ++rep_)
#define GSYNC() do { xcd_barrier(xbar); if ((PROBE_REP) == 100) xcd_barrier(xbar); } while (0)

#define LAS __attribute__((address_space(3)))
typedef unsigned short bf16_t;
typedef short bf16x8 __attribute__((ext_vector_type(8)));
typedef float f32x4 __attribute__((ext_vector_type(4)));
typedef float f32x2 __attribute__((ext_vector_type(2)));
typedef unsigned u32x4 __attribute__((ext_vector_type(4)));
typedef unsigned u32x2 __attribute__((ext_vector_type(2)));

constexpr int SEQ = 16384, DM = 1024, DIN = 3864, PP = 4096  , DFF = 2816, NUP = 5632;
constexpr int C_Q = 0, C_KC = 512, C_VC = 640, C_KSL = 768, C_VSL = 896, C_KWN = 1024, C_VWN = 1152, C_U = 1280, C_GA = 1792, C_GB = 2816, C_NG = 3840;
constexpr int VTP = SEQ + 64;
constexpr float EPS = 1e-6f;
constexpr float NEGF = -1e30f;

constexpr size_t MiB = 1u << 20;
constexpr size_t WS_RSTD1 = 0, WS_RSS2 = 64 * 1024, WS_RSS3 = 128 * 1024, WS_ROPEC = 256 * 1024, WS_ROPES = 768 * 1024;
constexpr size_t WS_ABAR = 1280 * 1024, WS_A128 = WS_ABAR + 16384, WS_BIASPE = WS_A128 + 16384, WS_BBAR = 1536 * 1024  ;
constexpr size_t WS_SBUF = 2 * MiB  , WS_HID = 4 * MiB  , WS_KCMP = 6 * MiB  , WS_VCMPT = 6 * MiB + 512 * 1024  ;
constexpr size_t WS_WUP = 8 * MiB, WS_WDOWN = 20 * MiB, WS_WIN = 26 * MiB, WS_WGLU = 34 * MiB, WS_WPA = 35 * MiB, WS_WPB = 36 * MiB, WS_WOUT = 37 * MiB, WS_W1K = 39 * MiB, WS_W1V = 40 * MiB;
constexpr size_t WS_XB = 41 * MiB, WS_MERGED = 41 * MiB, WS_PROJ = 73 * MiB, WS_VSLT = 202 * MiB + 512 * 1024, WS_VWNT = 207 * MiB;
constexpr size_t WS_X1B = 220 * MiB, WS_UPRAW = 26 * MiB, WS_ACT = 122 * MiB;
constexpr size_t WS_BAR = 192 * 1024, WS_KSL = 212 * MiB, WS_KWN = 216 * MiB;
constexpr size_t OUT_YA = 0, OUT_YBP = 16 * MiB, OUT_YB = 32 * MiB;
static_assert(WS_PROJ + (size_t)(SEQ + 32) * PP * 2 <= WS_VSLT, "proj");
static_assert(WS_VSLT + (size_t)128 * VTP * 2 + 4096 <= WS_VWNT && WS_VWNT + (size_t)128 * VTP * 2 + 4096 <= WS_X1B, "vt");
static_assert(WS_UPRAW + (size_t)33 * 256 * NUP * 2 <= WS_ACT && WS_ACT + (size_t)SEQ * DFF * 2 <= WS_X1B, "ffn");

__device__ __forceinline__ unsigned cvt_pk_bf16(float lo, float hi) { unsigned r; asm volatile("v_cvt_pk_bf16_f32 %0, %1, %2" : "=v"(r) : "v"(lo), "v"(hi)); return r; }
__device__ __forceinline__ float bf_lo(unsigned w) { return __uint_as_float(w << 16); }
__device__ __forceinline__ float bf_hi(unsigned w) { return __uint_as_float(w & 0xffff0000u); }
__device__ __forceinline__ float bf2f(bf16_t b) { return __uint_as_float((unsigned)b << 16); }
__device__ __forceinline__ float sigmoidf_(float v) { return 1.f / (1.f + __expf(-v)); }
__device__ __forceinline__ float gelu_tanh(float v) { const float z = 0.7978845608028654f * (v + 0.044715f * v * v * v); const float th = 1.f - 2.f / (__expf(2.f * z) + 1.f); return 0.5f * v * (1.f + th); }
__device__ __forceinline__ u32x4 pack8(f32x4 a, f32x4 b) { u32x4 w; w.x = cvt_pk_bf16(a[0], a[1]); w.y = cvt_pk_bf16(a[2], a[3]); w.z = cvt_pk_bf16(b[0], b[1]); w.w = cvt_pk_bf16(b[2], b[3]); return w; }

namespace pg8 {
#define PG8_LAS __attribute__((address_space(3)))
constexpr int BM = 256, BK = 64, HALF = 128, HTB = HALF * BK * 2, STAGE_BYTES = 8 * HTB, NXCD = 8, WGM = 8;
__host__ __device__ __forceinline__ int lds_byte(int r, int c) { const int st = (r >> 4) * 2 + (c >> 5), rr = r & 15, cc = c & 31, ob = rr * 64 + cc * 2; return st * 1024 + (ob ^ (((ob >> 9) & 1) << 5)); }
__host__ __device__ __forceinline__ void stage_rc(int b, int& R, int& C) { const int st = b / 1024, sb = b % 1024, swz = sb ^ (((sb >> 9) & 1) << 5); R = (st >> 1) * 16 + swz / 64; C = (st & 1) * 32 + (swz % 64) / 2; }
__host__ __device__ __forceinline__ int perm32(int rho) { const int n = rho >> 4, i = rho & 15; return 8 * (i >> 2) + 4 * n + (i & 3); }
struct Unit { int pm, pn, z; const char* A; const char* B; };
struct Gemm { int K; unsigned lda_b; unsigned kstepA; };
__device__ __forceinline__ bool tile_of(long L, int nM, int nN, int& pm, int& pn) {
    const int nwg = nM * nN; if (L >= nwg) return false;
    int wgid = (int)L; { const int q = nwg / NXCD, r = nwg % NXCD, xcd = wgid % NXCD, off = wgid / NXCD; wgid = (xcd < r ? xcd * (q + 1) : r * (q + 1) + (xcd - r) * q) + off; }
    const int nig = WGM * nN, gid = wgid / nig, fm = gid * WGM, gsz = (nM - fm) < WGM ? (nM - fm) : WGM;
    pm = fm + ((wgid % nig) % gsz); pn = (wgid % nig) / gsz; return true;
}
template <class Epi, class Sched, bool ALIGN_EPI = false, bool SP2 = false>
__device__ __forceinline__ void gemm_phase(PG8_LAS unsigned char* lds, const Gemm g, const Sched& S, const Epi& E) {
    int tid_ = threadIdx.x; asm volatile("" : "+v"(tid_));
    const int tid = tid_, wid = __builtin_amdgcn_readfirstlane(tid >> 6), lane = tid & 63, wr = wid >> 2, wc = wid & 3, fr = lane & 15, fq = lane >> 4;
    const int K = g.K, nt = K / BK;
    unsigned voffA[2], voffB[2];
#pragma unroll
    for (int i = 0; i < 2; ++i) { int R, C; stage_rc(tid * 16 + i * 8192, R, C); const int Rb = Epi::PERM ? ((R & ~31) + perm32(R & 31)) : R;
        voffA[i] = (unsigned)R * g.lda_b + (unsigned)C * 2u; voffB[i] = (unsigned)(Rb * K + C) * 2u; }
    const size_t kstepA = (size_t)g.kstepA, kstepB = (size_t)(BK * 2);
    const size_t hstepA = (size_t)HALF * g.lda_b, hstepB = (size_t)HALF * K * 2;
    const unsigned ldsw = (unsigned)wid * 1024u;
    const int aoff = lds_byte(wr * 64 + fr, fq * 8), boff = lds_byte(wc * 32 + fr, fq * 8);
#define PG8_SA(b, h) (((b) * 2 + (h)) * HTB)
#define PG8_SB(b, h) ((4 + (b) * 2 + (h)) * HTB)
#define PG8_STAGE(bufoff, gbase, voff) do { _Pragma("unroll") for (int _i = 0; _i < 2; ++_i) \
        __builtin_amdgcn_global_load_lds((const unsigned*)((const char*)(gbase) + (voff)[_i]), (PG8_LAS unsigned*)(lds + (bufoff) + ldsw + _i * 8192), 16, 0, 0); } while (0)
#define PG8_LDA(dst, b, h) do { _Pragma("unroll") for (int m = 0; m < 4; ++m) _Pragma("unroll") for (int k = 0; k < 2; ++k) dst[m][k] = *(const PG8_LAS bf16x8*)(lds + PG8_SA(b, h) + aoff + m * 2048 + k * 1024); } while (0)
#define PG8_LDB(dst, b, h) do { _Pragma("unroll") for (int n = 0; n < 2; ++n) _Pragma("unroll") for (int k = 0; k < 2; ++k) dst[n][k] = *(const PG8_LAS bf16x8*)(lds + PG8_SB(b, h) + boff + n * 2048 + k * 1024); } while (0)
#define PG8_MMA(ai, bj, At, Bt) do { __builtin_amdgcn_s_setprio(1); _Pragma("unroll") for (int m = 0; m < 4; ++m) _Pragma("unroll") for (int n = 0; n < 2; ++n) _Pragma("unroll") for (int k = 0; k < 2; ++k) \
        acc[ai][bj][m][n] = __builtin_amdgcn_mfma_f32_16x16x32_bf16(Bt[n][k], At[m][k], acc[ai][bj][m][n], 0, 0, 0); __builtin_amdgcn_s_setprio(0); } while (0)
#define PG8_WAIT_V(n) asm volatile("s_waitcnt vmcnt(" #n ")" ::: "memory")
#define PG8_WAIT_L(n) asm volatile("s_waitcnt lgkmcnt(" #n ")" ::: "memory")
#define PG8_BAR __builtin_amdgcn_s_barrier()
#define PG8_SCHED __builtin_amdgcn_sched_barrier(0)
    Unit cur, nxt; int ui = 0;
    if (!S.next(0, cur)) return;
    f32x4 acc[2][2][4][2];
#pragma unroll
    for (int a = 0; a < 2; ++a)
#pragma unroll
        for (int b = 0; b < 2; ++b)
#pragma unroll
            for (int m = 0; m < 4; ++m)
#pragma unroll
                for (int n = 0; n < 2; ++n) acc[a][b][m][n] = (f32x4){0.f, 0.f, 0.f, 0.f};
    bf16x8 At[4][2], B0[2][2], B1[2][2];
    const char* cA = cur.A; const char* cB = cur.B;
    if constexpr (SP2) {
        PG8_STAGE(PG8_SB(0, 0), cB, voffB); PG8_STAGE(PG8_SB(0, 1), cB + hstepB, voffB); PG8_STAGE(PG8_SA(0, 0), cA, voffA); PG8_STAGE(PG8_SA(0, 1), cA + hstepA, voffA);
        if (wr == 1) PG8_BAR;
        PG8_WAIT_V(2); PG8_BAR;
        PG8_STAGE(PG8_SB(1, 0), cB + kstepB, voffB); PG8_STAGE(PG8_SA(1, 0), cA + kstepA, voffA); PG8_STAGE(PG8_SB(1, 1), cB + hstepB + kstepB, voffB);
        PG8_WAIT_V(6); PG8_BAR;
    } else {
        PG8_STAGE(PG8_SB(0, 0), cB, voffB); PG8_STAGE(PG8_SA(0, 0), cA, voffA); PG8_STAGE(PG8_SB(0, 1), cB + hstepB, voffB); PG8_STAGE(PG8_SA(0, 1), cA + hstepA, voffA);
        if (wr == 1) PG8_BAR;
        PG8_WAIT_V(4); PG8_BAR;
        PG8_STAGE(PG8_SB(1, 0), cB + kstepB, voffB); PG8_STAGE(PG8_SA(1, 0), cA + kstepA, voffA); PG8_STAGE(PG8_SB(1, 1), cB + hstepB + kstepB, voffB);
        PG8_WAIT_V(6); PG8_BAR;
    }
    for (;;) {
        const bool has_next = S.next(ui + 1, nxt);
        const char* nA = has_next ? nxt.A : cA; const char* nB = has_next ? nxt.B : cB;
        for (int t = 0; t < nt; t += 2) {
            const bool last = (t == nt - 2);
            const char* a1 = cA + (size_t)(t + 1) * kstepA;
            const char* a2 = last ? nA : cA + (size_t)(t + 2) * kstepA; const char* b2 = last ? nB : cB + (size_t)(t + 2) * kstepB;
            const char* a3 = a2 + kstepA; const char* b3 = b2 + kstepB;
            if constexpr (SP2) {
            PG8_LDB(B0, 0, 0); PG8_LDB(B1, 0, 1); PG8_SCHED; PG8_LDA(At, 0, 0); PG8_STAGE(PG8_SA(1, 1), a1 + hstepA, voffA);
            PG8_WAIT_V(8); PG8_WAIT_L(0); PG8_BAR; PG8_MMA(0, 0, At, B0); PG8_MMA(0, 1, At, B1); PG8_BAR; PG8_SCHED;
            PG8_LDA(At, 0, 1); PG8_STAGE(PG8_SB(0, 0), b2, voffB); PG8_STAGE(PG8_SB(0, 1), b2 + hstepB, voffB); PG8_STAGE(PG8_SA(0, 0), a2, voffA);
            PG8_WAIT_V(8); PG8_WAIT_L(0); PG8_BAR; PG8_MMA(1, 0, At, B0); PG8_MMA(1, 1, At, B1); PG8_BAR; PG8_SCHED;
            PG8_LDB(B0, 1, 0); PG8_LDB(B1, 1, 1); PG8_SCHED; PG8_LDA(At, 1, 0); PG8_STAGE(PG8_SA(0, 1), a2 + hstepA, voffA);
            PG8_WAIT_V(8); PG8_WAIT_L(0); PG8_BAR; PG8_MMA(0, 0, At, B0); PG8_MMA(0, 1, At, B1); PG8_BAR; PG8_SCHED;
            PG8_LDA(At, 1, 1); PG8_STAGE(PG8_SB(1, 0), b3, voffB); PG8_STAGE(PG8_SB(1, 1), b3 + hstepB, voffB); PG8_STAGE(PG8_SA(1, 0), a3, voffA);
            PG8_WAIT_V(8); PG8_WAIT_L(0); PG8_BAR; PG8_MMA(1, 0, At, B0); PG8_MMA(1, 1, At, B1); PG8_BAR; PG8_SCHED;
            } else {
            PG8_LDB(B0, 0, 0); PG8_SCHED; PG8_LDA(At, 0, 0); PG8_STAGE(PG8_SA(1, 1), a1 + hstepA, voffA);
            PG8_WAIT_L(8); PG8_BAR; PG8_WAIT_L(0); PG8_MMA(0, 0, At, B0); PG8_BAR; PG8_SCHED;
            PG8_LDB(B1, 0, 1); PG8_STAGE(PG8_SB(0, 0), b2, voffB);
            PG8_BAR; PG8_WAIT_L(0); PG8_MMA(0, 1, At, B1); PG8_BAR;
            PG8_LDA(At, 0, 1); PG8_STAGE(PG8_SA(0, 0), a2, voffA);
            PG8_BAR; PG8_WAIT_L(0); PG8_MMA(1, 0, At, B0); PG8_BAR; PG8_SCHED;
            PG8_STAGE(PG8_SB(0, 1), b2 + hstepB, voffB);
            PG8_WAIT_V(6); PG8_BAR; PG8_MMA(1, 1, At, B1); PG8_BAR;
            PG8_LDB(B0, 1, 0); PG8_SCHED; PG8_LDA(At, 1, 0); PG8_STAGE(PG8_SA(0, 1), a2 + hstepA, voffA);
            PG8_WAIT_L(8); PG8_BAR; PG8_WAIT_L(0); PG8_MMA(0, 0, At, B0); PG8_BAR; PG8_SCHED;
            PG8_LDB(B1, 1, 1); PG8_STAGE(PG8_SB(1, 0), b3, voffB);
            PG8_BAR; PG8_WAIT_L(0); PG8_MMA(0, 1, At, B1); PG8_BAR;
            PG8_LDA(At, 1, 1); PG8_STAGE(PG8_SA(1, 0), a3, voffA);
            PG8_BAR; PG8_WAIT_L(0); PG8_MMA(1, 0, At, B0); PG8_BAR; PG8_SCHED;
            PG8_STAGE(PG8_SB(1, 1), b3 + hstepB, voffB);
            PG8_WAIT_V(6); PG8_BAR; PG8_MMA(1, 1, At, B1); PG8_BAR;
            }
        }
        if constexpr (ALIGN_EPI) { if (wr == 0) PG8_BAR; }
        E(acc, cur, wr, wc, fr, fq);
        if (!has_next) break;
#pragma unroll
        for (int a = 0; a < 2; ++a)
#pragma unroll
            for (int b = 0; b < 2; ++b)
#pragma unroll
                for (int m = 0; m < 4; ++m)
#pragma unroll
                    for (int n = 0; n < 2; ++n) acc[a][b][m][n] = (f32x4){0.f, 0.f, 0.f, 0.f};
        cur = nxt; cA = nA; cB = nB; ++ui;
        if constexpr (ALIGN_EPI) { if (wr == 1) PG8_BAR; }
    }
    PG8_WAIT_V(0);
    if constexpr (!ALIGN_EPI) { if (wr == 0) PG8_BAR; }
    PG8_BAR;
#undef PG8_SA
#undef PG8_SB
#undef PG8_STAGE
#undef PG8_LDA
#undef PG8_LDB
#undef PG8_MMA
#undef PG8_WAIT_V
#undef PG8_WAIT_L
#undef PG8_BAR
#undef PG8_SCHED
}
}


struct SchedMN {
    int nM, nN, nz, G, c, pm_off; const char* A0; const char* A1; const char* B0; const char* B1; size_t a_tile, b_tile;
    __device__ __forceinline__ bool next(int i, pg8::Unit& u) const {
        int pm, pn; if (!pg8::tile_of((long)(i / nz) * G + c, nM, nN, pm, pn)) return false;
        u.z = i % nz; u.pm = pm + pm_off; u.pn = pn; u.A = (u.z ? A1 : A0) + (size_t)u.pm * a_tile; u.B = (u.z ? B1 : B0) + (size_t)pn * b_tile; return true;
    }
};
struct SchedCmp {
    int c; const char* proj; const char* w1k; const char* w1v;
    __device__ __forceinline__ bool next(int i, pg8::Unit& u) const {
        if (i > ((PROBE_REP) == 22 ? 1 : 0) || c >= 16) return false;
        u.z = c >> 2; u.pm = c & 3; u.pn = 0; const int which = u.z >> 1, kh = u.z & 1;
        u.A = proj + ((size_t)(16 * 256 * u.pm) * PP + (which ? C_VC : C_KC) + kh * 64) * 2; u.B = which ? w1v : w1k; return true;
    }
};

#define EPI_LOOP_ROWS for (int ai = 0; ai < 2; ++ai) _Pragma("unroll") for (int m = 0; m < 4; ++m)

struct EpiProj {
    static constexpr bool PERM = true;
    bf16_t* proj; bf16_t* vslt; bf16_t* vwnt; bf16_t* kslc; bf16_t* kwnc; const float* rstd; const float* ropec; const float* ropes;
    __device__ __forceinline__ void operator()(const f32x4 (&acc)[2][2][4][2], const pg8::Unit& u, int wr, int wc, int fr, int fq) const {
        const int pn = u.pn; const int row0 = u.pm * 256 + wr * 64 + fr;
        const bool sig = pn >= 7;
#pragma unroll
        EPI_LOOP_ROWS {
            const int row = row0 + ai * 128 + m * 16; const float rs = rstd[row];
            f32x4 c0, c1, s0, s1;
            c0 = *(const f32x4*)(ropec + row * 8); c1 = *(const f32x4*)(ropec + row * 8 + 4); s0 = *(const f32x4*)(ropes + row * 8); s1 = *(const f32x4*)(ropes + row * 8 + 4);
#pragma unroll
            for (int bj = 0; bj < 2; ++bj) {
                f32x4 v0 = acc[ai][bj][m][0] * rs, v1 = acc[ai][bj][m][1] * rs;
                const int colt = bj * 128 + wc * 32 + 8 * fq;
                const bool ropet = (pn <= 1) || ((pn == 3 || pn == 4) && bj == 0);
                if (ropet && (wc & 1) == 0) {
                    f32x4 p0, p1;
#pragma unroll
                    for (int e = 0; e < 4; ++e) { p0[e] = __shfl_xor(v0[e], 16); p1[e] = __shfl_xor(v1[e], 16); }
                    if (fq == 0) { v0 = v0 * c0 - p0 * s0; v1 = v1 * c1 - p1 * s1; }
                    else if (fq == 1) { v0 = v0 * c0 + p0 * s0; v1 = v1 * c1 + p1 * s1; }
                }
                if (pn <= 1) { v0 = v0 * (0.125f * 1.4426950408889634f); v1 = v1 * (0.125f * 1.4426950408889634f); }
                if (sig) {
#pragma unroll
                    for (int e = 0; e < 4; ++e) { v0[e] = sigmoidf_(v0[e]); v1[e] = sigmoidf_(v1[e]); }
                }
                const u32x4 w = pack8(v0, v1);
                *(u32x4*)(proj + (size_t)row * PP + pn * 256 + colt) = w;
                if ((pn == 3 || pn == 4) && bj == 0) { bf16_t* kc = (pn == 3) ? kslc : kwnc; *(u32x4*)(kc + ((size_t)(colt >> 6) * SEQ + row) * 64 + (colt & 63)) = w; }
                if ((pn == 3 || pn == 4) && bj == 1) {
                    bf16_t* vt = (pn == 3) ? vslt : vwnt; const int d0 = colt - 128;
                    vt[(size_t)(d0 + 0) * VTP + row] = (bf16_t)(w.x & 0xffff); vt[(size_t)(d0 + 1) * VTP + row] = (bf16_t)(w.x >> 16);
                    vt[(size_t)(d0 + 2) * VTP + row] = (bf16_t)(w.y & 0xffff); vt[(size_t)(d0 + 3) * VTP + row] = (bf16_t)(w.y >> 16);
                    vt[(size_t)(d0 + 4) * VTP + row] = (bf16_t)(w.z & 0xffff); vt[(size_t)(d0 + 5) * VTP + row] = (bf16_t)(w.z >> 16);
                    vt[(size_t)(d0 + 6) * VTP + row] = (bf16_t)(w.w & 0xffff); vt[(size_t)(d0 + 7) * VTP + row] = (bf16_t)(w.w >> 16);
                }
            }
        }
    }
};

struct EpiCmp {
    static constexpr bool PERM = true;
    bf16_t* hid; const float* biaspe;
    __device__ __forceinline__ void operator()(const f32x4 (&acc)[2][2][4][2], const pg8::Unit& u, int wr, int wc, int fr, int fq) const {
        const int row0 = u.pm * 256 + wr * 64 + fr; const int which = u.z >> 1;
#pragma unroll
        for (int bj = 0; bj < 2; ++bj) {
            const int col = bj * 128 + wc * 32 + 8 * fq;
            const f32x4 b0 = *(const f32x4*)(biaspe + which * 256 + col), b1 = *(const f32x4*)(biaspe + which * 256 + col + 4);
#pragma unroll
            EPI_LOOP_ROWS {
                const int row = row0 + ai * 128 + m * 16;
                f32x4 v0 = acc[ai][bj][m][0] + b0, v1 = acc[ai][bj][m][1] + b1;
#pragma unroll
                for (int e = 0; e < 4; ++e) { v0[e] = gelu_tanh(v0[e]); v1[e] = gelu_tanh(v1[e]); }
                *(u32x4*)(hid + ((size_t)u.z * 1024 + row) * 256 + col) = pack8(v0, v1);
            }
        }
    }
};

struct EpiGlu {
    static constexpr bool PERM = true;
    const bf16_t* ybp; bf16_t* yb;
    __device__ __forceinline__ void operator()(const f32x4 (&acc)[2][2][4][2], const pg8::Unit& u, int wr, int wc, int fr, int fq) const {
        const int row0 = u.pm * 256 + wr * 64 + fr;
#pragma unroll
        EPI_LOOP_ROWS {
            const int row = row0 + ai * 128 + m * 16;
#pragma unroll
            for (int bj = 0; bj < 2; ++bj) {
                const size_t off = (size_t)row * 512 + u.pn * 256 + bj * 128 + wc * 32 + 8 * fq;
                const u32x4 y = *(const u32x4*)(ybp + off);
                f32x4 v0 = acc[ai][bj][m][0], v1 = acc[ai][bj][m][1];
                v0[0] = bf_lo(y.x) * sigmoidf_(v0[0]); v0[1] = bf_hi(y.x) * sigmoidf_(v0[1]); v0[2] = bf_lo(y.y) * sigmoidf_(v0[2]); v0[3] = bf_hi(y.y) * sigmoidf_(v0[3]);
                v1[0] = bf_lo(y.z) * sigmoidf_(v1[0]); v1[1] = bf_hi(y.z) * sigmoidf_(v1[1]); v1[2] = bf_lo(y.w) * sigmoidf_(v1[2]); v1[3] = bf_hi(y.w) * sigmoidf_(v1[3]);
                *(u32x4*)(yb + off) = pack8(v0, v1);
            }
        }
    }
};

struct EpiMerge {
    static constexpr bool PERM = true;
    const bf16_t* proj; bf16_t* merged;
    __device__ __forceinline__ void operator()(const f32x4 (&acc)[2][2][4][2], const pg8::Unit& u, int wr, int wc, int fr, int fq) const {
        const int row0 = u.pm * 256 + wr * 64 + fr; const int gcol = u.z ? C_GB : C_GA;
#pragma unroll
        EPI_LOOP_ROWS {
            const int row = row0 + ai * 128 + m * 16;
#pragma unroll
            for (int bj = 0; bj < 2; ++bj) {
                const int col = u.pn * 256 + bj * 128 + wc * 32 + 8 * fq;
                const u32x4 gt = *(const u32x4*)(proj + (size_t)row * PP + gcol + col);
                f32x4 v0 = acc[ai][bj][m][0], v1 = acc[ai][bj][m][1];
                v0[0] *= bf_lo(gt.x); v0[1] *= bf_hi(gt.x); v0[2] *= bf_lo(gt.y); v0[3] *= bf_hi(gt.y);
                v1[0] *= bf_lo(gt.z); v1[1] *= bf_hi(gt.z); v1[2] *= bf_lo(gt.w); v1[3] *= bf_hi(gt.w);
                bf16_t* dst = merged + (size_t)row * DM + col;
                if (u.z) { const u32x4 o = *(const u32x4*)dst;
                    v0[0] += bf_lo(o.x); v0[1] += bf_hi(o.x); v0[2] += bf_lo(o.y); v0[3] += bf_hi(o.y); v1[0] += bf_lo(o.z); v1[1] += bf_hi(o.z); v1[2] += bf_lo(o.w); v1[3] += bf_hi(o.w); }
                *(u32x4*)dst = pack8(v0, v1);
            }
        }
    }
};

struct EpiRes {
    static constexpr bool PERM = true;
    const float* xin; float* xo; bf16_t* xb; float* rss;
    __device__ __forceinline__ void operator()(const f32x4 (&acc)[2][2][4][2], const pg8::Unit& u, int wr, int wc, int fr, int fq) const {
        const int row0 = u.pm * 256 + wr * 64 + fr;
#pragma unroll
        EPI_LOOP_ROWS {
            const int row = row0 + ai * 128 + m * 16; float ss = 0.f;
#pragma unroll
            for (int bj = 0; bj < 2; ++bj) {
                const size_t off = (size_t)row * DM + u.pn * 256 + bj * 128 + wc * 32 + 8 * fq;
                const f32x4 v0 = *(const f32x4*)(xin + off) + acc[ai][bj][m][0], v1 = *(const f32x4*)(xin + off + 4) + acc[ai][bj][m][1];
                *(f32x4*)(xo + off) = v0; *(f32x4*)(xo + off + 4) = v1;
                if (xb) *(u32x4*)(xb + off) = pack8(v0, v1);
                ss += (v0[0] * v0[0] + v0[1] * v0[1]) + (v0[2] * v0[2] + v0[3] * v0[3]) + (v1[0] * v1[0] + v1[1] * v1[1]) + (v1[2] * v1[2] + v1[3] * v1[3]);
            }
            ss += __shfl_xor(ss, 16); ss += __shfl_xor(ss, 32);
            if (fq == 0) atomicAdd(rss + row, ss);
        }
    }
};

struct EpiUp {
    static constexpr bool PERM = true;
    bf16_t* up; const float* rss; int rowbase;
    __device__ __forceinline__ void operator()(const f32x4 (&acc)[2][2][4][2], const pg8::Unit& u, int wr, int wc, int fr, int fq) const {
        const int row0 = u.pm * 256 + wr * 64 + fr;
#pragma unroll
        EPI_LOOP_ROWS {
            const int row = row0 + ai * 128 + m * 16; const float rs = rsqrtf(rss[row] * (1.f / DM) + EPS);
#pragma unroll
            for (int bj = 0; bj < 2; ++bj) {
                const size_t off = (size_t)(row - rowbase) * NUP + u.pn * 256 + bj * 128 + wc * 32 + 8 * fq;
                *(u32x4*)(up + off) = pack8(acc[ai][bj][m][0] * rs, acc[ai][bj][m][1] * rs);
            }
        }
    }
};

struct Args { const float* in[28]; float* out; unsigned char* ws; };
constexpr int NT = 512, NWV = 8;
constexpr int LDS_BYTES = 147456;

__device__ __forceinline__ float wave_sum(float v) {
#pragma unroll
    for (int o = 1; o < 64; o <<= 1) v += __shfl_xor(v, o);
    return v;
}

#define XB_TMO      128
#define XB_XCNT(j)  (256  + 64 * (j))
#define XB_XSUB(j)  (1280 + 64 * (j))
#define XB_XGEN(j)  (2304 + 64 * (j))
#define XB_TOP      3328
#define XB_TOPGEN   3392
#define XCD_BAR_WORDS 3456
#define XB_SPIN_CAP (1u << 18)

__device__ __forceinline__ unsigned xb_ld(unsigned* p)              { return __hip_atomic_load(p, __ATOMIC_RELAXED, __HIP_MEMORY_SCOPE_AGENT); }
__device__ __forceinline__ unsigned xb_add(unsigned* p, unsigned v) { return __hip_atomic_fetch_add(p, v, __ATOMIC_RELAXED, __HIP_MEMORY_SCOPE_AGENT); }
__device__ __forceinline__ unsigned xb_xcc_id() { return (unsigned)__builtin_amdgcn_s_getreg((3 << 11) | 20) & 0xFu; }
#define XB_SPIN(cond, bar) do { unsigned _sp = 0; while (cond) { __builtin_amdgcn_s_sleep(1); \
    if ((++_sp & 255u) == 0u) { if (xb_ld(&(bar)[XB_TMO])) break; if (_sp > XB_SPIN_CAP) { atomicAdd(&(bar)[XB_TMO], 1u); break; } } } } while (0)

struct XcdBarrier {
    unsigned* bar; unsigned x;
    volatile LAS unsigned* st;
};

__device__ __forceinline__ XcdBarrier xcd_barrier_post(unsigned* bar, volatile LAS unsigned* st) {
    XcdBarrier b; b.bar = bar; b.x = xb_xcc_id(); b.st = st;
    if (threadIdx.x == 0) (void)xb_add(&bar[XB_XCNT(b.x)], 1u);
    return b;
}
__device__ __forceinline__ void xcd_barrier_complete(unsigned* bar, unsigned x, unsigned& nloc, unsigned& nx) {
    const unsigned G = gridDim.x * gridDim.y * gridDim.z;
    unsigned sum, cnt, mine, sp = 0u;
    for (;;) {
        sum = 0u; cnt = 0u; mine = 0u;
#pragma unroll
        for (unsigned j = 0; j < 16; ++j) { const unsigned c = xb_ld(&bar[XB_XCNT(j)]); sum += c; cnt += (c > 0u) ? 1u : 0u; mine = (j == x) ? c : mine; }
        if (sum == G) break;
        __builtin_amdgcn_s_sleep(1);
        if ((++sp & 255u) == 0u) { if (xb_ld(&bar[XB_TMO])) break; if (sp > XB_SPIN_CAP) { atomicAdd(&bar[XB_TMO], 1u); break; } }
    }
    nloc = mine > 0u ? mine : 1u; nx = cnt > 0u ? cnt : 1u;
}

__device__ __forceinline__ void xcd_barrier(const XcdBarrier& b) {
    asm volatile("s_waitcnt vmcnt(0)" ::: "memory");
    __syncthreads();
    if (threadIdx.x == 0) {
        unsigned* bar = b.bar;
        __builtin_amdgcn_s_waitcnt(0);
        unsigned nloc = b.st[0], nx = b.st[1];
        if (nloc == 0u) { xcd_barrier_complete(bar, b.x, nloc, nx); b.st[0] = nloc; b.st[1] = nx; }
        const unsigned old = xb_add(&bar[XB_XSUB(b.x)], 1u);
        const unsigned gen = old / nloc;
        if (old + 1u == (gen + 1u) * nloc) {
            __builtin_amdgcn_fence(__ATOMIC_RELEASE, "agent");
            asm volatile("s_waitcnt vmcnt(0)" ::: "memory");
            const unsigned og = xb_add(&bar[XB_TOP], 1u);
            const unsigned tg = og / nx;
            if (og + 1u == (tg + 1u) * nx) xb_add(&bar[XB_TOPGEN], 1u);
            else XB_SPIN(xb_ld(&bar[XB_TOPGEN]) == tg, bar);
            __builtin_amdgcn_fence(__ATOMIC_ACQUIRE, "agent");
            xb_add(&bar[XB_XGEN(b.x)], 1u);
            asm volatile("s_waitcnt vmcnt(0)" ::: "memory");
        } else {
            XB_SPIN(xb_ld(&bar[XB_XGEN(b.x)]) == gen, bar);
            __builtin_amdgcn_fence(__ATOMIC_ACQUIRE, "agent");
            asm volatile("s_waitcnt vmcnt(0)" ::: "memory");
        }
    }
    __syncthreads();
}

__device__ __forceinline__ int colmap(int kind, int c) {
    if (kind == 1) return c < 1280 ? c : (c < 1304 ? C_NG + (c - 1280) : c - 24);
    if (kind == 2) { return c < DFF ? (c >> 7) * 256 + (c & 127) : ((c - DFF) >> 7) * 256 + 128 + ((c - DFF) & 127); }
    return c;
}
__device__ __forceinline__ void transpose_item(const float* W, int K, int N, bf16_t* WT, LAS float* scr, int kb, int nb, int lane, const float* kscale, int kind) {
    const int k0 = 64 * kb, n0 = 32 * nb;
#pragma unroll 8
    for (int i = 0; i < 32; ++i) { const int kk = 2 * i + (lane >> 5), n = n0 + (lane & 31); float v = (n < N) ? W[(size_t)(k0 + kk) * N + n] : 0.f; if (kscale) v *= kscale[k0 + kk]; scr[kk * 33 + (lane & 31)] = v; }
    asm volatile("s_waitcnt lgkmcnt(0)" ::: "memory");
    const int c = lane & 7;
#pragma unroll
    for (int j = 0; j < 4; ++j) { const int n = (lane >> 3) + 8 * j; const LAS float* s = scr + (8 * c) * 33 + n;
        if (n0 + n < N) { u32x4 o; o.x = cvt_pk_bf16(s[0 * 33], s[1 * 33]); o.y = cvt_pk_bf16(s[2 * 33], s[3 * 33]); o.z = cvt_pk_bf16(s[4 * 33], s[5 * 33]); o.w = cvt_pk_bf16(s[6 * 33], s[7 * 33]);
            *(u32x4*)(WT + (size_t)colmap(kind, n0 + n) * K + k0 + 8 * c) = o; } }
    asm volatile("s_waitcnt lgkmcnt(0)" ::: "memory");
}

#define EXP2(x) __builtin_amdgcn_exp2f(x)
#define MFMA16(a, b, c) __builtin_amdgcn_mfma_f32_16x16x32_bf16((a), (b), (c), 0, 0, 0)
__device__ __forceinline__ float dpp_x1(float v) { return __int_as_float(__builtin_amdgcn_update_dpp(0, __float_as_int(v), 0xB1, 0xF, 0xF, true)); }
__device__ __forceinline__ float dpp_x2(float v) { return __int_as_float(__builtin_amdgcn_update_dpp(0, __float_as_int(v), 0x4E, 0xF, 0xF, true)); }
struct KOp { bf16x8 a00, a01, a10, a11; };
struct VOp { bf16x8 v0, v1, v2, v3; };
__device__ __forceinline__ KOp ldk(const bf16_t* Kb, size_t pitch, int kb, int lane) {
    const int i = lane & 15, q = lane >> 4;
    const bf16_t* r0 = Kb + (size_t)(kb + 8 * (i >> 2) + (i & 3)) * pitch + 8 * q; const bf16_t* r1 = r0 + 4 * pitch;
    KOp k; k.a00 = *(const bf16x8*)r0; k.a01 = *(const bf16x8*)(r0 + 32); k.a10 = *(const bf16x8*)r1; k.a11 = *(const bf16x8*)(r1 + 32); return k;
}
__device__ __forceinline__ VOp ldv(const bf16_t* Vt, size_t vpitch, int kb, int lane) {
    const int i = lane & 15, q = lane >> 4; const bf16_t* r = Vt + (size_t)i * vpitch + kb + 8 * q;
    VOp v; v.v0 = *(const bf16x8*)r; v.v1 = *(const bf16x8*)(r + 16 * vpitch); v.v2 = *(const bf16x8*)(r + 32 * vpitch); v.v3 = *(const bf16x8*)(r + 48 * vpitch); return v;
}
__device__ __forceinline__ void qk32(const KOp& k, const bf16x8& Bq0, const bf16x8& Bq1, f32x4& S0, f32x4& S1) {
    const f32x4 z = {0.f, 0.f, 0.f, 0.f};
    S0 = MFMA16(k.a00, Bq0, z); S0 = MFMA16(k.a01, Bq1, S0); S1 = MFMA16(k.a10, Bq0, z); S1 = MFMA16(k.a11, Bq1, S1);
}
__device__ __forceinline__ void pv32(const VOp& v, const bf16x8& P, f32x4 (&O)[4]) {
    O[0] = MFMA16(v.v0, P, O[0]); O[1] = MFMA16(v.v1, P, O[1]); O[2] = MFMA16(v.v2, P, O[2]); O[3] = MFMA16(v.v3, P, O[3]);
}
__device__ __forceinline__ bf16x8 packP(const f32x4& p0, const f32x4& p1) { u32x4 w = pack8(p0, p1); return __builtin_bit_cast(bf16x8, w); }

struct KbLin { int base; __device__ __forceinline__ int operator()(int i) const { return base + 32 * i; } };
struct KbLds { const LAS int* l; __device__ __forceinline__ int operator()(int i) const { return l[i]; } };

template <bool NEEDV, class KB, class Body>
__device__ __forceinline__ void pipe3(int n, const KB kbf, Body& body, const bf16_t* Kb, size_t kp, const bf16_t* Vt, size_t vp, int lane) {
    if (n <= 0) return;
    KOp k0, k1; VOp v;
    k0 = ldk(Kb, kp, kbf(0), lane);
    for (int i = 0; i < n; i += 2) {
        { const int kb = kbf(i); if (NEEDV) v = ldv(Vt, vp, kb, lane); k1 = ldk(Kb, kp, kbf(i + 1 < n ? i + 1 : n - 1), lane); body.run(kb, k0, v); }
        if (i + 1 >= n) break;
        { const int kb = kbf(i + 1); if (NEEDV) v = ldv(Vt, vp, kb, lane); k0 = ldk(Kb, kp, kbf(i + 2 < n ? i + 2 : n - 1), lane); body.run(kb, k1, v); }
    }
}

struct BodyCmp1 {
    bf16x8 Bq[2][2]; int nv[2], q; float ml[2], ll[2];
    __device__ __forceinline__ void run(int kb, const KOp& k, const VOp&) {
#pragma unroll
        for (int cg = 0; cg < 2; ++cg) {
            f32x4 S0, S1; qk32(k, Bq[cg][0], Bq[cg][1], S0, S1);
            const int k0 = kb + 8 * q; float mloc = NEGF;
#pragma unroll
            for (int e = 0; e < 4; ++e) { if (k0 + e >= nv[cg]) S0[e] = NEGF; if (k0 + 4 + e >= nv[cg]) S1[e] = NEGF; mloc = fmaxf(mloc, fmaxf(S0[e], S1[e])); }
            const float mn = fmaxf(ml[cg], mloc); float ps = 0.f;
#pragma unroll
            for (int e = 0; e < 4; ++e) { ps += (k0 + e < nv[cg]) ? EXP2(S0[e] - mn) : 0.f; ps += (k0 + 4 + e < nv[cg]) ? EXP2(S1[e] - mn) : 0.f; }
            ll[cg] = ll[cg] * EXP2(ml[cg] - mn) + ps; ml[cg] = mn;
        }
    }
};
struct BodyCmp2 {
    bf16x8 Bq[2][2]; int nv[2], q, g; float mc[2], inv[2]; LAS float* ia[2]; f32x4 O[2][4];
    __device__ __forceinline__ void run(int kb, const KOp& k, const VOp& v) {
#pragma unroll
        for (int cg = 0; cg < 2; ++cg) {
            f32x4 S0, S1; qk32(k, Bq[cg][0], Bq[cg][1], S0, S1);
            const int k0 = kb + 8 * q; f32x4 p0, p1;
#pragma unroll
            for (int e = 0; e < 4; ++e) { p0[e] = (k0 + e < nv[cg]) ? EXP2(S0[e] - mc[cg]) * inv[cg] : 0.f; p1[e] = (k0 + 4 + e < nv[cg]) ? EXP2(S1[e] - mc[cg]) * inv[cg] : 0.f; }
            f32x4 s0 = p0, s1 = p1;
#pragma unroll
            for (int e = 0; e < 4; ++e) { s0[e] += dpp_x1(s0[e]); s0[e] += dpp_x2(s0[e]); s1[e] += dpp_x1(s1[e]); s1[e] += dpp_x2(s1[e]); }
            if (g == 0) { const int j = k0 >> 2; LAS float* a = ia[cg] + j;
                __hip_atomic_fetch_add(a, (s0[0] + s0[1]) + (s0[2] + 0.5f * s0[3]), __ATOMIC_RELAXED, __HIP_MEMORY_SCOPE_WORKGROUP);
                __hip_atomic_fetch_add(a + 1, 0.5f * s0[3] + ((s1[0] + s1[1]) + (s1[2] + 0.5f * s1[3])), __ATOMIC_RELAXED, __HIP_MEMORY_SCOPE_WORKGROUP);
                __hip_atomic_fetch_add(a + 2, 0.5f * s1[3], __ATOMIC_RELAXED, __HIP_MEMORY_SCOPE_WORKGROUP); }
            pv32(v, packP(p0, p1), O[cg]);
        }
    }
};
struct BodyWin {
    bf16x8 Bq[2][2]; int q, tt[2]; float m[2], l[2]; f32x4 O[2][4];
    __device__ __forceinline__ void run(int kb, const KOp& k, const VOp& v) {
#pragma unroll
        for (int cg = 0; cg < 2; ++cg) {
            f32x4 S0, S1; qk32(k, Bq[cg][0], Bq[cg][1], S0, S1);
            const int k0 = kb + 8 * q; unsigned vm = 0u;
#pragma unroll
            for (int e = 0; e < 8; ++e) { const bool ok = (k0 + e <= tt[cg]) && (tt[cg] - (k0 + e) < 512); vm |= ok ? (1u << e) : 0u; }
            float mloc = NEGF;
#pragma unroll
            for (int e = 0; e < 4; ++e) { if (!((vm >> e) & 1u)) S0[e] = NEGF; if (!((vm >> (4 + e)) & 1u)) S1[e] = NEGF; mloc = fmaxf(mloc, fmaxf(S0[e], S1[e])); }
            mloc = fmaxf(mloc, __shfl_xor(mloc, 16)); mloc = fmaxf(mloc, __shfl_xor(mloc, 32));
            const float mn = fmaxf(m[cg], mloc), alpha = EXP2(m[cg] - mn); m[cg] = mn;
            f32x4 p0, p1; float ps = 0.f;
#pragma unroll
            for (int e = 0; e < 4; ++e) { p0[e] = ((vm >> e) & 1u) ? EXP2(S0[e] - mn) : 0.f; p1[e] = ((vm >> (4 + e)) & 1u) ? EXP2(S1[e] - mn) : 0.f; ps += p0[e] + p1[e]; }
            l[cg] = l[cg] * alpha + ps;
#pragma unroll
            for (int dt = 0; dt < 4; ++dt) O[cg][dt] = O[cg][dt] * alpha;
            pv32(v, packP(p0, p1), O[cg]);
        }
    }
};

struct AttnT { const bf16_t* proj; const bf16_t* kslc; const bf16_t* kwnc; const bf16_t* kcmp; const bf16_t* vcmpT; const bf16_t* vslT; const bf16_t* vwnT; bf16_t* ya; };

constexpr int AL_IMP = 0  , AL_OS = 0  , AL_TM = 67584  , AL_CNT = 69632  ,
              AL_OFF = 70656  , AL_UNITS = 71744  , AL_MM = 77888  , AL_LS = 78912  ;
constexpr int OSP = 65;
__device__ __forceinline__ int f2ord(float f) { const int b = __float_as_int(f); return b >= 0 ? b : b ^ 0x7fffffff; }
__device__ __forceinline__ float ord2f(int b) { return __int_as_float(b >= 0 ? b : b ^ 0x7fffffff); }

__device__ __forceinline__ void attn_wave_part1(const AttnT& T, int kh, int tq8, int lane, LAS float* imp  , LAS unsigned* tm, int wave) {
    const int col = lane & 15, q = lane >> 4, tk = col >> 2, g = col & 3;
    const int t0 = tq8 * 8, h = kh * 4 + g;
    bf16x8 Bq[2][2]; float g0[2], g2[2]; int tcg[2];
#pragma unroll
    for (int cg = 0; cg < 2; ++cg) { tcg[cg] = t0 + 4 * cg + tk; const bf16_t* prow = T.proj + (size_t)tcg[cg] * PP;
        Bq[cg][0] = *(const bf16x8*)(prow + C_Q + h * 64 + 8 * q); Bq[cg][1] = *(const bf16x8*)(prow + C_Q + h * 64 + 32 + 8 * q);
        g0[cg] = bf2f(prow[C_NG + h * 3 + 0]); g2[cg] = bf2f(prow[C_NG + h * 3 + 2]); }
    for (int i = lane; i < 8 * 264; i += 64) imp[i] = 0.f;
    {
        const bf16_t* Kc = T.kcmp + (size_t)kh * 1024 * 64; const bf16_t* Vc = T.vcmpT + (size_t)kh * 64 * 1024;
        const int tmax = t0 + 7, nvmax = tmax >= 31 ? ((tmax - 31) >> 4) + 1 : 0, nsteps = (nvmax + 31) >> 5;
        BodyCmp1 b1;
#pragma unroll
        for (int cg = 0; cg < 2; ++cg) { b1.Bq[cg][0] = Bq[cg][0]; b1.Bq[cg][1] = Bq[cg][1]; b1.nv[cg] = tcg[cg] >= 31 ? ((tcg[cg] - 31) >> 4) + 1 : 0; b1.ml[cg] = NEGF; b1.ll[cg] = 0.f; }
        b1.q = q;
        pipe3<false>(nsteps, KbLin{0}, b1, Kc, 64, Vc, 1024, lane);
        BodyCmp2 b2; b2.q = q; b2.g = g;
#pragma unroll
        for (int cg = 0; cg < 2; ++cg) {
            float mc = fmaxf(b1.ml[cg], __shfl_xor(b1.ml[cg], 16)); mc = fmaxf(mc, __shfl_xor(mc, 32));
            float lc = b1.ll[cg] * EXP2(b1.ml[cg] - mc); lc += __shfl_xor(lc, 16); lc += __shfl_xor(lc, 32);
            b2.Bq[cg][0] = Bq[cg][0]; b2.Bq[cg][1] = Bq[cg][1]; b2.nv[cg] = b1.nv[cg]; b2.mc[cg] = mc; b2.inv[cg] = 1.f / fmaxf(lc, 1e-30f); b2.ia[cg] = imp + (4 * cg + tk) * 264;
#pragma unroll
            for (int dt = 0; dt < 4; ++dt) b2.O[cg][dt] = (f32x4){0.f, 0.f, 0.f, 0.f};
        }
        asm volatile("s_waitcnt lgkmcnt(0)" ::: "memory");
        pipe3<true>(nsteps, KbLin{0}, b2, Kc, 64, Vc, 1024, lane);
#pragma unroll
        for (int cg = 0; cg < 2; ++cg) { bf16_t* yrow = T.ya + (size_t)tcg[cg] * 512 + h * 64 + 4 * q;
#pragma unroll
            for (int dt = 0; dt < 4; ++dt) { const f32x4 o = b2.O[cg][dt] * g0[cg]; u32x2 w; w.x = cvt_pk_bf16(o[0], o[1]); w.y = cvt_pk_bf16(o[2], o[3]); *(u32x2*)(yrow + 16 * dt) = w; } }
    }
    asm volatile("s_waitcnt lgkmcnt(0)" ::: "memory");
    for (int tk2 = 0; tk2 < 8; ++tk2) {
        const int tt = t0 + tk2, cur = tt >> 6, nvalid = cur + 1, KSEL = nvalid < 16 ? nvalid : 16;
        int bits[4];
#pragma unroll
        for (int s = 0; s < 4; ++s) { const int j = s * 64 + lane; const float v = imp[tk2 * 264 + j];
            bits[s] = (j == 0 || j == cur) ? 0x7F000000 : (j < nvalid ? __float_as_int(v) : -1); }
        int prefix = 0;
        for (int bit = 30; bit >= 0; --bit) { const int Tt = prefix | (1 << bit); int cnt = 0;
#pragma unroll
            for (int s = 0; s < 4; ++s) cnt += __popcll(__ballot(bits[s] >= Tt));
            if (cnt >= KSEL) prefix = Tt; }
        unsigned long long sel[4]; int need = KSEL;
#pragma unroll
        for (int s = 0; s < 4; ++s) { sel[s] = __ballot(bits[s] > prefix); need -= __popcll(sel[s]); }
#pragma unroll
        for (int s = 0; s < 4; ++s) { unsigned long long me = __ballot(bits[s] == prefix);
            while (me != 0ull && need > 0) { const unsigned long long low = me & (0ull - me); sel[s] |= low; me ^= low; --need; } }
        const int tbi = wave * 8 + tk2; const unsigned tbit = 1u << (tbi & 31);
#pragma unroll
        for (int s = 0; s < 4; ++s) if ((sel[s] >> lane) & 1ull) __hip_atomic_fetch_or(tm + (s * 64 + lane) * 2 + (tbi >> 5), tbit, __ATOMIC_RELAXED, __HIP_MEMORY_SCOPE_WORKGROUP);
    }
    {
        const bf16_t* Kw = T.kwnc + (size_t)kh * SEQ * 64; const bf16_t* Vw = T.vwnT + (size_t)kh * 64 * VTP;
        const int klo = (t0 - 511 > 0 ? t0 - 511 : 0) & ~31; const int n = ((t0 + 7 - klo) >> 5) + 1;
        BodyWin bo; bo.q = q;
#pragma unroll
        for (int cg = 0; cg < 2; ++cg) { bo.Bq[cg][0] = Bq[cg][0]; bo.Bq[cg][1] = Bq[cg][1]; bo.tt[cg] = tcg[cg]; bo.m[cg] = NEGF; bo.l[cg] = 0.f;
#pragma unroll
            for (int dt = 0; dt < 4; ++dt) bo.O[cg][dt] = (f32x4){0.f, 0.f, 0.f, 0.f}; }
        pipe3<true>(n, KbLin{klo}, bo, Kw, 64, Vw, VTP, lane);
#pragma unroll
        for (int cg = 0; cg < 2; ++cg) { float l = bo.l[cg]; l += __shfl_xor(l, 16); l += __shfl_xor(l, 32);
            const float sc = g2[cg] / fmaxf(l, 1e-30f); bf16_t* yrow = T.ya + (size_t)tcg[cg] * 512 + h * 64 + 4 * q;
#pragma unroll
            for (int dt = 0; dt < 4; ++dt) { const u32x2 y = *(const u32x2*)(yrow + 16 * dt); const f32x4 o = bo.O[cg][dt] * sc;
                u32x2 w; w.x = cvt_pk_bf16(bf_lo(y.x) + o[0], bf_hi(y.x) + o[1]); w.y = cvt_pk_bf16(bf_lo(y.y) + o[2], bf_hi(y.y) + o[3]); *(u32x2*)(yrow + 16 * dt) = w; } }
    }
    asm volatile("s_waitcnt lgkmcnt(0)" ::: "memory");
}

struct UnitPre { int j; unsigned tlo, thi; bf16x8 q00, q01, q10, q11; KOp ka, kb; VOp va, vb; };
template <int PASS>
__device__ __forceinline__ UnitPre unit_load(const AttnT& T, const bf16_t* Ks, const bf16_t* Vs, int kh, int tile, const LAS u32x4* units, int u, int lane) {
    const int col = lane & 15, q = lane >> 4, slot = col >> 2, g = col & 3;
    const u32x4 d = units[u]; UnitPre P; P.j = __builtin_amdgcn_readfirstlane((int)d.x); P.tlo = (unsigned)__builtin_amdgcn_readfirstlane((int)d.y); P.thi = (unsigned)__builtin_amdgcn_readfirstlane((int)d.z);
    const unsigned t0b = (P.tlo >> (8 * slot)) & 0xffu, t1b = (P.thi >> (8 * slot)) & 0xffu;
    const bf16_t* qr0 = T.proj + (size_t)(tile * 64 + (t0b == 0xffu ? 0 : (int)t0b)) * PP + C_Q + (kh * 4 + g) * 64 + 8 * q;
    const bf16_t* qr1 = T.proj + (size_t)(tile * 64 + (t1b == 0xffu ? 0 : (int)t1b)) * PP + C_Q + (kh * 4 + g) * 64 + 8 * q;
    P.q00 = *(const bf16x8*)qr0; P.q01 = *(const bf16x8*)(qr0 + 32); P.q10 = *(const bf16x8*)qr1; P.q11 = *(const bf16x8*)(qr1 + 32);
    P.ka = ldk(Ks, 64, 64 * P.j, lane); P.kb = ldk(Ks, 64, 64 * P.j + 32, lane);
    if (PASS == 1) { P.va = ldv(Vs, VTP, 64 * P.j, lane); P.vb = ldv(Vs, VTP, 64 * P.j + 32, lane); }
    return P;
}
template <int PASS>
__device__ __forceinline__ void unit_group(const UnitPre& P, const bf16x8& q0, const bf16x8& q1, unsigned toks, int tile, LAS unsigned char* lds, int lane) {
    const int col = lane & 15, q = lane >> 4, slot = col >> 2, g = col & 3;
    const int ti = (int)((toks >> (8 * slot)) & 0xffu);
    f32x4 S0a, S1a, S0b, S1b; qk32(P.ka, q0, q1, S0a, S1a); qk32(P.kb, q0, q1, S0b, S1b);
    const bool valid = ti != 0xff; const int row = (valid ? ti : 0) * 4 + g;
    const int lim = (P.j == tile) ? (valid ? ti : -1) - 8 * q : (valid ? 1000 : -1);
    LAS int* mm = (LAS int*)(lds + AL_MM); LAS float* ls = (LAS float*)(lds + AL_LS);
    if (PASS == 0) {
        float mloc = NEGF;
#pragma unroll
        for (int e = 0; e < 4; ++e) { mloc = fmaxf(mloc, e <= lim ? S0a[e] : NEGF); mloc = fmaxf(mloc, e + 4 <= lim ? S1a[e] : NEGF); mloc = fmaxf(mloc, e + 32 <= lim ? S0b[e] : NEGF); mloc = fmaxf(mloc, e + 36 <= lim ? S1b[e] : NEGF); }
        mloc = fmaxf(mloc, __shfl_xor(mloc, 16)); mloc = fmaxf(mloc, __shfl_xor(mloc, 32));
        if (q == 0 && valid) __hip_atomic_fetch_max(mm + row, f2ord(mloc), __ATOMIC_RELAXED, __HIP_MEMORY_SCOPE_WORKGROUP);
    } else {
        const float m = ord2f(mm[row]);
        f32x4 p0a, p1a, p0b, p1b; float ps = 0.f;
#pragma unroll
        for (int e = 0; e < 4; ++e) { p0a[e] = e <= lim ? EXP2(S0a[e] - m) : 0.f; p1a[e] = e + 4 <= lim ? EXP2(S1a[e] - m) : 0.f; p0b[e] = e + 32 <= lim ? EXP2(S0b[e] - m) : 0.f; p1b[e] = e + 36 <= lim ? EXP2(S1b[e] - m) : 0.f;
            ps += (p0a[e] + p1a[e]) + (p0b[e] + p1b[e]); }
        ps += __shfl_xor(ps, 16); ps += __shfl_xor(ps, 32);
        if (q == 0 && valid) __hip_atomic_fetch_add(ls + row, ps, __ATOMIC_RELAXED, __HIP_MEMORY_SCOPE_WORKGROUP);
        f32x4 O[4];
#pragma unroll
        for (int dt = 0; dt < 4; ++dt) O[dt] = (f32x4){0.f, 0.f, 0.f, 0.f};
        pv32(P.va, packP(p0a, p1a), O); pv32(P.vb, packP(p0b, p1b), O);
        if (valid) { LAS float* orow = (LAS float*)(lds + AL_OS) + row * OSP + 4 * q;
#pragma unroll
            for (int dt = 0; dt < 4; ++dt)
#pragma unroll
                for (int c = 0; c < 4; ++c) __hip_atomic_fetch_add(orow + 16 * dt + c, O[dt][c], __ATOMIC_RELAXED, __HIP_MEMORY_SCOPE_WORKGROUP); }
    }
}
template <int PASS>
__device__ __forceinline__ void unit_compute(const UnitPre& P, int tile, LAS unsigned char* lds, int lane) {
    unit_group<PASS>(P, P.q00, P.q01, P.tlo, tile, lds, lane);
    if (P.thi != 0xffffffffu) unit_group<PASS>(P, P.q10, P.q11, P.thi, tile, lds, lane);
}
template <int PASS>
__device__ __forceinline__ void unit_pass(const AttnT& T, int kh, int tile, int n, LAS unsigned char* lds, int wave, int lane) {
    const bf16_t* Ks = T.kslc + (size_t)kh * SEQ * 64; const bf16_t* Vs = T.vslT + (size_t)kh * 64 * VTP;
    const LAS u32x4* units = (const LAS u32x4*)(lds + AL_UNITS);
    for (int u = wave; u < n; u += 8) { const UnitPre A = unit_load<PASS>(T, Ks, Vs, kh, tile, units, u, lane); unit_compute<PASS>(A, tile, lds, lane); }
}

__device__ __forceinline__ void attn_tile(const AttnT& T, int kh, int tile, LAS unsigned char* lds, int tid, int wave, int lane) {
    LAS unsigned* tm = (LAS unsigned*)(lds + AL_TM);
    for (int i = tid; i < 512; i += NT) tm[i] = 0u;
    __syncthreads();
    for (int r3 = 0; r3 < ((PROBE_REP) == 41 ? 2 : 1); ++r3)
    attn_wave_part1(T, kh, tile * 8 + wave, lane, (LAS float*)(lds + AL_IMP + wave * 8448), tm, wave);
    __threadfence_block(); __syncthreads();
    LAS int* cnt = (LAS int*)(lds + AL_CNT); LAS int* off = (LAS int*)(lds + AL_OFF); LAS u32x4* units = (LAS u32x4*)(lds + AL_UNITS);
    for (int i = tid; i < 256 * OSP; i += NT) ((LAS float*)(lds + AL_OS))[i] = 0.f;
    if (tid < 256) { ((LAS int*)(lds + AL_MM))[tid] = f2ord(NEGF); ((LAS float*)(lds + AL_LS))[tid] = 0.f; cnt[tid] = (__popc(tm[2 * tid]) + __popc(tm[2 * tid + 1]) + 7) >> 3; }
    __syncthreads();
    if (tid < 64) {
        const int c0 = cnt[4 * tid], c1 = cnt[4 * tid + 1], c2 = cnt[4 * tid + 2], c3 = cnt[4 * tid + 3]; const int tot = (c0 + c1) + (c2 + c3); int inc = tot;
#pragma unroll
        for (int o = 1; o < 64; o <<= 1) { const int v = __shfl_up(inc, o); if (tid >= o) inc += v; }
        const int ex = inc - tot; off[4 * tid] = ex; off[4 * tid + 1] = ex + c0; off[4 * tid + 2] = ex + c0 + c1; off[4 * tid + 3] = ex + c0 + c1 + c2;
        if (tid == 63) off[256] = inc;
    }
    __syncthreads();
    if (tid < 256) { unsigned long long mask = (unsigned long long)tm[2 * tid] | ((unsigned long long)tm[2 * tid + 1] << 32); int o = off[tid];
        while (mask != 0ull) { unsigned tl = 0xffffffffu, th = 0xffffffffu;
#pragma unroll
            for (int k = 0; k < 4; ++k) if (mask != 0ull) { const unsigned ti = (unsigned)__builtin_ctzll(mask); mask &= mask - 1ull; tl = (tl & ~(0xffu << (8 * k))) | (ti << (8 * k)); }
#pragma unroll
            for (int k = 0; k < 4; ++k) if (mask != 0ull) { const unsigned ti = (unsigned)__builtin_ctzll(mask); mask &= mask - 1ull; th = (th & ~(0xffu << (8 * k))) | (ti << (8 * k)); }
            units[o++] = (u32x4){(unsigned)tid, tl, th, 0u}; } }
    __syncthreads();
    const int n = off[256];
    unit_pass<0>(T, kh, tile, n, lds, wave, lane);
    if ((PROBE_REP) == 42) unit_pass<0>(T, kh, tile, n, lds, wave, lane);
    __syncthreads();
    unit_pass<1>(T, kh, tile, n, lds, wave, lane);
    __syncthreads();
    { const int ti = tid >> 3, part = tid & 7, g = part >> 1, d0 = 32 * (part & 1), row = ti * 4 + g, t = tile * 64 + ti, h = kh * 4 + g;
      const float l = ((const LAS float*)(lds + AL_LS))[row]; const float sc = bf2f(T.proj[(size_t)t * PP + C_NG + h * 3 + 1]) / fmaxf(l, 1e-30f);
      const LAS float* orow = (const LAS float*)(lds + AL_OS) + row * OSP + d0; u32x4* yp = (u32x4*)(T.ya + (size_t)t * 512 + h * 64 + d0);
#pragma unroll
      for (int i = 0; i < 4; ++i) { const u32x4 y = yp[i]; f32x4 a, b;
          a[0] = bf_lo(y.x) + orow[8 * i + 0] * sc; a[1] = bf_hi(y.x) + orow[8 * i + 1] * sc; a[2] = bf_lo(y.y) + orow[8 * i + 2] * sc; a[3] = bf_hi(y.y) + orow[8 * i + 3] * sc;
          b[0] = bf_lo(y.z) + orow[8 * i + 4] * sc; b[1] = bf_hi(y.z) + orow[8 * i + 5] * sc; b[2] = bf_lo(y.w) + orow[8 * i + 6] * sc; b[3] = bf_hi(y.w) + orow[8 * i + 7] * sc;
          yp[i] = pack8(a, b); } }
    __syncthreads();
}

__device__ __forceinline__ void ssm_load_u(const bf16_t* proj, int c, int g, int lane, LAS float* ubuf) {
#pragma unroll
    for (int r = 0; r < 2; ++r) { const int tl = lane + 64 * r; const u32x4* src = (const u32x4*)(proj + (size_t)(c * 128 + tl) * PP + C_U + g * 16); const u32x4 a = src[0], b = src[1];
        LAS f32x4* d = (LAS f32x4*)(ubuf + tl * 16);
        d[0] = (f32x4){bf_lo(a.x), bf_hi(a.x), bf_lo(a.y), bf_hi(a.y)}; d[1] = (f32x4){bf_lo(a.z), bf_hi(a.z), bf_lo(a.w), bf_hi(a.w)};
        d[2] = (f32x4){bf_lo(b.x), bf_hi(b.x), bf_lo(b.y), bf_hi(b.y)}; d[3] = (f32x4){bf_lo(b.z), bf_hi(b.z), bf_lo(b.w), bf_hi(b.w)}; }
    asm volatile("s_waitcnt lgkmcnt(0)" ::: "memory");
}
__device__ __forceinline__ f32x2 ssm_step(const f32x2 (&Bb)[16], const f32x2 A, const f32x2 x, const LAS float* urow) {
    const f32x4 u0 = *(const LAS f32x4*)(urow), u1 = *(const LAS f32x4*)(urow + 4), u2 = *(const LAS f32x4*)(urow + 8), u3 = *(const LAS f32x4*)(urow + 12);
    f32x2 bu = Bb[0] * u0[0]; f32x2 bv = Bb[1] * u0[1];
    bu += Bb[2] * u0[2]; bv += Bb[3] * u0[3]; bu += Bb[4] * u1[0]; bv += Bb[5] * u1[1]; bu += Bb[6] * u1[2]; bv += Bb[7] * u1[3];
    bu += Bb[8] * u2[0]; bv += Bb[9] * u2[1]; bu += Bb[10] * u2[2]; bv += Bb[11] * u2[3]; bu += Bb[12] * u3[0]; bv += Bb[13] * u3[1]; bu += Bb[14] * u3[2]; bv += Bb[15] * u3[3];
    bu += bv;
    f32x2 r; r.x = A.x * x.x - A.y * x.y + bu.x; r.y = A.x * x.y + A.y * x.x + bu.y; return r;
}
__device__ __forceinline__ void ssm_pass1(const unsigned char* ws, int c, int g, int lane, LAS float* ubuf) {
    const bf16_t* proj = (const bf16_t*)(ws + WS_PROJ);
    ssm_load_u(proj, c, g, lane, ubuf);
    const f32x2* Bbar = (const f32x2*)(ws + WS_BBAR) + (size_t)(g * 64 + lane) * 16; f32x2 Bb[16];
#pragma unroll
    for (int hh = 0; hh < 16; ++hh) Bb[hh] = Bbar[hh];
    const f32x2 A = ((const f32x2*)(ws + WS_ABAR))[g * 64 + lane];
    f32x2 x = {0.f, 0.f};
    for (int s = 0; s < 128; ++s) x = ssm_step(Bb, A, x, ubuf + s * 16);
    ((f32x2*)(ws + WS_SBUF))[(size_t)(c * 32 + g) * 64 + lane] = x;
    asm volatile("s_waitcnt lgkmcnt(0)" ::: "memory");
}
__device__ __forceinline__ void ssm_pass3(const Args& a, int c, int g, int lane, LAS float* ubuf, LAS unsigned char* xl  ) {
    const unsigned char* ws = a.ws; const bf16_t* proj = (const bf16_t*)(ws + WS_PROJ);
    ssm_load_u(proj, c, g, lane, ubuf);
    const f32x2* Bbar = (const f32x2*)(ws + WS_BBAR) + (size_t)(g * 64 + lane) * 16; f32x2 Bb[16];
#pragma unroll
    for (int hh = 0; hh < 16; ++hh) Bb[hh] = Bbar[hh];
    const f32x2 A = ((const f32x2*)(ws + WS_ABAR))[g * 64 + lane], A128 = ((const f32x2*)(ws + WS_A128))[g * 64 + lane];
    f32x2 x = {0.f, 0.f};
    { const f32x2* Sb = (const f32x2*)(ws + WS_SBUF) + g * 64 + lane;
      _Pragma("unroll 8") for (int cc = 0; cc < c; ++cc) { const f32x2 s = Sb[(size_t)cc * 32 * 64]; f32x2 r; r.x = A128.x * x.x - A128.y * x.y + s.x; r.y = A128.x * x.y + A128.y * x.x + s.y; x = r; } }
    const int hrow = lane & 15, q = lane >> 4; bf16x8 Cm[4];
    { const float* cre = a.in[14] + (size_t)(g * 16 + hrow) * 64; const float* cim = a.in[15] + (size_t)(g * 16 + hrow) * 64;
#pragma unroll
      for (int ks = 0; ks < 4; ++ks) { const f32x4 r = *(const f32x4*)(cre + 16 * ks + 4 * q), im = *(const f32x4*)(cim + 16 * ks + 4 * q);
          u32x4 w; w.x = cvt_pk_bf16(r[0], -im[0]); w.y = cvt_pk_bf16(r[1], -im[1]); w.z = cvt_pk_bf16(r[2], -im[2]); w.w = cvt_pk_bf16(r[3], -im[3]); Cm[ks] = __builtin_bit_cast(bf16x8, w); } }
    const f32x4 dsk = *(const f32x4*)(a.in[16] + g * 16 + 4 * q);
    bf16_t* ybp = (bf16_t*)((unsigned char*)a.out + OUT_YBP);
    for (int sub = 0; sub < 8; ++sub) {
#pragma unroll 4
        for (int s = 0; s < 16; ++s) { x = ssm_step(Bb, A, x, ubuf + (sub * 16 + s) * 16); *(LAS unsigned*)(xl + s * 272 + lane * 4) = cvt_pk_bf16(x.x, x.y); }
        asm volatile("s_waitcnt lgkmcnt(0)" ::: "memory");
        f32x4 acc = {0.f, 0.f, 0.f, 0.f};
#pragma unroll
        for (int ks = 0; ks < 4; ++ks) { const bf16x8 b = *(const LAS bf16x8*)(xl + hrow * 272 + ks * 64 + q * 16); acc = MFMA16(Cm[ks], b, acc); }
        const int tl = sub * 16 + hrow; const f32x4 uu = *(const LAS f32x4*)(ubuf + tl * 16 + 4 * q);
        f32x4 y = acc + dsk * uu;
        u32x2 w; w.x = cvt_pk_bf16(gelu_tanh(y[0]), gelu_tanh(y[1])); w.y = cvt_pk_bf16(gelu_tanh(y[2]), gelu_tanh(y[3]));
        *(u32x2*)(ybp + (size_t)(c * 128 + tl) * 512 + g * 16 + 4 * q) = w;
        asm volatile("s_waitcnt lgkmcnt(0)" ::: "memory");
    }
}

__global__ void __launch_bounds__(NT, 2) fwd_mega(Args a) {
    extern __shared__ __attribute__((aligned(16))) unsigned char lds_raw[];
    cg::grid_group grid = cg::this_grid();
    LAS unsigned char* lds = (LAS unsigned char*)lds_raw;
    const int tid = threadIdx.x, lane = tid & 63, wave = __builtin_amdgcn_readfirstlane(tid >> 6);
    const int G = gridDim.x, bid = blockIdx.x;
    const int gw = bid * NWV + wave, NGW = G * NWV;
    const int gt = bid * NT + tid, NGT = G * NT;
    unsigned char* ws = a.ws;
    const float* x = a.in[0];
    if (tid < 4) ((volatile LAS unsigned*)(lds + 131072 + 64))[tid] = 0u;
    if (bid == 0) for (int i = tid; i < XCD_BAR_WORDS; i += NT) ((unsigned*)(ws + WS_BAR))[i] = 0u;
    __syncthreads();

    {
        if (bid < 16) {
            LAS float* red = (LAS float*)lds;
            const int o = bid * 32 + (tid & 31), ksl = tid >> 5, which = o >> 8, colc = o & 255;
            const float* pe = a.in[which ? 7 : 4]; const float* w1 = a.in[which ? 8 : 5]; float s = 0.f;
            _Pragma("unroll 16") for (int k = ksl * 128; k < ksl * 128 + 128; ++k) s += pe[k] * w1[(size_t)k * 256 + colc];
            red[ksl * 32 + (tid & 31)] = s; __syncthreads();
            if (tid < 32) { float t = 0.f; for (int i = 0; i < 16; ++i) t += red[i * 32 + tid]; ((float*)(ws + WS_BIASPE))[o] = t; }
            __syncthreads();
        }
        LAS float* scr = (LAS float*)(lds + wave * 8448);
        constexpr int I_IN = 16 * 121, I_GLU = 8 * 16, I_PA = 8 * 32, I_OUT = 16 * 32, I_UP = 16 * 176, I_DN = 44 * 32, I_W1 = 32 * 8;
        constexpr int NITEMS = I_IN + I_GLU + 2 * I_PA + I_OUT + I_UP + I_DN + 2 * I_W1;
        for (int it = gw; it < NITEMS; it += NGW) {
            int r = it;
            if (r < I_IN) { transpose_item(a.in[3], 1024, DIN, (bf16_t*)(ws + WS_WIN), scr, r / 121, r % 121, lane, a.in[2], 1); continue; } r -= I_IN;
            if (r < I_GLU) { transpose_item(a.in[18], 512, 512, (bf16_t*)(ws + WS_WGLU), scr, r / 16, r % 16, lane, nullptr, 0); continue; } r -= I_GLU;
            if (r < I_PA) { transpose_item(a.in[19], 512, 1024, (bf16_t*)(ws + WS_WPA), scr, r / 32, r % 32, lane, nullptr, 0); continue; } r -= I_PA;
            if (r < I_PA) { transpose_item(a.in[20], 512, 1024, (bf16_t*)(ws + WS_WPB), scr, r / 32, r % 32, lane, nullptr, 0); continue; } r -= I_PA;
            if (r < I_OUT) { transpose_item(a.in[21], 1024, 1024, (bf16_t*)(ws + WS_WOUT), scr, r / 32, r % 32, lane, nullptr, 0); continue; } r -= I_OUT;
            if (r < I_UP) { transpose_item(a.in[23], 1024, NUP, (bf16_t*)(ws + WS_WUP), scr, r / 176, r % 176, lane, a.in[22], 2); continue; } r -= I_UP;
            if (r < I_DN) { transpose_item(a.in[26], DFF, 1024, (bf16_t*)(ws + WS_WDOWN), scr, r / 32, r % 32, lane, nullptr, 0); continue; } r -= I_DN;
            if (r < I_W1) { transpose_item(a.in[5], 2048, 256, (bf16_t*)(ws + WS_W1K), scr, r / 8, r % 8, lane, nullptr, 0); continue; } r -= I_W1;
            transpose_item(a.in[8], 2048, 256, (bf16_t*)(ws + WS_W1V), scr, r / 8, r % 8, lane, nullptr, 0);
        }
        { u32x4* p = (u32x4*)(ws + WS_WIN + (size_t)DIN * 1024 * 2); const int n = (4096 - DIN) * 1024 * 2 / 16; for (int i = gt; i < n; i += NGT) p[i] = (u32x4){0u, 0u, 0u, 0u}; }
        { u32x4* p = (u32x4*)(ws + WS_PROJ + (size_t)SEQ * PP * 2); const int n = 32 * PP * 2 / 16; for (int i = gt; i < n; i += NGT) p[i] = (u32x4){0u, 0u, 0u, 0u}; }
        for (int i = gt; i < 128 * 64 + 2048; i += NGT) {
            if (i < 128 * 64) { const int r = i >> 6, cidx = SEQ + (i & 63); ((bf16_t*)(ws + WS_VSLT))[(size_t)r * VTP + cidx] = 0; ((bf16_t*)(ws + WS_VWNT))[(size_t)r * VTP + cidx] = 0; }
            else { const int j = i - 128 * 64; ((bf16_t*)(ws + WS_VSLT))[(size_t)128 * VTP + j] = 0; ((bf16_t*)(ws + WS_VWNT))[(size_t)128 * VTP + j] = 0; }
        }
        for (int i = gt; i < SEQ; i += NGT) { ((float*)(ws + WS_RSS2))[i] = 0.f; ((float*)(ws + WS_RSS3))[i] = 0.f; }
        { const int* pos = (const int*)a.in[1];
          for (int i = gt; i < SEQ * 8; i += NGT) { const int tt = i >> 3, fi = i & 7; const float invf = powf(500000.0f, -(float)(2 * fi) / 16.0f); const float ang = (float)pos[tt] * invf;
              float sn, cs; sincosf(ang, &sn, &cs); ((float*)(ws + WS_ROPEC))[i] = cs; ((float*)(ws + WS_ROPES))[i] = sn; } }
        for (int i = gt; i < 2048; i += NGT) { const int gg = i >> 6;
            const float dt = expf(a.in[17][gg]), ar = a.in[10][i], ai = a.in[11][i];
            const float e = expf(ar * dt), em1 = expm1f(ar * dt), th = ai * dt; float sn, cs; sincosf(th, &sn, &cs); const float sh = sinf(0.5f * th);
            const float Ax = e * cs, Ay = e * sn; const float nx = em1 * cs - 2.f * sh * sh, ny = e * sn;
            const float den = 1.f / (ar * ar + ai * ai); const float fx = (nx * ar + ny * ai) * den, fy = (ny * ar - nx * ai) * den;
            ((f32x2*)(ws + WS_ABAR))[i] = (f32x2){Ax, Ay};
            float px = Ax, py = Ay;
            for (int k = 0; k < 7; ++k) { const float qx = px * px - py * py, qy = 2.f * px * py; px = qx; py = qy; }
            ((f32x2*)(ws + WS_A128))[i] = (f32x2){px, py};
            const float* bre = a.in[12] + (size_t)i * 16; const float* bim = a.in[13] + (size_t)i * 16; f32x2* Bo = (f32x2*)(ws + WS_BBAR) + (size_t)i * 16;
            for (int hh = 0; hh < 16; ++hh) Bo[hh] = (f32x2){fx * bre[hh] - fy * bim[hh], fx * bim[hh] + fy * bre[hh]};
        }
        for (int r = gw; r < SEQ; r += NGW) {
            const f32x4* xr = (const f32x4*)(x + (size_t)r * DM) + lane; f32x4 v[4]; float s = 0.f;
#pragma unroll
            for (int j = 0; j < 4; ++j) { v[j] = xr[64 * j]; s += (v[j][0] * v[j][0] + v[j][1] * v[j][1]) + (v[j][2] * v[j][2] + v[j][3] * v[j][3]); }
            s = wave_sum(s);
            if (lane == 0) ((float*)(ws + WS_RSTD1))[r] = rsqrtf(s * (1.f / DM) + EPS);
            u32x2* o = (u32x2*)(ws + WS_XB + (size_t)r * DM * 2) + lane;
#pragma unroll
            for (int j = 0; j < 4; ++j) { u32x2 w; w.x = cvt_pk_bf16(v[j][0], v[j][1]); w.y = cvt_pk_bf16(v[j][2], v[j][3]); o[64 * j] = w; }
        }
    }
    grid.sync();
    XcdBarrier xbar = xcd_barrier_post((unsigned*)(ws + WS_BAR), (volatile LAS unsigned*)(lds + 131072 + 64));

    REPS(1) {
        pg8::Gemm g{1024, 2048u, 128u};
        SchedMN S{64, 16, 1, G, bid, 0, (const char*)(ws + WS_XB), nullptr, (const char*)(ws + WS_WIN), nullptr, (size_t)256 * 1024 * 2, (size_t)256 * 1024 * 2};
        EpiProj E{(bf16_t*)(ws + WS_PROJ), (bf16_t*)(ws + WS_VSLT), (bf16_t*)(ws + WS_VWNT), (bf16_t*)(ws + WS_KSL), (bf16_t*)(ws + WS_KWN), (const float*)(ws + WS_RSTD1), (const float*)(ws + WS_ROPEC), (const float*)(ws + WS_ROPES)};
        pg8::gemm_phase<EpiProj, SchedMN, true, true>(lds, g, S, E);
    }
    GSYNC();

    {
        if (bid < 16) {
            pg8::Gemm g{2048, (unsigned)(16 * PP * 2), (unsigned)(PP * 2)};
            SchedCmp S{bid, (const char*)(ws + WS_PROJ), (const char*)(ws + WS_W1K), (const char*)(ws + WS_W1V)};
            EpiCmp E{(bf16_t*)(ws + WS_HID), (const float*)(ws + WS_BIASPE)};
            pg8::gemm_phase<EpiCmp, SchedCmp, true, true>(lds, g, S, E);
        } else {
            LAS float* ubuf = (LAS float*)(lds + wave * 16384);
            for (int it = (bid - 16) * NWV + wave; it < 4096 * ((PROBE_REP) == 12 ? 2 : 1); it += (G - 16) * NWV) ssm_pass1(ws, (it & 4095) >> 5, it & 31, lane, ubuf);
        }
    }
    GSYNC();

    REPS(3) {
        const bf16_t* hid = (const bf16_t*)(ws + WS_HID);
        for (int r = gw; r < 4096; r += NGW) {
            const int z = r >> 10, n = r & 1023, which = z >> 1, kh = z & 1;
            float acc = 0.f;
            if (n < 1023) { const float* w2 = a.in[which ? 9 : 6]; const bf16_t* hr = hid + (size_t)r * 256;
                _Pragma("unroll 16") for (int k = 0; k < 256; k += 2) { const unsigned hw = *(const unsigned*)(hr + k); acc += bf_lo(hw) * w2[k * 64 + lane]; acc += bf_hi(hw) * w2[(k + 1) * 64 + lane]; } }
            if (which == 0) {
                const float other = __shfl_xor(acc, 8); const int prow = 16 * n + 31; float o = acc;
                if (lane < 16 && n < 1023) { const float cs = ((const float*)(ws + WS_ROPEC))[prow * 8 + (lane & 7)], sn = ((const float*)(ws + WS_ROPES))[prow * 8 + (lane & 7)];
                    o = lane < 8 ? acc * cs - other * sn : acc * cs + other * sn; }
                ((bf16_t*)(ws + WS_KCMP))[((size_t)kh * 1024 + n) * 64 + lane] = (bf16_t)(cvt_pk_bf16(o, 0.f) & 0xffff);
            } else {
                ((bf16_t*)(ws + WS_VCMPT))[((size_t)kh * 64 + lane) * 1024 + n] = (bf16_t)(cvt_pk_bf16(acc, 0.f) & 0xffff);
            }
        }
    }
    GSYNC();

    {
        AttnT T{(const bf16_t*)(ws + WS_PROJ), (const bf16_t*)(ws + WS_KSL), (const bf16_t*)(ws + WS_KWN), (const bf16_t*)(ws + WS_KCMP), (const bf16_t*)(ws + WS_VCMPT), (const bf16_t*)(ws + WS_VSLT), (const bf16_t*)(ws + WS_VWNT), (bf16_t*)((unsigned char*)a.out + OUT_YA)};
        LAS float* wl = (LAS float*)(lds + wave * 16384);
        for (int r2 = 0; r2 < ((PROBE_REP) == 4 ? 2 : 1); ++r2)
        for (int pr = bid; pr < 256; pr += G) {
            const int xcd = pr & 7, slot = pr >> 3, kh = xcd & 1, tl = 32 * (xcd >> 1) + slot;
            attn_tile(T, kh, tl, lds, tid, wave, lane);
            attn_tile(T, kh, 255 - tl, lds, tid, wave, lane);
        }
        for (int it = gw; it < 4096 * ((PROBE_REP) == 14 ? 2 : 1); it += NGW) ssm_pass3(a, (it & 4095) >> 5, it & 31, lane, wl, lds + wave * 16384 + 8192);
    }
    GSYNC();

    REPS(5) {
        pg8::Gemm g{512, 1024u, 128u};
        SchedMN S{64, 2, 1, G, bid, 0, (const char*)a.out + OUT_YBP, nullptr, (const char*)(ws + WS_WGLU), nullptr, (size_t)256 * 512 * 2, (size_t)256 * 512 * 2};
        EpiGlu E{(const bf16_t*)((const unsigned char*)a.out + OUT_YBP), (bf16_t*)((unsigned char*)a.out + OUT_YB)};
        pg8::gemm_phase<EpiGlu, SchedMN, true, true>(lds, g, S, E);
    }
    GSYNC();

    REPS(6) {
        pg8::Gemm g{512, 1024u, 128u};
        SchedMN S{64, 4, 2, G, bid, 0, (const char*)a.out + OUT_YA, (const char*)a.out + OUT_YB, (const char*)(ws + WS_WPA), (const char*)(ws + WS_WPB), (size_t)256 * 512 * 2, (size_t)256 * 512 * 2};
        EpiMerge E{(const bf16_t*)(ws + WS_PROJ), (bf16_t*)(ws + WS_MERGED)};
        pg8::gemm_phase<EpiMerge, SchedMN, true, true>(lds, g, S, E);
    }
    GSYNC();

    {
        pg8::Gemm g{1024, 2048u, 128u};
        SchedMN S{64, 4, 1, G, bid, 0, (const char*)(ws + WS_MERGED), nullptr, (const char*)(ws + WS_WOUT), nullptr, (size_t)256 * 1024 * 2, (size_t)256 * 1024 * 2};
        EpiRes E{x, a.out, (bf16_t*)(ws + WS_X1B), (float*)(ws + WS_RSS2)};
        pg8::gemm_phase<EpiRes, SchedMN, true, true>(lds, g, S, E);
    }
    GSYNC();

    for (int half = 0; half < 2; ++half) {
        const int pm_off = half ? 31 : 0, nM = half ? 33 : 32, rowbase = pm_off * 256;
        REPS(8) {
            pg8::Gemm g{1024, 2048u, 128u};
            SchedMN S{nM, 22, 1, G, bid, pm_off, (const char*)(ws + WS_X1B), nullptr, (const char*)(ws + WS_WUP), nullptr, (size_t)256 * 1024 * 2, (size_t)256 * 1024 * 2};
            EpiUp E{(bf16_t*)(ws + WS_UPRAW), (const float*)(ws + WS_RSS2), rowbase};
            pg8::gemm_phase<EpiUp, SchedMN, true, true>(lds, g, S, E);
        }
        GSYNC();
        REPS(9) {
            const bf16_t* up = (const bf16_t*)(ws + WS_UPRAW); bf16_t* act = (bf16_t*)(ws + WS_ACT);
            const float* cw = a.in[24]; const float* cb = a.in[25];
            const int tlo = half ? 8192 : 0;
            for (int it = gt; it < 256 * 352; it += NGT) {
                const int cg8 = it % 352, tb = it / 352, c0 = cg8 * 8, tile = c0 >> 7, jj = c0 & 127;
                const int ucol = tile * 256 + jj;
                float wg[3][8], wv[3][8], bg[8], bv[8];
#pragma unroll
                for (int e = 0; e < 8; ++e) { bg[e] = cb[c0 + e]; bv[e] = cb[DFF + c0 + e];
#pragma unroll
                    for (int k = 0; k < 3; ++k) { wg[k][e] = cw[k * NUP + c0 + e]; wv[k][e] = cw[k * NUP + DFF + c0 + e]; } }
                const int ts = tlo + tb * 32;
                float g2[8], g1[8], v2[8], v1[8];
#pragma unroll
                for (int e = 0; e < 8; ++e) { g2[e] = g1[e] = v2[e] = v1[e] = 0.f; }
                if (ts >= 2) {
                    const u32x4 a2 = *(const u32x4*)(up + (size_t)(ts - 2 - rowbase) * NUP + ucol), b2 = *(const u32x4*)(up + (size_t)(ts - 2 - rowbase) * NUP + ucol + 128);
                    const u32x4 a1 = *(const u32x4*)(up + (size_t)(ts - 1 - rowbase) * NUP + ucol), b1 = *(const u32x4*)(up + (size_t)(ts - 1 - rowbase) * NUP + ucol + 128);
                    g2[0] = bf_lo(a2.x); g2[1] = bf_hi(a2.x); g2[2] = bf_lo(a2.y); g2[3] = bf_hi(a2.y); g2[4] = bf_lo(a2.z); g2[5] = bf_hi(a2.z); g2[6] = bf_lo(a2.w); g2[7] = bf_hi(a2.w);
                    v2[0] = bf_lo(b2.x); v2[1] = bf_hi(b2.x); v2[2] = bf_lo(b2.y); v2[3] = bf_hi(b2.y); v2[4] = bf_lo(b2.z); v2[5] = bf_hi(b2.z); v2[6] = bf_lo(b2.w); v2[7] = bf_hi(b2.w);
                    g1[0] = bf_lo(a1.x); g1[1] = bf_hi(a1.x); g1[2] = bf_lo(a1.y); g1[3] = bf_hi(a1.y); g1[4] = bf_lo(a1.z); g1[5] = bf_hi(a1.z); g1[6] = bf_lo(a1.w); g1[7] = bf_hi(a1.w);
                    v1[0] = bf_lo(b1.x); v1[1] = bf_hi(b1.x); v1[2] = bf_lo(b1.y); v1[3] = bf_hi(b1.y); v1[4] = bf_lo(b1.z); v1[5] = bf_hi(b1.z); v1[6] = bf_lo(b1.w); v1[7] = bf_hi(b1.w);
                }
                for (int s = 0; s < 32; ++s) {
                    const int tt = ts + s;
                    const u32x4 a0 = *(const u32x4*)(up + (size_t)(tt - rowbase) * NUP + ucol), b0 = *(const u32x4*)(up + (size_t)(tt - rowbase) * NUP + ucol + 128);
                    float gc[8], vc[8];
                    gc[0] = bf_lo(a0.x); gc[1] = bf_hi(a0.x); gc[2] = bf_lo(a0.y); gc[3] = bf_hi(a0.y); gc[4] = bf_lo(a0.z); gc[5] = bf_hi(a0.z); gc[6] = bf_lo(a0.w); gc[7] = bf_hi(a0.w);
                    vc[0] = bf_lo(b0.x); vc[1] = bf_hi(b0.x); vc[2] = bf_lo(b0.y); vc[3] = bf_hi(b0.y); vc[4] = bf_lo(b0.z); vc[5] = bf_hi(b0.z); vc[6] = bf_lo(b0.w); vc[7] = bf_hi(b0.w);
                    float o[8];
#pragma unroll
                    for (int e = 0; e < 8; ++e) { const float gg = bg[e] + wg[0][e] * g2[e] + wg[1][e] * g1[e] + wg[2][e] * gc[e]; const float vv = bv[e] + wv[0][e] * v2[e] + wv[1][e] * v1[e] + wv[2][e] * vc[e];
                        o[e] = gg * sigmoidf_(gg) * vv; g2[e] = g1[e]; g1[e] = gc[e]; v2[e] = v1[e]; v1[e] = vc[e]; }
                    u32x4 w; w.x = cvt_pk_bf16(o[0], o[1]); w.y = cvt_pk_bf16(o[2], o[3]); w.z = cvt_pk_bf16(o[4], o[5]); w.w = cvt_pk_bf16(o[6], o[7]);
                    *(u32x4*)(act + (size_t)tt * DFF + c0) = w;
                }
            }
        }
        GSYNC();
    }

    {
        pg8::Gemm g{DFF, (unsigned)(DFF * 2), 128u};
        SchedMN S{64, 4, 1, G, bid, 0, (const char*)(ws + WS_ACT), nullptr, (const char*)(ws + WS_WDOWN), nullptr, (size_t)256 * DFF * 2, (size_t)256 * DFF * 2};
        EpiRes E{a.out, a.out, nullptr, (float*)(ws + WS_RSS3)};
        pg8::gemm_phase<EpiRes, SchedMN, true, true>(lds, g, S, E);
    }
    GSYNC();

    {
        const float* gf = a.in[27];
        for (int r = gw; r < SEQ; r += NGW) {
            const float rs = rsqrtf(((const float*)(ws + WS_RSS3))[r] * (1.f / DM) + EPS);
            f32x4* xr = (f32x4*)(a.out + (size_t)r * DM) + lane; const f32x4* gr = (const f32x4*)gf + lane;
#pragma unroll
            for (int j = 0; j < 4; ++j) xr[64 * j] = xr[64 * j] * rs * gr[64 * j];
        }
    }
}

extern "C" void kernel_launch(void* const* d_in, const int* in_sizes, int n_in, void* d_out, int out_size, void* d_ws, size_t ws_size, hipStream_t stream) {
    static int grid = 0;
    if (grid == 0) {
        int dev = 0, cus = 0, per_cu = 0;
        (void)hipGetDevice(&dev); (void)hipDeviceGetAttribute(&cus, hipDeviceAttributeMultiprocessorCount, dev);
        (void)hipFuncSetAttribute((const void*)fwd_mega, hipFuncAttributeMaxDynamicSharedMemorySize, LDS_BYTES);
        (void)hipOccupancyMaxActiveBlocksPerMultiprocessor(&per_cu, (const void*)fwd_mega, NT, LDS_BYTES);
        if (per_cu < 1) { fprintf(stderr, "kernel_launch: occupancy query says %d blocks per CU\n", per_cu); per_cu = 1; }
        grid = cus;
        if (n_in != 28 || ws_size < 252 * MiB) fprintf(stderr, "kernel_launch: unexpected n_in %d / ws_size %zu\n", n_in, ws_size);
    }
    Args a{};
    for (int i = 0; i < 28; ++i) a.in[i] = (const float*)d_in[i];
    a.out = (float*)d_out; a.ws = (unsigned char*)d_ws;
    void* kargs[] = {&a};
    hipError_t e = hipLaunchCooperativeKernel((const void*)fwd_mega, dim3(grid), dim3(NT), kargs, LDS_BYTES, stream);
    if (e != hipSuccess) fprintf(stderr, "cooperative launch failed: %s (grid %d)\n", hipGetErrorString(e), grid);
}
```

```cpp
#include <hip/hip_runtime.h>
#include <hip/hip_cooperative_groups.h>
#include <cstdio>
#include <cstdint>
namespace cg = cooperative_groups;
#ifndef PROBE_REP
#define PROBE_REP -1
#endif
#ifndef EXPV
#define EXPV 0
#endif
#ifndef TSK
#define TSK -1
#endif
#define STAMP(i) do { if ((TSK) >= 0 && blockIdx.x == 0 && threadIdx.x == 0) ((unsigned long long*)(a.ws + 240 * 1024))[i] = __builtin_amdgcn_s_memrealtime(); } while (0)
#define ASTAMP(k) do { if ((TSK) >= 20 && blockIdx.x == 0 && threadIdx.x == 0) { const unsigned long long t_ = __builtin_amdgcn_s_memrealtime(); T.tsa[k] += t_ - T.tsa[15]; T.tsa[15] = t_; } } while (0)
#define REPS(k) _Pragma("nounroll") for (int rep_ = 0; rep_ < ((PROBE_REP) == (k) ? 2 : 1); ++rep_)
#define GSYNC() do { xcd_barrier(xbar); if ((PROBE_REP) == 100) xcd_barrier(xbar); } while (0)

#define LAS __attribute__((address_space(3)))
typedef unsigned short bf16_t;
typedef short bf16x8 __attribute__((ext_vector_type(8)));
typedef float f32x4 __attribute__((ext_vector_type(4)));
typedef float f32x2 __attribute__((ext_vector_type(2)));
typedef unsigned u32x4 __attribute__((ext_vector_type(4)));
typedef unsigned u32x2 __attribute__((ext_vector_type(2)));

constexpr int SEQ = 16384, DM = 1024, DIN = 3864, PP = 4096  , DFF = 2816, NUP = 5632;
constexpr int C_Q = 0, C_KC = 512, C_VC = 640, C_KSL = 768, C_VSL = 896, C_KWN = 1024, C_VWN = 1152, C_U = 1280, C_GA = 1792, C_GB = 2816, C_NG = 3840;
constexpr int VTP = SEQ + 64;
constexpr float EPS = 1e-6f;
constexpr float NEGF = -1e30f;

constexpr size_t MiB = 1u << 20;
constexpr size_t WS_RSTD1 = 0, WS_RSS2 = 64 * 1024, WS_RSS3 = 128 * 1024, WS_ROPEC = 256 * 1024, WS_ROPES = 768 * 1024;
constexpr size_t WS_ABAR = 1280 * 1024, WS_A128 = WS_ABAR + 16384, WS_BIASPE = WS_A128 + 16384, WS_BBAR = 1536 * 1024  ;
constexpr size_t WS_SBUF = 2 * MiB  , WS_HID = 4 * MiB  , WS_KCMP = 6 * MiB  , WS_VCMPT = 6 * MiB + 512 * 1024  ;
constexpr size_t WS_WUP = 8 * MiB, WS_WDOWN = 20 * MiB, WS_WIN = 26 * MiB, WS_WGLU = 34 * MiB, WS_WPA = 35 * MiB, WS_WPB = 36 * MiB, WS_WOUT = 37 * MiB, WS_W1K = 39 * MiB, WS_W1V = 40 * MiB;
constexpr size_t WS_XB = 41 * MiB, WS_MERGED = 41 * MiB, WS_PROJ = 73 * MiB, WS_VSLT = 202 * MiB + 512 * 1024, WS_VWNT = 207 * MiB;
constexpr size_t WS_X1B = 220 * MiB, WS_UPRAW = 26 * MiB, WS_ACT = 122 * MiB;
constexpr size_t WS_BAR = 192 * 1024, WS_KSL = 212 * MiB, WS_KWN = 216 * MiB;
constexpr size_t OUT_YA = 0, OUT_YBP = 16 * MiB, OUT_YB = 32 * MiB;
static_assert(WS_PROJ + (size_t)(SEQ + 32) * PP * 2 <= WS_VSLT, "proj");
static_assert(WS_VSLT + (size_t)128 * VTP * 2 + 4096 <= WS_VWNT && WS_VWNT + (size_t)128 * VTP * 2 + 4096 <= WS_X1B, "vt");
static_assert(WS_UPRAW + (size_t)33 * 256 * NUP * 2 <= WS_ACT && WS_ACT + (size_t)SEQ * DFF * 2 <= WS_X1B, "ffn");

__device__ __forceinline__ unsigned cvt_pk_bf16(float lo, float hi) { unsigned r; asm volatile("v_cvt_pk_bf16_f32 %0, %1, %2" : "=v"(r) : "v"(lo), "v"(hi)); return r; }
__device__ __forceinline__ float bf_lo(unsigned w) { return __uint_as_float(w << 16); }
__device__ __forceinline__ float bf_hi(unsigned w) { return __uint_as_float(w & 0xffff0000u); }
__device__ __forceinline__ float bf2f(bf16_t b) { return __uint_as_float((unsigned)b << 16); }
__device__ __forceinline__ float sigmoidf_(float v) { return 1.f / (1.f + __expf(-v)); }
__device__ __forceinline__ float gelu_tanh(float v) { const float z = 0.7978845608028654f * (v + 0.044715f * v * v * v); const float th = 1.f - 2.f / (__expf(2.f * z) + 1.f); return 0.5f * v * (1.f + th); }
__device__ __forceinline__ u32x4 pack8(f32x4 a, f32x4 b) { u32x4 w; w.x = cvt_pk_bf16(a[0], a[1]); w.y = cvt_pk_bf16(a[2], a[3]); w.z = cvt_pk_bf16(b[0], b[1]); w.w = cvt_pk_bf16(b[2], b[3]); return w; }

namespace pg8 {
#define PG8_LAS __attribute__((address_space(3)))
constexpr int BM = 256, BK = 64, HALF = 128, HTB = HALF * BK * 2, STAGE_BYTES = 8 * HTB, NXCD = 8, WGM = 8;
__host__ __device__ __forceinline__ int lds_byte(int r, int c) { const int st = (r >> 4) * 2 + (c >> 5), rr = r & 15, cc = c & 31, ob = rr * 64 + cc * 2; return st * 1024 + (ob ^ (((ob >> 9) & 1) << 5)); }
__host__ __device__ __forceinline__ void stage_rc(int b, int& R, int& C) { const int st = b / 1024, sb = b % 1024, swz = sb ^ (((sb >> 9) & 1) << 5); R = (st >> 1) * 16 + swz / 64; C = (st & 1) * 32 + (swz % 64) / 2; }
__host__ __device__ __forceinline__ int perm32(int rho) { const int n = rho >> 4, i = rho & 15; return 8 * (i >> 2) + 4 * n + (i & 3); }
struct Unit { int pm, pn, z; const char* A; const char* B; };
struct Gemm { int K; unsigned lda_b; unsigned kstepA; };
__device__ __forceinline__ bool tile_of(long L, int nM, int nN, int& pm, int& pn) {
    const int nwg = nM * nN; if (L >= nwg) return false;
    int wgid = (int)L; { const int q = nwg / NXCD, r = nwg % NXCD, xcd = wgid % NXCD, off = wgid / NXCD; wgid = (xcd < r ? xcd * (q + 1) : r * (q + 1) + (xcd - r) * q) + off; }
    const int nig = WGM * nN, gid = wgid / nig, fm = gid * WGM, gsz = (nM - fm) < WGM ? (nM - fm) : WGM;
    pm = fm + ((wgid % nig) % gsz); pn = (wgid % nig) / gsz; return true;
}
template <class Epi, class Sched, bool ALIGN_EPI = false, bool SP2 = false>
__device__ __forceinline__ void gemm_phase(PG8_LAS unsigned char* lds, const Gemm g, const Sched& S, const Epi& E) {
    int tid_ = threadIdx.x; asm volatile("" : "+v"(tid_));
    const int tid = tid_, wid = __builtin_amdgcn_readfirstlane(tid >> 6), lane = tid & 63, wr = wid >> 2, wc = wid & 3, fr = lane & 15, fq = lane >> 4;
    const int K = g.K, nt = K / BK;
    unsigned voffA[2], voffB[2];
#pragma unroll
    for (int i = 0; i < 2; ++i) { int R, C; stage_rc(tid * 16 + i * 8192, R, C); const int Rb = Epi::PERM ? ((R & ~31) + perm32(R & 31)) : R;
        voffA[i] = (unsigned)R * g.lda_b + (unsigned)C * 2u; voffB[i] = (unsigned)(Rb * K + C) * 2u; }
    const size_t kstepA = (size_t)g.kstepA, kstepB = (size_t)(BK * 2);
    const size_t hstepA = (size_t)HALF * g.lda_b, hstepB = (size_t)HALF * K * 2;
    const unsigned ldsw = (unsigned)wid * 1024u;
    const int aoff = lds_byte(wr * 64 + fr, fq * 8), boff = lds_byte(wc * 32 + fr, fq * 8);
#define PG8_SA(b, h) (((b) * 2 + (h)) * HTB)
#define PG8_SB(b, h) ((4 + (b) * 2 + (h)) * HTB)
#define PG8_STAGE(bufoff, gbase, voff) do { _Pragma("unroll") for (int _i = 0; _i < 2; ++_i) \
        __builtin_amdgcn_global_load_lds((const unsigned*)((const char*)(gbase) + (voff)[_i]), (PG8_LAS unsigned*)(lds + (bufoff) + ldsw + _i * 8192), 16, 0, 0); } while (0)
#define PG8_LDA(dst, b, h) do { _Pragma("unroll") for (int m = 0; m < 4; ++m) _Pragma("unroll") for (int k = 0; k < 2; ++k) dst[m][k] = *(const PG8_LAS bf16x8*)(lds + PG8_SA(b, h) + aoff + m * 2048 + k * 1024); } while (0)
#define PG8_LDB(dst, b, h) do { _Pragma("unroll") for (int n = 0; n < 2; ++n) _Pragma("unroll") for (int k = 0; k < 2; ++k) dst[n][k] = *(const PG8_LAS bf16x8*)(lds + PG8_SB(b, h) + boff + n * 2048 + k * 1024); } while (0)
#define PG8_MMA(ai, bj, At, Bt) do { __builtin_amdgcn_s_setprio(1); _Pragma("unroll") for (int m = 0; m < 4; ++m) _Pragma("unroll") for (int n = 0; n < 2; ++n) _Pragma("unroll") for (int k = 0; k < 2; ++k) \
        acc[ai][bj][m][n] = __builtin_amdgcn_mfma_f32_16x16x32_bf16(Bt[n][k], At[m][k], acc[ai][bj][m][n], 0, 0, 0); __builtin_amdgcn_s_setprio(0); } while (0)
#define PG8_WAIT_V(n) asm volatile("s_waitcnt vmcnt(" #n ")" ::: "memory")
#define PG8_WAIT_L(n) asm volatile("s_waitcnt lgkmcnt(" #n ")" ::: "memory")
#define PG8_BAR __builtin_amdgcn_s_barrier()
#define PG8_SCHED __builtin_amdgcn_sched_barrier(0)
    Unit cur, nxt; int ui = 0;
    if (!S.next(0, cur)) return;
    f32x4 acc[2][2][4][2];
#pragma unroll
    for (int a = 0; a < 2; ++a)
#pragma unroll
        for (int b = 0; b < 2; ++b)
#pragma unroll
            for (int m = 0; m < 4; ++m)
#pragma unroll
                for (int n = 0; n < 2; ++n) acc[a][b][m][n] = (f32x4){0.f, 0.f, 0.f, 0.f};
    bf16x8 At[4][2], B0[2][2], B1[2][2];
    const char* cA = cur.A; const char* cB = cur.B;
    if constexpr (SP2) {
        PG8_STAGE(PG8_SB(0, 0), cB, voffB); PG8_STAGE(PG8_SB(0, 1), cB + hstepB, voffB); PG8_STAGE(PG8_SA(0, 0), cA, voffA); PG8_STAGE(PG8_SA(0, 1), cA + hstepA, voffA);
        if (wr == 1) PG8_BAR;
        PG8_WAIT_V(2); PG8_BAR;
        PG8_STAGE(PG8_SB(1, 0), cB + kstepB, voffB); PG8_STAGE(PG8_SA(1, 0), cA + kstepA, voffA); PG8_STAGE(PG8_SB(1, 1), cB + hstepB + kstepB, voffB);
        PG8_WAIT_V(6); PG8_BAR;
    } else {
        PG8_STAGE(PG8_SB(0, 0), cB, voffB); PG8_STAGE(PG8_SA(0, 0), cA, voffA); PG8_STAGE(PG8_SB(0, 1), cB + hstepB, voffB); PG8_STAGE(PG8_SA(0, 1), cA + hstepA, voffA);
        if (wr == 1) PG8_BAR;
        PG8_WAIT_V(4); PG8_BAR;
        PG8_STAGE(PG8_SB(1, 0), cB + kstepB, voffB); PG8_STAGE(PG8_SA(1, 0), cA + kstepA, voffA); PG8_STAGE(PG8_SB(1, 1), cB + hstepB + kstepB, voffB);
        PG8_WAIT_V(6); PG8_BAR;
    }
    for (;;) {
        const bool has_next = S.next(ui + 1, nxt);
        const char* nA = has_next ? nxt.A : cA; const char* nB = has_next ? nxt.B : cB;
        for (int t = 0; t < nt; t += 2) {
            const bool last = (t == nt - 2);
            const char* a1 = cA + (size_t)(t + 1) * kstepA;
            const char* a2 = last ? nA : cA + (size_t)(t + 2) * kstepA; const char* b2 = last ? nB : cB + (size_t)(t + 2) * kstepB;
            const char* a3 = a2 + kstepA; const char* b3 = b2 + kstepB;
            if constexpr (SP2) {
            PG8_LDB(B0, 0, 0); PG8_LDB(B1, 0, 1); PG8_SCHED; PG8_LDA(At, 0, 0); PG8_STAGE(PG8_SA(1, 1), a1 + hstepA, voffA);
            PG8_WAIT_V(8); PG8_WAIT_L(0); PG8_BAR; PG8_MMA(0, 0, At, B0); PG8_MMA(0, 1, At, B1); PG8_BAR; PG8_SCHED;
            PG8_LDA(At, 0, 1); PG8_STAGE(PG8_SB(0, 0), b2, voffB); PG8_STAGE(PG8_SB(0, 1), b2 + hstepB, voffB); PG8_STAGE(PG8_SA(0, 0), a2, voffA);
            PG8_WAIT_V(8); PG8_WAIT_L(0); PG8_BAR; PG8_MMA(1, 0, At, B0); PG8_MMA(1, 1, At, B1); PG8_BAR; PG8_SCHED;
            PG8_LDB(B0, 1, 0); PG8_LDB(B1, 1, 1); PG8_SCHED; PG8_LDA(At, 1, 0); PG8_STAGE(PG8_SA(0, 1), a2 + hstepA, voffA);
            PG8_WAIT_V(8); PG8_WAIT_L(0); PG8_BAR; PG8_MMA(0, 0, At, B0); PG8_MMA(0, 1, At, B1); PG8_BAR; PG8_SCHED;
            PG8_LDA(At, 1, 1); PG8_STAGE(PG8_SB(1, 0), b3, voffB); PG8_STAGE(PG8_SB(1, 1), b3 + hstepB, voffB); PG8_STAGE(PG8_SA(1, 0), a3, voffA);
            PG8_WAIT_V(8); PG8_WAIT_L(0); PG8_BAR; PG8_MMA(1, 0, At, B0); PG8_MMA(1, 1, At, B1); PG8_BAR; PG8_SCHED;
            } else {
            PG8_LDB(B0, 0, 0); PG8_SCHED; PG8_LDA(At, 0, 0); PG8_STAGE(PG8_SA(1, 1), a1 + hstepA, voffA);
            PG8_WAIT_L(8); PG8_BAR; PG8_WAIT_L(0); PG8_MMA(0, 0, At, B0); PG8_BAR; PG8_SCHED;
            PG8_LDB(B1, 0, 1); PG8_STAGE(PG8_SB(0, 0), b2, voffB);
            PG8_BAR; PG8_WAIT_L(0); PG8_MMA(0, 1, At, B1); PG8_BAR;
            PG8_LDA(At, 0, 1); PG8_STAGE(PG8_SA(0, 0), a2, voffA);
            PG8_BAR; PG8_WAIT_L(0); PG8_MMA(1, 0, At, B0); PG8_BAR; PG8_SCHED;
            PG8_STAGE(PG8_SB(0, 1), b2 + hstepB, voffB);
            PG8_WAIT_V(6); PG8_BAR; PG8_MMA(1, 1, At, B1); PG8_BAR;
            PG8_LDB(B0, 1, 0); PG8_SCHED; PG8_LDA(At, 1, 0); PG8_STAGE(PG8_SA(0, 1), a2 + hstepA, voffA);
            PG8_WAIT_L(8); PG8_BAR; PG8_WAIT_L(0); PG8_MMA(0, 0, At, B0); PG8_BAR; PG8_SCHED;
            PG8_LDB(B1, 1, 1); PG8_STAGE(PG8_SB(1, 0), b3, voffB);
            PG8_BAR; PG8_WAIT_L(0); PG8_MMA(0, 1, At, B1); PG8_BAR;
            PG8_LDA(At, 1, 1); PG8_STAGE(PG8_SA(1, 0), a3, voffA);
            PG8_BAR; PG8_WAIT_L(0); PG8_MMA(1, 0, At, B0); PG8_BAR; PG8_SCHED;
            PG8_STAGE(PG8_SB(1, 1), b3 + hstepB, voffB);
            PG8_WAIT_V(6); PG8_BAR; PG8_MMA(1, 1, At, B1); PG8_BAR;
            }
        }
        if constexpr (ALIGN_EPI) { if (wr == 0) PG8_BAR; }
        E(acc, cur, wr, wc, fr, fq);
        if (!has_next) break;
#pragma unroll
        for (int a = 0; a < 2; ++a)
#pragma unroll
            for (int b = 0; b < 2; ++b)
#pragma unroll
                for (int m = 0; m < 4; ++m)
#pragma unroll
                    for (int n = 0; n < 2; ++n) acc[a][b][m][n] = (f32x4){0.f, 0.f, 0.f, 0.f};
        cur = nxt; cA = nA; cB = nB; ++ui;
        if constexpr (ALIGN_EPI) { if (wr == 1) PG8_BAR; }
    }
    PG8_WAIT_V(0);
    if constexpr (!ALIGN_EPI) { if (wr == 0) PG8_BAR; }
    PG8_BAR;
#undef PG8_SA
#undef PG8_SB
#undef PG8_STAGE
#undef PG8_LDA
#undef PG8_LDB
#undef PG8_MMA
#undef PG8_WAIT_V
#undef PG8_WAIT_L
#undef PG8_BAR
#undef PG8_SCHED
}
}


struct SchedMN {
    int nM, nN, nz, G, c, pm_off; const char* A0; const char* A1; const char* B0; const char* B1; size_t a_tile, b_tile;
    __device__ __forceinline__ bool next(int i, pg8::Unit& u) const {
        int pm, pn; if (!pg8::tile_of((long)(i / nz) * G + c, nM, nN, pm, pn)) return false;
        u.z = i % nz; u.pm = pm + pm_off; u.pn = pn; u.A = (u.z ? A1 : A0) + (size_t)u.pm * a_tile; u.B = (u.z ? B1 : B0) + (size_t)pn * b_tile; return true;
    }
};
struct SchedCmp {
    int c; const char* proj; const char* w1k; const char* w1v;
    __device__ __forceinline__ bool next(int i, pg8::Unit& u) const {
        if (i > ((PROBE_REP) == 22 ? 1 : 0) || c >= 16) return false;
        u.z = c >> 2; u.pm = c & 3; u.pn = 0; const int which = u.z >> 1, kh = u.z & 1;
        u.A = proj + ((size_t)(16 * 256 * u.pm) * PP + (which ? C_VC : C_KC) + kh * 64) * 2; u.B = which ? w1v : w1k; return true;
    }
};

#define EPI_LOOP_ROWS for (int ai = 0; ai < 2; ++ai) _Pragma("unroll") for (int m = 0; m < 4; ++m)

struct EpiProj {
    static constexpr bool PERM = true;
    bf16_t* proj; bf16_t* vslt; bf16_t* vwnt; bf16_t* kslc; bf16_t* kwnc; const float* rstd; const float* ropec; const float* ropes;
    __device__ __forceinline__ void operator()(const f32x4 (&acc)[2][2][4][2], const pg8::Unit& u, int wr, int wc, int fr, int fq) const {
        const int pn = u.pn; const int row0 = u.pm * 256 + wr * 64 + fr;
        const bool sig = pn >= 7;
#pragma unroll
        EPI_LOOP_ROWS {
            const int row = row0 + ai * 128 + m * 16; const float rs = rstd[row];
            f32x4 c0, c1, s0, s1;
            c0 = *(const f32x4*)(ropec + row * 8); c1 = *(const f32x4*)(ropec + row * 8 + 4); s0 = *(const f32x4*)(ropes + row * 8); s1 = *(const f32x4*)(ropes + row * 8 + 4);
#pragma unroll
            for (int bj = 0; bj < 2; ++bj) {
                f32x4 v0 = acc[ai][bj][m][0] * rs, v1 = acc[ai][bj][m][1] * rs;
                const int colt = bj * 128 + wc * 32 + 8 * fq;
                const bool ropet = (pn <= 1) || ((pn == 3 || pn == 4) && bj == 0);
                if (ropet && (wc & 1) == 0) {
                    f32x4 p0, p1;
#pragma unroll
                    for (int e = 0; e < 4; ++e) { p0[e] = __shfl_xor(v0[e], 16); p1[e] = __shfl_xor(v1[e], 16); }
                    if (fq == 0) { v0 = v0 * c0 - p0 * s0; v1 = v1 * c1 - p1 * s1; }
                    else if (fq == 1) { v0 = v0 * c0 + p0 * s0; v1 = v1 * c1 + p1 * s1; }
                }
                if (pn <= 1) { v0 = v0 * (0.125f * 1.4426950408889634f); v1 = v1 * (0.125f * 1.4426950408889634f); }
                if (sig) {
#pragma unroll
                    for (int e = 0; e < 4; ++e) { v0[e] = sigmoidf_(v0[e]); v1[e] = sigmoidf_(v1[e]); }
                }
                const u32x4 w = pack8(v0, v1);
                *(u32x4*)(proj + (size_t)row * PP + pn * 256 + colt) = w;
                if ((pn == 3 || pn == 4) && bj == 0) { bf16_t* kc = (pn == 3) ? kslc : kwnc; *(u32x4*)(kc + ((size_t)(colt >> 6) * SEQ + row) * 64 + (colt & 63)) = w; }
                if ((pn == 3 || pn == 4) && bj == 1) {
                    bf16_t* vt = ((pn == 3) ? vslt : vwnt) + ((size_t)((colt - 128) >> 6) * 256 + (row >> 6)) * 4096 + (size_t)((colt - 128) & 63) * 64 + (row & 63);
                    vt[0 * 64] = (bf16_t)(w.x & 0xffff); vt[1 * 64] = (bf16_t)(w.x >> 16); vt[2 * 64] = (bf16_t)(w.y & 0xffff); vt[3 * 64] = (bf16_t)(w.y >> 16);
                    vt[4 * 64] = (bf16_t)(w.z & 0xffff); vt[5 * 64] = (bf16_t)(w.z >> 16); vt[6 * 64] = (bf16_t)(w.w & 0xffff); vt[7 * 64] = (bf16_t)(w.w >> 16);
                }
            }
        }
    }
};

struct EpiCmp {
    static constexpr bool PERM = true;
    bf16_t* hid; const float* biaspe;
    __device__ __forceinline__ void operator()(const f32x4 (&acc)[2][2][4][2], const pg8::Unit& u, int wr, int wc, int fr, int fq) const {
        const int row0 = u.pm * 256 + wr * 64 + fr; const int which = u.z >> 1;
#pragma unroll
        for (int bj = 0; bj < 2; ++bj) {
            const int col = bj * 128 + wc * 32 + 8 * fq;
            const f32x4 b0 = *(const f32x4*)(biaspe + which * 256 + col), b1 = *(const f32x4*)(biaspe + which * 256 + col + 4);
#pragma unroll
            EPI_LOOP_ROWS {
                const int row = row0 + ai * 128 + m * 16;
                f32x4 v0 = acc[ai][bj][m][0] + b0, v1 = acc[ai][bj][m][1] + b1;
#pragma unroll
                for (int e = 0; e < 4; ++e) { v0[e] = gelu_tanh(v0[e]); v1[e] = gelu_tanh(v1[e]); }
                *(u32x4*)(hid + ((size_t)u.z * 1024 + row) * 256 + col) = pack8(v0, v1);
            }
        }
    }
};

struct EpiGlu {
    static constexpr bool PERM = true;
    const bf16_t* ybp; bf16_t* yb;
    __device__ __forceinline__ void operator()(const f32x4 (&acc)[2][2][4][2], const pg8::Unit& u, int wr, int wc, int fr, int fq) const {
        const int row0 = u.pm * 256 + wr * 64 + fr;
#pragma unroll
        EPI_LOOP_ROWS {
            const int row = row0 + ai * 128 + m * 16;
#pragma unroll
            for (int bj = 0; bj < 2; ++bj) {
                const size_t off = (size_t)row * 512 + u.pn * 256 + bj * 128 + wc * 32 + 8 * fq;
                const u32x4 y = *(const u32x4*)(ybp + off);
                f32x4 v0 = acc[ai][bj][m][0], v1 = acc[ai][bj][m][1];
                v0[0] = bf_lo(y.x) * sigmoidf_(v0[0]); v0[1] = bf_hi(y.x) * sigmoidf_(v0[1]); v0[2] = bf_lo(y.y) * sigmoidf_(v0[2]); v0[3] = bf_hi(y.y) * sigmoidf_(v0[3]);
                v1[0] = bf_lo(y.z) * sigmoidf_(v1[0]); v1[1] = bf_hi(y.z) * sigmoidf_(v1[1]); v1[2] = bf_lo(y.w) * sigmoidf_(v1[2]); v1[3] = bf_hi(y.w) * sigmoidf_(v1[3]);
                *(u32x4*)(yb + off) = pack8(v0, v1);
            }
        }
    }
};

struct EpiMerge {
    static constexpr bool PERM = true;
    const bf16_t* proj; bf16_t* merged;
    __device__ __forceinline__ void operator()(const f32x4 (&acc)[2][2][4][2], const pg8::Unit& u, int wr, int wc, int fr, int fq) const {
        const int row0 = u.pm * 256 + wr * 64 + fr; const int gcol = u.z ? C_GB : C_GA;
#pragma unroll
        EPI_LOOP_ROWS {
            const int row = row0 + ai * 128 + m * 16;
#pragma unroll
            for (int bj = 0; bj < 2; ++bj) {
                const int col = u.pn * 256 + bj * 128 + wc * 32 + 8 * fq;
                const u32x4 gt = *(const u32x4*)(proj + (size_t)row * PP + gcol + col);
                f32x4 v0 = acc[ai][bj][m][0], v1 = acc[ai][bj][m][1];
                v0[0] *= bf_lo(gt.x); v0[1] *= bf_hi(gt.x); v0[2] *= bf_lo(gt.y); v0[3] *= bf_hi(gt.y);
                v1[0] *= bf_lo(gt.z); v1[1] *= bf_hi(gt.z); v1[2] *= bf_lo(gt.w); v1[3] *= bf_hi(gt.w);
                bf16_t* dst = merged + (size_t)row * DM + col;
                if (u.z) { const u32x4 o = *(const u32x4*)dst;
                    v0[0] += bf_lo(o.x); v0[1] += bf_hi(o.x); v0[2] += bf_lo(o.y); v0[3] += bf_hi(o.y); v1[0] += bf_lo(o.z); v1[1] += bf_hi(o.z); v1[2] += bf_lo(o.w); v1[3] += bf_hi(o.w); }
                *(u32x4*)dst = pack8(v0, v1);
            }
        }
    }
};

struct EpiRes {
    static constexpr bool PERM = true;
    const float* xin; float* xo; bf16_t* xb; float* rss;
    __device__ __forceinline__ void operator()(const f32x4 (&acc)[2][2][4][2], const pg8::Unit& u, int wr, int wc, int fr, int fq) const {
        const int row0 = u.pm * 256 + wr * 64 + fr;
#pragma unroll
        EPI_LOOP_ROWS {
            const int row = row0 + ai * 128 + m * 16; float ss = 0.f;
#pragma unroll
            for (int bj = 0; bj < 2; ++bj) {
                const size_t off = (size_t)row * DM + u.pn * 256 + bj * 128 + wc * 32 + 8 * fq;
                const f32x4 v0 = *(const f32x4*)(xin + off) + acc[ai][bj][m][0], v1 = *(const f32x4*)(xin + off + 4) + acc[ai][bj][m][1];
                *(f32x4*)(xo + off) = v0; *(f32x4*)(xo + off + 4) = v1;
                if (xb) *(u32x4*)(xb + off) = pack8(v0, v1);
                ss += (v0[0] * v0[0] + v0[1] * v0[1]) + (v0[2] * v0[2] + v0[3] * v0[3]) + (v1[0] * v1[0] + v1[1] * v1[1]) + (v1[2] * v1[2] + v1[3] * v1[3]);
            }
            ss += __shfl_xor(ss, 16); ss += __shfl_xor(ss, 32);
            if (fq == 0) atomicAdd(rss + row, ss);
        }
    }
};

struct EpiUp {
    static constexpr bool PERM = true;
    bf16_t* up; const float* rss; int rowbase;
    __device__ __forceinline__ void operator()(const f32x4 (&acc)[2][2][4][2], const pg8::Unit& u, int wr, int wc, int fr, int fq) const {
        const int row0 = u.pm * 256 + wr * 64 + fr;
#pragma unroll
        EPI_LOOP_ROWS {
            const int row = row0 + ai * 128 + m * 16; const float rs = rsqrtf(rss[row] * (1.f / DM) + EPS);
#pragma unroll
            for (int bj = 0; bj < 2; ++bj) {
                const size_t off = (size_t)(row - rowbase) * NUP + u.pn * 256 + bj * 128 + wc * 32 + 8 * fq;
                *(u32x4*)(up + off) = pack8(acc[ai][bj][m][0] * rs, acc[ai][bj][m][1] * rs);
            }
        }
    }
};

struct Args { const float* in[28]; float* out; unsigned char* ws; };
constexpr int NT = 512, NWV = 8;
constexpr int LDS_BYTES = 147456;

__device__ __forceinline__ float wave_sum(float v) {
#pragma unroll
    for (int o = 1; o < 64; o <<= 1) v += __shfl_xor(v, o);
    return v;
}

#define XB_TMO      128
#define XB_XCNT(j)  (256  + 64 * (j))
#define XB_XSUB(j)  (1280 + 64 * (j))
#define XB_XGEN(j)  (2304 + 64 * (j))
#define XB_TOP      3328
#define XB_TOPGEN   3392
#define XCD_BAR_WORDS 3456
#define XB_SPIN_CAP (1u << 18)

__device__ __forceinline__ unsigned xb_ld(unsigned* p)              { return __hip_atomic_load(p, __ATOMIC_RELAXED, __HIP_MEMORY_SCOPE_AGENT); }
__device__ __forceinline__ unsigned xb_add(unsigned* p, unsigned v) { return __hip_atomic_fetch_add(p, v, __ATOMIC_RELAXED, __HIP_MEMORY_SCOPE_AGENT); }
__device__ __forceinline__ unsigned xb_xcc_id() { return (unsigned)__builtin_amdgcn_s_getreg((3 << 11) | 20) & 0xFu; }
#define XB_SPIN(cond, bar) do { unsigned _sp = 0; while (cond) { __builtin_amdgcn_s_sleep(1); \
    if ((++_sp & 255u) == 0u) { if (xb_ld(&(bar)[XB_TMO])) break; if (_sp > XB_SPIN_CAP) { atomicAdd(&(bar)[XB_TMO], 1u); break; } } } } while (0)

struct XcdBarrier {
    unsigned* bar; unsigned x;
    volatile LAS unsigned* st;
};

__device__ __forceinline__ XcdBarrier xcd_barrier_post(unsigned* bar, volatile LAS unsigned* st) {
    XcdBarrier b; b.bar = bar; b.x = xb_xcc_id(); b.st = st;
    if (threadIdx.x == 0) (void)xb_add(&bar[XB_XCNT(b.x)], 1u);
    return b;
}
__device__ __forceinline__ void xcd_barrier_complete(unsigned* bar, unsigned x, unsigned& nloc, unsigned& nx) {
    const unsigned G = gridDim.x * gridDim.y * gridDim.z;
    unsigned sum, cnt, mine, sp = 0u;
    for (;;) {
        sum = 0u; cnt = 0u; mine = 0u;
#pragma unroll
        for (unsigned j = 0; j < 16; ++j) { const unsigned c = xb_ld(&bar[XB_XCNT(j)]); sum += c; cnt += (c > 0u) ? 1u : 0u; mine = (j == x) ? c : mine; }
        if (sum == G) break;
        __builtin_amdgcn_s_sleep(1);
        if ((++sp & 255u) == 0u) { if (xb_ld(&bar[XB_TMO])) break; if (sp > XB_SPIN_CAP) { atomicAdd(&bar[XB_TMO], 1u); break; } }
    }
    nloc = mine > 0u ? mine : 1u; nx = cnt > 0u ? cnt : 1u;
}

__device__ __forceinline__ void xcd_barrier(const XcdBarrier& b) {
    asm volatile("s_waitcnt vmcnt(0)" ::: "memory");
    __syncthreads();
    if (threadIdx.x == 0) {
        unsigned* bar = b.bar;
        __builtin_amdgcn_s_waitcnt(0);
        unsigned nloc = b.st[0], nx = b.st[1];
        if (nloc == 0u) { xcd_barrier_complete(bar, b.x, nloc, nx); b.st[0] = nloc; b.st[1] = nx; }
        const unsigned old = xb_add(&bar[XB_XSUB(b.x)], 1u);
        const unsigned gen = old / nloc;
        if (old + 1u == (gen + 1u) * nloc) {
            __builtin_amdgcn_fence(__ATOMIC_RELEASE, "agent");
            asm volatile("s_waitcnt vmcnt(0)" ::: "memory");
            const unsigned og = xb_add(&bar[XB_TOP], 1u);
            const unsigned tg = og / nx;
            if (og + 1u == (tg + 1u) * nx) xb_add(&bar[XB_TOPGEN], 1u);
            else XB_SPIN(xb_ld(&bar[XB_TOPGEN]) == tg, bar);
            __builtin_amdgcn_fence(__ATOMIC_ACQUIRE, "agent");
            xb_add(&bar[XB_XGEN(b.x)], 1u);
            asm volatile("s_waitcnt vmcnt(0)" ::: "memory");
        } else {
            XB_SPIN(xb_ld(&bar[XB_XGEN(b.x)]) == gen, bar);
            __builtin_amdgcn_fence(__ATOMIC_ACQUIRE, "agent");
            asm volatile("s_waitcnt vmcnt(0)" ::: "memory");
        }
    }
    __syncthreads();
}

__device__ __forceinline__ int colmap(int kind, int c) {
    if (kind == 1) return c < 1280 ? c : (c < 1304 ? C_NG + (c - 1280) : c - 24);
    if (kind == 2) { return c < DFF ? (c >> 7) * 256 + (c & 127) : ((c - DFF) >> 7) * 256 + 128 + ((c - DFF) & 127); }
    return c;
}
__device__ __forceinline__ void transpose_item(const float* W, int K, int N, bf16_t* WT, LAS float* scr, int kb, int nb, int lane, const float* kscale, int kind) {
    const int k0 = 64 * kb, n0 = 32 * nb;
#pragma unroll 8
    for (int i = 0; i < 32; ++i) { const int kk = 2 * i + (lane >> 5), n = n0 + (lane & 31); float v = (n < N) ? W[(size_t)(k0 + kk) * N + n] : 0.f; if (kscale) v *= kscale[k0 + kk]; scr[kk * 33 + (lane & 31)] = v; }
    asm volatile("s_waitcnt lgkmcnt(0)" ::: "memory");
    const int c = lane & 7;
#pragma unroll
    for (int j = 0; j < 4; ++j) { const int n = (lane >> 3) + 8 * j; const LAS float* s = scr + (8 * c) * 33 + n;
        if (n0 + n < N) { u32x4 o; o.x = cvt_pk_bf16(s[0 * 33], s[1 * 33]); o.y = cvt_pk_bf16(s[2 * 33], s[3 * 33]); o.z = cvt_pk_bf16(s[4 * 33], s[5 * 33]); o.w = cvt_pk_bf16(s[6 * 33], s[7 * 33]);
            *(u32x4*)(WT + (size_t)colmap(kind, n0 + n) * K + k0 + 8 * c) = o; } }
    asm volatile("s_waitcnt lgkmcnt(0)" ::: "memory");
}

#define EXP2(x) __builtin_amdgcn_exp2f(x)
#define MFMA16(a, b, c) __builtin_amdgcn_mfma_f32_16x16x32_bf16((a), (b), (c), 0, 0, 0)
__device__ __forceinline__ float dpp_x1(float v) { return __int_as_float(__builtin_amdgcn_update_dpp(0, __float_as_int(v), 0xB1, 0xF, 0xF, true)); }
__device__ __forceinline__ float dpp_x2(float v) { return __int_as_float(__builtin_amdgcn_update_dpp(0, __float_as_int(v), 0x4E, 0xF, 0xF, true)); }
struct KOp { bf16x8 a00, a01, a10, a11; };
struct VOp { bf16x8 v0, v1, v2, v3; };
__device__ __forceinline__ KOp ldk(const bf16_t* Kb, size_t pitch, int kb, int lane) {
    const int i = lane & 15, q = lane >> 4;
    const bf16_t* r0 = Kb + (size_t)(kb + 8 * (i >> 2) + (i & 3)) * pitch + 8 * q; const bf16_t* r1 = r0 + 4 * pitch;
    KOp k; k.a00 = *(const bf16x8*)r0; k.a01 = *(const bf16x8*)(r0 + 32); k.a10 = *(const bf16x8*)r1; k.a11 = *(const bf16x8*)(r1 + 32); return k;
}
__device__ __forceinline__ VOp ldv(const bf16_t* Vt, size_t vpitch, int kb, int lane) {
    const int i = lane & 15, q = lane >> 4; const size_t base = (vpitch == 64) ? (size_t)(kb >> 6) * 4096 + (kb & 63) : (size_t)kb;
    const bf16_t* r = Vt + base + (size_t)i * vpitch + 8 * q;
    VOp v; v.v0 = *(const bf16x8*)r; v.v1 = *(const bf16x8*)(r + 16 * vpitch); v.v2 = *(const bf16x8*)(r + 32 * vpitch); v.v3 = *(const bf16x8*)(r + 48 * vpitch); return v;
}
__device__ __forceinline__ void qk32(const KOp& k, const bf16x8& Bq0, const bf16x8& Bq1, f32x4& S0, f32x4& S1) {
    const f32x4 z = {0.f, 0.f, 0.f, 0.f};
    S0 = MFMA16(k.a00, Bq0, z); S0 = MFMA16(k.a01, Bq1, S0); S1 = MFMA16(k.a10, Bq0, z); S1 = MFMA16(k.a11, Bq1, S1);
}
__device__ __forceinline__ void pv32(const VOp& v, const bf16x8& P, f32x4 (&O)[4]) {
    O[0] = MFMA16(v.v0, P, O[0]); O[1] = MFMA16(v.v1, P, O[1]); O[2] = MFMA16(v.v2, P, O[2]); O[3] = MFMA16(v.v3, P, O[3]);
}
__device__ __forceinline__ bf16x8 packP(const f32x4& p0, const f32x4& p1) { u32x4 w = pack8(p0, p1); return __builtin_bit_cast(bf16x8, w); }

struct KbLin { int base; __device__ __forceinline__ int operator()(int i) const { return base + 32 * i; } };
struct KbLds { const LAS int* l; __device__ __forceinline__ int operator()(int i) const { return l[i]; } };

template <bool NEEDV, class KB, class Body>
__device__ __forceinline__ void pipe3(int n, const KB kbf, Body& body, const bf16_t* Kb, size_t kp, const bf16_t* Vt, size_t vp, int lane) {
    if (n <= 0) return;
    KOp k0, k1; VOp v;
    k0 = ldk(Kb, kp, kbf(0), lane);
    for (int i = 0; i < n; i += 2) {
        { const int kb = kbf(i); if (NEEDV) v = ldv(Vt, vp, kb, lane); k1 = ldk(Kb, kp, kbf(i + 1 < n ? i + 1 : n - 1), lane); body.run(kb, k0, v); }
        if (i + 1 >= n) break;
        { const int kb = kbf(i + 1); if (NEEDV) v = ldv(Vt, vp, kb, lane); k0 = ldk(Kb, kp, kbf(i + 2 < n ? i + 2 : n - 1), lane); body.run(kb, k1, v); }
    }
}

struct BodyCmp1 {
    bf16x8 Bq[2][2]; int nv[2], q; float ml[2], ll[2];
    __device__ __forceinline__ void run(int kb, const KOp& k, const VOp&) {
#pragma unroll
        for (int cg = 0; cg < 2; ++cg) {
            f32x4 S0, S1; qk32(k, Bq[cg][0], Bq[cg][1], S0, S1);
            const int k0 = kb + 8 * q; float mloc = NEGF;
#pragma unroll
            for (int e = 0; e < 4; ++e) { if (k0 + e >= nv[cg]) S0[e] = NEGF; if (k0 + 4 + e >= nv[cg]) S1[e] = NEGF; mloc = fmaxf(mloc, fmaxf(S0[e], S1[e])); }
            const float mn = fmaxf(ml[cg], mloc); float ps = 0.f;
#pragma unroll
            for (int e = 0; e < 4; ++e) { ps += (k0 + e < nv[cg]) ? EXP2(S0[e] - mn) : 0.f; ps += (k0 + 4 + e < nv[cg]) ? EXP2(S1[e] - mn) : 0.f; }
            ll[cg] = ll[cg] * EXP2(ml[cg] - mn) + ps; ml[cg] = mn;
        }
    }
};
struct BodyCmp2 {
    bf16x8 Bq[2][2]; int nv[2], q, g; float mc[2], inv[2]; LAS float* ia[2]; f32x4 O[2][4];
    __device__ __forceinline__ void run(int kb, const KOp& k, const VOp& v) {
#pragma unroll
        for (int cg = 0; cg < 2; ++cg) {
            f32x4 S0, S1; qk32(k, Bq[cg][0], Bq[cg][1], S0, S1);
            const int k0 = kb + 8 * q; f32x4 p0, p1;
#pragma unroll
            for (int e = 0; e < 4; ++e) { p0[e] = (k0 + e < nv[cg]) ? EXP2(S0[e] - mc[cg]) * inv[cg] : 0.f; p1[e] = (k0 + 4 + e < nv[cg]) ? EXP2(S1[e] - mc[cg]) * inv[cg] : 0.f; }
            f32x4 s0 = p0, s1 = p1;
#pragma unroll
            for (int e = 0; e < 4; ++e) { s0[e] += dpp_x1(s0[e]); s0[e] += dpp_x2(s0[e]); s1[e] += dpp_x1(s1[e]); s1[e] += dpp_x2(s1[e]); }
            if (g == 0) { const int j = k0 >> 2; LAS float* a = ia[cg] + j;
                __hip_atomic_fetch_add(a, (s0[0] + s0[1]) + (s0[2] + 0.5f * s0[3]), __ATOMIC_RELAXED, __HIP_MEMORY_SCOPE_WORKGROUP);
                __hip_atomic_fetch_add(a + 1, 0.5f * s0[3] + ((s1[0] + s1[1]) + (s1[2] + 0.5f * s1[3])), __ATOMIC_RELAXED, __HIP_MEMORY_SCOPE_WORKGROUP);
                __hip_atomic_fetch_add(a + 2, 0.5f * s1[3], __ATOMIC_RELAXED, __HIP_MEMORY_SCOPE_WORKGROUP); }
            pv32(v, packP(p0, p1), O[cg]);
        }
    }
};
struct BodyWin {
    bf16x8 Bq[2][2]; int q, tt[2]; float m[2], l[2]; f32x4 O[2][4];
    __device__ __forceinline__ void run(int kb, const KOp& k, const VOp& v) {
#pragma unroll
        for (int cg = 0; cg < 2; ++cg) {
            f32x4 S0, S1; qk32(k, Bq[cg][0], Bq[cg][1], S0, S1);
            const int k0 = kb + 8 * q; unsigned vm = 0u;
#pragma unroll
            for (int e = 0; e < 8; ++e) { const bool ok = (k0 + e <= tt[cg]) && (tt[cg] - (k0 + e) < 512); vm |= ok ? (1u << e) : 0u; }
            float mloc = NEGF;
#pragma unroll
            for (int e = 0; e < 4; ++e) { if (!((vm >> e) & 1u)) S0[e] = NEGF; if (!((vm >> (4 + e)) & 1u)) S1[e] = NEGF; mloc = fmaxf(mloc, fmaxf(S0[e], S1[e])); }
            mloc = fmaxf(mloc, __shfl_xor(mloc, 16)); mloc = fmaxf(mloc, __shfl_xor(mloc, 32));
            const float mn = fmaxf(m[cg], mloc), alpha = EXP2(m[cg] - mn); m[cg] = mn;
            f32x4 p0, p1; float ps = 0.f;
#pragma unroll
            for (int e = 0; e < 4; ++e) { p0[e] = ((vm >> e) & 1u) ? EXP2(S0[e] - mn) : 0.f; p1[e] = ((vm >> (4 + e)) & 1u) ? EXP2(S1[e] - mn) : 0.f; ps += p0[e] + p1[e]; }
            l[cg] = l[cg] * alpha + ps;
#pragma unroll
            for (int dt = 0; dt < 4; ++dt) O[cg][dt] = O[cg][dt] * alpha;
            pv32(v, packP(p0, p1), O[cg]);
        }
    }
};

struct AttnT { unsigned long long* tsa; const bf16_t* proj; const bf16_t* kslc; const bf16_t* kwnc; const bf16_t* kcmp; const bf16_t* vcmpT; const bf16_t* vslT; const bf16_t* vwnT; bf16_t* ya; };

constexpr int AL_IMP = 0  , AL_OS = 0  , AL_TM = 67584  , AL_CNT = 69632  ,
              AL_OFF = 70656  , AL_UNITS = 71744  , AL_MM = 77888  , AL_LS = 78912  ;
constexpr int OSP = 66;
typedef short s16x2 __attribute__((ext_vector_type(2)));
__device__ __forceinline__ int f2ord(float f) { const int b = __float_as_int(f); return b >= 0 ? b : b ^ 0x7fffffff; }
__device__ __forceinline__ float ord2f(int b) { return __int_as_float(b >= 0 ? b : b ^ 0x7fffffff); }

__device__ __forceinline__ void attn_wave_part1(const AttnT& T, int kh, int tq8, int lane, LAS float* imp  , LAS unsigned* tm, int wave) {
    const int col = lane & 15, q = lane >> 4, tk = col >> 2, g = col & 3;
    const int t0 = tq8 * 8, h = kh * 4 + g;
    bf16x8 Bq[2][2]; float g0[2], g2[2]; int tcg[2];
#pragma unroll
    for (int cg = 0; cg < 2; ++cg) { tcg[cg] = t0 + 4 * cg + tk; const bf16_t* prow = T.proj + (size_t)tcg[cg] * PP;
        Bq[cg][0] = *(const bf16x8*)(prow + C_Q + h * 64 + 8 * q); Bq[cg][1] = *(const bf16x8*)(prow + C_Q + h * 64 + 32 + 8 * q);
        g0[cg] = bf2f(prow[C_NG + h * 3 + 0]); g2[cg] = bf2f(prow[C_NG + h * 3 + 2]); }
    for (int i = lane; i < 8 * 264; i += 64) imp[i] = 0.f;
    {
        const bf16_t* Kc = T.kcmp + (size_t)kh * 1024 * 64; const bf16_t* Vc = T.vcmpT + (size_t)kh * 64 * 1024;
        const int tmax = t0 + 7, nvmax = tmax >= 31 ? ((tmax - 31) >> 4) + 1 : 0, nsteps = (nvmax + 31) >> 5;
        BodyCmp1 b1;
#pragma unroll
        for (int cg = 0; cg < 2; ++cg) { b1.Bq[cg][0] = Bq[cg][0]; b1.Bq[cg][1] = Bq[cg][1]; b1.nv[cg] = tcg[cg] >= 31 ? ((tcg[cg] - 31) >> 4) + 1 : 0; b1.ml[cg] = NEGF; b1.ll[cg] = 0.f; }
        b1.q = q;
        pipe3<false>(nsteps, KbLin{0}, b1, Kc, 64, Vc, 1024, lane);
        BodyCmp2 b2; b2.q = q; b2.g = g;
#pragma unroll
        for (int cg = 0; cg < 2; ++cg) {
            float mc = fmaxf(b1.ml[cg], __shfl_xor(b1.ml[cg], 16)); mc = fmaxf(mc, __shfl_xor(mc, 32));
            float lc = b1.ll[cg] * EXP2(b1.ml[cg] - mc); lc += __shfl_xor(lc, 16); lc += __shfl_xor(lc, 32);
            b2.Bq[cg][0] = Bq[cg][0]; b2.Bq[cg][1] = Bq[cg][1]; b2.nv[cg] = b1.nv[cg]; b2.mc[cg] = mc; b2.inv[cg] = 1.f / fmaxf(lc, 1e-30f); b2.ia[cg] = imp + (4 * cg + tk) * 264;
#pragma unroll
            for (int dt = 0; dt < 4; ++dt) b2.O[cg][dt] = (f32x4){0.f, 0.f, 0.f, 0.f};
        }
        asm volatile("s_waitcnt lgkmcnt(0)" ::: "memory");
        pipe3<true>(nsteps, KbLin{0}, b2, Kc, 64, Vc, 1024, lane);
#pragma unroll
        for (int cg = 0; cg < 2; ++cg) { bf16_t* yrow = T.ya + (size_t)tcg[cg] * 512 + h * 64 + 4 * q;
#pragma unroll
            for (int dt = 0; dt < 4; ++dt) { const f32x4 o = b2.O[cg][dt] * g0[cg]; u32x2 w; w.x = cvt_pk_bf16(o[0], o[1]); w.y = cvt_pk_bf16(o[2], o[3]); *(u32x2*)(yrow + 16 * dt) = w; } }
    }
    asm volatile("s_waitcnt lgkmcnt(0)" ::: "memory");
    for (int tk2 = 0; tk2 < 8; ++tk2) {
        const int tt = t0 + tk2, cur = tt >> 6, nvalid = cur + 1, KSEL = nvalid < 16 ? nvalid : 16;
        int bits[4];
#pragma unroll
        for (int s = 0; s < 4; ++s) { const int j = s * 64 + lane; const float v = imp[tk2 * 264 + j];
            bits[s] = (j == 0 || j == cur) ? 0x7F000000 : (j < nvalid ? __float_as_int(v) : -1); }
        int prefix = 0;
        for (int bit = 30; bit >= 0; --bit) { const int Tt = prefix | (1 << bit); int cnt = 0;
#pragma unroll
            for (int s = 0; s < 4; ++s) cnt += __popcll(__ballot(bits[s] >= Tt));
            if (cnt >= KSEL) prefix = Tt; }
        unsigned long long sel[4]; int need = KSEL;
#pragma unroll
        for (int s = 0; s < 4; ++s) { sel[s] = __ballot(bits[s] > prefix); need -= __popcll(sel[s]); }
#pragma unroll
        for (int s = 0; s < 4; ++s) { unsigned long long me = __ballot(bits[s] == prefix);
            while (me != 0ull && need > 0) { const unsigned long long low = me & (0ull - me); sel[s] |= low; me ^= low; --need; } }
        const int tbi = wave * 8 + tk2; const unsigned tbit = 1u << (tbi & 31);
#pragma unroll
        for (int s = 0; s < 4; ++s) if ((sel[s] >> lane) & 1ull) __hip_atomic_fetch_or(tm + (s * 64 + lane) * 2 + (tbi >> 5), tbit, __ATOMIC_RELAXED, __HIP_MEMORY_SCOPE_WORKGROUP);
    }
    {
        const bf16_t* Kw = T.kwnc + (size_t)kh * SEQ * 64; const bf16_t* Vw = T.vwnT + (size_t)kh * 256 * 4096;
        const int klo = (t0 - 511 > 0 ? t0 - 511 : 0) & ~31; const int n = ((t0 + 7 - klo) >> 5) + 1;
        BodyWin bo; bo.q = q;
#pragma unroll
        for (int cg = 0; cg < 2; ++cg) { bo.Bq[cg][0] = Bq[cg][0]; bo.Bq[cg][1] = Bq[cg][1]; bo.tt[cg] = tcg[cg]; bo.m[cg] = NEGF; bo.l[cg] = 0.f;
#pragma unroll
            for (int dt = 0; dt < 4; ++dt) bo.O[cg][dt] = (f32x4){0.f, 0.f, 0.f, 0.f}; }
        pipe3<true>(n, KbLin{klo}, bo, Kw, 64, Vw, 64, lane);
#pragma unroll
        for (int cg = 0; cg < 2; ++cg) { float l = bo.l[cg]; l += __shfl_xor(l, 16); l += __shfl_xor(l, 32);
            const float sc = g2[cg] / fmaxf(l, 1e-30f); bf16_t* yrow = T.ya + (size_t)tcg[cg] * 512 + h * 64 + 4 * q;
#pragma unroll
            for (int dt = 0; dt < 4; ++dt) { const u32x2 y = *(const u32x2*)(yrow + 16 * dt); const f32x4 o = bo.O[cg][dt] * sc;
                u32x2 w; w.x = cvt_pk_bf16(bf_lo(y.x) + o[0], bf_hi(y.x) + o[1]); w.y = cvt_pk_bf16(bf_lo(y.y) + o[2], bf_hi(y.y) + o[3]); *(u32x2*)(yrow + 16 * dt) = w; } }
    }
    asm volatile("s_waitcnt lgkmcnt(0)" ::: "memory");
}

struct UnitPre { int j; unsigned tlo, thi; bf16x8 q00, q01, q10, q11; KOp ka, kb; VOp va, vb; };
template <int PASS>
__device__ __forceinline__ UnitPre unit_load(const AttnT& T, const bf16_t* Ks, const bf16_t* Vs, int kh, int tile, const LAS u32x4* units, int u, int lane) {
    const int col = lane & 15, q = lane >> 4, slot = col >> 2, g = col & 3;
    const u32x4 d = units[u]; UnitPre P; P.j = __builtin_amdgcn_readfirstlane((int)d.x); P.tlo = (unsigned)__builtin_amdgcn_readfirstlane((int)d.y); P.thi = (unsigned)__builtin_amdgcn_readfirstlane((int)d.z);
    const unsigned t0b = (P.tlo >> (8 * slot)) & 0xffu, t1b = (P.thi >> (8 * slot)) & 0xffu;
    const bf16_t* qr0 = T.proj + (size_t)(tile * 64 + (t0b == 0xffu ? 0 : (int)t0b)) * PP + C_Q + (kh * 4 + g) * 64 + 8 * q;
    const bf16_t* qr1 = T.proj + (size_t)(tile * 64 + (t1b == 0xffu ? 0 : (int)t1b)) * PP + C_Q + (kh * 4 + g) * 64 + 8 * q;
    P.q00 = *(const bf16x8*)qr0; P.q01 = *(const bf16x8*)(qr0 + 32); P.q10 = *(const bf16x8*)qr1; P.q11 = *(const bf16x8*)(qr1 + 32);
    P.ka = ldk(Ks, 64, 64 * P.j, lane); P.kb = ldk(Ks, 64, 64 * P.j + 32, lane);
    if (PASS == 1) { if ((EXPV) == 2) { P.va.v0 = P.ka.a00; P.va.v1 = P.ka.a01; P.va.v2 = P.ka.a10; P.va.v3 = P.ka.a11; P.vb = P.va; } else { P.va = ldv(Vs, 64, 64 * P.j, lane); P.vb = ldv(Vs, 64, 64 * P.j + 32, lane); } }
    return P;
}
template <int PASS>
__device__ __forceinline__ void unit_group(const UnitPre& P, const bf16x8& q0, const bf16x8& q1, unsigned toks, int tile, LAS unsigned char* lds, int lane) {
    const int col = lane & 15, q = lane >> 4, slot = col >> 2, g = col & 3;
    const int ti = (int)((toks >> (8 * slot)) & 0xffu);
    f32x4 S0a, S1a, S0b, S1b; qk32(P.ka, q0, q1, S0a, S1a); qk32(P.kb, q0, q1, S0b, S1b);
    const bool valid = ti != 0xff; const int row = (valid ? ti : 0) * 4 + g;
    const int lim = (P.j == tile) ? (valid ? ti : -1) - 8 * q : (valid ? 1000 : -1);
    LAS int* mm = (LAS int*)(lds + AL_MM); LAS float* ls = (LAS float*)(lds + AL_LS);
    if (PASS == 0) {
        float mloc = NEGF;
#pragma unroll
        for (int e = 0; e < 4; ++e) { mloc = fmaxf(mloc, e <= lim ? S0a[e] : NEGF); mloc = fmaxf(mloc, e + 4 <= lim ? S1a[e] : NEGF); mloc = fmaxf(mloc, e + 32 <= lim ? S0b[e] : NEGF); mloc = fmaxf(mloc, e + 36 <= lim ? S1b[e] : NEGF); }
        mloc = fmaxf(mloc, __shfl_xor(mloc, 16)); mloc = fmaxf(mloc, __shfl_xor(mloc, 32));
        if (q == 0 && valid) __hip_atomic_fetch_max(mm + row, f2ord(mloc), __ATOMIC_RELAXED, __HIP_MEMORY_SCOPE_WORKGROUP);
    } else {
        const float m = ord2f(mm[row]);
        f32x4 p0a, p1a, p0b, p1b; float ps = 0.f;
#pragma unroll
        for (int e = 0; e < 4; ++e) { p0a[e] = e <= lim ? EXP2(S0a[e] - m) : 0.f; p1a[e] = e + 4 <= lim ? EXP2(S1a[e] - m) : 0.f; p0b[e] = e + 32 <= lim ? EXP2(S0b[e] - m) : 0.f; p1b[e] = e + 36 <= lim ? EXP2(S1b[e] - m) : 0.f;
            ps += (p0a[e] + p1a[e]) + (p0b[e] + p1b[e]); }
        ps += __shfl_xor(ps, 16); ps += __shfl_xor(ps, 32);
        if (q == 0 && valid) __hip_atomic_fetch_add(ls + row, ps, __ATOMIC_RELAXED, __HIP_MEMORY_SCOPE_WORKGROUP);
        f32x4 O[4];
#pragma unroll
        for (int dt = 0; dt < 4; ++dt) O[dt] = (f32x4){0.f, 0.f, 0.f, 0.f};
        pv32(P.va, packP(p0a, p1a), O); pv32(P.vb, packP(p0b, p1b), O);
        if (valid && (EXPV) != 1) { LAS bf16_t* orow = (LAS bf16_t*)(lds + AL_OS) + row * OSP + 4 * q;
#pragma unroll
            for (int dt = 0; dt < 4; ++dt) { const unsigned w0 = cvt_pk_bf16(O[dt][0], O[dt][1]), w1 = cvt_pk_bf16(O[dt][2], O[dt][3]);
                __builtin_amdgcn_ds_atomic_fadd_v2bf16((LAS s16x2*)(orow + 16 * dt), __builtin_bit_cast(s16x2, w0));
                __builtin_amdgcn_ds_atomic_fadd_v2bf16((LAS s16x2*)(orow + 16 * dt + 2), __builtin_bit_cast(s16x2, w1)); } }
    }
}
template <int PASS>
__device__ __forceinline__ void unit_compute(const UnitPre& P, int tile, LAS unsigned char* lds, int lane) {
    unit_group<PASS>(P, P.q00, P.q01, P.tlo, tile, lds, lane);
    if (P.thi != 0xffffffffu) unit_group<PASS>(P, P.q10, P.q11, P.thi, tile, lds, lane);
}
template <int PASS>
__device__ __forceinline__ void unit_pass(const AttnT& T, int kh, int tile, int n, LAS unsigned char* lds, int wave, int lane) {
    const bf16_t* Ks = T.kslc + (size_t)kh * SEQ * 64; const bf16_t* Vs = T.vslT + (size_t)kh * 256 * 4096;
    const LAS u32x4* units = (const LAS u32x4*)(lds + AL_UNITS);
    for (int u = wave; u < n; u += 8) { const UnitPre A = unit_load<PASS>(T, Ks, Vs, kh, tile, units, u, lane); unit_compute<PASS>(A, tile, lds, lane); }
}

__device__ __forceinline__ void attn_tile(const AttnT& T, int kh, int tile, LAS unsigned char* lds, int tid, int wave, int lane) {
    LAS unsigned* tm = (LAS unsigned*)(lds + AL_TM);
    for (int i = tid; i < 512; i += NT) tm[i] = 0u;
    __syncthreads();
    if ((TSK) >= 20 && blockIdx.x == 0 && threadIdx.x == 0) T.tsa[15] = __builtin_amdgcn_s_memrealtime();
    for (int r3 = 0; r3 < ((PROBE_REP) == 41 ? 2 : 1); ++r3)
    attn_wave_part1(T, kh, tile * 8 + wave, lane, (LAS float*)(lds + AL_IMP + wave * 8448), tm, wave);
    __threadfence_block(); __syncthreads();
    ASTAMP(0);
    LAS int* cnt = (LAS int*)(lds + AL_CNT); LAS int* off = (LAS int*)(lds + AL_OFF); LAS u32x4* units = (LAS u32x4*)(lds + AL_UNITS);
    for (int i = tid; i < 256 * OSP / 2; i += NT) ((LAS unsigned*)(lds + AL_OS))[i] = 0u;
    if (tid < 256) { ((LAS int*)(lds + AL_MM))[tid] = f2ord(NEGF); ((LAS float*)(lds + AL_LS))[tid] = 0.f; cnt[tid] = (__popc(tm[2 * tid]) + __popc(tm[2 * tid + 1]) + 7) >> 3; }
    __syncthreads();
    if (tid < 64) {
        const int c0 = cnt[4 * tid], c1 = cnt[4 * tid + 1], c2 = cnt[4 * tid + 2], c3 = cnt[4 * tid + 3]; const int tot = (c0 + c1) + (c2 + c3); int inc = tot;
#pragma unroll
        for (int o = 1; o < 64; o <<= 1) { const int v = __shfl_up(inc, o); if (tid >= o) inc += v; }
        const int ex = inc - tot; off[4 * tid] = ex; off[4 * tid + 1] = ex + c0; off[4 * tid + 2] = ex + c0 + c1; off[4 * tid + 3] = ex + c0 + c1 + c2;
        if (tid == 63) off[256] = inc;
    }
    __syncthreads();
    if (tid < 256) { unsigned long long mask = (unsigned long long)tm[2 * tid] | ((unsigned long long)tm[2 * tid + 1] << 32); int o = off[tid];
        while (mask != 0ull) { unsigned tl = 0xffffffffu, th = 0xffffffffu;
#pragma unroll
            for (int k = 0; k < 4; ++k) if (mask != 0ull) { const unsigned ti = (unsigned)__builtin_ctzll(mask); mask &= mask - 1ull; tl = (tl & ~(0xffu << (8 * k))) | (ti << (8 * k)); }
#pragma unroll
            for (int k = 0; k < 4; ++k) if (mask != 0ull) { const unsigned ti = (unsigned)__builtin_ctzll(mask); mask &= mask - 1ull; th = (th & ~(0xffu << (8 * k))) | (ti << (8 * k)); }
            units[o++] = (u32x4){(unsigned)tid, tl, th, 0u}; } }
    __syncthreads();
    const int n = off[256];
    ASTAMP(1);
    unit_pass<0>(T, kh, tile, n, lds, wave, lane);
    if ((PROBE_REP) == 42) unit_pass<0>(T, kh, tile, n, lds, wave, lane);
    __syncthreads();
    ASTAMP(2);
    unit_pass<1>(T, kh, tile, n, lds, wave, lane);
    __syncthreads();
    ASTAMP(3);
    { const int ti = tid >> 3, part = tid & 7, g = part >> 1, d0 = 32 * (part & 1), row = ti * 4 + g, t = tile * 64 + ti, h = kh * 4 + g;
      const float l = ((const LAS float*)(lds + AL_LS))[row]; const float sc = bf2f(T.proj[(size_t)t * PP + C_NG + h * 3 + 1]) / fmaxf(l, 1e-30f);
      const LAS unsigned* orow = (const LAS unsigned*)((const LAS bf16_t*)(lds + AL_OS) + row * OSP + d0); u32x4* yp = (u32x4*)(T.ya + (size_t)t * 512 + h * 64 + d0);
#pragma unroll
      for (int i = 0; i < 4; ++i) { const u32x4 y = yp[i]; const unsigned o0 = orow[4 * i], o1 = orow[4 * i + 1], o2 = orow[4 * i + 2], o3 = orow[4 * i + 3]; f32x4 a, b;
          a[0] = bf_lo(y.x) + bf_lo(o0) * sc; a[1] = bf_hi(y.x) + bf_hi(o0) * sc; a[2] = bf_lo(y.y) + bf_lo(o1) * sc; a[3] = bf_hi(y.y) + bf_hi(o1) * sc;
          b[0] = bf_lo(y.z) + bf_lo(o2) * sc; b[1] = bf_hi(y.z) + bf_hi(o2) * sc; b[2] = bf_lo(y.w) + bf_lo(o3) * sc; b[3] = bf_hi(y.w) + bf_hi(o3) * sc;
          yp[i] = pack8(a, b); } }
    __syncthreads();
    ASTAMP(4);
    if ((TSK) >= 20 && blockIdx.x == 0 && threadIdx.x == 0) T.tsa[5] += (unsigned long long)n;
}

__device__ __forceinline__ void ssm_load_u(const bf16_t* proj, int c, int g, int lane, LAS float* ubuf) {
#pragma unroll
    for (int r = 0; r < 2; ++r) { const int tl = lane + 64 * r; const u32x4* src = (const u32x4*)(proj + (size_t)(c * 128 + tl) * PP + C_U + g * 16); const u32x4 a = src[0], b = src[1];
        LAS f32x4* d = (LAS f32x4*)(ubuf + tl * 16);
        d[0] = (f32x4){bf_lo(a.x), bf_hi(a.x), bf_lo(a.y), bf_hi(a.y)}; d[1] = (f32x4){bf_lo(a.z), bf_hi(a.z), bf_lo(a.w), bf_hi(a.w)};
        d[2] = (f32x4){bf_lo(b.x), bf_hi(b.x), bf_lo(b.y), bf_hi(b.y)}; d[3] = (f32x4){bf_lo(b.z), bf_hi(b.z), bf_lo(b.w), bf_hi(b.w)}; }
    asm volatile("s_waitcnt lgkmcnt(0)" ::: "memory");
}
__device__ __forceinline__ f32x2 ssm_step(const f32x2 (&Bb)[16], const f32x2 A, const f32x2 x, const LAS float* urow) {
    const f32x4 u0 = *(const LAS f32x4*)(urow), u1 = *(const LAS f32x4*)(urow + 4), u2 = *(const LAS f32x4*)(urow + 8), u3 = *(const LAS f32x4*)(urow + 12);
    f32x2 bu = Bb[0] * u0[0]; f32x2 bv = Bb[1] * u0[1];
    bu += Bb[2] * u0[2]; bv += Bb[3] * u0[3]; bu += Bb[4] * u1[0]; bv += Bb[5] * u1[1]; bu += Bb[6] * u1[2]; bv += Bb[7] * u1[3];
    bu += Bb[8] * u2[0]; bv += Bb[9] * u2[1]; bu += Bb[10] * u2[2]; bv += Bb[11] * u2[3]; bu += Bb[12] * u3[0]; bv += Bb[13] * u3[1]; bu += Bb[14] * u3[2]; bv += Bb[15] * u3[3];
    bu += bv;
    f32x2 r; r.x = A.x * x.x - A.y * x.y + bu.x; r.y = A.x * x.y + A.y * x.x + bu.y; return r;
}
__device__ __forceinline__ void ssm_pass1(const unsigned char* ws, int c, int g, int lane, LAS float* ubuf) {
    const bf16_t* proj = (const bf16_t*)(ws + WS_PROJ);
    ssm_load_u(proj, c, g, lane, ubuf);
    const f32x2* Bbar = (const f32x2*)(ws + WS_BBAR) + (size_t)(g * 64 + lane) * 16; f32x2 Bb[16];
#pragma unroll
    for (int hh = 0; hh < 16; ++hh) Bb[hh] = Bbar[hh];
    const f32x2 A = ((const f32x2*)(ws + WS_ABAR))[g * 64 + lane];
    f32x2 x = {0.f, 0.f};
    for (int s = 0; s < 128; ++s) x = ssm_step(Bb, A, x, ubuf + s * 16);
    ((f32x2*)(ws + WS_SBUF))[(size_t)(c * 32 + g) * 64 + lane] = x;
    asm volatile("s_waitcnt lgkmcnt(0)" ::: "memory");
}
__device__ __forceinline__ void ssm_pass3(const Args& a, int c, int g, int lane, LAS float* ubuf, LAS unsigned char* xl  ) {
    const unsigned char* ws = a.ws; const bf16_t* proj = (const bf16_t*)(ws + WS_PROJ);
    ssm_load_u(proj, c, g, lane, ubuf);
    const f32x2* Bbar = (const f32x2*)(ws + WS_BBAR) + (size_t)(g * 64 + lane) * 16; f32x2 Bb[16];
#pragma unroll
    for (int hh = 0; hh < 16; ++hh) Bb[hh] = Bbar[hh];
    const f32x2 A = ((const f32x2*)(ws + WS_ABAR))[g * 64 + lane], A128 = ((const f32x2*)(ws + WS_A128))[g * 64 + lane];
    f32x2 x = {0.f, 0.f};
    { const f32x2* Sb = (const f32x2*)(ws + WS_SBUF) + g * 64 + lane;
      _Pragma("unroll 8") for (int cc = 0; cc < c; ++cc) { const f32x2 s = Sb[(size_t)cc * 32 * 64]; f32x2 r; r.x = A128.x * x.x - A128.y * x.y + s.x; r.y = A128.x * x.y + A128.y * x.x + s.y; x = r; } }
    const int hrow = lane & 15, q = lane >> 4; bf16x8 Cm[4];
    { const float* cre = a.in[14] + (size_t)(g * 16 + hrow) * 64; const float* cim = a.in[15] + (size_t)(g * 16 + hrow) * 64;
#pragma unroll
      for (int ks = 0; ks < 4; ++ks) { const f32x4 r = *(const f32x4*)(cre + 16 * ks + 4 * q), im = *(const f32x4*)(cim + 16 * ks + 4 * q);
          u32x4 w; w.x = cvt_pk_bf16(r[0], -im[0]); w.y = cvt_pk_bf16(r[1], -im[1]); w.z = cvt_pk_bf16(r[2], -im[2]); w.w = cvt_pk_bf16(r[3], -im[3]); Cm[ks] = __builtin_bit_cast(bf16x8, w); } }
    const f32x4 dsk = *(const f32x4*)(a.in[16] + g * 16 + 4 * q);
    bf16_t* ybp = (bf16_t*)((unsigned char*)a.out + OUT_YBP);
    for (int sub = 0; sub < 8; ++sub) {
#pragma unroll 4
        for (int s = 0; s < 16; ++s) { x = ssm_step(Bb, A, x, ubuf + (sub * 16 + s) * 16); *(LAS unsigned*)(xl + s * 272 + lane * 4) = cvt_pk_bf16(x.x, x.y); }
        asm volatile("s_waitcnt lgkmcnt(0)" ::: "memory");
        f32x4 acc = {0.f, 0.f, 0.f, 0.f};
#pragma unroll
        for (int ks = 0; ks < 4; ++ks) { const bf16x8 b = *(const LAS bf16x8*)(xl + hrow * 272 + ks * 64 + q * 16); acc = MFMA16(Cm[ks], b, acc); }
        const int tl = sub * 16 + hrow; const f32x4 uu = *(const LAS f32x4*)(ubuf + tl * 16 + 4 * q);
        f32x4 y = acc + dsk * uu;
        u32x2 w; w.x = cvt_pk_bf16(gelu_tanh(y[0]), gelu_tanh(y[1])); w.y = cvt_pk_bf16(gelu_tanh(y[2]), gelu_tanh(y[3]));
        *(u32x2*)(ybp + (size_t)(c * 128 + tl) * 512 + g * 16 + 4 * q) = w;
        asm volatile("s_waitcnt lgkmcnt(0)" ::: "memory");
    }
}

__global__ void __launch_bounds__(NT, 2) fwd_mega(Args a) {
    extern __shared__ __attribute__((aligned(16))) unsigned char lds_raw[];
    cg::grid_group grid = cg::this_grid();
    LAS unsigned char* lds = (LAS unsigned char*)lds_raw;
    const int tid = threadIdx.x, lane = tid & 63, wave = __builtin_amdgcn_readfirstlane(tid >> 6);
    const int G = gridDim.x, bid = blockIdx.x;
    const int gw = bid * NWV + wave, NGW = G * NWV;
    const int gt = bid * NT + tid, NGT = G * NT;
    unsigned char* ws = a.ws;
    const float* x = a.in[0];
    STAMP(0);
    if ((TSK) >= 20 && blockIdx.x == 0 && threadIdx.x == 0) for (int i = 0; i < 16; ++i) ((unsigned long long*)(a.ws + 244 * 1024))[i] = 0ull;
    if (tid < 4) ((volatile LAS unsigned*)(lds + 131072 + 64))[tid] = 0u;
    if (bid == 0) for (int i = tid; i < XCD_BAR_WORDS; i += NT) ((unsigned*)(ws + WS_BAR))[i] = 0u;
    __syncthreads();

    {
        if (bid < 16) {
            LAS float* red = (LAS float*)lds;
            const int o = bid * 32 + (tid & 31), ksl = tid >> 5, which = o >> 8, colc = o & 255;
            const float* pe = a.in[which ? 7 : 4]; const float* w1 = a.in[which ? 8 : 5]; float s = 0.f;
            _Pragma("unroll 16") for (int k = ksl * 128; k < ksl * 128 + 128; ++k) s += pe[k] * w1[(size_t)k * 256 + colc];
            red[ksl * 32 + (tid & 31)] = s; __syncthreads();
            if (tid < 32) { float t = 0.f; for (int i = 0; i < 16; ++i) t += red[i * 32 + tid]; ((float*)(ws + WS_BIASPE))[o] = t; }
            __syncthreads();
        }
        LAS float* scr = (LAS float*)(lds + wave * 8448);
        constexpr int I_IN = 16 * 121, I_GLU = 8 * 16, I_PA = 8 * 32, I_OUT = 16 * 32, I_UP = 16 * 176, I_DN = 44 * 32, I_W1 = 32 * 8;
        constexpr int NITEMS = I_IN + I_GLU + 2 * I_PA + I_OUT + I_UP + I_DN + 2 * I_W1;
        for (int it = gw; it < NITEMS; it += NGW) {
            int r = it;
            if (r < I_IN) { transpose_item(a.in[3], 1024, DIN, (bf16_t*)(ws + WS_WIN), scr, r / 121, r % 121, lane, a.in[2], 1); continue; } r -= I_IN;
            if (r < I_GLU) { transpose_item(a.in[18], 512, 512, (bf16_t*)(ws + WS_WGLU), scr, r / 16, r % 16, lane, nullptr, 0); continue; } r -= I_GLU;
            if (r < I_PA) { transpose_item(a.in[19], 512, 1024, (bf16_t*)(ws + WS_WPA), scr, r / 32, r % 32, lane, nullptr, 0); continue; } r -= I_PA;
            if (r < I_PA) { transpose_item(a.in[20], 512, 1024, (bf16_t*)(ws + WS_WPB), scr, r / 32, r % 32, lane, nullptr, 0); continue; } r -= I_PA;
            if (r < I_OUT) { transpose_item(a.in[21], 1024, 1024, (bf16_t*)(ws + WS_WOUT), scr, r / 32, r % 32, lane, nullptr, 0); continue; } r -= I_OUT;
            if (r < I_UP) { transpose_item(a.in[23], 1024, NUP, (bf16_t*)(ws + WS_WUP), scr, r / 176, r % 176, lane, a.in[22], 2); continue; } r -= I_UP;
            if (r < I_DN) { transpose_item(a.in[26], DFF, 1024, (bf16_t*)(ws + WS_WDOWN), scr, r / 32, r % 32, lane, nullptr, 0); continue; } r -= I_DN;
            if (r < I_W1) { transpose_item(a.in[5], 2048, 256, (bf16_t*)(ws + WS_W1K), scr, r / 8, r % 8, lane, nullptr, 0); continue; } r -= I_W1;
            transpose_item(a.in[8], 2048, 256, (bf16_t*)(ws + WS_W1V), scr, r / 8, r % 8, lane, nullptr, 0);
        }
        { u32x4* p = (u32x4*)(ws + WS_WIN + (size_t)DIN * 1024 * 2); const int n = (4096 - DIN) * 1024 * 2 / 16; for (int i = gt; i < n; i += NGT) p[i] = (u32x4){0u, 0u, 0u, 0u}; }
        { u32x4* p = (u32x4*)(ws + WS_PROJ + (size_t)SEQ * PP * 2); const int n = 32 * PP * 2 / 16; for (int i = gt; i < n; i += NGT) p[i] = (u32x4){0u, 0u, 0u, 0u}; }
        for (int i = gt; i < 128 * 64 + 2048; i += NGT) {
            if (i < 128 * 64) { const int r = i >> 6, cidx = SEQ + (i & 63); ((bf16_t*)(ws + WS_VSLT))[(size_t)r * VTP + cidx] = 0; ((bf16_t*)(ws + WS_VWNT))[(size_t)r * VTP + cidx] = 0; }
            else { const int j = i - 128 * 64; ((bf16_t*)(ws + WS_VSLT))[(size_t)128 * VTP + j] = 0; ((bf16_t*)(ws + WS_VWNT))[(size_t)128 * VTP + j] = 0; }
        }
        for (int i = gt; i < SEQ; i += NGT) { ((float*)(ws + WS_RSS2))[i] = 0.f; ((float*)(ws + WS_RSS3))[i] = 0.f; }
        { const int* pos = (const int*)a.in[1];
          for (int i = gt; i < SEQ * 8; i += NGT) { const int tt = i >> 3, fi = i & 7; const float invf = powf(500000.0f, -(float)(2 * fi) / 16.0f); const float ang = (float)pos[tt] * invf;
              float sn, cs; sincosf(ang, &sn, &cs); ((float*)(ws + WS_ROPEC))[i] = cs; ((float*)(ws + WS_ROPES))[i] = sn; } }
        for (int i = gt; i < 2048; i += NGT) { const int gg = i >> 6;
            const float dt = expf(a.in[17][gg]), ar = a.in[10][i], ai = a.in[11][i];
            const float e = expf(ar * dt), em1 = expm1f(ar * dt), th = ai * dt; float sn, cs; sincosf(th, &sn, &cs); const float sh = sinf(0.5f * th);
            const float Ax = e * cs, Ay = e * sn; const float nx = em1 * cs - 2.f * sh * sh, ny = e * sn;
            const float den = 1.f / (ar * ar + ai * ai); const float fx = (nx * ar + ny * ai) * den, fy = (ny * ar - nx * ai) * den;
            ((f32x2*)(ws + WS_ABAR))[i] = (f32x2){Ax, Ay};
            float px = Ax, py = Ay;
            for (int k = 0; k < 7; ++k) { const float qx = px * px - py * py, qy = 2.f * px * py; px = qx; py = qy; }
            ((f32x2*)(ws + WS_A128))[i] = (f32x2){px, py};
            const float* bre = a.in[12] + (size_t)i * 16; const float* bim = a.in[13] + (size_t)i * 16; f32x2* Bo = (f32x2*)(ws + WS_BBAR) + (size_t)i * 16;
            for (int hh = 0; hh < 16; ++hh) Bo[hh] = (f32x2){fx * bre[hh] - fy * bim[hh], fx * bim[hh] + fy * bre[hh]};
        }
        for (int r = gw; r < SEQ; r += NGW) {
            const f32x4* xr = (const f32x4*)(x + (size_t)r * DM) + lane; f32x4 v[4]; float s = 0.f;
#pragma unroll
            for (int j = 0; j < 4; ++j) { v[j] = xr[64 * j]; s += (v[j][0] * v[j][0] + v[j][1] * v[j][1]) + (v[j][2] * v[j][2] + v[j][3] * v[j][3]); }
            s = wave_sum(s);
            if (lane == 0) ((float*)(ws + WS_RSTD1))[r] = rsqrtf(s * (1.f / DM) + EPS);
            u32x2* o = (u32x2*)(ws + WS_XB + (size_t)r * DM * 2) + lane;
#pragma unroll
            for (int j = 0; j < 4; ++j) { u32x2 w; w.x = cvt_pk_bf16(v[j][0], v[j][1]); w.y = cvt_pk_bf16(v[j][2], v[j][3]); o[64 * j] = w; }
        }
    }
    grid.sync();
    STAMP(1);
    XcdBarrier xbar = xcd_barrier_post((unsigned*)(ws + WS_BAR), (volatile LAS unsigned*)(lds + 131072 + 64));

    REPS(1) {
        pg8::Gemm g{1024, 2048u, 128u};
        SchedMN S{64, 16, 1, G, bid, 0, (const char*)(ws + WS_XB), nullptr, (const char*)(ws + WS_WIN), nullptr, (size_t)256 * 1024 * 2, (size_t)256 * 1024 * 2};
        EpiProj E{(bf16_t*)(ws + WS_PROJ), (bf16_t*)(ws + WS_VSLT), (bf16_t*)(ws + WS_VWNT), (bf16_t*)(ws + WS_KSL), (bf16_t*)(ws + WS_KWN), (const float*)(ws + WS_RSTD1), (const float*)(ws + WS_ROPEC), (const float*)(ws + WS_ROPES)};
        pg8::gemm_phase<EpiProj, SchedMN, true, true>(lds, g, S, E);
    }
    GSYNC();
    STAMP(2);

    {
        if (bid < 16) {
            pg8::Gemm g{2048, (unsigned)(16 * PP * 2), (unsigned)(PP * 2)};
            SchedCmp S{bid, (const char*)(ws + WS_PROJ), (const char*)(ws + WS_W1K), (const char*)(ws + WS_W1V)};
            EpiCmp E{(bf16_t*)(ws + WS_HID), (const float*)(ws + WS_BIASPE)};
            pg8::gemm_phase<EpiCmp, SchedCmp, true, true>(lds, g, S, E);
        } else {
            LAS float* ubuf = (LAS float*)(lds + wave * 16384);
            for (int it = (bid - 16) * NWV + wave; it < 4096 * ((PROBE_REP) == 12 ? 2 : 1); it += (G - 16) * NWV) ssm_pass1(ws, (it & 4095) >> 5, it & 31, lane, ubuf);
        }
    }
    GSYNC();
    STAMP(3);

    REPS(3) {
        const bf16_t* hid = (const bf16_t*)(ws + WS_HID);
        for (int r = gw; r < 4096; r += NGW) {
            const int z = r >> 10, n = r & 1023, which = z >> 1, kh = z & 1;
            float acc = 0.f;
            if (n < 1023) { const float* w2 = a.in[which ? 9 : 6]; const bf16_t* hr = hid + (size_t)r * 256;
                _Pragma("unroll 16") for (int k = 0; k < 256; k += 2) { const unsigned hw = *(const unsigned*)(hr + k); acc += bf_lo(hw) * w2[k * 64 + lane]; acc += bf_hi(hw) * w2[(k + 1) * 64 + lane]; } }
            if (which == 0) {
                const float other = __shfl_xor(acc, 8); const int prow = 16 * n + 31; float o = acc;
                if (lane < 16 && n < 1023) { const float cs = ((const float*)(ws + WS_ROPEC))[prow * 8 + (lane & 7)], sn = ((const float*)(ws + WS_ROPES))[prow * 8 + (lane & 7)];
                    o = lane < 8 ? acc * cs - other * sn : acc * cs + other * sn; }
                ((bf16_t*)(ws + WS_KCMP))[((size_t)kh * 1024 + n) * 64 + lane] = (bf16_t)(cvt_pk_bf16(o, 0.f) & 0xffff);
            } else {
                ((bf16_t*)(ws + WS_VCMPT))[((size_t)kh * 64 + lane) * 1024 + n] = (bf16_t)(cvt_pk_bf16(acc, 0.f) & 0xffff);
            }
        }
    }
    GSYNC();
    STAMP(4);

    {
        AttnT T{(unsigned long long*)(ws + 244 * 1024), (const bf16_t*)(ws + WS_PROJ), (const bf16_t*)(ws + WS_KSL), (const bf16_t*)(ws + WS_KWN), (const bf16_t*)(ws + WS_KCMP), (const bf16_t*)(ws + WS_VCMPT), (const bf16_t*)(ws + WS_VSLT), (const bf16_t*)(ws + WS_VWNT), (bf16_t*)((unsigned char*)a.out + OUT_YA)};
        LAS float* wl = (LAS float*)(lds + wave * 16384);
        for (int r2 = 0; r2 < ((PROBE_REP) == 4 ? 2 : 1); ++r2)
        for (int pr = bid; pr < 256; pr += G) {
            const int xcd = pr & 7, slot = pr >> 3, kh = xcd & 1, tl = 32 * (xcd >> 1) + slot;
_Pragma("nounroll")
            for (int k2 = 0; k2 < 2; ++k2) attn_tile(T, kh, k2 ? 255 - tl : tl, lds, tid, wave, lane);
        }
        if ((PROBE_REP) == 4) {
            AttnT T2 = T; T2.ya = (bf16_t*)(ws + WS_XB);
            for (int pr = bid; pr < 256; pr += G) { const int xcd = pr & 7, slot = pr >> 3, kh = xcd & 1, tl = 32 * (xcd >> 1) + slot;
                _Pragma("nounroll") for (int k2 = 0; k2 < 2; ++k2) attn_tile(T2, kh, k2 ? 255 - tl : tl, lds, tid, wave, lane); }
        }
        int tid2 = threadIdx.x; asm volatile("" : "+v"(tid2));
        const int lane2 = tid2 & 63, wave2 = __builtin_amdgcn_readfirstlane(tid2 >> 6), gw2 = bid * NWV + wave2;
        for (int it = gw2; it < 4096 * ((PROBE_REP) == 14 ? 2 : 1); it += NGW) ssm_pass3(a, (it & 4095) >> 5, it & 31, lane2, (LAS float*)(lds + wave2 * 16384), lds + wave2 * 16384 + 8192);
    }
    GSYNC();
    STAMP(5);

    REPS(5) {
        pg8::Gemm g{512, 1024u, 128u};
        SchedMN S{64, 2, 1, G, bid, 0, (const char*)a.out + OUT_YBP, nullptr, (const char*)(ws + WS_WGLU), nullptr, (size_t)256 * 512 * 2, (size_t)256 * 512 * 2};
        EpiGlu E{(const bf16_t*)((const unsigned char*)a.out + OUT_YBP), (bf16_t*)((unsigned char*)a.out + OUT_YB)};
        pg8::gemm_phase<EpiGlu, SchedMN, true, true>(lds, g, S, E);
    }
    GSYNC();
    STAMP(6);

    REPS(6) {
        pg8::Gemm g{512, 1024u, 128u};
        SchedMN S{64, 4, 2, G, bid, 0, (const char*)a.out + OUT_YA, (const char*)a.out + OUT_YB, (const char*)(ws + WS_WPA), (const char*)(ws + WS_WPB), (size_t)256 * 512 * 2, (size_t)256 * 512 * 2};
        EpiMerge E{(const bf16_t*)(ws + WS_PROJ), (bf16_t*)(ws + WS_MERGED)};
        pg8::gemm_phase<EpiMerge, SchedMN, true, true>(lds, g, S, E);
    }
    GSYNC();
    STAMP(7);

    {
        pg8::Gemm g{1024, 2048u, 128u};
        SchedMN S{64, 4, 1, G, bid, 0, (const char*)(ws + WS_MERGED), nullptr, (const char*)(ws + WS_WOUT), nullptr, (size_t)256 * 1024 * 2, (size_t)256 * 1024 * 2};
        EpiRes E{x, a.out, (bf16_t*)(ws + WS_X1B), (float*)(ws + WS_RSS2)};
        pg8::gemm_phase<EpiRes, SchedMN, true, true>(lds, g, S, E);
    }
    GSYNC();
    STAMP(8);

    for (int half = 0; half < 2; ++half) {
        const int pm_off = half ? 31 : 0, nM = half ? 33 : 32, rowbase = pm_off * 256;
        REPS(8) {
            pg8::Gemm g{1024, 2048u, 128u};
            SchedMN S{nM, 22, 1, G, bid, pm_off, (const char*)(ws + WS_X1B), nullptr, (const char*)(ws + WS_WUP), nullptr, (size_t)256 * 1024 * 2, (size_t)256 * 1024 * 2};
            EpiUp E{(bf16_t*)(ws + WS_UPRAW), (const float*)(ws + WS_RSS2), rowbase};
            pg8::gemm_phase<EpiUp, SchedMN, true, true>(lds, g, S, E);
        }
        GSYNC();
    STAMP(9);
        REPS(9) {
            const bf16_t* up = (const bf16_t*)(ws + WS_UPRAW); bf16_t* act = (bf16_t*)(ws + WS_ACT);
            const float* cw = a.in[24]; const float* cb = a.in[25];
            const int tlo = half ? 8192 : 0;
            for (int it = gt; it < 256 * 352; it += NGT) {
                const int cg8 = it % 352, tb = it / 352, c0 = cg8 * 8, tile = c0 >> 7, jj = c0 & 127;
                const int ucol = tile * 256 + jj;
                float wg[3][8], wv[3][8], bg[8], bv[8];
#pragma unroll
                for (int e = 0; e < 8; ++e) { bg[e] = cb[c0 + e]; bv[e] = cb[DFF + c0 + e];
#pragma unroll
                    for (int k = 0; k < 3; ++k) { wg[k][e] = cw[k * NUP + c0 + e]; wv[k][e] = cw[k * NUP + DFF + c0 + e]; } }
                const int ts = tlo + tb * 32;
                float g2[8], g1[8], v2[8], v1[8];
#pragma unroll
                for (int e = 0; e < 8; ++e) { g2[e] = g1[e] = v2[e] = v1[e] = 0.f; }
                if (ts >= 2) {
                    const u32x4 a2 = *(const u32x4*)(up + (size_t)(ts - 2 - rowbase) * NUP + ucol), b2 = *(const u32x4*)(up + (size_t)(ts - 2 - rowbase) * NUP + ucol + 128);
                    const u32x4 a1 = *(const u32x4*)(up + (size_t)(ts - 1 - rowbase) * NUP + ucol), b1 = *(const u32x4*)(up + (size_t)(ts - 1 - rowbase) * NUP + ucol + 128);
                    g2[0] = bf_lo(a2.x); g2[1] = bf_hi(a2.x); g2[2] = bf_lo(a2.y); g2[3] = bf_hi(a2.y); g2[4] = bf_lo(a2.z); g2[5] = bf_hi(a2.z); g2[6] = bf_lo(a2.w); g2[7] = bf_hi(a2.w);
                    v2[0] = bf_lo(b2.x); v2[1] = bf_hi(b2.x); v2[2] = bf_lo(b2.y); v2[3] = bf_hi(b2.y); v2[4] = bf_lo(b2.z); v2[5] = bf_hi(b2.z); v2[6] = bf_lo(b2.w); v2[7] = bf_hi(b2.w);
                    g1[0] = bf_lo(a1.x); g1[1] = bf_hi(a1.x); g1[2] = bf_lo(a1.y); g1[3] = bf_hi(a1.y); g1[4] = bf_lo(a1.z); g1[5] = bf_hi(a1.z); g1[6] = bf_lo(a1.w); g1[7] = bf_hi(a1.w);
                    v1[0] = bf_lo(b1.x); v1[1] = bf_hi(b1.x); v1[2] = bf_lo(b1.y); v1[3] = bf_hi(b1.y); v1[4] = bf_lo(b1.z); v1[5] = bf_hi(b1.z); v1[6] = bf_lo(b1.w); v1[7] = bf_hi(b1.w);
                }
                for (int s = 0; s < 32; ++s) {
                    const int tt = ts + s;
                    const u32x4 a0 = *(const u32x4*)(up + (size_t)(tt - rowbase) * NUP + ucol), b0 = *(const u32x4*)(up + (size_t)(tt - rowbase) * NUP + ucol + 128);
                    float gc[8], vc[8];
                    gc[0] = bf_lo(a0.x); gc[1] = bf_hi(a0.x); gc[2] = bf_lo(a0.y); gc[3] = bf_hi(a0.y); gc[4] = bf_lo(a0.z); gc[5] = bf_hi(a0.z); gc[6] = bf_lo(a0.w); gc[7] = bf_hi(a0.w);
                    vc[0] = bf_lo(b0.x); vc[1] = bf_hi(b0.x); vc[2] = bf_lo(b0.y); vc[3] = bf_hi(b0.y); vc[4] = bf_lo(b0.z); vc[5] = bf_hi(b0.z); vc[6] = bf_lo(b0.w); vc[7] = bf_hi(b0.w);
                    float o[8];
#pragma unroll
                    for (int e = 0; e < 8; ++e) { const float gg = bg[e] + wg[0][e] * g2[e] + wg[1][e] * g1[e] + wg[2][e] * gc[e]; const float vv = bv[e] + wv[0][e] * v2[e] + wv[1][e] * v1[e] + wv[2][e] * vc[e];
                        o[e] = gg * sigmoidf_(gg) * vv; g2[e] = g1[e]; g1[e] = gc[e]; v2[e] = v1[e]; v1[e] = vc[e]; }
                    u32x4 w; w.x = cvt_pk_bf16(o[0], o[1]); w.y = cvt_pk_bf16(o[2], o[3]); w.z = cvt_pk_bf16(o[4], o[5]); w.w = cvt_pk_bf16(o[6], o[7]);
                    *(u32x4*)(act + (size_t)tt * DFF + c0) = w;
                }
            }
        }
        GSYNC();
    STAMP(10);
    }

    {
        pg8::Gemm g{DFF, (unsigned)(DFF * 2), 128u};
        SchedMN S{64, 4, 1, G, bid, 0, (const char*)(ws + WS_ACT), nullptr, (const char*)(ws + WS_WDOWN), nullptr, (size_t)256 * DFF * 2, (size_t)256 * DFF * 2};
        EpiRes E{a.out, a.out, nullptr, (float*)(ws + WS_RSS3)};
        pg8::gemm_phase<EpiRes, SchedMN, true, true>(lds, g, S, E);
    }
    GSYNC();
    STAMP(11);

    {
        const float* gf = a.in[27];
        for (int r = gw; r < SEQ; r += NGW) {
            const float rs = rsqrtf(((const float*)(ws + WS_RSS3))[r] * (1.f / DM) + EPS);
            f32x4* xr = (f32x4*)(a.out + (size_t)r * DM) + lane; const f32x4* gr = (const f32x4*)gf + lane;
#pragma unroll
            for (int j = 0; j < 4; ++j) xr[64 * j] = xr[64 * j] * rs * gr[64 * j];
        }
    }
    if ((TSK) >= 0 && blockIdx.x == 0 && threadIdx.x == 0) {
        const unsigned long long tend = __builtin_amdgcn_s_memrealtime(); const unsigned long long* ts = (const unsigned long long*)(a.ws + 240 * 1024);
        const unsigned long long t1 = ((TSK) + 1 > 11) ? tend : ts[(TSK) + 1 > 11 ? 0 : (TSK) + 1];
        asm volatile("s_waitcnt vmcnt(0)" ::: "memory");
        a.out[0] = ((TSK) >= 20) ? (float)((const unsigned long long*)(a.ws + 244 * 1024))[(TSK) >= 20 ? (TSK) - 20 : 0] * ((TSK) == 25 ? 1.0f : 0.01f) : (float)(t1 - ts[(TSK) > 11 ? 11 : (TSK)]) * 0.01f;
    }
}

extern "C" void kernel_launch(void* const* d_in, const int* in_sizes, int n_in, void* d_out, int out_size, void* d_ws, size_t ws_size, hipStream_t stream) {
    static int grid = 0;
    if (grid == 0) {
        int dev = 0, cus = 0, per_cu = 0;
        (void)hipGetDevice(&dev); (void)hipDeviceGetAttribute(&cus, hipDeviceAttributeMultiprocessorCount, dev);
        (void)hipFuncSetAttribute((const void*)fwd_mega, hipFuncAttributeMaxDynamicSharedMemorySize, LDS_BYTES);
        (void)hipOccupancyMaxActiveBlocksPerMultiprocessor(&per_cu, (const void*)fwd_mega, NT, LDS_BYTES);
        if (per_cu < 1) { fprintf(stderr, "kernel_launch: occupancy query says %d blocks per CU\n", per_cu); per_cu = 1; }
        grid = cus;
        if (n_in != 28 || ws_size < 252 * MiB) fprintf(stderr, "kernel_launch: unexpected n_in %d / ws_size %zu\n", n_in, ws_size);
    }
    Args a{};
    for (int i = 0; i < 28; ++i) a.in[i] = (const float*)d_in[i];
    a.out = (float*)d_out; a.ws = (unsigned char*)d_ws;
    void* kargs[] = {&a};
    hipError_t e = hipLaunchCooperativeKernel((const void*)fwd_mega, dim3(grid), dim3(NT), kargs, LDS_BYTES, stream);
    if (e != hipSuccess) fprintf(stderr, "cooperative launch failed: %s (grid %d)\n", hipGetErrorString(e), grid);
}
```

```cpp
#include <hip/hip_runtime.h>
#include <hip/hip_cooperative_groups.h>
#include <cstdio>
#include <cstdint>
namespace cg = cooperative_groups;
#ifndef PROBE_REP
#define PROBE_REP -1
#endif
#ifndef EXPV
#define EXPV 0
#endif
#ifndef TSK
#define TSK -1
#endif
#define STAMP(i) do { if ((TSK) >= 0 && blockIdx.x == 0 && threadIdx.x == 0) ((unsigned long long*)(a.ws + 240 * 1024))[i] = __builtin_amdgcn_s_memrealtime(); } while (0)
#define ASTAMP(k) do { if ((TSK) >= 20 && blockIdx.x == 0 && threadIdx.x == 0) { const unsigned long long t_ = __builtin_amdgcn_s_memrealtime(); T.tsa[k] += t_ - T.tsa[15]; T.tsa[15] = t_; } } while (0)
#define REPS(k) _Pragma("nounroll") for (int rep_ = 0; rep_ < ((PROBE_REP) == (k) ? 2 : 1); ++rep_)
#define GSYNC() do { xcd_barrier(xbar); if ((PROBE_REP) == 100) xcd_barrier(xbar); } while (0)

#define LAS __attribute__((address_space(3)))
typedef unsigned short bf16_t;
typedef short bf16x8 __attribute__((ext_vector_type(8)));
typedef float f32x4 __attribute__((ext_vector_type(4)));
typedef float f32x2 __attribute__((ext_vector_type(2)));
typedef unsigned u32x4 __attribute__((ext_vector_type(4)));
typedef unsigned u32x2 __attribute__((ext_vector_type(2)));

constexpr int SEQ = 16384, DM = 1024, DIN = 3864, PP = 4096  , DFF = 2816, NUP = 5632;
constexpr int C_Q = 0, C_KC = 512, C_VC = 640, C_KSL = 768, C_VSL = 896, C_KWN = 1024, C_VWN = 1152, C_U = 1280, C_GA = 1792, C_GB = 2816, C_NG = 3840;
constexpr int VTP = SEQ + 64;
constexpr float EPS = 1e-6f;
constexpr float NEGF = -1e30f;

constexpr size_t MiB = 1u << 20;
constexpr size_t WS_RSTD1 = 0, WS_RSS2 = 64 * 1024, WS_RSS3 = 128 * 1024, WS_ROPEC = 256 * 1024, WS_ROPES = 768 * 1024;
constexpr size_t WS_ABAR = 1280 * 1024, WS_A128 = WS_ABAR + 16384, WS_BIASPE = WS_A128 + 16384, WS_BBAR = 1536 * 1024  ;
constexpr size_t WS_SBUF = 2 * MiB  , WS_HID = 4 * MiB  , WS_KCMP = 6 * MiB  , WS_VCMPT = 6 * MiB + 512 * 1024  ;
constexpr size_t WS_WUP = 8 * MiB, WS_WDOWN = 20 * MiB, WS_WIN = 26 * MiB, WS_WGLU = 34 * MiB, WS_WPA = 35 * MiB, WS_WPB = 36 * MiB, WS_WOUT = 37 * MiB, WS_W1K = 39 * MiB, WS_W1V = 40 * MiB;
constexpr size_t WS_XB = 41 * MiB, WS_MERGED = 41 * MiB, WS_PROJ = 73 * MiB, WS_VSLT = 202 * MiB + 512 * 1024, WS_VWNT = 207 * MiB;
constexpr size_t WS_X1B = 220 * MiB, WS_UPRAW = 26 * MiB, WS_ACT = 122 * MiB;
constexpr size_t WS_BAR = 192 * 1024, WS_KSL = 212 * MiB, WS_KWN = 216 * MiB;
constexpr size_t OUT_YA = 0, OUT_YBP = 16 * MiB, OUT_YB = 32 * MiB;
static_assert(WS_PROJ + (size_t)(SEQ + 32) * PP * 2 <= WS_VSLT, "proj");
static_assert(WS_VSLT + (size_t)128 * VTP * 2 + 4096 <= WS_VWNT && WS_VWNT + (size_t)128 * VTP * 2 + 4096 <= WS_X1B, "vt");
static_assert(WS_UPRAW + (size_t)33 * 256 * NUP * 2 <= WS_ACT && WS_ACT + (size_t)SEQ * DFF * 2 <= WS_X1B, "ffn");

__device__ __forceinline__ unsigned cvt_pk_bf16(float lo, float hi) { unsigned r; asm volatile("v_cvt_pk_bf16_f32 %0, %1, %2" : "=v"(r) : "v"(lo), "v"(hi)); return r; }
__device__ __forceinline__ float bf_lo(unsigned w) { return __uint_as_float(w << 16); }
__device__ __forceinline__ float bf_hi(unsigned w) { return __uint_as_float(w & 0xffff0000u); }
__device__ __forceinline__ float bf2f(bf16_t b) { return __uint_as_float((unsigned)b << 16); }
__device__ __forceinline__ float sigmoidf_(float v) { return 1.f / (1.f + __expf(-v)); }
__device__ __forceinline__ float gelu_tanh(float v) { const float z = 0.7978845608028654f * (v + 0.044715f * v * v * v); const float th = 1.f - 2.f / (__expf(2.f * z) + 1.f); return 0.5f * v * (1.f + th); }
__device__ __forceinline__ u32x4 pack8(f32x4 a, f32x4 b) { u32x4 w; w.x = cvt_pk_bf16(a[0], a[1]); w.y = cvt_pk_bf16(a[2], a[3]); w.z = cvt_pk_bf16(b[0], b[1]); w.w = cvt_pk_bf16(b[2], b[3]); return w; }

namespace pg8 {
#define PG8_LAS __attribute__((address_space(3)))
constexpr int BM = 256, BK = 64, HALF = 128, HTB = HALF * BK * 2, STAGE_BYTES = 8 * HTB, NXCD = 8, WGM = 8;
__host__ __device__ __forceinline__ int lds_byte(int r, int c) { const int st = (r >> 4) * 2 + (c >> 5), rr = r & 15, cc = c & 31, ob = rr * 64 + cc * 2; return st * 1024 + (ob ^ (((ob >> 9) & 1) << 5)); }
__host__ __device__ __forceinline__ void stage_rc(int b, int& R, int& C) { const int st = b / 1024, sb = b % 1024, swz = sb ^ (((sb >> 9) & 1) << 5); R = (st >> 1) * 16 + swz / 64; C = (st & 1) * 32 + (swz % 64) / 2; }
__host__ __device__ __forceinline__ int perm32(int rho) { const int n = rho >> 4, i = rho & 15; return 8 * (i >> 2) + 4 * n + (i & 3); }
struct Unit { int pm, pn, z; const char* A; const char* B; };
struct Gemm { int K; unsigned lda_b; unsigned kstepA; };
__device__ __forceinline__ bool tile_of(long L, int nM, int nN, int& pm, int& pn) {
    const int nwg = nM * nN; if (L >= nwg) return false;
    int wgid = (int)L; { const int q = nwg / NXCD, r = nwg % NXCD, xcd = wgid % NXCD, off = wgid / NXCD; wgid = (xcd < r ? xcd * (q + 1) : r * (q + 1) + (xcd - r) * q) + off; }
    const int nig = WGM * nN, gid = wgid / nig, fm = gid * WGM, gsz = (nM - fm) < WGM ? (nM - fm) : WGM;
    pm = fm + ((wgid % nig) % gsz); pn = (wgid % nig) / gsz; return true;
}
template <class Epi, class Sched, bool ALIGN_EPI = false, bool SP2 = false>
__device__ __forceinline__ void gemm_phase(PG8_LAS unsigned char* lds, const Gemm g, const Sched& S, const Epi& E) {
    int tid_ = threadIdx.x; asm volatile("" : "+v"(tid_));
    const int tid = tid_, wid = __builtin_amdgcn_readfirstlane(tid >> 6), lane = tid & 63, wr = wid >> 2, wc = wid & 3, fr = lane & 15, fq = lane >> 4;
    const int K = g.K, nt = K / BK;
    unsigned voffA[2], voffB[2];
#pragma unroll
    for (int i = 0; i < 2; ++i) { int R, C; stage_rc(tid * 16 + i * 8192, R, C); const int Rb = Epi::PERM ? ((R & ~31) + perm32(R & 31)) : R;
        voffA[i] = (unsigned)R * g.lda_b + (unsigned)C * 2u; voffB[i] = (unsigned)(Rb * K + C) * 2u; }
    const size_t kstepA = (size_t)g.kstepA, kstepB = (size_t)(BK * 2);
    const size_t hstepA = (size_t)HALF * g.lda_b, hstepB = (size_t)HALF * K * 2;
    const unsigned ldsw = (unsigned)wid * 1024u;
    const int aoff = lds_byte(wr * 64 + fr, fq * 8), boff = lds_byte(wc * 32 + fr, fq * 8);
#define PG8_SA(b, h) (((b) * 2 + (h)) * HTB)
#define PG8_SB(b, h) ((4 + (b) * 2 + (h)) * HTB)
#define PG8_STAGE(bufoff, gbase, voff) do { _Pragma("unroll") for (int _i = 0; _i < 2; ++_i) \
        __builtin_amdgcn_global_load_lds((const unsigned*)((const char*)(gbase) + (voff)[_i]), (PG8_LAS unsigned*)(lds + (bufoff) + ldsw + _i * 8192), 16, 0, 0); } while (0)
#define PG8_LDA(dst, b, h) do { _Pragma("unroll") for (int m = 0; m < 4; ++m) _Pragma("unroll") for (int k = 0; k < 2; ++k) dst[m][k] = *(const PG8_LAS bf16x8*)(lds + PG8_SA(b, h) + aoff + m * 2048 + k * 1024); } while (0)
#define PG8_LDB(dst, b, h) do { _Pragma("unroll") for (int n = 0; n < 2; ++n) _Pragma("unroll") for (int k = 0; k < 2; ++k) dst[n][k] = *(const PG8_LAS bf16x8*)(lds + PG8_SB(b, h) + boff + n * 2048 + k * 1024); } while (0)
#define PG8_MMA(ai, bj, At, Bt) do { __builtin_amdgcn_s_setprio(1); _Pragma("unroll") for (int m = 0; m < 4; ++m) _Pragma("unroll") for (int n = 0; n < 2; ++n) _Pragma("unroll") for (int k = 0; k < 2; ++k) \
        acc[ai][bj][m][n] = __builtin_amdgcn_mfma_f32_16x16x32_bf16(Bt[n][k], At[m][k], acc[ai][bj][m][n], 0, 0, 0); __builtin_amdgcn_s_setprio(0); } while (0)
#define PG8_WAIT_V(n) asm volatile("s_waitcnt vmcnt(" #n ")" ::: "memory")
#define PG8_WAIT_L(n) asm volatile("s_waitcnt lgkmcnt(" #n ")" ::: "memory")
#define PG8_BAR __builtin_amdgcn_s_barrier()
#define PG8_SCHED __builtin_amdgcn_sched_barrier(0)
    Unit cur, nxt; int ui = 0;
    if (!S.next(0, cur)) return;
    f32x4 acc[2][2][4][2];
#pragma unroll
    for (int a = 0; a < 2; ++a)
#pragma unroll
        for (int b = 0; b < 2; ++b)
#pragma unroll
            for (int m = 0; m < 4; ++m)
#pragma unroll
                for (int n = 0; n < 2; ++n) acc[a][b][m][n] = (f32x4){0.f, 0.f, 0.f, 0.f};
    bf16x8 At[4][2], B0[2][2], B1[2][2];
    const char* cA = cur.A; const char* cB = cur.B;
    if constexpr (SP2) {
        PG8_STAGE(PG8_SB(0, 0), cB, voffB); PG8_STAGE(PG8_SB(0, 1), cB + hstepB, voffB); PG8_STAGE(PG8_SA(0, 0), cA, voffA); PG8_STAGE(PG8_SA(0, 1), cA + hstepA, voffA);
        if (wr == 1) PG8_BAR;
        PG8_WAIT_V(2); PG8_BAR;
        PG8_STAGE(PG8_SB(1, 0), cB + kstepB, voffB); PG8_STAGE(PG8_SA(1, 0), cA + kstepA, voffA); PG8_STAGE(PG8_SB(1, 1), cB + hstepB + kstepB, voffB);
        PG8_WAIT_V(6); PG8_BAR;
    } else {
        PG8_STAGE(PG8_SB(0, 0), cB, voffB); PG8_STAGE(PG8_SA(0, 0), cA, voffA); PG8_STAGE(PG8_SB(0, 1), cB + hstepB, voffB); PG8_STAGE(PG8_SA(0, 1), cA + hstepA, voffA);
        if (wr == 1) PG8_BAR;
        PG8_WAIT_V(4); PG8_BAR;
        PG8_STAGE(PG8_SB(1, 0), cB + kstepB, voffB); PG8_STAGE(PG8_SA(1, 0), cA + kstepA, voffA); PG8_STAGE(PG8_SB(1, 1), cB + hstepB + kstepB, voffB);
        PG8_WAIT_V(6); PG8_BAR;
    }
    for (;;) {
        const bool has_next = S.next(ui + 1, nxt);
        const char* nA = has_next ? nxt.A : cA; const char* nB = has_next ? nxt.B : cB;
        for (int t = 0; t < nt; t += 2) {
            const bool last = (t == nt - 2);
            const char* a1 = cA + (size_t)(t + 1) * kstepA;
            const char* a2 = last ? nA : cA + (size_t)(t + 2) * kstepA; const char* b2 = last ? nB : cB + (size_t)(t + 2) * kstepB;
            const char* a3 = a2 + kstepA; const char* b3 = b2 + kstepB;
            if constexpr (SP2) {
            PG8_LDB(B0, 0, 0); PG8_LDB(B1, 0, 1); PG8_SCHED; PG8_LDA(At, 0, 0); PG8_STAGE(PG8_SA(1, 1), a1 + hstepA, voffA);
            PG8_WAIT_V(8); PG8_WAIT_L(0); PG8_BAR; PG8_MMA(0, 0, At, B0); PG8_MMA(0, 1, At, B1); PG8_BAR; PG8_SCHED;
            PG8_LDA(At, 0, 1); PG8_STAGE(PG8_SB(0, 0), b2, voffB); PG8_STAGE(PG8_SB(0, 1), b2 + hstepB, voffB); PG8_STAGE(PG8_SA(0, 0), a2, voffA);
            PG8_WAIT_V(8); PG8_WAIT_L(0); PG8_BAR; PG8_MMA(1, 0, At, B0); PG8_MMA(1, 1, At, B1); PG8_BAR; PG8_SCHED;
            PG8_LDB(B0, 1, 0); PG8_LDB(B1, 1, 1); PG8_SCHED; PG8_LDA(At, 1, 0); PG8_STAGE(PG8_SA(0, 1), a2 + hstepA, voffA);
            PG8_WAIT_V(8); PG8_WAIT_L(0); PG8_BAR; PG8_MMA(0, 0, At, B0); PG8_MMA(0, 1, At, B1); PG8_BAR; PG8_SCHED;
            PG8_LDA(At, 1, 1); PG8_STAGE(PG8_SB(1, 0), b3, voffB); PG8_STAGE(PG8_SB(1, 1), b3 + hstepB, voffB); PG8_STAGE(PG8_SA(1, 0), a3, voffA);
            PG8_WAIT_V(8); PG8_WAIT_L(0); PG8_BAR; PG8_MMA(1, 0, At, B0); PG8_MMA(1, 1, At, B1); PG8_BAR; PG8_SCHED;
            } else {
            PG8_LDB(B0, 0, 0); PG8_SCHED; PG8_LDA(At, 0, 0); PG8_STAGE(PG8_SA(1, 1), a1 + hstepA, voffA);
            PG8_WAIT_L(8); PG8_BAR; PG8_WAIT_L(0); PG8_MMA(0, 0, At, B0); PG8_BAR; PG8_SCHED;
            PG8_LDB(B1, 0, 1); PG8_STAGE(PG8_SB(0, 0), b2, voffB);
            PG8_BAR; PG8_WAIT_L(0); PG8_MMA(0, 1, At, B1); PG8_BAR;
            PG8_LDA(At, 0, 1); PG8_STAGE(PG8_SA(0, 0), a2, voffA);
            PG8_BAR; PG8_WAIT_L(0); PG8_MMA(1, 0, At, B0); PG8_BAR; PG8_SCHED;
            PG8_STAGE(PG8_SB(0, 1), b2 + hstepB, voffB);
            PG8_WAIT_V(6); PG8_BAR; PG8_MMA(1, 1, At, B1); PG8_BAR;
            PG8_LDB(B0, 1, 0); PG8_SCHED; PG8_LDA(At, 1, 0); PG8_STAGE(PG8_SA(0, 1), a2 + hstepA, voffA);
            PG8_WAIT_L(8); PG8_BAR; PG8_WAIT_L(0); PG8_MMA(0, 0, At, B0); PG8_BAR; PG8_SCHED;
            PG8_LDB(B1, 1, 1); PG8_STAGE(PG8_SB(1, 0), b3, voffB);
            PG8_BAR; PG8_WAIT_L(0); PG8_MMA(0, 1, At, B1); PG8_BAR;
            PG8_LDA(At, 1, 1); PG8_STAGE(PG8_SA(1, 0), a3, voffA);
            PG8_BAR; PG8_WAIT_L(0); PG8_MMA(1, 0, At, B0); PG8_BAR; PG8_SCHED;
            PG8_STAGE(PG8_SB(1, 1), b3 + hstepB, voffB);
            PG8_WAIT_V(6); PG8_BAR; PG8_MMA(1, 1, At, B1); PG8_BAR;
            }
        }
        if constexpr (ALIGN_EPI) { if (wr == 0) PG8_BAR; }
        E(acc, cur, wr, wc, fr, fq);
        if (!has_next) break;
#pragma unroll
        for (int a = 0; a < 2; ++a)
#pragma unroll
            for (int b = 0; b < 2; ++b)
#pragma unroll
                for (int m = 0; m < 4; ++m)
#pragma unroll
                    for (int n = 0; n < 2; ++n) acc[a][b][m][n] = (f32x4){0.f, 0.f, 0.f, 0.f};
        cur = nxt; cA = nA; cB = nB; ++ui;
        if constexpr (ALIGN_EPI) { if (wr == 1) PG8_BAR; }
    }
    PG8_WAIT_V(0);
    if constexpr (!ALIGN_EPI) { if (wr == 0) PG8_BAR; }
    PG8_BAR;
#undef PG8_SA
#undef PG8_SB
#undef PG8_STAGE
#undef PG8_LDA
#undef PG8_LDB
#undef PG8_MMA
#undef PG8_WAIT_V
#undef PG8_WAIT_L
#undef PG8_BAR
#undef PG8_SCHED
}
}


struct SchedMN {
    int nM, nN, nz, G, c, pm_off; const char* A0; const char* A1; const char* B0; const char* B1; size_t a_tile, b_tile;
    __device__ __forceinline__ bool next(int i, pg8::Unit& u) const {
        int pm, pn; if (!pg8::tile_of((long)(i / nz) * G + c, nM, nN, pm, pn)) return false;
        u.z = i % nz; u.pm = pm + pm_off; u.pn = pn; u.A = (u.z ? A1 : A0) + (size_t)u.pm * a_tile; u.B = (u.z ? B1 : B0) + (size_t)pn * b_tile; return true;
    }
};
struct SchedCmp {
    int c; const char* proj; const char* w1k; const char* w1v;
    __device__ __forceinline__ bool next(int i, pg8::Unit& u) const {
        if (i > ((PROBE_REP) == 22 ? 1 : 0) || c >= 16) return false;
        u.z = c >> 2; u.pm = c & 3; u.pn = 0; const int which = u.z >> 1, kh = u.z & 1;
        u.A = proj + ((size_t)(16 * 256 * u.pm) * PP + (which ? C_VC : C_KC) + kh * 64) * 2; u.B = which ? w1v : w1k; return true;
    }
};

#define EPI_LOOP_ROWS for (int ai = 0; ai < 2; ++ai) _Pragma("unroll") for (int m = 0; m < 4; ++m)

struct EpiProj {
    static constexpr bool PERM = true;
    bf16_t* proj; bf16_t* vslt; bf16_t* vwnt; bf16_t* kslc; bf16_t* kwnc; const float* rstd; const float* ropec; const float* ropes;
    __device__ __forceinline__ void operator()(const f32x4 (&acc)[2][2][4][2], const pg8::Unit& u, int wr, int wc, int fr, int fq) const {
        const int pn = u.pn; const int row0 = u.pm * 256 + wr * 64 + fr;
        const bool sig = pn >= 7;
#pragma unroll
        EPI_LOOP_ROWS {
            const int row = row0 + ai * 128 + m * 16; const float rs = rstd[row];
            f32x4 c0, c1, s0, s1;
            c0 = *(const f32x4*)(ropec + row * 8); c1 = *(const f32x4*)(ropec + row * 8 + 4); s0 = *(const f32x4*)(ropes + row * 8); s1 = *(const f32x4*)(ropes + row * 8 + 4);
#pragma unroll
            for (int bj = 0; bj < 2; ++bj) {
                f32x4 v0 = acc[ai][bj][m][0] * rs, v1 = acc[ai][bj][m][1] * rs;
                const int colt = bj * 128 + wc * 32 + 8 * fq;
                const bool ropet = (pn <= 1) || ((pn == 3 || pn == 4) && bj == 0);
                if (ropet && (wc & 1) == 0) {
                    f32x4 p0, p1;
#pragma unroll
                    for (int e = 0; e < 4; ++e) { p0[e] = __shfl_xor(v0[e], 16); p1[e] = __shfl_xor(v1[e], 16); }
                    if (fq == 0) { v0 = v0 * c0 - p0 * s0; v1 = v1 * c1 - p1 * s1; }
                    else if (fq == 1) { v0 = v0 * c0 + p0 * s0; v1 = v1 * c1 + p1 * s1; }
                }
                if (pn <= 1) { v0 = v0 * (0.125f * 1.4426950408889634f); v1 = v1 * (0.125f * 1.4426950408889634f); }
                if (sig) {
#pragma unroll
                    for (int e = 0; e < 4; ++e) { v0[e] = sigmoidf_(v0[e]); v1[e] = sigmoidf_(v1[e]); }
                }
                const u32x4 w = pack8(v0, v1);
                *(u32x4*)(proj + (size_t)row * PP + pn * 256 + colt) = w;
                if ((pn == 3 || pn == 4) && bj == 0) { bf16_t* kc = (pn == 3) ? kslc : kwnc; *(u32x4*)(kc + ((size_t)(colt >> 6) * SEQ + row) * 64 + (colt & 63)) = w; }
                if ((pn == 3 || pn == 4) && bj == 1) {
                    bf16_t* vt = ((pn == 3) ? vslt : vwnt) + ((size_t)((colt - 128) >> 6) * 256 + (row >> 6)) * 4096 + (size_t)((colt - 128) & 63) * 64 + (row & 63);
                    vt[0 * 64] = (bf16_t)(w.x & 0xffff); vt[1 * 64] = (bf16_t)(w.x >> 16); vt[2 * 64] = (bf16_t)(w.y & 0xffff); vt[3 * 64] = (bf16_t)(w.y >> 16);
                    vt[4 * 64] = (bf16_t)(w.z & 0xffff); vt[5 * 64] = (bf16_t)(w.z >> 16); vt[6 * 64] = (bf16_t)(w.w & 0xffff); vt[7 * 64] = (bf16_t)(w.w >> 16);
                }
            }
        }
    }
};

struct EpiCmp {
    static constexpr bool PERM = true;
    bf16_t* hid; const float* biaspe;
    __device__ __forceinline__ void operator()(const f32x4 (&acc)[2][2][4][2], const pg8::Unit& u, int wr, int wc, int fr, int fq) const {
        const int row0 = u.pm * 256 + wr * 64 + fr; const int which = u.z >> 1;
#pragma unroll
        for (int bj = 0; bj < 2; ++bj) {
            const int col = bj * 128 + wc * 32 + 8 * fq;
            const f32x4 b0 = *(const f32x4*)(biaspe + which * 256 + col), b1 = *(const f32x4*)(biaspe + which * 256 + col + 4);
#pragma unroll
            EPI_LOOP_ROWS {
                const int row = row0 + ai * 128 + m * 16;
                f32x4 v0 = acc[ai][bj][m][0] + b0, v1 = acc[ai][bj][m][1] + b1;
#pragma unroll
                for (int e = 0; e < 4; ++e) { v0[e] = gelu_tanh(v0[e]); v1[e] = gelu_tanh(v1[e]); }
                *(u32x4*)(hid + ((size_t)u.z * 1024 + row) * 256 + col) = pack8(v0, v1);
            }
        }
    }
};

struct EpiGlu {
    static constexpr bool PERM = true;
    const bf16_t* ybp; bf16_t* yb;
    __device__ __forceinline__ void operator()(const f32x4 (&acc)[2][2][4][2], const pg8::Unit& u, int wr, int wc, int fr, int fq) const {
        const int row0 = u.pm * 256 + wr * 64 + fr;
#pragma unroll
        EPI_LOOP_ROWS {
            const int row = row0 + ai * 128 + m * 16;
#pragma unroll
            for (int bj = 0; bj < 2; ++bj) {
                const size_t off = (size_t)row * 512 + u.pn * 256 + bj * 128 + wc * 32 + 8 * fq;
                const u32x4 y = *(const u32x4*)(ybp + off);
                f32x4 v0 = acc[ai][bj][m][0], v1 = acc[ai][bj][m][1];
                v0[0] = bf_lo(y.x) * sigmoidf_(v0[0]); v0[1] = bf_hi(y.x) * sigmoidf_(v0[1]); v0[2] = bf_lo(y.y) * sigmoidf_(v0[2]); v0[3] = bf_hi(y.y) * sigmoidf_(v0[3]);
                v1[0] = bf_lo(y.z) * sigmoidf_(v1[0]); v1[1] = bf_hi(y.z) * sigmoidf_(v1[1]); v1[2] = bf_lo(y.w) * sigmoidf_(v1[2]); v1[3] = bf_hi(y.w) * sigmoidf_(v1[3]);
                *(u32x4*)(yb + off) = pack8(v0, v1);
            }
        }
    }
};

struct EpiMerge {
    static constexpr bool PERM = true;
    const bf16_t* proj; bf16_t* merged;
    __device__ __forceinline__ void operator()(const f32x4 (&acc)[2][2][4][2], const pg8::Unit& u, int wr, int wc, int fr, int fq) const {
        const int row0 = u.pm * 256 + wr * 64 + fr; const int gcol = u.z ? C_GB : C_GA;
#pragma unroll
        EPI_LOOP_ROWS {
            const int row = row0 + ai * 128 + m * 16;
#pragma unroll
            for (int bj = 0; bj < 2; ++bj) {
                const int col = u.pn * 256 + bj * 128 + wc * 32 + 8 * fq;
                const u32x4 gt = *(const u32x4*)(proj + (size_t)row * PP + gcol + col);
                f32x4 v0 = acc[ai][bj][m][0], v1 = acc[ai][bj][m][1];
                v0[0] *= bf_lo(gt.x); v0[1] *= bf_hi(gt.x); v0[2] *= bf_lo(gt.y); v0[3] *= bf_hi(gt.y);
                v1[0] *= bf_lo(gt.z); v1[1] *= bf_hi(gt.z); v1[2] *= bf_lo(gt.w); v1[3] *= bf_hi(gt.w);
                bf16_t* dst = merged + (size_t)row * DM + col;
                if (u.z) { const u32x4 o = *(const u32x4*)dst;
                    v0[0] += bf_lo(o.x); v0[1] += bf_hi(o.x); v0[2] += bf_lo(o.y); v0[3] += bf_hi(o.y); v1[0] += bf_lo(o.z); v1[1] += bf_hi(o.z); v1[2] += bf_lo(o.w); v1[3] += bf_hi(o.w); }
                *(u32x4*)dst = pack8(v0, v1);
            }
        }
    }
};

struct EpiRes {
    static constexpr bool PERM = true;
    const float* xin; float* xo; bf16_t* xb; float* rss;
    __device__ __forceinline__ void operator()(const f32x4 (&acc)[2][2][4][2], const pg8::Unit& u, int wr, int wc, int fr, int fq) const {
        const int row0 = u.pm * 256 + wr * 64 + fr;
#pragma unroll
        EPI_LOOP_ROWS {
            const int row = row0 + ai * 128 + m * 16; float ss = 0.f;
#pragma unroll
            for (int bj = 0; bj < 2; ++bj) {
                const size_t off = (size_t)row * DM + u.pn * 256 + bj * 128 + wc * 32 + 8 * fq;
                const f32x4 v0 = *(const f32x4*)(xin + off) + acc[ai][bj][m][0], v1 = *(const f32x4*)(xin + off + 4) + acc[ai][bj][m][1];
                *(f32x4*)(xo + off) = v0; *(f32x4*)(xo + off + 4) = v1;
                if (xb) *(u32x4*)(xb + off) = pack8(v0, v1);
                ss += (v0[0] * v0[0] + v0[1] * v0[1]) + (v0[2] * v0[2] + v0[3] * v0[3]) + (v1[0] * v1[0] + v1[1] * v1[1]) + (v1[2] * v1[2] + v1[3] * v1[3]);
            }
            ss += __shfl_xor(ss, 16); ss += __shfl_xor(ss, 32);
            if (fq == 0) atomicAdd(rss + row, ss);
        }
    }
};

struct EpiUp {
    static constexpr bool PERM = true;
    bf16_t* up; const float* rss; int rowbase;
    __device__ __forceinline__ void operator()(const f32x4 (&acc)[2][2][4][2], const pg8::Unit& u, int wr, int wc, int fr, int fq) const {
        const int row0 = u.pm * 256 + wr * 64 + fr;
#pragma unroll
        EPI_LOOP_ROWS {
            const int row = row0 + ai * 128 + m * 16; const float rs = rsqrtf(rss[row] * (1.f / DM) + EPS);
#pragma unroll
            for (int bj = 0; bj < 2; ++bj) {
                const size_t off = (size_t)(row - rowbase) * NUP + u.pn * 256 + bj * 128 + wc * 32 + 8 * fq;
                *(u32x4*)(up + off) = pack8(acc[ai][bj][m][0] * rs, acc[ai][bj][m][1] * rs);
            }
        }
    }
};

struct Args { const float* in[28]; float* out; unsigned char* ws; };
constexpr int NT = 512, NWV = 8;
constexpr int LDS_BYTES = 147456;

__device__ __forceinline__ float wave_sum(float v) {
#pragma unroll
    for (int o = 1; o < 64; o <<= 1) v += __shfl_xor(v, o);
    return v;
}

#define XB_TMO      128
#define XB_XCNT(j)  (256  + 64 * (j))
#define XB_XSUB(j)  (1280 + 64 * (j))
#define XB_XGEN(j)  (2304 + 64 * (j))
#define XB_TOP      3328
#define XB_TOPGEN   3392
#define XCD_BAR_WORDS 3456
#define XB_SPIN_CAP (1u << 18)

__device__ __forceinline__ unsigned xb_ld(unsigned* p)              { return __hip_atomic_load(p, __ATOMIC_RELAXED, __HIP_MEMORY_SCOPE_AGENT); }
__device__ __forceinline__ unsigned xb_add(unsigned* p, unsigned v) { return __hip_atomic_fetch_add(p, v, __ATOMIC_RELAXED, __HIP_MEMORY_SCOPE_AGENT); }
__device__ __forceinline__ unsigned xb_xcc_id() { return (unsigned)__builtin_amdgcn_s_getreg((3 << 11) | 20) & 0xFu; }
#define XB_SPIN(cond, bar) do { unsigned _sp = 0; while (cond) { __builtin_amdgcn_s_sleep(1); \
    if ((++_sp & 255u) == 0u) { if (xb_ld(&(bar)[XB_TMO])) break; if (_sp > XB_SPIN_CAP) { atomicAdd(&(bar)[XB_TMO], 1u); break; } } } } while (0)

struct XcdBarrier {
    unsigned* bar; unsigned x;
    volatile LAS unsigned* st;
};

__device__ __forceinline__ XcdBarrier xcd_barrier_post(unsigned* bar, volatile LAS unsigned* st) {
    XcdBarrier b; b.bar = bar; b.x = xb_xcc_id(); b.st = st;
    if (threadIdx.x == 0) (void)xb_add(&bar[XB_XCNT(b.x)], 1u);
    return b;
}
__device__ __forceinline__ void xcd_barrier_complete(unsigned* bar, unsigned x, unsigned& nloc, unsigned& nx) {
    const unsigned G = gridDim.x * gridDim.y * gridDim.z;
    unsigned sum, cnt, mine, sp = 0u;
    for (;;) {
        sum = 0u; cnt = 0u; mine = 0u;
#pragma unroll
        for (unsigned j = 0; j < 16; ++j) { const unsigned c = xb_ld(&bar[XB_XCNT(j)]); sum += c; cnt += (c > 0u) ? 1u : 0u; mine = (j == x) ? c : mine; }
        if (sum == G) break;
        __builtin_amdgcn_s_sleep(1);
        if ((++sp & 255u) == 0u) { if (xb_ld(&bar[XB_TMO])) break; if (sp > XB_SPIN_CAP) { atomicAdd(&bar[XB_TMO], 1u); break; } }
    }
    nloc = mine > 0u ? mine : 1u; nx = cnt > 0u ? cnt : 1u;
}

__device__ __forceinline__ void xcd_barrier(const XcdBarrier& b) {
    asm volatile("s_waitcnt vmcnt(0)" ::: "memory");
    __syncthreads();
    if (threadIdx.x == 0) {
        unsigned* bar = b.bar;
        __builtin_amdgcn_s_waitcnt(0);
        unsigned nloc = b.st[0], nx = b.st[1];
        if (nloc == 0u) { xcd_barrier_complete(bar, b.x, nloc, nx); b.st[0] = nloc; b.st[1] = nx; }
        const unsigned old = xb_add(&bar[XB_XSUB(b.x)], 1u);
        const unsigned gen = old / nloc;
        if (old + 1u == (gen + 1u) * nloc) {
            __builtin_amdgcn_fence(__ATOMIC_RELEASE, "agent");
            asm volatile("s_waitcnt vmcnt(0)" ::: "memory");
            const unsigned og = xb_add(&bar[XB_TOP], 1u);
            const unsigned tg = og / nx;
            if (og + 1u == (tg + 1u) * nx) xb_add(&bar[XB_TOPGEN], 1u);
            else XB_SPIN(xb_ld(&bar[XB_TOPGEN]) == tg, bar);
            __builtin_amdgcn_fence(__ATOMIC_ACQUIRE, "agent");
            xb_add(&bar[XB_XGEN(b.x)], 1u);
            asm volatile("s_waitcnt vmcnt(0)" ::: "memory");
        } else {
            XB_SPIN(xb_ld(&bar[XB_XGEN(b.x)]) == gen, bar);
            __builtin_amdgcn_fence(__ATOMIC_ACQUIRE, "agent");
            asm volatile("s_waitcnt vmcnt(0)" ::: "memory");
        }
    }
    __syncthreads();
}

__device__ __forceinline__ int colmap(int kind, int c) {
    if (kind == 1) return c < 1280 ? c : (c < 1304 ? C_NG + (c - 1280) : c - 24);
    if (kind == 2) { return c < DFF ? (c >> 7) * 256 + (c & 127) : ((c - DFF) >> 7) * 256 + 128 + ((c - DFF) & 127); }
    return c;
}
__device__ __forceinline__ void transpose_item(const float* W, int K, int N, bf16_t* WT, LAS float* scr, int kb, int nb, int lane, const float* kscale, int kind) {
    const int k0 = 64 * kb, n0 = 32 * nb;
#pragma unroll 8
    for (int i = 0; i < 32; ++i) { const int kk = 2 * i + (lane >> 5), n = n0 + (lane & 31); float v = (n < N) ? W[(size_t)(k0 + kk) * N + n] : 0.f; if (kscale) v *= kscale[k0 + kk]; scr[kk * 33 + (lane & 31)] = v; }
    asm volatile("s_waitcnt lgkmcnt(0)" ::: "memory");
    const int c = lane & 7;
#pragma unroll
    for (int j = 0; j < 4; ++j) { const int n = (lane >> 3) + 8 * j; const LAS float* s = scr + (8 * c) * 33 + n;
        if (n0 + n < N) { u32x4 o; o.x = cvt_pk_bf16(s[0 * 33], s[1 * 33]); o.y = cvt_pk_bf16(s[2 * 33], s[3 * 33]); o.z = cvt_pk_bf16(s[4 * 33], s[5 * 33]); o.w = cvt_pk_bf16(s[6 * 33], s[7 * 33]);
            *(u32x4*)(WT + (size_t)colmap(kind, n0 + n) * K + k0 + 8 * c) = o; } }
    asm volatile("s_waitcnt lgkmcnt(0)" ::: "memory");
}

#define EXP2(x) __builtin_amdgcn_exp2f(x)
#define MFMA16(a, b, c) __builtin_amdgcn_mfma_f32_16x16x32_bf16((a), (b), (c), 0, 0, 0)
__device__ __forceinline__ float dpp_x1(float v) { return __int_as_float(__builtin_amdgcn_update_dpp(0, __float_as_int(v), 0xB1, 0xF, 0xF, true)); }
__device__ __forceinline__ float dpp_x2(float v) { return __int_as_float(__builtin_amdgcn_update_dpp(0, __float_as_int(v), 0x4E, 0xF, 0xF, true)); }
struct KOp { bf16x8 a00, a01, a10, a11; };
struct VOp { bf16x8 v0, v1, v2, v3; };
__device__ __forceinline__ KOp ldk(const bf16_t* Kb, size_t pitch, int kb, int lane) {
    const int i = lane & 15, q = lane >> 4;
    const bf16_t* r0 = Kb + (size_t)(kb + 8 * (i >> 2) + (i & 3)) * pitch + 8 * q; const bf16_t* r1 = r0 + 4 * pitch;
    KOp k; k.a00 = *(const bf16x8*)r0; k.a01 = *(const bf16x8*)(r0 + 32); k.a10 = *(const bf16x8*)r1; k.a11 = *(const bf16x8*)(r1 + 32); return k;
}
__device__ __forceinline__ VOp ldv(const bf16_t* Vt, size_t vpitch, int kb, int lane) {
    const int i = lane & 15, q = lane >> 4; const size_t base = (vpitch == 64) ? (size_t)(kb >> 6) * 4096 + (kb & 63) : (size_t)kb;
    const bf16_t* r = Vt + base + (size_t)i * vpitch + 8 * q;
    VOp v; v.v0 = *(const bf16x8*)r; v.v1 = *(const bf16x8*)(r + 16 * vpitch); v.v2 = *(const bf16x8*)(r + 32 * vpitch); v.v3 = *(const bf16x8*)(r + 48 * vpitch); return v;
}
__device__ __forceinline__ void qk32(const KOp& k, const bf16x8& Bq0, const bf16x8& Bq1, f32x4& S0, f32x4& S1) {
    const f32x4 z = {0.f, 0.f, 0.f, 0.f};
    S0 = MFMA16(k.a00, Bq0, z); S0 = MFMA16(k.a01, Bq1, S0); S1 = MFMA16(k.a10, Bq0, z); S1 = MFMA16(k.a11, Bq1, S1);
}
__device__ __forceinline__ void pv32(const VOp& v, const bf16x8& P, f32x4 (&O)[4]) {
    O[0] = MFMA16(v.v0, P, O[0]); O[1] = MFMA16(v.v1, P, O[1]); O[2] = MFMA16(v.v2, P, O[2]); O[3] = MFMA16(v.v3, P, O[3]);
}
__device__ __forceinline__ bf16x8 packP(const f32x4& p0, const f32x4& p1) { u32x4 w = pack8(p0, p1); return __builtin_bit_cast(bf16x8, w); }

struct KbLin { int base; __device__ __forceinline__ int operator()(int i) const { return base + 32 * i; } };
struct KbLds { const LAS int* l; __device__ __forceinline__ int operator()(int i) const { return l[i]; } };

template <bool NEEDV, class KB, class Body>
__device__ __forceinline__ void pipe3(int n, const KB kbf, Body& body, const bf16_t* Kb, size_t kp, const bf16_t* Vt, size_t vp, int lane) {
    if (n <= 0) return;
    KOp k0, k1; VOp v;
    k0 = ldk(Kb, kp, kbf(0), lane);
    for (int i = 0; i < n; i += 2) {
        { const int kb = kbf(i); if (NEEDV) v = ldv(Vt, vp, kb, lane); k1 = ldk(Kb, kp, kbf(i + 1 < n ? i + 1 : n - 1), lane); body.run(kb, k0, v); }
        if (i + 1 >= n) break;
        { const int kb = kbf(i + 1); if (NEEDV) v = ldv(Vt, vp, kb, lane); k0 = ldk(Kb, kp, kbf(i + 2 < n ? i + 2 : n - 1), lane); body.run(kb, k1, v); }
    }
}

struct BodyCmp1 {
    bf16x8 Bq[2][2]; int nv[2], q; float ml[2], ll[2];
    __device__ __forceinline__ void run(int kb, const KOp& k, const VOp&) {
#pragma unroll
        for (int cg = 0; cg < 2; ++cg) {
            f32x4 S0, S1; qk32(k, Bq[cg][0], Bq[cg][1], S0, S1);
            const int k0 = kb + 8 * q; float mloc = NEGF;
#pragma unroll
            for (int e = 0; e < 4; ++e) { if (k0 + e >= nv[cg]) S0[e] = NEGF; if (k0 + 4 + e >= nv[cg]) S1[e] = NEGF; mloc = fmaxf(mloc, fmaxf(S0[e], S1[e])); }
            const float mn = fmaxf(ml[cg], mloc); float ps = 0.f;
#pragma unroll
            for (int e = 0; e < 4; ++e) { ps += (k0 + e < nv[cg]) ? EXP2(S0[e] - mn) : 0.f; ps += (k0 + 4 + e < nv[cg]) ? EXP2(S1[e] - mn) : 0.f; }
            ll[cg] = ll[cg] * EXP2(ml[cg] - mn) + ps; ml[cg] = mn;
        }
    }
};
struct BodyCmp2 {
    bf16x8 Bq[2][2]; int nv[2], q, g, lane_; float mc[2], inv[2], carry[2]; LAS float* ia[2]; f32x4 O[2][4];
    __device__ __forceinline__ void run(int kb, const KOp& k, const VOp& v) {
#pragma unroll
        for (int cg = 0; cg < 2; ++cg) {
            f32x4 S0, S1; qk32(k, Bq[cg][0], Bq[cg][1], S0, S1);
            const int k0 = kb + 8 * q; f32x4 p0, p1;
#pragma unroll
            for (int e = 0; e < 4; ++e) { p0[e] = (k0 + e < nv[cg]) ? EXP2(S0[e] - mc[cg]) * inv[cg] : 0.f; p1[e] = (k0 + 4 + e < nv[cg]) ? EXP2(S1[e] - mc[cg]) * inv[cg] : 0.f; }
            f32x4 s0 = p0, s1 = p1;
#pragma unroll
            for (int e = 0; e < 4; ++e) { s0[e] += dpp_x1(s0[e]); s0[e] += dpp_x2(s0[e]); s1[e] += dpp_x1(s1[e]); s1[e] += dpp_x2(s1[e]); }
            const float bout = 0.5f * s1[3]; const float recv = __shfl(bout, (lane_ + 48) & 63); const float bin = (q == 0) ? carry[cg] : recv; carry[cg] = recv;
            if (g == 0) { const int j = k0 >> 2; ia[cg][j] = ((s0[0] + s0[1]) + (s0[2] + 0.5f * s0[3])) + bin; ia[cg][j + 1] = 0.5f * s0[3] + ((s1[0] + s1[1]) + (s1[2] + 0.5f * s1[3])); }
            pv32(v, packP(p0, p1), O[cg]);
        }
    }
};
struct BodyWin {
    bf16x8 Bq[2][2]; int q, tt[2]; float m[2], l[2]; f32x4 O[2][4];
    __device__ __forceinline__ void run(int kb, const KOp& k, const VOp& v) {
#pragma unroll
        for (int cg = 0; cg < 2; ++cg) {
            f32x4 S0, S1; qk32(k, Bq[cg][0], Bq[cg][1], S0, S1);
            const int k0 = kb + 8 * q; unsigned vm = 0u;
#pragma unroll
            for (int e = 0; e < 8; ++e) { const bool ok = (k0 + e <= tt[cg]) && (tt[cg] - (k0 + e) < 512); vm |= ok ? (1u << e) : 0u; }
            float mloc = NEGF;
#pragma unroll
            for (int e = 0; e < 4; ++e) { if (!((vm >> e) & 1u)) S0[e] = NEGF; if (!((vm >> (4 + e)) & 1u)) S1[e] = NEGF; mloc = fmaxf(mloc, fmaxf(S0[e], S1[e])); }
            mloc = fmaxf(mloc, __shfl_xor(mloc, 16)); mloc = fmaxf(mloc, __shfl_xor(mloc, 32));
            const float mn = fmaxf(m[cg], mloc), alpha = EXP2(m[cg] - mn); m[cg] = mn;
            f32x4 p0, p1; float ps = 0.f;
#pragma unroll
            for (int e = 0; e < 4; ++e) { p0[e] = ((vm >> e) & 1u) ? EXP2(S0[e] - mn) : 0.f; p1[e] = ((vm >> (4 + e)) & 1u) ? EXP2(S1[e] - mn) : 0.f; ps += p0[e] + p1[e]; }
            l[cg] = l[cg] * alpha + ps;
#pragma unroll
            for (int dt = 0; dt < 4; ++dt) O[cg][dt] = O[cg][dt] * alpha;
            pv32(v, packP(p0, p1), O[cg]);
        }
    }
};

struct AttnT { unsigned long long* tsa; const bf16_t* proj; const bf16_t* kslc; const bf16_t* kwnc; const bf16_t* kcmp; const bf16_t* vcmpT; const bf16_t* vslT; const bf16_t* vwnT; bf16_t* ya; };

constexpr int AL_IMP = 0  , AL_OS = 0  , AL_TM = 67584  , AL_CNT = 69632  ,
              AL_OFF = 70656  , AL_UNITS = 71744  , AL_MM = 77888  , AL_LS = 78912  ;
constexpr int AL_Q = 81920  , QROWB = 528;
constexpr int OSP = 66;
typedef short s16x2 __attribute__((ext_vector_type(2)));
__device__ __forceinline__ int f2ord(float f) { const int b = __float_as_int(f); return b >= 0 ? b : b ^ 0x7fffffff; }
__device__ __forceinline__ float ord2f(int b) { return __int_as_float(b >= 0 ? b : b ^ 0x7fffffff); }

__device__ __forceinline__ void attn_wave_part1(const AttnT& T, int kh, int tq8, int lane, LAS float* imp  , LAS unsigned* tm, int wave) {
    const int col = lane & 15, q = lane >> 4, tk = col >> 2, g = col & 3;
    const int t0 = tq8 * 8, h = kh * 4 + g;
    bf16x8 Bq[2][2]; float g0[2], g2[2]; int tcg[2];
#pragma unroll
    for (int cg = 0; cg < 2; ++cg) { tcg[cg] = t0 + 4 * cg + tk; const bf16_t* prow = T.proj + (size_t)tcg[cg] * PP;
        Bq[cg][0] = *(const bf16x8*)(prow + C_Q + h * 64 + 8 * q); Bq[cg][1] = *(const bf16x8*)(prow + C_Q + h * 64 + 32 + 8 * q);
        g0[cg] = bf2f(prow[C_NG + h * 3 + 0]); g2[cg] = bf2f(prow[C_NG + h * 3 + 2]); }
    for (int i = lane; i < 8 * 264; i += 64) imp[i] = 0.f;
    {
        const bf16_t* Kc = T.kcmp + (size_t)kh * 1024 * 64; const bf16_t* Vc = T.vcmpT + (size_t)kh * 64 * 1024;
        const int tmax = t0 + 7, nvmax = tmax >= 31 ? ((tmax - 31) >> 4) + 1 : 0, nsteps = (nvmax + 31) >> 5;
        BodyCmp1 b1;
#pragma unroll
        for (int cg = 0; cg < 2; ++cg) { b1.Bq[cg][0] = Bq[cg][0]; b1.Bq[cg][1] = Bq[cg][1]; b1.nv[cg] = tcg[cg] >= 31 ? ((tcg[cg] - 31) >> 4) + 1 : 0; b1.ml[cg] = NEGF; b1.ll[cg] = 0.f; }
        b1.q = q;
        pipe3<false>(nsteps, KbLin{0}, b1, Kc, 64, Vc, 1024, lane);
        BodyCmp2 b2; b2.q = q; b2.g = g; b2.lane_ = lane; b2.carry[0] = 0.f; b2.carry[1] = 0.f;
#pragma unroll
        for (int cg = 0; cg < 2; ++cg) {
            float mc = fmaxf(b1.ml[cg], __shfl_xor(b1.ml[cg], 16)); mc = fmaxf(mc, __shfl_xor(mc, 32));
            float lc = b1.ll[cg] * EXP2(b1.ml[cg] - mc); lc += __shfl_xor(lc, 16); lc += __shfl_xor(lc, 32);
            b2.Bq[cg][0] = Bq[cg][0]; b2.Bq[cg][1] = Bq[cg][1]; b2.nv[cg] = b1.nv[cg]; b2.mc[cg] = mc; b2.inv[cg] = 1.f / fmaxf(lc, 1e-30f); b2.ia[cg] = imp + (4 * cg + tk) * 264;
#pragma unroll
            for (int dt = 0; dt < 4; ++dt) b2.O[cg][dt] = (f32x4){0.f, 0.f, 0.f, 0.f};
        }
        asm volatile("s_waitcnt lgkmcnt(0)" ::: "memory");
        pipe3<true>(nsteps, KbLin{0}, b2, Kc, 64, Vc, 1024, lane);
        if (q == 0 && g == 0 && nsteps > 0) { b2.ia[0][8 * nsteps] = b2.carry[0]; b2.ia[1][8 * nsteps] = b2.carry[1]; }
#pragma unroll
        for (int cg = 0; cg < 2; ++cg) { bf16_t* yrow = T.ya + (size_t)tcg[cg] * 512 + h * 64 + 4 * q;
#pragma unroll
            for (int dt = 0; dt < 4; ++dt) { const f32x4 o = b2.O[cg][dt] * g0[cg]; u32x2 w; w.x = cvt_pk_bf16(o[0], o[1]); w.y = cvt_pk_bf16(o[2], o[3]); *(u32x2*)(yrow + 16 * dt) = w; } }
    }
    asm volatile("s_waitcnt lgkmcnt(0)" ::: "memory");
    for (int tk2 = 0; tk2 < 8; ++tk2) {
        const int tt = t0 + tk2, cur = tt >> 6, nvalid = cur + 1, KSEL = nvalid < 16 ? nvalid : 16;
        int bits[4];
#pragma unroll
        for (int s = 0; s < 4; ++s) { const int j = s * 64 + lane; const float v = imp[tk2 * 264 + j];
            bits[s] = (j == 0 || j == cur) ? 0x7F000000 : (j < nvalid ? __float_as_int(v) : -1); }
        int prefix = 0;
        for (int bit = 30; bit >= 0; --bit) { const int Tt = prefix | (1 << bit); int cnt = 0;
#pragma unroll
            for (int s = 0; s < 4; ++s) cnt += __popcll(__ballot(bits[s] >= Tt));
            if (cnt >= KSEL) prefix = Tt; }
        unsigned long long sel[4]; int need = KSEL;
#pragma unroll
        for (int s = 0; s < 4; ++s) { sel[s] = __ballot(bits[s] > prefix); need -= __popcll(sel[s]); }
#pragma unroll
        for (int s = 0; s < 4; ++s) { unsigned long long me = __ballot(bits[s] == prefix);
            while (me != 0ull && need > 0) { const unsigned long long low = me & (0ull - me); sel[s] |= low; me ^= low; --need; } }
        const int tbi = wave * 8 + tk2; const unsigned tbit = 1u << (tbi & 31);
#pragma unroll
        for (int s = 0; s < 4; ++s) if ((sel[s] >> lane) & 1ull) __hip_atomic_fetch_or(tm + (s * 64 + lane) * 2 + (tbi >> 5), tbit, __ATOMIC_RELAXED, __HIP_MEMORY_SCOPE_WORKGROUP);
    }
    {
        const bf16_t* Kw = T.kwnc + (size_t)kh * SEQ * 64; const bf16_t* Vw = T.vwnT + (size_t)kh * 256 * 4096;
        const int klo = (t0 - 511 > 0 ? t0 - 511 : 0) & ~31; const int n = ((t0 + 7 - klo) >> 5) + 1;
        BodyWin bo; bo.q = q;
#pragma unroll
        for (int cg = 0; cg < 2; ++cg) { bo.Bq[cg][0] = Bq[cg][0]; bo.Bq[cg][1] = Bq[cg][1]; bo.tt[cg] = tcg[cg]; bo.m[cg] = NEGF; bo.l[cg] = 0.f;
#pragma unroll
            for (int dt = 0; dt < 4; ++dt) bo.O[cg][dt] = (f32x4){0.f, 0.f, 0.f, 0.f}; }
        pipe3<true>(n, KbLin{klo}, bo, Kw, 64, Vw, 64, lane);
#pragma unroll
        for (int cg = 0; cg < 2; ++cg) { float l = bo.l[cg]; l += __shfl_xor(l, 16); l += __shfl_xor(l, 32);
            const float sc = g2[cg] / fmaxf(l, 1e-30f); bf16_t* yrow = T.ya + (size_t)tcg[cg] * 512 + h * 64 + 4 * q;
#pragma unroll
            for (int dt = 0; dt < 4; ++dt) { const u32x2 y = *(const u32x2*)(yrow + 16 * dt); const f32x4 o = bo.O[cg][dt] * sc;
                u32x2 w; w.x = cvt_pk_bf16(bf_lo(y.x) + o[0], bf_hi(y.x) + o[1]); w.y = cvt_pk_bf16(bf_lo(y.y) + o[2], bf_hi(y.y) + o[3]); *(u32x2*)(yrow + 16 * dt) = w; } }
    }
    asm volatile("s_waitcnt lgkmcnt(0)" ::: "memory");
}

struct UnitPre { int j; unsigned tlo, thi; bf16x8 q00, q01, q10, q11; KOp ka, kb; VOp va, vb; };
template <int PASS>
__device__ __forceinline__ UnitPre unit_load(const LAS unsigned char* qlds, const bf16_t* Ks, const bf16_t* Vs, int kh, int tile, const LAS u32x4* units, int u, int lane) {
    const int col = lane & 15, q = lane >> 4, slot = col >> 2, g = col & 3;
    const u32x4 d = units[u]; UnitPre P; P.j = __builtin_amdgcn_readfirstlane((int)d.x); P.tlo = (unsigned)__builtin_amdgcn_readfirstlane((int)d.y); P.thi = (unsigned)__builtin_amdgcn_readfirstlane((int)d.z);
    const unsigned t0b = (P.tlo >> (8 * slot)) & 0xffu, t1b = (P.thi >> (8 * slot)) & 0xffu;
    const LAS unsigned char* qr0 = qlds + (t0b == 0xffu ? 0 : (int)t0b) * QROWB + g * 128 + 16 * q;
    const LAS unsigned char* qr1 = qlds + (t1b == 0xffu ? 0 : (int)t1b) * QROWB + g * 128 + 16 * q;
    P.q00 = *(const LAS bf16x8*)qr0; P.q01 = *(const LAS bf16x8*)(qr0 + 64); P.q10 = *(const LAS bf16x8*)qr1; P.q11 = *(const LAS bf16x8*)(qr1 + 64);
    P.ka = ldk(Ks, 64, 64 * P.j, lane); P.kb = ldk(Ks, 64, 64 * P.j + 32, lane);
    if (PASS == 1) { if ((EXPV) == 2) { P.va.v0 = P.ka.a00; P.va.v1 = P.ka.a01; P.va.v2 = P.ka.a10; P.va.v3 = P.ka.a11; P.vb = P.va; } else { P.va = ldv(Vs, 64, 64 * P.j, lane); P.vb = ldv(Vs, 64, 64 * P.j + 32, lane); } }
    return P;
}
template <int PASS>
__device__ __forceinline__ void unit_group(const UnitPre& P, const bf16x8& q0, const bf16x8& q1, unsigned toks, int tile, LAS unsigned char* lds, int lane) {
    const int col = lane & 15, q = lane >> 4, slot = col >> 2, g = col & 3;
    const int ti = (int)((toks >> (8 * slot)) & 0xffu);
    f32x4 S0a, S1a, S0b, S1b; qk32(P.ka, q0, q1, S0a, S1a); qk32(P.kb, q0, q1, S0b, S1b);
    const bool valid = ti != 0xff; const int row = (valid ? ti : 0) * 4 + g;
    const int lim = (P.j == tile) ? (valid ? ti : -1) - 8 * q : (valid ? 1000 : -1);
    LAS int* mm = (LAS int*)(lds + AL_MM); LAS float* ls = (LAS float*)(lds + AL_LS);
    if (PASS == 0) {
        float mloc = NEGF;
#pragma unroll
        for (int e = 0; e < 4; ++e) { mloc = fmaxf(mloc, e <= lim ? S0a[e] : NEGF); mloc = fmaxf(mloc, e + 4 <= lim ? S1a[e] : NEGF); mloc = fmaxf(mloc, e + 32 <= lim ? S0b[e] : NEGF); mloc = fmaxf(mloc, e + 36 <= lim ? S1b[e] : NEGF); }
        if ((EXPV) != 4) { mloc = fmaxf(mloc, __shfl_xor(mloc, 16)); mloc = fmaxf(mloc, __shfl_xor(mloc, 32)); }
        if (q == 0 && valid && (EXPV) != 3) __hip_atomic_fetch_max(mm + row, f2ord(mloc), __ATOMIC_RELAXED, __HIP_MEMORY_SCOPE_WORKGROUP);
    } else {
        const float m = ord2f(mm[row]);
        f32x4 p0a, p1a, p0b, p1b; float ps = 0.f;
#pragma unroll
        for (int e = 0; e < 4; ++e) { p0a[e] = e <= lim ? EXP2(S0a[e] - m) : 0.f; p1a[e] = e + 4 <= lim ? EXP2(S1a[e] - m) : 0.f; p0b[e] = e + 32 <= lim ? EXP2(S0b[e] - m) : 0.f; p1b[e] = e + 36 <= lim ? EXP2(S1b[e] - m) : 0.f;
            ps += (p0a[e] + p1a[e]) + (p0b[e] + p1b[e]); }
        ps += __shfl_xor(ps, 16); ps += __shfl_xor(ps, 32);
        if (q == 0 && valid) __hip_atomic_fetch_add(ls + row, ps, __ATOMIC_RELAXED, __HIP_MEMORY_SCOPE_WORKGROUP);
        f32x4 O[4];
#pragma unroll
        for (int dt = 0; dt < 4; ++dt) O[dt] = (f32x4){0.f, 0.f, 0.f, 0.f};
        pv32(P.va, packP(p0a, p1a), O); pv32(P.vb, packP(p0b, p1b), O);
        if (valid && (EXPV) != 1) { LAS bf16_t* orow = (LAS bf16_t*)(lds + AL_OS) + row * OSP + 4 * q;
#pragma unroll
            for (int dt = 0; dt < 4; ++dt) { const unsigned w0 = cvt_pk_bf16(O[dt][0], O[dt][1]), w1 = cvt_pk_bf16(O[dt][2], O[dt][3]);
                __builtin_amdgcn_ds_atomic_fadd_v2bf16((LAS s16x2*)(orow + 16 * dt), __builtin_bit_cast(s16x2, w0));
                __builtin_amdgcn_ds_atomic_fadd_v2bf16((LAS s16x2*)(orow + 16 * dt + 2), __builtin_bit_cast(s16x2, w1)); } }
    }
}
template <int PASS>
__device__ __forceinline__ void unit_compute(const UnitPre& P, int tile, LAS unsigned char* lds, int lane) {
    unit_group<PASS>(P, P.q00, P.q01, P.tlo, tile, lds, lane);
    if (P.thi != 0xffffffffu) unit_group<PASS>(P, P.q10, P.q11, P.thi, tile, lds, lane);
}
template <int PASS>
__device__ __forceinline__ void unit_pass(const AttnT& T, int kh, int tile, int n, LAS unsigned char* lds, int wave, int lane) {
    const bf16_t* Ks = T.kslc + (size_t)kh * SEQ * 64; const bf16_t* Vs = T.vslT + (size_t)kh * 256 * 4096;
    const LAS u32x4* units = (const LAS u32x4*)(lds + AL_UNITS);
    int u = wave; if (u >= n) return;
    UnitPre A = unit_load<PASS>(lds + AL_Q, Ks, Vs, kh, tile, units, u, lane), B = A;
    for (; u < n; u += 16) {
        const int u1 = u + 8; if (u1 < n) B = unit_load<PASS>(lds + AL_Q, Ks, Vs, kh, tile, units, u1, lane);
        unit_compute<PASS>(A, tile, lds, lane);
        if (u1 >= n) break;
        const int u2 = u + 16; if (u2 < n) A = unit_load<PASS>(lds + AL_Q, Ks, Vs, kh, tile, units, u2, lane);
        unit_compute<PASS>(B, tile, lds, lane);
    }
}

__device__ __forceinline__ void attn_tile(const AttnT& T, int kh, int tile, LAS unsigned char* lds, int tid, int wave, int lane) {
    LAS unsigned* tm = (LAS unsigned*)(lds + AL_TM);
    for (int i = tid; i < 512; i += NT) tm[i] = 0u;
    { const int ti = tid >> 3, part = tid & 7; const u32x4* src = (const u32x4*)(T.proj + (size_t)(tile * 64 + ti) * PP + C_Q + kh * 256 + part * 32); LAS u32x4* dst = (LAS u32x4*)(lds + AL_Q + ti * QROWB + part * 64);
      dst[0] = src[0]; dst[1] = src[1]; dst[2] = src[2]; dst[3] = src[3]; }
    __syncthreads();
    if ((TSK) >= 20 && blockIdx.x == 0 && threadIdx.x == 0) T.tsa[15] = __builtin_amdgcn_s_memrealtime();
    for (int r3 = 0; r3 < ((PROBE_REP) == 41 ? 2 : 1); ++r3)
    attn_wave_part1(T, kh, tile * 8 + wave, lane, (LAS float*)(lds + AL_IMP + wave * 8448), tm, wave);
    __threadfence_block(); __syncthreads();
    ASTAMP(0);
    LAS int* cnt = (LAS int*)(lds + AL_CNT); LAS int* off = (LAS int*)(lds + AL_OFF); LAS u32x4* units = (LAS u32x4*)(lds + AL_UNITS);
    for (int i = tid; i < 256 * OSP / 2; i += NT) ((LAS unsigned*)(lds + AL_OS))[i] = 0u;
    if (tid < 256) { ((LAS int*)(lds + AL_MM))[tid] = f2ord(NEGF); ((LAS float*)(lds + AL_LS))[tid] = 0.f; cnt[tid] = (__popc(tm[2 * tid]) + __popc(tm[2 * tid + 1]) + 7) >> 3; }
    __syncthreads();
    if (tid < 64) {
        const int c0 = cnt[4 * tid], c1 = cnt[4 * tid + 1], c2 = cnt[4 * tid + 2], c3 = cnt[4 * tid + 3]; const int tot = (c0 + c1) + (c2 + c3); int inc = tot;
#pragma unroll
        for (int o = 1; o < 64; o <<= 1) { const int v = __shfl_up(inc, o); if (tid >= o) inc += v; }
        const int ex = inc - tot; off[4 * tid] = ex; off[4 * tid + 1] = ex + c0; off[4 * tid + 2] = ex + c0 + c1; off[4 * tid + 3] = ex + c0 + c1 + c2;
        if (tid == 63) off[256] = inc;
    }
    __syncthreads();
    if (tid < 256) { unsigned long long mask = (unsigned long long)tm[2 * tid] | ((unsigned long long)tm[2 * tid + 1] << 32); int o = off[tid];
        while (mask != 0ull) { unsigned tl = 0xffffffffu, th = 0xffffffffu;
#pragma unroll
            for (int k = 0; k < 4; ++k) if (mask != 0ull) { const unsigned ti = (unsigned)__builtin_ctzll(mask); mask &= mask - 1ull; tl = (tl & ~(0xffu << (8 * k))) | (ti << (8 * k)); }
#pragma unroll
            for (int k = 0; k < 4; ++k) if (mask != 0ull) { const unsigned ti = (unsigned)__builtin_ctzll(mask); mask &= mask - 1ull; th = (th & ~(0xffu << (8 * k))) | (ti << (8 * k)); }
            units[o++] = (u32x4){(unsigned)tid, tl, th, 0u}; } }
    __syncthreads();
    const int n = off[256];
    ASTAMP(1);
    unit_pass<0>(T, kh, tile, n, lds, wave, lane);
    if ((PROBE_REP) == 42) unit_pass<0>(T, kh, tile, n, lds, wave, lane);
    __syncthreads();
    ASTAMP(2);
    unit_pass<1>(T, kh, tile, n, lds, wave, lane);
    __syncthreads();
    ASTAMP(3);
    { const int ti = tid >> 3, part = tid & 7, g = part >> 1, d0 = 32 * (part & 1), row = ti * 4 + g, t = tile * 64 + ti, h = kh * 4 + g;
      const float l = ((const LAS float*)(lds + AL_LS))[row]; const float sc = bf2f(T.proj[(size_t)t * PP + C_NG + h * 3 + 1]) / fmaxf(l, 1e-30f);
      const LAS unsigned* orow = (const LAS unsigned*)((const LAS bf16_t*)(lds + AL_OS) + row * OSP + d0); u32x4* yp = (u32x4*)(T.ya + (size_t)t * 512 + h * 64 + d0);
#pragma unroll
      for (int i = 0; i < 4; ++i) { const u32x4 y = yp[i]; const unsigned o0 = orow[4 * i], o1 = orow[4 * i + 1], o2 = orow[4 * i + 2], o3 = orow[4 * i + 3]; f32x4 a, b;
          a[0] = bf_lo(y.x) + bf_lo(o0) * sc; a[1] = bf_hi(y.x) + bf_hi(o0) * sc; a[2] = bf_lo(y.y) + bf_lo(o1) * sc; a[3] = bf_hi(y.y) + bf_hi(o1) * sc;
          b[0] = bf_lo(y.z) + bf_lo(o2) * sc; b[1] = bf_hi(y.z) + bf_hi(o2) * sc; b[2] = bf_lo(y.w) + bf_lo(o3) * sc; b[3] = bf_hi(y.w) + bf_hi(o3) * sc;
          yp[i] = pack8(a, b); } }
    __syncthreads();
    ASTAMP(4);
    if ((TSK) >= 20 && blockIdx.x == 0 && threadIdx.x == 0) T.tsa[5] += (unsigned long long)n;
}

__device__ __forceinline__ void ssm_load_u(const bf16_t* proj, int c, int g, int lane, LAS float* ubuf) {
#pragma unroll
    for (int r = 0; r < 2; ++r) { const int tl = lane + 64 * r; const u32x4* src = (const u32x4*)(proj + (size_t)(c * 128 + tl) * PP + C_U + g * 16); const u32x4 a = src[0], b = src[1];
        LAS f32x4* d = (LAS f32x4*)(ubuf + tl * 16);
        d[0] = (f32x4){bf_lo(a.x), bf_hi(a.x), bf_lo(a.y), bf_hi(a.y)}; d[1] = (f32x4){bf_lo(a.z), bf_hi(a.z), bf_lo(a.w), bf_hi(a.w)};
        d[2] = (f32x4){bf_lo(b.x), bf_hi(b.x), bf_lo(b.y), bf_hi(b.y)}; d[3] = (f32x4){bf_lo(b.z), bf_hi(b.z), bf_lo(b.w), bf_hi(b.w)}; }
    asm volatile("s_waitcnt lgkmcnt(0)" ::: "memory");
}
__device__ __forceinline__ f32x2 ssm_step(const f32x2 (&Bb)[16], const f32x2 A, const f32x2 x, const LAS float* urow) {
    const f32x4 u0 = *(const LAS f32x4*)(urow), u1 = *(const LAS f32x4*)(urow + 4), u2 = *(const LAS f32x4*)(urow + 8), u3 = *(const LAS f32x4*)(urow + 12);
    f32x2 bu = Bb[0] * u0[0]; f32x2 bv = Bb[1] * u0[1];
    bu += Bb[2] * u0[2]; bv += Bb[3] * u0[3]; bu += Bb[4] * u1[0]; bv += Bb[5] * u1[1]; bu += Bb[6] * u1[2]; bv += Bb[7] * u1[3];
    bu += Bb[8] * u2[0]; bv += Bb[9] * u2[1]; bu += Bb[10] * u2[2]; bv += Bb[11] * u2[3]; bu += Bb[12] * u3[0]; bv += Bb[13] * u3[1]; bu += Bb[14] * u3[2]; bv += Bb[15] * u3[3];
    bu += bv;
    f32x2 r; r.x = A.x * x.x - A.y * x.y + bu.x; r.y = A.x * x.y + A.y * x.x + bu.y; return r;
}
__device__ __forceinline__ void ssm_pass1(const unsigned char* ws, int c, int g, int lane, LAS float* ubuf) {
    const bf16_t* proj = (const bf16_t*)(ws + WS_PROJ);
    ssm_load_u(proj, c, g, lane, ubuf);
    const f32x2* Bbar = (const f32x2*)(ws + WS_BBAR) + (size_t)(g * 64 + lane) * 16; f32x2 Bb[16];
#pragma unroll
    for (int hh = 0; hh < 16; ++hh) Bb[hh] = Bbar[hh];
    const f32x2 A = ((const f32x2*)(ws + WS_ABAR))[g * 64 + lane];
    f32x2 x = {0.f, 0.f};
    for (int s = 0; s < 128; ++s) x = ssm_step(Bb, A, x, ubuf + s * 16);
    ((f32x2*)(ws + WS_SBUF))[(size_t)(c * 32 + g) * 64 + lane] = x;
    asm volatile("s_waitcnt lgkmcnt(0)" ::: "memory");
}
__device__ __forceinline__ void ssm_pass3(const Args& a, int c, int g, int lane, LAS float* ubuf, LAS unsigned char* xl  ) {
    const unsigned char* ws = a.ws; const bf16_t* proj = (const bf16_t*)(ws + WS_PROJ);
    ssm_load_u(proj, c, g, lane, ubuf);
    const f32x2* Bbar = (const f32x2*)(ws + WS_BBAR) + (size_t)(g * 64 + lane) * 16; f32x2 Bb[16];
#pragma unroll
    for (int hh = 0; hh < 16; ++hh) Bb[hh] = Bbar[hh];
    const f32x2 A = ((const f32x2*)(ws + WS_ABAR))[g * 64 + lane], A128 = ((const f32x2*)(ws + WS_A128))[g * 64 + lane];
    f32x2 x = {0.f, 0.f};
    { const f32x2* Sb = (const f32x2*)(ws + WS_SBUF) + g * 64 + lane;
      _Pragma("unroll 8") for (int cc = 0; cc < c; ++cc) { const f32x2 s = Sb[(size_t)cc * 32 * 64]; f32x2 r; r.x = A128.x * x.x - A128.y * x.y + s.x; r.y = A128.x * x.y + A128.y * x.x + s.y; x = r; } }
    const int hrow = lane & 15, q = lane >> 4; bf16x8 Cm[4];
    { const float* cre = a.in[14] + (size_t)(g * 16 + hrow) * 64; const float* cim = a.in[15] + (size_t)(g * 16 + hrow) * 64;
#pragma unroll
      for (int ks = 0; ks < 4; ++ks) { const f32x4 r = *(const f32x4*)(cre + 16 * ks + 4 * q), im = *(const f32x4*)(cim + 16 * ks + 4 * q);
          u32x4 w; w.x = cvt_pk_bf16(r[0], -im[0]); w.y = cvt_pk_bf16(r[1], -im[1]); w.z = cvt_pk_bf16(r[2], -im[2]); w.w = cvt_pk_bf16(r[3], -im[3]); Cm[ks] = __builtin_bit_cast(bf16x8, w); } }
    const f32x4 dsk = *(const f32x4*)(a.in[16] + g * 16 + 4 * q);
    bf16_t* ybp = (bf16_t*)((unsigned char*)a.out + OUT_YBP);
    for (int sub = 0; sub < 8; ++sub) {
#pragma unroll 4
        for (int s = 0; s < 16; ++s) { x = ssm_step(Bb, A, x, ubuf + (sub * 16 + s) * 16); *(LAS unsigned*)(xl + s * 272 + lane * 4) = cvt_pk_bf16(x.x, x.y); }
        asm volatile("s_waitcnt lgkmcnt(0)" ::: "memory");
        f32x4 acc = {0.f, 0.f, 0.f, 0.f};
#pragma unroll
        for (int ks = 0; ks < 4; ++ks) { const bf16x8 b = *(const LAS bf16x8*)(xl + hrow * 272 + ks * 64 + q * 16); acc = MFMA16(Cm[ks], b, acc); }
        const int tl = sub * 16 + hrow; const f32x4 uu = *(const LAS f32x4*)(ubuf + tl * 16 + 4 * q);
        f32x4 y = acc + dsk * uu;
        u32x2 w; w.x = cvt_pk_bf16(gelu_tanh(y[0]), gelu_tanh(y[1])); w.y = cvt_pk_bf16(gelu_tanh(y[2]), gelu_tanh(y[3]));
        *(u32x2*)(ybp + (size_t)(c * 128 + tl) * 512 + g * 16 + 4 * q) = w;
        asm volatile("s_waitcnt lgkmcnt(0)" ::: "memory");
    }
}

__global__ void __launch_bounds__(NT, 2) fwd_mega(Args a) {
    extern __shared__ __attribute__((aligned(16))) unsigned char lds_raw[];
    cg::grid_group grid = cg::this_grid();
    LAS unsigned char* lds = (LAS unsigned char*)lds_raw;
    const int tid = threadIdx.x, lane = tid & 63, wave = __builtin_amdgcn_readfirstlane(tid >> 6);
    const int G = gridDim.x, bid = blockIdx.x;
    const int gw = bid * NWV + wave, NGW = G * NWV;
    const int gt = bid * NT + tid, NGT = G * NT;
    unsigned char* ws = a.ws;
    const float* x = a.in[0];
    STAMP(0);
    if ((TSK) >= 20 && blockIdx.x == 0 && threadIdx.x == 0) for (int i = 0; i < 16; ++i) ((unsigned long long*)(a.ws + 244 * 1024))[i] = 0ull;
    if (tid < 4) ((volatile LAS unsigned*)(lds + 131072 + 64))[tid] = 0u;
    if (bid == 0) for (int i = tid; i < XCD_BAR_WORDS; i += NT) ((unsigned*)(ws + WS_BAR))[i] = 0u;
    __syncthreads();

    {
        if (bid < 16) {
            LAS float* red = (LAS float*)lds;
            const int o = bid * 32 + (tid & 31), ksl = tid >> 5, which = o >> 8, colc = o & 255;
            const float* pe = a.in[which ? 7 : 4]; const float* w1 = a.in[which ? 8 : 5]; float s = 0.f;
            _Pragma("unroll 16") for (int k = ksl * 128; k < ksl * 128 + 128; ++k) s += pe[k] * w1[(size_t)k * 256 + colc];
            red[ksl * 32 + (tid & 31)] = s; __syncthreads();
            if (tid < 32) { float t = 0.f; for (int i = 0; i < 16; ++i) t += red[i * 32 + tid]; ((float*)(ws + WS_BIASPE))[o] = t; }
            __syncthreads();
        }
        LAS float* scr = (LAS float*)(lds + wave * 8448);
        constexpr int I_IN = 16 * 121, I_GLU = 8 * 16, I_PA = 8 * 32, I_OUT = 16 * 32, I_UP = 16 * 176, I_DN = 44 * 32, I_W1 = 32 * 8;
        constexpr int NITEMS = I_IN + I_GLU + 2 * I_PA + I_OUT + I_UP + I_DN + 2 * I_W1;
        for (int it = gw; it < NITEMS; it += NGW) {
            int r = it;
            if (r < I_IN) { transpose_item(a.in[3], 1024, DIN, (bf16_t*)(ws + WS_WIN), scr, r / 121, r % 121, lane, a.in[2], 1); continue; } r -= I_IN;
            if (r < I_GLU) { transpose_item(a.in[18], 512, 512, (bf16_t*)(ws + WS_WGLU), scr, r / 16, r % 16, lane, nullptr, 0); continue; } r -= I_GLU;
            if (r < I_PA) { transpose_item(a.in[19], 512, 1024, (bf16_t*)(ws + WS_WPA), scr, r / 32, r % 32, lane, nullptr, 0); continue; } r -= I_PA;
            if (r < I_PA) { transpose_item(a.in[20], 512, 1024, (bf16_t*)(ws + WS_WPB), scr, r / 32, r % 32, lane, nullptr, 0); continue; } r -= I_PA;
            if (r < I_OUT) { transpose_item(a.in[21], 1024, 1024, (bf16_t*)(ws + WS_WOUT), scr, r / 32, r % 32, lane, nullptr, 0); continue; } r -= I_OUT;
            if (r < I_UP) { transpose_item(a.in[23], 1024, NUP, (bf16_t*)(ws + WS_WUP), scr, r / 176, r % 176, lane, a.in[22], 2); continue; } r -= I_UP;
            if (r < I_DN) { transpose_item(a.in[26], DFF, 1024, (bf16_t*)(ws + WS_WDOWN), scr, r / 32, r % 32, lane, nullptr, 0); continue; } r -= I_DN;
            if (r < I_W1) { transpose_item(a.in[5], 2048, 256, (bf16_t*)(ws + WS_W1K), scr, r / 8, r % 8, lane, nullptr, 0); continue; } r -= I_W1;
            transpose_item(a.in[8], 2048, 256, (bf16_t*)(ws + WS_W1V), scr, r / 8, r % 8, lane, nullptr, 0);
        }
        { u32x4* p = (u32x4*)(ws + WS_WIN + (size_t)DIN * 1024 * 2); const int n = (4096 - DIN) * 1024 * 2 / 16; for (int i = gt; i < n; i += NGT) p[i] = (u32x4){0u, 0u, 0u, 0u}; }
        { u32x4* p = (u32x4*)(ws + WS_PROJ + (size_t)SEQ * PP * 2); const int n = 32 * PP * 2 / 16; for (int i = gt; i < n; i += NGT) p[i] = (u32x4){0u, 0u, 0u, 0u}; }
        for (int i = gt; i < 128 * 64 + 2048; i += NGT) {
            if (i < 128 * 64) { const int r = i >> 6, cidx = SEQ + (i & 63); ((bf16_t*)(ws + WS_VSLT))[(size_t)r * VTP + cidx] = 0; ((bf16_t*)(ws + WS_VWNT))[(size_t)r * VTP + cidx] = 0; }
            else { const int j = i - 128 * 64; ((bf16_t*)(ws + WS_VSLT))[(size_t)128 * VTP + j] = 0; ((bf16_t*)(ws + WS_VWNT))[(size_t)128 * VTP + j] = 0; }
        }
        for (int i = gt; i < SEQ; i += NGT) { ((float*)(ws + WS_RSS2))[i] = 0.f; ((float*)(ws + WS_RSS3))[i] = 0.f; }
        { const int* pos = (const int*)a.in[1];
          for (int i = gt; i < SEQ * 8; i += NGT) { const int tt = i >> 3, fi = i & 7; const float invf = powf(500000.0f, -(float)(2 * fi) / 16.0f); const float ang = (float)pos[tt] * invf;
              float sn, cs; sincosf(ang, &sn, &cs); ((float*)(ws + WS_ROPEC))[i] = cs; ((float*)(ws + WS_ROPES))[i] = sn; } }
        for (int i = gt; i < 2048; i += NGT) { const int gg = i >> 6;
            const float dt = expf(a.in[17][gg]), ar = a.in[10][i], ai = a.in[11][i];
            const float e = expf(ar * dt), em1 = expm1f(ar * dt), th = ai * dt; float sn, cs; sincosf(th, &sn, &cs); const float sh = sinf(0.5f * th);
            const float Ax = e * cs, Ay = e * sn; const float nx = em1 * cs - 2.f * sh * sh, ny = e * sn;
            const float den = 1.f / (ar * ar + ai * ai); const float fx = (nx * ar + ny * ai) * den, fy = (ny * ar - nx * ai) * den;
            ((f32x2*)(ws + WS_ABAR))[i] = (f32x2){Ax, Ay};
            float px = Ax, py = Ay;
            for (int k = 0; k < 7; ++k) { const float qx = px * px - py * py, qy = 2.f * px * py; px = qx; py = qy; }
            ((f32x2*)(ws + WS_A128))[i] = (f32x2){px, py};
            const float* bre = a.in[12] + (size_t)i * 16; const float* bim = a.in[13] + (size_t)i * 16; f32x2* Bo = (f32x2*)(ws + WS_BBAR) + (size_t)i * 16;
            for (int hh = 0; hh < 16; ++hh) Bo[hh] = (f32x2){fx * bre[hh] - fy * bim[hh], fx * bim[hh] + fy * bre[hh]};
        }
        for (int r = gw; r < SEQ; r += NGW) {
            const f32x4* xr = (const f32x4*)(x + (size_t)r * DM) + lane; f32x4 v[4]; float s = 0.f;
#pragma unroll
            for (int j = 0; j < 4; ++j) { v[j] = xr[64 * j]; s += (v[j][0] * v[j][0] + v[j][1] * v[j][1]) + (v[j][2] * v[j][2] + v[j][3] * v[j][3]); }
            s = wave_sum(s);
            if (lane == 0) ((float*)(ws + WS_RSTD1))[r] = rsqrtf(s * (1.f / DM) + EPS);
            u32x2* o = (u32x2*)(ws + WS_XB + (size_t)r * DM * 2) + lane;
#pragma unroll
            for (int j = 0; j < 4; ++j) { u32x2 w; w.x = cvt_pk_bf16(v[j][0], v[j][1]); w.y = cvt_pk_bf16(v[j][2], v[j][3]); o[64 * j] = w; }
        }
    }
    grid.sync();
    STAMP(1);
    XcdBarrier xbar = xcd_barrier_post((unsigned*)(ws + WS_BAR), (volatile LAS unsigned*)(lds + 131072 + 64));

    REPS(1) {
        pg8::Gemm g{1024, 2048u, 128u};
        SchedMN S{64, 16, 1, G, bid, 0, (const char*)(ws + WS_XB), nullptr, (const char*)(ws + WS_WIN), nullptr, (size_t)256 * 1024 * 2, (size_t)256 * 1024 * 2};
        EpiProj E{(bf16_t*)(ws + WS_PROJ), (bf16_t*)(ws + WS_VSLT), (bf16_t*)(ws + WS_VWNT), (bf16_t*)(ws + WS_KSL), (bf16_t*)(ws + WS_KWN), (const float*)(ws + WS_RSTD1), (const float*)(ws + WS_ROPEC), (const float*)(ws + WS_ROPES)};
        pg8::gemm_phase<EpiProj, SchedMN, true, true>(lds, g, S, E);
    }
    GSYNC();
    STAMP(2);

    {
        if (bid < 16) {
            pg8::Gemm g{2048, (unsigned)(16 * PP * 2), (unsigned)(PP * 2)};
            SchedCmp S{bid, (const char*)(ws + WS_PROJ), (const char*)(ws + WS_W1K), (const char*)(ws + WS_W1V)};
            EpiCmp E{(bf16_t*)(ws + WS_HID), (const float*)(ws + WS_BIASPE)};
            pg8::gemm_phase<EpiCmp, SchedCmp, true, true>(lds, g, S, E);
        } else {
            LAS float* ubuf = (LAS float*)(lds + wave * 16384);
            for (int it = (bid - 16) * NWV + wave; it < 4096 * ((PROBE_REP) == 12 ? 2 : 1); it += (G - 16) * NWV) ssm_pass1(ws, (it & 4095) >> 5, it & 31, lane, ubuf);
        }
    }
    GSYNC();
    STAMP(3);

    REPS(3) {
        const bf16_t* hid = (const bf16_t*)(ws + WS_HID);
        for (int r = gw; r < 4096; r += NGW) {
            const int z = r >> 10, n = r & 1023, which = z >> 1, kh = z & 1;
            float acc = 0.f;
            if (n < 1023) { const float* w2 = a.in[which ? 9 : 6]; const bf16_t* hr = hid + (size_t)r * 256;
                _Pragma("unroll 16") for (int k = 0; k < 256; k += 2) { const unsigned hw = *(const unsigned*)(hr + k); acc += bf_lo(hw) * w2[k * 64 + lane]; acc += bf_hi(hw) * w2[(k + 1) * 64 + lane]; } }
            if (which == 0) {
                const float other = __shfl_xor(acc, 8); const int prow = 16 * n + 31; float o = acc;
                if (lane < 16 && n < 1023) { const float cs = ((const float*)(ws + WS_ROPEC))[prow * 8 + (lane & 7)], sn = ((const float*)(ws + WS_ROPES))[prow * 8 + (lane & 7)];
                    o = lane < 8 ? acc * cs - other * sn : acc * cs + other * sn; }
                ((bf16_t*)(ws + WS_KCMP))[((size_t)kh * 1024 + n) * 64 + lane] = (bf16_t)(cvt_pk_bf16(o, 0.f) & 0xffff);
            } else {
                ((bf16_t*)(ws + WS_VCMPT))[((size_t)kh * 64 + lane) * 1024 + n] = (bf16_t)(cvt_pk_bf16(acc, 0.f) & 0xffff);
            }
        }
    }
    GSYNC();
    STAMP(4);

    {
        AttnT T{(unsigned long long*)(ws + 244 * 1024), (const bf16_t*)(ws + WS_PROJ), (const bf16_t*)(ws + WS_KSL), (const bf16_t*)(ws + WS_KWN), (const bf16_t*)(ws + WS_KCMP), (const bf16_t*)(ws + WS_VCMPT), (const bf16_t*)(ws + WS_VSLT), (const bf16_t*)(ws + WS_VWNT), (bf16_t*)((unsigned char*)a.out + OUT_YA)};
        LAS float* wl = (LAS float*)(lds + wave * 16384);
        for (int r2 = 0; r2 < ((PROBE_REP) == 4 ? 2 : 1); ++r2)
        for (int pr = bid; pr < 256; pr += G) {
            const int xcd = pr & 7, slot = pr >> 3, kh = xcd & 1, tl = 32 * (xcd >> 1) + slot;
_Pragma("nounroll")
            for (int k2 = 0; k2 < 2; ++k2) { int tk_ = threadIdx.x; asm volatile("" : "+v"(tk_)); attn_tile(T, kh, k2 ? 255 - tl : tl, lds, tk_, __builtin_amdgcn_readfirstlane(tk_ >> 6), tk_ & 63); }
        }
        if ((PROBE_REP) == 4) {
            AttnT T2 = T; T2.ya = (bf16_t*)(ws + WS_XB);
            for (int pr = bid; pr < 256; pr += G) { const int xcd = pr & 7, slot = pr >> 3, kh = xcd & 1, tl = 32 * (xcd >> 1) + slot;
                _Pragma("nounroll") for (int k2 = 0; k2 < 2; ++k2) attn_tile(T2, kh, k2 ? 255 - tl : tl, lds, tid, wave, lane); }
        }
        int tid2 = threadIdx.x; asm volatile("" : "+v"(tid2));
        const int lane2 = tid2 & 63, wave2 = __builtin_amdgcn_readfirstlane(tid2 >> 6), gw2 = bid * NWV + wave2;
        for (int it = gw2; it < 4096 * ((PROBE_REP) == 14 ? 2 : 1); it += NGW) ssm_pass3(a, (it & 4095) >> 5, it & 31, lane2, (LAS float*)(lds + wave2 * 16384), lds + wave2 * 16384 + 8192);
    }
    GSYNC();
    STAMP(5);

    REPS(5) {
        pg8::Gemm g{512, 1024u, 128u};
        SchedMN S{64, 2, 1, G, bid, 0, (const char*)a.out + OUT_YBP, nullptr, (const char*)(ws + WS_WGLU), nullptr, (size_t)256 * 512 * 2, (size_t)256 * 512 * 2};
        EpiGlu E{(const bf16_t*)((const unsigned char*)a.out + OUT_YBP), (bf16_t*)((unsigned char*)a.out + OUT_YB)};
        pg8::gemm_phase<EpiGlu, SchedMN, true, true>(lds, g, S, E);
    }
    GSYNC();
    STAMP(6);

    REPS(6) {
        pg8::Gemm g{512, 1024u, 128u};
        SchedMN S{64, 4, 2, G, bid, 0, (const char*)a.out + OUT_YA, (const char*)a.out + OUT_YB, (const char*)(ws + WS_WPA), (const char*)(ws + WS_WPB), (size_t)256 * 512 * 2, (size_t)256 * 512 * 2};
        EpiMerge E{(const bf16_t*)(ws + WS_PROJ), (bf16_t*)(ws + WS_MERGED)};
        pg8::gemm_phase<EpiMerge, SchedMN, true, true>(lds, g, S, E);
    }
    GSYNC();
    STAMP(7);

    {
        pg8::Gemm g{1024, 2048u, 128u};
        SchedMN S{64, 4, 1, G, bid, 0, (const char*)(ws + WS_MERGED), nullptr, (const char*)(ws + WS_WOUT), nullptr, (size_t)256 * 1024 * 2, (size_t)256 * 1024 * 2};
        EpiRes E{x, a.out, (bf16_t*)(ws + WS_X1B), (float*)(ws + WS_RSS2)};
        pg8::gemm_phase<EpiRes, SchedMN, true, true>(lds, g, S, E);
    }
    GSYNC();
    STAMP(8);

    for (int half = 0; half < 2; ++half) {
        const int pm_off = half ? 31 : 0, nM = half ? 33 : 32, rowbase = pm_off * 256;
        REPS(8) {
            pg8::Gemm g{1024, 2048u, 128u};
            SchedMN S{nM, 22, 1, G, bid, pm_off, (const char*)(ws + WS_X1B), nullptr, (const char*)(ws + WS_WUP), nullptr, (size_t)256 * 1024 * 2, (size_t)256 * 1024 * 2};
            EpiUp E{(bf16_t*)(ws + WS_UPRAW), (const float*)(ws + WS_RSS2), rowbase};
            pg8::gemm_phase<EpiUp, SchedMN, true, true>(lds, g, S, E);
        }
        GSYNC();
    STAMP(9);
        REPS(9) {
            const bf16_t* up = (const bf16_t*)(ws + WS_UPRAW); bf16_t* act = (bf16_t*)(ws + WS_ACT);
            const float* cw = a.in[24]; const float* cb = a.in[25];
            const int tlo = half ? 8192 : 0;
            for (int it = gt; it < 256 * 352; it += NGT) {
                const int cg8 = it % 352, tb = it / 352, c0 = cg8 * 8, tile = c0 >> 7, jj = c0 & 127;
                const int ucol = tile * 256 + jj;
                float wg[3][8], wv[3][8], bg[8], bv[8];
#pragma unroll
                for (int e = 0; e < 8; ++e) { bg[e] = cb[c0 + e]; bv[e] = cb[DFF + c0 + e];
#pragma unroll
                    for (int k = 0; k < 3; ++k) { wg[k][e] = cw[k * NUP + c0 + e]; wv[k][e] = cw[k * NUP + DFF + c0 + e]; } }
                const int ts = tlo + tb * 32;
                float g2[8], g1[8], v2[8], v1[8];
#pragma unroll
                for (int e = 0; e < 8; ++e) { g2[e] = g1[e] = v2[e] = v1[e] = 0.f; }
                if (ts >= 2) {
                    const u32x4 a2 = *(const u32x4*)(up + (size_t)(ts - 2 - rowbase) * NUP + ucol), b2 = *(const u32x4*)(up + (size_t)(ts - 2 - rowbase) * NUP + ucol + 128);
                    const u32x4 a1 = *(const u32x4*)(up + (size_t)(ts - 1 - rowbase) * NUP + ucol), b1 = *(const u32x4*)(up + (size_t)(ts - 1 - rowbase) * NUP + ucol + 128);
                    g2[0] = bf_lo(a2.x); g2[1] = bf_hi(a2.x); g2[2] = bf_lo(a2.y); g2[3] = bf_hi(a2.y); g2[4] = bf_lo(a2.z); g2[5] = bf_hi(a2.z); g2[6] = bf_lo(a2.w); g2[7] = bf_hi(a2.w);
                    v2[0] = bf_lo(b2.x); v2[1] = bf_hi(b2.x); v2[2] = bf_lo(b2.y); v2[3] = bf_hi(b2.y); v2[4] = bf_lo(b2.z); v2[5] = bf_hi(b2.z); v2[6] = bf_lo(b2.w); v2[7] = bf_hi(b2.w);
                    g1[0] = bf_lo(a1.x); g1[1] = bf_hi(a1.x); g1[2] = bf_lo(a1.y); g1[3] = bf_hi(a1.y); g1[4] = bf_lo(a1.z); g1[5] = bf_hi(a1.z); g1[6] = bf_lo(a1.w); g1[7] = bf_hi(a1.w);
                    v1[0] = bf_lo(b1.x); v1[1] = bf_hi(b1.x); v1[2] = bf_lo(b1.y); v1[3] = bf_hi(b1.y); v1[4] = bf_lo(b1.z); v1[5] = bf_hi(b1.z); v1[6] = bf_lo(b1.w); v1[7] = bf_hi(b1.w);
                }
                for (int s = 0; s < 32; ++s) {
                    const int tt = ts + s;
                    const u32x4 a0 = *(const u32x4*)(up + (size_t)(tt - rowbase) * NUP + ucol), b0 = *(const u32x4*)(up + (size_t)(tt - rowbase) * NUP + ucol + 128);
                    float gc[8], vc[8];
                    gc[0] = bf_lo(a0.x); gc[1] = bf_hi(a0.x); gc[2] = bf_lo(a0.y); gc[3] = bf_hi(a0.y); gc[4] = bf_lo(a0.z); gc[5] = bf_hi(a0.z); gc[6] = bf_lo(a0.w); gc[7] = bf_hi(a0.w);
                    vc[0] = bf_lo(b0.x); vc[1] = bf_hi(b0.x); vc[2] = bf_lo(b0.y); vc[3] = bf_hi(b0.y); vc[4] = bf_lo(b0.z); vc[5] = bf_hi(b0.z); vc[6] = bf_lo(b0.w); vc[7] = bf_hi(b0.w);
                    float o[8];
#pragma unroll
                    for (int e = 0; e < 8; ++e) { const float gg = bg[e] + wg[0][e] * g2[e] + wg[1][e] * g1[e] + wg[2][e] * gc[e]; const float vv = bv[e] + wv[0][e] * v2[e] + wv[1][e] * v1[e] + wv[2][e] * vc[e];
                        o[e] = gg * sigmoidf_(gg) * vv; g2[e] = g1[e]; g1[e] = gc[e]; v2[e] = v1[e]; v1[e] = vc[e]; }
                    u32x4 w; w.x = cvt_pk_bf16(o[0], o[1]); w.y = cvt_pk_bf16(o[2], o[3]); w.z = cvt_pk_bf16(o[4], o[5]); w.w = cvt_pk_bf16(o[6], o[7]);
                    *(u32x4*)(act + (size_t)tt * DFF + c0) = w;
                }
            }
        }
        GSYNC();
    STAMP(10);
    }

    {
        pg8::Gemm g{DFF, (unsigned)(DFF * 2), 128u};
        SchedMN S{64, 4, 1, G, bid, 0, (const char*)(ws + WS_ACT), nullptr, (const char*)(ws + WS_WDOWN), nullptr, (size_t)256 * DFF * 2, (size_t)256 * DFF * 2};
        EpiRes E{a.out, a.out, nullptr, (float*)(ws + WS_RSS3)};
        pg8::gemm_phase<EpiRes, SchedMN, true, true>(lds, g, S, E);
    }
    GSYNC();
    STAMP(11);

    {
        const float* gf = a.in[27];
        for (int r = gw; r < SEQ; r += NGW) {
            const float rs = rsqrtf(((const float*)(ws + WS_RSS3))[r] * (1.f / DM) + EPS);
            f32x4* xr = (f32x4*)(a.out + (size_t)r * DM) + lane; const f32x4* gr = (const f32x4*)gf + lane;
#pragma unroll
            for (int j = 0; j < 4; ++j) xr[64 * j] = xr[64 * j] * rs * gr[64 * j];
        }
    }
    if ((TSK) >= 0 && blockIdx.x == 0 && threadIdx.x == 0) {
        const unsigned long long tend = __builtin_amdgcn_s_memrealtime(); const unsigned long long* ts = (const unsigned long long*)(a.ws + 240 * 1024);
        const unsigned long long t1 = ((TSK) + 1 > 11) ? tend : ts[(TSK) + 1 > 11 ? 0 : (TSK) + 1];
        asm volatile("s_waitcnt vmcnt(0)" ::: "memory");
        a.out[0] = ((TSK) >= 20) ? (float)((const unsigned long long*)(a.ws + 244 * 1024))[(TSK) >= 20 ? (TSK) - 20 : 0] * ((TSK) == 25 ? 1.0f : 0.01f) : (float)(t1 - ts[(TSK) > 11 ? 11 : (TSK)]) * 0.01f;
    }
}

extern "C" void kernel_launch(void* const* d_in, const int* in_sizes, int n_in, void* d_out, int out_size, void* d_ws, size_t ws_size, hipStream_t stream) {
    static int grid = 0;
    if (grid == 0) {
        int dev = 0, cus = 0, per_cu = 0;
        (void)hipGetDevice(&dev); (void)hipDeviceGetAttribute(&cus, hipDeviceAttributeMultiprocessorCount, dev);
        (void)hipFuncSetAttribute((const void*)fwd_mega, hipFuncAttributeMaxDynamicSharedMemorySize, LDS_BYTES);
        (void)hipOccupancyMaxActiveBlocksPerMultiprocessor(&per_cu, (const void*)fwd_mega, NT, LDS_BYTES);
        if (per_cu < 1) { fprintf(stderr, "kernel_launch: occupancy query says %d blocks per CU\n", per_cu); per_cu = 1; }
        grid = cus;
        if (n_in != 28 || ws_size < 252 * MiB) fprintf(stderr, "kernel_launch: unexpected n_in %d / ws_size %zu\n", n_in, ws_size);
    }
    Args a{};
    for (int i = 0; i < 28; ++i) a.in[i] = (const float*)d_in[i];
    a.out = (float*)d_out; a.ws = (unsigned char*)d_ws;
    void* kargs[] = {&a};
    hipError_t e = hipLaunchCooperativeKernel((const void*)fwd_mega, dim3(grid), dim3(NT), kargs, LDS_BYTES, stream);
    if (e != hipSuccess) fprintf(stderr, "cooperative launch failed: %s (grid %d)\n", hipGetErrorString(e), grid);
}
```

```cpp
#include <hip/hip_runtime.h>
#include <hip/hip_cooperative_groups.h>
#include <cstdio>
#include <cstdint>
namespace cg = cooperative_groups;
#ifndef PROBE_REP
#define PROBE_REP -1
#endif
#ifndef EXPV
#define EXPV 0
#endif
#ifndef TSK
#define TSK -1
#endif
#define STAMP(i) do { if ((TSK) >= 0 && blockIdx.x == 0 && threadIdx.x == 0) ((unsigned long long*)(a.ws + 240 * 1024))[i] = __builtin_amdgcn_s_memrealtime(); } while (0)
#define ASTAMP(k) do { if ((TSK) >= 20 && blockIdx.x == 0 && threadIdx.x == 0) { const unsigned long long t_ = __builtin_amdgcn_s_memrealtime(); T.tsa[k] += t_ - T.tsa[15]; T.tsa[15] = t_; } } while (0)
#define REPS(k) _Pragma("nounroll") for (int rep_ = 0; rep_ < ((PROBE_REP) == (k) ? 2 : 1); ++rep_)
#define GSYNC() do { xcd_barrier(xbar); if ((PROBE_REP) == 100) xcd_barrier(xbar); } while (0)

#define LAS __attribute__((address_space(3)))
typedef unsigned short bf16_t;
typedef short bf16x8 __attribute__((ext_vector_type(8)));
typedef float f32x4 __attribute__((ext_vector_type(4)));
typedef float f32x2 __attribute__((ext_vector_type(2)));
typedef unsigned u32x4 __attribute__((ext_vector_type(4)));
typedef unsigned u32x2 __attribute__((ext_vector_type(2)));

constexpr int SEQ = 16384, DM = 1024, DIN = 3864, PP = 4096  , DFF = 2816, NUP = 5632;
constexpr int C_Q = 0, C_KC = 512, C_VC = 640, C_KSL = 768, C_VSL = 896, C_KWN = 1024, C_VWN = 1152, C_U = 1280, C_GA = 1792, C_GB = 2816, C_NG = 3840;
constexpr int VTP = SEQ + 64;
constexpr float EPS = 1e-6f;
constexpr float NEGF = -1e30f;

constexpr size_t MiB = 1u << 20;
constexpr size_t WS_RSTD1 = 0, WS_RSS2 = 64 * 1024, WS_RSS3 = 128 * 1024, WS_ROPEC = 256 * 1024, WS_ROPES = 768 * 1024;
constexpr size_t WS_ABAR = 1280 * 1024, WS_A128 = WS_ABAR + 16384, WS_BIASPE = WS_A128 + 16384, WS_BBAR = 1536 * 1024  ;
constexpr size_t WS_SBUF = 2 * MiB  , WS_HID = 4 * MiB  , WS_KCMP = 6 * MiB  , WS_VCMPT = 6 * MiB + 512 * 1024  ;
constexpr size_t WS_WUP = 8 * MiB, WS_WDOWN = 20 * MiB, WS_WIN = 26 * MiB, WS_WGLU = 34 * MiB, WS_WPA = 35 * MiB, WS_WPB = 36 * MiB, WS_WOUT = 37 * MiB, WS_W1K = 39 * MiB, WS_W1V = 40 * MiB;
constexpr size_t WS_XB = 41 * MiB, WS_MERGED = 41 * MiB, WS_PROJ = 73 * MiB, WS_VSLT = 202 * MiB + 512 * 1024, WS_VWNT = 207 * MiB;
constexpr size_t WS_X1B = 220 * MiB, WS_UPRAW = 26 * MiB, WS_ACT = 122 * MiB;
constexpr size_t WS_BAR = 192 * 1024, WS_KSL = 212 * MiB, WS_KWN = 216 * MiB;
constexpr size_t OUT_YA = 0, OUT_YBP = 16 * MiB, OUT_YB = 32 * MiB;
static_assert(WS_PROJ + (size_t)(SEQ + 32) * PP * 2 <= WS_VSLT, "proj");
static_assert(WS_VSLT + (size_t)128 * VTP * 2 + 4096 <= WS_VWNT && WS_VWNT + (size_t)128 * VTP * 2 + 4096 <= WS_X1B, "vt");
static_assert(WS_UPRAW + (size_t)33 * 256 * NUP * 2 <= WS_ACT && WS_ACT + (size_t)SEQ * DFF * 2 <= WS_X1B, "ffn");

__device__ __forceinline__ unsigned cvt_pk_bf16(float lo, float hi) { unsigned r; asm volatile("v_cvt_pk_bf16_f32 %0, %1, %2" : "=v"(r) : "v"(lo), "v"(hi)); return r; }
__device__ __forceinline__ float bf_lo(unsigned w) { return __uint_as_float(w << 16); }
__device__ __forceinline__ float bf_hi(unsigned w) { return __uint_as_float(w & 0xffff0000u); }
__device__ __forceinline__ float bf2f(bf16_t b) { return __uint_as_float((unsigned)b << 16); }
__device__ __forceinline__ float sigmoidf_(float v) { return 1.f / (1.f + __expf(-v)); }
__device__ __forceinline__ float gelu_tanh(float v) { const float z = 0.7978845608028654f * (v + 0.044715f * v * v * v); const float th = 1.f - 2.f / (__expf(2.f * z) + 1.f); return 0.5f * v * (1.f + th); }
__device__ __forceinline__ u32x4 pack8(f32x4 a, f32x4 b) { u32x4 w; w.x = cvt_pk_bf16(a[0], a[1]); w.y = cvt_pk_bf16(a[2], a[3]); w.z = cvt_pk_bf16(b[0], b[1]); w.w = cvt_pk_bf16(b[2], b[3]); return w; }

namespace pg8 {
#define PG8_LAS __attribute__((address_space(3)))
constexpr int BM = 256, BK = 64, HALF = 128, HTB = HALF * BK * 2, STAGE_BYTES = 8 * HTB, NXCD = 8, WGM = 8;
__host__ __device__ __forceinline__ int lds_byte(int r, int c) { const int st = (r >> 4) * 2 + (c >> 5), rr = r & 15, cc = c & 31, ob = rr * 64 + cc * 2; return st * 1024 + (ob ^ (((ob >> 9) & 1) << 5)); }
__host__ __device__ __forceinline__ void stage_rc(int b, int& R, int& C) { const int st = b / 1024, sb = b % 1024, swz = sb ^ (((sb >> 9) & 1) << 5); R = (st >> 1) * 16 + swz / 64; C = (st & 1) * 32 + (swz % 64) / 2; }
__host__ __device__ __forceinline__ int perm32(int rho) { const int n = rho >> 4, i = rho & 15; return 8 * (i >> 2) + 4 * n + (i & 3); }
struct Unit { int pm, pn, z; const char* A; const char* B; };
struct Gemm { int K; unsigned lda_b; unsigned kstepA; };
__device__ __forceinline__ bool tile_of(long L, int nM, int nN, int& pm, int& pn) {
    const int nwg = nM * nN; if (L >= nwg) return false;
    int wgid = (int)L; { const int q = nwg / NXCD, r = nwg % NXCD, xcd = wgid % NXCD, off = wgid / NXCD; wgid = (xcd < r ? xcd * (q + 1) : r * (q + 1) + (xcd - r) * q) + off; }
    const int nig = WGM * nN, gid = wgid / nig, fm = gid * WGM, gsz = (nM - fm) < WGM ? (nM - fm) : WGM;
    pm = fm + ((wgid % nig) % gsz); pn = (wgid % nig) / gsz; return true;
}
template <class Epi, class Sched, bool ALIGN_EPI = false, bool SP2 = false>
__device__ __forceinline__ void gemm_phase(PG8_LAS unsigned char* lds, const Gemm g, const Sched& S, const Epi& E) {
    int tid_ = threadIdx.x; asm volatile("" : "+v"(tid_));
    const int tid = tid_, wid = __builtin_amdgcn_readfirstlane(tid >> 6), lane = tid & 63, wr = wid >> 2, wc = wid & 3, fr = lane & 15, fq = lane >> 4;
    const int K = g.K, nt = K / BK;
    unsigned voffA[2], voffB[2];
#pragma unroll
    for (int i = 0; i < 2; ++i) { int R, C; stage_rc(tid * 16 + i * 8192, R, C); const int Rb = Epi::PERM ? ((R & ~31) + perm32(R & 31)) : R;
        voffA[i] = (unsigned)R * g.lda_b + (unsigned)C * 2u; voffB[i] = (unsigned)(Rb * K + C) * 2u; }
    const size_t kstepA = (size_t)g.kstepA, kstepB = (size_t)(BK * 2);
    const size_t hstepA = (size_t)HALF * g.lda_b, hstepB = (size_t)HALF * K * 2;
    const unsigned ldsw = (unsigned)wid * 1024u;
    const int aoff = lds_byte(wr * 64 + fr, fq * 8), boff = lds_byte(wc * 32 + fr, fq * 8);
#define PG8_SA(b, h) (((b) * 2 + (h)) * HTB)
#define PG8_SB(b, h) ((4 + (b) * 2 + (h)) * HTB)
#define PG8_STAGE(bufoff, gbase, voff) do { _Pragma("unroll") for (int _i = 0; _i < 2; ++_i) \
        __builtin_amdgcn_global_load_lds((const unsigned*)((const char*)(gbase) + (voff)[_i]), (PG8_LAS unsigned*)(lds + (bufoff) + ldsw + _i * 8192), 16, 0, 0); } while (0)
#define PG8_LDA(dst, b, h) do { _Pragma("unroll") for (int m = 0; m < 4; ++m) _Pragma("unroll") for (int k = 0; k < 2; ++k) dst[m][k] = *(const PG8_LAS bf16x8*)(lds + PG8_SA(b, h) + aoff + m * 2048 + k * 1024); } while (0)
#define PG8_LDB(dst, b, h) do { _Pragma("unroll") for (int n = 0; n < 2; ++n) _Pragma("unroll") for (int k = 0; k < 2; ++k) dst[n][k] = *(const PG8_LAS bf16x8*)(lds + PG8_SB(b, h) + boff + n * 2048 + k * 1024); } while (0)
#define PG8_MMA(ai, bj, At, Bt) do { __builtin_amdgcn_s_setprio(1); _Pragma("unroll") for (int m = 0; m < 4; ++m) _Pragma("unroll") for (int n = 0; n < 2; ++n) _Pragma("unroll") for (int k = 0; k < 2; ++k) \
        acc[ai][bj][m][n] = __builtin_amdgcn_mfma_f32_16x16x32_bf16(Bt[n][k], At[m][k], acc[ai][bj][m][n], 0, 0, 0); __builtin_amdgcn_s_setprio(0); } while (0)
#define PG8_WAIT_V(n) asm volatile("s_waitcnt vmcnt(" #n ")" ::: "memory")
#define PG8_WAIT_L(n) asm volatile("s_waitcnt lgkmcnt(" #n ")" ::: "memory")
#define PG8_BAR __builtin_amdgcn_s_barrier()
#define PG8_SCHED __builtin_amdgcn_sched_barrier(0)
    Unit cur, nxt; int ui = 0;
    if (!S.next(0, cur)) return;
    f32x4 acc[2][2][4][2];
#pragma unroll
    for (int a = 0; a < 2; ++a)
#pragma unroll
        for (int b = 0; b < 2; ++b)
#pragma unroll
            for (int m = 0; m < 4; ++m)
#pragma unroll
                for (int n = 0; n < 2; ++n) acc[a][b][m][n] = (f32x4){0.f, 0.f, 0.f, 0.f};
    bf16x8 At[4][2], B0[2][2], B1[2][2];
    const char* cA = cur.A; const char* cB = cur.B;
    if constexpr (SP2) {
        PG8_STAGE(PG8_SB(0, 0), cB, voffB); PG8_STAGE(PG8_SB(0, 1), cB + hstepB, voffB); PG8_STAGE(PG8_SA(0, 0), cA, voffA); PG8_STAGE(PG8_SA(0, 1), cA + hstepA, voffA);
        if (wr == 1) PG8_BAR;
        PG8_WAIT_V(2); PG8_BAR;
        PG8_STAGE(PG8_SB(1, 0), cB + kstepB, voffB); PG8_STAGE(PG8_SA(1, 0), cA + kstepA, voffA); PG8_STAGE(PG8_SB(1, 1), cB + hstepB + kstepB, voffB);
        PG8_WAIT_V(6); PG8_BAR;
    } else {
        PG8_STAGE(PG8_SB(0, 0), cB, voffB); PG8_STAGE(PG8_SA(0, 0), cA, voffA); PG8_STAGE(PG8_SB(0, 1), cB + hstepB, voffB); PG8_STAGE(PG8_SA(0, 1), cA + hstepA, voffA);
        if (wr == 1) PG8_BAR;
        PG8_WAIT_V(4); PG8_BAR;
        PG8_STAGE(PG8_SB(1, 0), cB + kstepB, voffB); PG8_STAGE(PG8_SA(1, 0), cA + kstepA, voffA); PG8_STAGE(PG8_SB(1, 1), cB + hstepB + kstepB, voffB);
        PG8_WAIT_V(6); PG8_BAR;
    }
    for (;;) {
        const bool has_next = S.next(ui + 1, nxt);
        const char* nA = has_next ? nxt.A : cA; const char* nB = has_next ? nxt.B : cB;
        for (int t = 0; t < nt; t += 2) {
            const bool last = (t == nt - 2);
            const char* a1 = cA + (size_t)(t + 1) * kstepA;
            const char* a2 = last ? nA : cA + (size_t)(t + 2) * kstepA; const char* b2 = last ? nB : cB + (size_t)(t + 2) * kstepB;
            const char* a3 = a2 + kstepA; const char* b3 = b2 + kstepB;
            if constexpr (SP2) {
            PG8_LDB(B0, 0, 0); PG8_LDB(B1, 0, 1); PG8_SCHED; PG8_LDA(At, 0, 0); PG8_STAGE(PG8_SA(1, 1), a1 + hstepA, voffA);
            PG8_WAIT_V(8); PG8_WAIT_L(0); PG8_BAR; PG8_MMA(0, 0, At, B0); PG8_MMA(0, 1, At, B1); PG8_BAR; PG8_SCHED;
            PG8_LDA(At, 0, 1); PG8_STAGE(PG8_SB(0, 0), b2, voffB); PG8_STAGE(PG8_SB(0, 1), b2 + hstepB, voffB); PG8_STAGE(PG8_SA(0, 0), a2, voffA);
            PG8_WAIT_V(8); PG8_WAIT_L(0); PG8_BAR; PG8_MMA(1, 0, At, B0); PG8_MMA(1, 1, At, B1); PG8_BAR; PG8_SCHED;
            PG8_LDB(B0, 1, 0); PG8_LDB(B1, 1, 1); PG8_SCHED; PG8_LDA(At, 1, 0); PG8_STAGE(PG8_SA(0, 1), a2 + hstepA, voffA);
            PG8_WAIT_V(8); PG8_WAIT_L(0); PG8_BAR; PG8_MMA(0, 0, At, B0); PG8_MMA(0, 1, At, B1); PG8_BAR; PG8_SCHED;
            PG8_LDA(At, 1, 1); PG8_STAGE(PG8_SB(1, 0), b3, voffB); PG8_STAGE(PG8_SB(1, 1), b3 + hstepB, voffB); PG8_STAGE(PG8_SA(1, 0), a3, voffA);
            PG8_WAIT_V(8); PG8_WAIT_L(0); PG8_BAR; PG8_MMA(1, 0, At, B0); PG8_MMA(1, 1, At, B1); PG8_BAR; PG8_SCHED;
            } else {
            PG8_LDB(B0, 0, 0); PG8_SCHED; PG8_LDA(At, 0, 0); PG8_STAGE(PG8_SA(1, 1), a1 + hstepA, voffA);
            PG8_WAIT_L(8); PG8_BAR; PG8_WAIT_L(0); PG8_MMA(0, 0, At, B0); PG8_BAR; PG8_SCHED;
            PG8_LDB(B1, 0, 1); PG8_STAGE(PG8_SB(0, 0), b2, voffB);
            PG8_BAR; PG8_WAIT_L(0); PG8_MMA(0, 1, At, B1); PG8_BAR;
            PG8_LDA(At, 0, 1); PG8_STAGE(PG8_SA(0, 0), a2, voffA);
            PG8_BAR; PG8_WAIT_L(0); PG8_MMA(1, 0, At, B0); PG8_BAR; PG8_SCHED;
            PG8_STAGE(PG8_SB(0, 1), b2 + hstepB, voffB);
            PG8_WAIT_V(6); PG8_BAR; PG8_MMA(1, 1, At, B1); PG8_BAR;
            PG8_LDB(B0, 1, 0); PG8_SCHED; PG8_LDA(At, 1, 0); PG8_STAGE(PG8_SA(0, 1), a2 + hstepA, voffA);
            PG8_WAIT_L(8); PG8_BAR; PG8_WAIT_L(0); PG8_MMA(0, 0, At, B0); PG8_BAR; PG8_SCHED;
            PG8_LDB(B1, 1, 1); PG8_STAGE(PG8_SB(1, 0), b3, voffB);
            PG8_BAR; PG8_WAIT_L(0); PG8_MMA(0, 1, At, B1); PG8_BAR;
            PG8_LDA(At, 1, 1); PG8_STAGE(PG8_SA(1, 0), a3, voffA);
            PG8_BAR; PG8_WAIT_L(0); PG8_MMA(1, 0, At, B0); PG8_BAR; PG8_SCHED;
            PG8_STAGE(PG8_SB(1, 1), b3 + hstepB, voffB);
            PG8_WAIT_V(6); PG8_BAR; PG8_MMA(1, 1, At, B1); PG8_BAR;
            }
        }
        if constexpr (ALIGN_EPI) { if (wr == 0) PG8_BAR; }
        E(acc, cur, wr, wc, fr, fq);
        if (!has_next) break;
#pragma unroll
        for (int a = 0; a < 2; ++a)
#pragma unroll
            for (int b = 0; b < 2; ++b)
#pragma unroll
                for (int m = 0; m < 4; ++m)
#pragma unroll
                    for (int n = 0; n < 2; ++n) acc[a][b][m][n] = (f32x4){0.f, 0.f, 0.f, 0.f};
        cur = nxt; cA = nA; cB = nB; ++ui;
        if constexpr (ALIGN_EPI) { if (wr == 1) PG8_BAR; }
    }
    PG8_WAIT_V(0);
    if constexpr (!ALIGN_EPI) { if (wr == 0) PG8_BAR; }
    PG8_BAR;
#undef PG8_SA
#undef PG8_SB
#undef PG8_STAGE
#undef PG8_LDA
#undef PG8_LDB
#undef PG8_MMA
#undef PG8_WAIT_V
#undef PG8_WAIT_L
#undef PG8_BAR
#undef PG8_SCHED
}
}


struct SchedMN {
    int nM, nN, nz, G, c, pm_off; const char* A0; const char* A1; const char* B0; const char* B1; size_t a_tile, b_tile;
    __device__ __forceinline__ bool next(int i, pg8::Unit& u) const {
        int pm, pn; if (!pg8::tile_of((long)(i / nz) * G + c, nM, nN, pm, pn)) return false;
        u.z = i % nz; u.pm = pm + pm_off; u.pn = pn; u.A = (u.z ? A1 : A0) + (size_t)u.pm * a_tile; u.B = (u.z ? B1 : B0) + (size_t)pn * b_tile; return true;
    }
};
struct SchedCmp {
    int c; const char* proj; const char* w1k; const char* w1v;
    __device__ __forceinline__ bool next(int i, pg8::Unit& u) const {
        if (i > ((PROBE_REP) == 22 ? 1 : 0) || c >= 16) return false;
        u.z = c >> 2; u.pm = c & 3; u.pn = 0; const int which = u.z >> 1, kh = u.z & 1;
        u.A = proj + ((size_t)(16 * 256 * u.pm) * PP + (which ? C_VC : C_KC) + kh * 64) * 2; u.B = which ? w1v : w1k; return true;
    }
};

#define EPI_LOOP_ROWS for (int ai = 0; ai < 2; ++ai) _Pragma("unroll") for (int m = 0; m < 4; ++m)

struct EpiProj {
    static constexpr bool PERM = true;
    bf16_t* proj; bf16_t* vslt; bf16_t* vwnt; bf16_t* kslc; bf16_t* kwnc; const float* rstd; const float* ropec; const float* ropes;
    __device__ __forceinline__ void operator()(const f32x4 (&acc)[2][2][4][2], const pg8::Unit& u, int wr, int wc, int fr, int fq) const {
        const int pn = u.pn; const int row0 = u.pm * 256 + wr * 64 + fr;
        const bool sig = pn >= 7;
#pragma unroll
        EPI_LOOP_ROWS {
            const int row = row0 + ai * 128 + m * 16; const float rs = rstd[row];
            f32x4 c0 = {1.f, 1.f, 1.f, 1.f}, c1 = c0, s0 = {0.f, 0.f, 0.f, 0.f}, s1 = s0;
            if ((pn <= 1 || pn == 3 || pn == 4) && (wc & 1) == 0) { c0 = *(const f32x4*)(ropec + row * 8); c1 = *(const f32x4*)(ropec + row * 8 + 4); s0 = *(const f32x4*)(ropes + row * 8); s1 = *(const f32x4*)(ropes + row * 8 + 4); }
#pragma unroll
            for (int bj = 0; bj < 2; ++bj) {
                f32x4 v0 = acc[ai][bj][m][0] * rs, v1 = acc[ai][bj][m][1] * rs;
                const int colt = bj * 128 + wc * 32 + 8 * fq;
                const bool ropet = (pn <= 1) || ((pn == 3 || pn == 4) && bj == 0);
                if (ropet && (wc & 1) == 0) {
                    f32x4 p0, p1;
#pragma unroll
                    for (int e = 0; e < 4; ++e) { p0[e] = __shfl_xor(v0[e], 16); p1[e] = __shfl_xor(v1[e], 16); }
                    if (fq == 0) { v0 = v0 * c0 - p0 * s0; v1 = v1 * c1 - p1 * s1; }
                    else if (fq == 1) { v0 = v0 * c0 + p0 * s0; v1 = v1 * c1 + p1 * s1; }
                }
                if (pn <= 1) { v0 = v0 * (0.125f * 1.4426950408889634f); v1 = v1 * (0.125f * 1.4426950408889634f); }
                if (sig) {
#pragma unroll
                    for (int e = 0; e < 4; ++e) { v0[e] = sigmoidf_(v0[e]); v1[e] = sigmoidf_(v1[e]); }
                }
                const u32x4 w = pack8(v0, v1);
                if (!((pn == 3 || pn == 4))) *(u32x4*)(proj + (size_t)row * PP + pn * 256 + colt) = w;
                if ((pn == 3 || pn == 4) && bj == 0) { bf16_t* kc = (pn == 3) ? kslc : kwnc; *(u32x4*)(kc + ((size_t)(colt >> 6) * SEQ + row) * 64 + (colt & 63)) = w; }
                if ((pn == 3 || pn == 4) && bj == 1) {
                    bf16_t* vt = ((pn == 3) ? vslt : vwnt) + ((size_t)((colt - 128) >> 6) * 256 + (row >> 6)) * 4096 + (size_t)((colt - 128) & 63) * 64 + (row & 63);
                    vt[0 * 64] = (bf16_t)(w.x & 0xffff); vt[1 * 64] = (bf16_t)(w.x >> 16); vt[2 * 64] = (bf16_t)(w.y & 0xffff); vt[3 * 64] = (bf16_t)(w.y >> 16);
                    vt[4 * 64] = (bf16_t)(w.z & 0xffff); vt[5 * 64] = (bf16_t)(w.z >> 16); vt[6 * 64] = (bf16_t)(w.w & 0xffff); vt[7 * 64] = (bf16_t)(w.w >> 16);
                }
            }
        }
    }
};

struct EpiCmp {
    static constexpr bool PERM = true;
    bf16_t* hid; const float* biaspe;
    __device__ __forceinline__ void operator()(const f32x4 (&acc)[2][2][4][2], const pg8::Unit& u, int wr, int wc, int fr, int fq) const {
        const int row0 = u.pm * 256 + wr * 64 + fr; const int which = u.z >> 1;
#pragma unroll
        for (int bj = 0; bj < 2; ++bj) {
            const int col = bj * 128 + wc * 32 + 8 * fq;
            const f32x4 b0 = *(const f32x4*)(biaspe + which * 256 + col), b1 = *(const f32x4*)(biaspe + which * 256 + col + 4);
#pragma unroll
            EPI_LOOP_ROWS {
                const int row = row0 + ai * 128 + m * 16;
                f32x4 v0 = acc[ai][bj][m][0] + b0, v1 = acc[ai][bj][m][1] + b1;
#pragma unroll
                for (int e = 0; e < 4; ++e) { v0[e] = gelu_tanh(v0[e]); v1[e] = gelu_tanh(v1[e]); }
                *(u32x4*)(hid + ((size_t)u.z * 1024 + row) * 256 + col) = pack8(v0, v1);
            }
        }
    }
};

struct EpiGlu {
    static constexpr bool PERM = true;
    const bf16_t* ybp; bf16_t* yb;
    __device__ __forceinline__ void operator()(const f32x4 (&acc)[2][2][4][2], const pg8::Unit& u, int wr, int wc, int fr, int fq) const {
        const int row0 = u.pm * 256 + wr * 64 + fr;
#pragma unroll
        EPI_LOOP_ROWS {
            const int row = row0 + ai * 128 + m * 16;
#pragma unroll
            for (int bj = 0; bj < 2; ++bj) {
                const size_t off = (size_t)row * 512 + u.pn * 256 + bj * 128 + wc * 32 + 8 * fq;
                const u32x4 y = *(const u32x4*)(ybp + off);
                f32x4 v0 = acc[ai][bj][m][0], v1 = acc[ai][bj][m][1];
                v0[0] = bf_lo(y.x) * sigmoidf_(v0[0]); v0[1] = bf_hi(y.x) * sigmoidf_(v0[1]); v0[2] = bf_lo(y.y) * sigmoidf_(v0[2]); v0[3] = bf_hi(y.y) * sigmoidf_(v0[3]);
                v1[0] = bf_lo(y.z) * sigmoidf_(v1[0]); v1[1] = bf_hi(y.z) * sigmoidf_(v1[1]); v1[2] = bf_lo(y.w) * sigmoidf_(v1[2]); v1[3] = bf_hi(y.w) * sigmoidf_(v1[3]);
                *(u32x4*)(yb + off) = pack8(v0, v1);
            }
        }
    }
};

struct EpiMerge {
    static constexpr bool PERM = true;
    const bf16_t* proj; bf16_t* merged;
    __device__ __forceinline__ void operator()(const f32x4 (&acc)[2][2][4][2], const pg8::Unit& u, int wr, int wc, int fr, int fq) const {
        const int row0 = u.pm * 256 + wr * 64 + fr; const int gcol = u.z ? C_GB : C_GA;
#pragma unroll
        EPI_LOOP_ROWS {
            const int row = row0 + ai * 128 + m * 16;
#pragma unroll
            for (int bj = 0; bj < 2; ++bj) {
                const int col = u.pn * 256 + bj * 128 + wc * 32 + 8 * fq;
                const u32x4 gt = *(const u32x4*)(proj + (size_t)row * PP + gcol + col);
                f32x4 v0 = acc[ai][bj][m][0], v1 = acc[ai][bj][m][1];
                v0[0] *= bf_lo(gt.x); v0[1] *= bf_hi(gt.x); v0[2] *= bf_lo(gt.y); v0[3] *= bf_hi(gt.y);
                v1[0] *= bf_lo(gt.z); v1[1] *= bf_hi(gt.z); v1[2] *= bf_lo(gt.w); v1[3] *= bf_hi(gt.w);
                bf16_t* dst = merged + (size_t)row * DM + col;
                if (u.z) { const u32x4 o = *(const u32x4*)dst;
                    v0[0] += bf_lo(o.x); v0[1] += bf_hi(o.x); v0[2] += bf_lo(o.y); v0[3] += bf_hi(o.y); v1[0] += bf_lo(o.z); v1[1] += bf_hi(o.z); v1[2] += bf_lo(o.w); v1[3] += bf_hi(o.w); }
                *(u32x4*)dst = pack8(v0, v1);
            }
        }
    }
};

struct EpiRes {
    static constexpr bool PERM = true;
    const float* xin; float* xo; bf16_t* xb; float* rss;
    __device__ __forceinline__ void operator()(const f32x4 (&acc)[2][2][4][2], const pg8::Unit& u, int wr, int wc, int fr, int fq) const {
        const int row0 = u.pm * 256 + wr * 64 + fr;
#pragma unroll
        EPI_LOOP_ROWS {
            const int row = row0 + ai * 128 + m * 16; float ss = 0.f;
#pragma unroll
            for (int bj = 0; bj < 2; ++bj) {
                const size_t off = (size_t)row * DM + u.pn * 256 + bj * 128 + wc * 32 + 8 * fq;
                const f32x4 v0 = *(const f32x4*)(xin + off) + acc[ai][bj][m][0], v1 = *(const f32x4*)(xin + off + 4) + acc[ai][bj][m][1];
                *(f32x4*)(xo + off) = v0; *(f32x4*)(xo + off + 4) = v1;
                if (xb) *(u32x4*)(xb + off) = pack8(v0, v1);
                ss += (v0[0] * v0[0] + v0[1] * v0[1]) + (v0[2] * v0[2] + v0[3] * v0[3]) + (v1[0] * v1[0] + v1[1] * v1[1]) + (v1[2] * v1[2] + v1[3] * v1[3]);
            }
            ss += __shfl_xor(ss, 16); ss += __shfl_xor(ss, 32);
            if (fq == 0) atomicAdd(rss + row, ss);
        }
    }
};

struct EpiUp {
    static constexpr bool PERM = true;
    bf16_t* up; const float* rss; int rowbase;
    __device__ __forceinline__ void operator()(const f32x4 (&acc)[2][2][4][2], const pg8::Unit& u, int wr, int wc, int fr, int fq) const {
        const int row0 = u.pm * 256 + wr * 64 + fr;
#pragma unroll
        EPI_LOOP_ROWS {
            const int row = row0 + ai * 128 + m * 16; const float rs = rsqrtf(rss[row] * (1.f / DM) + EPS);
#pragma unroll
            for (int bj = 0; bj < 2; ++bj) {
                const size_t off = (size_t)(row - rowbase) * NUP + u.pn * 256 + bj * 128 + wc * 32 + 8 * fq;
                *(u32x4*)(up + off) = pack8(acc[ai][bj][m][0] * rs, acc[ai][bj][m][1] * rs);
            }
        }
    }
};

struct Args { const float* in[28]; float* out; unsigned char* ws; };
constexpr int NT = 512, NWV = 8;
constexpr int LDS_BYTES = 147456;

__device__ __forceinline__ float wave_sum(float v) {
#pragma unroll
    for (int o = 1; o < 64; o <<= 1) v += __shfl_xor(v, o);
    return v;
}

#define XB_TMO      128
#define XB_XCNT(j)  (256  + 64 * (j))
#define XB_XSUB(j)  (1280 + 64 * (j))
#define XB_XGEN(j)  (2304 + 64 * (j))
#define XB_TOP      3328
#define XB_TOPGEN   3392
#define XCD_BAR_WORDS 3456
#define XB_SPIN_CAP (1u << 18)

__device__ __forceinline__ unsigned xb_ld(unsigned* p)              { return __hip_atomic_load(p, __ATOMIC_RELAXED, __HIP_MEMORY_SCOPE_AGENT); }
__device__ __forceinline__ unsigned xb_add(unsigned* p, unsigned v) { return __hip_atomic_fetch_add(p, v, __ATOMIC_RELAXED, __HIP_MEMORY_SCOPE_AGENT); }
__device__ __forceinline__ unsigned xb_xcc_id() { return (unsigned)__builtin_amdgcn_s_getreg((3 << 11) | 20) & 0xFu; }
#define XB_SPIN(cond, bar) do { unsigned _sp = 0; while (cond) { __builtin_amdgcn_s_sleep(1); \
    if ((++_sp & 255u) == 0u) { if (xb_ld(&(bar)[XB_TMO])) break; if (_sp > XB_SPIN_CAP) { atomicAdd(&(bar)[XB_TMO], 1u); break; } } } } while (0)

struct XcdBarrier {
    unsigned* bar; unsigned x;
    volatile LAS unsigned* st;
};

__device__ __forceinline__ XcdBarrier xcd_barrier_post(unsigned* bar, volatile LAS unsigned* st) {
    XcdBarrier b; b.bar = bar; b.x = xb_xcc_id(); b.st = st;
    if (threadIdx.x == 0) (void)xb_add(&bar[XB_XCNT(b.x)], 1u);
    return b;
}
__device__ __forceinline__ void xcd_barrier_complete(unsigned* bar, unsigned x, unsigned& nloc, unsigned& nx) {
    const unsigned G = gridDim.x * gridDim.y * gridDim.z;
    unsigned sum, cnt, mine, sp = 0u;
    for (;;) {
        sum = 0u; cnt = 0u; mine = 0u;
#pragma unroll
        for (unsigned j = 0; j < 16; ++j) { const unsigned c = xb_ld(&bar[XB_XCNT(j)]); sum += c; cnt += (c > 0u) ? 1u : 0u; mine = (j == x) ? c : mine; }
        if (sum == G) break;
        __builtin_amdgcn_s_sleep(1);
        if ((++sp & 255u) == 0u) { if (xb_ld(&bar[XB_TMO])) break; if (sp > XB_SPIN_CAP) { atomicAdd(&bar[XB_TMO], 1u); break; } }
    }
    nloc = mine > 0u ? mine : 1u; nx = cnt > 0u ? cnt : 1u;
}

__device__ __forceinline__ void xcd_barrier(const XcdBarrier& b) {
    asm volatile("s_waitcnt vmcnt(0)" ::: "memory");
    __syncthreads();
    if (threadIdx.x == 0) {
        unsigned* bar = b.bar;
        __builtin_amdgcn_s_waitcnt(0);
        unsigned nloc = b.st[0], nx = b.st[1];
        if (nloc == 0u) { xcd_barrier_complete(bar, b.x, nloc, nx); b.st[0] = nloc; b.st[1] = nx; }
        const unsigned old = xb_add(&bar[XB_XSUB(b.x)], 1u);
        const unsigned gen = old / nloc;
        if (old + 1u == (gen + 1u) * nloc) {
            __builtin_amdgcn_fence(__ATOMIC_RELEASE, "agent");
            asm volatile("s_waitcnt vmcnt(0)" ::: "memory");
            const unsigned og = xb_add(&bar[XB_TOP], 1u);
            const unsigned tg = og / nx;
            if (og + 1u == (tg + 1u) * nx) xb_add(&bar[XB_TOPGEN], 1u);
            else XB_SPIN(xb_ld(&bar[XB_TOPGEN]) == tg, bar);
            __builtin_amdgcn_fence(__ATOMIC_ACQUIRE, "agent");
            xb_add(&bar[XB_XGEN(b.x)], 1u);
            asm volatile("s_waitcnt vmcnt(0)" ::: "memory");
        } else {
            XB_SPIN(xb_ld(&bar[XB_XGEN(b.x)]) == gen, bar);
            __builtin_amdgcn_fence(__ATOMIC_ACQUIRE, "agent");
            asm volatile("s_waitcnt vmcnt(0)" ::: "memory");
        }
    }
    __syncthreads();
}

__device__ __forceinline__ int colmap(int kind, int c) {
    if (kind == 1) return c < 1280 ? c : (c < 1304 ? C_NG + (c - 1280) : c - 24);
    if (kind == 2) { return c < DFF ? (c >> 7) * 256 + (c & 127) : ((c - DFF) >> 7) * 256 + 128 + ((c - DFF) & 127); }
    return c;
}
__device__ __forceinline__ void transpose_item(const float* W, int K, int N, bf16_t* WT, LAS float* scr, int kb, int nb, int lane, const float* kscale, int kind) {
    const int k0 = 64 * kb, n0 = 32 * nb;
#pragma unroll 8
    for (int i = 0; i < 32; ++i) { const int kk = 2 * i + (lane >> 5), n = n0 + (lane & 31); float v = (n < N) ? W[(size_t)(k0 + kk) * N + n] : 0.f; if (kscale) v *= kscale[k0 + kk]; scr[kk * 33 + (lane & 31)] = v; }
    asm volatile("s_waitcnt lgkmcnt(0)" ::: "memory");
    const int c = lane & 7;
#pragma unroll
    for (int j = 0; j < 4; ++j) { const int n = (lane >> 3) + 8 * j; const LAS float* s = scr + (8 * c) * 33 + n;
        if (n0 + n < N) { u32x4 o; o.x = cvt_pk_bf16(s[0 * 33], s[1 * 33]); o.y = cvt_pk_bf16(s[2 * 33], s[3 * 33]); o.z = cvt_pk_bf16(s[4 * 33], s[5 * 33]); o.w = cvt_pk_bf16(s[6 * 33], s[7 * 33]);
            *(u32x4*)(WT + (size_t)colmap(kind, n0 + n) * K + k0 + 8 * c) = o; } }
    asm volatile("s_waitcnt lgkmcnt(0)" ::: "memory");
}

#define EXP2(x) __builtin_amdgcn_exp2f(x)
#define MFMA16(a, b, c) __builtin_amdgcn_mfma_f32_16x16x32_bf16((a), (b), (c), 0, 0, 0)
__device__ __forceinline__ float dpp_x1(float v) { return __int_as_float(__builtin_amdgcn_update_dpp(0, __float_as_int(v), 0xB1, 0xF, 0xF, true)); }
__device__ __forceinline__ float dpp_x2(float v) { return __int_as_float(__builtin_amdgcn_update_dpp(0, __float_as_int(v), 0x4E, 0xF, 0xF, true)); }
struct KOp { bf16x8 a00, a01, a10, a11; };
struct VOp { bf16x8 v0, v1, v2, v3; };
__device__ __forceinline__ KOp ldk(const bf16_t* Kb, size_t pitch, int kb, int lane) {
    const int i = lane & 15, q = lane >> 4;
    const bf16_t* r0 = Kb + (size_t)(kb + 8 * (i >> 2) + (i & 3)) * pitch + 8 * q; const bf16_t* r1 = r0 + 4 * pitch;
    KOp k; k.a00 = *(const bf16x8*)r0; k.a01 = *(const bf16x8*)(r0 + 32); k.a10 = *(const bf16x8*)r1; k.a11 = *(const bf16x8*)(r1 + 32); return k;
}
__device__ __forceinline__ VOp ldv(const bf16_t* Vt, size_t vpitch, int kb, int lane) {
    const int i = lane & 15, q = lane >> 4; const size_t base = (vpitch == 64) ? (size_t)(kb >> 6) * 4096 + (kb & 63) : (size_t)kb;
    const bf16_t* r = Vt + base + (size_t)i * vpitch + 8 * q;
    VOp v; v.v0 = *(const bf16x8*)r; v.v1 = *(const bf16x8*)(r + 16 * vpitch); v.v2 = *(const bf16x8*)(r + 32 * vpitch); v.v3 = *(const bf16x8*)(r + 48 * vpitch); return v;
}
__device__ __forceinline__ void qk32(const KOp& k, const bf16x8& Bq0, const bf16x8& Bq1, f32x4& S0, f32x4& S1) {
    const f32x4 z = {0.f, 0.f, 0.f, 0.f};
    S0 = MFMA16(k.a00, Bq0, z); S0 = MFMA16(k.a01, Bq1, S0); S1 = MFMA16(k.a10, Bq0, z); S1 = MFMA16(k.a11, Bq1, S1);
}
__device__ __forceinline__ void pv32(const VOp& v, const bf16x8& P, f32x4 (&O)[4]) {
    O[0] = MFMA16(v.v0, P, O[0]); O[1] = MFMA16(v.v1, P, O[1]); O[2] = MFMA16(v.v2, P, O[2]); O[3] = MFMA16(v.v3, P, O[3]);
}
__device__ __forceinline__ bf16x8 packP(const f32x4& p0, const f32x4& p1) { u32x4 w = pack8(p0, p1); return __builtin_bit_cast(bf16x8, w); }

struct KbLin { int base; __device__ __forceinline__ int operator()(int i) const { return base + 32 * i; } };
struct KbLds { const LAS int* l; __device__ __forceinline__ int operator()(int i) const { return l[i]; } };

template <bool NEEDV, class KB, class Body>
__device__ __forceinline__ void pipe3(int n, const KB kbf, Body& body, const bf16_t* Kb, size_t kp, const bf16_t* Vt, size_t vp, int lane) {
    if (n <= 0) return;
    KOp k0, k1; VOp v;
    k0 = ldk(Kb, kp, kbf(0), lane);
    for (int i = 0; i < n; i += 2) {
        { const int kb = kbf(i); if (NEEDV) v = ldv(Vt, vp, kb, lane); k1 = ldk(Kb, kp, kbf(i + 1 < n ? i + 1 : n - 1), lane); body.run(kb, k0, v); }
        if (i + 1 >= n) break;
        { const int kb = kbf(i + 1); if (NEEDV) v = ldv(Vt, vp, kb, lane); k0 = ldk(Kb, kp, kbf(i + 2 < n ? i + 2 : n - 1), lane); body.run(kb, k1, v); }
    }
}

struct BodyCmp1 {
    bf16x8 Bq[2][2]; int nv[2], q; float ml[2], ll[2];
    __device__ __forceinline__ void run(int kb, const KOp& k, const VOp&) {
#pragma unroll
        for (int cg = 0; cg < 2; ++cg) {
            f32x4 S0, S1; qk32(k, Bq[cg][0], Bq[cg][1], S0, S1);
            const int k0 = kb + 8 * q; float mloc = NEGF;
#pragma unroll
            for (int e = 0; e < 4; ++e) { if (k0 + e >= nv[cg]) S0[e] = NEGF; if (k0 + 4 + e >= nv[cg]) S1[e] = NEGF; mloc = fmaxf(mloc, fmaxf(S0[e], S1[e])); }
            const float mn = fmaxf(ml[cg], mloc); float ps = 0.f;
#pragma unroll
            for (int e = 0; e < 4; ++e) { ps += (k0 + e < nv[cg]) ? EXP2(S0[e] - mn) : 0.f; ps += (k0 + 4 + e < nv[cg]) ? EXP2(S1[e] - mn) : 0.f; }
            ll[cg] = ll[cg] * EXP2(ml[cg] - mn) + ps; ml[cg] = mn;
        }
    }
};
struct BodyCmp2 {
    bf16x8 Bq[2][2]; int nv[2], q, g, lane_; float mc[2], inv[2], carry[2]; LAS float* ia[2]; f32x4 O[2][4];
    __device__ __forceinline__ void run(int kb, const KOp& k, const VOp& v) {
#pragma unroll
        for (int cg = 0; cg < 2; ++cg) {
            f32x4 S0, S1; qk32(k, Bq[cg][0], Bq[cg][1], S0, S1);
            const int k0 = kb + 8 * q; f32x4 p0, p1;
#pragma unroll
            for (int e = 0; e < 4; ++e) { p0[e] = (k0 + e < nv[cg]) ? EXP2(S0[e] - mc[cg]) * inv[cg] : 0.f; p1[e] = (k0 + 4 + e < nv[cg]) ? EXP2(S1[e] - mc[cg]) * inv[cg] : 0.f; }
            f32x4 s0 = p0, s1 = p1;
#pragma unroll
            for (int e = 0; e < 4; ++e) { s0[e] += dpp_x1(s0[e]); s0[e] += dpp_x2(s0[e]); s1[e] += dpp_x1(s1[e]); s1[e] += dpp_x2(s1[e]); }
            const float bout = 0.5f * s1[3]; const float recv = __shfl(bout, (lane_ + 48) & 63); const float bin = (q == 0) ? carry[cg] : recv; carry[cg] = recv;
            if (g == 0) { const int j = k0 >> 2; ia[cg][j] = ((s0[0] + s0[1]) + (s0[2] + 0.5f * s0[3])) + bin; ia[cg][j + 1] = 0.5f * s0[3] + ((s1[0] + s1[1]) + (s1[2] + 0.5f * s1[3])); }
            pv32(v, packP(p0, p1), O[cg]);
        }
    }
};
struct BodyWin {
    bf16x8 Bq[2][2]; int q, tt[2]; float m[2], l[2]; f32x4 O[2][4];
    __device__ __forceinline__ void run(int kb, const KOp& k, const VOp& v) {
#pragma unroll
        for (int cg = 0; cg < 2; ++cg) {
            f32x4 S0, S1; qk32(k, Bq[cg][0], Bq[cg][1], S0, S1);
            const int k0 = kb + 8 * q; unsigned vm = 0u;
#pragma unroll
            for (int e = 0; e < 8; ++e) { const bool ok = (k0 + e <= tt[cg]) && (tt[cg] - (k0 + e) < 512); vm |= ok ? (1u << e) : 0u; }
            float mloc = NEGF;
#pragma unroll
            for (int e = 0; e < 4; ++e) { if (!((vm >> e) & 1u)) S0[e] = NEGF; if (!((vm >> (4 + e)) & 1u)) S1[e] = NEGF; mloc = fmaxf(mloc, fmaxf(S0[e], S1[e])); }
            mloc = fmaxf(mloc, __shfl_xor(mloc, 16)); mloc = fmaxf(mloc, __shfl_xor(mloc, 32));
            const float mn = fmaxf(m[cg], mloc), alpha = EXP2(m[cg] - mn); m[cg] = mn;
            f32x4 p0, p1; float ps = 0.f;
#pragma unroll
            for (int e = 0; e < 4; ++e) { p0[e] = ((vm >> e) & 1u) ? EXP2(S0[e] - mn) : 0.f; p1[e] = ((vm >> (4 + e)) & 1u) ? EXP2(S1[e] - mn) : 0.f; ps += p0[e] + p1[e]; }
            l[cg] = l[cg] * alpha + ps;
#pragma unroll
            for (int dt = 0; dt < 4; ++dt) O[cg][dt] = O[cg][dt] * alpha;
            pv32(v, packP(p0, p1), O[cg]);
        }
    }
};

struct AttnT { unsigned long long* tsa; const bf16_t* proj; const bf16_t* kslc; const bf16_t* kwnc; const bf16_t* kcmp; const bf16_t* vcmpT; const bf16_t* vslT; const bf16_t* vwnT; bf16_t* ya; };

constexpr int AL_IMP = 0  , AL_OS = 0  , AL_TM = 67584  , AL_CNT = 69632  ,
              AL_OFF = 70656  , AL_UNITS = 71744  , AL_MM = 77888  , AL_LS = 78912  ;
constexpr int AL_Q = 81920  , QROWB = 528;
constexpr int OSP = 66;
typedef short s16x2 __attribute__((ext_vector_type(2)));
__device__ __forceinline__ int f2ord(float f) { const int b = __float_as_int(f); return b >= 0 ? b : b ^ 0x7fffffff; }
__device__ __forceinline__ float ord2f(int b) { return __int_as_float(b >= 0 ? b : b ^ 0x7fffffff); }

__device__ __forceinline__ void attn_wave_part1(const AttnT& T, int kh, int tq8, int lane, LAS float* imp  , LAS unsigned* tm, int wave) {
    const int col = lane & 15, q = lane >> 4, tk = col >> 2, g = col & 3;
    const int t0 = tq8 * 8, h = kh * 4 + g;
    bf16x8 Bq[2][2]; float g0[2], g2[2]; int tcg[2];
#pragma unroll
    for (int cg = 0; cg < 2; ++cg) { tcg[cg] = t0 + 4 * cg + tk; const bf16_t* prow = T.proj + (size_t)tcg[cg] * PP;
        Bq[cg][0] = *(const bf16x8*)(prow + C_Q + h * 64 + 8 * q); Bq[cg][1] = *(const bf16x8*)(prow + C_Q + h * 64 + 32 + 8 * q);
        g0[cg] = bf2f(prow[C_NG + h * 3 + 0]); g2[cg] = bf2f(prow[C_NG + h * 3 + 2]); }
    for (int i = lane; i < 8 * 264; i += 64) imp[i] = 0.f;
    {
        const bf16_t* Kc = T.kcmp + (size_t)kh * 1024 * 64; const bf16_t* Vc = T.vcmpT + (size_t)kh * 64 * 1024;
        const int tmax = t0 + 7, nvmax = tmax >= 31 ? ((tmax - 31) >> 4) + 1 : 0, nsteps = (nvmax + 31) >> 5;
        BodyCmp1 b1;
#pragma unroll
        for (int cg = 0; cg < 2; ++cg) { b1.Bq[cg][0] = Bq[cg][0]; b1.Bq[cg][1] = Bq[cg][1]; b1.nv[cg] = tcg[cg] >= 31 ? ((tcg[cg] - 31) >> 4) + 1 : 0; b1.ml[cg] = NEGF; b1.ll[cg] = 0.f; }
        b1.q = q;
        pipe3<false>(nsteps, KbLin{0}, b1, Kc, 64, Vc, 1024, lane);
        BodyCmp2 b2; b2.q = q; b2.g = g; b2.lane_ = lane; b2.carry[0] = 0.f; b2.carry[1] = 0.f;
#pragma unroll
        for (int cg = 0; cg < 2; ++cg) {
            float mc = fmaxf(b1.ml[cg], __shfl_xor(b1.ml[cg], 16)); mc = fmaxf(mc, __shfl_xor(mc, 32));
            float lc = b1.ll[cg] * EXP2(b1.ml[cg] - mc); lc += __shfl_xor(lc, 16); lc += __shfl_xor(lc, 32);
            b2.Bq[cg][0] = Bq[cg][0]; b2.Bq[cg][1] = Bq[cg][1]; b2.nv[cg] = b1.nv[cg]; b2.mc[cg] = mc; b2.inv[cg] = 1.f / fmaxf(lc, 1e-30f); b2.ia[cg] = imp + (4 * cg + tk) * 264;
#pragma unroll
            for (int dt = 0; dt < 4; ++dt) b2.O[cg][dt] = (f32x4){0.f, 0.f, 0.f, 0.f};
        }
        asm volatile("s_waitcnt lgkmcnt(0)" ::: "memory");
        pipe3<true>(nsteps, KbLin{0}, b2, Kc, 64, Vc, 1024, lane);
        if (q == 0 && g == 0 && nsteps > 0) { b2.ia[0][8 * nsteps] = b2.carry[0]; b2.ia[1][8 * nsteps] = b2.carry[1]; }
#pragma unroll
        for (int cg = 0; cg < 2; ++cg) { bf16_t* yrow = T.ya + (size_t)tcg[cg] * 512 + h * 64 + 4 * q;
#pragma unroll
            for (int dt = 0; dt < 4; ++dt) { const f32x4 o = b2.O[cg][dt] * g0[cg]; u32x2 w; w.x = cvt_pk_bf16(o[0], o[1]); w.y = cvt_pk_bf16(o[2], o[3]); *(u32x2*)(yrow + 16 * dt) = w; } }
    }
    asm volatile("s_waitcnt lgkmcnt(0)" ::: "memory");
    for (int tk2 = 0; tk2 < 8; ++tk2) {
        const int tt = t0 + tk2, cur = tt >> 6, nvalid = cur + 1, KSEL = nvalid < 16 ? nvalid : 16;
        int bits[4];
#pragma unroll
        for (int s = 0; s < 4; ++s) { const int j = s * 64 + lane; const float v = imp[tk2 * 264 + j];
            bits[s] = (j == 0 || j == cur) ? 0x7F000000 : (j < nvalid ? __float_as_int(v) : -1); }
        int prefix = 0;
        for (int bit = 30; bit >= 0; --bit) { const int Tt = prefix | (1 << bit); int cnt = 0;
#pragma unroll
            for (int s = 0; s < 4; ++s) cnt += __popcll(__ballot(bits[s] >= Tt));
            if (cnt >= KSEL) prefix = Tt; }
        unsigned long long sel[4]; int need = KSEL;
#pragma unroll
        for (int s = 0; s < 4; ++s) { sel[s] = __ballot(bits[s] > prefix); need -= __popcll(sel[s]); }
#pragma unroll
        for (int s = 0; s < 4; ++s) { unsigned long long me = __ballot(bits[s] == prefix);
            while (me != 0ull && need > 0) { const unsigned long long low = me & (0ull - me); sel[s] |= low; me ^= low; --need; } }
        const int tbi = wave * 8 + tk2; const unsigned tbit = 1u << (tbi & 31);
#pragma unroll
        for (int s = 0; s < 4; ++s) if ((sel[s] >> lane) & 1ull) __hip_atomic_fetch_or(tm + (s * 64 + lane) * 2 + (tbi >> 5), tbit, __ATOMIC_RELAXED, __HIP_MEMORY_SCOPE_WORKGROUP);
    }
    {
        const bf16_t* Kw = T.kwnc + (size_t)kh * SEQ * 64; const bf16_t* Vw = T.vwnT + (size_t)kh * 256 * 4096;
        const int klo = (t0 - 511 > 0 ? t0 - 511 : 0) & ~31; const int n = ((t0 + 7 - klo) >> 5) + 1;
        BodyWin bo; bo.q = q;
#pragma unroll
        for (int cg = 0; cg < 2; ++cg) { bo.Bq[cg][0] = Bq[cg][0]; bo.Bq[cg][1] = Bq[cg][1]; bo.tt[cg] = tcg[cg]; bo.m[cg] = NEGF; bo.l[cg] = 0.f;
#pragma unroll
            for (int dt = 0; dt < 4; ++dt) bo.O[cg][dt] = (f32x4){0.f, 0.f, 0.f, 0.f}; }
        pipe3<true>(n, KbLin{klo}, bo, Kw, 64, Vw, 64, lane);
#pragma unroll
        for (int cg = 0; cg < 2; ++cg) { float l = bo.l[cg]; l += __shfl_xor(l, 16); l += __shfl_xor(l, 32);
            const float sc = g2[cg] / fmaxf(l, 1e-30f); bf16_t* yrow = T.ya + (size_t)tcg[cg] * 512 + h * 64 + 4 * q;
#pragma unroll
            for (int dt = 0; dt < 4; ++dt) { const u32x2 y = *(const u32x2*)(yrow + 16 * dt); const f32x4 o = bo.O[cg][dt] * sc;
                u32x2 w; w.x = cvt_pk_bf16(bf_lo(y.x) + o[0], bf_hi(y.x) + o[1]); w.y = cvt_pk_bf16(bf_lo(y.y) + o[2], bf_hi(y.y) + o[3]); *(u32x2*)(yrow + 16 * dt) = w; } }
    }
    asm volatile("s_waitcnt lgkmcnt(0)" ::: "memory");
}

struct UnitPre { int j; unsigned tlo, thi; bf16x8 q00, q01, q10, q11; KOp ka, kb; VOp va, vb; };
template <int PASS>
__device__ __forceinline__ UnitPre unit_load(const LAS unsigned char* qlds, const bf16_t* Ks, const bf16_t* Vs, int kh, int tile, const LAS u32x4* units, int u, int lane) {
    const int col = lane & 15, q = lane >> 4, slot = col >> 2, g = col & 3;
    const u32x4 d = units[u]; UnitPre P; P.j = __builtin_amdgcn_readfirstlane((int)d.x); P.tlo = (unsigned)__builtin_amdgcn_readfirstlane((int)d.y); P.thi = (unsigned)__builtin_amdgcn_readfirstlane((int)d.z);
    const unsigned t0b = (P.tlo >> (8 * slot)) & 0xffu, t1b = (P.thi >> (8 * slot)) & 0xffu;
    const LAS unsigned char* qr0 = qlds + (t0b == 0xffu ? 0 : (int)t0b) * QROWB + g * 128 + 16 * q;
    const LAS unsigned char* qr1 = qlds + (t1b == 0xffu ? 0 : (int)t1b) * QROWB + g * 128 + 16 * q;
    P.q00 = *(const LAS bf16x8*)qr0; P.q01 = *(const LAS bf16x8*)(qr0 + 64); P.q10 = *(const LAS bf16x8*)qr1; P.q11 = *(const LAS bf16x8*)(qr1 + 64);
    P.ka = ldk(Ks, 64, 64 * P.j, lane); P.kb = ldk(Ks, 64, 64 * P.j + 32, lane);
    if (PASS == 1) { if ((EXPV) == 2) { P.va.v0 = P.ka.a00; P.va.v1 = P.ka.a01; P.va.v2 = P.ka.a10; P.va.v3 = P.ka.a11; P.vb = P.va; } else { P.va = ldv(Vs, 64, 64 * P.j, lane); P.vb = ldv(Vs, 64, 64 * P.j + 32, lane); } }
    return P;
}
template <int PASS>
__device__ __forceinline__ void unit_group(const UnitPre& P, const bf16x8& q0, const bf16x8& q1, unsigned toks, int tile, LAS unsigned char* lds, int lane) {
    const int col = lane & 15, q = lane >> 4, slot = col >> 2, g = col & 3;
    const int ti = (int)((toks >> (8 * slot)) & 0xffu);
    f32x4 S0a, S1a, S0b, S1b; qk32(P.ka, q0, q1, S0a, S1a); qk32(P.kb, q0, q1, S0b, S1b);
    const bool valid = ti != 0xff; const int row = (valid ? ti : 0) * 4 + g;
    const int lim = (P.j == tile) ? (valid ? ti : -1) - 8 * q : (valid ? 1000 : -1);
    LAS int* mm = (LAS int*)(lds + AL_MM); LAS float* ls = (LAS float*)(lds + AL_LS);
    if (PASS == 0) {
        float mloc = NEGF;
#pragma unroll
        for (int e = 0; e < 4; ++e) { mloc = fmaxf(mloc, e <= lim ? S0a[e] : NEGF); mloc = fmaxf(mloc, e + 4 <= lim ? S1a[e] : NEGF); mloc = fmaxf(mloc, e + 32 <= lim ? S0b[e] : NEGF); mloc = fmaxf(mloc, e + 36 <= lim ? S1b[e] : NEGF); }
        if ((EXPV) != 4) { mloc = fmaxf(mloc, __shfl_xor(mloc, 16)); mloc = fmaxf(mloc, __shfl_xor(mloc, 32)); }
        if (q == 0 && valid && (EXPV) != 3) __hip_atomic_fetch_max(mm + row, f2ord(mloc), __ATOMIC_RELAXED, __HIP_MEMORY_SCOPE_WORKGROUP);
    } else {
        const float m = ord2f(mm[row]);
        f32x4 p0a, p1a, p0b, p1b; float ps = 0.f;
#pragma unroll
        for (int e = 0; e < 4; ++e) { p0a[e] = e <= lim ? EXP2(S0a[e] - m) : 0.f; p1a[e] = e + 4 <= lim ? EXP2(S1a[e] - m) : 0.f; p0b[e] = e + 32 <= lim ? EXP2(S0b[e] - m) : 0.f; p1b[e] = e + 36 <= lim ? EXP2(S1b[e] - m) : 0.f;
            ps += (p0a[e] + p1a[e]) + (p0b[e] + p1b[e]); }
        ps += __shfl_xor(ps, 16); ps += __shfl_xor(ps, 32);
        if (q == 0 && valid) __hip_atomic_fetch_add(ls + row, ps, __ATOMIC_RELAXED, __HIP_MEMORY_SCOPE_WORKGROUP);
        f32x4 O[4];
#pragma unroll
        for (int dt = 0; dt < 4; ++dt) O[dt] = (f32x4){0.f, 0.f, 0.f, 0.f};
        pv32(P.va, packP(p0a, p1a), O); pv32(P.vb, packP(p0b, p1b), O);
        if (valid && (EXPV) != 1) { LAS bf16_t* orow = (LAS bf16_t*)(lds + AL_OS) + row * OSP + 4 * q;
#pragma unroll
            for (int dt = 0; dt < 4; ++dt) { const unsigned w0 = cvt_pk_bf16(O[dt][0], O[dt][1]), w1 = cvt_pk_bf16(O[dt][2], O[dt][3]);
                __builtin_amdgcn_ds_atomic_fadd_v2bf16((LAS s16x2*)(orow + 16 * dt), __builtin_bit_cast(s16x2, w0));
                __builtin_amdgcn_ds_atomic_fadd_v2bf16((LAS s16x2*)(orow + 16 * dt + 2), __builtin_bit_cast(s16x2, w1)); } }
    }
}
template <int PASS>
__device__ __forceinline__ void unit_compute(const UnitPre& P, int tile, LAS unsigned char* lds, int lane) {
    unit_group<PASS>(P, P.q00, P.q01, P.tlo, tile, lds, lane);
    if (P.thi != 0xffffffffu) unit_group<PASS>(P, P.q10, P.q11, P.thi, tile, lds, lane);
}
template <int PASS>
__device__ __forceinline__ void unit_pass(const AttnT& T, int kh, int tile, int n, LAS unsigned char* lds, int wave, int lane) {
    const bf16_t* Ks = T.kslc + (size_t)kh * SEQ * 64; const bf16_t* Vs = T.vslT + (size_t)kh * 256 * 4096;
    const LAS u32x4* units = (const LAS u32x4*)(lds + AL_UNITS);
    int u = wave; if (u >= n) return;
    UnitPre A = unit_load<PASS>(lds + AL_Q, Ks, Vs, kh, tile, units, u, lane), B = A;
    for (; u < n; u += 16) {
        const int u1 = u + 8; if (u1 < n) B = unit_load<PASS>(lds + AL_Q, Ks, Vs, kh, tile, units, u1, lane);
        unit_compute<PASS>(A, tile, lds, lane);
        if (u1 >= n) break;
        const int u2 = u + 16; if (u2 < n) A = unit_load<PASS>(lds + AL_Q, Ks, Vs, kh, tile, units, u2, lane);
        unit_compute<PASS>(B, tile, lds, lane);
    }
}

__device__ __forceinline__ void attn_tile(const AttnT& T, int kh, int tile, LAS unsigned char* lds, int tid, int wave, int lane) {
    LAS unsigned* tm = (LAS unsigned*)(lds + AL_TM);
    for (int i = tid; i < 512; i += NT) tm[i] = 0u;
    { const int ti = tid >> 3, part = tid & 7; const u32x4* src = (const u32x4*)(T.proj + (size_t)(tile * 64 + ti) * PP + C_Q + kh * 256 + part * 32); LAS u32x4* dst = (LAS u32x4*)(lds + AL_Q + ti * QROWB + part * 64);
      dst[0] = src[0]; dst[1] = src[1]; dst[2] = src[2]; dst[3] = src[3]; }
    __syncthreads();
    if ((TSK) >= 20 && blockIdx.x == 0 && threadIdx.x == 0) T.tsa[15] = __builtin_amdgcn_s_memrealtime();
    for (int r3 = 0; r3 < ((PROBE_REP) == 41 ? 2 : 1); ++r3)
    attn_wave_part1(T, kh, tile * 8 + wave, lane, (LAS float*)(lds + AL_IMP + wave * 8448), tm, wave);
    __threadfence_block(); __syncthreads();
    ASTAMP(0);
    LAS int* cnt = (LAS int*)(lds + AL_CNT); LAS int* off = (LAS int*)(lds + AL_OFF); LAS u32x4* units = (LAS u32x4*)(lds + AL_UNITS);
    for (int i = tid; i < 256 * OSP / 2; i += NT) ((LAS unsigned*)(lds + AL_OS))[i] = 0u;
    if (tid < 256) { ((LAS int*)(lds + AL_MM))[tid] = f2ord(NEGF); ((LAS float*)(lds + AL_LS))[tid] = 0.f; cnt[tid] = (__popc(tm[2 * tid]) + __popc(tm[2 * tid + 1]) + 7) >> 3; }
    __syncthreads();
    if (tid < 64) {
        const int c0 = cnt[4 * tid], c1 = cnt[4 * tid + 1], c2 = cnt[4 * tid + 2], c3 = cnt[4 * tid + 3]; const int tot = (c0 + c1) + (c2 + c3); int inc = tot;
#pragma unroll
        for (int o = 1; o < 64; o <<= 1) { const int v = __shfl_up(inc, o); if (tid >= o) inc += v; }
        const int ex = inc - tot; off[4 * tid] = ex; off[4 * tid + 1] = ex + c0; off[4 * tid + 2] = ex + c0 + c1; off[4 * tid + 3] = ex + c0 + c1 + c2;
        if (tid == 63) off[256] = inc;
    }
    __syncthreads();
    if (tid < 256) { unsigned long long mask = (unsigned long long)tm[2 * tid] | ((unsigned long long)tm[2 * tid + 1] << 32); int o = off[tid];
        while (mask != 0ull) { unsigned tl = 0xffffffffu, th = 0xffffffffu;
#pragma unroll
            for (int k = 0; k < 4; ++k) if (mask != 0ull) { const unsigned ti = (unsigned)__builtin_ctzll(mask); mask &= mask - 1ull; tl = (tl & ~(0xffu << (8 * k))) | (ti << (8 * k)); }
#pragma unroll
            for (int k = 0; k < 4; ++k) if (mask != 0ull) { const unsigned ti = (unsigned)__builtin_ctzll(mask); mask &= mask - 1ull; th = (th & ~(0xffu << (8 * k))) | (ti << (8 * k)); }
            units[o++] = (u32x4){(unsigned)tid, tl, th, 0u}; } }
    __syncthreads();
    const int n = off[256];
    ASTAMP(1);
    unit_pass<0>(T, kh, tile, n, lds, wave, lane);
    if ((PROBE_REP) == 42) unit_pass<0>(T, kh, tile, n, lds, wave, lane);
    __syncthreads();
    ASTAMP(2);
    unit_pass<1>(T, kh, tile, n, lds, wave, lane);
    __syncthreads();
    ASTAMP(3);
    { const int ti = tid >> 3, part = tid & 7, g = part >> 1, d0 = 32 * (part & 1), row = ti * 4 + g, t = tile * 64 + ti, h = kh * 4 + g;
      const float l = ((const LAS float*)(lds + AL_LS))[row]; const float sc = bf2f(T.proj[(size_t)t * PP + C_NG + h * 3 + 1]) / fmaxf(l, 1e-30f);
      const LAS unsigned* orow = (const LAS unsigned*)((const LAS bf16_t*)(lds + AL_OS) + row * OSP + d0); u32x4* yp = (u32x4*)(T.ya + (size_t)t * 512 + h * 64 + d0);
#pragma unroll
      for (int i = 0; i < 4; ++i) { const u32x4 y = yp[i]; const unsigned o0 = orow[4 * i], o1 = orow[4 * i + 1], o2 = orow[4 * i + 2], o3 = orow[4 * i + 3]; f32x4 a, b;
          a[0] = bf_lo(y.x) + bf_lo(o0) * sc; a[1] = bf_hi(y.x) + bf_hi(o0) * sc; a[2] = bf_lo(y.y) + bf_lo(o1) * sc; a[3] = bf_hi(y.y) + bf_hi(o1) * sc;
          b[0] = bf_lo(y.z) + bf_lo(o2) * sc; b[1] = bf_hi(y.z) + bf_hi(o2) * sc; b[2] = bf_lo(y.w) + bf_lo(o3) * sc; b[3] = bf_hi(y.w) + bf_hi(o3) * sc;
          yp[i] = pack8(a, b); } }
    __syncthreads();
    ASTAMP(4);
    if ((TSK) >= 20 && blockIdx.x == 0 && threadIdx.x == 0) T.tsa[5] += (unsigned long long)n;
}

__device__ __forceinline__ void ssm_load_u(const bf16_t* proj, int c, int g, int lane, LAS float* ubuf) {
#pragma unroll
    for (int r = 0; r < 2; ++r) { const int tl = lane + 64 * r; const u32x4* src = (const u32x4*)(proj + (size_t)(c * 128 + tl) * PP + C_U + g * 16); const u32x4 a = src[0], b = src[1];
        LAS f32x4* d = (LAS f32x4*)(ubuf + tl * 16);
        d[0] = (f32x4){bf_lo(a.x), bf_hi(a.x), bf_lo(a.y), bf_hi(a.y)}; d[1] = (f32x4){bf_lo(a.z), bf_hi(a.z), bf_lo(a.w), bf_hi(a.w)};
        d[2] = (f32x4){bf_lo(b.x), bf_hi(b.x), bf_lo(b.y), bf_hi(b.y)}; d[3] = (f32x4){bf_lo(b.z), bf_hi(b.z), bf_lo(b.w), bf_hi(b.w)}; }
    asm volatile("s_waitcnt lgkmcnt(0)" ::: "memory");
}
__device__ __forceinline__ f32x2 ssm_step(const f32x2 (&Bb)[16], const f32x2 A, const f32x2 x, const LAS float* urow) {
    const f32x4 u0 = *(const LAS f32x4*)(urow), u1 = *(const LAS f32x4*)(urow + 4), u2 = *(const LAS f32x4*)(urow + 8), u3 = *(const LAS f32x4*)(urow + 12);
    f32x2 bu = Bb[0] * u0[0]; f32x2 bv = Bb[1] * u0[1];
    bu += Bb[2] * u0[2]; bv += Bb[3] * u0[3]; bu += Bb[4] * u1[0]; bv += Bb[5] * u1[1]; bu += Bb[6] * u1[2]; bv += Bb[7] * u1[3];
    bu += Bb[8] * u2[0]; bv += Bb[9] * u2[1]; bu += Bb[10] * u2[2]; bv += Bb[11] * u2[3]; bu += Bb[12] * u3[0]; bv += Bb[13] * u3[1]; bu += Bb[14] * u3[2]; bv += Bb[15] * u3[3];
    bu += bv;
    f32x2 r; r.x = A.x * x.x - A.y * x.y + bu.x; r.y = A.x * x.y + A.y * x.x + bu.y; return r;
}
__device__ __forceinline__ void ssm_pass1(const unsigned char* ws, int c, int g, int lane, LAS float* ubuf) {
    const bf16_t* proj = (const bf16_t*)(ws + WS_PROJ);
    ssm_load_u(proj, c, g, lane, ubuf);
    const f32x2* Bbar = (const f32x2*)(ws + WS_BBAR) + (size_t)(g * 64 + lane) * 16; f32x2 Bb[16];
#pragma unroll
    for (int hh = 0; hh < 16; ++hh) Bb[hh] = Bbar[hh];
    const f32x2 A = ((const f32x2*)(ws + WS_ABAR))[g * 64 + lane];
    f32x2 x = {0.f, 0.f};
    for (int s = 0; s < 128; ++s) x = ssm_step(Bb, A, x, ubuf + s * 16);
    ((f32x2*)(ws + WS_SBUF))[(size_t)(c * 32 + g) * 64 + lane] = x;
    asm volatile("s_waitcnt lgkmcnt(0)" ::: "memory");
}
__device__ __forceinline__ void ssm_pass3(const Args& a, int c, int g, int lane, LAS float* ubuf, LAS unsigned char* xl  ) {
    const unsigned char* ws = a.ws; const bf16_t* proj = (const bf16_t*)(ws + WS_PROJ);
    ssm_load_u(proj, c, g, lane, ubuf);
    const f32x2* Bbar = (const f32x2*)(ws + WS_BBAR) + (size_t)(g * 64 + lane) * 16; f32x2 Bb[16];
#pragma unroll
    for (int hh = 0; hh < 16; ++hh) Bb[hh] = Bbar[hh];
    const f32x2 A = ((const f32x2*)(ws + WS_ABAR))[g * 64 + lane], A128 = ((const f32x2*)(ws + WS_A128))[g * 64 + lane];
    f32x2 x = {0.f, 0.f};
    { const f32x2* Sb = (const f32x2*)(ws + WS_SBUF) + g * 64 + lane;
      _Pragma("unroll 8") for (int cc = 0; cc < c; ++cc) { const f32x2 s = Sb[(size_t)cc * 32 * 64]; f32x2 r; r.x = A128.x * x.x - A128.y * x.y + s.x; r.y = A128.x * x.y + A128.y * x.x + s.y; x = r; } }
    const int hrow = lane & 15, q = lane >> 4; bf16x8 Cm[4];
    { const float* cre = a.in[14] + (size_t)(g * 16 + hrow) * 64; const float* cim = a.in[15] + (size_t)(g * 16 + hrow) * 64;
#pragma unroll
      for (int ks = 0; ks < 4; ++ks) { const f32x4 r = *(const f32x4*)(cre + 16 * ks + 4 * q), im = *(const f32x4*)(cim + 16 * ks + 4 * q);
          u32x4 w; w.x = cvt_pk_bf16(r[0], -im[0]); w.y = cvt_pk_bf16(r[1], -im[1]); w.z = cvt_pk_bf16(r[2], -im[2]); w.w = cvt_pk_bf16(r[3], -im[3]); Cm[ks] = __builtin_bit_cast(bf16x8, w); } }
    const f32x4 dsk = *(const f32x4*)(a.in[16] + g * 16 + 4 * q);
    bf16_t* ybp = (bf16_t*)((unsigned char*)a.out + OUT_YBP);
    for (int sub = 0; sub < 8; ++sub) {
#pragma unroll 4
        for (int s = 0; s < 16; ++s) { x = ssm_step(Bb, A, x, ubuf + (sub * 16 + s) * 16); *(LAS unsigned*)(xl + s * 272 + lane * 4) = cvt_pk_bf16(x.x, x.y); }
        asm volatile("s_waitcnt lgkmcnt(0)" ::: "memory");
        f32x4 acc = {0.f, 0.f, 0.f, 0.f};
#pragma unroll
        for (int ks = 0; ks < 4; ++ks) { const bf16x8 b = *(const LAS bf16x8*)(xl + hrow * 272 + ks * 64 + q * 16); acc = MFMA16(Cm[ks], b, acc); }
        const int tl = sub * 16 + hrow; const f32x4 uu = *(const LAS f32x4*)(ubuf + tl * 16 + 4 * q);
        f32x4 y = acc + dsk * uu;
        u32x2 w; w.x = cvt_pk_bf16(gelu_tanh(y[0]), gelu_tanh(y[1])); w.y = cvt_pk_bf16(gelu_tanh(y[2]), gelu_tanh(y[3]));
        *(u32x2*)(ybp + (size_t)(c * 128 + tl) * 512 + g * 16 + 4 * q) = w;
        asm volatile("s_waitcnt lgkmcnt(0)" ::: "memory");
    }
}

__global__ void __launch_bounds__(NT, 2) fwd_mega(Args a) {
    extern __shared__ __attribute__((aligned(16))) unsigned char lds_raw[];
    cg::grid_group grid = cg::this_grid();
    LAS unsigned char* lds = (LAS unsigned char*)lds_raw;
    const int tid = threadIdx.x, lane = tid & 63, wave = __builtin_amdgcn_readfirstlane(tid >> 6);
    const int G = gridDim.x, bid = blockIdx.x;
    const int gw = bid * NWV + wave, NGW = G * NWV;
    const int gt = bid * NT + tid, NGT = G * NT;
    unsigned char* ws = a.ws;
    const float* x = a.in[0];
    STAMP(0);
    if ((TSK) >= 20 && blockIdx.x == 0 && threadIdx.x == 0) for (int i = 0; i < 16; ++i) ((unsigned long long*)(a.ws + 244 * 1024))[i] = 0ull;
    if (tid < 4) ((volatile LAS unsigned*)(lds + 131072 + 64))[tid] = 0u;
    if (bid == 0) for (int i = tid; i < XCD_BAR_WORDS; i += NT) ((unsigned*)(ws + WS_BAR))[i] = 0u;
    __syncthreads();

    {
        if (bid < 16) {
            LAS float* red = (LAS float*)lds;
            const int o = bid * 32 + (tid & 31), ksl = tid >> 5, which = o >> 8, colc = o & 255;
            const float* pe = a.in[which ? 7 : 4]; const float* w1 = a.in[which ? 8 : 5]; float s = 0.f;
            _Pragma("unroll 16") for (int k = ksl * 128; k < ksl * 128 + 128; ++k) s += pe[k] * w1[(size_t)k * 256 + colc];
            red[ksl * 32 + (tid & 31)] = s; __syncthreads();
            if (tid < 32) { float t = 0.f; for (int i = 0; i < 16; ++i) t += red[i * 32 + tid]; ((float*)(ws + WS_BIASPE))[o] = t; }
            __syncthreads();
        }
        LAS float* scr = (LAS float*)(lds + wave * 8448);
        constexpr int I_IN = 16 * 121, I_GLU = 8 * 16, I_PA = 8 * 32, I_OUT = 16 * 32, I_UP = 16 * 176, I_DN = 44 * 32, I_W1 = 32 * 8;
        constexpr int NITEMS = I_IN + I_GLU + 2 * I_PA + I_OUT + I_UP + I_DN + 2 * I_W1;
        for (int it = gw; it < NITEMS; it += NGW) {
            int r = it;
            if (r < I_IN) { transpose_item(a.in[3], 1024, DIN, (bf16_t*)(ws + WS_WIN), scr, r / 121, r % 121, lane, a.in[2], 1); continue; } r -= I_IN;
            if (r < I_GLU) { transpose_item(a.in[18], 512, 512, (bf16_t*)(ws + WS_WGLU), scr, r / 16, r % 16, lane, nullptr, 0); continue; } r -= I_GLU;
            if (r < I_PA) { transpose_item(a.in[19], 512, 1024, (bf16_t*)(ws + WS_WPA), scr, r / 32, r % 32, lane, nullptr, 0); continue; } r -= I_PA;
            if (r < I_PA) { transpose_item(a.in[20], 512, 1024, (bf16_t*)(ws + WS_WPB), scr, r / 32, r % 32, lane, nullptr, 0); continue; } r -= I_PA;
            if (r < I_OUT) { transpose_item(a.in[21], 1024, 1024, (bf16_t*)(ws + WS_WOUT), scr, r / 32, r % 32, lane, nullptr, 0); continue; } r -= I_OUT;
            if (r < I_UP) { transpose_item(a.in[23], 1024, NUP, (bf16_t*)(ws + WS_WUP), scr, r / 176, r % 176, lane, a.in[22], 2); continue; } r -= I_UP;
            if (r < I_DN) { transpose_item(a.in[26], DFF, 1024, (bf16_t*)(ws + WS_WDOWN), scr, r / 32, r % 32, lane, nullptr, 0); continue; } r -= I_DN;
            if (r < I_W1) { transpose_item(a.in[5], 2048, 256, (bf16_t*)(ws + WS_W1K), scr, r / 8, r % 8, lane, nullptr, 0); continue; } r -= I_W1;
            transpose_item(a.in[8], 2048, 256, (bf16_t*)(ws + WS_W1V), scr, r / 8, r % 8, lane, nullptr, 0);
        }
        { u32x4* p = (u32x4*)(ws + WS_WIN + (size_t)DIN * 1024 * 2); const int n = (4096 - DIN) * 1024 * 2 / 16; for (int i = gt; i < n; i += NGT) p[i] = (u32x4){0u, 0u, 0u, 0u}; }
        { u32x4* p = (u32x4*)(ws + WS_PROJ + (size_t)SEQ * PP * 2); const int n = 32 * PP * 2 / 16; for (int i = gt; i < n; i += NGT) p[i] = (u32x4){0u, 0u, 0u, 0u}; }
        for (int i = gt; i < 128 * 64 + 2048; i += NGT) {
            if (i < 128 * 64) { const int r = i >> 6, cidx = SEQ + (i & 63); ((bf16_t*)(ws + WS_VSLT))[(size_t)r * VTP + cidx] = 0; ((bf16_t*)(ws + WS_VWNT))[(size_t)r * VTP + cidx] = 0; }
            else { const int j = i - 128 * 64; ((bf16_t*)(ws + WS_VSLT))[(size_t)128 * VTP + j] = 0; ((bf16_t*)(ws + WS_VWNT))[(size_t)128 * VTP + j] = 0; }
        }
        for (int i = gt; i < SEQ; i += NGT) { ((float*)(ws + WS_RSS2))[i] = 0.f; ((float*)(ws + WS_RSS3))[i] = 0.f; }
        { const int* pos = (const int*)a.in[1];
          for (int i = gt; i < SEQ * 8; i += NGT) { const int tt = i >> 3, fi = i & 7; const float invf = powf(500000.0f, -(float)(2 * fi) / 16.0f); const float ang = (float)pos[tt] * invf;
              float sn, cs; sincosf(ang, &sn, &cs); ((float*)(ws + WS_ROPEC))[i] = cs; ((float*)(ws + WS_ROPES))[i] = sn; } }
        for (int i = gt; i < 2048; i += NGT) { const int gg = i >> 6;
            const float dt = expf(a.in[17][gg]), ar = a.in[10][i], ai = a.in[11][i];
            const float e = expf(ar * dt), em1 = expm1f(ar * dt), th = ai * dt; float sn, cs; sincosf(th, &sn, &cs); const float sh = sinf(0.5f * th);
            const float Ax = e * cs, Ay = e * sn; const float nx = em1 * cs - 2.f * sh * sh, ny = e * sn;
            const float den = 1.f / (ar * ar + ai * ai); const float fx = (nx * ar + ny * ai) * den, fy = (ny * ar - nx * ai) * den;
            ((f32x2*)(ws + WS_ABAR))[i] = (f32x2){Ax, Ay};
            float px = Ax, py = Ay;
            for (int k = 0; k < 7; ++k) { const float qx = px * px - py * py, qy = 2.f * px * py; px = qx; py = qy; }
            ((f32x2*)(ws + WS_A128))[i] = (f32x2){px, py};
            const float* bre = a.in[12] + (size_t)i * 16; const float* bim = a.in[13] + (size_t)i * 16; f32x2* Bo = (f32x2*)(ws + WS_BBAR) + (size_t)i * 16;
            for (int hh = 0; hh < 16; ++hh) Bo[hh] = (f32x2){fx * bre[hh] - fy * bim[hh], fx * bim[hh] + fy * bre[hh]};
        }
        for (int r = gw; r < SEQ; r += NGW) {
            const f32x4* xr = (const f32x4*)(x + (size_t)r * DM) + lane; f32x4 v[4]; float s = 0.f;
#pragma unroll
            for (int j = 0; j < 4; ++j) { v[j] = xr[64 * j]; s += (v[j][0] * v[j][0] + v[j][1] * v[j][1]) + (v[j][2] * v[j][2] + v[j][3] * v[j][3]); }
            s = wave_sum(s);
            if (lane == 0) ((float*)(ws + WS_RSTD1))[r] = rsqrtf(s * (1.f / DM) + EPS);
            u32x2* o = (u32x2*)(ws + WS_XB + (size_t)r * DM * 2) + lane;
#pragma unroll
            for (int j = 0; j < 4; ++j) { u32x2 w; w.x = cvt_pk_bf16(v[j][0], v[j][1]); w.y = cvt_pk_bf16(v[j][2], v[j][3]); o[64 * j] = w; }
        }
    }
    grid.sync();
    STAMP(1);
    XcdBarrier xbar = xcd_barrier_post((unsigned*)(ws + WS_BAR), (volatile LAS unsigned*)(lds + 131072 + 64));

    REPS(1) {
        pg8::Gemm g{1024, 2048u, 128u};
        SchedMN S{64, 16, 1, G, bid, 0, (const char*)(ws + WS_XB), nullptr, (const char*)(ws + WS_WIN), nullptr, (size_t)256 * 1024 * 2, (size_t)256 * 1024 * 2};
        EpiProj E{(bf16_t*)(ws + WS_PROJ), (bf16_t*)(ws + WS_VSLT), (bf16_t*)(ws + WS_VWNT), (bf16_t*)(ws + WS_KSL), (bf16_t*)(ws + WS_KWN), (const float*)(ws + WS_RSTD1), (const float*)(ws + WS_ROPEC), (const float*)(ws + WS_ROPES)};
        pg8::gemm_phase<EpiProj, SchedMN, true, true>(lds, g, S, E);
    }
    GSYNC();
    STAMP(2);

    {
        if (bid < 16) {
            pg8::Gemm g{2048, (unsigned)(16 * PP * 2), (unsigned)(PP * 2)};
            SchedCmp S{bid, (const char*)(ws + WS_PROJ), (const char*)(ws + WS_W1K), (const char*)(ws + WS_W1V)};
            EpiCmp E{(bf16_t*)(ws + WS_HID), (const float*)(ws + WS_BIASPE)};
            pg8::gemm_phase<EpiCmp, SchedCmp, true, true>(lds, g, S, E);
        } else {
            LAS float* ubuf = (LAS float*)(lds + wave * 16384);
            for (int it = (bid - 16) * NWV + wave; it < 4096 * ((PROBE_REP) == 12 ? 2 : 1); it += (G - 16) * NWV) ssm_pass1(ws, (it & 4095) >> 5, it & 31, lane, ubuf);
        }
    }
    GSYNC();
    STAMP(3);

    REPS(3) {
        const bf16_t* hid = (const bf16_t*)(ws + WS_HID);
        for (int r = gw; r < 4096; r += NGW) {
            const int z = r >> 10, n = r & 1023, which = z >> 1, kh = z & 1;
            float acc = 0.f;
            if (n < 1023) { const float* w2 = a.in[which ? 9 : 6]; const bf16_t* hr = hid + (size_t)r * 256;
                _Pragma("unroll 16") for (int k = 0; k < 256; k += 2) { const unsigned hw = *(const unsigned*)(hr + k); acc += bf_lo(hw) * w2[k * 64 + lane]; acc += bf_hi(hw) * w2[(k + 1) * 64 + lane]; } }
            if (which == 0) {
                const float other = __shfl_xor(acc, 8); const int prow = 16 * n + 31; float o = acc;
                if (lane < 16 && n < 1023) { const float cs = ((const float*)(ws + WS_ROPEC))[prow * 8 + (lane & 7)], sn = ((const float*)(ws + WS_ROPES))[prow * 8 + (lane & 7)];
                    o = lane < 8 ? acc * cs - other * sn : acc * cs + other * sn; }
                ((bf16_t*)(ws + WS_KCMP))[((size_t)kh * 1024 + n) * 64 + lane] = (bf16_t)(cvt_pk_bf16(o, 0.f) & 0xffff);
            } else {
                ((bf16_t*)(ws + WS_VCMPT))[((size_t)kh * 64 + lane) * 1024 + n] = (bf16_t)(cvt_pk_bf16(acc, 0.f) & 0xffff);
            }
        }
    }
    GSYNC();
    STAMP(4);

    {
        AttnT T{(unsigned long long*)(ws + 244 * 1024), (const bf16_t*)(ws + WS_PROJ), (const bf16_t*)(ws + WS_KSL), (const bf16_t*)(ws + WS_KWN), (const bf16_t*)(ws + WS_KCMP), (const bf16_t*)(ws + WS_VCMPT), (const bf16_t*)(ws + WS_VSLT), (const bf16_t*)(ws + WS_VWNT), (bf16_t*)((unsigned char*)a.out + OUT_YA)};
        LAS float* wl = (LAS float*)(lds + wave * 16384);
        for (int r2 = 0; r2 < ((PROBE_REP) == 4 ? 2 : 1); ++r2)
        for (int pr = bid; pr < 256; pr += G) {
            const int xcd = pr & 7, slot = pr >> 3, kh = xcd & 1, tl = 32 * (xcd >> 1) + slot;
_Pragma("nounroll")
            for (int k2 = 0; k2 < 2; ++k2) { int tk_ = threadIdx.x; asm volatile("" : "+v"(tk_)); attn_tile(T, kh, k2 ? 255 - tl : tl, lds, tk_, __builtin_amdgcn_readfirstlane(tk_ >> 6), tk_ & 63); }
        }
        if ((PROBE_REP) == 4) {
            AttnT T2 = T; T2.ya = (bf16_t*)(ws + WS_XB);
            for (int pr = bid; pr < 256; pr += G) { const int xcd = pr & 7, slot = pr >> 3, kh = xcd & 1, tl = 32 * (xcd >> 1) + slot;
                _Pragma("nounroll") for (int k2 = 0; k2 < 2; ++k2) attn_tile(T2, kh, k2 ? 255 - tl : tl, lds, tid, wave, lane); }
        }
        int tid2 = threadIdx.x; asm volatile("" : "+v"(tid2));
        const int lane2 = tid2 & 63, wave2 = __builtin_amdgcn_readfirstlane(tid2 >> 6), gw2 = bid * NWV + wave2;
        for (int it = gw2; it < 4096 * ((PROBE_REP) == 14 ? 2 : 1); it += NGW) ssm_pass3(a, (it & 4095) >> 5, it & 31, lane2, (LAS float*)(lds + wave2 * 16384), lds + wave2 * 16384 + 8192);
    }
    GSYNC();
    STAMP(5);

    REPS(5) {
        pg8::Gemm g{512, 1024u, 128u};
        SchedMN S{64, 2, 1, G, bid, 0, (const char*)a.out + OUT_YBP, nullptr, (const char*)(ws + WS_WGLU), nullptr, (size_t)256 * 512 * 2, (size_t)256 * 512 * 2};
        EpiGlu E{(const bf16_t*)((const unsigned char*)a.out + OUT_YBP), (bf16_t*)((unsigned char*)a.out + OUT_YB)};
        pg8::gemm_phase<EpiGlu, SchedMN, true, true>(lds, g, S, E);
    }
    GSYNC();
    STAMP(6);

    REPS(6) {
        pg8::Gemm g{512, 1024u, 128u};
        SchedMN S{64, 4, 2, G, bid, 0, (const char*)a.out + OUT_YA, (const char*)a.out + OUT_YB, (const char*)(ws + WS_WPA), (const char*)(ws + WS_WPB), (size_t)256 * 512 * 2, (size_t)256 * 512 * 2};
        EpiMerge E{(const bf16_t*)(ws + WS_PROJ), (bf16_t*)(ws + WS_MERGED)};
        pg8::gemm_phase<EpiMerge, SchedMN, true, true>(lds, g, S, E);
    }
    GSYNC();
    STAMP(7);

    {
        pg8::Gemm g{1024, 2048u, 128u};
        SchedMN S{64, 4, 1, G, bid, 0, (const char*)(ws + WS_MERGED), nullptr, (const char*)(ws + WS_WOUT), nullptr, (size_t)256 * 1024 * 2, (size_t)256 * 1024 * 2};
        EpiRes E{x, a.out, (bf16_t*)(ws + WS_X1B), (float*)(ws + WS_RSS2)};
        pg8::gemm_phase<EpiRes, SchedMN, true, true>(lds, g, S, E);
    }
    GSYNC();
    STAMP(8);

    for (int half = 0; half < 2; ++half) {
        const int pm_off = half ? 31 : 0, nM = half ? 33 : 32, rowbase = pm_off * 256;
        REPS(8) {
            pg8::Gemm g{1024, 2048u, 128u};
            SchedMN S{nM, 22, 1, G, bid, pm_off, (const char*)(ws + WS_X1B), nullptr, (const char*)(ws + WS_WUP), nullptr, (size_t)256 * 1024 * 2, (size_t)256 * 1024 * 2};
            EpiUp E{(bf16_t*)(ws + WS_UPRAW), (const float*)(ws + WS_RSS2), rowbase};
            pg8::gemm_phase<EpiUp, SchedMN, true, true>(lds, g, S, E);
        }
        GSYNC();
    STAMP(9);
        REPS(9) {
            const bf16_t* up = (const bf16_t*)(ws + WS_UPRAW); bf16_t* act = (bf16_t*)(ws + WS_ACT);
            const float* cw = a.in[24]; const float* cb = a.in[25];
            const int tlo = half ? 8192 : 0;
            for (int it = gt; it < 256 * 352; it += NGT) {
                const int cg8 = it % 352, tb = it / 352, c0 = cg8 * 8, tile = c0 >> 7, jj = c0 & 127;
                const int ucol = tile * 256 + jj;
                float wg[3][8], wv[3][8], bg[8], bv[8];
#pragma unroll
                for (int e = 0; e < 8; ++e) { bg[e] = cb[c0 + e]; bv[e] = cb[DFF + c0 + e];
#pragma unroll
                    for (int k = 0; k < 3; ++k) { wg[k][e] = cw[k * NUP + c0 + e]; wv[k][e] = cw[k * NUP + DFF + c0 + e]; } }
                const int ts = tlo + tb * 32;
                float g2[8], g1[8], v2[8], v1[8];
#pragma unroll
                for (int e = 0; e < 8; ++e) { g2[e] = g1[e] = v2[e] = v1[e] = 0.f; }
                if (ts >= 2) {
                    const u32x4 a2 = *(const u32x4*)(up + (size_t)(ts - 2 - rowbase) * NUP + ucol), b2 = *(const u32x4*)(up + (size_t)(ts - 2 - rowbase) * NUP + ucol + 128);
                    const u32x4 a1 = *(const u32x4*)(up + (size_t)(ts - 1 - rowbase) * NUP + ucol), b1 = *(const u32x4*)(up + (size_t)(ts - 1 - rowbase) * NUP + ucol + 128);
                    g2[0] = bf_lo(a2.x); g2[1] = bf_hi(a2.x); g2[2] = bf_lo(a2.y); g2[3] = bf_hi(a2.y); g2[4] = bf_lo(a2.z); g2[5] = bf_hi(a2.z); g2[6] = bf_lo(a2.w); g2[7] = bf_hi(a2.w);
                    v2[0] = bf_lo(b2.x); v2[1] = bf_hi(b2.x); v2[2] = bf_lo(b2.y); v2[3] = bf_hi(b2.y); v2[4] = bf_lo(b2.z); v2[5] = bf_hi(b2.z); v2[6] = bf_lo(b2.w); v2[7] = bf_hi(b2.w);
                    g1[0] = bf_lo(a1.x); g1[1] = bf_hi(a1.x); g1[2] = bf_lo(a1.y); g1[3] = bf_hi(a1.y); g1[4] = bf_lo(a1.z); g1[5] = bf_hi(a1.z); g1[6] = bf_lo(a1.w); g1[7] = bf_hi(a1.w);
                    v1[0] = bf_lo(b1.x); v1[1] = bf_hi(b1.x); v1[2] = bf_lo(b1.y); v1[3] = bf_hi(b1.y); v1[4] = bf_lo(b1.z); v1[5] = bf_hi(b1.z); v1[6] = bf_lo(b1.w); v1[7] = bf_hi(b1.w);
                }
                for (int s = 0; s < 32; ++s) {
                    const int tt = ts + s;
                    const u32x4 a0 = *(const u32x4*)(up + (size_t)(tt - rowbase) * NUP + ucol), b0 = *(const u32x4*)(up + (size_t)(tt - rowbase) * NUP + ucol + 128);
                    float gc[8], vc[8];
                    gc[0] = bf_lo(a0.x); gc[1] = bf_hi(a0.x); gc[2] = bf_lo(a0.y); gc[3] = bf_hi(a0.y); gc[4] = bf_lo(a0.z); gc[5] = bf_hi(a0.z); gc[6] = bf_lo(a0.w); gc[7] = bf_hi(a0.w);
                    vc[0] = bf_lo(b0.x); vc[1] = bf_hi(b0.x); vc[2] = bf_lo(b0.y); vc[3] = bf_hi(b0.y); vc[4] = bf_lo(b0.z); vc[5] = bf_hi(b0.z); vc[6] = bf_lo(b0.w); vc[7] = bf_hi(b0.w);
                    float o[8];
#pragma unroll
                    for (int e = 0; e < 8; ++e) { const float gg = bg[e] + wg[0][e] * g2[e] + wg[1][e] * g1[e] + wg[2][e] * gc[e]; const float vv = bv[e] + wv[0][e] * v2[e] + wv[1][e] * v1[e] + wv[2][e] * vc[e];
                        o[e] = gg * sigmoidf_(gg) * vv; g2[e] = g1[e]; g1[e] = gc[e]; v2[e] = v1[e]; v1[e] = vc[e]; }
                    u32x4 w; w.x = cvt_pk_bf16(o[0], o[1]); w.y = cvt_pk_bf16(o[2], o[3]); w.z = cvt_pk_bf16(o[4], o[5]); w.w = cvt_pk_bf16(o[6], o[7]);
                    *(u32x4*)(act + (size_t)tt * DFF + c0) = w;
                }
            }
        }
        GSYNC();
    STAMP(10);
    }

    {
        pg8::Gemm g{DFF, (unsigned)(DFF * 2), 128u};
        SchedMN S{64, 4, 1, G, bid, 0, (const char*)(ws + WS_ACT), nullptr, (const char*)(ws + WS_WDOWN), nullptr, (size_t)256 * DFF * 2, (size_t)256 * DFF * 2};
        EpiRes E{a.out, a.out, nullptr, (float*)(ws + WS_RSS3)};
        pg8::gemm_phase<EpiRes, SchedMN, true, true>(lds, g, S, E);
    }
    GSYNC();
    STAMP(11);

    {
        const float* gf = a.in[27];
        for (int r = gw; r < SEQ; r += NGW) {
            const float rs = rsqrtf(((const float*)(ws + WS_RSS3))[r] * (1.f / DM) + EPS);
            f32x4* xr = (f32x4*)(a.out + (size_t)r * DM) + lane; const f32x4* gr = (const f32x4*)gf + lane;
#pragma unroll
            for (int j = 0; j < 4; ++j) xr[64 * j] = xr[64 * j] * rs * gr[64 * j];
        }
    }
    if ((TSK) >= 0 && blockIdx.x == 0 && threadIdx.x == 0) {
        const unsigned long long tend = __builtin_amdgcn_s_memrealtime(); const unsigned long long* ts = (const unsigned long long*)(a.ws + 240 * 1024);
        const unsigned long long t1 = ((TSK) + 1 > 11) ? tend : ts[(TSK) + 1 > 11 ? 0 : (TSK) + 1];
        asm volatile("s_waitcnt vmcnt(0)" ::: "memory");
        a.out[0] = ((TSK) >= 20) ? (float)((const unsigned long long*)(a.ws + 244 * 1024))[(TSK) >= 20 ? (TSK) - 20 : 0] * ((TSK) == 25 ? 1.0f : 0.01f) : (float)(t1 - ts[(TSK) > 11 ? 11 : (TSK)]) * 0.01f;
    }
}

extern "C" void kernel_launch(void* const* d_in, const int* in_sizes, int n_in, void* d_out, int out_size, void* d_ws, size_t ws_size, hipStream_t stream) {
    static int grid = 0;
    if (grid == 0) {
        int dev = 0, cus = 0, per_cu = 0;
        (void)hipGetDevice(&dev); (void)hipDeviceGetAttribute(&cus, hipDeviceAttributeMultiprocessorCount, dev);
        (void)hipFuncSetAttribute((const void*)fwd_mega, hipFuncAttributeMaxDynamicSharedMemorySize, LDS_BYTES);
        (void)hipOccupancyMaxActiveBlocksPerMultiprocessor(&per_cu, (const void*)fwd_mega, NT, LDS_BYTES);
        if (per_cu < 1) { fprintf(stderr, "kernel_launch: occupancy query says %d blocks per CU\n", per_cu); per_cu = 1; }
        grid = cus;
        if (n_in != 28 || ws_size < 252 * MiB) fprintf(stderr, "kernel_launch: unexpected n_in %d / ws_size %zu\n", n_in, ws_size);
    }
    Args a{};
    for (int i = 0; i < 28; ++i) a.in[i] = (const float*)d_in[i];
    a.out = (float*)d_out; a.ws = (unsigned char*)d_ws;
    void* kargs[] = {&a};
    hipError_t e = hipLaunchCooperativeKernel((const void*)fwd_mega, dim3(grid), dim3(NT), kargs, LDS_BYTES, stream);
    if (e != hipSuccess) fprintf(stderr, "cooperative launch failed: %s (grid %d)\n", hipGetErrorString(e), grid);
}
```

```cpp
#include <hip/hip_runtime.h>
#include <hip/hip_cooperative_groups.h>
#include <cstdio>
#include <cstdint>
namespace cg = cooperative_groups;
#ifndef PROBE_REP
#define PROBE_REP -1
#endif
#ifndef EXPV
#define EXPV 0
#endif
#ifndef TSK
#define TSK -1
#endif
#define STAMP(i) do { if ((TSK) >= 0 && blockIdx.x == 0 && threadIdx.x == 0) ((unsigned long long*)(a.ws + 240 * 1024))[i] = __builtin_amdgcn_s_memrealtime(); } while (0)
#define ASTAMP(k) do { if ((TSK) >= 20 && blockIdx.x == 0 && threadIdx.x == 0) { const unsigned long long t_ = __builtin_amdgcn_s_memrealtime(); T.tsa[k] += t_ - T.tsa[15]; T.tsa[15] = t_; } } while (0)
#define REPS(k) _Pragma("nounroll") for (int rep_ = 0; rep_ < ((PROBE_REP) == (k) ? 2 : 1); ++rep_)
#define GSYNC() do { xcd_barrier(xbar); if ((PROBE_REP) == 100) xcd_barrier(xbar); } while (0)

#define LAS __attribute__((address_space(3)))
typedef unsigned short bf16_t;
typedef short bf16x8 __attribute__((ext_vector_type(8)));
typedef float f32x4 __attribute__((ext_vector_type(4)));
typedef float f32x2 __attribute__((ext_vector_type(2)));
typedef unsigned u32x4 __attribute__((ext_vector_type(4)));
typedef unsigned u32x2 __attribute__((ext_vector_type(2)));

constexpr int SEQ = 16384, DM = 1024, DIN = 3864, PP = 4096  , DFF = 2816, NUP = 5632;
constexpr int C_Q = 0, C_KC = 512, C_VC = 640, C_KSL = 768, C_VSL = 896, C_KWN = 1024, C_VWN = 1152, C_U = 1280, C_GA = 1792, C_GB = 2816, C_NG = 3840;
constexpr int VTP = SEQ + 64;
constexpr float EPS = 1e-6f;
constexpr float NEGF = -1e30f;

constexpr size_t MiB = 1u << 20;
constexpr size_t WS_RSTD1 = 0, WS_RSS2 = 64 * 1024, WS_RSS3 = 128 * 1024, WS_ROPEC = 256 * 1024, WS_ROPES = 768 * 1024;
constexpr size_t WS_ABAR = 1280 * 1024, WS_A128 = WS_ABAR + 16384, WS_BIASPE = WS_A128 + 16384, WS_BBAR = 1536 * 1024  ;
constexpr size_t WS_SBUF = 2 * MiB  , WS_HID = 4 * MiB  , WS_KCMP = 6 * MiB  , WS_VCMPT = 6 * MiB + 512 * 1024  ;
constexpr size_t WS_WUP = 8 * MiB, WS_WDOWN = 20 * MiB, WS_WIN = 26 * MiB, WS_WGLU = 34 * MiB, WS_WPA = 35 * MiB, WS_WPB = 36 * MiB, WS_WOUT = 37 * MiB, WS_W1K = 39 * MiB, WS_W1V = 40 * MiB;
constexpr size_t WS_XB = 41 * MiB, WS_MERGED = 41 * MiB, WS_PROJ = 73 * MiB, WS_VSLT = 202 * MiB + 512 * 1024, WS_VWNT = 207 * MiB;
constexpr size_t WS_X1B = 220 * MiB, WS_UPRAW = 26 * MiB, WS_ACT = 122 * MiB;
constexpr size_t WS_VMAX = 232 * 1024, WS_BAR = 192 * 1024, WS_KSL = 212 * MiB, WS_KWN = 216 * MiB;
constexpr size_t OUT_YA = 0, OUT_YBP = 16 * MiB, OUT_YB = 32 * MiB;
static_assert(WS_PROJ + (size_t)(SEQ + 32) * PP * 2 <= WS_VSLT, "proj");
static_assert(WS_VSLT + (size_t)128 * VTP * 2 + 4096 <= WS_VWNT && WS_VWNT + (size_t)128 * VTP * 2 + 4096 <= WS_X1B, "vt");
static_assert(WS_UPRAW + (size_t)33 * 256 * NUP * 2 <= WS_ACT && WS_ACT + (size_t)SEQ * DFF * 2 <= WS_X1B, "ffn");

__device__ __forceinline__ unsigned cvt_pk_bf16(float lo, float hi) { unsigned r; asm volatile("v_cvt_pk_bf16_f32 %0, %1, %2" : "=v"(r) : "v"(lo), "v"(hi)); return r; }
__device__ __forceinline__ float bf_lo(unsigned w) { return __uint_as_float(w << 16); }
__device__ __forceinline__ float bf_hi(unsigned w) { return __uint_as_float(w & 0xffff0000u); }
__device__ __forceinline__ float bf2f(bf16_t b) { return __uint_as_float((unsigned)b << 16); }
__device__ __forceinline__ float sigmoidf_(float v) { return 1.f / (1.f + __expf(-v)); }
__device__ __forceinline__ float gelu_tanh(float v) { const float z = 0.7978845608028654f * (v + 0.044715f * v * v * v); const float th = 1.f - 2.f / (__expf(2.f * z) + 1.f); return 0.5f * v * (1.f + th); }
__device__ __forceinline__ u32x4 pack8(f32x4 a, f32x4 b) { u32x4 w; w.x = cvt_pk_bf16(a[0], a[1]); w.y = cvt_pk_bf16(a[2], a[3]); w.z = cvt_pk_bf16(b[0], b[1]); w.w = cvt_pk_bf16(b[2], b[3]); return w; }

namespace pg8 {
#define PG8_LAS __attribute__((address_space(3)))
constexpr int BM = 256, BK = 64, HALF = 128, HTB = HALF * BK * 2, STAGE_BYTES = 8 * HTB, NXCD = 8, WGM = 8;
__host__ __device__ __forceinline__ int lds_byte(int r, int c) { const int st = (r >> 4) * 2 + (c >> 5), rr = r & 15, cc = c & 31, ob = rr * 64 + cc * 2; return st * 1024 + (ob ^ (((ob >> 9) & 1) << 5)); }
__host__ __device__ __forceinline__ void stage_rc(int b, int& R, int& C) { const int st = b / 1024, sb = b % 1024, swz = sb ^ (((sb >> 9) & 1) << 5); R = (st >> 1) * 16 + swz / 64; C = (st & 1) * 32 + (swz % 64) / 2; }
__host__ __device__ __forceinline__ int perm32(int rho) { const int n = rho >> 4, i = rho & 15; return 8 * (i >> 2) + 4 * n + (i & 3); }
struct Unit { int pm, pn, z; const char* A; const char* B; };
struct Gemm { int K; unsigned lda_b; unsigned kstepA; };
__device__ __forceinline__ bool tile_of(long L, int nM, int nN, int& pm, int& pn) {
    const int nwg = nM * nN; if (L >= nwg) return false;
    int wgid = (int)L; { const int q = nwg / NXCD, r = nwg % NXCD, xcd = wgid % NXCD, off = wgid / NXCD; wgid = (xcd < r ? xcd * (q + 1) : r * (q + 1) + (xcd - r) * q) + off; }
    const int nig = WGM * nN, gid = wgid / nig, fm = gid * WGM, gsz = (nM - fm) < WGM ? (nM - fm) : WGM;
    pm = fm + ((wgid % nig) % gsz); pn = (wgid % nig) / gsz; return true;
}
template <class Epi, class Sched, bool ALIGN_EPI = false, bool SP2 = false>
__device__ __forceinline__ void gemm_phase(PG8_LAS unsigned char* lds, const Gemm g, const Sched& S, const Epi& E) {
    int tid_ = threadIdx.x; asm volatile("" : "+v"(tid_));
    const int tid = tid_, wid = __builtin_amdgcn_readfirstlane(tid >> 6), lane = tid & 63, wr = wid >> 2, wc = wid & 3, fr = lane & 15, fq = lane >> 4;
    const int K = g.K, nt = K / BK;
    unsigned voffA[2], voffB[2];
#pragma unroll
    for (int i = 0; i < 2; ++i) { int R, C; stage_rc(tid * 16 + i * 8192, R, C); const int Rb = Epi::PERM ? ((R & ~31) + perm32(R & 31)) : R;
        voffA[i] = (unsigned)R * g.lda_b + (unsigned)C * 2u; voffB[i] = (unsigned)(Rb * K + C) * 2u; }
    const size_t kstepA = (size_t)g.kstepA, kstepB = (size_t)(BK * 2);
    const size_t hstepA = (size_t)HALF * g.lda_b, hstepB = (size_t)HALF * K * 2;
    const unsigned ldsw = (unsigned)wid * 1024u;
    const int aoff = lds_byte(wr * 64 + fr, fq * 8), boff = lds_byte(wc * 32 + fr, fq * 8);
#define PG8_SA(b, h) (((b) * 2 + (h)) * HTB)
#define PG8_SB(b, h) ((4 + (b) * 2 + (h)) * HTB)
#define PG8_STAGE(bufoff, gbase, voff) do { _Pragma("unroll") for (int _i = 0; _i < 2; ++_i) \
        __builtin_amdgcn_global_load_lds((const unsigned*)((const char*)(gbase) + (voff)[_i]), (PG8_LAS unsigned*)(lds + (bufoff) + ldsw + _i * 8192), 16, 0, 0); } while (0)
#define PG8_LDA(dst, b, h) do { _Pragma("unroll") for (int m = 0; m < 4; ++m) _Pragma("unroll") for (int k = 0; k < 2; ++k) dst[m][k] = *(const PG8_LAS bf16x8*)(lds + PG8_SA(b, h) + aoff + m * 2048 + k * 1024); } while (0)
#define PG8_LDB(dst, b, h) do { _Pragma("unroll") for (int n = 0; n < 2; ++n) _Pragma("unroll") for (int k = 0; k < 2; ++k) dst[n][k] = *(const PG8_LAS bf16x8*)(lds + PG8_SB(b, h) + boff + n * 2048 + k * 1024); } while (0)
#define PG8_MMA(ai, bj, At, Bt) do { __builtin_amdgcn_s_setprio(1); _Pragma("unroll") for (int m = 0; m < 4; ++m) _Pragma("unroll") for (int n = 0; n < 2; ++n) _Pragma("unroll") for (int k = 0; k < 2; ++k) \
        acc[ai][bj][m][n] = __builtin_amdgcn_mfma_f32_16x16x32_bf16(Bt[n][k], At[m][k], acc[ai][bj][m][n], 0, 0, 0); __builtin_amdgcn_s_setprio(0); } while (0)
#define PG8_WAIT_V(n) asm volatile("s_waitcnt vmcnt(" #n ")" ::: "memory")
#define PG8_WAIT_L(n) asm volatile("s_waitcnt lgkmcnt(" #n ")" ::: "memory")
#define PG8_BAR __builtin_amdgcn_s_barrier()
#define PG8_SCHED __builtin_amdgcn_sched_barrier(0)
    Unit cur, nxt; int ui = 0;
    if (!S.next(0, cur)) return;
    f32x4 acc[2][2][4][2];
#pragma unroll
    for (int a = 0; a < 2; ++a)
#pragma unroll
        for (int b = 0; b < 2; ++b)
#pragma unroll
            for (int m = 0; m < 4; ++m)
#pragma unroll
                for (int n = 0; n < 2; ++n) acc[a][b][m][n] = (f32x4){0.f, 0.f, 0.f, 0.f};
    bf16x8 At[4][2], B0[2][2], B1[2][2];
    const char* cA = cur.A; const char* cB = cur.B;
    if constexpr (SP2) {
        PG8_STAGE(PG8_SB(0, 0), cB, voffB); PG8_STAGE(PG8_SB(0, 1), cB + hstepB, voffB); PG8_STAGE(PG8_SA(0, 0), cA, voffA); PG8_STAGE(PG8_SA(0, 1), cA + hstepA, voffA);
        if (wr == 1) PG8_BAR;
        PG8_WAIT_V(2); PG8_BAR;
        PG8_STAGE(PG8_SB(1, 0), cB + kstepB, voffB); PG8_STAGE(PG8_SA(1, 0), cA + kstepA, voffA); PG8_STAGE(PG8_SB(1, 1), cB + hstepB + kstepB, voffB);
        PG8_WAIT_V(6); PG8_BAR;
    } else {
        PG8_STAGE(PG8_SB(0, 0), cB, voffB); PG8_STAGE(PG8_SA(0, 0), cA, voffA); PG8_STAGE(PG8_SB(0, 1), cB + hstepB, voffB); PG8_STAGE(PG8_SA(0, 1), cA + hstepA, voffA);
        if (wr == 1) PG8_BAR;
        PG8_WAIT_V(4); PG8_BAR;
        PG8_STAGE(PG8_SB(1, 0), cB + kstepB, voffB); PG8_STAGE(PG8_SA(1, 0), cA + kstepA, voffA); PG8_STAGE(PG8_SB(1, 1), cB + hstepB + kstepB, voffB);
        PG8_WAIT_V(6); PG8_BAR;
    }
    for (;;) {
        const bool has_next = S.next(ui + 1, nxt);
        const char* nA = has_next ? nxt.A : cA; const char* nB = has_next ? nxt.B : cB;
        for (int t = 0; t < nt; t += 2) {
            const bool last = (t == nt - 2);
            const char* a1 = cA + (size_t)(t + 1) * kstepA;
            const char* a2 = last ? nA : cA + (size_t)(t + 2) * kstepA; const char* b2 = last ? nB : cB + (size_t)(t + 2) * kstepB;
            const char* a3 = a2 + kstepA; const char* b3 = b2 + kstepB;
            if constexpr (SP2) {
            PG8_LDB(B0, 0, 0); PG8_LDB(B1, 0, 1); PG8_SCHED; PG8_LDA(At, 0, 0); PG8_STAGE(PG8_SA(1, 1), a1 + hstepA, voffA);
            PG8_WAIT_V(8); PG8_WAIT_L(0); PG8_BAR; PG8_MMA(0, 0, At, B0); PG8_MMA(0, 1, At, B1); PG8_BAR; PG8_SCHED;
            PG8_LDA(At, 0, 1); PG8_STAGE(PG8_SB(0, 0), b2, voffB); PG8_STAGE(PG8_SB(0, 1), b2 + hstepB, voffB); PG8_STAGE(PG8_SA(0, 0), a2, voffA);
            PG8_WAIT_V(8); PG8_WAIT_L(0); PG8_BAR; PG8_MMA(1, 0, At, B0); PG8_MMA(1, 1, At, B1); PG8_BAR; PG8_SCHED;
            PG8_LDB(B0, 1, 0); PG8_LDB(B1, 1, 1); PG8_SCHED; PG8_LDA(At, 1, 0); PG8_STAGE(PG8_SA(0, 1), a2 + hstepA, voffA);
            PG8_WAIT_V(8); PG8_WAIT_L(0); PG8_BAR; PG8_MMA(0, 0, At, B0); PG8_MMA(0, 1, At, B1); PG8_BAR; PG8_SCHED;
            PG8_LDA(At, 1, 1); PG8_STAGE(PG8_SB(1, 0), b3, voffB); PG8_STAGE(PG8_SB(1, 1), b3 + hstepB, voffB); PG8_STAGE(PG8_SA(1, 0), a3, voffA);
            PG8_WAIT_V(8); PG8_WAIT_L(0); PG8_BAR; PG8_MMA(1, 0, At, B0); PG8_MMA(1, 1, At, B1); PG8_BAR; PG8_SCHED;
            } else {
            PG8_LDB(B0, 0, 0); PG8_SCHED; PG8_LDA(At, 0, 0); PG8_STAGE(PG8_SA(1, 1), a1 + hstepA, voffA);
            PG8_WAIT_L(8); PG8_BAR; PG8_WAIT_L(0); PG8_MMA(0, 0, At, B0); PG8_BAR; PG8_SCHED;
            PG8_LDB(B1, 0, 1); PG8_STAGE(PG8_SB(0, 0), b2, voffB);
            PG8_BAR; PG8_WAIT_L(0); PG8_MMA(0, 1, At, B1); PG8_BAR;
            PG8_LDA(At, 0, 1); PG8_STAGE(PG8_SA(0, 0), a2, voffA);
            PG8_BAR; PG8_WAIT_L(0); PG8_MMA(1, 0, At, B0); PG8_BAR; PG8_SCHED;
            PG8_STAGE(PG8_SB(0, 1), b2 + hstepB, voffB);
            PG8_WAIT_V(6); PG8_BAR; PG8_MMA(1, 1, At, B1); PG8_BAR;
            PG8_LDB(B0, 1, 0); PG8_SCHED; PG8_LDA(At, 1, 0); PG8_STAGE(PG8_SA(0, 1), a2 + hstepA, voffA);
            PG8_WAIT_L(8); PG8_BAR; PG8_WAIT_L(0); PG8_MMA(0, 0, At, B0); PG8_BAR; PG8_SCHED;
            PG8_LDB(B1, 1, 1); PG8_STAGE(PG8_SB(1, 0), b3, voffB);
            PG8_BAR; PG8_WAIT_L(0); PG8_MMA(0, 1, At, B1); PG8_BAR;
            PG8_LDA(At, 1, 1); PG8_STAGE(PG8_SA(1, 0), a3, voffA);
            PG8_BAR; PG8_WAIT_L(0); PG8_MMA(1, 0, At, B0); PG8_BAR; PG8_SCHED;
            PG8_STAGE(PG8_SB(1, 1), b3 + hstepB, voffB);
            PG8_WAIT_V(6); PG8_BAR; PG8_MMA(1, 1, At, B1); PG8_BAR;
            }
        }
        if constexpr (ALIGN_EPI) { if (wr == 0) PG8_BAR; }
        E(acc, cur, wr, wc, fr, fq);
        if (!has_next) break;
#pragma unroll
        for (int a = 0; a < 2; ++a)
#pragma unroll
            for (int b = 0; b < 2; ++b)
#pragma unroll
                for (int m = 0; m < 4; ++m)
#pragma unroll
                    for (int n = 0; n < 2; ++n) acc[a][b][m][n] = (f32x4){0.f, 0.f, 0.f, 0.f};
        cur = nxt; cA = nA; cB = nB; ++ui;
        if constexpr (ALIGN_EPI) { if (wr == 1) PG8_BAR; }
    }
    PG8_WAIT_V(0);
    if constexpr (!ALIGN_EPI) { if (wr == 0) PG8_BAR; }
    PG8_BAR;
#undef PG8_SA
#undef PG8_SB
#undef PG8_STAGE
#undef PG8_LDA
#undef PG8_LDB
#undef PG8_MMA
#undef PG8_WAIT_V
#undef PG8_WAIT_L
#undef PG8_BAR
#undef PG8_SCHED
}
}


struct SchedMN {
    int nM, nN, nz, G, c, pm_off; const char* A0; const char* A1; const char* B0; const char* B1; size_t a_tile, b_tile;
    __device__ __forceinline__ bool next(int i, pg8::Unit& u) const {
        int pm, pn; if (!pg8::tile_of((long)(i / nz) * G + c, nM, nN, pm, pn)) return false;
        u.z = i % nz; u.pm = pm + pm_off; u.pn = pn; u.A = (u.z ? A1 : A0) + (size_t)u.pm * a_tile; u.B = (u.z ? B1 : B0) + (size_t)pn * b_tile; return true;
    }
};
struct SchedCmp {
    int c; const char* proj; const char* w1k; const char* w1v;
    __device__ __forceinline__ bool next(int i, pg8::Unit& u) const {
        if (i > ((PROBE_REP) == 22 ? 1 : 0) || c >= 16) return false;
        u.z = c >> 2; u.pm = c & 3; u.pn = 0; const int which = u.z >> 1, kh = u.z & 1;
        u.A = proj + ((size_t)(16 * 256 * u.pm) * PP + (which ? C_VC : C_KC) + kh * 64) * 2; u.B = which ? w1v : w1k; return true;
    }
};

#define EPI_LOOP_ROWS for (int ai = 0; ai < 2; ++ai) _Pragma("unroll") for (int m = 0; m < 4; ++m)

struct EpiProj {
    static constexpr bool PERM = true;
    bf16_t* proj; bf16_t* vslt; bf16_t* vwnt; bf16_t* kslc; bf16_t* kwnc; const float* rstd; const float* ropec; const float* ropes;
    __device__ __forceinline__ void operator()(const f32x4 (&acc)[2][2][4][2], const pg8::Unit& u, int wr, int wc, int fr, int fq) const {
        const int pn = u.pn; const int row0 = u.pm * 256 + wr * 64 + fr;
        const bool sig = pn >= 7;
#pragma unroll
        EPI_LOOP_ROWS {
            const int row = row0 + ai * 128 + m * 16; const float rs = rstd[row];
            f32x4 c0 = {1.f, 1.f, 1.f, 1.f}, c1 = c0, s0 = {0.f, 0.f, 0.f, 0.f}, s1 = s0;
            if ((pn <= 1 || pn == 3 || pn == 4) && (wc & 1) == 0) { c0 = *(const f32x4*)(ropec + row * 8); c1 = *(const f32x4*)(ropec + row * 8 + 4); s0 = *(const f32x4*)(ropes + row * 8); s1 = *(const f32x4*)(ropes + row * 8 + 4); }
#pragma unroll
            for (int bj = 0; bj < 2; ++bj) {
                f32x4 v0 = acc[ai][bj][m][0] * rs, v1 = acc[ai][bj][m][1] * rs;
                const int colt = bj * 128 + wc * 32 + 8 * fq;
                const bool ropet = (pn <= 1) || ((pn == 3 || pn == 4) && bj == 0);
                if (ropet && (wc & 1) == 0) {
                    f32x4 p0, p1;
#pragma unroll
                    for (int e = 0; e < 4; ++e) { p0[e] = __shfl_xor(v0[e], 16); p1[e] = __shfl_xor(v1[e], 16); }
                    if (fq == 0) { v0 = v0 * c0 - p0 * s0; v1 = v1 * c1 - p1 * s1; }
                    else if (fq == 1) { v0 = v0 * c0 + p0 * s0; v1 = v1 * c1 + p1 * s1; }
                }
                if (pn <= 1) { v0 = v0 * (0.125f * 1.4426950408889634f); v1 = v1 * (0.125f * 1.4426950408889634f); }
                if (sig) {
#pragma unroll
                    for (int e = 0; e < 4; ++e) { v0[e] = sigmoidf_(v0[e]); v1[e] = sigmoidf_(v1[e]); }
                }
                const u32x4 w = pack8(v0, v1);
                if (!((pn == 3 || pn == 4))) *(u32x4*)(proj + (size_t)row * PP + pn * 256 + colt) = w;
                if ((pn == 3 || pn == 4) && bj == 0) { bf16_t* kc = (pn == 3) ? kslc : kwnc; *(u32x4*)(kc + ((size_t)(colt >> 6) * SEQ + row) * 64 + (colt & 63)) = w; }
                if ((pn == 3 || pn == 4) && bj == 1) {
                    bf16_t* vt = ((pn == 3) ? vslt : vwnt) + ((size_t)((colt - 128) >> 6) * 256 + (row >> 6)) * 4096 + (size_t)((colt - 128) & 63) * 64 + (row & 63);
                    vt[0 * 64] = (bf16_t)(w.x & 0xffff); vt[1 * 64] = (bf16_t)(w.x >> 16); vt[2 * 64] = (bf16_t)(w.y & 0xffff); vt[3 * 64] = (bf16_t)(w.y >> 16);
                    vt[4 * 64] = (bf16_t)(w.z & 0xffff); vt[5 * 64] = (bf16_t)(w.z >> 16); vt[6 * 64] = (bf16_t)(w.w & 0xffff); vt[7 * 64] = (bf16_t)(w.w >> 16);
                }
            }
        }
    }
};

struct EpiCmp {
    static constexpr bool PERM = true;
    bf16_t* hid; const float* biaspe;
    __device__ __forceinline__ void operator()(const f32x4 (&acc)[2][2][4][2], const pg8::Unit& u, int wr, int wc, int fr, int fq) const {
        const int row0 = u.pm * 256 + wr * 64 + fr; const int which = u.z >> 1;
#pragma unroll
        for (int bj = 0; bj < 2; ++bj) {
            const int col = bj * 128 + wc * 32 + 8 * fq;
            const f32x4 b0 = *(const f32x4*)(biaspe + which * 256 + col), b1 = *(const f32x4*)(biaspe + which * 256 + col + 4);
#pragma unroll
            EPI_LOOP_ROWS {
                const int row = row0 + ai * 128 + m * 16;
                f32x4 v0 = acc[ai][bj][m][0] + b0, v1 = acc[ai][bj][m][1] + b1;
#pragma unroll
                for (int e = 0; e < 4; ++e) { v0[e] = gelu_tanh(v0[e]); v1[e] = gelu_tanh(v1[e]); }
                *(u32x4*)(hid + ((size_t)u.z * 1024 + row) * 256 + col) = pack8(v0, v1);
            }
        }
    }
};

struct EpiGlu {
    static constexpr bool PERM = true;
    const bf16_t* ybp; bf16_t* yb;
    __device__ __forceinline__ void operator()(const f32x4 (&acc)[2][2][4][2], const pg8::Unit& u, int wr, int wc, int fr, int fq) const {
        const int row0 = u.pm * 256 + wr * 64 + fr;
#pragma unroll
        EPI_LOOP_ROWS {
            const int row = row0 + ai * 128 + m * 16;
#pragma unroll
            for (int bj = 0; bj < 2; ++bj) {
                const size_t off = (size_t)row * 512 + u.pn * 256 + bj * 128 + wc * 32 + 8 * fq;
                const u32x4 y = *(const u32x4*)(ybp + off);
                f32x4 v0 = acc[ai][bj][m][0], v1 = acc[ai][bj][m][1];
                v0[0] = bf_lo(y.x) * sigmoidf_(v0[0]); v0[1] = bf_hi(y.x) * sigmoidf_(v0[1]); v0[2] = bf_lo(y.y) * sigmoidf_(v0[2]); v0[3] = bf_hi(y.y) * sigmoidf_(v0[3]);
                v1[0] = bf_lo(y.z) * sigmoidf_(v1[0]); v1[1] = bf_hi(y.z) * sigmoidf_(v1[1]); v1[2] = bf_lo(y.w) * sigmoidf_(v1[2]); v1[3] = bf_hi(y.w) * sigmoidf_(v1[3]);
                *(u32x4*)(yb + off) = pack8(v0, v1);
            }
        }
    }
};

struct EpiMerge {
    static constexpr bool PERM = true;
    const bf16_t* proj; bf16_t* merged;
    __device__ __forceinline__ void operator()(const f32x4 (&acc)[2][2][4][2], const pg8::Unit& u, int wr, int wc, int fr, int fq) const {
        const int row0 = u.pm * 256 + wr * 64 + fr; const int gcol = u.z ? C_GB : C_GA;
#pragma unroll
        EPI_LOOP_ROWS {
            const int row = row0 + ai * 128 + m * 16;
#pragma unroll
            for (int bj = 0; bj < 2; ++bj) {
                const int col = u.pn * 256 + bj * 128 + wc * 32 + 8 * fq;
                const u32x4 gt = *(const u32x4*)(proj + (size_t)row * PP + gcol + col);
                f32x4 v0 = acc[ai][bj][m][0], v1 = acc[ai][bj][m][1];
                v0[0] *= bf_lo(gt.x); v0[1] *= bf_hi(gt.x); v0[2] *= bf_lo(gt.y); v0[3] *= bf_hi(gt.y);
                v1[0] *= bf_lo(gt.z); v1[1] *= bf_hi(gt.z); v1[2] *= bf_lo(gt.w); v1[3] *= bf_hi(gt.w);
                bf16_t* dst = merged + (size_t)row * DM + col;
                if (u.z) { const u32x4 o = *(const u32x4*)dst;
                    v0[0] += bf_lo(o.x); v0[1] += bf_hi(o.x); v0[2] += bf_lo(o.y); v0[3] += bf_hi(o.y); v1[0] += bf_lo(o.z); v1[1] += bf_hi(o.z); v1[2] += bf_lo(o.w); v1[3] += bf_hi(o.w); }
                *(u32x4*)dst = pack8(v0, v1);
            }
        }
    }
};

struct EpiRes {
    static constexpr bool PERM = true;
    const float* xin; float* xo; bf16_t* xb; float* rss;
    __device__ __forceinline__ void operator()(const f32x4 (&acc)[2][2][4][2], const pg8::Unit& u, int wr, int wc, int fr, int fq) const {
        const int row0 = u.pm * 256 + wr * 64 + fr;
#pragma unroll
        EPI_LOOP_ROWS {
            const int row = row0 + ai * 128 + m * 16; float ss = 0.f;
#pragma unroll
            for (int bj = 0; bj < 2; ++bj) {
                const size_t off = (size_t)row * DM + u.pn * 256 + bj * 128 + wc * 32 + 8 * fq;
                const f32x4 v0 = *(const f32x4*)(xin + off) + acc[ai][bj][m][0], v1 = *(const f32x4*)(xin + off + 4) + acc[ai][bj][m][1];
                *(f32x4*)(xo + off) = v0; *(f32x4*)(xo + off + 4) = v1;
                if (xb) *(u32x4*)(xb + off) = pack8(v0, v1);
                ss += (v0[0] * v0[0] + v0[1] * v0[1]) + (v0[2] * v0[2] + v0[3] * v0[3]) + (v1[0] * v1[0] + v1[1] * v1[1]) + (v1[2] * v1[2] + v1[3] * v1[3]);
            }
            ss += __shfl_xor(ss, 16); ss += __shfl_xor(ss, 32);
            if (fq == 0) atomicAdd(rss + row, ss);
        }
    }
};

struct EpiUp {
    static constexpr bool PERM = true;
    bf16_t* up; const float* rss; int rowbase;
    __device__ __forceinline__ void operator()(const f32x4 (&acc)[2][2][4][2], const pg8::Unit& u, int wr, int wc, int fr, int fq) const {
        const int row0 = u.pm * 256 + wr * 64 + fr;
#pragma unroll
        EPI_LOOP_ROWS {
            const int row = row0 + ai * 128 + m * 16; const float rs = rsqrtf(rss[row] * (1.f / DM) + EPS);
#pragma unroll
            for (int bj = 0; bj < 2; ++bj) {
                const size_t off = (size_t)(row - rowbase) * NUP + u.pn * 256 + bj * 128 + wc * 32 + 8 * fq;
                *(u32x4*)(up + off) = pack8(acc[ai][bj][m][0] * rs, acc[ai][bj][m][1] * rs);
            }
        }
    }
};

struct Args { const float* in[28]; float* out; unsigned char* ws; };
constexpr int NT = 512, NWV = 8;
constexpr int LDS_BYTES = 147456;

__device__ __forceinline__ float wave_sum(float v) {
#pragma unroll
    for (int o = 1; o < 64; o <<= 1) v += __shfl_xor(v, o);
    return v;
}

#define XB_TMO      128
#define XB_XCNT(j)  (256  + 64 * (j))
#define XB_XSUB(j)  (1280 + 64 * (j))
#define XB_XGEN(j)  (2304 + 64 * (j))
#define XB_TOP      3328
#define XB_TOPGEN   3392
#define XCD_BAR_WORDS 3456
#define XB_SPIN_CAP (1u << 18)

__device__ __forceinline__ unsigned xb_ld(unsigned* p)              { return __hip_atomic_load(p, __ATOMIC_RELAXED, __HIP_MEMORY_SCOPE_AGENT); }
__device__ __forceinline__ unsigned xb_add(unsigned* p, unsigned v) { return __hip_atomic_fetch_add(p, v, __ATOMIC_RELAXED, __HIP_MEMORY_SCOPE_AGENT); }
__device__ __forceinline__ unsigned xb_xcc_id() { return (unsigned)__builtin_amdgcn_s_getreg((3 << 11) | 20) & 0xFu; }
#define XB_SPIN(cond, bar) do { unsigned _sp = 0; while (cond) { __builtin_amdgcn_s_sleep(1); \
    if ((++_sp & 255u) == 0u) { if (xb_ld(&(bar)[XB_TMO])) break; if (_sp > XB_SPIN_CAP) { atomicAdd(&(bar)[XB_TMO], 1u); break; } } } } while (0)

struct XcdBarrier {
    unsigned* bar; unsigned x;
    volatile LAS unsigned* st;
};

__device__ __forceinline__ XcdBarrier xcd_barrier_post(unsigned* bar, volatile LAS unsigned* st) {
    XcdBarrier b; b.bar = bar; b.x = xb_xcc_id(); b.st = st;
    if (threadIdx.x == 0) (void)xb_add(&bar[XB_XCNT(b.x)], 1u);
    return b;
}
__device__ __forceinline__ void xcd_barrier_complete(unsigned* bar, unsigned x, unsigned& nloc, unsigned& nx) {
    const unsigned G = gridDim.x * gridDim.y * gridDim.z;
    unsigned sum, cnt, mine, sp = 0u;
    for (;;) {
        sum = 0u; cnt = 0u; mine = 0u;
#pragma unroll
        for (unsigned j = 0; j < 16; ++j) { const unsigned c = xb_ld(&bar[XB_XCNT(j)]); sum += c; cnt += (c > 0u) ? 1u : 0u; mine = (j == x) ? c : mine; }
        if (sum == G) break;
        __builtin_amdgcn_s_sleep(1);
        if ((++sp & 255u) == 0u) { if (xb_ld(&bar[XB_TMO])) break; if (sp > XB_SPIN_CAP) { atomicAdd(&bar[XB_TMO], 1u); break; } }
    }
    nloc = mine > 0u ? mine : 1u; nx = cnt > 0u ? cnt : 1u;
}

__device__ __forceinline__ void xcd_barrier(const XcdBarrier& b) {
    asm volatile("s_waitcnt vmcnt(0)" ::: "memory");
    __syncthreads();
    if (threadIdx.x == 0) {
        unsigned* bar = b.bar;
        __builtin_amdgcn_s_waitcnt(0);
        unsigned nloc = b.st[0], nx = b.st[1];
        if (nloc == 0u) { xcd_barrier_complete(bar, b.x, nloc, nx); b.st[0] = nloc; b.st[1] = nx; }
        const unsigned old = xb_add(&bar[XB_XSUB(b.x)], 1u);
        const unsigned gen = old / nloc;
        if (old + 1u == (gen + 1u) * nloc) {
            __builtin_amdgcn_fence(__ATOMIC_RELEASE, "agent");
            asm volatile("s_waitcnt vmcnt(0)" ::: "memory");
            const unsigned og = xb_add(&bar[XB_TOP], 1u);
            const unsigned tg = og / nx;
            if (og + 1u == (tg + 1u) * nx) xb_add(&bar[XB_TOPGEN], 1u);
            else XB_SPIN(xb_ld(&bar[XB_TOPGEN]) == tg, bar);
            __builtin_amdgcn_fence(__ATOMIC_ACQUIRE, "agent");
            xb_add(&bar[XB_XGEN(b.x)], 1u);
            asm volatile("s_waitcnt vmcnt(0)" ::: "memory");
        } else {
            XB_SPIN(xb_ld(&bar[XB_XGEN(b.x)]) == gen, bar);
            __builtin_amdgcn_fence(__ATOMIC_ACQUIRE, "agent");
            asm volatile("s_waitcnt vmcnt(0)" ::: "memory");
        }
    }
    __syncthreads();
}

__device__ __forceinline__ int colmap(int kind, int c) {
    if (kind == 1) return c < 1280 ? c : (c < 1304 ? C_NG + (c - 1280) : c - 24);
    if (kind == 2) { return c < DFF ? (c >> 7) * 256 + (c & 127) : ((c - DFF) >> 7) * 256 + 128 + ((c - DFF) & 127); }
    return c;
}
__device__ __forceinline__ void transpose_item(const float* W, int K, int N, bf16_t* WT, LAS float* scr, int kb, int nb, int lane, const float* kscale, int kind) {
    const int k0 = 64 * kb, n0 = 32 * nb;
#pragma unroll 8
    for (int i = 0; i < 32; ++i) { const int kk = 2 * i + (lane >> 5), n = n0 + (lane & 31); float v = (n < N) ? W[(size_t)(k0 + kk) * N + n] : 0.f; if (kscale) v *= kscale[k0 + kk]; scr[kk * 33 + (lane & 31)] = v; }
    asm volatile("s_waitcnt lgkmcnt(0)" ::: "memory");
    const int c = lane & 7;
#pragma unroll
    for (int j = 0; j < 4; ++j) { const int n = (lane >> 3) + 8 * j; const LAS float* s = scr + (8 * c) * 33 + n;
        if (n0 + n < N) { u32x4 o; o.x = cvt_pk_bf16(s[0 * 33], s[1 * 33]); o.y = cvt_pk_bf16(s[2 * 33], s[3 * 33]); o.z = cvt_pk_bf16(s[4 * 33], s[5 * 33]); o.w = cvt_pk_bf16(s[6 * 33], s[7 * 33]);
            *(u32x4*)(WT + (size_t)colmap(kind, n0 + n) * K + k0 + 8 * c) = o; } }
    asm volatile("s_waitcnt lgkmcnt(0)" ::: "memory");
}

#define EXP2(x) __builtin_amdgcn_exp2f(x)
#define MFMA16(a, b, c) __builtin_amdgcn_mfma_f32_16x16x32_bf16((a), (b), (c), 0, 0, 0)
__device__ __forceinline__ float dpp_x1(float v) { return __int_as_float(__builtin_amdgcn_update_dpp(0, __float_as_int(v), 0xB1, 0xF, 0xF, true)); }
__device__ __forceinline__ float dpp_x2(float v) { return __int_as_float(__builtin_amdgcn_update_dpp(0, __float_as_int(v), 0x4E, 0xF, 0xF, true)); }
struct KOp { bf16x8 a00, a01, a10, a11; };
struct VOp { bf16x8 v0, v1, v2, v3; };
__device__ __forceinline__ KOp ldk(const bf16_t* Kb, size_t pitch, int kb, int lane) {
    const int i = lane & 15, q = lane >> 4;
    const bf16_t* r0 = Kb + (size_t)(kb + 8 * (i >> 2) + (i & 3)) * pitch + 8 * q; const bf16_t* r1 = r0 + 4 * pitch;
    KOp k; k.a00 = *(const bf16x8*)r0; k.a01 = *(const bf16x8*)(r0 + 32); k.a10 = *(const bf16x8*)r1; k.a11 = *(const bf16x8*)(r1 + 32); return k;
}
__device__ __forceinline__ VOp ldv(const bf16_t* Vt, size_t vpitch, int kb, int lane) {
    const int i = lane & 15, q = lane >> 4; const size_t base = (vpitch == 64) ? (size_t)(kb >> 6) * 4096 + (kb & 63) : (size_t)kb;
    const bf16_t* r = Vt + base + (size_t)i * vpitch + 8 * q;
    VOp v; v.v0 = *(const bf16x8*)r; v.v1 = *(const bf16x8*)(r + 16 * vpitch); v.v2 = *(const bf16x8*)(r + 32 * vpitch); v.v3 = *(const bf16x8*)(r + 48 * vpitch); return v;
}
__device__ __forceinline__ void qk32(const KOp& k, const bf16x8& Bq0, const bf16x8& Bq1, f32x4& S0, f32x4& S1) {
    const f32x4 z = {0.f, 0.f, 0.f, 0.f};
    S0 = MFMA16(k.a00, Bq0, z); S0 = MFMA16(k.a01, Bq1, S0); S1 = MFMA16(k.a10, Bq0, z); S1 = MFMA16(k.a11, Bq1, S1);
}
__device__ __forceinline__ void pv32(const VOp& v, const bf16x8& P, f32x4 (&O)[4]) {
    O[0] = MFMA16(v.v0, P, O[0]); O[1] = MFMA16(v.v1, P, O[1]); O[2] = MFMA16(v.v2, P, O[2]); O[3] = MFMA16(v.v3, P, O[3]);
}
__device__ __forceinline__ bf16x8 packP(const f32x4& p0, const f32x4& p1) { u32x4 w = pack8(p0, p1); return __builtin_bit_cast(bf16x8, w); }

struct KbLin { int base; __device__ __forceinline__ int operator()(int i) const { return base + 32 * i; } };
struct KbLds { const LAS int* l; __device__ __forceinline__ int operator()(int i) const { return l[i]; } };

template <bool NEEDV, class KB, class Body>
__device__ __forceinline__ void pipe3(int n, const KB kbf, Body& body, const bf16_t* Kb, size_t kp, const bf16_t* Vt, size_t vp, int lane) {
    if (n <= 0) return;
    KOp k0, k1; VOp v;
    k0 = ldk(Kb, kp, kbf(0), lane);
    for (int i = 0; i < n; i += 2) {
        { const int kb = kbf(i); if (NEEDV) v = ldv(Vt, vp, kb, lane); k1 = ldk(Kb, kp, kbf(i + 1 < n ? i + 1 : n - 1), lane); body.run(kb, k0, v); }
        if (i + 1 >= n) break;
        { const int kb = kbf(i + 1); if (NEEDV) v = ldv(Vt, vp, kb, lane); k0 = ldk(Kb, kp, kbf(i + 2 < n ? i + 2 : n - 1), lane); body.run(kb, k1, v); }
    }
}

struct BodyCmp1 {
    bf16x8 Bq[2][2]; int nv[2], q; float ml[2], ll[2];
    __device__ __forceinline__ void run(int kb, const KOp& k, const VOp&) {
#pragma unroll
        for (int cg = 0; cg < 2; ++cg) {
            f32x4 S0, S1; qk32(k, Bq[cg][0], Bq[cg][1], S0, S1);
            const int k0 = kb + 8 * q; float mloc = NEGF;
#pragma unroll
            for (int e = 0; e < 4; ++e) { if (k0 + e >= nv[cg]) S0[e] = NEGF; if (k0 + 4 + e >= nv[cg]) S1[e] = NEGF; mloc = fmaxf(mloc, fmaxf(S0[e], S1[e])); }
            const float mn = fmaxf(ml[cg], mloc); float ps = 0.f;
#pragma unroll
            for (int e = 0; e < 4; ++e) { ps += (k0 + e < nv[cg]) ? EXP2(S0[e] - mn) : 0.f; ps += (k0 + 4 + e < nv[cg]) ? EXP2(S1[e] - mn) : 0.f; }
            ll[cg] = ll[cg] * EXP2(ml[cg] - mn) + ps; ml[cg] = mn;
        }
    }
};
struct BodyCmp2 {
    bf16x8 Bq[2][2]; int nv[2], q, g, lane_; float mc[2], inv[2], carry[2]; LAS float* ia[2]; f32x4 O[2][4];
    __device__ __forceinline__ void run(int kb, const KOp& k, const VOp& v) {
#pragma unroll
        for (int cg = 0; cg < 2; ++cg) {
            f32x4 S0, S1; qk32(k, Bq[cg][0], Bq[cg][1], S0, S1);
            const int k0 = kb + 8 * q; f32x4 p0, p1;
#pragma unroll
            for (int e = 0; e < 4; ++e) { p0[e] = (k0 + e < nv[cg]) ? EXP2(S0[e] - mc[cg]) * inv[cg] : 0.f; p1[e] = (k0 + 4 + e < nv[cg]) ? EXP2(S1[e] - mc[cg]) * inv[cg] : 0.f; }
            f32x4 s0 = p0, s1 = p1;
#pragma unroll
            for (int e = 0; e < 4; ++e) { s0[e] += dpp_x1(s0[e]); s0[e] += dpp_x2(s0[e]); s1[e] += dpp_x1(s1[e]); s1[e] += dpp_x2(s1[e]); }
            const float bout = 0.5f * s1[3]; const float recv = __shfl(bout, (lane_ + 48) & 63); const float bin = (q == 0) ? carry[cg] : recv; carry[cg] = recv;
            if (g == 0) { const int j = k0 >> 2; ia[cg][j] = ((s0[0] + s0[1]) + (s0[2] + 0.5f * s0[3])) + bin; ia[cg][j + 1] = 0.5f * s0[3] + ((s1[0] + s1[1]) + (s1[2] + 0.5f * s1[3])); }
            pv32(v, packP(p0, p1), O[cg]);
        }
    }
};
struct BodyWin {
    bf16x8 Bq[2][2]; int q, tt[2]; float m[2], l[2]; f32x4 O[2][4];
    __device__ __forceinline__ void run(int kb, const KOp& k, const VOp& v) {
#pragma unroll
        for (int cg = 0; cg < 2; ++cg) {
            f32x4 S0, S1; qk32(k, Bq[cg][0], Bq[cg][1], S0, S1);
            const int k0 = kb + 8 * q; unsigned vm = 0u;
#pragma unroll
            for (int e = 0; e < 8; ++e) { const bool ok = (k0 + e <= tt[cg]) && (tt[cg] - (k0 + e) < 512); vm |= ok ? (1u << e) : 0u; }
            float mloc = NEGF;
#pragma unroll
            for (int e = 0; e < 4; ++e) { if (!((vm >> e) & 1u)) S0[e] = NEGF; if (!((vm >> (4 + e)) & 1u)) S1[e] = NEGF; mloc = fmaxf(mloc, fmaxf(S0[e], S1[e])); }
            mloc = fmaxf(mloc, __shfl_xor(mloc, 16)); mloc = fmaxf(mloc, __shfl_xor(mloc, 32));
            const float mn = fmaxf(m[cg], mloc), alpha = EXP2(m[cg] - mn); m[cg] = mn;
            f32x4 p0, p1; float ps = 0.f;
#pragma unroll
            for (int e = 0; e < 4; ++e) { p0[e] = ((vm >> e) & 1u) ? EXP2(S0[e] - mn) : 0.f; p1[e] = ((vm >> (4 + e)) & 1u) ? EXP2(S1[e] - mn) : 0.f; ps += p0[e] + p1[e]; }
            l[cg] = l[cg] * alpha + ps;
#pragma unroll
            for (int dt = 0; dt < 4; ++dt) O[cg][dt] = O[cg][dt] * alpha;
            pv32(v, packP(p0, p1), O[cg]);
        }
    }
};

struct AttnT { float fxs; unsigned long long* tsa; const bf16_t* proj; const bf16_t* kslc; const bf16_t* kwnc; const bf16_t* kcmp; const bf16_t* vcmpT; const bf16_t* vslT; const bf16_t* vwnT; bf16_t* ya; };

constexpr int AL_IMP = 0  , AL_OS = 0  , AL_TM = 67584  , AL_CNT = 69632  ,
              AL_OFF = 70656  , AL_UNITS = 71744  , AL_MM = 77888  , AL_LS = 78912  ;
constexpr int AL_Q = 81920  , QROWB = 528;
constexpr int OSP = 33;
constexpr float FXB = 67108864.0f;
typedef short s16x2 __attribute__((ext_vector_type(2)));
__device__ __forceinline__ int f2ord(float f) { const int b = __float_as_int(f); return b >= 0 ? b : b ^ 0x7fffffff; }
__device__ __forceinline__ float ord2f(int b) { return __int_as_float(b >= 0 ? b : b ^ 0x7fffffff); }

__device__ __forceinline__ void attn_wave_part1(const AttnT& T, int kh, int tq8, int lane, LAS float* imp  , LAS unsigned* tm, int wave) {
    const int col = lane & 15, q = lane >> 4, tk = col >> 2, g = col & 3;
    const int t0 = tq8 * 8, h = kh * 4 + g;
    bf16x8 Bq[2][2]; float g0[2], g2[2]; int tcg[2];
#pragma unroll
    for (int cg = 0; cg < 2; ++cg) { tcg[cg] = t0 + 4 * cg + tk; const bf16_t* prow = T.proj + (size_t)tcg[cg] * PP;
        Bq[cg][0] = *(const bf16x8*)(prow + C_Q + h * 64 + 8 * q); Bq[cg][1] = *(const bf16x8*)(prow + C_Q + h * 64 + 32 + 8 * q);
        g0[cg] = bf2f(prow[C_NG + h * 3 + 0]); g2[cg] = bf2f(prow[C_NG + h * 3 + 2]); }
    for (int i = lane; i < 8 * 264; i += 64) imp[i] = 0.f;
    {
        const bf16_t* Kc = T.kcmp + (size_t)kh * 1024 * 64; const bf16_t* Vc = T.vcmpT + (size_t)kh * 64 * 1024;
        const int tmax = t0 + 7, nvmax = tmax >= 31 ? ((tmax - 31) >> 4) + 1 : 0, nsteps = (nvmax + 31) >> 5;
        BodyCmp1 b1;
#pragma unroll
        for (int cg = 0; cg < 2; ++cg) { b1.Bq[cg][0] = Bq[cg][0]; b1.Bq[cg][1] = Bq[cg][1]; b1.nv[cg] = tcg[cg] >= 31 ? ((tcg[cg] - 31) >> 4) + 1 : 0; b1.ml[cg] = NEGF; b1.ll[cg] = 0.f; }
        b1.q = q;
        pipe3<false>(nsteps, KbLin{0}, b1, Kc, 64, Vc, 1024, lane);
        BodyCmp2 b2; b2.q = q; b2.g = g; b2.lane_ = lane; b2.carry[0] = 0.f; b2.carry[1] = 0.f;
#pragma unroll
        for (int cg = 0; cg < 2; ++cg) {
            float mc = fmaxf(b1.ml[cg], __shfl_xor(b1.ml[cg], 16)); mc = fmaxf(mc, __shfl_xor(mc, 32));
            float lc = b1.ll[cg] * EXP2(b1.ml[cg] - mc); lc += __shfl_xor(lc, 16); lc += __shfl_xor(lc, 32);
            b2.Bq[cg][0] = Bq[cg][0]; b2.Bq[cg][1] = Bq[cg][1]; b2.nv[cg] = b1.nv[cg]; b2.mc[cg] = mc; b2.inv[cg] = 1.f / fmaxf(lc, 1e-30f); b2.ia[cg] = imp + (4 * cg + tk) * 264;
#pragma unroll
            for (int dt = 0; dt < 4; ++dt) b2.O[cg][dt] = (f32x4){0.f, 0.f, 0.f, 0.f};
        }
        asm volatile("s_waitcnt lgkmcnt(0)" ::: "memory");
        pipe3<true>(nsteps, KbLin{0}, b2, Kc, 64, Vc, 1024, lane);
        if (q == 0 && g == 0 && nsteps > 0) { b2.ia[0][8 * nsteps] = b2.carry[0]; b2.ia[1][8 * nsteps] = b2.carry[1]; }
#pragma unroll
        for (int cg = 0; cg < 2; ++cg) { bf16_t* yrow = T.ya + (size_t)tcg[cg] * 512 + h * 64 + 4 * q;
#pragma unroll
            for (int dt = 0; dt < 4; ++dt) { const f32x4 o = b2.O[cg][dt] * g0[cg]; u32x2 w; w.x = cvt_pk_bf16(o[0], o[1]); w.y = cvt_pk_bf16(o[2], o[3]); *(u32x2*)(yrow + 16 * dt) = w; } }
    }
    asm volatile("s_waitcnt lgkmcnt(0)" ::: "memory");
    for (int tk2 = 0; tk2 < 8; ++tk2) {
        const int tt = t0 + tk2, cur = tt >> 6, nvalid = cur + 1, KSEL = nvalid < 16 ? nvalid : 16;
        int bits[4];
#pragma unroll
        for (int s = 0; s < 4; ++s) { const int j = s * 64 + lane; const float v = imp[tk2 * 264 + j];
            bits[s] = (j == 0 || j == cur) ? 0x7F000000 : (j < nvalid ? __float_as_int(v) : -1); }
        int prefix = 0;
        for (int bit = 30; bit >= 0; --bit) { const int Tt = prefix | (1 << bit); int cnt = 0;
#pragma unroll
            for (int s = 0; s < 4; ++s) cnt += __popcll(__ballot(bits[s] >= Tt));
            if (cnt >= KSEL) prefix = Tt; }
        unsigned long long sel[4]; int need = KSEL;
#pragma unroll
        for (int s = 0; s < 4; ++s) { sel[s] = __ballot(bits[s] > prefix); need -= __popcll(sel[s]); }
#pragma unroll
        for (int s = 0; s < 4; ++s) { unsigned long long me = __ballot(bits[s] == prefix);
            while (me != 0ull && need > 0) { const unsigned long long low = me & (0ull - me); sel[s] |= low; me ^= low; --need; } }
        const int tbi = wave * 8 + tk2; const unsigned tbit = 1u << (tbi & 31);
#pragma unroll
        for (int s = 0; s < 4; ++s) if ((sel[s] >> lane) & 1ull) __hip_atomic_fetch_or(tm + (s * 64 + lane) * 2 + (tbi >> 5), tbit, __ATOMIC_RELAXED, __HIP_MEMORY_SCOPE_WORKGROUP);
    }
    {
        const bf16_t* Kw = T.kwnc + (size_t)kh * SEQ * 64; const bf16_t* Vw = T.vwnT + (size_t)kh * 256 * 4096;
        const int klo = (t0 - 511 > 0 ? t0 - 511 : 0) & ~31; const int n = ((t0 + 7 - klo) >> 5) + 1;
        BodyWin bo; bo.q = q;
#pragma unroll
        for (int cg = 0; cg < 2; ++cg) { bo.Bq[cg][0] = Bq[cg][0]; bo.Bq[cg][1] = Bq[cg][1]; bo.tt[cg] = tcg[cg]; bo.m[cg] = NEGF; bo.l[cg] = 0.f;
#pragma unroll
            for (int dt = 0; dt < 4; ++dt) bo.O[cg][dt] = (f32x4){0.f, 0.f, 0.f, 0.f}; }
        pipe3<true>(n, KbLin{klo}, bo, Kw, 64, Vw, 64, lane);
#pragma unroll
        for (int cg = 0; cg < 2; ++cg) { float l = bo.l[cg]; l += __shfl_xor(l, 16); l += __shfl_xor(l, 32);
            const float sc = g2[cg] / fmaxf(l, 1e-30f); bf16_t* yrow = T.ya + (size_t)tcg[cg] * 512 + h * 64 + 4 * q;
#pragma unroll
            for (int dt = 0; dt < 4; ++dt) { const u32x2 y = *(const u32x2*)(yrow + 16 * dt); const f32x4 o = bo.O[cg][dt] * sc;
                u32x2 w; w.x = cvt_pk_bf16(bf_lo(y.x) + o[0], bf_hi(y.x) + o[1]); w.y = cvt_pk_bf16(bf_lo(y.y) + o[2], bf_hi(y.y) + o[3]); *(u32x2*)(yrow + 16 * dt) = w; } }
    }
    asm volatile("s_waitcnt lgkmcnt(0)" ::: "memory");
}

struct UnitPre { int j; unsigned tlo, thi; bf16x8 q00, q01, q10, q11; KOp ka, kb; VOp va, vb; };
template <int PASS>
__device__ __forceinline__ UnitPre unit_load(const LAS unsigned char* qlds, const bf16_t* Ks, const bf16_t* Vs, int kh, int tile, const LAS u32x4* units, int u, int lane) {
    const int col = lane & 15, q = lane >> 4, slot = col >> 2, g = col & 3;
    const u32x4 d = units[u]; UnitPre P; P.j = __builtin_amdgcn_readfirstlane((int)d.x); P.tlo = (unsigned)__builtin_amdgcn_readfirstlane((int)d.y); P.thi = (unsigned)__builtin_amdgcn_readfirstlane((int)d.z);
    const unsigned t0b = (P.tlo >> (8 * slot)) & 0xffu, t1b = (P.thi >> (8 * slot)) & 0xffu;
    const LAS unsigned char* qr0 = qlds + (t0b == 0xffu ? 0 : (int)t0b) * QROWB + g * 128 + 16 * q;
    const LAS unsigned char* qr1 = qlds + (t1b == 0xffu ? 0 : (int)t1b) * QROWB + g * 128 + 16 * q;
    P.q00 = *(const LAS bf16x8*)qr0; P.q01 = *(const LAS bf16x8*)(qr0 + 64); P.q10 = *(const LAS bf16x8*)qr1; P.q11 = *(const LAS bf16x8*)(qr1 + 64);
    P.ka = ldk(Ks, 64, 64 * P.j, lane); P.kb = ldk(Ks, 64, 64 * P.j + 32, lane);
    if (PASS == 1) { if ((EXPV) == 2) { P.va.v0 = P.ka.a00; P.va.v1 = P.ka.a01; P.va.v2 = P.ka.a10; P.va.v3 = P.ka.a11; P.vb = P.va; } else { P.va = ldv(Vs, 64, 64 * P.j, lane); P.vb = ldv(Vs, 64, 64 * P.j + 32, lane); } }
    return P;
}
template <int PASS>
__device__ __forceinline__ void unit_group(const UnitPre& P, const bf16x8& q0, const bf16x8& q1, unsigned toks, int tile, LAS unsigned char* lds, float fxs, int lane) {
    const int col = lane & 15, q = lane >> 4, slot = col >> 2, g = col & 3;
    const int ti = (int)((toks >> (8 * slot)) & 0xffu);
    f32x4 S0a, S1a, S0b, S1b; qk32(P.ka, q0, q1, S0a, S1a); qk32(P.kb, q0, q1, S0b, S1b);
    const bool valid = ti != 0xff; const int row = (valid ? ti : 0) * 4 + g;
    const int lim = (P.j == tile) ? (valid ? ti : -1) - 8 * q : (valid ? 1000 : -1);
    LAS int* mm = (LAS int*)(lds + AL_MM); LAS float* ls = (LAS float*)(lds + AL_LS);
    if (PASS == 0) {
        float mloc = NEGF;
#pragma unroll
        for (int e = 0; e < 4; ++e) { mloc = fmaxf(mloc, e <= lim ? S0a[e] : NEGF); mloc = fmaxf(mloc, e + 4 <= lim ? S1a[e] : NEGF); mloc = fmaxf(mloc, e + 32 <= lim ? S0b[e] : NEGF); mloc = fmaxf(mloc, e + 36 <= lim ? S1b[e] : NEGF); }
        if ((EXPV) != 4) { mloc = fmaxf(mloc, __shfl_xor(mloc, 16)); mloc = fmaxf(mloc, __shfl_xor(mloc, 32)); }
        if (q == 0 && valid && (EXPV) != 3) __hip_atomic_fetch_max(mm + row, f2ord(mloc), __ATOMIC_RELAXED, __HIP_MEMORY_SCOPE_WORKGROUP);
    } else {
        const float m = ord2f(mm[row]);
        f32x4 p0a, p1a, p0b, p1b; float ps = 0.f;
#pragma unroll
        for (int e = 0; e < 4; ++e) { p0a[e] = e <= lim ? EXP2(S0a[e] - m) : 0.f; p1a[e] = e + 4 <= lim ? EXP2(S1a[e] - m) : 0.f; p0b[e] = e + 32 <= lim ? EXP2(S0b[e] - m) : 0.f; p1b[e] = e + 36 <= lim ? EXP2(S1b[e] - m) : 0.f;
            ps += (p0a[e] + p1a[e]) + (p0b[e] + p1b[e]); }
        ps += __shfl_xor(ps, 16); ps += __shfl_xor(ps, 32);
        if (q == 0 && valid) __hip_atomic_fetch_add(ls + row, ps, __ATOMIC_RELAXED, __HIP_MEMORY_SCOPE_WORKGROUP);
        f32x4 O[4];
#pragma unroll
        for (int dt = 0; dt < 4; ++dt) O[dt] = (f32x4){0.f, 0.f, 0.f, 0.f};
        pv32(P.va, packP(p0a, p1a), O); pv32(P.vb, packP(p0b, p1b), O);
        if (valid) { LAS unsigned long long* orow = (LAS unsigned long long*)(lds + AL_OS) + row * OSP + 2 * q;
#pragma unroll
            for (int dt = 0; dt < 4; ++dt) {
                const unsigned a0 = (unsigned)((int)rintf(O[dt][0] * fxs) + (1 << 26)), a1 = (unsigned)((int)rintf(O[dt][1] * fxs) + (1 << 26)), a2 = (unsigned)((int)rintf(O[dt][2] * fxs) + (1 << 26)), a3 = (unsigned)((int)rintf(O[dt][3] * fxs) + (1 << 26));
                __hip_atomic_fetch_add(orow + 8 * dt, (unsigned long long)a0 | ((unsigned long long)a1 << 32), __ATOMIC_RELAXED, __HIP_MEMORY_SCOPE_WORKGROUP);
                __hip_atomic_fetch_add(orow + 8 * dt + 1, (unsigned long long)a2 | ((unsigned long long)a3 << 32), __ATOMIC_RELAXED, __HIP_MEMORY_SCOPE_WORKGROUP); } }
    }
}
template <int PASS>
__device__ __forceinline__ void unit_compute(const UnitPre& P, int tile, LAS unsigned char* lds, float fxs, int lane) {
    unit_group<PASS>(P, P.q00, P.q01, P.tlo, tile, lds, fxs, lane);
    if (P.thi != 0xffffffffu) unit_group<PASS>(P, P.q10, P.q11, P.thi, tile, lds, fxs, lane);
}
template <int PASS>
__device__ __forceinline__ void unit_pass(const AttnT& T, int kh, int tile, int n, LAS unsigned char* lds, int wave, int lane) {
    const bf16_t* Ks = T.kslc + (size_t)kh * SEQ * 64; const bf16_t* Vs = T.vslT + (size_t)kh * 256 * 4096;
    const LAS u32x4* units = (const LAS u32x4*)(lds + AL_UNITS);
    int u = wave; if (u >= n) return;
    UnitPre A = unit_load<PASS>(lds + AL_Q, Ks, Vs, kh, tile, units, u, lane), B = A;
    for (; u < n; u += 16) {
        const int u1 = u + 8; if (u1 < n) B = unit_load<PASS>(lds + AL_Q, Ks, Vs, kh, tile, units, u1, lane);
        unit_compute<PASS>(A, tile, lds, T.fxs, lane);
        if (u1 >= n) break;
        const int u2 = u + 16; if (u2 < n) A = unit_load<PASS>(lds + AL_Q, Ks, Vs, kh, tile, units, u2, lane);
        unit_compute<PASS>(B, tile, lds, T.fxs, lane);
    }
}

__device__ __forceinline__ void attn_tile(const AttnT& T, int kh, int tile, LAS unsigned char* lds, int tid, int wave, int lane) {
    LAS unsigned* tm = (LAS unsigned*)(lds + AL_TM);
    for (int i = tid; i < 512; i += NT) tm[i] = 0u;
    { const int ti = tid >> 3, part = tid & 7; const u32x4* src = (const u32x4*)(T.proj + (size_t)(tile * 64 + ti) * PP + C_Q + kh * 256 + part * 32); LAS u32x4* dst = (LAS u32x4*)(lds + AL_Q + ti * QROWB + part * 64);
      dst[0] = src[0]; dst[1] = src[1]; dst[2] = src[2]; dst[3] = src[3]; }
    __syncthreads();
    if ((TSK) >= 20 && blockIdx.x == 0 && threadIdx.x == 0) T.tsa[15] = __builtin_amdgcn_s_memrealtime();
    for (int r3 = 0; r3 < ((PROBE_REP) == 41 ? 2 : 1); ++r3)
    attn_wave_part1(T, kh, tile * 8 + wave, lane, (LAS float*)(lds + AL_IMP + wave * 8448), tm, wave);
    __threadfence_block(); __syncthreads();
    ASTAMP(0);
    LAS int* cnt = (LAS int*)(lds + AL_CNT); LAS int* off = (LAS int*)(lds + AL_OFF); LAS u32x4* units = (LAS u32x4*)(lds + AL_UNITS);
    for (int i = tid; i < 256 * OSP; i += NT) ((LAS unsigned long long*)(lds + AL_OS))[i] = 0ull;
    if (tid < 256) { ((LAS int*)(lds + AL_MM))[tid] = f2ord(NEGF); ((LAS float*)(lds + AL_LS))[tid] = 0.f; cnt[tid] = (__popc(tm[2 * tid]) + __popc(tm[2 * tid + 1]) + 7) >> 3; }
    __syncthreads();
    if (tid < 64) {
        const int c0 = cnt[4 * tid], c1 = cnt[4 * tid + 1], c2 = cnt[4 * tid + 2], c3 = cnt[4 * tid + 3]; const int tot = (c0 + c1) + (c2 + c3); int inc = tot;
#pragma unroll
        for (int o = 1; o < 64; o <<= 1) { const int v = __shfl_up(inc, o); if (tid >= o) inc += v; }
        const int ex = inc - tot; off[4 * tid] = ex; off[4 * tid + 1] = ex + c0; off[4 * tid + 2] = ex + c0 + c1; off[4 * tid + 3] = ex + c0 + c1 + c2;
        if (tid == 63) off[256] = inc;
    }
    __syncthreads();
    if (tid < 256) { unsigned long long mask = (unsigned long long)tm[2 * tid] | ((unsigned long long)tm[2 * tid + 1] << 32); int o = off[tid];
        while (mask != 0ull) { unsigned tl = 0xffffffffu, th = 0xffffffffu;
#pragma unroll
            for (int k = 0; k < 4; ++k) if (mask != 0ull) { const unsigned ti = (unsigned)__builtin_ctzll(mask); mask &= mask - 1ull; tl = (tl & ~(0xffu << (8 * k))) | (ti << (8 * k)); }
#pragma unroll
            for (int k = 0; k < 4; ++k) if (mask != 0ull) { const unsigned ti = (unsigned)__builtin_ctzll(mask); mask &= mask - 1ull; th = (th & ~(0xffu << (8 * k))) | (ti << (8 * k)); }
            units[o++] = (u32x4){(unsigned)tid, tl, th, 0u}; } }
    __syncthreads();
    const int n = off[256];
    ASTAMP(1);
    unit_pass<0>(T, kh, tile, n, lds, wave, lane);
    if ((PROBE_REP) == 42) unit_pass<0>(T, kh, tile, n, lds, wave, lane);
    __syncthreads();
    ASTAMP(2);
    unit_pass<1>(T, kh, tile, n, lds, wave, lane);
    __syncthreads();
    ASTAMP(3);
    { const int ti = tid >> 3, part = tid & 7, g = part >> 1, d0 = 32 * (part & 1), row = ti * 4 + g, t = tile * 64 + ti, h = kh * 4 + g;
      const float l = ((const LAS float*)(lds + AL_LS))[row]; const float sc = bf2f(T.proj[(size_t)t * PP + C_NG + h * 3 + 1]) / fmaxf(l, 1e-30f);
      const LAS unsigned long long* orow = (const LAS unsigned long long*)(lds + AL_OS) + row * OSP + (d0 >> 1); u32x4* yp = (u32x4*)(T.ya + (size_t)t * 512 + h * 64 + d0);
      const int nsel = ((t >> 6) + 1) < 16 ? ((t >> 6) + 1) : 16; const unsigned bias = (unsigned)nsel << 26; const float sc2 = sc / T.fxs;
#pragma unroll
      for (int i = 0; i < 4; ++i) { const u32x4 y = yp[i]; const unsigned long long o0 = orow[4 * i], o1 = orow[4 * i + 1], o2 = orow[4 * i + 2], o3 = orow[4 * i + 3]; f32x4 a, b;
          a[0] = bf_lo(y.x) + (float)(int)((unsigned)o0 - bias) * sc2; a[1] = bf_hi(y.x) + (float)(int)((unsigned)(o0 >> 32) - bias) * sc2; a[2] = bf_lo(y.y) + (float)(int)((unsigned)o1 - bias) * sc2; a[3] = bf_hi(y.y) + (float)(int)((unsigned)(o1 >> 32) - bias) * sc2;
          b[0] = bf_lo(y.z) + (float)(int)((unsigned)o2 - bias) * sc2; b[1] = bf_hi(y.z) + (float)(int)((unsigned)(o2 >> 32) - bias) * sc2; b[2] = bf_lo(y.w) + (float)(int)((unsigned)o3 - bias) * sc2; b[3] = bf_hi(y.w) + (float)(int)((unsigned)(o3 >> 32) - bias) * sc2;
          yp[i] = pack8(a, b); } }
    __syncthreads();
    ASTAMP(4);
    if ((TSK) >= 20 && blockIdx.x == 0 && threadIdx.x == 0) T.tsa[5] += (unsigned long long)n;
}

__device__ __forceinline__ void ssm_load_u(const bf16_t* proj, int c, int g, int lane, LAS float* ubuf) {
#pragma unroll
    for (int r = 0; r < 2; ++r) { const int tl = lane + 64 * r; const u32x4* src = (const u32x4*)(proj + (size_t)(c * 128 + tl) * PP + C_U + g * 16); const u32x4 a = src[0], b = src[1];
        LAS f32x4* d = (LAS f32x4*)(ubuf + tl * 16);
        d[0] = (f32x4){bf_lo(a.x), bf_hi(a.x), bf_lo(a.y), bf_hi(a.y)}; d[1] = (f32x4){bf_lo(a.z), bf_hi(a.z), bf_lo(a.w), bf_hi(a.w)};
        d[2] = (f32x4){bf_lo(b.x), bf_hi(b.x), bf_lo(b.y), bf_hi(b.y)}; d[3] = (f32x4){bf_lo(b.z), bf_hi(b.z), bf_lo(b.w), bf_hi(b.w)}; }
    asm volatile("s_waitcnt lgkmcnt(0)" ::: "memory");
}
__device__ __forceinline__ f32x2 ssm_step(const f32x2 (&Bb)[16], const f32x2 A, const f32x2 x, const LAS float* urow) {
    const f32x4 u0 = *(const LAS f32x4*)(urow), u1 = *(const LAS f32x4*)(urow + 4), u2 = *(const LAS f32x4*)(urow + 8), u3 = *(const LAS f32x4*)(urow + 12);
    f32x2 bu = Bb[0] * u0[0]; f32x2 bv = Bb[1] * u0[1];
    bu += Bb[2] * u0[2]; bv += Bb[3] * u0[3]; bu += Bb[4] * u1[0]; bv += Bb[5] * u1[1]; bu += Bb[6] * u1[2]; bv += Bb[7] * u1[3];
    bu += Bb[8] * u2[0]; bv += Bb[9] * u2[1]; bu += Bb[10] * u2[2]; bv += Bb[11] * u2[3]; bu += Bb[12] * u3[0]; bv += Bb[13] * u3[1]; bu += Bb[14] * u3[2]; bv += Bb[15] * u3[3];
    bu += bv;
    f32x2 r; r.x = A.x * x.x - A.y * x.y + bu.x; r.y = A.x * x.y + A.y * x.x + bu.y; return r;
}
__device__ __forceinline__ void ssm_pass1(const unsigned char* ws, int c, int g, int lane, LAS float* ubuf) {
    const bf16_t* proj = (const bf16_t*)(ws + WS_PROJ);
    ssm_load_u(proj, c, g, lane, ubuf);
    const f32x2* Bbar = (const f32x2*)(ws + WS_BBAR) + (size_t)(g * 64 + lane) * 16; f32x2 Bb[16];
#pragma unroll
    for (int hh = 0; hh < 16; ++hh) Bb[hh] = Bbar[hh];
    const f32x2 A = ((const f32x2*)(ws + WS_ABAR))[g * 64 + lane];
    f32x2 x = {0.f, 0.f};
    for (int s = 0; s < 128; ++s) x = ssm_step(Bb, A, x, ubuf + s * 16);
    ((f32x2*)(ws + WS_SBUF))[(size_t)(c * 32 + g) * 64 + lane] = x;
    asm volatile("s_waitcnt lgkmcnt(0)" ::: "memory");
}
__device__ __forceinline__ void ssm_pass3(const Args& a, int c, int g, int lane, LAS float* ubuf, LAS unsigned char* xl  ) {
    const unsigned char* ws = a.ws; const bf16_t* proj = (const bf16_t*)(ws + WS_PROJ);
    ssm_load_u(proj, c, g, lane, ubuf);
    const f32x2* Bbar = (const f32x2*)(ws + WS_BBAR) + (size_t)(g * 64 + lane) * 16; f32x2 Bb[16];
#pragma unroll
    for (int hh = 0; hh < 16; ++hh) Bb[hh] = Bbar[hh];
    const f32x2 A = ((const f32x2*)(ws + WS_ABAR))[g * 64 + lane], A128 = ((const f32x2*)(ws + WS_A128))[g * 64 + lane];
    f32x2 x = {0.f, 0.f};
    { const f32x2* Sb = (const f32x2*)(ws + WS_SBUF) + g * 64 + lane;
      _Pragma("unroll 8") for (int cc = 0; cc < c; ++cc) { const f32x2 s = Sb[(size_t)cc * 32 * 64]; f32x2 r; r.x = A128.x * x.x - A128.y * x.y + s.x; r.y = A128.x * x.y + A128.y * x.x + s.y; x = r; } }
    const int hrow = lane & 15, q = lane >> 4; bf16x8 Cm[4];
    { const float* cre = a.in[14] + (size_t)(g * 16 + hrow) * 64; const float* cim = a.in[15] + (size_t)(g * 16 + hrow) * 64;
#pragma unroll
      for (int ks = 0; ks < 4; ++ks) { const f32x4 r = *(const f32x4*)(cre + 16 * ks + 4 * q), im = *(const f32x4*)(cim + 16 * ks + 4 * q);
          u32x4 w; w.x = cvt_pk_bf16(r[0], -im[0]); w.y = cvt_pk_bf16(r[1], -im[1]); w.z = cvt_pk_bf16(r[2], -im[2]); w.w = cvt_pk_bf16(r[3], -im[3]); Cm[ks] = __builtin_bit_cast(bf16x8, w); } }
    const f32x4 dsk = *(const f32x4*)(a.in[16] + g * 16 + 4 * q);
    bf16_t* ybp = (bf16_t*)((unsigned char*)a.out + OUT_YBP);
    for (int sub = 0; sub < 8; ++sub) {
#pragma unroll 4
        for (int s = 0; s < 16; ++s) { x = ssm_step(Bb, A, x, ubuf + (sub * 16 + s) * 16); *(LAS unsigned*)(xl + s * 272 + lane * 4) = cvt_pk_bf16(x.x, x.y); }
        asm volatile("s_waitcnt lgkmcnt(0)" ::: "memory");
        f32x4 acc = {0.f, 0.f, 0.f, 0.f};
#pragma unroll
        for (int ks = 0; ks < 4; ++ks) { const bf16x8 b = *(const LAS bf16x8*)(xl + hrow * 272 + ks * 64 + q * 16); acc = MFMA16(Cm[ks], b, acc); }
        const int tl = sub * 16 + hrow; const f32x4 uu = *(const LAS f32x4*)(ubuf + tl * 16 + 4 * q);
        f32x4 y = acc + dsk * uu;
        u32x2 w; w.x = cvt_pk_bf16(gelu_tanh(y[0]), gelu_tanh(y[1])); w.y = cvt_pk_bf16(gelu_tanh(y[2]), gelu_tanh(y[3]));
        *(u32x2*)(ybp + (size_t)(c * 128 + tl) * 512 + g * 16 + 4 * q) = w;
        asm volatile("s_waitcnt lgkmcnt(0)" ::: "memory");
    }
}

__global__ void __launch_bounds__(NT, 2) fwd_mega(Args a) {
    extern __shared__ __attribute__((aligned(16))) unsigned char lds_raw[];
    cg::grid_group grid = cg::this_grid();
    LAS unsigned char* lds = (LAS unsigned char*)lds_raw;
    const int tid = threadIdx.x, lane = tid & 63, wave = __builtin_amdgcn_readfirstlane(tid >> 6);
    const int G = gridDim.x, bid = blockIdx.x;
    const int gw = bid * NWV + wave, NGW = G * NWV;
    const int gt = bid * NT + tid, NGT = G * NT;
    unsigned char* ws = a.ws;
    const float* x = a.in[0];
    STAMP(0);
    if ((TSK) >= 20 && blockIdx.x == 0 && threadIdx.x == 0) for (int i = 0; i < 16; ++i) ((unsigned long long*)(a.ws + 244 * 1024))[i] = 0ull;
    if (tid < 4) ((volatile LAS unsigned*)(lds + 131072 + 64))[tid] = 0u;
    if (bid == 0) for (int i = tid; i < XCD_BAR_WORDS; i += NT) ((unsigned*)(ws + WS_BAR))[i] = 0u;
    __syncthreads();

    {
        if (bid < 16) {
            LAS float* red = (LAS float*)lds;
            const int o = bid * 32 + (tid & 31), ksl = tid >> 5, which = o >> 8, colc = o & 255;
            const float* pe = a.in[which ? 7 : 4]; const float* w1 = a.in[which ? 8 : 5]; float s = 0.f;
            _Pragma("unroll 16") for (int k = ksl * 128; k < ksl * 128 + 128; ++k) s += pe[k] * w1[(size_t)k * 256 + colc];
            red[ksl * 32 + (tid & 31)] = s; __syncthreads();
            if (tid < 32) { float t = 0.f; for (int i = 0; i < 16; ++i) t += red[i * 32 + tid]; ((float*)(ws + WS_BIASPE))[o] = t; }
            __syncthreads();
        }
        LAS float* scr = (LAS float*)(lds + wave * 8448);
        constexpr int I_IN = 16 * 121, I_GLU = 8 * 16, I_PA = 8 * 32, I_OUT = 16 * 32, I_UP = 16 * 176, I_DN = 44 * 32, I_W1 = 32 * 8;
        constexpr int NITEMS = I_IN + I_GLU + 2 * I_PA + I_OUT + I_UP + I_DN + 2 * I_W1;
        for (int it = gw; it < NITEMS; it += NGW) {
            int r = it;
            if (r < I_IN) { transpose_item(a.in[3], 1024, DIN, (bf16_t*)(ws + WS_WIN), scr, r / 121, r % 121, lane, a.in[2], 1); continue; } r -= I_IN;
            if (r < I_GLU) { transpose_item(a.in[18], 512, 512, (bf16_t*)(ws + WS_WGLU), scr, r / 16, r % 16, lane, nullptr, 0); continue; } r -= I_GLU;
            if (r < I_PA) { transpose_item(a.in[19], 512, 1024, (bf16_t*)(ws + WS_WPA), scr, r / 32, r % 32, lane, nullptr, 0); continue; } r -= I_PA;
            if (r < I_PA) { transpose_item(a.in[20], 512, 1024, (bf16_t*)(ws + WS_WPB), scr, r / 32, r % 32, lane, nullptr, 0); continue; } r -= I_PA;
            if (r < I_OUT) { transpose_item(a.in[21], 1024, 1024, (bf16_t*)(ws + WS_WOUT), scr, r / 32, r % 32, lane, nullptr, 0); continue; } r -= I_OUT;
            if (r < I_UP) { transpose_item(a.in[23], 1024, NUP, (bf16_t*)(ws + WS_WUP), scr, r / 176, r % 176, lane, a.in[22], 2); continue; } r -= I_UP;
            if (r < I_DN) { transpose_item(a.in[26], DFF, 1024, (bf16_t*)(ws + WS_WDOWN), scr, r / 32, r % 32, lane, nullptr, 0); continue; } r -= I_DN;
            if (r < I_W1) { transpose_item(a.in[5], 2048, 256, (bf16_t*)(ws + WS_W1K), scr, r / 8, r % 8, lane, nullptr, 0); continue; } r -= I_W1;
            transpose_item(a.in[8], 2048, 256, (bf16_t*)(ws + WS_W1V), scr, r / 8, r % 8, lane, nullptr, 0);
        }
        { u32x4* p = (u32x4*)(ws + WS_WIN + (size_t)DIN * 1024 * 2); const int n = (4096 - DIN) * 1024 * 2 / 16; for (int i = gt; i < n; i += NGT) p[i] = (u32x4){0u, 0u, 0u, 0u}; }
        { u32x4* p = (u32x4*)(ws + WS_PROJ + (size_t)SEQ * PP * 2); const int n = 32 * PP * 2 / 16; for (int i = gt; i < n; i += NGT) p[i] = (u32x4){0u, 0u, 0u, 0u}; }
        for (int i = gt; i < 128 * 64 + 2048; i += NGT) {
            if (i < 128 * 64) { const int r = i >> 6, cidx = SEQ + (i & 63); ((bf16_t*)(ws + WS_VSLT))[(size_t)r * VTP + cidx] = 0; ((bf16_t*)(ws + WS_VWNT))[(size_t)r * VTP + cidx] = 0; }
            else { const int j = i - 128 * 64; ((bf16_t*)(ws + WS_VSLT))[(size_t)128 * VTP + j] = 0; ((bf16_t*)(ws + WS_VWNT))[(size_t)128 * VTP + j] = 0; }
        }
        for (int i = gt; i < SEQ; i += NGT) { ((float*)(ws + WS_RSS2))[i] = 0.f; ((float*)(ws + WS_RSS3))[i] = 0.f; }
        if (gt == 0) *(unsigned*)(ws + WS_VMAX) = 0u;
        { const int* pos = (const int*)a.in[1];
          for (int i = gt; i < SEQ * 8; i += NGT) { const int tt = i >> 3, fi = i & 7; const float invf = powf(500000.0f, -(float)(2 * fi) / 16.0f); const float ang = (float)pos[tt] * invf;
              float sn, cs; sincosf(ang, &sn, &cs); ((float*)(ws + WS_ROPEC))[i] = cs; ((float*)(ws + WS_ROPES))[i] = sn; } }
        for (int i = gt; i < 2048; i += NGT) { const int gg = i >> 6;
            const float dt = expf(a.in[17][gg]), ar = a.in[10][i], ai = a.in[11][i];
            const float e = expf(ar * dt), em1 = expm1f(ar * dt), th = ai * dt; float sn, cs; sincosf(th, &sn, &cs); const float sh = sinf(0.5f * th);
            const float Ax = e * cs, Ay = e * sn; const float nx = em1 * cs - 2.f * sh * sh, ny = e * sn;
            const float den = 1.f / (ar * ar + ai * ai); const float fx = (nx * ar + ny * ai) * den, fy = (ny * ar - nx * ai) * den;
            ((f32x2*)(ws + WS_ABAR))[i] = (f32x2){Ax, Ay};
            float px = Ax, py = Ay;
            for (int k = 0; k < 7; ++k) { const float qx = px * px - py * py, qy = 2.f * px * py; px = qx; py = qy; }
            ((f32x2*)(ws + WS_A128))[i] = (f32x2){px, py};
            const float* bre = a.in[12] + (size_t)i * 16; const float* bim = a.in[13] + (size_t)i * 16; f32x2* Bo = (f32x2*)(ws + WS_BBAR) + (size_t)i * 16;
            for (int hh = 0; hh < 16; ++hh) Bo[hh] = (f32x2){fx * bre[hh] - fy * bim[hh], fx * bim[hh] + fy * bre[hh]};
        }
        for (int r = gw; r < SEQ; r += NGW) {
            const f32x4* xr = (const f32x4*)(x + (size_t)r * DM) + lane; f32x4 v[4]; float s = 0.f;
#pragma unroll
            for (int j = 0; j < 4; ++j) { v[j] = xr[64 * j]; s += (v[j][0] * v[j][0] + v[j][1] * v[j][1]) + (v[j][2] * v[j][2] + v[j][3] * v[j][3]); }
            s = wave_sum(s);
            if (lane == 0) ((float*)(ws + WS_RSTD1))[r] = rsqrtf(s * (1.f / DM) + EPS);
            u32x2* o = (u32x2*)(ws + WS_XB + (size_t)r * DM * 2) + lane;
#pragma unroll
            for (int j = 0; j < 4; ++j) { u32x2 w; w.x = cvt_pk_bf16(v[j][0], v[j][1]); w.y = cvt_pk_bf16(v[j][2], v[j][3]); o[64 * j] = w; }
        }
    }
    grid.sync();
    STAMP(1);
    XcdBarrier xbar = xcd_barrier_post((unsigned*)(ws + WS_BAR), (volatile LAS unsigned*)(lds + 131072 + 64));

    REPS(1) {
        pg8::Gemm g{1024, 2048u, 128u};
        SchedMN S{64, 16, 1, G, bid, 0, (const char*)(ws + WS_XB), nullptr, (const char*)(ws + WS_WIN), nullptr, (size_t)256 * 1024 * 2, (size_t)256 * 1024 * 2};
        EpiProj E{(bf16_t*)(ws + WS_PROJ), (bf16_t*)(ws + WS_VSLT), (bf16_t*)(ws + WS_VWNT), (bf16_t*)(ws + WS_KSL), (bf16_t*)(ws + WS_KWN), (const float*)(ws + WS_RSTD1), (const float*)(ws + WS_ROPEC), (const float*)(ws + WS_ROPES)};
        pg8::gemm_phase<EpiProj, SchedMN, true, true>(lds, g, S, E);
    }
    GSYNC();
    STAMP(2);

    {
        if (bid < 16) {
            pg8::Gemm g{2048, (unsigned)(16 * PP * 2), (unsigned)(PP * 2)};
            SchedCmp S{bid, (const char*)(ws + WS_PROJ), (const char*)(ws + WS_W1K), (const char*)(ws + WS_W1V)};
            EpiCmp E{(bf16_t*)(ws + WS_HID), (const float*)(ws + WS_BIASPE)};
            pg8::gemm_phase<EpiCmp, SchedCmp, true, true>(lds, g, S, E);
        } else {
            LAS float* ubuf = (LAS float*)(lds + wave * 16384);
            for (int it = (bid - 16) * NWV + wave; it < 4096 * ((PROBE_REP) == 12 ? 2 : 1); it += (G - 16) * NWV) ssm_pass1(ws, (it & 4095) >> 5, it & 31, lane, ubuf);
        }
    }
    GSYNC();
    STAMP(3);

    REPS(3) {
        {
            const u32x4* vp = (const u32x4*)(ws + WS_VSLT); unsigned mx = 0u;
            for (int i = gt; i < 262144; i += NGT) { const u32x4 v = vp[i];
                mx = max(mx, max(max(v.x & 0x7fffu, (v.x >> 16) & 0x7fffu), max(v.y & 0x7fffu, (v.y >> 16) & 0x7fffu)));
                mx = max(mx, max(max(v.z & 0x7fffu, (v.z >> 16) & 0x7fffu), max(v.w & 0x7fffu, (v.w >> 16) & 0x7fffu))); }
#pragma unroll
            for (int o = 1; o < 64; o <<= 1) mx = max(mx, (unsigned)__shfl_xor((int)mx, o));
            if (lane == 0) atomicMax((unsigned*)(ws + WS_VMAX), mx);
        }
        const bf16_t* hid = (const bf16_t*)(ws + WS_HID);
        for (int r = gw; r < 4096; r += NGW) {
            const int z = r >> 10, n = r & 1023, which = z >> 1, kh = z & 1;
            float acc = 0.f;
            if (n < 1023) { const float* w2 = a.in[which ? 9 : 6]; const bf16_t* hr = hid + (size_t)r * 256;
                _Pragma("unroll 16") for (int k = 0; k < 256; k += 2) { const unsigned hw = *(const unsigned*)(hr + k); acc += bf_lo(hw) * w2[k * 64 + lane]; acc += bf_hi(hw) * w2[(k + 1) * 64 + lane]; } }
            if (which == 0) {
                const float other = __shfl_xor(acc, 8); const int prow = 16 * n + 31; float o = acc;
                if (lane < 16 && n < 1023) { const float cs = ((const float*)(ws + WS_ROPEC))[prow * 8 + (lane & 7)], sn = ((const float*)(ws + WS_ROPES))[prow * 8 + (lane & 7)];
                    o = lane < 8 ? acc * cs - other * sn : acc * cs + other * sn; }
                ((bf16_t*)(ws + WS_KCMP))[((size_t)kh * 1024 + n) * 64 + lane] = (bf16_t)(cvt_pk_bf16(o, 0.f) & 0xffff);
            } else {
                ((bf16_t*)(ws + WS_VCMPT))[((size_t)kh * 64 + lane) * 1024 + n] = (bf16_t)(cvt_pk_bf16(acc, 0.f) & 0xffff);
            }
        }
    }
    GSYNC();
    STAMP(4);

    {
        AttnT T{0.f, (unsigned long long*)(ws + 244 * 1024), (const bf16_t*)(ws + WS_PROJ), (const bf16_t*)(ws + WS_KSL), (const bf16_t*)(ws + WS_KWN), (const bf16_t*)(ws + WS_KCMP), (const bf16_t*)(ws + WS_VCMPT), (const bf16_t*)(ws + WS_VSLT), (const bf16_t*)(ws + WS_VWNT), (bf16_t*)((unsigned char*)a.out + OUT_YA)};
        { const unsigned vb = __hip_atomic_load((unsigned*)(ws + WS_VMAX), __ATOMIC_RELAXED, __HIP_MEMORY_SCOPE_AGENT); const float vmax = fmaxf(__uint_as_float(vb << 16), 1e-30f); T.fxs = FXB / (64.0f * 1.01f * vmax); }
        LAS float* wl = (LAS float*)(lds + wave * 16384);
        for (int r2 = 0; r2 < ((PROBE_REP) == 4 ? 2 : 1); ++r2)
        for (int pr = bid; pr < 256; pr += G) {
            const int xcd = pr & 7, slot = pr >> 3, kh = xcd & 1, tl = 32 * (xcd >> 1) + slot;
_Pragma("nounroll")
            for (int k2 = 0; k2 < 2; ++k2) { int tk_ = threadIdx.x; asm volatile("" : "+v"(tk_)); attn_tile(T, kh, k2 ? 255 - tl : tl, lds, tk_, __builtin_amdgcn_readfirstlane(tk_ >> 6), tk_ & 63); }
        }
        if ((PROBE_REP) == 4) {
            AttnT T2 = T; T2.ya = (bf16_t*)(ws + WS_XB);
            for (int pr = bid; pr < 256; pr += G) { const int xcd = pr & 7, slot = pr >> 3, kh = xcd & 1, tl = 32 * (xcd >> 1) + slot;
                _Pragma("nounroll") for (int k2 = 0; k2 < 2; ++k2) attn_tile(T2, kh, k2 ? 255 - tl : tl, lds, tid, wave, lane); }
        }
        int tid2 = threadIdx.x; asm volatile("" : "+v"(tid2));
        const int lane2 = tid2 & 63, wave2 = __builtin_amdgcn_readfirstlane(tid2 >> 6), gw2 = bid * NWV + wave2;
        for (int it = gw2; it < 4096 * ((PROBE_REP) == 14 ? 2 : 1); it += NGW) ssm_pass3(a, (it & 4095) >> 5, it & 31, lane2, (LAS float*)(lds + wave2 * 16384), lds + wave2 * 16384 + 8192);
    }
    GSYNC();
    STAMP(5);

    REPS(5) {
        pg8::Gemm g{512, 1024u, 128u};
        SchedMN S{64, 2, 1, G, bid, 0, (const char*)a.out + OUT_YBP, nullptr, (const char*)(ws + WS_WGLU), nullptr, (size_t)256 * 512 * 2, (size_t)256 * 512 * 2};
        EpiGlu E{(const bf16_t*)((const unsigned char*)a.out + OUT_YBP), (bf16_t*)((unsigned char*)a.out + OUT_YB)};
        pg8::gemm_phase<EpiGlu, SchedMN, true, true>(lds, g, S, E);
    }
    GSYNC();
    STAMP(6);

    REPS(6) {
        pg8::Gemm g{512, 1024u, 128u};
        SchedMN S{64, 4, 2, G, bid, 0, (const char*)a.out + OUT_YA, (const char*)a.out + OUT_YB, (const char*)(ws + WS_WPA), (const char*)(ws + WS_WPB), (size_t)256 * 512 * 2, (size_t)256 * 512 * 2};
        EpiMerge E{(const bf16_t*)(ws + WS_PROJ), (bf16_t*)(ws + WS_MERGED)};
        pg8::gemm_phase<EpiMerge, SchedMN, true, true>(lds, g, S, E);
    }
    GSYNC();
    STAMP(7);

    {
        pg8::Gemm g{1024, 2048u, 128u};
        SchedMN S{64, 4, 1, G, bid, 0, (const char*)(ws + WS_MERGED), nullptr, (const char*)(ws + WS_WOUT), nullptr, (size_t)256 * 1024 * 2, (size_t)256 * 1024 * 2};
        EpiRes E{x, a.out, (bf16_t*)(ws + WS_X1B), (float*)(ws + WS_RSS2)};
        pg8::gemm_phase<EpiRes, SchedMN, true, true>(lds, g, S, E);
    }
    GSYNC();
    STAMP(8);

    for (int half = 0; half < 2; ++half) {
        const int pm_off = half ? 31 : 0, nM = half ? 33 : 32, rowbase = pm_off * 256;
        REPS(8) {
            pg8::Gemm g{1024, 2048u, 128u};
            SchedMN S{nM, 22, 1, G, bid, pm_off, (const char*)(ws + WS_X1B), nullptr, (const char*)(ws + WS_WUP), nullptr, (size_t)256 * 1024 * 2, (size_t)256 * 1024 * 2};
            EpiUp E{(bf16_t*)(ws + WS_UPRAW), (const float*)(ws + WS_RSS2), rowbase};
            pg8::gemm_phase<EpiUp, SchedMN, true, true>(lds, g, S, E);
        }
        GSYNC();
    STAMP(9);
        REPS(9) {
            const bf16_t* up = (const bf16_t*)(ws + WS_UPRAW); bf16_t* act = (bf16_t*)(ws + WS_ACT);
            const float* cw = a.in[24]; const float* cb = a.in[25];
            const int tlo = half ? 8192 : 0;
            for (int it = gt; it < 256 * 352; it += NGT) {
                const int cg8 = it % 352, tb = it / 352, c0 = cg8 * 8, tile = c0 >> 7, jj = c0 & 127;
                const int ucol = tile * 256 + jj;
                float wg[3][8], wv[3][8], bg[8], bv[8];
#pragma unroll
                for (int e = 0; e < 8; ++e) { bg[e] = cb[c0 + e]; bv[e] = cb[DFF + c0 + e];
#pragma unroll
                    for (int k = 0; k < 3; ++k) { wg[k][e] = cw[k * NUP + c0 + e]; wv[k][e] = cw[k * NUP + DFF + c0 + e]; } }
                const int ts = tlo + tb * 32;
                float g2[8], g1[8], v2[8], v1[8];
#pragma unroll
                for (int e = 0; e < 8; ++e) { g2[e] = g1[e] = v2[e] = v1[e] = 0.f; }
                if (ts >= 2) {
                    const u32x4 a2 = *(const u32x4*)(up + (size_t)(ts - 2 - rowbase) * NUP + ucol), b2 = *(const u32x4*)(up + (size_t)(ts - 2 - rowbase) * NUP + ucol + 128);
                    const u32x4 a1 = *(const u32x4*)(up + (size_t)(ts - 1 - rowbase) * NUP + ucol), b1 = *(const u32x4*)(up + (size_t)(ts - 1 - rowbase) * NUP + ucol + 128);
                    g2[0] = bf_lo(a2.x); g2[1] = bf_hi(a2.x); g2[2] = bf_lo(a2.y); g2[3] = bf_hi(a2.y); g2[4] = bf_lo(a2.z); g2[5] = bf_hi(a2.z); g2[6] = bf_lo(a2.w); g2[7] = bf_hi(a2.w);
                    v2[0] = bf_lo(b2.x); v2[1] = bf_hi(b2.x); v2[2] = bf_lo(b2.y); v2[3] = bf_hi(b2.y); v2[4] = bf_lo(b2.z); v2[5] = bf_hi(b2.z); v2[6] = bf_lo(b2.w); v2[7] = bf_hi(b2.w);
                    g1[0] = bf_lo(a1.x); g1[1] = bf_hi(a1.x); g1[2] = bf_lo(a1.y); g1[3] = bf_hi(a1.y); g1[4] = bf_lo(a1.z); g1[5] = bf_hi(a1.z); g1[6] = bf_lo(a1.w); g1[7] = bf_hi(a1.w);
                    v1[0] = bf_lo(b1.x); v1[1] = bf_hi(b1.x); v1[2] = bf_lo(b1.y); v1[3] = bf_hi(b1.y); v1[4] = bf_lo(b1.z); v1[5] = bf_hi(b1.z); v1[6] = bf_lo(b1.w); v1[7] = bf_hi(b1.w);
                }
                for (int s = 0; s < 32; ++s) {
                    const int tt = ts + s;
                    const u32x4 a0 = *(const u32x4*)(up + (size_t)(tt - rowbase) * NUP + ucol), b0 = *(const u32x4*)(up + (size_t)(tt - rowbase) * NUP + ucol + 128);
                    float gc[8], vc[8];
                    gc[0] = bf_lo(a0.x); gc[1] = bf_hi(a0.x); gc[2] = bf_lo(a0.y); gc[3] = bf_hi(a0.y); gc[4] = bf_lo(a0.z); gc[5] = bf_hi(a0.z); gc[6] = bf_lo(a0.w); gc[7] = bf_hi(a0.w);
                    vc[0] = bf_lo(b0.x); vc[1] = bf_hi(b0.x); vc[2] = bf_lo(b0.y); vc[3] = bf_hi(b0.y); vc[4] = bf_lo(b0.z); vc[5] = bf_hi(b0.z); vc[6] = bf_lo(b0.w); vc[7] = bf_hi(b0.w);
                    float o[8];
#pragma unroll
                    for (int e = 0; e < 8; ++e) { const float gg = bg[e] + wg[0][e] * g2[e] + wg[1][e] * g1[e] + wg[2][e] * gc[e]; const float vv = bv[e] + wv[0][e] * v2[e] + wv[1][e] * v1[e] + wv[2][e] * vc[e];
                        o[e] = gg * sigmoidf_(gg) * vv; g2[e] = g1[e]; g1[e] = gc[e]; v2[e] = v1[e]; v1[e] = vc[e]; }
                    u32x4 w; w.x = cvt_pk_bf16(o[0], o[1]); w.y = cvt_pk_bf16(o[2], o[3]); w.z = cvt_pk_bf16(o[4], o[5]); w.w = cvt_pk_bf16(o[6], o[7]);
                    *(u32x4*)(act + (size_t)tt * DFF + c0) = w;
                }
            }
        }
        GSYNC();
    STAMP(10);
    }

    {
        pg8::Gemm g{DFF, (unsigned)(DFF * 2), 128u};
        SchedMN S{64, 4, 1, G, bid, 0, (const char*)(ws + WS_ACT), nullptr, (const char*)(ws + WS_WDOWN), nullptr, (size_t)256 * DFF * 2, (size_t)256 * DFF * 2};
        EpiRes E{a.out, a.out, nullptr, (float*)(ws + WS_RSS3)};
        pg8::gemm_phase<EpiRes, SchedMN, true, true>(lds, g, S, E);
    }
    GSYNC();
    STAMP(11);

    {
        const float* gf = a.in[27];
        for (int r = gw; r < SEQ; r += NGW) {
            const float rs = rsqrtf(((const float*)(ws + WS_RSS3))[r] * (1.f / DM) + EPS);
            f32x4* xr = (f32x4*)(a.out + (size_t)r * DM) + lane; const f32x4* gr = (const f32x4*)gf + lane;
#pragma unroll
            for (int j = 0; j < 4; ++j) xr[64 * j] = xr[64 * j] * rs * gr[64 * j];
        }
    }
    if ((TSK) >= 0 && blockIdx.x == 0 && threadIdx.x == 0) {
        const unsigned long long tend = __builtin_amdgcn_s_memrealtime(); const unsigned long long* ts = (const unsigned long long*)(a.ws + 240 * 1024);
        const unsigned long long t1 = ((TSK) + 1 > 11) ? tend : ts[(TSK) + 1 > 11 ? 0 : (TSK) + 1];
        asm volatile("s_waitcnt vmcnt(0)" ::: "memory");
        a.out[0] = ((TSK) >= 20) ? (float)((const unsigned long long*)(a.ws + 244 * 1024))[(TSK) >= 20 ? (TSK) - 20 : 0] * ((TSK) == 25 ? 1.0f : 0.01f) : (float)(t1 - ts[(TSK) > 11 ? 11 : (TSK)]) * 0.01f;
    }
}

extern "C" void kernel_launch(void* const* d_in, const int* in_sizes, int n_in, void* d_out, int out_size, void* d_ws, size_t ws_size, hipStream_t stream) {
    static int grid = 0;
    if (grid == 0) {
        int dev = 0, cus = 0, per_cu = 0;
        (void)hipGetDevice(&dev); (void)hipDeviceGetAttribute(&cus, hipDeviceAttributeMultiprocessorCount, dev);
        (void)hipFuncSetAttribute((const void*)fwd_mega, hipFuncAttributeMaxDynamicSharedMemorySize, LDS_BYTES);
        (void)hipOccupancyMaxActiveBlocksPerMultiprocessor(&per_cu, (const void*)fwd_mega, NT, LDS_BYTES);
        if (per_cu < 1) { fprintf(stderr, "kernel_launch: occupancy query says %d blocks per CU\n", per_cu); per_cu = 1; }
        grid = cus;
        if (n_in != 28 || ws_size < 252 * MiB) fprintf(stderr, "kernel_launch: unexpected n_in %d / ws_size %zu\n", n_in, ws_size);
    }
    Args a{};
    for (int i = 0; i < 28; ++i) a.in[i] = (const float*)d_in[i];
    a.out = (float*)d_out; a.ws = (unsigned char*)d_ws;
    void* kargs[] = {&a};
    hipError_t e = hipLaunchCooperativeKernel((const void*)fwd_mega, dim3(grid), dim3(NT), kargs, LDS_BYTES, stream);
    if (e != hipSuccess) fprintf(stderr, "cooperative launch failed: %s (grid %d)\n", hipGetErrorString(e), grid);
}
```

```cpp
#include <hip/hip_runtime.h>
#include <hip/hip_cooperative_groups.h>
#include <cstdio>
#include <cstdint>
namespace cg = cooperative_groups;
#ifndef PROBE_REP
#define PROBE_REP -1
#endif
#ifndef EXPV
#define EXPV 0
#endif
#ifndef TSK
#define TSK -1
#endif
#define STAMP(i) do { if ((TSK) >= 0 && blockIdx.x == 0 && threadIdx.x == 0) ((unsigned long long*)(a.ws + 240 * 1024))[i] = __builtin_amdgcn_s_memrealtime(); } while (0)
#define ASTAMP(k) do { if ((TSK) >= 20 && blockIdx.x == 0 && threadIdx.x == 0) { const unsigned long long t_ = __builtin_amdgcn_s_memrealtime(); T.tsa[k] += t_ - T.tsa[15]; T.tsa[15] = t_; } } while (0)
#define REPS(k) _Pragma("nounroll") for (int rep_ = 0; rep_ < ((PROBE_REP) == (k) ? 2 : 1); ++rep_)
#define GSYNC() do { xcd_barrier(xbar); if ((PROBE_REP) == 100) xcd_barrier(xbar); } while (0)

#define LAS __attribute__((address_space(3)))
typedef unsigned short bf16_t;
typedef short bf16x8 __attribute__((ext_vector_type(8)));
typedef float f32x4 __attribute__((ext_vector_type(4)));
typedef float f32x2 __attribute__((ext_vector_type(2)));
typedef unsigned u32x4 __attribute__((ext_vector_type(4)));
typedef unsigned u32x2 __attribute__((ext_vector_type(2)));

constexpr int SEQ = 16384, DM = 1024, DIN = 3864, PP = 4096  , DFF = 2816, NUP = 5632;
constexpr int C_Q = 0, C_KC = 512, C_VC = 640, C_KSL = 768, C_VSL = 896, C_KWN = 1024, C_VWN = 1152, C_U = 1280, C_GA = 1792, C_GB = 2816, C_NG = 3840;
constexpr int VTP = SEQ + 64;
constexpr float EPS = 1e-6f;
constexpr float NEGF = -1e30f;

constexpr size_t MiB = 1u << 20;
constexpr size_t WS_RSTD1 = 0, WS_RSS2 = 64 * 1024, WS_RSS3 = 128 * 1024, WS_ROPEC = 256 * 1024, WS_ROPES = 768 * 1024;
constexpr size_t WS_ABAR = 1280 * 1024, WS_A128 = WS_ABAR + 16384, WS_BIASPE = WS_A128 + 16384, WS_BBAR = 1536 * 1024  ;
constexpr size_t WS_SBUF = 2 * MiB  , WS_HID = 4 * MiB  , WS_KCMP = 6 * MiB  , WS_VCMPT = 6 * MiB + 512 * 1024  ;
constexpr size_t WS_WUP = 8 * MiB, WS_WDOWN = 20 * MiB, WS_WIN = 26 * MiB, WS_WGLU = 34 * MiB, WS_WPA = 35 * MiB, WS_WPB = 36 * MiB, WS_WOUT = 37 * MiB, WS_W1K = 39 * MiB, WS_W1V = 40 * MiB;
constexpr size_t WS_XB = 41 * MiB, WS_MERGED = 41 * MiB, WS_PROJ = 73 * MiB, WS_VSLT = 202 * MiB + 512 * 1024, WS_VWNT = 207 * MiB;
constexpr size_t WS_X1B = 220 * MiB, WS_UPRAW = 26 * MiB, WS_ACT = 122 * MiB;
constexpr size_t WS_VMAX = 232 * 1024, WS_BAR = 192 * 1024, WS_KSL = 212 * MiB, WS_KWN = 216 * MiB;
constexpr size_t OUT_YA = 0, OUT_YBP = 16 * MiB, OUT_YB = 32 * MiB;
static_assert(WS_PROJ + (size_t)(SEQ + 32) * PP * 2 <= WS_VSLT, "proj");
static_assert(WS_VSLT + (size_t)128 * VTP * 2 + 4096 <= WS_VWNT && WS_VWNT + (size_t)128 * VTP * 2 + 4096 <= WS_X1B, "vt");
static_assert(WS_UPRAW + (size_t)33 * 256 * NUP * 2 <= WS_ACT && WS_ACT + (size_t)SEQ * DFF * 2 <= WS_X1B, "ffn");

__device__ __forceinline__ unsigned cvt_pk_bf16(float lo, float hi) { unsigned r; asm volatile("v_cvt_pk_bf16_f32 %0, %1, %2" : "=v"(r) : "v"(lo), "v"(hi)); return r; }
__device__ __forceinline__ float bf_lo(unsigned w) { return __uint_as_float(w << 16); }
__device__ __forceinline__ float bf_hi(unsigned w) { return __uint_as_float(w & 0xffff0000u); }
__device__ __forceinline__ float bf2f(bf16_t b) { return __uint_as_float((unsigned)b << 16); }
__device__ __forceinline__ float sigmoidf_(float v) { return 1.f / (1.f + __expf(-v)); }
__device__ __forceinline__ float gelu_tanh(float v) { const float z = 0.7978845608028654f * (v + 0.044715f * v * v * v); const float th = 1.f - 2.f / (__expf(2.f * z) + 1.f); return 0.5f * v * (1.f + th); }
__device__ __forceinline__ u32x4 pack8(f32x4 a, f32x4 b) { u32x4 w; w.x = cvt_pk_bf16(a[0], a[1]); w.y = cvt_pk_bf16(a[2], a[3]); w.z = cvt_pk_bf16(b[0], b[1]); w.w = cvt_pk_bf16(b[2], b[3]); return w; }

namespace pg8 {
#define PG8_LAS __attribute__((address_space(3)))
constexpr int BM = 256, BK = 64, HALF = 128, HTB = HALF * BK * 2, STAGE_BYTES = 8 * HTB, NXCD = 8, WGM = 8;
__host__ __device__ __forceinline__ int lds_byte(int r, int c) { const int st = (r >> 4) * 2 + (c >> 5), rr = r & 15, cc = c & 31, ob = rr * 64 + cc * 2; return st * 1024 + (ob ^ (((ob >> 9) & 1) << 5)); }
__host__ __device__ __forceinline__ void stage_rc(int b, int& R, int& C) { const int st = b / 1024, sb = b % 1024, swz = sb ^ (((sb >> 9) & 1) << 5); R = (st >> 1) * 16 + swz / 64; C = (st & 1) * 32 + (swz % 64) / 2; }
__host__ __device__ __forceinline__ int perm32(int rho) { const int n = rho >> 4, i = rho & 15; return 8 * (i >> 2) + 4 * n + (i & 3); }
struct Unit { int pm, pn, z; const char* A; const char* B; };
struct Gemm { int K; unsigned lda_b; unsigned kstepA; };
__device__ __forceinline__ bool tile_of(long L, int nM, int nN, int& pm, int& pn) {
    const int nwg = nM * nN; if (L >= nwg) return false;
    int wgid = (int)L; { const int q = nwg / NXCD, r = nwg % NXCD, xcd = wgid % NXCD, off = wgid / NXCD; wgid = (xcd < r ? xcd * (q + 1) : r * (q + 1) + (xcd - r) * q) + off; }
    const int nig = WGM * nN, gid = wgid / nig, fm = gid * WGM, gsz = (nM - fm) < WGM ? (nM - fm) : WGM;
    pm = fm + ((wgid % nig) % gsz); pn = (wgid % nig) / gsz; return true;
}
template <class Epi, class Sched, bool ALIGN_EPI = false, bool SP2 = false>
__device__ __forceinline__ void gemm_phase(PG8_LAS unsigned char* lds, const Gemm g, const Sched& S, const Epi& E) {
    int tid_ = threadIdx.x; asm volatile("" : "+v"(tid_));
    const int tid = tid_, wid = __builtin_amdgcn_readfirstlane(tid >> 6), lane = tid & 63, wr = wid >> 2, wc = wid & 3, fr = lane & 15, fq = lane >> 4;
    const int K = g.K, nt = K / BK;
    unsigned voffA[2], voffB[2];
#pragma unroll
    for (int i = 0; i < 2; ++i) { int R, C; stage_rc(tid * 16 + i * 8192, R, C); const int Rb = Epi::PERM ? ((R & ~31) + perm32(R & 31)) : R;
        voffA[i] = (unsigned)R * g.lda_b + (unsigned)C * 2u; voffB[i] = (unsigned)(Rb * K + C) * 2u; }
    const size_t kstepA = (size_t)g.kstepA, kstepB = (size_t)(BK * 2);
    const size_t hstepA = (size_t)HALF * g.lda_b, hstepB = (size_t)HALF * K * 2;
    const unsigned ldsw = (unsigned)wid * 1024u;
    const int aoff = lds_byte(wr * 64 + fr, fq * 8), boff = lds_byte(wc * 32 + fr, fq * 8);
#define PG8_SA(b, h) (((b) * 2 + (h)) * HTB)
#define PG8_SB(b, h) ((4 + (b) * 2 + (h)) * HTB)
#define PG8_STAGE(bufoff, gbase, voff) do { _Pragma("unroll") for (int _i = 0; _i < 2; ++_i) \
        __builtin_amdgcn_global_load_lds((const unsigned*)((const char*)(gbase) + (voff)[_i]), (PG8_LAS unsigned*)(lds + (bufoff) + ldsw + _i * 8192), 16, 0, 0); } while (0)
#define PG8_LDA(dst, b, h) do { _Pragma("unroll") for (int m = 0; m < 4; ++m) _Pragma("unroll") for (int k = 0; k < 2; ++k) dst[m][k] = *(const PG8_LAS bf16x8*)(lds + PG8_SA(b, h) + aoff + m * 2048 + k * 1024); } while (0)
#define PG8_LDB(dst, b, h) do { _Pragma("unroll") for (int n = 0; n < 2; ++n) _Pragma("unroll") for (int k = 0; k < 2; ++k) dst[n][k] = *(const PG8_LAS bf16x8*)(lds + PG8_SB(b, h) + boff + n * 2048 + k * 1024); } while (0)
#define PG8_MMA(ai, bj, At, Bt) do { __builtin_amdgcn_s_setprio(1); _Pragma("unroll") for (int m = 0; m < 4; ++m) _Pragma("unroll") for (int n = 0; n < 2; ++n) _Pragma("unroll") for (int k = 0; k < 2; ++k) \
        acc[ai][bj][m][n] = __builtin_amdgcn_mfma_f32_16x16x32_bf16(Bt[n][k], At[m][k], acc[ai][bj][m][n], 0, 0, 0); __builtin_amdgcn_s_setprio(0); } while (0)
#define PG8_WAIT_V(n) asm volatile("s_waitcnt vmcnt(" #n ")" ::: "memory")
#define PG8_WAIT_L(n) asm volatile("s_waitcnt lgkmcnt(" #n ")" ::: "memory")
#define PG8_BAR __builtin_amdgcn_s_barrier()
#define PG8_SCHED __builtin_amdgcn_sched_barrier(0)
    Unit cur, nxt; int ui = 0;
    if (!S.next(0, cur)) return;
    f32x4 acc[2][2][4][2];
#pragma unroll
    for (int a = 0; a < 2; ++a)
#pragma unroll
        for (int b = 0; b < 2; ++b)
#pragma unroll
            for (int m = 0; m < 4; ++m)
#pragma unroll
                for (int n = 0; n < 2; ++n) acc[a][b][m][n] = (f32x4){0.f, 0.f, 0.f, 0.f};
    bf16x8 At[4][2], B0[2][2], B1[2][2];
    const char* cA = cur.A; const char* cB = cur.B;
    if constexpr (SP2) {
        PG8_STAGE(PG8_SB(0, 0), cB, voffB); PG8_STAGE(PG8_SB(0, 1), cB + hstepB, voffB); PG8_STAGE(PG8_SA(0, 0), cA, voffA); PG8_STAGE(PG8_SA(0, 1), cA + hstepA, voffA);
        if (wr == 1) PG8_BAR;
        PG8_WAIT_V(2); PG8_BAR;
        PG8_STAGE(PG8_SB(1, 0), cB + kstepB, voffB); PG8_STAGE(PG8_SA(1, 0), cA + kstepA, voffA); PG8_STAGE(PG8_SB(1, 1), cB + hstepB + kstepB, voffB);
        PG8_WAIT_V(6); PG8_BAR;
    } else {
        PG8_STAGE(PG8_SB(0, 0), cB, voffB); PG8_STAGE(PG8_SA(0, 0), cA, voffA); PG8_STAGE(PG8_SB(0, 1), cB + hstepB, voffB); PG8_STAGE(PG8_SA(0, 1), cA + hstepA, voffA);
        if (wr == 1) PG8_BAR;
        PG8_WAIT_V(4); PG8_BAR;
        PG8_STAGE(PG8_SB(1, 0), cB + kstepB, voffB); PG8_STAGE(PG8_SA(1, 0), cA + kstepA, voffA); PG8_STAGE(PG8_SB(1, 1), cB + hstepB + kstepB, voffB);
        PG8_WAIT_V(6); PG8_BAR;
    }
    for (;;) {
        const bool has_next = S.next(ui + 1, nxt);
        const char* nA = has_next ? nxt.A : cA; const char* nB = has_next ? nxt.B : cB;
        for (int t = 0; t < nt; t += 2) {
            const bool last = (t == nt - 2);
            const char* a1 = cA + (size_t)(t + 1) * kstepA;
            const char* a2 = last ? nA : cA + (size_t)(t + 2) * kstepA; const char* b2 = last ? nB : cB + (size_t)(t + 2) * kstepB;
            const char* a3 = a2 + kstepA; const char* b3 = b2 + kstepB;
            if constexpr (SP2) {
            PG8_LDB(B0, 0, 0); PG8_LDB(B1, 0, 1); PG8_SCHED; PG8_LDA(At, 0, 0); PG8_STAGE(PG8_SA(1, 1), a1 + hstepA, voffA);
            PG8_WAIT_V(8); PG8_WAIT_L(0); PG8_BAR; PG8_MMA(0, 0, At, B0); PG8_MMA(0, 1, At, B1); PG8_BAR; PG8_SCHED;
            PG8_LDA(At, 0, 1); PG8_STAGE(PG8_SB(0, 0), b2, voffB); PG8_STAGE(PG8_SB(0, 1), b2 + hstepB, voffB); PG8_STAGE(PG8_SA(0, 0), a2, voffA);
            PG8_WAIT_V(8); PG8_WAIT_L(0); PG8_BAR; PG8_MMA(1, 0, At, B0); PG8_MMA(1, 1, At, B1); PG8_BAR; PG8_SCHED;
            PG8_LDB(B0, 1, 0); PG8_LDB(B1, 1, 1); PG8_SCHED; PG8_LDA(At, 1, 0); PG8_STAGE(PG8_SA(0, 1), a2 + hstepA, voffA);
            PG8_WAIT_V(8); PG8_WAIT_L(0); PG8_BAR; PG8_MMA(0, 0, At, B0); PG8_MMA(0, 1, At, B1); PG8_BAR; PG8_SCHED;
            PG8_LDA(At, 1, 1); PG8_STAGE(PG8_SB(1, 0), b3, voffB); PG8_STAGE(PG8_SB(1, 1), b3 + hstepB, voffB); PG8_STAGE(PG8_SA(1, 0), a3, voffA);
            PG8_WAIT_V(8); PG8_WAIT_L(0); PG8_BAR; PG8_MMA(1, 0, At, B0); PG8_MMA(1, 1, At, B1); PG8_BAR; PG8_SCHED;
            } else {
            PG8_LDB(B0, 0, 0); PG8_SCHED; PG8_LDA(At, 0, 0); PG8_STAGE(PG8_SA(1, 1), a1 + hstepA, voffA);
            PG8_WAIT_L(8); PG8_BAR; PG8_WAIT_L(0); PG8_MMA(0, 0, At, B0); PG8_BAR; PG8_SCHED;
            PG8_LDB(B1, 0, 1); PG8_STAGE(PG8_SB(0, 0), b2, voffB);
            PG8_BAR; PG8_WAIT_L(0); PG8_MMA(0, 1, At, B1); PG8_BAR;
            PG8_LDA(At, 0, 1); PG8_STAGE(PG8_SA(0, 0), a2, voffA);
            PG8_BAR; PG8_WAIT_L(0); PG8_MMA(1, 0, At, B0); PG8_BAR; PG8_SCHED;
            PG8_STAGE(PG8_SB(0, 1), b2 + hstepB, voffB);
            PG8_WAIT_V(6); PG8_BAR; PG8_MMA(1, 1, At, B1); PG8_BAR;
            PG8_LDB(B0, 1, 0); PG8_SCHED; PG8_LDA(At, 1, 0); PG8_STAGE(PG8_SA(0, 1), a2 + hstepA, voffA);
            PG8_WAIT_L(8); PG8_BAR; PG8_WAIT_L(0); PG8_MMA(0, 0, At, B0); PG8_BAR; PG8_SCHED;
            PG8_LDB(B1, 1, 1); PG8_STAGE(PG8_SB(1, 0), b3, voffB);
            PG8_BAR; PG8_WAIT_L(0); PG8_MMA(0, 1, At, B1); PG8_BAR;
            PG8_LDA(At, 1, 1); PG8_STAGE(PG8_SA(1, 0), a3, voffA);
            PG8_BAR; PG8_WAIT_L(0); PG8_MMA(1, 0, At, B0); PG8_BAR; PG8_SCHED;
            PG8_STAGE(PG8_SB(1, 1), b3 + hstepB, voffB);
            PG8_WAIT_V(6); PG8_BAR; PG8_MMA(1, 1, At, B1); PG8_BAR;
            }
        }
        if constexpr (ALIGN_EPI) { if (wr == 0) PG8_BAR; }
        E(acc, cur, wr, wc, fr, fq);
        if (!has_next) break;
#pragma unroll
        for (int a = 0; a < 2; ++a)
#pragma unroll
            for (int b = 0; b < 2; ++b)
#pragma unroll
                for (int m = 0; m < 4; ++m)
#pragma unroll
                    for (int n = 0; n < 2; ++n) acc[a][b][m][n] = (f32x4){0.f, 0.f, 0.f, 0.f};
        cur = nxt; cA = nA; cB = nB; ++ui;
        if constexpr (ALIGN_EPI) { if (wr == 1) PG8_BAR; }
    }
    PG8_WAIT_V(0);
    if constexpr (!ALIGN_EPI) { if (wr == 0) PG8_BAR; }
    PG8_BAR;
#undef PG8_SA
#undef PG8_SB
#undef PG8_STAGE
#undef PG8_LDA
#undef PG8_LDB
#undef PG8_MMA
#undef PG8_WAIT_V
#undef PG8_WAIT_L
#undef PG8_BAR
#undef PG8_SCHED
}
}


struct SchedMN {
    int nM, nN, nz, G, c, pm_off; const char* A0; const char* A1; const char* B0; const char* B1; size_t a_tile, b_tile;
    __device__ __forceinline__ bool next(int i, pg8::Unit& u) const {
        int pm, pn; if (!pg8::tile_of((long)(i / nz) * G + c, nM, nN, pm, pn)) return false;
        u.z = i % nz; u.pm = pm + pm_off; u.pn = pn; u.A = (u.z ? A1 : A0) + (size_t)u.pm * a_tile; u.B = (u.z ? B1 : B0) + (size_t)pn * b_tile; return true;
    }
};
struct SchedCmp {
    int c; const char* proj; const char* w1k; const char* w1v;
    __device__ __forceinline__ bool next(int i, pg8::Unit& u) const {
        if (i > ((PROBE_REP) == 22 ? 1 : 0) || c >= 16) return false;
        u.z = c >> 2; u.pm = c & 3; u.pn = 0; const int which = u.z >> 1, kh = u.z & 1;
        u.A = proj + ((size_t)(16 * 256 * u.pm) * PP + (which ? C_VC : C_KC) + kh * 64) * 2; u.B = which ? w1v : w1k; return true;
    }
};

#define EPI_LOOP_ROWS for (int ai = 0; ai < 2; ++ai) _Pragma("unroll") for (int m = 0; m < 4; ++m)

struct EpiProj {
    static constexpr bool PERM = true;
    bf16_t* proj; bf16_t* vslt; bf16_t* vwnt; bf16_t* kslc; bf16_t* kwnc; const float* rstd; const float* ropec; const float* ropes;
    __device__ __forceinline__ void operator()(const f32x4 (&acc)[2][2][4][2], const pg8::Unit& u, int wr, int wc, int fr, int fq) const {
        const int pn = u.pn; const int row0 = u.pm * 256 + wr * 64 + fr;
        const bool sig = pn >= 7;
#pragma unroll
        EPI_LOOP_ROWS {
            const int row = row0 + ai * 128 + m * 16; const float rs = rstd[row];
            f32x4 c0 = {1.f, 1.f, 1.f, 1.f}, c1 = c0, s0 = {0.f, 0.f, 0.f, 0.f}, s1 = s0;
            if ((pn <= 1 || pn == 3 || pn == 4) && (wc & 1) == 0) { c0 = *(const f32x4*)(ropec + row * 8); c1 = *(const f32x4*)(ropec + row * 8 + 4); s0 = *(const f32x4*)(ropes + row * 8); s1 = *(const f32x4*)(ropes + row * 8 + 4); }
#pragma unroll
            for (int bj = 0; bj < 2; ++bj) {
                f32x4 v0 = acc[ai][bj][m][0] * rs, v1 = acc[ai][bj][m][1] * rs;
                const int colt = bj * 128 + wc * 32 + 8 * fq;
                const bool ropet = (pn <= 1) || ((pn == 3 || pn == 4) && bj == 0);
                if (ropet && (wc & 1) == 0) {
                    f32x4 p0, p1;
#pragma unroll
                    for (int e = 0; e < 4; ++e) { p0[e] = __shfl_xor(v0[e], 16); p1[e] = __shfl_xor(v1[e], 16); }
                    if (fq == 0) { v0 = v0 * c0 - p0 * s0; v1 = v1 * c1 - p1 * s1; }
                    else if (fq == 1) { v0 = v0 * c0 + p0 * s0; v1 = v1 * c1 + p1 * s1; }
                }
                if (pn <= 1) { v0 = v0 * (0.125f * 1.4426950408889634f); v1 = v1 * (0.125f * 1.4426950408889634f); }
                if (sig) {
#pragma unroll
                    for (int e = 0; e < 4; ++e) { v0[e] = sigmoidf_(v0[e]); v1[e] = sigmoidf_(v1[e]); }
                }
                const u32x4 w = pack8(v0, v1);
                if (!((pn == 3 || pn == 4))) *(u32x4*)(proj + (size_t)row * PP + pn * 256 + colt) = w;
                if ((pn == 3 || pn == 4) && bj == 0) { bf16_t* kc = (pn == 3) ? kslc : kwnc; *(u32x4*)(kc + ((size_t)(colt >> 6) * SEQ + row) * 64 + (colt & 63)) = w; }
                if ((pn == 3 || pn == 4) && bj == 1) {
                    bf16_t* vt = ((pn == 3) ? vslt : vwnt) + ((size_t)((colt - 128) >> 6) * 256 + (row >> 6)) * 4096 + (size_t)((colt - 128) & 63) * 64 + (row & 63);
                    vt[0 * 64] = (bf16_t)(w.x & 0xffff); vt[1 * 64] = (bf16_t)(w.x >> 16); vt[2 * 64] = (bf16_t)(w.y & 0xffff); vt[3 * 64] = (bf16_t)(w.y >> 16);
                    vt[4 * 64] = (bf16_t)(w.z & 0xffff); vt[5 * 64] = (bf16_t)(w.z >> 16); vt[6 * 64] = (bf16_t)(w.w & 0xffff); vt[7 * 64] = (bf16_t)(w.w >> 16);
                }
            }
        }
    }
};

struct EpiCmp {
    static constexpr bool PERM = true;
    bf16_t* hid; const float* biaspe;
    __device__ __forceinline__ void operator()(const f32x4 (&acc)[2][2][4][2], const pg8::Unit& u, int wr, int wc, int fr, int fq) const {
        const int row0 = u.pm * 256 + wr * 64 + fr; const int which = u.z >> 1;
#pragma unroll
        for (int bj = 0; bj < 2; ++bj) {
            const int col = bj * 128 + wc * 32 + 8 * fq;
            const f32x4 b0 = *(const f32x4*)(biaspe + which * 256 + col), b1 = *(const f32x4*)(biaspe + which * 256 + col + 4);
#pragma unroll
            EPI_LOOP_ROWS {
                const int row = row0 + ai * 128 + m * 16;
                f32x4 v0 = acc[ai][bj][m][0] + b0, v1 = acc[ai][bj][m][1] + b1;
#pragma unroll
                for (int e = 0; e < 4; ++e) { v0[e] = gelu_tanh(v0[e]); v1[e] = gelu_tanh(v1[e]); }
                *(u32x4*)(hid + ((size_t)u.z * 1024 + row) * 256 + col) = pack8(v0, v1);
            }
        }
    }
};

struct EpiGlu {
    static constexpr bool PERM = true;
    const bf16_t* ybp; bf16_t* yb;
    __device__ __forceinline__ void operator()(const f32x4 (&acc)[2][2][4][2], const pg8::Unit& u, int wr, int wc, int fr, int fq) const {
        const int row0 = u.pm * 256 + wr * 64 + fr;
#pragma unroll
        EPI_LOOP_ROWS {
            const int row = row0 + ai * 128 + m * 16;
#pragma unroll
            for (int bj = 0; bj < 2; ++bj) {
                const size_t off = (size_t)row * 512 + u.pn * 256 + bj * 128 + wc * 32 + 8 * fq;
                const u32x4 y = *(const u32x4*)(ybp + off);
                f32x4 v0 = acc[ai][bj][m][0], v1 = acc[ai][bj][m][1];
                v0[0] = bf_lo(y.x) * sigmoidf_(v0[0]); v0[1] = bf_hi(y.x) * sigmoidf_(v0[1]); v0[2] = bf_lo(y.y) * sigmoidf_(v0[2]); v0[3] = bf_hi(y.y) * sigmoidf_(v0[3]);
                v1[0] = bf_lo(y.z) * sigmoidf_(v1[0]); v1[1] = bf_hi(y.z) * sigmoidf_(v1[1]); v1[2] = bf_lo(y.w) * sigmoidf_(v1[2]); v1[3] = bf_hi(y.w) * sigmoidf_(v1[3]);
                *(u32x4*)(yb + off) = pack8(v0, v1);
            }
        }
    }
};

struct EpiMerge {
    static constexpr bool PERM = true;
    const bf16_t* proj; bf16_t* merged;
    __device__ __forceinline__ void operator()(const f32x4 (&acc)[2][2][4][2], const pg8::Unit& u, int wr, int wc, int fr, int fq) const {
        const int row0 = u.pm * 256 + wr * 64 + fr; const int gcol = u.z ? C_GB : C_GA;
#pragma unroll
        EPI_LOOP_ROWS {
            const int row = row0 + ai * 128 + m * 16;
#pragma unroll
            for (int bj = 0; bj < 2; ++bj) {
                const int col = u.pn * 256 + bj * 128 + wc * 32 + 8 * fq;
                const u32x4 gt = *(const u32x4*)(proj + (size_t)row * PP + gcol + col);
                f32x4 v0 = acc[ai][bj][m][0], v1 = acc[ai][bj][m][1];
                v0[0] *= bf_lo(gt.x); v0[1] *= bf_hi(gt.x); v0[2] *= bf_lo(gt.y); v0[3] *= bf_hi(gt.y);
                v1[0] *= bf_lo(gt.z); v1[1] *= bf_hi(gt.z); v1[2] *= bf_lo(gt.w); v1[3] *= bf_hi(gt.w);
                bf16_t* dst = merged + (size_t)row * DM + col;
                if (u.z) { const u32x4 o = *(const u32x4*)dst;
                    v0[0] += bf_lo(o.x); v0[1] += bf_hi(o.x); v0[2] += bf_lo(o.y); v0[3] += bf_hi(o.y); v1[0] += bf_lo(o.z); v1[1] += bf_hi(o.z); v1[2] += bf_lo(o.w); v1[3] += bf_hi(o.w); }
                *(u32x4*)dst = pack8(v0, v1);
            }
        }
    }
};

struct EpiRes {
    static constexpr bool PERM = true;
    const float* xin; float* xo; bf16_t* xb; float* rss;
    __device__ __forceinline__ void operator()(const f32x4 (&acc)[2][2][4][2], const pg8::Unit& u, int wr, int wc, int fr, int fq) const {
        const int row0 = u.pm * 256 + wr * 64 + fr;
#pragma unroll
        EPI_LOOP_ROWS {
            const int row = row0 + ai * 128 + m * 16; float ss = 0.f;
#pragma unroll
            for (int bj = 0; bj < 2; ++bj) {
                const size_t off = (size_t)row * DM + u.pn * 256 + bj * 128 + wc * 32 + 8 * fq;
                const f32x4 v0 = *(const f32x4*)(xin + off) + acc[ai][bj][m][0], v1 = *(const f32x4*)(xin + off + 4) + acc[ai][bj][m][1];
                *(f32x4*)(xo + off) = v0; *(f32x4*)(xo + off + 4) = v1;
                if (xb) *(u32x4*)(xb + off) = pack8(v0, v1);
                ss += (v0[0] * v0[0] + v0[1] * v0[1]) + (v0[2] * v0[2] + v0[3] * v0[3]) + (v1[0] * v1[0] + v1[1] * v1[1]) + (v1[2] * v1[2] + v1[3] * v1[3]);
            }
            ss += __shfl_xor(ss, 16); ss += __shfl_xor(ss, 32);
            if (fq == 0) atomicAdd(rss + row, ss);
        }
    }
};

struct EpiUp {
    static constexpr bool PERM = true;
    bf16_t* up; const float* rss; int rowbase;
    __device__ __forceinline__ void operator()(const f32x4 (&acc)[2][2][4][2], const pg8::Unit& u, int wr, int wc, int fr, int fq) const {
        const int row0 = u.pm * 256 + wr * 64 + fr;
#pragma unroll
        EPI_LOOP_ROWS {
            const int row = row0 + ai * 128 + m * 16; const float rs = rsqrtf(rss[row] * (1.f / DM) + EPS);
#pragma unroll
            for (int bj = 0; bj < 2; ++bj) {
                const size_t off = (size_t)(row - rowbase) * NUP + u.pn * 256 + bj * 128 + wc * 32 + 8 * fq;
                *(u32x4*)(up + off) = pack8(acc[ai][bj][m][0] * rs, acc[ai][bj][m][1] * rs);
            }
        }
    }
};

struct Args { const float* in[28]; float* out; unsigned char* ws; };
constexpr int NT = 512, NWV = 8;
constexpr int LDS_BYTES = 147456;

__device__ __forceinline__ float wave_sum(float v) {
#pragma unroll
    for (int o = 1; o < 64; o <<= 1) v += __shfl_xor(v, o);
    return v;
}

#define XB_TMO      128
#define XB_XCNT(j)  (256  + 64 * (j))
#define XB_XSUB(j)  (1280 + 64 * (j))
#define XB_XGEN(j)  (2304 + 64 * (j))
#define XB_TOP      3328
#define XB_TOPGEN   3392
#define XCD_BAR_WORDS 3456
#define XB_SPIN_CAP (1u << 18)

__device__ __forceinline__ unsigned xb_ld(unsigned* p)              { return __hip_atomic_load(p, __ATOMIC_RELAXED, __HIP_MEMORY_SCOPE_AGENT); }
__device__ __forceinline__ unsigned xb_add(unsigned* p, unsigned v) { return __hip_atomic_fetch_add(p, v, __ATOMIC_RELAXED, __HIP_MEMORY_SCOPE_AGENT); }
__device__ __forceinline__ unsigned xb_xcc_id() { return (unsigned)__builtin_amdgcn_s_getreg((3 << 11) | 20) & 0xFu; }
#define XB_SPIN(cond, bar) do { unsigned _sp = 0; while (cond) { __builtin_amdgcn_s_sleep(1); \
    if ((++_sp & 255u) == 0u) { if (xb_ld(&(bar)[XB_TMO])) break; if (_sp > XB_SPIN_CAP) { atomicAdd(&(bar)[XB_TMO], 1u); break; } } } } while (0)

struct XcdBarrier {
    unsigned* bar; unsigned x;
    volatile LAS unsigned* st;
};

__device__ __forceinline__ XcdBarrier xcd_barrier_post(unsigned* bar, volatile LAS unsigned* st) {
    XcdBarrier b; b.bar = bar; b.x = xb_xcc_id(); b.st = st;
    if (threadIdx.x == 0) (void)xb_add(&bar[XB_XCNT(b.x)], 1u);
    return b;
}
__device__ __forceinline__ void xcd_barrier_complete(unsigned* bar, unsigned x, unsigned& nloc, unsigned& nx) {
    const unsigned G = gridDim.x * gridDim.y * gridDim.z;
    unsigned sum, cnt, mine, sp = 0u;
    for (;;) {
        sum = 0u; cnt = 0u; mine = 0u;
#pragma unroll
        for (unsigned j = 0; j < 16; ++j) { const unsigned c = xb_ld(&bar[XB_XCNT(j)]); sum += c; cnt += (c > 0u) ? 1u : 0u; mine = (j == x) ? c : mine; }
        if (sum == G) break;
        __builtin_amdgcn_s_sleep(1);
        if ((++sp & 255u) == 0u) { if (xb_ld(&bar[XB_TMO])) break; if (sp > XB_SPIN_CAP) { atomicAdd(&bar[XB_TMO], 1u); break; } }
    }
    nloc = mine > 0u ? mine : 1u; nx = cnt > 0u ? cnt : 1u;
}

__device__ __forceinline__ void xcd_barrier(const XcdBarrier& b) {
    asm volatile("s_waitcnt vmcnt(0)" ::: "memory");
    __syncthreads();
    if (threadIdx.x == 0) {
        unsigned* bar = b.bar;
        __builtin_amdgcn_s_waitcnt(0);
        unsigned nloc = b.st[0], nx = b.st[1];
        if (nloc == 0u) { xcd_barrier_complete(bar, b.x, nloc, nx); b.st[0] = nloc; b.st[1] = nx; }
        const unsigned old = xb_add(&bar[XB_XSUB(b.x)], 1u);
        const unsigned gen = old / nloc;
        if (old + 1u == (gen + 1u) * nloc) {
            __builtin_amdgcn_fence(__ATOMIC_RELEASE, "agent");
            asm volatile("s_waitcnt vmcnt(0)" ::: "memory");
            const unsigned og = xb_add(&bar[XB_TOP], 1u);
            const unsigned tg = og / nx;
            if (og + 1u == (tg + 1u) * nx) xb_add(&bar[XB_TOPGEN], 1u);
            else XB_SPIN(xb_ld(&bar[XB_TOPGEN]) == tg, bar);
            __builtin_amdgcn_fence(__ATOMIC_ACQUIRE, "agent");
            xb_add(&bar[XB_XGEN(b.x)], 1u);
            asm volatile("s_waitcnt vmcnt(0)" ::: "memory");
        } else {
            XB_SPIN(xb_ld(&bar[XB_XGEN(b.x)]) == gen, bar);
            __builtin_amdgcn_fence(__ATOMIC_ACQUIRE, "agent");
            asm volatile("s_waitcnt vmcnt(0)" ::: "memory");
        }
    }
    __syncthreads();
}

__device__ __forceinline__ int colmap(int kind, int c) {
    if (kind == 1) return c < 1280 ? c : (c < 1304 ? C_NG + (c - 1280) : c - 24);
    if (kind == 2) { return c < DFF ? (c >> 7) * 256 + (c & 127) : ((c - DFF) >> 7) * 256 + 128 + ((c - DFF) & 127); }
    return c;
}
__device__ __forceinline__ void transpose_item(const float* W, int K, int N, bf16_t* WT, LAS float* scr, int kb, int nb, int lane, const float* kscale, int kind) {
    const int k0 = 64 * kb, n0 = 32 * nb;
#pragma unroll 8
    for (int i = 0; i < 32; ++i) { const int kk = 2 * i + (lane >> 5), n = n0 + (lane & 31); float v = (n < N) ? W[(size_t)(k0 + kk) * N + n] : 0.f; if (kscale) v *= kscale[k0 + kk]; scr[kk * 33 + (lane & 31)] = v; }
    asm volatile("s_waitcnt lgkmcnt(0)" ::: "memory");
    const int c = lane & 7;
#pragma unroll
    for (int j = 0; j < 4; ++j) { const int n = (lane >> 3) + 8 * j; const LAS float* s = scr + (8 * c) * 33 + n;
        if (n0 + n < N) { u32x4 o; o.x = cvt_pk_bf16(s[0 * 33], s[1 * 33]); o.y = cvt_pk_bf16(s[2 * 33], s[3 * 33]); o.z = cvt_pk_bf16(s[4 * 33], s[5 * 33]); o.w = cvt_pk_bf16(s[6 * 33], s[7 * 33]);
            *(u32x4*)(WT + (size_t)colmap(kind, n0 + n) * K + k0 + 8 * c) = o; } }
    asm volatile("s_waitcnt lgkmcnt(0)" ::: "memory");
}

#define EXP2(x) __builtin_amdgcn_exp2f(x)
#define MFMA16(a, b, c) __builtin_amdgcn_mfma_f32_16x16x32_bf16((a), (b), (c), 0, 0, 0)
__device__ __forceinline__ float dpp_x1(float v) { return __int_as_float(__builtin_amdgcn_update_dpp(0, __float_as_int(v), 0xB1, 0xF, 0xF, true)); }
__device__ __forceinline__ float dpp_x2(float v) { return __int_as_float(__builtin_amdgcn_update_dpp(0, __float_as_int(v), 0x4E, 0xF, 0xF, true)); }
struct KOp { bf16x8 a00, a01, a10, a11; };
struct VOp { bf16x8 v0, v1, v2, v3; };
__device__ __forceinline__ KOp ldk(const bf16_t* Kb, size_t pitch, int kb, int lane) {
    const int i = lane & 15, q = lane >> 4;
    const bf16_t* r0 = Kb + (size_t)(kb + 8 * (i >> 2) + (i & 3)) * pitch + 8 * q; const bf16_t* r1 = r0 + 4 * pitch;
    KOp k; k.a00 = *(const bf16x8*)r0; k.a01 = *(const bf16x8*)(r0 + 32); k.a10 = *(const bf16x8*)r1; k.a11 = *(const bf16x8*)(r1 + 32); return k;
}
__device__ __forceinline__ VOp ldv(const bf16_t* Vt, size_t vpitch, int kb, int lane) {
    const int i = lane & 15, q = lane >> 4; const size_t base = (vpitch == 64) ? (size_t)(kb >> 6) * 4096 + (kb & 63) : (size_t)kb;
    const bf16_t* r = Vt + base + (size_t)i * vpitch + 8 * q;
    VOp v; v.v0 = *(const bf16x8*)r; v.v1 = *(const bf16x8*)(r + 16 * vpitch); v.v2 = *(const bf16x8*)(r + 32 * vpitch); v.v3 = *(const bf16x8*)(r + 48 * vpitch); return v;
}
__device__ __forceinline__ void qk32(const KOp& k, const bf16x8& Bq0, const bf16x8& Bq1, f32x4& S0, f32x4& S1) {
    const f32x4 z = {0.f, 0.f, 0.f, 0.f};
    S0 = MFMA16(k.a00, Bq0, z); S0 = MFMA16(k.a01, Bq1, S0); S1 = MFMA16(k.a10, Bq0, z); S1 = MFMA16(k.a11, Bq1, S1);
}
__device__ __forceinline__ void pv32(const VOp& v, const bf16x8& P, f32x4 (&O)[4]) {
    O[0] = MFMA16(v.v0, P, O[0]); O[1] = MFMA16(v.v1, P, O[1]); O[2] = MFMA16(v.v2, P, O[2]); O[3] = MFMA16(v.v3, P, O[3]);
}
__device__ __forceinline__ bf16x8 packP(const f32x4& p0, const f32x4& p1) { u32x4 w = pack8(p0, p1); return __builtin_bit_cast(bf16x8, w); }

struct KbLin { int base; __device__ __forceinline__ int operator()(int i) const { return base + 32 * i; } };
struct KbLds { const LAS int* l; __device__ __forceinline__ int operator()(int i) const { return l[i]; } };

template <bool NEEDV, class KB, class Body>
__device__ __forceinline__ void pipe3(int n, const KB kbf, Body& body, const bf16_t* Kb, size_t kp, const bf16_t* Vt, size_t vp, int lane) {
    if (n <= 0) return;
    KOp k0, k1; VOp v;
    k0 = ldk(Kb, kp, kbf(0), lane);
    for (int i = 0; i < n; i += 2) {
        { const int kb = kbf(i); if (NEEDV) v = ldv(Vt, vp, kb, lane); k1 = ldk(Kb, kp, kbf(i + 1 < n ? i + 1 : n - 1), lane); body.run(kb, k0, v); }
        if (i + 1 >= n) break;
        { const int kb = kbf(i + 1); if (NEEDV) v = ldv(Vt, vp, kb, lane); k0 = ldk(Kb, kp, kbf(i + 2 < n ? i + 2 : n - 1), lane); body.run(kb, k1, v); }
    }
}

struct BodyCmp1 {
    bf16x8 Bq[2][2]; int nv[2], q; float ml[2], ll[2];
    __device__ __forceinline__ void run(int kb, const KOp& k, const VOp&) {
#pragma unroll
        for (int cg = 0; cg < 2; ++cg) {
            f32x4 S0, S1; qk32(k, Bq[cg][0], Bq[cg][1], S0, S1);
            const int k0 = kb + 8 * q; float mloc = NEGF;
#pragma unroll
            for (int e = 0; e < 4; ++e) { if (k0 + e >= nv[cg]) S0[e] = NEGF; if (k0 + 4 + e >= nv[cg]) S1[e] = NEGF; mloc = fmaxf(mloc, fmaxf(S0[e], S1[e])); }
            const float mn = fmaxf(ml[cg], mloc); float ps = 0.f;
#pragma unroll
            for (int e = 0; e < 4; ++e) { ps += (k0 + e < nv[cg]) ? EXP2(S0[e] - mn) : 0.f; ps += (k0 + 4 + e < nv[cg]) ? EXP2(S1[e] - mn) : 0.f; }
            ll[cg] = ll[cg] * EXP2(ml[cg] - mn) + ps; ml[cg] = mn;
        }
    }
};
struct BodyCmp2 {
    bf16x8 Bq[2][2]; int nv[2], q, g, lane_; float mc[2], inv[2], carry[2]; LAS float* ia[2]; f32x4 O[2][4];
    __device__ __forceinline__ void run(int kb, const KOp& k, const VOp& v) {
#pragma unroll
        for (int cg = 0; cg < 2; ++cg) {
            f32x4 S0, S1; qk32(k, Bq[cg][0], Bq[cg][1], S0, S1);
            const int k0 = kb + 8 * q; f32x4 p0, p1;
#pragma unroll
            for (int e = 0; e < 4; ++e) { p0[e] = (k0 + e < nv[cg]) ? EXP2(S0[e] - mc[cg]) * inv[cg] : 0.f; p1[e] = (k0 + 4 + e < nv[cg]) ? EXP2(S1[e] - mc[cg]) * inv[cg] : 0.f; }
            f32x4 s0 = p0, s1 = p1;
#pragma unroll
            for (int e = 0; e < 4; ++e) { s0[e] += dpp_x1(s0[e]); s0[e] += dpp_x2(s0[e]); s1[e] += dpp_x1(s1[e]); s1[e] += dpp_x2(s1[e]); }
            const float bout = 0.5f * s1[3]; const float recv = __shfl(bout, (lane_ + 48) & 63); const float bin = (q == 0) ? carry[cg] : recv; carry[cg] = recv;
            if (g == 0) { const int j = k0 >> 2; ia[cg][j] = ((s0[0] + s0[1]) + (s0[2] + 0.5f * s0[3])) + bin; ia[cg][j + 1] = 0.5f * s0[3] + ((s1[0] + s1[1]) + (s1[2] + 0.5f * s1[3])); }
            pv32(v, packP(p0, p1), O[cg]);
        }
    }
};
struct BodyWin {
    bf16x8 Bq[2][2]; int q, tt[2]; float m[2], l[2]; f32x4 O[2][4];
    __device__ __forceinline__ void run(int kb, const KOp& k, const VOp& v) {
#pragma unroll
        for (int cg = 0; cg < 2; ++cg) {
            f32x4 S0, S1; qk32(k, Bq[cg][0], Bq[cg][1], S0, S1);
            const int k0 = kb + 8 * q; unsigned vm = 0u;
#pragma unroll
            for (int e = 0; e < 8; ++e) { const bool ok = (k0 + e <= tt[cg]) && (tt[cg] - (k0 + e) < 512); vm |= ok ? (1u << e) : 0u; }
            float mloc = NEGF;
#pragma unroll
            for (int e = 0; e < 4; ++e) { if (!((vm >> e) & 1u)) S0[e] = NEGF; if (!((vm >> (4 + e)) & 1u)) S1[e] = NEGF; mloc = fmaxf(mloc, fmaxf(S0[e], S1[e])); }
            mloc = fmaxf(mloc, __shfl_xor(mloc, 16)); mloc = fmaxf(mloc, __shfl_xor(mloc, 32));
            const float mn = fmaxf(m[cg], mloc), alpha = EXP2(m[cg] - mn); m[cg] = mn;
            f32x4 p0, p1; float ps = 0.f;
#pragma unroll
            for (int e = 0; e < 4; ++e) { p0[e] = ((vm >> e) & 1u) ? EXP2(S0[e] - mn) : 0.f; p1[e] = ((vm >> (4 + e)) & 1u) ? EXP2(S1[e] - mn) : 0.f; ps += p0[e] + p1[e]; }
            l[cg] = l[cg] * alpha + ps;
#pragma unroll
            for (int dt = 0; dt < 4; ++dt) O[cg][dt] = O[cg][dt] * alpha;
            pv32(v, packP(p0, p1), O[cg]);
        }
    }
};

struct AttnT { float fxs; unsigned long long* tsa; const bf16_t* proj; const bf16_t* kslc; const bf16_t* kwnc; const bf16_t* kcmp; const bf16_t* vcmpT; const bf16_t* vslT; const bf16_t* vwnT; bf16_t* ya; };

constexpr int AL_IMP = 0  , AL_OS = 0  , AL_TM = 67584  , AL_CNT = 69632  ,
              AL_OFF = 70656  , AL_UNITS = 71744  , AL_MM = 77888  , AL_LS = 78912  ;
constexpr int AL_Q = 81920  , QROWB = 528;
constexpr int OSP = 33;
constexpr float FXB = 67108864.0f;
typedef short s16x2 __attribute__((ext_vector_type(2)));
__device__ __forceinline__ int f2ord(float f) { const int b = __float_as_int(f); return b >= 0 ? b : b ^ 0x7fffffff; }
__device__ __forceinline__ float ord2f(int b) { return __int_as_float(b >= 0 ? b : b ^ 0x7fffffff); }

__device__ __forceinline__ void attn_wave_part1(const AttnT& T, int kh, int tq8, int lane, LAS float* imp  , LAS unsigned* tm, int wave) {
    const int col = lane & 15, q = lane >> 4, tk = col >> 2, g = col & 3;
    const int t0 = tq8 * 8, h = kh * 4 + g;
    bf16x8 Bq[2][2]; float g0[2], g2[2]; int tcg[2];
#pragma unroll
    for (int cg = 0; cg < 2; ++cg) { tcg[cg] = t0 + 4 * cg + tk; const bf16_t* prow = T.proj + (size_t)tcg[cg] * PP;
        Bq[cg][0] = *(const bf16x8*)(prow + C_Q + h * 64 + 8 * q); Bq[cg][1] = *(const bf16x8*)(prow + C_Q + h * 64 + 32 + 8 * q);
        g0[cg] = bf2f(prow[C_NG + h * 3 + 0]); g2[cg] = bf2f(prow[C_NG + h * 3 + 2]); }
    for (int i = lane; i < 8 * 264; i += 64) imp[i] = 0.f;
    {
        const bf16_t* Kc = T.kcmp + (size_t)kh * 1024 * 64; const bf16_t* Vc = T.vcmpT + (size_t)kh * 64 * 1024;
        const int tmax = t0 + 7, nvmax = tmax >= 31 ? ((tmax - 31) >> 4) + 1 : 0, nsteps = (nvmax + 31) >> 5;
        BodyCmp1 b1;
#pragma unroll
        for (int cg = 0; cg < 2; ++cg) { b1.Bq[cg][0] = Bq[cg][0]; b1.Bq[cg][1] = Bq[cg][1]; b1.nv[cg] = tcg[cg] >= 31 ? ((tcg[cg] - 31) >> 4) + 1 : 0; b1.ml[cg] = NEGF; b1.ll[cg] = 0.f; }
        b1.q = q;
        pipe3<false>(nsteps, KbLin{0}, b1, Kc, 64, Vc, 1024, lane);
        BodyCmp2 b2; b2.q = q; b2.g = g; b2.lane_ = lane; b2.carry[0] = 0.f; b2.carry[1] = 0.f;
#pragma unroll
        for (int cg = 0; cg < 2; ++cg) {
            float mc = fmaxf(b1.ml[cg], __shfl_xor(b1.ml[cg], 16)); mc = fmaxf(mc, __shfl_xor(mc, 32));
            float lc = b1.ll[cg] * EXP2(b1.ml[cg] - mc); lc += __shfl_xor(lc, 16); lc += __shfl_xor(lc, 32);
            b2.Bq[cg][0] = Bq[cg][0]; b2.Bq[cg][1] = Bq[cg][1]; b2.nv[cg] = b1.nv[cg]; b2.mc[cg] = mc; b2.inv[cg] = 1.f / fmaxf(lc, 1e-30f); b2.ia[cg] = imp + (4 * cg + tk) * 264;
#pragma unroll
            for (int dt = 0; dt < 4; ++dt) b2.O[cg][dt] = (f32x4){0.f, 0.f, 0.f, 0.f};
        }
        asm volatile("s_waitcnt lgkmcnt(0)" ::: "memory");
        pipe3<true>(nsteps, KbLin{0}, b2, Kc, 64, Vc, 1024, lane);
        if (q == 0 && g == 0 && nsteps > 0) { b2.ia[0][8 * nsteps] = b2.carry[0]; b2.ia[1][8 * nsteps] = b2.carry[1]; }
#pragma unroll
        for (int cg = 0; cg < 2; ++cg) { bf16_t* yrow = T.ya + (size_t)tcg[cg] * 512 + h * 64 + 4 * q;
#pragma unroll
            for (int dt = 0; dt < 4; ++dt) { const f32x4 o = b2.O[cg][dt] * g0[cg]; u32x2 w; w.x = cvt_pk_bf16(o[0], o[1]); w.y = cvt_pk_bf16(o[2], o[3]); *(u32x2*)(yrow + 16 * dt) = w; } }
    }
    asm volatile("s_waitcnt lgkmcnt(0)" ::: "memory");
    for (int tk2 = 0; tk2 < 8; ++tk2) {
        const int tt = t0 + tk2, cur = tt >> 6, nvalid = cur + 1, KSEL = nvalid < 16 ? nvalid : 16;
        int bits[4];
#pragma unroll
        for (int s = 0; s < 4; ++s) { const int j = s * 64 + lane; const float v = imp[tk2 * 264 + j];
            bits[s] = (j == 0 || j == cur) ? 0x7F000000 : (j < nvalid ? __float_as_int(v) : -1); }
        int prefix = 0;
        for (int bit = 30; bit >= 0; --bit) { const int Tt = prefix | (1 << bit); int cnt = 0;
#pragma unroll
            for (int s = 0; s < 4; ++s) cnt += __popcll(__ballot(bits[s] >= Tt));
            if (cnt >= KSEL) prefix = Tt; }
        unsigned long long sel[4]; int need = KSEL;
#pragma unroll
        for (int s = 0; s < 4; ++s) { sel[s] = __ballot(bits[s] > prefix); need -= __popcll(sel[s]); }
#pragma unroll
        for (int s = 0; s < 4; ++s) { unsigned long long me = __ballot(bits[s] == prefix);
            while (me != 0ull && need > 0) { const unsigned long long low = me & (0ull - me); sel[s] |= low; me ^= low; --need; } }
        const int tbi = wave * 8 + tk2; const unsigned tbit = 1u << (tbi & 31);
#pragma unroll
        for (int s = 0; s < 4; ++s) if ((sel[s] >> lane) & 1ull) __hip_atomic_fetch_or(tm + (s * 64 + lane) * 2 + (tbi >> 5), tbit, __ATOMIC_RELAXED, __HIP_MEMORY_SCOPE_WORKGROUP);
    }
    {
        const bf16_t* Kw = T.kwnc + (size_t)kh * SEQ * 64; const bf16_t* Vw = T.vwnT + (size_t)kh * 256 * 4096;
        const int klo = (t0 - 511 > 0 ? t0 - 511 : 0) & ~31; const int n = ((t0 + 7 - klo) >> 5) + 1;
        BodyWin bo; bo.q = q;
#pragma unroll
        for (int cg = 0; cg < 2; ++cg) { bo.Bq[cg][0] = Bq[cg][0]; bo.Bq[cg][1] = Bq[cg][1]; bo.tt[cg] = tcg[cg]; bo.m[cg] = NEGF; bo.l[cg] = 0.f;
#pragma unroll
            for (int dt = 0; dt < 4; ++dt) bo.O[cg][dt] = (f32x4){0.f, 0.f, 0.f, 0.f}; }
        pipe3<true>(n, KbLin{klo}, bo, Kw, 64, Vw, 64, lane);
#pragma unroll
        for (int cg = 0; cg < 2; ++cg) { float l = bo.l[cg]; l += __shfl_xor(l, 16); l += __shfl_xor(l, 32);
            const float sc = g2[cg] / fmaxf(l, 1e-30f); bf16_t* yrow = T.ya + (size_t)tcg[cg] * 512 + h * 64 + 4 * q;
#pragma unroll
            for (int dt = 0; dt < 4; ++dt) { const u32x2 y = *(const u32x2*)(yrow + 16 * dt); const f32x4 o = bo.O[cg][dt] * sc;
                u32x2 w; w.x = cvt_pk_bf16(bf_lo(y.x) + o[0], bf_hi(y.x) + o[1]); w.y = cvt_pk_bf16(bf_lo(y.y) + o[2], bf_hi(y.y) + o[3]); *(u32x2*)(yrow + 16 * dt) = w; } }
    }
    asm volatile("s_waitcnt lgkmcnt(0)" ::: "memory");
}

struct UnitPre { int j; unsigned tlo, thi; bf16x8 q00, q01, q10, q11; KOp ka, kb; VOp va, vb; };
template <int PASS>
__device__ __forceinline__ UnitPre unit_load(const LAS unsigned char* qlds, const bf16_t* Ks, const bf16_t* Vs, int kh, int tile, const LAS u32x4* units, int u, int lane) {
    const int col = lane & 15, q = lane >> 4, slot = col >> 2, g = col & 3;
    const u32x4 d = units[u]; UnitPre P; P.j = __builtin_amdgcn_readfirstlane((int)d.x); P.tlo = (unsigned)__builtin_amdgcn_readfirstlane((int)d.y); P.thi = (unsigned)__builtin_amdgcn_readfirstlane((int)d.z);
    const unsigned t0b = (P.tlo >> (8 * slot)) & 0xffu, t1b = (P.thi >> (8 * slot)) & 0xffu;
    const LAS unsigned char* qr0 = qlds + (t0b == 0xffu ? 0 : (int)t0b) * QROWB + g * 128 + 16 * q;
    const LAS unsigned char* qr1 = qlds + (t1b == 0xffu ? 0 : (int)t1b) * QROWB + g * 128 + 16 * q;
    P.q00 = *(const LAS bf16x8*)qr0; P.q01 = *(const LAS bf16x8*)(qr0 + 64); P.q10 = *(const LAS bf16x8*)qr1; P.q11 = *(const LAS bf16x8*)(qr1 + 64);
    P.ka = ldk(Ks, 64, 64 * P.j, lane); P.kb = ldk(Ks, 64, 64 * P.j + 32, lane);
    if (PASS == 1) { if ((EXPV) == 2) { P.va.v0 = P.ka.a00; P.va.v1 = P.ka.a01; P.va.v2 = P.ka.a10; P.va.v3 = P.ka.a11; P.vb = P.va; } else { P.va = ldv(Vs, 64, 64 * P.j, lane); P.vb = ldv(Vs, 64, 64 * P.j + 32, lane); } }
    return P;
}
template <int PASS>
__device__ __forceinline__ void unit_group(const UnitPre& P, const bf16x8& q0, const bf16x8& q1, unsigned toks, int tile, LAS unsigned char* lds, float fxs, int lane) {
    const int col = lane & 15, q = lane >> 4, slot = col >> 2, g = col & 3;
    const int ti = (int)((toks >> (8 * slot)) & 0xffu);
    f32x4 S0a, S1a, S0b, S1b; qk32(P.ka, q0, q1, S0a, S1a); qk32(P.kb, q0, q1, S0b, S1b);
    const bool valid = ti != 0xff; const int row = (valid ? ti : 0) * 4 + g;
    const int lim = (P.j == tile) ? (valid ? ti : -1) - 8 * q : (valid ? 1000 : -1);
    LAS int* mm = (LAS int*)(lds + AL_MM); LAS float* ls = (LAS float*)(lds + AL_LS);
    if (PASS == 0) {
        float mloc = NEGF;
#pragma unroll
        for (int e = 0; e < 4; ++e) { mloc = fmaxf(mloc, e <= lim ? S0a[e] : NEGF); mloc = fmaxf(mloc, e + 4 <= lim ? S1a[e] : NEGF); mloc = fmaxf(mloc, e + 32 <= lim ? S0b[e] : NEGF); mloc = fmaxf(mloc, e + 36 <= lim ? S1b[e] : NEGF); }
        if ((EXPV) != 4) { mloc = fmaxf(mloc, __shfl_xor(mloc, 16)); mloc = fmaxf(mloc, __shfl_xor(mloc, 32)); }
        if (q == 0 && valid && (EXPV) != 3) __hip_atomic_fetch_max(mm + row, f2ord(mloc), __ATOMIC_RELAXED, __HIP_MEMORY_SCOPE_WORKGROUP);
    } else {
        const float m = ord2f(mm[row]);
        f32x4 p0a, p1a, p0b, p1b; float ps = 0.f;
#pragma unroll
        for (int e = 0; e < 4; ++e) { p0a[e] = e <= lim ? EXP2(S0a[e] - m) : 0.f; p1a[e] = e + 4 <= lim ? EXP2(S1a[e] - m) : 0.f; p0b[e] = e + 32 <= lim ? EXP2(S0b[e] - m) : 0.f; p1b[e] = e + 36 <= lim ? EXP2(S1b[e] - m) : 0.f;
            ps += (p0a[e] + p1a[e]) + (p0b[e] + p1b[e]); }
        ps += __shfl_xor(ps, 16); ps += __shfl_xor(ps, 32);
        if (q == 0 && valid) __hip_atomic_fetch_add(ls + row, ps, __ATOMIC_RELAXED, __HIP_MEMORY_SCOPE_WORKGROUP);
        f32x4 O[4];
#pragma unroll
        for (int dt = 0; dt < 4; ++dt) O[dt] = (f32x4){0.f, 0.f, 0.f, 0.f};
        pv32(P.va, packP(p0a, p1a), O); pv32(P.vb, packP(p0b, p1b), O);
        if (valid) { LAS unsigned long long* orow = (LAS unsigned long long*)(lds + AL_OS) + row * OSP + 2 * q;
#pragma unroll
            for (int dt = 0; dt < 4; ++dt) {
                const unsigned a0 = (unsigned)((int)rintf(O[dt][0] * fxs) + (1 << 26)), a1 = (unsigned)((int)rintf(O[dt][1] * fxs) + (1 << 26)), a2 = (unsigned)((int)rintf(O[dt][2] * fxs) + (1 << 26)), a3 = (unsigned)((int)rintf(O[dt][3] * fxs) + (1 << 26));
                __hip_atomic_fetch_add(orow + 8 * dt, (unsigned long long)a0 | ((unsigned long long)a1 << 32), __ATOMIC_RELAXED, __HIP_MEMORY_SCOPE_WORKGROUP);
                __hip_atomic_fetch_add(orow + 8 * dt + 1, (unsigned long long)a2 | ((unsigned long long)a3 << 32), __ATOMIC_RELAXED, __HIP_MEMORY_SCOPE_WORKGROUP); } }
    }
}
template <int PASS>
__device__ __forceinline__ void unit_compute(const UnitPre& P, int tile, LAS unsigned char* lds, float fxs, int lane) {
    unit_group<PASS>(P, P.q00, P.q01, P.tlo, tile, lds, fxs, lane);
    if (P.thi != 0xffffffffu) unit_group<PASS>(P, P.q10, P.q11, P.thi, tile, lds, fxs, lane);
}
template <int PASS>
__device__ __forceinline__ void unit_pass(const AttnT& T, int kh, int tile, int n, LAS unsigned char* lds, int wave, int lane) {
    const bf16_t* Ks = T.kslc + (size_t)kh * SEQ * 64; const bf16_t* Vs = T.vslT + (size_t)kh * 256 * 4096;
    const LAS u32x4* units = (const LAS u32x4*)(lds + AL_UNITS);
    int u = wave; if (u >= n) return;
    UnitPre A = unit_load<PASS>(lds + AL_Q, Ks, Vs, kh, tile, units, u, lane), B = A;
    for (; u < n; u += 16) {
        const int u1 = u + 8; if (u1 < n) B = unit_load<PASS>(lds + AL_Q, Ks, Vs, kh, tile, units, u1, lane);
        unit_compute<PASS>(A, tile, lds, T.fxs, lane);
        if (u1 >= n) break;
        const int u2 = u + 16; if (u2 < n) A = unit_load<PASS>(lds + AL_Q, Ks, Vs, kh, tile, units, u2, lane);
        unit_compute<PASS>(B, tile, lds, T.fxs, lane);
    }
}

__device__ __forceinline__ void attn_tile(const AttnT& T, int kh, int tile, LAS unsigned char* lds, int tid, int wave, int lane) {
    LAS unsigned* tm = (LAS unsigned*)(lds + AL_TM);
    for (int i = tid; i < 512; i += NT) tm[i] = 0u;
    { const int ti = tid >> 3, part = tid & 7; const u32x4* src = (const u32x4*)(T.proj + (size_t)(tile * 64 + ti) * PP + C_Q + kh * 256 + part * 32); LAS u32x4* dst = (LAS u32x4*)(lds + AL_Q + ti * QROWB + part * 64);
      dst[0] = src[0]; dst[1] = src[1]; dst[2] = src[2]; dst[3] = src[3]; }
    __syncthreads();
    if ((TSK) >= 20 && blockIdx.x == 0 && threadIdx.x == 0) T.tsa[15] = __builtin_amdgcn_s_memrealtime();
    for (int r3 = 0; r3 < ((PROBE_REP) == 41 ? 2 : 1); ++r3)
    attn_wave_part1(T, kh, tile * 8 + wave, lane, (LAS float*)(lds + AL_IMP + wave * 8448), tm, wave);
    __threadfence_block(); __syncthreads();
    ASTAMP(0);
    LAS int* cnt = (LAS int*)(lds + AL_CNT); LAS int* off = (LAS int*)(lds + AL_OFF); LAS u32x4* units = (LAS u32x4*)(lds + AL_UNITS);
    for (int i = tid; i < 256 * OSP; i += NT) ((LAS unsigned long long*)(lds + AL_OS))[i] = 0ull;
    if (tid < 256) { ((LAS int*)(lds + AL_MM))[tid] = f2ord(NEGF); ((LAS float*)(lds + AL_LS))[tid] = 0.f; cnt[tid] = (__popc(tm[2 * tid]) + __popc(tm[2 * tid + 1]) + 7) >> 3; }
    __syncthreads();
    if (tid < 64) {
        const int c0 = cnt[4 * tid], c1 = cnt[4 * tid + 1], c2 = cnt[4 * tid + 2], c3 = cnt[4 * tid + 3]; const int tot = (c0 + c1) + (c2 + c3); int inc = tot;
#pragma unroll
        for (int o = 1; o < 64; o <<= 1) { const int v = __shfl_up(inc, o); if (tid >= o) inc += v; }
        const int ex = inc - tot; off[4 * tid] = ex; off[4 * tid + 1] = ex + c0; off[4 * tid + 2] = ex + c0 + c1; off[4 * tid + 3] = ex + c0 + c1 + c2;
        if (tid == 63) off[256] = inc;
    }
    __syncthreads();
    if (tid < 256) { unsigned long long mask = (unsigned long long)tm[2 * tid] | ((unsigned long long)tm[2 * tid + 1] << 32); int o = off[tid];
        while (mask != 0ull) { unsigned tl = 0xffffffffu, th = 0xffffffffu;
#pragma unroll
            for (int k = 0; k < 4; ++k) if (mask != 0ull) { const unsigned ti = (unsigned)__builtin_ctzll(mask); mask &= mask - 1ull; tl = (tl & ~(0xffu << (8 * k))) | (ti << (8 * k)); }
#pragma unroll
            for (int k = 0; k < 4; ++k) if (mask != 0ull) { const unsigned ti = (unsigned)__builtin_ctzll(mask); mask &= mask - 1ull; th = (th & ~(0xffu << (8 * k))) | (ti << (8 * k)); }
            units[o++] = (u32x4){(unsigned)tid, tl, th, 0u}; } }
    __syncthreads();
    const int n = off[256];
    ASTAMP(1);
    unit_pass<0>(T, kh, tile, n, lds, wave, lane);
    if ((PROBE_REP) == 42) unit_pass<0>(T, kh, tile, n, lds, wave, lane);
    __syncthreads();
    ASTAMP(2);
    unit_pass<1>(T, kh, tile, n, lds, wave, lane);
    __syncthreads();
    ASTAMP(3);
    { const int ti = tid >> 3, part = tid & 7, g = part >> 1, d0 = 32 * (part & 1), row = ti * 4 + g, t = tile * 64 + ti, h = kh * 4 + g;
      const float l = ((const LAS float*)(lds + AL_LS))[row]; const float sc = bf2f(T.proj[(size_t)t * PP + C_NG + h * 3 + 1]) / fmaxf(l, 1e-30f);
      const LAS unsigned long long* orow = (const LAS unsigned long long*)(lds + AL_OS) + row * OSP + (d0 >> 1); u32x4* yp = (u32x4*)(T.ya + (size_t)t * 512 + h * 64 + d0);
      const int nsel = ((t >> 6) + 1) < 16 ? ((t >> 6) + 1) : 16; const unsigned bias = (unsigned)nsel << 26; const float sc2 = sc / T.fxs;
#pragma unroll
      for (int i = 0; i < 4; ++i) { const u32x4 y = yp[i]; const unsigned long long o0 = orow[4 * i], o1 = orow[4 * i + 1], o2 = orow[4 * i + 2], o3 = orow[4 * i + 3]; f32x4 a, b;
          a[0] = bf_lo(y.x) + (float)(int)((unsigned)o0 - bias) * sc2; a[1] = bf_hi(y.x) + (float)(int)((unsigned)(o0 >> 32) - bias) * sc2; a[2] = bf_lo(y.y) + (float)(int)((unsigned)o1 - bias) * sc2; a[3] = bf_hi(y.y) + (float)(int)((unsigned)(o1 >> 32) - bias) * sc2;
          b[0] = bf_lo(y.z) + (float)(int)((unsigned)o2 - bias) * sc2; b[1] = bf_hi(y.z) + (float)(int)((unsigned)(o2 >> 32) - bias) * sc2; b[2] = bf_lo(y.w) + (float)(int)((unsigned)o3 - bias) * sc2; b[3] = bf_hi(y.w) + (float)(int)((unsigned)(o3 >> 32) - bias) * sc2;
          yp[i] = pack8(a, b); } }
    __syncthreads();
    ASTAMP(4);
    if ((TSK) >= 20 && blockIdx.x == 0 && threadIdx.x == 0) T.tsa[5] += (unsigned long long)n;
}

struct SsmB { bf16x8 a[8]; };
__device__ __forceinline__ SsmB ssm_load_b(const unsigned char* ws, int g, int lane) {
    const int i = lane & 15, q = lane >> 4; SsmB B; const bf16x8 z = {0, 0, 0, 0, 0, 0, 0, 0};
    const bf16_t* t = (const bf16_t*)(ws + WS_BBAR) + ((size_t)(g * 128 + i) * 16 + 8 * (q & 1));
#pragma unroll
    for (int rt = 0; rt < 8; ++rt) B.a[rt] = (q < 2) ? *(const bf16x8*)(t + (size_t)rt * 16 * 16) : z;
    return B;
}
__device__ __forceinline__ void ssm_bu16(const bf16_t* proj, const SsmB& B, int tok0, int g, int lane, LAS float* bul) {
    const int i = lane & 15, q = lane >> 4; const bf16x8 z = {0, 0, 0, 0, 0, 0, 0, 0};
    const bf16x8 ub = (q < 2) ? *(const bf16x8*)(proj + (size_t)(tok0 + i) * PP + C_U + g * 16 + 8 * (q & 1)) : z;
    const f32x4 z4 = {0.f, 0.f, 0.f, 0.f};
#pragma unroll
    for (int rt = 0; rt < 8; ++rt) { const f32x4 acc = MFMA16(B.a[rt], ub, z4); *(LAS f32x4*)(bul + i * 132 + 16 * rt + 4 * q) = acc; }
    asm volatile("s_waitcnt lgkmcnt(0)" ::: "memory");
}
__device__ __forceinline__ f32x2 ssm_step(const f32x2 A, const f32x2 x, const f32x2 bu) { f32x2 r; r.x = A.x * x.x - A.y * x.y + bu.x; r.y = A.x * x.y + A.y * x.x + bu.y; return r; }
__device__ __forceinline__ void ssm_pass1(const unsigned char* ws, int c, int g, int lane, LAS float* bul) {
    const bf16_t* proj = (const bf16_t*)(ws + WS_PROJ);
    const SsmB B = ssm_load_b(ws, g, lane);
    const f32x2 A = ((const f32x2*)(ws + WS_ABAR))[g * 64 + lane];
    f32x2 x = {0.f, 0.f};
    for (int sub = 0; sub < 8; ++sub) {
        ssm_bu16(proj, B, c * 128 + sub * 16, g, lane, bul);
#pragma unroll
        for (int s = 0; s < 16; ++s) x = ssm_step(A, x, *(const LAS f32x2*)(bul + s * 132 + 2 * lane));
        asm volatile("s_waitcnt lgkmcnt(0)" ::: "memory");
    }
    ((f32x2*)(ws + WS_SBUF))[(size_t)(c * 32 + g) * 64 + lane] = x;
}
__device__ __forceinline__ void ssm_pass3(const Args& a, int c, int g, int lane, LAS float* bul, LAS unsigned char* xl  ) {
    const unsigned char* ws = a.ws; const bf16_t* proj = (const bf16_t*)(ws + WS_PROJ);
    const SsmB B = ssm_load_b(ws, g, lane);
    const f32x2 A = ((const f32x2*)(ws + WS_ABAR))[g * 64 + lane], A128 = ((const f32x2*)(ws + WS_A128))[g * 64 + lane];
    f32x2 x = {0.f, 0.f};
    { const f32x2* Sb = (const f32x2*)(ws + WS_SBUF) + g * 64 + lane;
      _Pragma("unroll 8") for (int cc = 0; cc < c; ++cc) { const f32x2 s = Sb[(size_t)cc * 32 * 64]; f32x2 r; r.x = A128.x * x.x - A128.y * x.y + s.x; r.y = A128.x * x.y + A128.y * x.x + s.y; x = r; } }
    const int hrow = lane & 15, q = lane >> 4; bf16x8 Cm[4];
    { const float* cre = a.in[14] + (size_t)(g * 16 + hrow) * 64; const float* cim = a.in[15] + (size_t)(g * 16 + hrow) * 64;
#pragma unroll
      for (int ks = 0; ks < 4; ++ks) { const f32x4 r = *(const f32x4*)(cre + 16 * ks + 4 * q), im = *(const f32x4*)(cim + 16 * ks + 4 * q);
          u32x4 w; w.x = cvt_pk_bf16(r[0], -im[0]); w.y = cvt_pk_bf16(r[1], -im[1]); w.z = cvt_pk_bf16(r[2], -im[2]); w.w = cvt_pk_bf16(r[3], -im[3]); Cm[ks] = __builtin_bit_cast(bf16x8, w); } }
    const f32x4 dsk = *(const f32x4*)(a.in[16] + g * 16 + 4 * q);
    bf16_t* ybp = (bf16_t*)((unsigned char*)a.out + OUT_YBP);
    for (int sub = 0; sub < 8; ++sub) {
        const int tok0 = c * 128 + sub * 16;
        ssm_bu16(proj, B, tok0, g, lane, bul);
#pragma unroll
        for (int s = 0; s < 16; ++s) { x = ssm_step(A, x, *(const LAS f32x2*)(bul + s * 132 + 2 * lane)); *(LAS unsigned*)(xl + s * 272 + lane * 4) = cvt_pk_bf16(x.x, x.y); }
        asm volatile("s_waitcnt lgkmcnt(0)" ::: "memory");
        f32x4 acc = {0.f, 0.f, 0.f, 0.f};
#pragma unroll
        for (int ks = 0; ks < 4; ++ks) { const bf16x8 b = *(const LAS bf16x8*)(xl + hrow * 272 + ks * 64 + q * 16); acc = MFMA16(Cm[ks], b, acc); }
        const u32x2 uw = *(const u32x2*)(proj + (size_t)(tok0 + hrow) * PP + C_U + g * 16 + 4 * q);
        const f32x4 uu = {bf_lo(uw.x), bf_hi(uw.x), bf_lo(uw.y), bf_hi(uw.y)};
        f32x4 y = acc + dsk * uu;
        u32x2 w; w.x = cvt_pk_bf16(gelu_tanh(y[0]), gelu_tanh(y[1])); w.y = cvt_pk_bf16(gelu_tanh(y[2]), gelu_tanh(y[3]));
        *(u32x2*)(ybp + (size_t)(tok0 + hrow) * 512 + g * 16 + 4 * q) = w;
        asm volatile("s_waitcnt lgkmcnt(0)" ::: "memory");
    }
}

__global__ void __launch_bounds__(NT, 2) fwd_mega(Args a) {
    extern __shared__ __attribute__((aligned(16))) unsigned char lds_raw[];
    cg::grid_group grid = cg::this_grid();
    LAS unsigned char* lds = (LAS unsigned char*)lds_raw;
    const int tid = threadIdx.x, lane = tid & 63, wave = __builtin_amdgcn_readfirstlane(tid >> 6);
    const int G = gridDim.x, bid = blockIdx.x;
    const int gw = bid * NWV + wave, NGW = G * NWV;
    const int gt = bid * NT + tid, NGT = G * NT;
    unsigned char* ws = a.ws;
    const float* x = a.in[0];
    STAMP(0);
    if ((TSK) >= 20 && blockIdx.x == 0 && threadIdx.x == 0) for (int i = 0; i < 16; ++i) ((unsigned long long*)(a.ws + 244 * 1024))[i] = 0ull;
    if (tid < 4) ((volatile LAS unsigned*)(lds + 131072 + 64))[tid] = 0u;
    if (bid == 0) for (int i = tid; i < XCD_BAR_WORDS; i += NT) ((unsigned*)(ws + WS_BAR))[i] = 0u;
    __syncthreads();

    {
        if (bid < 16) {
            LAS float* red = (LAS float*)lds;
            const int o = bid * 32 + (tid & 31), ksl = tid >> 5, which = o >> 8, colc = o & 255;
            const float* pe = a.in[which ? 7 : 4]; const float* w1 = a.in[which ? 8 : 5]; float s = 0.f;
            _Pragma("unroll 16") for (int k = ksl * 128; k < ksl * 128 + 128; ++k) s += pe[k] * w1[(size_t)k * 256 + colc];
            red[ksl * 32 + (tid & 31)] = s; __syncthreads();
            if (tid < 32) { float t = 0.f; for (int i = 0; i < 16; ++i) t += red[i * 32 + tid]; ((float*)(ws + WS_BIASPE))[o] = t; }
            __syncthreads();
        }
        LAS float* scr = (LAS float*)(lds + wave * 8448);
        constexpr int I_IN = 16 * 121, I_GLU = 8 * 16, I_PA = 8 * 32, I_OUT = 16 * 32, I_UP = 16 * 176, I_DN = 44 * 32, I_W1 = 32 * 8;
        constexpr int NITEMS = I_IN + I_GLU + 2 * I_PA + I_OUT + I_UP + I_DN + 2 * I_W1;
        for (int it = gw; it < NITEMS; it += NGW) {
            int r = it;
            if (r < I_IN) { transpose_item(a.in[3], 1024, DIN, (bf16_t*)(ws + WS_WIN), scr, r / 121, r % 121, lane, a.in[2], 1); continue; } r -= I_IN;
            if (r < I_GLU) { transpose_item(a.in[18], 512, 512, (bf16_t*)(ws + WS_WGLU), scr, r / 16, r % 16, lane, nullptr, 0); continue; } r -= I_GLU;
            if (r < I_PA) { transpose_item(a.in[19], 512, 1024, (bf16_t*)(ws + WS_WPA), scr, r / 32, r % 32, lane, nullptr, 0); continue; } r -= I_PA;
            if (r < I_PA) { transpose_item(a.in[20], 512, 1024, (bf16_t*)(ws + WS_WPB), scr, r / 32, r % 32, lane, nullptr, 0); continue; } r -= I_PA;
            if (r < I_OUT) { transpose_item(a.in[21], 1024, 1024, (bf16_t*)(ws + WS_WOUT), scr, r / 32, r % 32, lane, nullptr, 0); continue; } r -= I_OUT;
            if (r < I_UP) { transpose_item(a.in[23], 1024, NUP, (bf16_t*)(ws + WS_WUP), scr, r / 176, r % 176, lane, a.in[22], 2); continue; } r -= I_UP;
            if (r < I_DN) { transpose_item(a.in[26], DFF, 1024, (bf16_t*)(ws + WS_WDOWN), scr, r / 32, r % 32, lane, nullptr, 0); continue; } r -= I_DN;
            if (r < I_W1) { transpose_item(a.in[5], 2048, 256, (bf16_t*)(ws + WS_W1K), scr, r / 8, r % 8, lane, nullptr, 0); continue; } r -= I_W1;
            transpose_item(a.in[8], 2048, 256, (bf16_t*)(ws + WS_W1V), scr, r / 8, r % 8, lane, nullptr, 0);
        }
        { u32x4* p = (u32x4*)(ws + WS_WIN + (size_t)DIN * 1024 * 2); const int n = (4096 - DIN) * 1024 * 2 / 16; for (int i = gt; i < n; i += NGT) p[i] = (u32x4){0u, 0u, 0u, 0u}; }
        { u32x4* p = (u32x4*)(ws + WS_PROJ + (size_t)SEQ * PP * 2); const int n = 32 * PP * 2 / 16; for (int i = gt; i < n; i += NGT) p[i] = (u32x4){0u, 0u, 0u, 0u}; }
        for (int i = gt; i < 128 * 64 + 2048; i += NGT) {
            if (i < 128 * 64) { const int r = i >> 6, cidx = SEQ + (i & 63); ((bf16_t*)(ws + WS_VSLT))[(size_t)r * VTP + cidx] = 0; ((bf16_t*)(ws + WS_VWNT))[(size_t)r * VTP + cidx] = 0; }
            else { const int j = i - 128 * 64; ((bf16_t*)(ws + WS_VSLT))[(size_t)128 * VTP + j] = 0; ((bf16_t*)(ws + WS_VWNT))[(size_t)128 * VTP + j] = 0; }
        }
        for (int i = gt; i < SEQ; i += NGT) { ((float*)(ws + WS_RSS2))[i] = 0.f; ((float*)(ws + WS_RSS3))[i] = 0.f; }
        if (gt == 0) *(unsigned*)(ws + WS_VMAX) = 0u;
        { const int* pos = (const int*)a.in[1];
          for (int i = gt; i < SEQ * 8; i += NGT) { const int tt = i >> 3, fi = i & 7; const float invf = powf(500000.0f, -(float)(2 * fi) / 16.0f); const float ang = (float)pos[tt] * invf;
              float sn, cs; sincosf(ang, &sn, &cs); ((float*)(ws + WS_ROPEC))[i] = cs; ((float*)(ws + WS_ROPES))[i] = sn; } }
        for (int i = gt; i < 2048; i += NGT) { const int gg = i >> 6;
            const float dt = expf(a.in[17][gg]), ar = a.in[10][i], ai = a.in[11][i];
            const float e = expf(ar * dt), em1 = expm1f(ar * dt), th = ai * dt; float sn, cs; sincosf(th, &sn, &cs); const float sh = sinf(0.5f * th);
            const float Ax = e * cs, Ay = e * sn; const float nx = em1 * cs - 2.f * sh * sh, ny = e * sn;
            const float den = 1.f / (ar * ar + ai * ai); const float fx = (nx * ar + ny * ai) * den, fy = (ny * ar - nx * ai) * den;
            ((f32x2*)(ws + WS_ABAR))[i] = (f32x2){Ax, Ay};
            float px = Ax, py = Ay;
            for (int k = 0; k < 7; ++k) { const float qx = px * px - py * py, qy = 2.f * px * py; px = qx; py = qy; }
            ((f32x2*)(ws + WS_A128))[i] = (f32x2){px, py};
            const float* bre = a.in[12] + (size_t)i * 16; const float* bim = a.in[13] + (size_t)i * 16; const int pp = i & 63;
            bf16_t* Bo = (bf16_t*)(ws + WS_BBAR) + ((size_t)(gg * 128 + 2 * pp) * 16);
            for (int hh = 0; hh < 16; hh += 2) { *(unsigned*)(Bo + hh) = cvt_pk_bf16(fx * bre[hh] - fy * bim[hh], fx * bre[hh + 1] - fy * bim[hh + 1]);
                                                 *(unsigned*)(Bo + 16 + hh) = cvt_pk_bf16(fx * bim[hh] + fy * bre[hh], fx * bim[hh + 1] + fy * bre[hh + 1]); }
        }
        for (int r = gw; r < SEQ; r += NGW) {
            const f32x4* xr = (const f32x4*)(x + (size_t)r * DM) + lane; f32x4 v[4]; float s = 0.f;
#pragma unroll
            for (int j = 0; j < 4; ++j) { v[j] = xr[64 * j]; s += (v[j][0] * v[j][0] + v[j][1] * v[j][1]) + (v[j][2] * v[j][2] + v[j][3] * v[j][3]); }
            s = wave_sum(s);
            if (lane == 0) ((float*)(ws + WS_RSTD1))[r] = rsqrtf(s * (1.f / DM) + EPS);
            u32x2* o = (u32x2*)(ws + WS_XB + (size_t)r * DM * 2) + lane;
#pragma unroll
            for (int j = 0; j < 4; ++j) { u32x2 w; w.x = cvt_pk_bf16(v[j][0], v[j][1]); w.y = cvt_pk_bf16(v[j][2], v[j][3]); o[64 * j] = w; }
        }
    }
    grid.sync();
    STAMP(1);
    XcdBarrier xbar = xcd_barrier_post((unsigned*)(ws + WS_BAR), (volatile LAS unsigned*)(lds + 131072 + 64));

    REPS(1) {
        pg8::Gemm g{1024, 2048u, 128u};
        SchedMN S{64, 16, 1, G, bid, 0, (const char*)(ws + WS_XB), nullptr, (const char*)(ws + WS_WIN), nullptr, (size_t)256 * 1024 * 2, (size_t)256 * 1024 * 2};
        EpiProj E{(bf16_t*)(ws + WS_PROJ), (bf16_t*)(ws + WS_VSLT), (bf16_t*)(ws + WS_VWNT), (bf16_t*)(ws + WS_KSL), (bf16_t*)(ws + WS_KWN), (const float*)(ws + WS_RSTD1), (const float*)(ws + WS_ROPEC), (const float*)(ws + WS_ROPES)};
        pg8::gemm_phase<EpiProj, SchedMN, true, true>(lds, g, S, E);
    }
    GSYNC();
    STAMP(2);

    {
        if (bid < 16) {
            pg8::Gemm g{2048, (unsigned)(16 * PP * 2), (unsigned)(PP * 2)};
            SchedCmp S{bid, (const char*)(ws + WS_PROJ), (const char*)(ws + WS_W1K), (const char*)(ws + WS_W1V)};
            EpiCmp E{(bf16_t*)(ws + WS_HID), (const float*)(ws + WS_BIASPE)};
            pg8::gemm_phase<EpiCmp, SchedCmp, true, true>(lds, g, S, E);
        } else {
            LAS float* ubuf = (LAS float*)(lds + wave * 16384);
            for (int it = (bid - 16) * NWV + wave; it < 4096 * ((PROBE_REP) == 12 ? 2 : 1); it += (G - 16) * NWV) ssm_pass1(ws, (it & 4095) >> 5, it & 31, lane, ubuf);
        }
    }
    GSYNC();
    STAMP(3);

    REPS(3) {
        {
            const u32x4* vp = (const u32x4*)(ws + WS_VSLT); unsigned mx = 0u;
            for (int i = gt; i < 262144; i += NGT) { const u32x4 v = vp[i];
                mx = max(mx, max(max(v.x & 0x7fffu, (v.x >> 16) & 0x7fffu), max(v.y & 0x7fffu, (v.y >> 16) & 0x7fffu)));
                mx = max(mx, max(max(v.z & 0x7fffu, (v.z >> 16) & 0x7fffu), max(v.w & 0x7fffu, (v.w >> 16) & 0x7fffu))); }
#pragma unroll
            for (int o = 1; o < 64; o <<= 1) mx = max(mx, (unsigned)__shfl_xor((int)mx, o));
            if (lane == 0) atomicMax((unsigned*)(ws + WS_VMAX), mx);
        }
        const bf16_t* hid = (const bf16_t*)(ws + WS_HID);
        for (int r = gw; r < 4096; r += NGW) {
            const int z = r >> 10, n = r & 1023, which = z >> 1, kh = z & 1;
            float acc = 0.f;
            if (n < 1023) { const float* w2 = a.in[which ? 9 : 6]; const bf16_t* hr = hid + (size_t)r * 256;
                _Pragma("unroll 16") for (int k = 0; k < 256; k += 2) { const unsigned hw = *(const unsigned*)(hr + k); acc += bf_lo(hw) * w2[k * 64 + lane]; acc += bf_hi(hw) * w2[(k + 1) * 64 + lane]; } }
            if (which == 0) {
                const float other = __shfl_xor(acc, 8); const int prow = 16 * n + 31; float o = acc;
                if (lane < 16 && n < 1023) { const float cs = ((const float*)(ws + WS_ROPEC))[prow * 8 + (lane & 7)], sn = ((const float*)(ws + WS_ROPES))[prow * 8 + (lane & 7)];
                    o = lane < 8 ? acc * cs - other * sn : acc * cs + other * sn; }
                ((bf16_t*)(ws + WS_KCMP))[((size_t)kh * 1024 + n) * 64 + lane] = (bf16_t)(cvt_pk_bf16(o, 0.f) & 0xffff);
            } else {
                ((bf16_t*)(ws + WS_VCMPT))[((size_t)kh * 64 + lane) * 1024 + n] = (bf16_t)(cvt_pk_bf16(acc, 0.f) & 0xffff);
            }
        }
    }
    GSYNC();
    STAMP(4);

    {
        AttnT T{0.f, (unsigned long long*)(ws + 244 * 1024), (const bf16_t*)(ws + WS_PROJ), (const bf16_t*)(ws + WS_KSL), (const bf16_t*)(ws + WS_KWN), (const bf16_t*)(ws + WS_KCMP), (const bf16_t*)(ws + WS_VCMPT), (const bf16_t*)(ws + WS_VSLT), (const bf16_t*)(ws + WS_VWNT), (bf16_t*)((unsigned char*)a.out + OUT_YA)};
        { const unsigned vb = __hip_atomic_load((unsigned*)(ws + WS_VMAX), __ATOMIC_RELAXED, __HIP_MEMORY_SCOPE_AGENT); const float vmax = fmaxf(__uint_as_float(vb << 16), 1e-30f); T.fxs = FXB / (64.0f * 1.01f * vmax); }
        LAS float* wl = (LAS float*)(lds + wave * 16384);
        for (int r2 = 0; r2 < ((PROBE_REP) == 4 ? 2 : 1); ++r2)
        for (int pr = bid; pr < 256; pr += G) {
            const int xcd = pr & 7, slot = pr >> 3, kh = xcd & 1, tl = 32 * (xcd >> 1) + slot;
_Pragma("nounroll")
            for (int k2 = 0; k2 < 2; ++k2) { int tk_ = threadIdx.x; asm volatile("" : "+v"(tk_)); attn_tile(T, kh, k2 ? 255 - tl : tl, lds, tk_, __builtin_amdgcn_readfirstlane(tk_ >> 6), tk_ & 63); }
        }
        if ((PROBE_REP) == 4) {
            AttnT T2 = T; T2.ya = (bf16_t*)(ws + WS_XB);
            for (int pr = bid; pr < 256; pr += G) { const int xcd = pr & 7, slot = pr >> 3, kh = xcd & 1, tl = 32 * (xcd >> 1) + slot;
                _Pragma("nounroll") for (int k2 = 0; k2 < 2; ++k2) attn_tile(T2, kh, k2 ? 255 - tl : tl, lds, tid, wave, lane); }
        }
        int tid2 = threadIdx.x; asm volatile("" : "+v"(tid2));
        const int lane2 = tid2 & 63, wave2 = __builtin_amdgcn_readfirstlane(tid2 >> 6), gw2 = bid * NWV + wave2;
        for (int it = gw2; it < 4096 * ((PROBE_REP) == 14 ? 2 : 1); it += NGW) ssm_pass3(a, (it & 4095) >> 5, it & 31, lane2, (LAS float*)(lds + wave2 * 16384), lds + wave2 * 16384 + 8448);
    }
    GSYNC();
    STAMP(5);

    REPS(5) {
        pg8::Gemm g{512, 1024u, 128u};
        SchedMN S{64, 2, 1, G, bid, 0, (const char*)a.out + OUT_YBP, nullptr, (const char*)(ws + WS_WGLU), nullptr, (size_t)256 * 512 * 2, (size_t)256 * 512 * 2};
        EpiGlu E{(const bf16_t*)((const unsigned char*)a.out + OUT_YBP), (bf16_t*)((unsigned char*)a.out + OUT_YB)};
        pg8::gemm_phase<EpiGlu, SchedMN, true, true>(lds, g, S, E);
    }
    GSYNC();
    STAMP(6);

    REPS(6) {
        pg8::Gemm g{512, 1024u, 128u};
        SchedMN S{64, 4, 2, G, bid, 0, (const char*)a.out + OUT_YA, (const char*)a.out + OUT_YB, (const char*)(ws + WS_WPA), (const char*)(ws + WS_WPB), (size_t)256 * 512 * 2, (size_t)256 * 512 * 2};
        EpiMerge E{(const bf16_t*)(ws + WS_PROJ), (bf16_t*)(ws + WS_MERGED)};
        pg8::gemm_phase<EpiMerge, SchedMN, true, true>(lds, g, S, E);
    }
    GSYNC();
    STAMP(7);

    {
        pg8::Gemm g{1024, 2048u, 128u};
        SchedMN S{64, 4, 1, G, bid, 0, (const char*)(ws + WS_MERGED), nullptr, (const char*)(ws + WS_WOUT), nullptr, (size_t)256 * 1024 * 2, (size_t)256 * 1024 * 2};
        EpiRes E{x, a.out, (bf16_t*)(ws + WS_X1B), (float*)(ws + WS_RSS2)};
        pg8::gemm_phase<EpiRes, SchedMN, true, true>(lds, g, S, E);
    }
    GSYNC();
    STAMP(8);

    for (int half = 0; half < 2; ++half) {
        const int pm_off = half ? 31 : 0, nM = half ? 33 : 32, rowbase = pm_off * 256;
        REPS(8) {
            pg8::Gemm g{1024, 2048u, 128u};
            SchedMN S{nM, 22, 1, G, bid, pm_off, (const char*)(ws + WS_X1B), nullptr, (const char*)(ws + WS_WUP), nullptr, (size_t)256 * 1024 * 2, (size_t)256 * 1024 * 2};
            EpiUp E{(bf16_t*)(ws + WS_UPRAW), (const float*)(ws + WS_RSS2), rowbase};
            pg8::gemm_phase<EpiUp, SchedMN, true, true>(lds, g, S, E);
        }
        GSYNC();
    STAMP(9);
        REPS(9) {
            const bf16_t* up = (const bf16_t*)(ws + WS_UPRAW); bf16_t* act = (bf16_t*)(ws + WS_ACT);
            const float* cw = a.in[24]; const float* cb = a.in[25];
            const int tlo = half ? 8192 : 0;
            for (int it = gt; it < 256 * 352; it += NGT) {
                const int cg8 = it % 352, tb = it / 352, c0 = cg8 * 8, tile = c0 >> 7, jj = c0 & 127;
                const int ucol = tile * 256 + jj;
                float wg[3][8], wv[3][8], bg[8], bv[8];
#pragma unroll
                for (int e = 0; e < 8; ++e) { bg[e] = cb[c0 + e]; bv[e] = cb[DFF + c0 + e];
#pragma unroll
                    for (int k = 0; k < 3; ++k) { wg[k][e] = cw[k * NUP + c0 + e]; wv[k][e] = cw[k * NUP + DFF + c0 + e]; } }
                const int ts = tlo + tb * 32;
                float g2[8], g1[8], v2[8], v1[8];
#pragma unroll
                for (int e = 0; e < 8; ++e) { g2[e] = g1[e] = v2[e] = v1[e] = 0.f; }
                if (ts >= 2) {
                    const u32x4 a2 = *(const u32x4*)(up + (size_t)(ts - 2 - rowbase) * NUP + ucol), b2 = *(const u32x4*)(up + (size_t)(ts - 2 - rowbase) * NUP + ucol + 128);
                    const u32x4 a1 = *(const u32x4*)(up + (size_t)(ts - 1 - rowbase) * NUP + ucol), b1 = *(const u32x4*)(up + (size_t)(ts - 1 - rowbase) * NUP + ucol + 128);
                    g2[0] = bf_lo(a2.x); g2[1] = bf_hi(a2.x); g2[2] = bf_lo(a2.y); g2[3] = bf_hi(a2.y); g2[4] = bf_lo(a2.z); g2[5] = bf_hi(a2.z); g2[6] = bf_lo(a2.w); g2[7] = bf_hi(a2.w);
                    v2[0] = bf_lo(b2.x); v2[1] = bf_hi(b2.x); v2[2] = bf_lo(b2.y); v2[3] = bf_hi(b2.y); v2[4] = bf_lo(b2.z); v2[5] = bf_hi(b2.z); v2[6] = bf_lo(b2.w); v2[7] = bf_hi(b2.w);
                    g1[0] = bf_lo(a1.x); g1[1] = bf_hi(a1.x); g1[2] = bf_lo(a1.y); g1[3] = bf_hi(a1.y); g1[4] = bf_lo(a1.z); g1[5] = bf_hi(a1.z); g1[6] = bf_lo(a1.w); g1[7] = bf_hi(a1.w);
                    v1[0] = bf_lo(b1.x); v1[1] = bf_hi(b1.x); v1[2] = bf_lo(b1.y); v1[3] = bf_hi(b1.y); v1[4] = bf_lo(b1.z); v1[5] = bf_hi(b1.z); v1[6] = bf_lo(b1.w); v1[7] = bf_hi(b1.w);
                }
                for (int s = 0; s < 32; ++s) {
                    const int tt = ts + s;
                    const u32x4 a0 = *(const u32x4*)(up + (size_t)(tt - rowbase) * NUP + ucol), b0 = *(const u32x4*)(up + (size_t)(tt - rowbase) * NUP + ucol + 128);
                    float gc[8], vc[8];
                    gc[0] = bf_lo(a0.x); gc[1] = bf_hi(a0.x); gc[2] = bf_lo(a0.y); gc[3] = bf_hi(a0.y); gc[4] = bf_lo(a0.z); gc[5] = bf_hi(a0.z); gc[6] = bf_lo(a0.w); gc[7] = bf_hi(a0.w);
                    vc[0] = bf_lo(b0.x); vc[1] = bf_hi(b0.x); vc[2] = bf_lo(b0.y); vc[3] = bf_hi(b0.y); vc[4] = bf_lo(b0.z); vc[5] = bf_hi(b0.z); vc[6] = bf_lo(b0.w); vc[7] = bf_hi(b0.w);
                    float o[8];
#pragma unroll
                    for (int e = 0; e < 8; ++e) { const float gg = bg[e] + wg[0][e] * g2[e] + wg[1][e] * g1[e] + wg[2][e] * gc[e]; const float vv = bv[e] + wv[0][e] * v2[e] + wv[1][e] * v1[e] + wv[2][e] * vc[e];
                        o[e] = gg * sigmoidf_(gg) * vv; g2[e] = g1[e]; g1[e] = gc[e]; v2[e] = v1[e]; v1[e] = vc[e]; }
                    u32x4 w; w.x = cvt_pk_bf16(o[0], o[1]); w.y = cvt_pk_bf16(o[2], o[3]); w.z = cvt_pk_bf16(o[4], o[5]); w.w = cvt_pk_bf16(o[6], o[7]);
                    *(u32x4*)(act + (size_t)tt * DFF + c0) = w;
                }
            }
        }
        GSYNC();
    STAMP(10);
    }

    {
        pg8::Gemm g{DFF, (unsigned)(DFF * 2), 128u};
        SchedMN S{64, 4, 1, G, bid, 0, (const char*)(ws + WS_ACT), nullptr, (const char*)(ws + WS_WDOWN), nullptr, (size_t)256 * DFF * 2, (size_t)256 * DFF * 2};
        EpiRes E{a.out, a.out, nullptr, (float*)(ws + WS_RSS3)};
        pg8::gemm_phase<EpiRes, SchedMN, true, true>(lds, g, S, E);
    }
    GSYNC();
    STAMP(11);

    {
        const float* gf = a.in[27];
        for (int r = gw; r < SEQ; r += NGW) {
            const float rs = rsqrtf(((const float*)(ws + WS_RSS3))[r] * (1.f / DM) + EPS);
            f32x4* xr = (f32x4*)(a.out + (size_t)r * DM) + lane; const f32x4* gr = (const f32x4*)gf + lane;
#pragma unroll
            for (int j = 0; j < 4; ++j) xr[64 * j] = xr[64 * j] * rs * gr[64 * j];
        }
    }
    if ((TSK) >= 0 && blockIdx.x == 0 && threadIdx.x == 0) {
        const unsigned long long tend = __builtin_amdgcn_s_memrealtime(); const unsigned long long* ts = (const unsigned long long*)(a.ws + 240 * 1024);
        const unsigned long long t1 = ((TSK) + 1 > 11) ? tend : ts[(TSK) + 1 > 11 ? 0 : (TSK) + 1];
        asm volatile("s_waitcnt vmcnt(0)" ::: "memory");
        a.out[0] = ((TSK) >= 20) ? (float)((const unsigned long long*)(a.ws + 244 * 1024))[(TSK) >= 20 ? (TSK) - 20 : 0] * ((TSK) == 25 ? 1.0f : 0.01f) : (float)(t1 - ts[(TSK) > 11 ? 11 : (TSK)]) * 0.01f;
    }
}

extern "C" void kernel_launch(void* const* d_in, const int* in_sizes, int n_in, void* d_out, int out_size, void* d_ws, size_t ws_size, hipStream_t stream) {
    static int grid = 0;
    if (grid == 0) {
        int dev = 0, cus = 0, per_cu = 0;
        (void)hipGetDevice(&dev); (void)hipDeviceGetAttribute(&cus, hipDeviceAttributeMultiprocessorCount, dev);
        (void)hipFuncSetAttribute((const void*)fwd_mega, hipFuncAttributeMaxDynamicSharedMemorySize, LDS_BYTES);
        (void)hipOccupancyMaxActiveBlocksPerMultiprocessor(&per_cu, (const void*)fwd_mega, NT, LDS_BYTES);
        if (per_cu < 1) { fprintf(stderr, "kernel_launch: occupancy query says %d blocks per CU\n", per_cu); per_cu = 1; }
        grid = cus;
        if (n_in != 28 || ws_size < 252 * MiB) fprintf(stderr, "kernel_launch: unexpected n_in %d / ws_size %zu\n", n_in, ws_size);
    }
    Args a{};
    for (int i = 0; i < 28; ++i) a.in[i] = (const float*)d_in[i];
    a.out = (float*)d_out; a.ws = (unsigned char*)d_ws;
    void* kargs[] = {&a};
    hipError_t e = hipLaunchCooperativeKernel((const void*)fwd_mega, dim3(grid), dim3(NT), kargs, LDS_BYTES, stream);
    if (e != hipSuccess) fprintf(stderr, "cooperative launch failed: %s (grid %d)\n", hipGetErrorString(e), grid);
}
```

```cpp
#include <hip/hip_runtime.h>
#include <hip/hip_cooperative_groups.h>
#include <cstdio>
#include <cstdint>
namespace cg = cooperative_groups;
#ifndef PROBE_REP
#define PROBE_REP -1
#endif
#ifndef EXPV
#define EXPV 0
#endif
#ifndef TSK
#define TSK -1
#endif
#define STAMP(i) do { if ((TSK) >= 0 && blockIdx.x == 0 && threadIdx.x == 0) ((unsigned long long*)(a.ws + 240 * 1024))[i] = __builtin_amdgcn_s_memrealtime(); } while (0)
#define ASTAMP(k) do { if ((TSK) >= 20 && blockIdx.x == 0 && threadIdx.x == 0) { const unsigned long long t_ = __builtin_amdgcn_s_memrealtime(); T.tsa[k] += t_ - T.tsa[15]; T.tsa[15] = t_; } } while (0)
#define REPS(k) _Pragma("nounroll") for (int rep_ = 0; rep_ < ((PROBE_REP) == (k) ? 2 : 1); ++rep_)
#define GSYNC() do { xcd_barrier(xbar); if ((PROBE_REP) == 100) xcd_barrier(xbar); } while (0)

#define LAS __attribute__((address_space(3)))
typedef unsigned short bf16_t;
typedef short bf16x8 __attribute__((ext_vector_type(8)));
typedef float f32x4 __attribute__((ext_vector_type(4)));
typedef float f32x2 __attribute__((ext_vector_type(2)));
typedef unsigned u32x4 __attribute__((ext_vector_type(4)));
typedef unsigned u32x2 __attribute__((ext_vector_type(2)));

constexpr int SEQ = 16384, DM = 1024, DIN = 3864, PP = 4096  , DFF = 2816, NUP = 5632;
constexpr int C_Q = 0, C_KC = 512, C_VC = 640, C_KSL = 768, C_VSL = 896, C_KWN = 1024, C_VWN = 1152, C_U = 1280, C_GA = 1792, C_GB = 2816, C_NG = 3840;
constexpr int VTP = SEQ + 64;
constexpr float EPS = 1e-6f;
constexpr float NEGF = -1e30f;

constexpr size_t MiB = 1u << 20;
constexpr size_t WS_RSTD1 = 0, WS_RSS2 = 64 * 1024, WS_RSS3 = 128 * 1024, WS_ROPEC = 256 * 1024, WS_ROPES = 768 * 1024;
constexpr size_t WS_ABAR = 1280 * 1024, WS_A128 = WS_ABAR + 16384, WS_BIASPE = WS_A128 + 16384, WS_BBAR = 1536 * 1024  ;
constexpr size_t WS_SBUF = 2 * MiB  , WS_HID = 4 * MiB  , WS_KCMP = 6 * MiB  , WS_VCMPT = 6 * MiB + 512 * 1024  ;
constexpr size_t WS_WUP = 8 * MiB, WS_WDOWN = 20 * MiB, WS_WIN = 26 * MiB, WS_WGLU = 34 * MiB, WS_WPA = 35 * MiB, WS_WPB = 36 * MiB, WS_WOUT = 37 * MiB, WS_W1K = 39 * MiB, WS_W1V = 40 * MiB;
constexpr size_t WS_XB = 41 * MiB, WS_MERGED = 41 * MiB, WS_PROJ = 73 * MiB, WS_VSLT = 202 * MiB + 512 * 1024, WS_VWNT = 207 * MiB;
constexpr size_t WS_X1B = 220 * MiB, WS_UPRAW = 26 * MiB, WS_ACT = 122 * MiB;
constexpr size_t WS_VMAX = 232 * 1024, WS_BAR = 192 * 1024, WS_KSL = 212 * MiB, WS_KWN = 216 * MiB;
constexpr size_t OUT_YA = 0, OUT_YBP = 16 * MiB, OUT_YB = 32 * MiB;
static_assert(WS_PROJ + (size_t)(SEQ + 32) * PP * 2 <= WS_VSLT, "proj");
static_assert(WS_VSLT + (size_t)128 * VTP * 2 + 4096 <= WS_VWNT && WS_VWNT + (size_t)128 * VTP * 2 + 4096 <= WS_X1B, "vt");
static_assert(WS_UPRAW + (size_t)33 * 256 * NUP * 2 <= WS_ACT && WS_ACT + (size_t)SEQ * DFF * 2 <= WS_X1B, "ffn");

__device__ __forceinline__ unsigned cvt_pk_bf16(float lo, float hi) { unsigned r; asm volatile("v_cvt_pk_bf16_f32 %0, %1, %2" : "=v"(r) : "v"(lo), "v"(hi)); return r; }
__device__ __forceinline__ float bf_lo(unsigned w) { return __uint_as_float(w << 16); }
__device__ __forceinline__ float bf_hi(unsigned w) { return __uint_as_float(w & 0xffff0000u); }
__device__ __forceinline__ float bf2f(bf16_t b) { return __uint_as_float((unsigned)b << 16); }
__device__ __forceinline__ float sigmoidf_(float v) { return 1.f / (1.f + __expf(-v)); }
__device__ __forceinline__ float gelu_tanh(float v) { const float z = 0.7978845608028654f * (v + 0.044715f * v * v * v); const float th = 1.f - 2.f / (__expf(2.f * z) + 1.f); return 0.5f * v * (1.f + th); }
__device__ __forceinline__ u32x4 pack8(f32x4 a, f32x4 b) { u32x4 w; w.x = cvt_pk_bf16(a[0], a[1]); w.y = cvt_pk_bf16(a[2], a[3]); w.z = cvt_pk_bf16(b[0], b[1]); w.w = cvt_pk_bf16(b[2], b[3]); return w; }

namespace pg8 {
#define PG8_LAS __attribute__((address_space(3)))
constexpr int BM = 256, BK = 64, HALF = 128, HTB = HALF * BK * 2, STAGE_BYTES = 8 * HTB, NXCD = 8, WGM = 8;
__host__ __device__ __forceinline__ int lds_byte(int r, int c) { const int st = (r >> 4) * 2 + (c >> 5), rr = r & 15, cc = c & 31, ob = rr * 64 + cc * 2; return st * 1024 + (ob ^ (((ob >> 9) & 1) << 5)); }
__host__ __device__ __forceinline__ void stage_rc(int b, int& R, int& C) { const int st = b / 1024, sb = b % 1024, swz = sb ^ (((sb >> 9) & 1) << 5); R = (st >> 1) * 16 + swz / 64; C = (st & 1) * 32 + (swz % 64) / 2; }
__host__ __device__ __forceinline__ int perm32(int rho) { const int n = rho >> 4, i = rho & 15; return 8 * (i >> 2) + 4 * n + (i & 3); }
struct Unit { int pm, pn, z; const char* A; const char* B; };
struct Gemm { int K; unsigned lda_b; unsigned kstepA; unsigned ldb_b; };
__device__ __forceinline__ bool tile_of(long L, int nM, int nN, int& pm, int& pn) {
    const int nwg = nM * nN; if (L >= nwg) return false;
    int wgid = (int)L; { const int q = nwg / NXCD, r = nwg % NXCD, xcd = wgid % NXCD, off = wgid / NXCD; wgid = (xcd < r ? xcd * (q + 1) : r * (q + 1) + (xcd - r) * q) + off; }
    const int nig = WGM * nN, gid = wgid / nig, fm = gid * WGM, gsz = (nM - fm) < WGM ? (nM - fm) : WGM;
    pm = fm + ((wgid % nig) % gsz); pn = (wgid % nig) / gsz; return true;
}
template <class Epi, class Sched, bool ALIGN_EPI = false, bool SP2 = false>
__device__ __forceinline__ void gemm_phase(PG8_LAS unsigned char* lds, const Gemm g, const Sched& S, const Epi& E) {
    int tid_ = threadIdx.x; asm volatile("" : "+v"(tid_));
    const int tid = tid_, wid = __builtin_amdgcn_readfirstlane(tid >> 6), lane = tid & 63, wr = wid >> 2, wc = wid & 3, fr = lane & 15, fq = lane >> 4;
    const int K = g.K, nt = K / BK;
    unsigned voffA[2], voffB[2];
#pragma unroll
    for (int i = 0; i < 2; ++i) { int R, C; stage_rc(tid * 16 + i * 8192, R, C); const int Rb = Epi::PERM ? ((R & ~31) + perm32(R & 31)) : R;
        voffA[i] = (unsigned)R * g.lda_b + (unsigned)C * 2u; voffB[i] = (unsigned)Rb * g.ldb_b + (unsigned)C * 2u; }
    const size_t kstepA = (size_t)g.kstepA, kstepB = (size_t)(BK * 2);
    const size_t hstepA = (size_t)HALF * g.lda_b, hstepB = (size_t)HALF * g.ldb_b;
    const unsigned ldsw = (unsigned)wid * 1024u;
    const int aoff = lds_byte(wr * 64 + fr, fq * 8), boff = lds_byte(wc * 32 + fr, fq * 8);
#define PG8_SA(b, h) (((b) * 2 + (h)) * HTB)
#define PG8_SB(b, h) ((4 + (b) * 2 + (h)) * HTB)
#define PG8_STAGE(bufoff, gbase, voff) do { _Pragma("unroll") for (int _i = 0; _i < 2; ++_i) \
        __builtin_amdgcn_global_load_lds((const unsigned*)((const char*)(gbase) + (voff)[_i]), (PG8_LAS unsigned*)(lds + (bufoff) + ldsw + _i * 8192), 16, 0, 0); } while (0)
#define PG8_LDA(dst, b, h) do { _Pragma("unroll") for (int m = 0; m < 4; ++m) _Pragma("unroll") for (int k = 0; k < 2; ++k) dst[m][k] = *(const PG8_LAS bf16x8*)(lds + PG8_SA(b, h) + aoff + m * 2048 + k * 1024); } while (0)
#define PG8_LDB(dst, b, h) do { _Pragma("unroll") for (int n = 0; n < 2; ++n) _Pragma("unroll") for (int k = 0; k < 2; ++k) dst[n][k] = *(const PG8_LAS bf16x8*)(lds + PG8_SB(b, h) + boff + n * 2048 + k * 1024); } while (0)
#define PG8_MMA(ai, bj, At, Bt) do { __builtin_amdgcn_s_setprio(1); _Pragma("unroll") for (int m = 0; m < 4; ++m) _Pragma("unroll") for (int n = 0; n < 2; ++n) _Pragma("unroll") for (int k = 0; k < 2; ++k) \
        acc[ai][bj][m][n] = __builtin_amdgcn_mfma_f32_16x16x32_bf16(Bt[n][k], At[m][k], acc[ai][bj][m][n], 0, 0, 0); __builtin_amdgcn_s_setprio(0); } while (0)
#define PG8_WAIT_V(n) asm volatile("s_waitcnt vmcnt(" #n ")" ::: "memory")
#define PG8_WAIT_L(n) asm volatile("s_waitcnt lgkmcnt(" #n ")" ::: "memory")
#define PG8_BAR __builtin_amdgcn_s_barrier()
#define PG8_SCHED __builtin_amdgcn_sched_barrier(0)
    Unit cur, nxt; int ui = 0;
    if (!S.next(0, cur)) return;
    f32x4 acc[2][2][4][2];
#pragma unroll
    for (int a = 0; a < 2; ++a)
#pragma unroll
        for (int b = 0; b < 2; ++b)
#pragma unroll
            for (int m = 0; m < 4; ++m)
#pragma unroll
                for (int n = 0; n < 2; ++n) acc[a][b][m][n] = (f32x4){0.f, 0.f, 0.f, 0.f};
    bf16x8 At[4][2], B0[2][2], B1[2][2];
    const char* cA = cur.A; const char* cB = cur.B;
    if constexpr (SP2) {
        PG8_STAGE(PG8_SB(0, 0), cB, voffB); PG8_STAGE(PG8_SB(0, 1), cB + hstepB, voffB); PG8_STAGE(PG8_SA(0, 0), cA, voffA); PG8_STAGE(PG8_SA(0, 1), cA + hstepA, voffA);
        if (wr == 1) PG8_BAR;
        PG8_WAIT_V(2); PG8_BAR;
        PG8_STAGE(PG8_SB(1, 0), cB + kstepB, voffB); PG8_STAGE(PG8_SA(1, 0), cA + kstepA, voffA); PG8_STAGE(PG8_SB(1, 1), cB + hstepB + kstepB, voffB);
        PG8_WAIT_V(6); PG8_BAR;
    } else {
        PG8_STAGE(PG8_SB(0, 0), cB, voffB); PG8_STAGE(PG8_SA(0, 0), cA, voffA); PG8_STAGE(PG8_SB(0, 1), cB + hstepB, voffB); PG8_STAGE(PG8_SA(0, 1), cA + hstepA, voffA);
        if (wr == 1) PG8_BAR;
        PG8_WAIT_V(4); PG8_BAR;
        PG8_STAGE(PG8_SB(1, 0), cB + kstepB, voffB); PG8_STAGE(PG8_SA(1, 0), cA + kstepA, voffA); PG8_STAGE(PG8_SB(1, 1), cB + hstepB + kstepB, voffB);
        PG8_WAIT_V(6); PG8_BAR;
    }
    for (;;) {
        const bool has_next = S.next(ui + 1, nxt);
        const char* nA = has_next ? nxt.A : cA; const char* nB = has_next ? nxt.B : cB;
        for (int t = 0; t < nt; t += 2) {
            const bool last = (t == nt - 2);
            const char* a1 = cA + (size_t)(t + 1) * kstepA;
            const char* a2 = last ? nA : cA + (size_t)(t + 2) * kstepA; const char* b2 = last ? nB : cB + (size_t)(t + 2) * kstepB;
            const char* a3 = a2 + kstepA; const char* b3 = b2 + kstepB;
            if constexpr (SP2) {
            PG8_LDB(B0, 0, 0); PG8_LDB(B1, 0, 1); PG8_SCHED; PG8_LDA(At, 0, 0); PG8_STAGE(PG8_SA(1, 1), a1 + hstepA, voffA);
            PG8_WAIT_V(8); PG8_WAIT_L(0); PG8_BAR; PG8_MMA(0, 0, At, B0); PG8_MMA(0, 1, At, B1); PG8_BAR; PG8_SCHED;
            PG8_LDA(At, 0, 1); PG8_STAGE(PG8_SB(0, 0), b2, voffB); PG8_STAGE(PG8_SB(0, 1), b2 + hstepB, voffB); PG8_STAGE(PG8_SA(0, 0), a2, voffA);
            PG8_WAIT_V(8); PG8_WAIT_L(0); PG8_BAR; PG8_MMA(1, 0, At, B0); PG8_MMA(1, 1, At, B1); PG8_BAR; PG8_SCHED;
            PG8_LDB(B0, 1, 0); PG8_LDB(B1, 1, 1); PG8_SCHED; PG8_LDA(At, 1, 0); PG8_STAGE(PG8_SA(0, 1), a2 + hstepA, voffA);
            PG8_WAIT_V(8); PG8_WAIT_L(0); PG8_BAR; PG8_MMA(0, 0, At, B0); PG8_MMA(0, 1, At, B1); PG8_BAR; PG8_SCHED;
            PG8_LDA(At, 1, 1); PG8_STAGE(PG8_SB(1, 0), b3, voffB); PG8_STAGE(PG8_SB(1, 1), b3 + hstepB, voffB); PG8_STAGE(PG8_SA(1, 0), a3, voffA);
            PG8_WAIT_V(8); PG8_WAIT_L(0); PG8_BAR; PG8_MMA(1, 0, At, B0); PG8_MMA(1, 1, At, B1); PG8_BAR; PG8_SCHED;
            } else {
            PG8_LDB(B0, 0, 0); PG8_SCHED; PG8_LDA(At, 0, 0); PG8_STAGE(PG8_SA(1, 1), a1 + hstepA, voffA);
            PG8_WAIT_L(8); PG8_BAR; PG8_WAIT_L(0); PG8_MMA(0, 0, At, B0); PG8_BAR; PG8_SCHED;
            PG8_LDB(B1, 0, 1); PG8_STAGE(PG8_SB(0, 0), b2, voffB);
            PG8_BAR; PG8_WAIT_L(0); PG8_MMA(0, 1, At, B1); PG8_BAR;
            PG8_LDA(At, 0, 1); PG8_STAGE(PG8_SA(0, 0), a2, voffA);
            PG8_BAR; PG8_WAIT_L(0); PG8_MMA(1, 0, At, B0); PG8_BAR; PG8_SCHED;
            PG8_STAGE(PG8_SB(0, 1), b2 + hstepB, voffB);
            PG8_WAIT_V(6); PG8_BAR; PG8_MMA(1, 1, At, B1); PG8_BAR;
            PG8_LDB(B0, 1, 0); PG8_SCHED; PG8_LDA(At, 1, 0); PG8_STAGE(PG8_SA(0, 1), a2 + hstepA, voffA);
            PG8_WAIT_L(8); PG8_BAR; PG8_WAIT_L(0); PG8_MMA(0, 0, At, B0); PG8_BAR; PG8_SCHED;
            PG8_LDB(B1, 1, 1); PG8_STAGE(PG8_SB(1, 0), b3, voffB);
            PG8_BAR; PG8_WAIT_L(0); PG8_MMA(0, 1, At, B1); PG8_BAR;
            PG8_LDA(At, 1, 1); PG8_STAGE(PG8_SA(1, 0), a3, voffA);
            PG8_BAR; PG8_WAIT_L(0); PG8_MMA(1, 0, At, B0); PG8_BAR; PG8_SCHED;
            PG8_STAGE(PG8_SB(1, 1), b3 + hstepB, voffB);
            PG8_WAIT_V(6); PG8_BAR; PG8_MMA(1, 1, At, B1); PG8_BAR;
            }
        }
        if constexpr (ALIGN_EPI) { if (wr == 0) PG8_BAR; }
        E(acc, cur, wr, wc, fr, fq);
        if (!has_next) break;
#pragma unroll
        for (int a = 0; a < 2; ++a)
#pragma unroll
            for (int b = 0; b < 2; ++b)
#pragma unroll
                for (int m = 0; m < 4; ++m)
#pragma unroll
                    for (int n = 0; n < 2; ++n) acc[a][b][m][n] = (f32x4){0.f, 0.f, 0.f, 0.f};
        cur = nxt; cA = nA; cB = nB; ++ui;
        if constexpr (ALIGN_EPI) { if (wr == 1) PG8_BAR; }
    }
    PG8_WAIT_V(0);
    if constexpr (!ALIGN_EPI) { if (wr == 0) PG8_BAR; }
    PG8_BAR;
#undef PG8_SA
#undef PG8_SB
#undef PG8_STAGE
#undef PG8_LDA
#undef PG8_LDB
#undef PG8_MMA
#undef PG8_WAIT_V
#undef PG8_WAIT_L
#undef PG8_BAR
#undef PG8_SCHED
}
}


struct SchedMN {
    int nM, nN, nz, G, c, pm_off; const char* A0; const char* A1; const char* B0; const char* B1; size_t a_tile, b_tile;
    __device__ __forceinline__ bool next(int i, pg8::Unit& u) const {
        int pm, pn; if (!pg8::tile_of((long)(i / nz) * G + c, nM, nN, pm, pn)) return false;
        u.z = i % nz; u.pm = pm + pm_off; u.pn = pn; u.A = (u.z ? A1 : A0) + (size_t)u.pm * a_tile; u.B = (u.z ? B1 : B0) + (size_t)pn * b_tile; return true;
    }
};
struct SchedCmp {
    int c; const char* proj; const char* w1k; const char* w1v;
    __device__ __forceinline__ bool next(int i, pg8::Unit& u) const {
        if (i > 0 || c >= 64) return false;
        const int ks = c & 3; u.pm = (c >> 2) & 3; u.z = c >> 4; u.pn = ks; const int which = u.z >> 1, kh = u.z & 1;
        u.A = proj + ((size_t)(16 * 256 * u.pm + 8 * ks) * PP + (which ? C_VC : C_KC) + kh * 64) * 2; u.B = (which ? w1v : w1k) + (size_t)ks * 512 * 2; return true;
    }
};

#define EPI_LOOP_ROWS for (int ai = 0; ai < 2; ++ai) _Pragma("unroll") for (int m = 0; m < 4; ++m)

struct EpiProj {
    static constexpr bool PERM = true;
    bf16_t* proj; bf16_t* vslt; bf16_t* vwnt; bf16_t* kslc; bf16_t* kwnc; const float* rstd; const float* ropec; const float* ropes;
    __device__ __forceinline__ void operator()(const f32x4 (&acc)[2][2][4][2], const pg8::Unit& u, int wr, int wc, int fr, int fq) const {
        const int pn = u.pn; const int row0 = u.pm * 256 + wr * 64 + fr;
        const bool sig = pn >= 7;
#pragma unroll
        EPI_LOOP_ROWS {
            const int row = row0 + ai * 128 + m * 16; const float rs = rstd[row];
            f32x4 c0 = {1.f, 1.f, 1.f, 1.f}, c1 = c0, s0 = {0.f, 0.f, 0.f, 0.f}, s1 = s0;
            if ((pn <= 1 || pn == 3 || pn == 4) && (wc & 1) == 0) { c0 = *(const f32x4*)(ropec + row * 8); c1 = *(const f32x4*)(ropec + row * 8 + 4); s0 = *(const f32x4*)(ropes + row * 8); s1 = *(const f32x4*)(ropes + row * 8 + 4); }
#pragma unroll
            for (int bj = 0; bj < 2; ++bj) {
                f32x4 v0 = acc[ai][bj][m][0] * rs, v1 = acc[ai][bj][m][1] * rs;
                const int colt = bj * 128 + wc * 32 + 8 * fq;
                const bool ropet = (pn <= 1) || ((pn == 3 || pn == 4) && bj == 0);
                if (ropet && (wc & 1) == 0) {
                    f32x4 p0, p1;
#pragma unroll
                    for (int e = 0; e < 4; ++e) { p0[e] = __shfl_xor(v0[e], 16); p1[e] = __shfl_xor(v1[e], 16); }
                    if (fq == 0) { v0 = v0 * c0 - p0 * s0; v1 = v1 * c1 - p1 * s1; }
                    else if (fq == 1) { v0 = v0 * c0 + p0 * s0; v1 = v1 * c1 + p1 * s1; }
                }
                if (pn <= 1) { v0 = v0 * (0.125f * 1.4426950408889634f); v1 = v1 * (0.125f * 1.4426950408889634f); }
                if (sig) {
#pragma unroll
                    for (int e = 0; e < 4; ++e) { v0[e] = sigmoidf_(v0[e]); v1[e] = sigmoidf_(v1[e]); }
                }
                const u32x4 w = pack8(v0, v1);
                if (!((pn == 3 || pn == 4))) *(u32x4*)(proj + (size_t)row * PP + pn * 256 + colt) = w;
                if ((pn == 3 || pn == 4) && bj == 0) { bf16_t* kc = (pn == 3) ? kslc : kwnc; *(u32x4*)(kc + ((size_t)(colt >> 6) * SEQ + row) * 64 + (colt & 63)) = w; }
                if ((pn == 3 || pn == 4) && bj == 1) {
                    bf16_t* vt = ((pn == 3) ? vslt : vwnt) + ((size_t)((colt - 128) >> 6) * 256 + (row >> 6)) * 4096 + (size_t)((colt - 128) & 63) * 64 + (row & 63);
                    vt[0 * 64] = (bf16_t)(w.x & 0xffff); vt[1 * 64] = (bf16_t)(w.x >> 16); vt[2 * 64] = (bf16_t)(w.y & 0xffff); vt[3 * 64] = (bf16_t)(w.y >> 16);
                    vt[4 * 64] = (bf16_t)(w.z & 0xffff); vt[5 * 64] = (bf16_t)(w.z >> 16); vt[6 * 64] = (bf16_t)(w.w & 0xffff); vt[7 * 64] = (bf16_t)(w.w >> 16);
                }
            }
        }
    }
};

struct EpiCmp {
    static constexpr bool PERM = true;
    float* hidp;
    __device__ __forceinline__ void operator()(const f32x4 (&acc)[2][2][4][2], const pg8::Unit& u, int wr, int wc, int fr, int fq) const {
        const int row0 = u.pm * 256 + wr * 64 + fr;
#pragma unroll
        for (int bj = 0; bj < 2; ++bj) {
            const int col = bj * 128 + wc * 32 + 8 * fq;
#pragma unroll
            EPI_LOOP_ROWS {
                const int row = row0 + ai * 128 + m * 16; float* d = hidp + (((size_t)u.pn * 4 + u.z) * 1024 + row) * 256 + col;
                *(f32x4*)d = acc[ai][bj][m][0]; *(f32x4*)(d + 4) = acc[ai][bj][m][1];
            }
        }
    }
};

struct EpiGlu {
    static constexpr bool PERM = true;
    const bf16_t* ybp; bf16_t* yb;
    __device__ __forceinline__ void operator()(const f32x4 (&acc)[2][2][4][2], const pg8::Unit& u, int wr, int wc, int fr, int fq) const {
        const int row0 = u.pm * 256 + wr * 64 + fr;
#pragma unroll
        EPI_LOOP_ROWS {
            const int row = row0 + ai * 128 + m * 16;
#pragma unroll
            for (int bj = 0; bj < 2; ++bj) {
                const size_t off = (size_t)row * 512 + u.pn * 256 + bj * 128 + wc * 32 + 8 * fq;
                const u32x4 y = *(const u32x4*)(ybp + off);
                f32x4 v0 = acc[ai][bj][m][0], v1 = acc[ai][bj][m][1];
                v0[0] = bf_lo(y.x) * sigmoidf_(v0[0]); v0[1] = bf_hi(y.x) * sigmoidf_(v0[1]); v0[2] = bf_lo(y.y) * sigmoidf_(v0[2]); v0[3] = bf_hi(y.y) * sigmoidf_(v0[3]);
                v1[0] = bf_lo(y.z) * sigmoidf_(v1[0]); v1[1] = bf_hi(y.z) * sigmoidf_(v1[1]); v1[2] = bf_lo(y.w) * sigmoidf_(v1[2]); v1[3] = bf_hi(y.w) * sigmoidf_(v1[3]);
                *(u32x4*)(yb + off) = pack8(v0, v1);
            }
        }
    }
};

struct EpiMerge {
    static constexpr bool PERM = true;
    const bf16_t* proj; bf16_t* merged;
    __device__ __forceinline__ void operator()(const f32x4 (&acc)[2][2][4][2], const pg8::Unit& u, int wr, int wc, int fr, int fq) const {
        const int row0 = u.pm * 256 + wr * 64 + fr; const int gcol = u.z ? C_GB : C_GA;
#pragma unroll
        EPI_LOOP_ROWS {
            const int row = row0 + ai * 128 + m * 16;
#pragma unroll
            for (int bj = 0; bj < 2; ++bj) {
                const int col = u.pn * 256 + bj * 128 + wc * 32 + 8 * fq;
                const u32x4 gt = *(const u32x4*)(proj + (size_t)row * PP + gcol + col);
                f32x4 v0 = acc[ai][bj][m][0], v1 = acc[ai][bj][m][1];
                v0[0] *= bf_lo(gt.x); v0[1] *= bf_hi(gt.x); v0[2] *= bf_lo(gt.y); v0[3] *= bf_hi(gt.y);
                v1[0] *= bf_lo(gt.z); v1[1] *= bf_hi(gt.z); v1[2] *= bf_lo(gt.w); v1[3] *= bf_hi(gt.w);
                bf16_t* dst = merged + (size_t)row * DM + col;
                if (u.z) { const u32x4 o = *(const u32x4*)dst;
                    v0[0] += bf_lo(o.x); v0[1] += bf_hi(o.x); v0[2] += bf_lo(o.y); v0[3] += bf_hi(o.y); v1[0] += bf_lo(o.z); v1[1] += bf_hi(o.z); v1[2] += bf_lo(o.w); v1[3] += bf_hi(o.w); }
                *(u32x4*)dst = pack8(v0, v1);
            }
        }
    }
};

struct EpiRes {
    static constexpr bool PERM = true;
    const float* xin; float* xo; bf16_t* xb; float* rss;
    __device__ __forceinline__ void operator()(const f32x4 (&acc)[2][2][4][2], const pg8::Unit& u, int wr, int wc, int fr, int fq) const {
        const int row0 = u.pm * 256 + wr * 64 + fr;
#pragma unroll
        EPI_LOOP_ROWS {
            const int row = row0 + ai * 128 + m * 16; float ss = 0.f;
#pragma unroll
            for (int bj = 0; bj < 2; ++bj) {
                const size_t off = (size_t)row * DM + u.pn * 256 + bj * 128 + wc * 32 + 8 * fq;
                const f32x4 v0 = *(const f32x4*)(xin + off) + acc[ai][bj][m][0], v1 = *(const f32x4*)(xin + off + 4) + acc[ai][bj][m][1];
                *(f32x4*)(xo + off) = v0; *(f32x4*)(xo + off + 4) = v1;
                if (xb) *(u32x4*)(xb + off) = pack8(v0, v1);
                ss += (v0[0] * v0[0] + v0[1] * v0[1]) + (v0[2] * v0[2] + v0[3] * v0[3]) + (v1[0] * v1[0] + v1[1] * v1[1]) + (v1[2] * v1[2] + v1[3] * v1[3]);
            }
            ss += __shfl_xor(ss, 16); ss += __shfl_xor(ss, 32);
            if (fq == 0) atomicAdd(rss + row, ss);
        }
    }
};

struct EpiUp {
    static constexpr bool PERM = true;
    bf16_t* up; const float* rss; int rowbase;
    __device__ __forceinline__ void operator()(const f32x4 (&acc)[2][2][4][2], const pg8::Unit& u, int wr, int wc, int fr, int fq) const {
        const int row0 = u.pm * 256 + wr * 64 + fr;
#pragma unroll
        EPI_LOOP_ROWS {
            const int row = row0 + ai * 128 + m * 16; const float rs = rsqrtf(rss[row] * (1.f / DM) + EPS);
#pragma unroll
            for (int bj = 0; bj < 2; ++bj) {
                const size_t off = (size_t)(row - rowbase) * NUP + u.pn * 256 + bj * 128 + wc * 32 + 8 * fq;
                *(u32x4*)(up + off) = pack8(acc[ai][bj][m][0] * rs, acc[ai][bj][m][1] * rs);
            }
        }
    }
};

struct Args { const float* in[28]; float* out; unsigned char* ws; };
constexpr int NT = 512, NWV = 8;
constexpr int LDS_BYTES = 147456;

__device__ __forceinline__ float wave_sum(float v) {
#pragma unroll
    for (int o = 1; o < 64; o <<= 1) v += __shfl_xor(v, o);
    return v;
}

#define XB_TMO      128
#define XB_XCNT(j)  (256  + 64 * (j))
#define XB_XSUB(j)  (1280 + 64 * (j))
#define XB_XGEN(j)  (2304 + 64 * (j))
#define XB_TOP      3328
#define XB_TOPGEN   3392
#define XCD_BAR_WORDS 3456
#define XB_SPIN_CAP (1u << 18)

__device__ __forceinline__ unsigned xb_ld(unsigned* p)              { return __hip_atomic_load(p, __ATOMIC_RELAXED, __HIP_MEMORY_SCOPE_AGENT); }
__device__ __forceinline__ unsigned xb_add(unsigned* p, unsigned v) { return __hip_atomic_fetch_add(p, v, __ATOMIC_RELAXED, __HIP_MEMORY_SCOPE_AGENT); }
__device__ __forceinline__ unsigned xb_xcc_id() { return (unsigned)__builtin_amdgcn_s_getreg((3 << 11) | 20) & 0xFu; }
#define XB_SPIN(cond, bar) do { unsigned _sp = 0; while (cond) { __builtin_amdgcn_s_sleep(1); \
    if ((++_sp & 255u) == 0u) { if (xb_ld(&(bar)[XB_TMO])) break; if (_sp > XB_SPIN_CAP) { atomicAdd(&(bar)[XB_TMO], 1u); break; } } } } while (0)

struct XcdBarrier {
    unsigned* bar; unsigned x;
    volatile LAS unsigned* st;
};

__device__ __forceinline__ XcdBarrier xcd_barrier_post(unsigned* bar, volatile LAS unsigned* st) {
    XcdBarrier b; b.bar = bar; b.x = xb_xcc_id(); b.st = st;
    if (threadIdx.x == 0) (void)xb_add(&bar[XB_XCNT(b.x)], 1u);
    return b;
}
__device__ __forceinline__ void xcd_barrier_complete(unsigned* bar, unsigned x, unsigned& nloc, unsigned& nx) {
    const unsigned G = gridDim.x * gridDim.y * gridDim.z;
    unsigned sum, cnt, mine, sp = 0u;
    for (;;) {
        sum = 0u; cnt = 0u; mine = 0u;
#pragma unroll
        for (unsigned j = 0; j < 16; ++j) { const unsigned c = xb_ld(&bar[XB_XCNT(j)]); sum += c; cnt += (c > 0u) ? 1u : 0u; mine = (j == x) ? c : mine; }
        if (sum == G) break;
        __builtin_amdgcn_s_sleep(1);
        if ((++sp & 255u) == 0u) { if (xb_ld(&bar[XB_TMO])) break; if (sp > XB_SPIN_CAP) { atomicAdd(&bar[XB_TMO], 1u); break; } }
    }
    nloc = mine > 0u ? mine : 1u; nx = cnt > 0u ? cnt : 1u;
}

__device__ __forceinline__ void xcd_barrier(const XcdBarrier& b) {
    asm volatile("s_waitcnt vmcnt(0)" ::: "memory");
    __syncthreads();
    if (threadIdx.x == 0) {
        unsigned* bar = b.bar;
        __builtin_amdgcn_s_waitcnt(0);
        unsigned nloc = b.st[0], nx = b.st[1];
        if (nloc == 0u) { xcd_barrier_complete(bar, b.x, nloc, nx); b.st[0] = nloc; b.st[1] = nx; }
        const unsigned old = xb_add(&bar[XB_XSUB(b.x)], 1u);
        const unsigned gen = old / nloc;
        if (old + 1u == (gen + 1u) * nloc) {
            __builtin_amdgcn_fence(__ATOMIC_RELEASE, "agent");
            asm volatile("s_waitcnt vmcnt(0)" ::: "memory");
            const unsigned og = xb_add(&bar[XB_TOP], 1u);
            const unsigned tg = og / nx;
            if (og + 1u == (tg + 1u) * nx) xb_add(&bar[XB_TOPGEN], 1u);
            else XB_SPIN(xb_ld(&bar[XB_TOPGEN]) == tg, bar);
            __builtin_amdgcn_fence(__ATOMIC_ACQUIRE, "agent");
            xb_add(&bar[XB_XGEN(b.x)], 1u);
            asm volatile("s_waitcnt vmcnt(0)" ::: "memory");
        } else {
            XB_SPIN(xb_ld(&bar[XB_XGEN(b.x)]) == gen, bar);
            __builtin_amdgcn_fence(__ATOMIC_ACQUIRE, "agent");
            asm volatile("s_waitcnt vmcnt(0)" ::: "memory");
        }
    }
    __syncthreads();
}

__device__ __forceinline__ int colmap(int kind, int c) {
    if (kind == 1) return c < 1280 ? c : (c < 1304 ? C_NG + (c - 1280) : c - 24);
    if (kind == 2) { return c < DFF ? (c >> 7) * 256 + (c & 127) : ((c - DFF) >> 7) * 256 + 128 + ((c - DFF) & 127); }
    return c;
}
__device__ __forceinline__ void transpose_item(const float* W, int K, int N, bf16_t* WT, LAS float* scr, int kb, int nb, int lane, const float* kscale, int kind) {
    const int k0 = 64 * kb, n0 = 32 * nb;
#pragma unroll 8
    for (int i = 0; i < 32; ++i) { const int kk = 2 * i + (lane >> 5), n = n0 + (lane & 31); float v = (n < N) ? W[(size_t)(k0 + kk) * N + n] : 0.f; if (kscale) v *= kscale[k0 + kk]; scr[kk * 33 + (lane & 31)] = v; }
    asm volatile("s_waitcnt lgkmcnt(0)" ::: "memory");
    const int c = lane & 7;
#pragma unroll
    for (int j = 0; j < 4; ++j) { const int n = (lane >> 3) + 8 * j; const LAS float* s = scr + (8 * c) * 33 + n;
        if (n0 + n < N) { u32x4 o; o.x = cvt_pk_bf16(s[0 * 33], s[1 * 33]); o.y = cvt_pk_bf16(s[2 * 33], s[3 * 33]); o.z = cvt_pk_bf16(s[4 * 33], s[5 * 33]); o.w = cvt_pk_bf16(s[6 * 33], s[7 * 33]);
            *(u32x4*)(WT + (size_t)colmap(kind, n0 + n) * K + k0 + 8 * c) = o; } }
    asm volatile("s_waitcnt lgkmcnt(0)" ::: "memory");
}

#define EXP2(x) __builtin_amdgcn_exp2f(x)
#define MFMA16(a, b, c) __builtin_amdgcn_mfma_f32_16x16x32_bf16((a), (b), (c), 0, 0, 0)
__device__ __forceinline__ float dpp_x1(float v) { return __int_as_float(__builtin_amdgcn_update_dpp(0, __float_as_int(v), 0xB1, 0xF, 0xF, true)); }
__device__ __forceinline__ float dpp_x2(float v) { return __int_as_float(__builtin_amdgcn_update_dpp(0, __float_as_int(v), 0x4E, 0xF, 0xF, true)); }
struct KOp { bf16x8 a00, a01, a10, a11; };
struct VOp { bf16x8 v0, v1, v2, v3; };
__device__ __forceinline__ KOp ldk(const bf16_t* Kb, size_t pitch, int kb, int lane) {
    const int i = lane & 15, q = lane >> 4;
    const bf16_t* r0 = Kb + (size_t)(kb + 8 * (i >> 2) + (i & 3)) * pitch + 8 * q; const bf16_t* r1 = r0 + 4 * pitch;
    KOp k; k.a00 = *(const bf16x8*)r0; k.a01 = *(const bf16x8*)(r0 + 32); k.a10 = *(const bf16x8*)r1; k.a11 = *(const bf16x8*)(r1 + 32); return k;
}
__device__ __forceinline__ VOp ldv(const bf16_t* Vt, size_t vpitch, int kb, int lane) {
    const int i = lane & 15, q = lane >> 4; const size_t base = (vpitch == 64) ? (size_t)(kb >> 6) * 4096 + (kb & 63) : (size_t)kb;
    const bf16_t* r = Vt + base + (size_t)i * vpitch + 8 * q;
    VOp v; v.v0 = *(const bf16x8*)r; v.v1 = *(const bf16x8*)(r + 16 * vpitch); v.v2 = *(const bf16x8*)(r + 32 * vpitch); v.v3 = *(const bf16x8*)(r + 48 * vpitch); return v;
}
__device__ __forceinline__ void qk32(const KOp& k, const bf16x8& Bq0, const bf16x8& Bq1, f32x4& S0, f32x4& S1) {
    const f32x4 z = {0.f, 0.f, 0.f, 0.f};
    S0 = MFMA16(k.a00, Bq0, z); S0 = MFMA16(k.a01, Bq1, S0); S1 = MFMA16(k.a10, Bq0, z); S1 = MFMA16(k.a11, Bq1, S1);
}
__device__ __forceinline__ void pv32(const VOp& v, const bf16x8& P, f32x4 (&O)[4]) {
    O[0] = MFMA16(v.v0, P, O[0]); O[1] = MFMA16(v.v1, P, O[1]); O[2] = MFMA16(v.v2, P, O[2]); O[3] = MFMA16(v.v3, P, O[3]);
}
__device__ __forceinline__ bf16x8 packP(const f32x4& p0, const f32x4& p1) { u32x4 w = pack8(p0, p1); return __builtin_bit_cast(bf16x8, w); }

struct KbLin { int base; __device__ __forceinline__ int operator()(int i) const { return base + 32 * i; } };
struct KbLds { const LAS int* l; __device__ __forceinline__ int operator()(int i) const { return l[i]; } };

template <bool NEEDV, class KB, class Body>
__device__ __forceinline__ void pipe3(int n, const KB kbf, Body& body, const bf16_t* Kb, size_t kp, const bf16_t* Vt, size_t vp, int lane) {
    if (n <= 0) return;
    KOp k0, k1; VOp v;
    k0 = ldk(Kb, kp, kbf(0), lane);
    for (int i = 0; i < n; i += 2) {
        { const int kb = kbf(i); if (NEEDV) v = ldv(Vt, vp, kb, lane); k1 = ldk(Kb, kp, kbf(i + 1 < n ? i + 1 : n - 1), lane); body.run(kb, k0, v); }
        if (i + 1 >= n) break;
        { const int kb = kbf(i + 1); if (NEEDV) v = ldv(Vt, vp, kb, lane); k0 = ldk(Kb, kp, kbf(i + 2 < n ? i + 2 : n - 1), lane); body.run(kb, k1, v); }
    }
}

struct BodyCmp1 {
    bf16x8 Bq[2][2]; int nv[2], q; float ml[2], ll[2];
    __device__ __forceinline__ void run(int kb, const KOp& k, const VOp&) {
#pragma unroll
        for (int cg = 0; cg < 2; ++cg) {
            f32x4 S0, S1; qk32(k, Bq[cg][0], Bq[cg][1], S0, S1);
            const int k0 = kb + 8 * q; float mloc = NEGF;
#pragma unroll
            for (int e = 0; e < 4; ++e) { if (k0 + e >= nv[cg]) S0[e] = NEGF; if (k0 + 4 + e >= nv[cg]) S1[e] = NEGF; mloc = fmaxf(mloc, fmaxf(S0[e], S1[e])); }
            const float mn = fmaxf(ml[cg], mloc); float ps = 0.f;
#pragma unroll
            for (int e = 0; e < 4; ++e) { ps += (k0 + e < nv[cg]) ? EXP2(S0[e] - mn) : 0.f; ps += (k0 + 4 + e < nv[cg]) ? EXP2(S1[e] - mn) : 0.f; }
            ll[cg] = ll[cg] * EXP2(ml[cg] - mn) + ps; ml[cg] = mn;
        }
    }
};
struct BodyCmp2 {
    bf16x8 Bq[2][2]; int nv[2], q, g, lane_; float mc[2], inv[2], carry[2]; LAS float* ia[2]; f32x4 O[2][4];
    __device__ __forceinline__ void run(int kb, const KOp& k, const VOp& v) {
#pragma unroll
        for (int cg = 0; cg < 2; ++cg) {
            f32x4 S0, S1; qk32(k, Bq[cg][0], Bq[cg][1], S0, S1);
            const int k0 = kb + 8 * q; f32x4 p0, p1;
#pragma unroll
            for (int e = 0; e < 4; ++e) { p0[e] = (k0 + e < nv[cg]) ? EXP2(S0[e] - mc[cg]) * inv[cg] : 0.f; p1[e] = (k0 + 4 + e < nv[cg]) ? EXP2(S1[e] - mc[cg]) * inv[cg] : 0.f; }
            f32x4 s0 = p0, s1 = p1;
#pragma unroll
            for (int e = 0; e < 4; ++e) { s0[e] += dpp_x1(s0[e]); s0[e] += dpp_x2(s0[e]); s1[e] += dpp_x1(s1[e]); s1[e] += dpp_x2(s1[e]); }
            const float bout = 0.5f * s1[3]; const float recv = __shfl(bout, (lane_ + 48) & 63); const float bin = (q == 0) ? carry[cg] : recv; carry[cg] = recv;
            if (g == 0) { const int j = k0 >> 2; ia[cg][j] = ((s0[0] + s0[1]) + (s0[2] + 0.5f * s0[3])) + bin; ia[cg][j + 1] = 0.5f * s0[3] + ((s1[0] + s1[1]) + (s1[2] + 0.5f * s1[3])); }
            pv32(v, packP(p0, p1), O[cg]);
        }
    }
};
struct BodyWin {
    bf16x8 Bq[2][2]; int q, tt[2]; float m[2], l[2]; f32x4 O[2][4];
    __device__ __forceinline__ void run(int kb, const KOp& k, const VOp& v) {
#pragma unroll
        for (int cg = 0; cg < 2; ++cg) {
            f32x4 S0, S1; qk32(k, Bq[cg][0], Bq[cg][1], S0, S1);
            const int k0 = kb + 8 * q; unsigned vm = 0u;
#pragma unroll
            for (int e = 0; e < 8; ++e) { const bool ok = (k0 + e <= tt[cg]) && (tt[cg] - (k0 + e) < 512); vm |= ok ? (1u << e) : 0u; }
            float mloc = NEGF;
#pragma unroll
            for (int e = 0; e < 4; ++e) { if (!((vm >> e) & 1u)) S0[e] = NEGF; if (!((vm >> (4 + e)) & 1u)) S1[e] = NEGF; mloc = fmaxf(mloc, fmaxf(S0[e], S1[e])); }
            mloc = fmaxf(mloc, __shfl_xor(mloc, 16)); mloc = fmaxf(mloc, __shfl_xor(mloc, 32));
            const float mn = fmaxf(m[cg], mloc), alpha = EXP2(m[cg] - mn); m[cg] = mn;
            f32x4 p0, p1; float ps = 0.f;
#pragma unroll
            for (int e = 0; e < 4; ++e) { p0[e] = ((vm >> e) & 1u) ? EXP2(S0[e] - mn) : 0.f; p1[e] = ((vm >> (4 + e)) & 1u) ? EXP2(S1[e] - mn) : 0.f; ps += p0[e] + p1[e]; }
            l[cg] = l[cg] * alpha + ps;
#pragma unroll
            for (int dt = 0; dt < 4; ++dt) O[cg][dt] = O[cg][dt] * alpha;
            pv32(v, packP(p0, p1), O[cg]);
        }
    }
};

struct AttnT { float fxs; unsigned long long* tsa; const bf16_t* proj; const bf16_t* kslc; const bf16_t* kwnc; const bf16_t* kcmp; const bf16_t* vcmpT; const bf16_t* vslT; const bf16_t* vwnT; bf16_t* ya; };

constexpr int AL_IMP = 0  , AL_OS = 0  , AL_TM = 67584  , AL_CNT = 69632  ,
              AL_OFF = 70656  , AL_UNITS = 71744  , AL_MM = 77888  , AL_LS = 78912  ;
constexpr int AL_Q = 81920  , QROWB = 528;
constexpr int OSP = 33;
constexpr float FXB = 67108864.0f;
typedef short s16x2 __attribute__((ext_vector_type(2)));
__device__ __forceinline__ int f2ord(float f) { const int b = __float_as_int(f); return b >= 0 ? b : b ^ 0x7fffffff; }
__device__ __forceinline__ float ord2f(int b) { return __int_as_float(b >= 0 ? b : b ^ 0x7fffffff); }

__device__ __forceinline__ void attn_wave_part1(const AttnT& T, int kh, int tq8, int lane, LAS float* imp  , LAS unsigned* tm, int wave) {
    const int col = lane & 15, q = lane >> 4, tk = col >> 2, g = col & 3;
    const int t0 = tq8 * 8, h = kh * 4 + g;
    bf16x8 Bq[2][2]; float g0[2], g2[2]; int tcg[2];
#pragma unroll
    for (int cg = 0; cg < 2; ++cg) { tcg[cg] = t0 + 4 * cg + tk; const bf16_t* prow = T.proj + (size_t)tcg[cg] * PP;
        Bq[cg][0] = *(const bf16x8*)(prow + C_Q + h * 64 + 8 * q); Bq[cg][1] = *(const bf16x8*)(prow + C_Q + h * 64 + 32 + 8 * q);
        g0[cg] = bf2f(prow[C_NG + h * 3 + 0]); g2[cg] = bf2f(prow[C_NG + h * 3 + 2]); }
    for (int i = lane; i < 8 * 264; i += 64) imp[i] = 0.f;
    {
        const bf16_t* Kc = T.kcmp + (size_t)kh * 1024 * 64; const bf16_t* Vc = T.vcmpT + (size_t)kh * 64 * 1024;
        const int tmax = t0 + 7, nvmax = tmax >= 31 ? ((tmax - 31) >> 4) + 1 : 0, nsteps = (nvmax + 31) >> 5;
        BodyCmp1 b1;
#pragma unroll
        for (int cg = 0; cg < 2; ++cg) { b1.Bq[cg][0] = Bq[cg][0]; b1.Bq[cg][1] = Bq[cg][1]; b1.nv[cg] = tcg[cg] >= 31 ? ((tcg[cg] - 31) >> 4) + 1 : 0; b1.ml[cg] = NEGF; b1.ll[cg] = 0.f; }
        b1.q = q;
        pipe3<false>(nsteps, KbLin{0}, b1, Kc, 64, Vc, 1024, lane);
        BodyCmp2 b2; b2.q = q; b2.g = g; b2.lane_ = lane; b2.carry[0] = 0.f; b2.carry[1] = 0.f;
#pragma unroll
        for (int cg = 0; cg < 2; ++cg) {
            float mc = fmaxf(b1.ml[cg], __shfl_xor(b1.ml[cg], 16)); mc = fmaxf(mc, __shfl_xor(mc, 32));
            float lc = b1.ll[cg] * EXP2(b1.ml[cg] - mc); lc += __shfl_xor(lc, 16); lc += __shfl_xor(lc, 32);
            b2.Bq[cg][0] = Bq[cg][0]; b2.Bq[cg][1] = Bq[cg][1]; b2.nv[cg] = b1.nv[cg]; b2.mc[cg] = mc; b2.inv[cg] = 1.f / fmaxf(lc, 1e-30f); b2.ia[cg] = imp + (4 * cg + tk) * 264;
#pragma unroll
            for (int dt = 0; dt < 4; ++dt) b2.O[cg][dt] = (f32x4){0.f, 0.f, 0.f, 0.f};
        }
        asm volatile("s_waitcnt lgkmcnt(0)" ::: "memory");
        pipe3<true>(nsteps, KbLin{0}, b2, Kc, 64, Vc, 1024, lane);
        if (q == 0 && g == 0 && nsteps > 0) { b2.ia[0][8 * nsteps] = b2.carry[0]; b2.ia[1][8 * nsteps] = b2.carry[1]; }
#pragma unroll
        for (int cg = 0; cg < 2; ++cg) { bf16_t* yrow = T.ya + (size_t)tcg[cg] * 512 + h * 64 + 4 * q;
#pragma unroll
            for (int dt = 0; dt < 4; ++dt) { const f32x4 o = b2.O[cg][dt] * g0[cg]; u32x2 w; w.x = cvt_pk_bf16(o[0], o[1]); w.y = cvt_pk_bf16(o[2], o[3]); *(u32x2*)(yrow + 16 * dt) = w; } }
    }
    asm volatile("s_waitcnt lgkmcnt(0)" ::: "memory");
    for (int tk2 = 0; tk2 < 8; ++tk2) {
        const int tt = t0 + tk2, cur = tt >> 6, nvalid = cur + 1, KSEL = nvalid < 16 ? nvalid : 16;
        int bits[4];
#pragma unroll
        for (int s = 0; s < 4; ++s) { const int j = s * 64 + lane; const float v = imp[tk2 * 264 + j];
            bits[s] = (j == 0 || j == cur) ? 0x7F000000 : (j < nvalid ? __float_as_int(v) : -1); }
        int prefix = 0;
        for (int bit = 30; bit >= 0; --bit) { const int Tt = prefix | (1 << bit); int cnt = 0;
#pragma unroll
            for (int s = 0; s < 4; ++s) cnt += __popcll(__ballot(bits[s] >= Tt));
            if (cnt >= KSEL) prefix = Tt; }
        unsigned long long sel[4]; int need = KSEL;
#pragma unroll
        for (int s = 0; s < 4; ++s) { sel[s] = __ballot(bits[s] > prefix); need -= __popcll(sel[s]); }
#pragma unroll
        for (int s = 0; s < 4; ++s) { unsigned long long me = __ballot(bits[s] == prefix);
            while (me != 0ull && need > 0) { const unsigned long long low = me & (0ull - me); sel[s] |= low; me ^= low; --need; } }
        const int tbi = wave * 8 + tk2; const unsigned tbit = 1u << (tbi & 31);
#pragma unroll
        for (int s = 0; s < 4; ++s) if ((sel[s] >> lane) & 1ull) __hip_atomic_fetch_or(tm + (s * 64 + lane) * 2 + (tbi >> 5), tbit, __ATOMIC_RELAXED, __HIP_MEMORY_SCOPE_WORKGROUP);
    }
    {
        const bf16_t* Kw = T.kwnc + (size_t)kh * SEQ * 64; const bf16_t* Vw = T.vwnT + (size_t)kh * 256 * 4096;
        const int klo = (t0 - 511 > 0 ? t0 - 511 : 0) & ~31; const int n = ((t0 + 7 - klo) >> 5) + 1;
        BodyWin bo; bo.q = q;
#pragma unroll
        for (int cg = 0; cg < 2; ++cg) { bo.Bq[cg][0] = Bq[cg][0]; bo.Bq[cg][1] = Bq[cg][1]; bo.tt[cg] = tcg[cg]; bo.m[cg] = NEGF; bo.l[cg] = 0.f;
#pragma unroll
            for (int dt = 0; dt < 4; ++dt) bo.O[cg][dt] = (f32x4){0.f, 0.f, 0.f, 0.f}; }
        pipe3<true>(n, KbLin{klo}, bo, Kw, 64, Vw, 64, lane);
#pragma unroll
        for (int cg = 0; cg < 2; ++cg) { float l = bo.l[cg]; l += __shfl_xor(l, 16); l += __shfl_xor(l, 32);
            const float sc = g2[cg] / fmaxf(l, 1e-30f); bf16_t* yrow = T.ya + (size_t)tcg[cg] * 512 + h * 64 + 4 * q;
#pragma unroll
            for (int dt = 0; dt < 4; ++dt) { const u32x2 y = *(const u32x2*)(yrow + 16 * dt); const f32x4 o = bo.O[cg][dt] * sc;
                u32x2 w; w.x = cvt_pk_bf16(bf_lo(y.x) + o[0], bf_hi(y.x) + o[1]); w.y = cvt_pk_bf16(bf_lo(y.y) + o[2], bf_hi(y.y) + o[3]); *(u32x2*)(yrow + 16 * dt) = w; } }
    }
    asm volatile("s_waitcnt lgkmcnt(0)" ::: "memory");
}

struct UnitPre { int j; unsigned tlo, thi; bf16x8 q00, q01, q10, q11; KOp ka, kb; VOp va, vb; };
template <int PASS>
__device__ __forceinline__ UnitPre unit_load(const LAS unsigned char* qlds, const bf16_t* Ks, const bf16_t* Vs, int kh, int tile, const LAS u32x4* units, int u, int lane) {
    const int col = lane & 15, q = lane >> 4, slot = col >> 2, g = col & 3;
    const u32x4 d = units[u]; UnitPre P; P.j = __builtin_amdgcn_readfirstlane((int)d.x); P.tlo = (unsigned)__builtin_amdgcn_readfirstlane((int)d.y); P.thi = (unsigned)__builtin_amdgcn_readfirstlane((int)d.z);
    const unsigned t0b = (P.tlo >> (8 * slot)) & 0xffu, t1b = (P.thi >> (8 * slot)) & 0xffu;
    const LAS unsigned char* qr0 = qlds + (t0b == 0xffu ? 0 : (int)t0b) * QROWB + g * 128 + 16 * q;
    const LAS unsigned char* qr1 = qlds + (t1b == 0xffu ? 0 : (int)t1b) * QROWB + g * 128 + 16 * q;
    P.q00 = *(const LAS bf16x8*)qr0; P.q01 = *(const LAS bf16x8*)(qr0 + 64); P.q10 = *(const LAS bf16x8*)qr1; P.q11 = *(const LAS bf16x8*)(qr1 + 64);
    P.ka = ldk(Ks, 64, 64 * P.j, lane); P.kb = ldk(Ks, 64, 64 * P.j + 32, lane);
    if (PASS == 1) { if ((EXPV) == 2) { P.va.v0 = P.ka.a00; P.va.v1 = P.ka.a01; P.va.v2 = P.ka.a10; P.va.v3 = P.ka.a11; P.vb = P.va; } else { P.va = ldv(Vs, 64, 64 * P.j, lane); P.vb = ldv(Vs, 64, 64 * P.j + 32, lane); } }
    return P;
}
template <int PASS>
__device__ __forceinline__ void unit_group(const UnitPre& P, const bf16x8& q0, const bf16x8& q1, unsigned toks, int tile, LAS unsigned char* lds, float fxs, int lane) {
    const int col = lane & 15, q = lane >> 4, slot = col >> 2, g = col & 3;
    const int ti = (int)((toks >> (8 * slot)) & 0xffu);
    f32x4 S0a, S1a, S0b, S1b; qk32(P.ka, q0, q1, S0a, S1a); qk32(P.kb, q0, q1, S0b, S1b);
    const bool valid = ti != 0xff; const int row = (valid ? ti : 0) * 4 + g;
    const int lim = (P.j == tile) ? (valid ? ti : -1) - 8 * q : (valid ? 1000 : -1);
    LAS int* mm = (LAS int*)(lds + AL_MM); LAS float* ls = (LAS float*)(lds + AL_LS);
    if (PASS == 0) {
        float mloc = NEGF;
#pragma unroll
        for (int e = 0; e < 4; ++e) { mloc = fmaxf(mloc, e <= lim ? S0a[e] : NEGF); mloc = fmaxf(mloc, e + 4 <= lim ? S1a[e] : NEGF); mloc = fmaxf(mloc, e + 32 <= lim ? S0b[e] : NEGF); mloc = fmaxf(mloc, e + 36 <= lim ? S1b[e] : NEGF); }
        if ((EXPV) != 4) { mloc = fmaxf(mloc, __shfl_xor(mloc, 16)); mloc = fmaxf(mloc, __shfl_xor(mloc, 32)); }
        if (q == 0 && valid && (EXPV) != 3) __hip_atomic_fetch_max(mm + row, f2ord(mloc), __ATOMIC_RELAXED, __HIP_MEMORY_SCOPE_WORKGROUP);
    } else {
        const float m = ord2f(mm[row]);
        f32x4 p0a, p1a, p0b, p1b; float ps = 0.f;
#pragma unroll
        for (int e = 0; e < 4; ++e) { p0a[e] = e <= lim ? EXP2(S0a[e] - m) : 0.f; p1a[e] = e + 4 <= lim ? EXP2(S1a[e] - m) : 0.f; p0b[e] = e + 32 <= lim ? EXP2(S0b[e] - m) : 0.f; p1b[e] = e + 36 <= lim ? EXP2(S1b[e] - m) : 0.f;
            ps += (p0a[e] + p1a[e]) + (p0b[e] + p1b[e]); }
        ps += __shfl_xor(ps, 16); ps += __shfl_xor(ps, 32);
        if (q == 0 && valid) __hip_atomic_fetch_add(ls + row, ps, __ATOMIC_RELAXED, __HIP_MEMORY_SCOPE_WORKGROUP);
        f32x4 O[4];
#pragma unroll
        for (int dt = 0; dt < 4; ++dt) O[dt] = (f32x4){0.f, 0.f, 0.f, 0.f};
        pv32(P.va, packP(p0a, p1a), O); pv32(P.vb, packP(p0b, p1b), O);
        if (valid) { LAS unsigned long long* orow = (LAS unsigned long long*)(lds + AL_OS) + row * OSP + 2 * q;
#pragma unroll
            for (int dt = 0; dt < 4; ++dt) {
                const unsigned a0 = (unsigned)((int)rintf(O[dt][0] * fxs) + (1 << 26)), a1 = (unsigned)((int)rintf(O[dt][1] * fxs) + (1 << 26)), a2 = (unsigned)((int)rintf(O[dt][2] * fxs) + (1 << 26)), a3 = (unsigned)((int)rintf(O[dt][3] * fxs) + (1 << 26));
                __hip_atomic_fetch_add(orow + 8 * dt, (unsigned long long)a0 | ((unsigned long long)a1 << 32), __ATOMIC_RELAXED, __HIP_MEMORY_SCOPE_WORKGROUP);
                __hip_atomic_fetch_add(orow + 8 * dt + 1, (unsigned long long)a2 | ((unsigned long long)a3 << 32), __ATOMIC_RELAXED, __HIP_MEMORY_SCOPE_WORKGROUP); } }
    }
}
template <int PASS>
__device__ __forceinline__ void unit_compute(const UnitPre& P, int tile, LAS unsigned char* lds, float fxs, int lane) {
    unit_group<PASS>(P, P.q00, P.q01, P.tlo, tile, lds, fxs, lane);
    if (P.thi != 0xffffffffu) unit_group<PASS>(P, P.q10, P.q11, P.thi, tile, lds, fxs, lane);
}
template <int PASS>
__device__ __forceinline__ void unit_pass(const AttnT& T, int kh, int tile, int n, LAS unsigned char* lds, int wave, int lane) {
    const bf16_t* Ks = T.kslc + (size_t)kh * SEQ * 64; const bf16_t* Vs = T.vslT + (size_t)kh * 256 * 4096;
    const LAS u32x4* units = (const LAS u32x4*)(lds + AL_UNITS);
    int u = wave; if (u >= n) return;
    UnitPre A = unit_load<PASS>(lds + AL_Q, Ks, Vs, kh, tile, units, u, lane), B = A;
    for (; u < n; u += 16) {
        const int u1 = u + 8; if (u1 < n) B = unit_load<PASS>(lds + AL_Q, Ks, Vs, kh, tile, units, u1, lane);
        unit_compute<PASS>(A, tile, lds, T.fxs, lane);
        if (u1 >= n) break;
        const int u2 = u + 16; if (u2 < n) A = unit_load<PASS>(lds + AL_Q, Ks, Vs, kh, tile, units, u2, lane);
        unit_compute<PASS>(B, tile, lds, T.fxs, lane);
    }
}

__device__ __forceinline__ void attn_tile(const AttnT& T, int kh, int tile, LAS unsigned char* lds, int tid, int wave, int lane) {
    LAS unsigned* tm = (LAS unsigned*)(lds + AL_TM);
    for (int i = tid; i < 512; i += NT) tm[i] = 0u;
    { const int ti = tid >> 3, part = tid & 7; const u32x4* src = (const u32x4*)(T.proj + (size_t)(tile * 64 + ti) * PP + C_Q + kh * 256 + part * 32); LAS u32x4* dst = (LAS u32x4*)(lds + AL_Q + ti * QROWB + part * 64);
      dst[0] = src[0]; dst[1] = src[1]; dst[2] = src[2]; dst[3] = src[3]; }
    __syncthreads();
    if ((TSK) >= 20 && blockIdx.x == 0 && threadIdx.x == 0) T.tsa[15] = __builtin_amdgcn_s_memrealtime();
    for (int r3 = 0; r3 < ((PROBE_REP) == 41 ? 2 : 1); ++r3)
    attn_wave_part1(T, kh, tile * 8 + wave, lane, (LAS float*)(lds + AL_IMP + wave * 8448), tm, wave);
    __threadfence_block(); __syncthreads();
    ASTAMP(0);
    LAS int* cnt = (LAS int*)(lds + AL_CNT); LAS int* off = (LAS int*)(lds + AL_OFF); LAS u32x4* units = (LAS u32x4*)(lds + AL_UNITS);
    for (int i = tid; i < 256 * OSP; i += NT) ((LAS unsigned long long*)(lds + AL_OS))[i] = 0ull;
    if (tid < 256) { ((LAS int*)(lds + AL_MM))[tid] = f2ord(NEGF); ((LAS float*)(lds + AL_LS))[tid] = 0.f; cnt[tid] = (__popc(tm[2 * tid]) + __popc(tm[2 * tid + 1]) + 7) >> 3; }
    __syncthreads();
    if (tid < 64) {
        const int c0 = cnt[4 * tid], c1 = cnt[4 * tid + 1], c2 = cnt[4 * tid + 2], c3 = cnt[4 * tid + 3]; const int tot = (c0 + c1) + (c2 + c3); int inc = tot;
#pragma unroll
        for (int o = 1; o < 64; o <<= 1) { const int v = __shfl_up(inc, o); if (tid >= o) inc += v; }
        const int ex = inc - tot; off[4 * tid] = ex; off[4 * tid + 1] = ex + c0; off[4 * tid + 2] = ex + c0 + c1; off[4 * tid + 3] = ex + c0 + c1 + c2;
        if (tid == 63) off[256] = inc;
    }
    __syncthreads();
    if (tid < 256) { unsigned long long mask = (unsigned long long)tm[2 * tid] | ((unsigned long long)tm[2 * tid + 1] << 32); int o = off[tid];
        while (mask != 0ull) { unsigned tl = 0xffffffffu, th = 0xffffffffu;
#pragma unroll
            for (int k = 0; k < 4; ++k) if (mask != 0ull) { const unsigned ti = (unsigned)__builtin_ctzll(mask); mask &= mask - 1ull; tl = (tl & ~(0xffu << (8 * k))) | (ti << (8 * k)); }
#pragma unroll
            for (int k = 0; k < 4; ++k) if (mask != 0ull) { const unsigned ti = (unsigned)__builtin_ctzll(mask); mask &= mask - 1ull; th = (th & ~(0xffu << (8 * k))) | (ti << (8 * k)); }
            units[o++] = (u32x4){(unsigned)tid, tl, th, 0u}; } }
    __syncthreads();
    const int n = off[256];
    ASTAMP(1);
    unit_pass<0>(T, kh, tile, n, lds, wave, lane);
    if ((PROBE_REP) == 42) unit_pass<0>(T, kh, tile, n, lds, wave, lane);
    __syncthreads();
    ASTAMP(2);
    unit_pass<1>(T, kh, tile, n, lds, wave, lane);
    __syncthreads();
    ASTAMP(3);
    { const int ti = tid >> 3, part = tid & 7, g = part >> 1, d0 = 32 * (part & 1), row = ti * 4 + g, t = tile * 64 + ti, h = kh * 4 + g;
      const float l = ((const LAS float*)(lds + AL_LS))[row]; const float sc = bf2f(T.proj[(size_t)t * PP + C_NG + h * 3 + 1]) / fmaxf(l, 1e-30f);
      const LAS unsigned long long* orow = (const LAS unsigned long long*)(lds + AL_OS) + row * OSP + (d0 >> 1); u32x4* yp = (u32x4*)(T.ya + (size_t)t * 512 + h * 64 + d0);
      const int nsel = ((t >> 6) + 1) < 16 ? ((t >> 6) + 1) : 16; const unsigned bias = (unsigned)nsel << 26; const float sc2 = sc / T.fxs;
#pragma unroll
      for (int i = 0; i < 4; ++i) { const u32x4 y = yp[i]; const unsigned long long o0 = orow[4 * i], o1 = orow[4 * i + 1], o2 = orow[4 * i + 2], o3 = orow[4 * i + 3]; f32x4 a, b;
          a[0] = bf_lo(y.x) + (float)(int)((unsigned)o0 - bias) * sc2; a[1] = bf_hi(y.x) + (float)(int)((unsigned)(o0 >> 32) - bias) * sc2; a[2] = bf_lo(y.y) + (float)(int)((unsigned)o1 - bias) * sc2; a[3] = bf_hi(y.y) + (float)(int)((unsigned)(o1 >> 32) - bias) * sc2;
          b[0] = bf_lo(y.z) + (float)(int)((unsigned)o2 - bias) * sc2; b[1] = bf_hi(y.z) + (float)(int)((unsigned)(o2 >> 32) - bias) * sc2; b[2] = bf_lo(y.w) + (float)(int)((unsigned)o3 - bias) * sc2; b[3] = bf_hi(y.w) + (float)(int)((unsigned)(o3 >> 32) - bias) * sc2;
          yp[i] = pack8(a, b); } }
    __syncthreads();
    ASTAMP(4);
    if ((TSK) >= 20 && blockIdx.x == 0 && threadIdx.x == 0) T.tsa[5] += (unsigned long long)n;
}

struct SsmB { bf16x8 a[8]; };
__device__ __forceinline__ SsmB ssm_load_b(const unsigned char* ws, int g, int lane) {
    const int i = lane & 15, q = lane >> 4; SsmB B; const bf16x8 z = {0, 0, 0, 0, 0, 0, 0, 0};
    const bf16_t* t = (const bf16_t*)(ws + WS_BBAR) + ((size_t)(g * 128 + i) * 16 + 8 * (q & 1));
#pragma unroll
    for (int rt = 0; rt < 8; ++rt) B.a[rt] = (q < 2) ? *(const bf16x8*)(t + (size_t)rt * 16 * 16) : z;
    return B;
}
__device__ __forceinline__ void ssm_bu16(const bf16_t* proj, const SsmB& B, int tok0, int g, int lane, LAS float* bul) {
    const int i = lane & 15, q = lane >> 4; const bf16x8 z = {0, 0, 0, 0, 0, 0, 0, 0};
    const bf16x8 ub = (q < 2) ? *(const bf16x8*)(proj + (size_t)(tok0 + i) * PP + C_U + g * 16 + 8 * (q & 1)) : z;
    const f32x4 z4 = {0.f, 0.f, 0.f, 0.f};
#pragma unroll
    for (int rt = 0; rt < 8; ++rt) { const f32x4 acc = MFMA16(B.a[rt], ub, z4); *(LAS f32x4*)(bul + i * 132 + 16 * rt + 4 * q) = acc; }
    asm volatile("s_waitcnt lgkmcnt(0)" ::: "memory");
}
__device__ __forceinline__ f32x2 ssm_step(const f32x2 A, const f32x2 x, const f32x2 bu) { f32x2 r; r.x = A.x * x.x - A.y * x.y + bu.x; r.y = A.x * x.y + A.y * x.x + bu.y; return r; }
__device__ __forceinline__ void ssm_pass1(const unsigned char* ws, int c, int g, int lane, LAS float* bul) {
    const bf16_t* proj = (const bf16_t*)(ws + WS_PROJ);
    const SsmB B = ssm_load_b(ws, g, lane);
    const f32x2 A = ((const f32x2*)(ws + WS_ABAR))[g * 64 + lane];
    f32x2 x = {0.f, 0.f};
    for (int sub = 0; sub < 8; ++sub) {
        ssm_bu16(proj, B, c * 128 + sub * 16, g, lane, bul);
#pragma unroll
        for (int s = 0; s < 16; ++s) x = ssm_step(A, x, *(const LAS f32x2*)(bul + s * 132 + 2 * lane));
        asm volatile("s_waitcnt lgkmcnt(0)" ::: "memory");
    }
    ((f32x2*)(ws + WS_SBUF))[(size_t)(c * 32 + g) * 64 + lane] = x;
}
__device__ __forceinline__ void ssm_pass3(const Args& a, int c, int g, int lane, LAS float* bul, LAS unsigned char* xl  ) {
    const unsigned char* ws = a.ws; const bf16_t* proj = (const bf16_t*)(ws + WS_PROJ);
    const SsmB B = ssm_load_b(ws, g, lane);
    const f32x2 A = ((const f32x2*)(ws + WS_ABAR))[g * 64 + lane], A128 = ((const f32x2*)(ws + WS_A128))[g * 64 + lane];
    f32x2 x = {0.f, 0.f};
    { const f32x2* Sb = (const f32x2*)(ws + WS_SBUF) + g * 64 + lane;
      _Pragma("unroll 8") for (int cc = 0; cc < c; ++cc) { const f32x2 s = Sb[(size_t)cc * 32 * 64]; f32x2 r; r.x = A128.x * x.x - A128.y * x.y + s.x; r.y = A128.x * x.y + A128.y * x.x + s.y; x = r; } }
    const int hrow = lane & 15, q = lane >> 4; bf16x8 Cm[4];
    { const float* cre = a.in[14] + (size_t)(g * 16 + hrow) * 64; const float* cim = a.in[15] + (size_t)(g * 16 + hrow) * 64;
#pragma unroll
      for (int ks = 0; ks < 4; ++ks) { const f32x4 r = *(const f32x4*)(cre + 16 * ks + 4 * q), im = *(const f32x4*)(cim + 16 * ks + 4 * q);
          u32x4 w; w.x = cvt_pk_bf16(r[0], -im[0]); w.y = cvt_pk_bf16(r[1], -im[1]); w.z = cvt_pk_bf16(r[2], -im[2]); w.w = cvt_pk_bf16(r[3], -im[3]); Cm[ks] = __builtin_bit_cast(bf16x8, w); } }
    const f32x4 dsk = *(const f32x4*)(a.in[16] + g * 16 + 4 * q);
    bf16_t* ybp = (bf16_t*)((unsigned char*)a.out + OUT_YBP);
    for (int sub = 0; sub < 8; ++sub) {
        const int tok0 = c * 128 + sub * 16;
        ssm_bu16(proj, B, tok0, g, lane, bul);
#pragma unroll
        for (int s = 0; s < 16; ++s) { x = ssm_step(A, x, *(const LAS f32x2*)(bul + s * 132 + 2 * lane)); *(LAS unsigned*)(xl + s * 272 + lane * 4) = cvt_pk_bf16(x.x, x.y); }
        asm volatile("s_waitcnt lgkmcnt(0)" ::: "memory");
        f32x4 acc = {0.f, 0.f, 0.f, 0.f};
#pragma unroll
        for (int ks = 0; ks < 4; ++ks) { const bf16x8 b = *(const LAS bf16x8*)(xl + hrow * 272 + ks * 64 + q * 16); acc = MFMA16(Cm[ks], b, acc); }
        const u32x2 uw = *(const u32x2*)(proj + (size_t)(tok0 + hrow) * PP + C_U + g * 16 + 4 * q);
        const f32x4 uu = {bf_lo(uw.x), bf_hi(uw.x), bf_lo(uw.y), bf_hi(uw.y)};
        f32x4 y = acc + dsk * uu;
        u32x2 w; w.x = cvt_pk_bf16(gelu_tanh(y[0]), gelu_tanh(y[1])); w.y = cvt_pk_bf16(gelu_tanh(y[2]), gelu_tanh(y[3]));
        *(u32x2*)(ybp + (size_t)(tok0 + hrow) * 512 + g * 16 + 4 * q) = w;
        asm volatile("s_waitcnt lgkmcnt(0)" ::: "memory");
    }
}

__global__ void __launch_bounds__(NT, 2) fwd_mega(Args a) {
    extern __shared__ __attribute__((aligned(16))) unsigned char lds_raw[];
    cg::grid_group grid = cg::this_grid();
    LAS unsigned char* lds = (LAS unsigned char*)lds_raw;
    const int tid = threadIdx.x, lane = tid & 63, wave = __builtin_amdgcn_readfirstlane(tid >> 6);
    const int G = gridDim.x, bid = blockIdx.x;
    const int gw = bid * NWV + wave, NGW = G * NWV;
    const int gt = bid * NT + tid, NGT = G * NT;
    unsigned char* ws = a.ws;
    const float* x = a.in[0];
    STAMP(0);
    if ((TSK) >= 20 && blockIdx.x == 0 && threadIdx.x == 0) for (int i = 0; i < 16; ++i) ((unsigned long long*)(a.ws + 244 * 1024))[i] = 0ull;
    if (tid < 4) ((volatile LAS unsigned*)(lds + 131072 + 64))[tid] = 0u;
    if (bid == 0) for (int i = tid; i < XCD_BAR_WORDS; i += NT) ((unsigned*)(ws + WS_BAR))[i] = 0u;
    __syncthreads();

    {
        if (bid < 16) {
            LAS float* red = (LAS float*)lds;
            const int o = bid * 32 + (tid & 31), ksl = tid >> 5, which = o >> 8, colc = o & 255;
            const float* pe = a.in[which ? 7 : 4]; const float* w1 = a.in[which ? 8 : 5]; float s = 0.f;
            _Pragma("unroll 16") for (int k = ksl * 128; k < ksl * 128 + 128; ++k) s += pe[k] * w1[(size_t)k * 256 + colc];
            red[ksl * 32 + (tid & 31)] = s; __syncthreads();
            if (tid < 32) { float t = 0.f; for (int i = 0; i < 16; ++i) t += red[i * 32 + tid]; ((float*)(ws + WS_BIASPE))[o] = t; }
            __syncthreads();
        }
        LAS float* scr = (LAS float*)(lds + wave * 8448);
        constexpr int I_IN = 16 * 121, I_GLU = 8 * 16, I_PA = 8 * 32, I_OUT = 16 * 32, I_UP = 16 * 176, I_DN = 44 * 32, I_W1 = 32 * 8;
        constexpr int NITEMS = I_IN + I_GLU + 2 * I_PA + I_OUT + I_UP + I_DN + 2 * I_W1;
        for (int it = gw; it < NITEMS; it += NGW) {
            int r = it;
            if (r < I_IN) { transpose_item(a.in[3], 1024, DIN, (bf16_t*)(ws + WS_WIN), scr, r / 121, r % 121, lane, a.in[2], 1); continue; } r -= I_IN;
            if (r < I_GLU) { transpose_item(a.in[18], 512, 512, (bf16_t*)(ws + WS_WGLU), scr, r / 16, r % 16, lane, nullptr, 0); continue; } r -= I_GLU;
            if (r < I_PA) { transpose_item(a.in[19], 512, 1024, (bf16_t*)(ws + WS_WPA), scr, r / 32, r % 32, lane, nullptr, 0); continue; } r -= I_PA;
            if (r < I_PA) { transpose_item(a.in[20], 512, 1024, (bf16_t*)(ws + WS_WPB), scr, r / 32, r % 32, lane, nullptr, 0); continue; } r -= I_PA;
            if (r < I_OUT) { transpose_item(a.in[21], 1024, 1024, (bf16_t*)(ws + WS_WOUT), scr, r / 32, r % 32, lane, nullptr, 0); continue; } r -= I_OUT;
            if (r < I_UP) { transpose_item(a.in[23], 1024, NUP, (bf16_t*)(ws + WS_WUP), scr, r / 176, r % 176, lane, a.in[22], 2); continue; } r -= I_UP;
            if (r < I_DN) { transpose_item(a.in[26], DFF, 1024, (bf16_t*)(ws + WS_WDOWN), scr, r / 32, r % 32, lane, nullptr, 0); continue; } r -= I_DN;
            if (r < I_W1) { transpose_item(a.in[5], 2048, 256, (bf16_t*)(ws + WS_W1K), scr, r / 8, r % 8, lane, nullptr, 0); continue; } r -= I_W1;
            transpose_item(a.in[8], 2048, 256, (bf16_t*)(ws + WS_W1V), scr, r / 8, r % 8, lane, nullptr, 0);
        }
        { u32x4* p = (u32x4*)(ws + WS_WIN + (size_t)DIN * 1024 * 2); const int n = (4096 - DIN) * 1024 * 2 / 16; for (int i = gt; i < n; i += NGT) p[i] = (u32x4){0u, 0u, 0u, 0u}; }
        { u32x4* p = (u32x4*)(ws + WS_PROJ + (size_t)SEQ * PP * 2); const int n = 32 * PP * 2 / 16; for (int i = gt; i < n; i += NGT) p[i] = (u32x4){0u, 0u, 0u, 0u}; }
        for (int i = gt; i < 128 * 64 + 2048; i += NGT) {
            if (i < 128 * 64) { const int r = i >> 6, cidx = SEQ + (i & 63); ((bf16_t*)(ws + WS_VSLT))[(size_t)r * VTP + cidx] = 0; ((bf16_t*)(ws + WS_VWNT))[(size_t)r * VTP + cidx] = 0; }
            else { const int j = i - 128 * 64; ((bf16_t*)(ws + WS_VSLT))[(size_t)128 * VTP + j] = 0; ((bf16_t*)(ws + WS_VWNT))[(size_t)128 * VTP + j] = 0; }
        }
        for (int i = gt; i < SEQ; i += NGT) { ((float*)(ws + WS_RSS2))[i] = 0.f; ((float*)(ws + WS_RSS3))[i] = 0.f; }
        if (gt == 0) *(unsigned*)(ws + WS_VMAX) = 0u;
        { const int* pos = (const int*)a.in[1];
          for (int i = gt; i < SEQ * 8; i += NGT) { const int tt = i >> 3, fi = i & 7; const float invf = powf(500000.0f, -(float)(2 * fi) / 16.0f); const float ang = (float)pos[tt] * invf;
              float sn, cs; sincosf(ang, &sn, &cs); ((float*)(ws + WS_ROPEC))[i] = cs; ((float*)(ws + WS_ROPES))[i] = sn; } }
        for (int i = gt; i < 2048; i += NGT) { const int gg = i >> 6;
            const float dt = expf(a.in[17][gg]), ar = a.in[10][i], ai = a.in[11][i];
            const float e = expf(ar * dt), em1 = expm1f(ar * dt), th = ai * dt; float sn, cs; sincosf(th, &sn, &cs); const float sh = sinf(0.5f * th);
            const float Ax = e * cs, Ay = e * sn; const float nx = em1 * cs - 2.f * sh * sh, ny = e * sn;
            const float den = 1.f / (ar * ar + ai * ai); const float fx = (nx * ar + ny * ai) * den, fy = (ny * ar - nx * ai) * den;
            ((f32x2*)(ws + WS_ABAR))[i] = (f32x2){Ax, Ay};
            float px = Ax, py = Ay;
            for (int k = 0; k < 7; ++k) { const float qx = px * px - py * py, qy = 2.f * px * py; px = qx; py = qy; }
            ((f32x2*)(ws + WS_A128))[i] = (f32x2){px, py};
            const float* bre = a.in[12] + (size_t)i * 16; const float* bim = a.in[13] + (size_t)i * 16; const int pp = i & 63;
            bf16_t* Bo = (bf16_t*)(ws + WS_BBAR) + ((size_t)(gg * 128 + 2 * pp) * 16);
            for (int hh = 0; hh < 16; hh += 2) { *(unsigned*)(Bo + hh) = cvt_pk_bf16(fx * bre[hh] - fy * bim[hh], fx * bre[hh + 1] - fy * bim[hh + 1]);
                                                 *(unsigned*)(Bo + 16 + hh) = cvt_pk_bf16(fx * bim[hh] + fy * bre[hh], fx * bim[hh + 1] + fy * bre[hh + 1]); }
        }
        for (int r = gw; r < SEQ; r += NGW) {
            const f32x4* xr = (const f32x4*)(x + (size_t)r * DM) + lane; f32x4 v[4]; float s = 0.f;
#pragma unroll
            for (int j = 0; j < 4; ++j) { v[j] = xr[64 * j]; s += (v[j][0] * v[j][0] + v[j][1] * v[j][1]) + (v[j][2] * v[j][2] + v[j][3] * v[j][3]); }
            s = wave_sum(s);
            if (lane == 0) ((float*)(ws + WS_RSTD1))[r] = rsqrtf(s * (1.f / DM) + EPS);
            u32x2* o = (u32x2*)(ws + WS_XB + (size_t)r * DM * 2) + lane;
#pragma unroll
            for (int j = 0; j < 4; ++j) { u32x2 w; w.x = cvt_pk_bf16(v[j][0], v[j][1]); w.y = cvt_pk_bf16(v[j][2], v[j][3]); o[64 * j] = w; }
        }
    }
    grid.sync();
    STAMP(1);
    XcdBarrier xbar = xcd_barrier_post((unsigned*)(ws + WS_BAR), (volatile LAS unsigned*)(lds + 131072 + 64));

    REPS(1) {
        pg8::Gemm g{1024, 2048u, 128u, (unsigned)(1024) * 2u};
        SchedMN S{64, 16, 1, G, bid, 0, (const char*)(ws + WS_XB), nullptr, (const char*)(ws + WS_WIN), nullptr, (size_t)256 * 1024 * 2, (size_t)256 * 1024 * 2};
        EpiProj E{(bf16_t*)(ws + WS_PROJ), (bf16_t*)(ws + WS_VSLT), (bf16_t*)(ws + WS_VWNT), (bf16_t*)(ws + WS_KSL), (bf16_t*)(ws + WS_KWN), (const float*)(ws + WS_RSTD1), (const float*)(ws + WS_ROPEC), (const float*)(ws + WS_ROPES)};
        pg8::gemm_phase<EpiProj, SchedMN, true, true>(lds, g, S, E);
    }
    GSYNC();
    STAMP(2);

    {
        if (bid < 64) {
            pg8::Gemm g{512, (unsigned)(16 * PP * 2), (unsigned)(PP * 2), (unsigned)(2048) * 2u};
            SchedCmp S{bid, (const char*)(ws + WS_PROJ), (const char*)(ws + WS_W1K), (const char*)(ws + WS_W1V)};
            EpiCmp E{(float*)(ws + WS_XB)};
            pg8::gemm_phase<EpiCmp, SchedCmp, true, true>(lds, g, S, E);
        } else {
            LAS float* ubuf = (LAS float*)(lds + wave * 16384);
            for (int it = (bid - 64) * NWV + wave; it < 4096 * ((PROBE_REP) == 12 ? 2 : 1); it += (G - 64) * NWV) ssm_pass1(ws, (it & 4095) >> 5, it & 31, lane, ubuf);
        }
    }
    GSYNC();
    STAMP(3);

    REPS(3) {
        {
            const u32x4* vp = (const u32x4*)(ws + WS_VSLT); unsigned mx = 0u;
            for (int i = gt; i < 262144; i += NGT) { const u32x4 v = vp[i];
                mx = max(mx, max(max(v.x & 0x7fffu, (v.x >> 16) & 0x7fffu), max(v.y & 0x7fffu, (v.y >> 16) & 0x7fffu)));
                mx = max(mx, max(max(v.z & 0x7fffu, (v.z >> 16) & 0x7fffu), max(v.w & 0x7fffu, (v.w >> 16) & 0x7fffu))); }
#pragma unroll
            for (int o = 1; o < 64; o <<= 1) mx = max(mx, (unsigned)__shfl_xor((int)mx, o));
            LAS unsigned* red = (LAS unsigned*)(lds + 65536); if (lane == 0) red[wave] = mx; __syncthreads();
            if (tid == 0) { unsigned m8 = red[0]; for (int w = 1; w < NWV; ++w) m8 = max(m8, red[w]); atomicMax((unsigned*)(ws + WS_VMAX), m8); }
            __syncthreads();
        }
        const float* hidp = (const float*)(ws + WS_XB); LAS float* hrow = (LAS float*)(lds + wave * 1024);
        for (int r = gw; r < 4096; r += NGW) {
            const int z = r >> 10, n = r & 1023, which = z >> 1, kh = z & 1;
            float acc = 0.f;
            if (n < 1023) { const float* w2 = a.in[which ? 9 : 6];
                f32x4 hv = *(const f32x4*)((const float*)(ws + WS_BIASPE) + which * 256 + 4 * lane);
#pragma unroll
                for (int ks = 0; ks < 4; ++ks) hv += *(const f32x4*)(hidp + ((size_t)ks * 4096 + r) * 256 + 4 * lane);
                hv[0] = gelu_tanh(hv[0]); hv[1] = gelu_tanh(hv[1]); hv[2] = gelu_tanh(hv[2]); hv[3] = gelu_tanh(hv[3]);
                *(LAS f32x4*)(hrow + 4 * lane) = hv; asm volatile("s_waitcnt lgkmcnt(0)" ::: "memory");
                _Pragma("unroll 16") for (int k = 0; k < 256; k += 4) { const f32x4 h4 = *(const LAS f32x4*)(hrow + k);
                    acc += h4[0] * w2[k * 64 + lane]; acc += h4[1] * w2[(k + 1) * 64 + lane]; acc += h4[2] * w2[(k + 2) * 64 + lane]; acc += h4[3] * w2[(k + 3) * 64 + lane]; }
                asm volatile("s_waitcnt lgkmcnt(0)" ::: "memory"); }
            if (which == 0) {
                const float other = __shfl_xor(acc, 8); const int prow = 16 * n + 31; float o = acc;
                if (lane < 16 && n < 1023) { const float cs = ((const float*)(ws + WS_ROPEC))[prow * 8 + (lane & 7)], sn = ((const float*)(ws + WS_ROPES))[prow * 8 + (lane & 7)];
                    o = lane < 8 ? acc * cs - other * sn : acc * cs + other * sn; }
                ((bf16_t*)(ws + WS_KCMP))[((size_t)kh * 1024 + n) * 64 + lane] = (bf16_t)(cvt_pk_bf16(o, 0.f) & 0xffff);
            } else {
                ((bf16_t*)(ws + WS_VCMPT))[((size_t)kh * 64 + lane) * 1024 + n] = (bf16_t)(cvt_pk_bf16(acc, 0.f) & 0xffff);
            }
        }
    }
    GSYNC();
    STAMP(4);

    {
        AttnT T{0.f, (unsigned long long*)(ws + 244 * 1024), (const bf16_t*)(ws + WS_PROJ), (const bf16_t*)(ws + WS_KSL), (const bf16_t*)(ws + WS_KWN), (const bf16_t*)(ws + WS_KCMP), (const bf16_t*)(ws + WS_VCMPT), (const bf16_t*)(ws + WS_VSLT), (const bf16_t*)(ws + WS_VWNT), (bf16_t*)((unsigned char*)a.out + OUT_YA)};
        { const unsigned vb = __hip_atomic_load((unsigned*)(ws + WS_VMAX), __ATOMIC_RELAXED, __HIP_MEMORY_SCOPE_AGENT); const float vmax = fmaxf(__uint_as_float(vb << 16), 1e-30f); T.fxs = FXB / (64.0f * 1.01f * vmax); }
        LAS float* wl = (LAS float*)(lds + wave * 16384);
        for (int r2 = 0; r2 < ((PROBE_REP) == 4 ? 2 : 1); ++r2)
        for (int pr = bid; pr < 256; pr += G) {
            const int xcd = pr & 7, slot = pr >> 3, kh = xcd & 1, tl = 32 * (xcd >> 1) + slot;
_Pragma("nounroll")
            for (int k2 = 0; k2 < 2; ++k2) { int tk_ = threadIdx.x; asm volatile("" : "+v"(tk_)); attn_tile(T, kh, k2 ? 255 - tl : tl, lds, tk_, __builtin_amdgcn_readfirstlane(tk_ >> 6), tk_ & 63); }
        }
        if ((PROBE_REP) == 4) {
            AttnT T2 = T; T2.ya = (bf16_t*)(ws + WS_XB);
            for (int pr = bid; pr < 256; pr += G) { const int xcd = pr & 7, slot = pr >> 3, kh = xcd & 1, tl = 32 * (xcd >> 1) + slot;
                _Pragma("nounroll") for (int k2 = 0; k2 < 2; ++k2) attn_tile(T2, kh, k2 ? 255 - tl : tl, lds, tid, wave, lane); }
        }
        int tid2 = threadIdx.x; asm volatile("" : "+v"(tid2));
        const int lane2 = tid2 & 63, wave2 = __builtin_amdgcn_readfirstlane(tid2 >> 6), gw2 = bid * NWV + wave2;
        for (int it = gw2; it < 4096 * ((PROBE_REP) == 14 ? 2 : 1); it += NGW) ssm_pass3(a, (it & 4095) >> 5, it & 31, lane2, (LAS float*)(lds + wave2 * 16384), lds + wave2 * 16384 + 8448);
    }
    GSYNC();
    STAMP(5);

    REPS(5) {
        pg8::Gemm g{512, 1024u, 128u, (unsigned)(512) * 2u};
        SchedMN S{64, 2, 1, G, bid, 0, (const char*)a.out + OUT_YBP, nullptr, (const char*)(ws + WS_WGLU), nullptr, (size_t)256 * 512 * 2, (size_t)256 * 512 * 2};
        EpiGlu E{(const bf16_t*)((const unsigned char*)a.out + OUT_YBP), (bf16_t*)((unsigned char*)a.out + OUT_YB)};
        pg8::gemm_phase<EpiGlu, SchedMN, true, true>(lds, g, S, E);
    }
    GSYNC();
    STAMP(6);

    REPS(6) {
        pg8::Gemm g{512, 1024u, 128u, (unsigned)(512) * 2u};
        SchedMN S{64, 4, 2, G, bid, 0, (const char*)a.out + OUT_YA, (const char*)a.out + OUT_YB, (const char*)(ws + WS_WPA), (const char*)(ws + WS_WPB), (size_t)256 * 512 * 2, (size_t)256 * 512 * 2};
        EpiMerge E{(const bf16_t*)(ws + WS_PROJ), (bf16_t*)(ws + WS_MERGED)};
        pg8::gemm_phase<EpiMerge, SchedMN, true, true>(lds, g, S, E);
    }
    GSYNC();
    STAMP(7);

    {
        pg8::Gemm g{1024, 2048u, 128u, (unsigned)(1024) * 2u};
        SchedMN S{64, 4, 1, G, bid, 0, (const char*)(ws + WS_MERGED), nullptr, (const char*)(ws + WS_WOUT), nullptr, (size_t)256 * 1024 * 2, (size_t)256 * 1024 * 2};
        EpiRes E{x, a.out, (bf16_t*)(ws + WS_X1B), (float*)(ws + WS_RSS2)};
        pg8::gemm_phase<EpiRes, SchedMN, true, true>(lds, g, S, E);
    }
    GSYNC();
    STAMP(8);

    for (int half = 0; half < 2; ++half) {
        const int pm_off = half ? 31 : 0, nM = half ? 33 : 32, rowbase = pm_off * 256;
        REPS(8) {
            pg8::Gemm g{1024, 2048u, 128u, (unsigned)(1024) * 2u};
            SchedMN S{nM, 22, 1, G, bid, pm_off, (const char*)(ws + WS_X1B), nullptr, (const char*)(ws + WS_WUP), nullptr, (size_t)256 * 1024 * 2, (size_t)256 * 1024 * 2};
            EpiUp E{(bf16_t*)(ws + WS_UPRAW), (const float*)(ws + WS_RSS2), rowbase};
            pg8::gemm_phase<EpiUp, SchedMN, true, true>(lds, g, S, E);
        }
        GSYNC();
    STAMP(9);
        REPS(9) {
            const bf16_t* up = (const bf16_t*)(ws + WS_UPRAW); bf16_t* act = (bf16_t*)(ws + WS_ACT);
            const float* cw = a.in[24]; const float* cb = a.in[25];
            const int tlo = half ? 8192 : 0;
            for (int it = gt; it < 256 * 352; it += NGT) {
                const int cg8 = it % 352, tb = it / 352, c0 = cg8 * 8, tile = c0 >> 7, jj = c0 & 127;
                const int ucol = tile * 256 + jj;
                float wg[3][8], wv[3][8], bg[8], bv[8];
#pragma unroll
                for (int e = 0; e < 8; ++e) { bg[e] = cb[c0 + e]; bv[e] = cb[DFF + c0 + e];
#pragma unroll
                    for (int k = 0; k < 3; ++k) { wg[k][e] = cw[k * NUP + c0 + e]; wv[k][e] = cw[k * NUP + DFF + c0 + e]; } }
                const int ts = tlo + tb * 32;
                float g2[8], g1[8], v2[8], v1[8];
#pragma unroll
                for (int e = 0; e < 8; ++e) { g2[e] = g1[e] = v2[e] = v1[e] = 0.f; }
                if (ts >= 2) {
                    const u32x4 a2 = *(const u32x4*)(up + (size_t)(ts - 2 - rowbase) * NUP + ucol), b2 = *(const u32x4*)(up + (size_t)(ts - 2 - rowbase) * NUP + ucol + 128);
                    const u32x4 a1 = *(const u32x4*)(up + (size_t)(ts - 1 - rowbase) * NUP + ucol), b1 = *(const u32x4*)(up + (size_t)(ts - 1 - rowbase) * NUP + ucol + 128);
                    g2[0] = bf_lo(a2.x); g2[1] = bf_hi(a2.x); g2[2] = bf_lo(a2.y); g2[3] = bf_hi(a2.y); g2[4] = bf_lo(a2.z); g2[5] = bf_hi(a2.z); g2[6] = bf_lo(a2.w); g2[7] = bf_hi(a2.w);
                    v2[0] = bf_lo(b2.x); v2[1] = bf_hi(b2.x); v2[2] = bf_lo(b2.y); v2[3] = bf_hi(b2.y); v2[4] = bf_lo(b2.z); v2[5] = bf_hi(b2.z); v2[6] = bf_lo(b2.w); v2[7] = bf_hi(b2.w);
                    g1[0] = bf_lo(a1.x); g1[1] = bf_hi(a1.x); g1[2] = bf_lo(a1.y); g1[3] = bf_hi(a1.y); g1[4] = bf_lo(a1.z); g1[5] = bf_hi(a1.z); g1[6] = bf_lo(a1.w); g1[7] = bf_hi(a1.w);
                    v1[0] = bf_lo(b1.x); v1[1] = bf_hi(b1.x); v1[2] = bf_lo(b1.y); v1[3] = bf_hi(b1.y); v1[4] = bf_lo(b1.z); v1[5] = bf_hi(b1.z); v1[6] = bf_lo(b1.w); v1[7] = bf_hi(b1.w);
                }
                for (int s = 0; s < 32; ++s) {
                    const int tt = ts + s;
                    const u32x4 a0 = *(const u32x4*)(up + (size_t)(tt - rowbase) * NUP + ucol), b0 = *(const u32x4*)(up + (size_t)(tt - rowbase) * NUP + ucol + 128);
                    float gc[8], vc[8];
                    gc[0] = bf_lo(a0.x); gc[1] = bf_hi(a0.x); gc[2] = bf_lo(a0.y); gc[3] = bf_hi(a0.y); gc[4] = bf_lo(a0.z); gc[5] = bf_hi(a0.z); gc[6] = bf_lo(a0.w); gc[7] = bf_hi(a0.w);
                    vc[0] = bf_lo(b0.x); vc[1] = bf_hi(b0.x); vc[2] = bf_lo(b0.y); vc[3] = bf_hi(b0.y); vc[4] = bf_lo(b0.z); vc[5] = bf_hi(b0.z); vc[6] = bf_lo(b0.w); vc[7] = bf_hi(b0.w);
                    float o[8];
#pragma unroll
                    for (int e = 0; e < 8; ++e) { const float gg = bg[e] + wg[0][e] * g2[e] + wg[1][e] * g1[e] + wg[2][e] * gc[e]; const float vv = bv[e] + wv[0][e] * v2[e] + wv[1][e] * v1[e] + wv[2][e] * vc[e];
                        o[e] = gg * sigmoidf_(gg) * vv; g2[e] = g1[e]; g1[e] = gc[e]; v2[e] = v1[e]; v1[e] = vc[e]; }
                    u32x4 w; w.x = cvt_pk_bf16(o[0], o[1]); w.y = cvt_pk_bf16(o[2], o[3]); w.z = cvt_pk_bf16(o[4], o[5]); w.w = cvt_pk_bf16(o[6], o[7]);
                    *(u32x4*)(act + (size_t)tt * DFF + c0) = w;
                }
            }
        }
        GSYNC();
    STAMP(10);
    }

    {
        pg8::Gemm g{DFF, (unsigned)(DFF * 2), 128u, (unsigned)(DFF) * 2u};
        SchedMN S{64, 4, 1, G, bid, 0, (const char*)(ws + WS_ACT), nullptr, (const char*)(ws + WS_WDOWN), nullptr, (size_t)256 * DFF * 2, (size_t)256 * DFF * 2};
        EpiRes E{a.out, a.out, nullptr, (float*)(ws + WS_RSS3)};
        pg8::gemm_phase<EpiRes, SchedMN, true, true>(lds, g, S, E);
    }
    GSYNC();
    STAMP(11);

    {
        const float* gf = a.in[27];
        for (int r = gw; r < SEQ; r += NGW) {
            const float rs = rsqrtf(((const float*)(ws + WS_RSS3))[r] * (1.f / DM) + EPS);
            f32x4* xr = (f32x4*)(a.out + (size_t)r * DM) + lane; const f32x4* gr = (const f32x4*)gf + lane;
#pragma unroll
            for (int j = 0; j < 4; ++j) xr[64 * j] = xr[64 * j] * rs * gr[64 * j];
        }
    }
    if ((TSK) >= 0 && blockIdx.x == 0 && threadIdx.x == 0) {
        const unsigned long long tend = __builtin_amdgcn_s_memrealtime(); const unsigned long long* ts = (const unsigned long long*)(a.ws + 240 * 1024);
        const unsigned long long t1 = ((TSK) + 1 > 11) ? tend : ts[(TSK) + 1 > 11 ? 0 : (TSK) + 1];
        asm volatile("s_waitcnt vmcnt(0)" ::: "memory");
        a.out[0] = ((TSK) >= 20) ? (float)((const unsigned long long*)(a.ws + 244 * 1024))[(TSK) >= 20 ? (TSK) - 20 : 0] * ((TSK) == 25 ? 1.0f : 0.01f) : (float)(t1 - ts[(TSK) > 11 ? 11 : (TSK)]) * 0.01f;
    }
}

extern "C" void kernel_launch(void* const* d_in, const int* in_sizes, int n_in, void* d_out, int out_size, void* d_ws, size_t ws_size, hipStream_t stream) {
    static int grid = 0;
    if (grid == 0) {
        int dev = 0, cus = 0, per_cu = 0;
        (void)hipGetDevice(&dev); (void)hipDeviceGetAttribute(&cus, hipDeviceAttributeMultiprocessorCount, dev);
        (void)hipFuncSetAttribute((const void*)fwd_mega, hipFuncAttributeMaxDynamicSharedMemorySize, LDS_BYTES);
        (void)hipOccupancyMaxActiveBlocksPerMultiprocessor(&per_cu, (const void*)fwd_mega, NT, LDS_BYTES);
        if (per_cu < 1) { fprintf(stderr, "kernel_launch: occupancy query says %d blocks per CU\n", per_cu); per_cu = 1; }
        grid = cus;
        if (n_in != 28 || ws_size < 252 * MiB) fprintf(stderr, "kernel_launch: unexpected n_in %d / ws_size %zu\n", n_in, ws_size);
    }
    Args a{};
    for (int i = 0; i < 28; ++i) a.in[i] = (const float*)d_in[i];
    a.out = (float*)d_out; a.ws = (unsigned char*)d_ws;
    void* kargs[] = {&a};
    hipError_t e = hipLaunchCooperativeKernel((const void*)fwd_mega, dim3(grid), dim3(NT), kargs, LDS_BYTES, stream);
    if (e != hipSuccess) fprintf(stderr, "cooperative launch failed: %s (grid %d)\n", hipGetErrorString(e), grid);
}
```

```cpp
#include <hip/hip_runtime.h>
#include <hip/hip_cooperative_groups.h>
#include <cstdio>
#include <cstdint>
namespace cg = cooperative_groups;
#ifndef PROBE_REP
#define PROBE_REP -1
#endif
#ifndef EXPV
#define EXPV 0
#endif
#ifndef TSK
#define TSK -1
#endif
#define STAMP(i) do { if ((TSK) >= 0 && blockIdx.x == 0 && threadIdx.x == 0) ((unsigned long long*)(a.ws + 240 * 1024))[i] = __builtin_amdgcn_s_memrealtime(); } while (0)
#define ASTAMP(k) do { if ((TSK) >= 20 && blockIdx.x == 0 && threadIdx.x == 0) { const unsigned long long t_ = __builtin_amdgcn_s_memrealtime(); T.tsa[k] += t_ - T.tsa[15]; T.tsa[15] = t_; } } while (0)
#define REPS(k) _Pragma("nounroll") for (int rep_ = 0; rep_ < ((PROBE_REP) == (k) ? 2 : 1); ++rep_)
#define GSYNC() do { xcd_barrier(xbar); if ((PROBE_REP) == 100) xcd_barrier(xbar); } while (0)

#define LAS __attribute__((address_space(3)))
typedef unsigned short bf16_t;
typedef short bf16x8 __attribute__((ext_vector_type(8)));
typedef float f32x4 __attribute__((ext_vector_type(4)));
typedef float f32x2 __attribute__((ext_vector_type(2)));
typedef unsigned u32x4 __attribute__((ext_vector_type(4)));
typedef unsigned u32x2 __attribute__((ext_vector_type(2)));

constexpr int SEQ = 16384, DM = 1024, DIN = 3864, PP = 4096  , DFF = 2816, NUP = 5632;
constexpr int C_Q = 0, C_KC = 512, C_VC = 640, C_KSL = 768, C_VSL = 896, C_KWN = 1024, C_VWN = 1152, C_U = 1280, C_GA = 1792, C_GB = 2816, C_NG = 3840;
constexpr int VTP = SEQ + 64;
constexpr float EPS = 1e-6f;
constexpr float NEGF = -1e30f;

constexpr size_t MiB = 1u << 20;
constexpr size_t WS_RSTD1 = 0, WS_RSS2 = 64 * 1024, WS_RSS3 = 128 * 1024, WS_ROPEC = 256 * 1024, WS_ROPES = 768 * 1024;
constexpr size_t WS_ABAR = 1280 * 1024, WS_A128 = WS_ABAR + 16384, WS_BIASPE = WS_A128 + 16384, WS_BBAR = 1536 * 1024  ;
constexpr size_t WS_SBUF = 2 * MiB  , WS_HID = 4 * MiB  , WS_KCMP = 6 * MiB  , WS_VCMPT = 6 * MiB + 512 * 1024  ;
constexpr size_t WS_WUP = 8 * MiB, WS_WDOWN = 20 * MiB, WS_WIN = 26 * MiB, WS_WGLU = 34 * MiB, WS_WPA = 35 * MiB, WS_WPB = 36 * MiB, WS_WOUT = 37 * MiB, WS_W1K = 39 * MiB, WS_W1V = 40 * MiB;
constexpr size_t WS_XB = 41 * MiB, WS_MERGED = 41 * MiB, WS_PROJ = 73 * MiB, WS_VSLT = 202 * MiB + 512 * 1024, WS_VWNT = 207 * MiB;
constexpr size_t WS_X1B = 220 * MiB, WS_UPRAW = 26 * MiB, WS_ACT = 122 * MiB;
constexpr size_t WS_VMAX = 232 * 1024, WS_BAR = 192 * 1024, WS_KSL = 212 * MiB, WS_KWN = 216 * MiB;
constexpr size_t OUT_YA = 0, OUT_YBP = 16 * MiB, OUT_YB = 32 * MiB;
static_assert(WS_PROJ + (size_t)(SEQ + 32) * PP * 2 <= WS_VSLT, "proj");
static_assert(WS_VSLT + (size_t)128 * VTP * 2 + 4096 <= WS_VWNT && WS_VWNT + (size_t)128 * VTP * 2 + 4096 <= WS_X1B, "vt");
static_assert(WS_UPRAW + (size_t)33 * 256 * NUP * 2 <= WS_ACT && WS_ACT + (size_t)SEQ * DFF * 2 <= WS_X1B, "ffn");

__device__ __forceinline__ unsigned cvt_pk_bf16(float lo, float hi) { unsigned r; asm volatile("v_cvt_pk_bf16_f32 %0, %1, %2" : "=v"(r) : "v"(lo), "v"(hi)); return r; }
__device__ __forceinline__ float bf_lo(unsigned w) { return __uint_as_float(w << 16); }
__device__ __forceinline__ float bf_hi(unsigned w) { return __uint_as_float(w & 0xffff0000u); }
__device__ __forceinline__ float bf2f(bf16_t b) { return __uint_as_float((unsigned)b << 16); }
__device__ __forceinline__ float sigmoidf_(float v) { return 1.f / (1.f + __expf(-v)); }
__device__ __forceinline__ float gelu_tanh(float v) { const float z = 0.7978845608028654f * (v + 0.044715f * v * v * v); const float th = 1.f - 2.f / (__expf(2.f * z) + 1.f); return 0.5f * v * (1.f + th); }
__device__ __forceinline__ u32x4 pack8(f32x4 a, f32x4 b) { u32x4 w; w.x = cvt_pk_bf16(a[0], a[1]); w.y = cvt_pk_bf16(a[2], a[3]); w.z = cvt_pk_bf16(b[0], b[1]); w.w = cvt_pk_bf16(b[2], b[3]); return w; }

namespace pg8 {
#define PG8_LAS __attribute__((address_space(3)))
constexpr int BM = 256, BK = 64, HALF = 128, HTB = HALF * BK * 2, STAGE_BYTES = 8 * HTB, NXCD = 8, WGM = 8;
__host__ __device__ __forceinline__ int lds_byte(int r, int c) { const int st = (r >> 4) * 2 + (c >> 5), rr = r & 15, cc = c & 31, ob = rr * 64 + cc * 2; return st * 1024 + (ob ^ (((ob >> 9) & 1) << 5)); }
__host__ __device__ __forceinline__ void stage_rc(int b, int& R, int& C) { const int st = b / 1024, sb = b % 1024, swz = sb ^ (((sb >> 9) & 1) << 5); R = (st >> 1) * 16 + swz / 64; C = (st & 1) * 32 + (swz % 64) / 2; }
__host__ __device__ __forceinline__ int perm32(int rho) { const int n = rho >> 4, i = rho & 15; return 8 * (i >> 2) + 4 * n + (i & 3); }
struct Unit { int pm, pn, z; const char* A; const char* B; };
struct Gemm { int K; unsigned lda_b; unsigned kstepA; unsigned ldb_b; };
__device__ __forceinline__ bool tile_of(long L, int nM, int nN, int& pm, int& pn) {
    const int nwg = nM * nN; if (L >= nwg) return false;
    int wgid = (int)L; { const int q = nwg / NXCD, r = nwg % NXCD, xcd = wgid % NXCD, off = wgid / NXCD; wgid = (xcd < r ? xcd * (q + 1) : r * (q + 1) + (xcd - r) * q) + off; }
    const int nig = WGM * nN, gid = wgid / nig, fm = gid * WGM, gsz = (nM - fm) < WGM ? (nM - fm) : WGM;
    pm = fm + ((wgid % nig) % gsz); pn = (wgid % nig) / gsz; return true;
}
template <class Epi, class Sched, bool ALIGN_EPI = false, bool SP2 = false>
__device__ __forceinline__ void gemm_phase(PG8_LAS unsigned char* lds, const Gemm g, const Sched& S, const Epi& E) {
    int tid_ = threadIdx.x; asm volatile("" : "+v"(tid_));
    const int tid = tid_, wid = __builtin_amdgcn_readfirstlane(tid >> 6), lane = tid & 63, wr = wid >> 2, wc = wid & 3, fr = lane & 15, fq = lane >> 4;
    const int K = g.K, nt = K / BK;
    unsigned voffA[2], voffB[2];
#pragma unroll
    for (int i = 0; i < 2; ++i) { int R, C; stage_rc(tid * 16 + i * 8192, R, C); const int Rb = Epi::PERM ? ((R & ~31) + perm32(R & 31)) : R;
        voffA[i] = (unsigned)R * g.lda_b + (unsigned)C * 2u; voffB[i] = (unsigned)Rb * g.ldb_b + (unsigned)C * 2u; }
    const size_t kstepA = (size_t)g.kstepA, kstepB = (size_t)(BK * 2);
    const size_t hstepA = (size_t)HALF * g.lda_b, hstepB = (size_t)HALF * g.ldb_b;
    const unsigned ldsw = (unsigned)wid * 1024u;
    const int aoff = lds_byte(wr * 64 + fr, fq * 8), boff = lds_byte(wc * 32 + fr, fq * 8);
#define PG8_SA(b, h) (((b) * 2 + (h)) * HTB)
#define PG8_SB(b, h) ((4 + (b) * 2 + (h)) * HTB)
#define PG8_STAGE(bufoff, gbase, voff) do { _Pragma("unroll") for (int _i = 0; _i < 2; ++_i) \
        __builtin_amdgcn_global_load_lds((const unsigned*)((const char*)(gbase) + (voff)[_i]), (PG8_LAS unsigned*)(lds + (bufoff) + ldsw + _i * 8192), 16, 0, 0); } while (0)
#define PG8_LDA(dst, b, h) do { _Pragma("unroll") for (int m = 0; m < 4; ++m) _Pragma("unroll") for (int k = 0; k < 2; ++k) dst[m][k] = *(const PG8_LAS bf16x8*)(lds + PG8_SA(b, h) + aoff + m * 2048 + k * 1024); } while (0)
#define PG8_LDB(dst, b, h) do { _Pragma("unroll") for (int n = 0; n < 2; ++n) _Pragma("unroll") for (int k = 0; k < 2; ++k) dst[n][k] = *(const PG8_LAS bf16x8*)(lds + PG8_SB(b, h) + boff + n * 2048 + k * 1024); } while (0)
#define PG8_MMA(ai, bj, At, Bt) do { __builtin_amdgcn_s_setprio(1); _Pragma("unroll") for (int m = 0; m < 4; ++m) _Pragma("unroll") for (int n = 0; n < 2; ++n) _Pragma("unroll") for (int k = 0; k < 2; ++k) \
        acc[ai][bj][m][n] = __builtin_amdgcn_mfma_f32_16x16x32_bf16(Bt[n][k], At[m][k], acc[ai][bj][m][n], 0, 0, 0); __builtin_amdgcn_s_setprio(0); } while (0)
#define PG8_WAIT_V(n) asm volatile("s_waitcnt vmcnt(" #n ")" ::: "memory")
#define PG8_WAIT_L(n) asm volatile("s_waitcnt lgkmcnt(" #n ")" ::: "memory")
#define PG8_BAR __builtin_amdgcn_s_barrier()
#define PG8_SCHED __builtin_amdgcn_sched_barrier(0)
    Unit cur, nxt; int ui = 0;
    if (!S.next(0, cur)) return;
    f32x4 acc[2][2][4][2];
#pragma unroll
    for (int a = 0; a < 2; ++a)
#pragma unroll
        for (int b = 0; b < 2; ++b)
#pragma unroll
            for (int m = 0; m < 4; ++m)
#pragma unroll
                for (int n = 0; n < 2; ++n) acc[a][b][m][n] = (f32x4){0.f, 0.f, 0.f, 0.f};
    bf16x8 At[4][2], B0[2][2], B1[2][2];
    const char* cA = cur.A; const char* cB = cur.B;
    if constexpr (SP2) {
        PG8_STAGE(PG8_SB(0, 0), cB, voffB); PG8_STAGE(PG8_SB(0, 1), cB + hstepB, voffB); PG8_STAGE(PG8_SA(0, 0), cA, voffA); PG8_STAGE(PG8_SA(0, 1), cA + hstepA, voffA);
        if (wr == 1) PG8_BAR;
        PG8_WAIT_V(2); PG8_BAR;
        PG8_STAGE(PG8_SB(1, 0), cB + kstepB, voffB); PG8_STAGE(PG8_SA(1, 0), cA + kstepA, voffA); PG8_STAGE(PG8_SB(1, 1), cB + hstepB + kstepB, voffB);
        PG8_WAIT_V(6); PG8_BAR;
    } else {
        PG8_STAGE(PG8_SB(0, 0), cB, voffB); PG8_STAGE(PG8_SA(0, 0), cA, voffA); PG8_STAGE(PG8_SB(0, 1), cB + hstepB, voffB); PG8_STAGE(PG8_SA(0, 1), cA + hstepA, voffA);
        if (wr == 1) PG8_BAR;
        PG8_WAIT_V(4); PG8_BAR;
        PG8_STAGE(PG8_SB(1, 0), cB + kstepB, voffB); PG8_STAGE(PG8_SA(1, 0), cA + kstepA, voffA); PG8_STAGE(PG8_SB(1, 1), cB + hstepB + kstepB, voffB);
        PG8_WAIT_V(6); PG8_BAR;
    }
    for (;;) {
        const bool has_next = S.next(ui + 1, nxt);
        const char* nA = has_next ? nxt.A : cA; const char* nB = has_next ? nxt.B : cB;
        for (int t = 0; t < nt; t += 2) {
            const bool last = (t == nt - 2);
            const char* a1 = cA + (size_t)(t + 1) * kstepA;
            const char* a2 = last ? nA : cA + (size_t)(t + 2) * kstepA; const char* b2 = last ? nB : cB + (size_t)(t + 2) * kstepB;
            const char* a3 = a2 + kstepA; const char* b3 = b2 + kstepB;
            if constexpr (SP2) {
            PG8_LDB(B0, 0, 0); PG8_LDB(B1, 0, 1); PG8_SCHED; PG8_LDA(At, 0, 0); PG8_STAGE(PG8_SA(1, 1), a1 + hstepA, voffA);
            PG8_WAIT_V(8); PG8_WAIT_L(0); PG8_BAR; PG8_MMA(0, 0, At, B0); PG8_MMA(0, 1, At, B1); PG8_BAR; PG8_SCHED;
            PG8_LDA(At, 0, 1); PG8_STAGE(PG8_SB(0, 0), b2, voffB); PG8_STAGE(PG8_SB(0, 1), b2 + hstepB, voffB); PG8_STAGE(PG8_SA(0, 0), a2, voffA);
            PG8_WAIT_V(8); PG8_WAIT_L(0); PG8_BAR; PG8_MMA(1, 0, At, B0); PG8_MMA(1, 1, At, B1); PG8_BAR; PG8_SCHED;
            PG8_LDB(B0, 1, 0); PG8_LDB(B1, 1, 1); PG8_SCHED; PG8_LDA(At, 1, 0); PG8_STAGE(PG8_SA(0, 1), a2 + hstepA, voffA);
            PG8_WAIT_V(8); PG8_WAIT_L(0); PG8_BAR; PG8_MMA(0, 0, At, B0); PG8_MMA(0, 1, At, B1); PG8_BAR; PG8_SCHED;
            PG8_LDA(At, 1, 1); PG8_STAGE(PG8_SB(1, 0), b3, voffB); PG8_STAGE(PG8_SB(1, 1), b3 + hstepB, voffB); PG8_STAGE(PG8_SA(1, 0), a3, voffA);
            PG8_WAIT_V(8); PG8_WAIT_L(0); PG8_BAR; PG8_MMA(1, 0, At, B0); PG8_MMA(1, 1, At, B1); PG8_BAR; PG8_SCHED;
            } else {
            PG8_LDB(B0, 0, 0); PG8_SCHED; PG8_LDA(At, 0, 0); PG8_STAGE(PG8_SA(1, 1), a1 + hstepA, voffA);
            PG8_WAIT_L(8); PG8_BAR; PG8_WAIT_L(0); PG8_MMA(0, 0, At, B0); PG8_BAR; PG8_SCHED;
            PG8_LDB(B1, 0, 1); PG8_STAGE(PG8_SB(0, 0), b2, voffB);
            PG8_BAR; PG8_WAIT_L(0); PG8_MMA(0, 1, At, B1); PG8_BAR;
            PG8_LDA(At, 0, 1); PG8_STAGE(PG8_SA(0, 0), a2, voffA);
            PG8_BAR; PG8_WAIT_L(0); PG8_MMA(1, 0, At, B0); PG8_BAR; PG8_SCHED;
            PG8_STAGE(PG8_SB(0, 1), b2 + hstepB, voffB);
            PG8_WAIT_V(6); PG8_BAR; PG8_MMA(1, 1, At, B1); PG8_BAR;
            PG8_LDB(B0, 1, 0); PG8_SCHED; PG8_LDA(At, 1, 0); PG8_STAGE(PG8_SA(0, 1), a2 + hstepA, voffA);
            PG8_WAIT_L(8); PG8_BAR; PG8_WAIT_L(0); PG8_MMA(0, 0, At, B0); PG8_BAR; PG8_SCHED;
            PG8_LDB(B1, 1, 1); PG8_STAGE(PG8_SB(1, 0), b3, voffB);
            PG8_BAR; PG8_WAIT_L(0); PG8_MMA(0, 1, At, B1); PG8_BAR;
            PG8_LDA(At, 1, 1); PG8_STAGE(PG8_SA(1, 0), a3, voffA);
            PG8_BAR; PG8_WAIT_L(0); PG8_MMA(1, 0, At, B0); PG8_BAR; PG8_SCHED;
            PG8_STAGE(PG8_SB(1, 1), b3 + hstepB, voffB);
            PG8_WAIT_V(6); PG8_BAR; PG8_MMA(1, 1, At, B1); PG8_BAR;
            }
        }
        if constexpr (ALIGN_EPI) { if (wr == 0) PG8_BAR; }
        E(acc, cur, wr, wc, fr, fq);
        if (!has_next) break;
#pragma unroll
        for (int a = 0; a < 2; ++a)
#pragma unroll
            for (int b = 0; b < 2; ++b)
#pragma unroll
                for (int m = 0; m < 4; ++m)
#pragma unroll
                    for (int n = 0; n < 2; ++n) acc[a][b][m][n] = (f32x4){0.f, 0.f, 0.f, 0.f};
        cur = nxt; cA = nA; cB = nB; ++ui;
        if constexpr (ALIGN_EPI) { if (wr == 1) PG8_BAR; }
    }
    PG8_WAIT_V(0);
    if constexpr (!ALIGN_EPI) { if (wr == 0) PG8_BAR; }
    PG8_BAR;
#undef PG8_SA
#undef PG8_SB
#undef PG8_STAGE
#undef PG8_LDA
#undef PG8_LDB
#undef PG8_MMA
#undef PG8_WAIT_V
#undef PG8_WAIT_L
#undef PG8_BAR
#undef PG8_SCHED
}
}


struct SchedMN {
    int nM, nN, nz, G, c, pm_off; const char* A0; const char* A1; const char* B0; const char* B1; size_t a_tile, b_tile;
    __device__ __forceinline__ bool next(int i, pg8::Unit& u) const {
        int pm, pn; if (!pg8::tile_of((long)(i / nz) * G + c, nM, nN, pm, pn)) return false;
        u.z = i % nz; u.pm = pm + pm_off; u.pn = pn; u.A = (u.z ? A1 : A0) + (size_t)u.pm * a_tile; u.B = (u.z ? B1 : B0) + (size_t)pn * b_tile; return true;
    }
};
struct SchedCmp {
    int c; const char* proj; const char* w1k; const char* w1v;
    __device__ __forceinline__ bool next(int i, pg8::Unit& u) const {
        if (i > 0 || c >= 64) return false;
        const int ks = c & 3; u.pm = (c >> 2) & 3; u.z = c >> 4; u.pn = ks; const int which = u.z >> 1, kh = u.z & 1;
        u.A = proj + ((size_t)(16 * 256 * u.pm + 8 * ks) * PP + (which ? C_VC : C_KC) + kh * 64) * 2; u.B = (which ? w1v : w1k) + (size_t)ks * 512 * 2; return true;
    }
};

#define EPI_LOOP_ROWS for (int ai = 0; ai < 2; ++ai) _Pragma("unroll") for (int m = 0; m < 4; ++m)

struct EpiProj {
    static constexpr bool PERM = true;
    bf16_t* proj; bf16_t* vslt; bf16_t* vwnt; bf16_t* kslc; bf16_t* kwnc; const float* rstd; const float* ropec; const float* ropes;
    __device__ __forceinline__ void operator()(const f32x4 (&acc)[2][2][4][2], const pg8::Unit& u, int wr, int wc, int fr, int fq) const {
        const int pn = u.pn; const int row0 = u.pm * 256 + wr * 64 + fr;
        const bool sig = pn >= 7;
#pragma unroll
        EPI_LOOP_ROWS {
            const int row = row0 + ai * 128 + m * 16; const float rs = rstd[row];
            f32x4 c0 = {1.f, 1.f, 1.f, 1.f}, c1 = c0, s0 = {0.f, 0.f, 0.f, 0.f}, s1 = s0;
            if ((pn <= 1 || pn == 3 || pn == 4) && (wc & 1) == 0) { c0 = *(const f32x4*)(ropec + row * 8); c1 = *(const f32x4*)(ropec + row * 8 + 4); s0 = *(const f32x4*)(ropes + row * 8); s1 = *(const f32x4*)(ropes + row * 8 + 4); }
#pragma unroll
            for (int bj = 0; bj < 2; ++bj) {
                f32x4 v0 = acc[ai][bj][m][0] * rs, v1 = acc[ai][bj][m][1] * rs;
                const int colt = bj * 128 + wc * 32 + 8 * fq;
                const bool ropet = (pn <= 1) || ((pn == 3 || pn == 4) && bj == 0);
                if (ropet && (wc & 1) == 0) {
                    f32x4 p0, p1;
#pragma unroll
                    for (int e = 0; e < 4; ++e) { p0[e] = __shfl_xor(v0[e], 16); p1[e] = __shfl_xor(v1[e], 16); }
                    if (fq == 0) { v0 = v0 * c0 - p0 * s0; v1 = v1 * c1 - p1 * s1; }
                    else if (fq == 1) { v0 = v0 * c0 + p0 * s0; v1 = v1 * c1 + p1 * s1; }
                }
                if (pn <= 1) { v0 = v0 * (0.125f * 1.4426950408889634f); v1 = v1 * (0.125f * 1.4426950408889634f); }
                if (sig) {
#pragma unroll
                    for (int e = 0; e < 4; ++e) { v0[e] = sigmoidf_(v0[e]); v1[e] = sigmoidf_(v1[e]); }
                }
                const u32x4 w = pack8(v0, v1);
                if (!((pn == 3 || pn == 4))) *(u32x4*)(proj + (size_t)row * PP + pn * 256 + colt) = w;
                if ((pn == 3 || pn == 4) && bj == 0) { bf16_t* kc = (pn == 3) ? kslc : kwnc; *(u32x4*)(kc + ((size_t)(colt >> 6) * SEQ + row) * 64 + (colt & 63)) = w; }
                if ((pn == 3 || pn == 4) && bj == 1) {
                    bf16_t* vt = ((pn == 3) ? vslt : vwnt) + ((size_t)((colt - 128) >> 6) * 256 + (row >> 6)) * 4096 + (size_t)((colt - 128) & 63) * 64 + (row & 63);
                    vt[0 * 64] = (bf16_t)(w.x & 0xffff); vt[1 * 64] = (bf16_t)(w.x >> 16); vt[2 * 64] = (bf16_t)(w.y & 0xffff); vt[3 * 64] = (bf16_t)(w.y >> 16);
                    vt[4 * 64] = (bf16_t)(w.z & 0xffff); vt[5 * 64] = (bf16_t)(w.z >> 16); vt[6 * 64] = (bf16_t)(w.w & 0xffff); vt[7 * 64] = (bf16_t)(w.w >> 16);
                }
            }
        }
    }
};

struct EpiCmp {
    static constexpr bool PERM = true;
    float* hidp;
    __device__ __forceinline__ void operator()(const f32x4 (&acc)[2][2][4][2], const pg8::Unit& u, int wr, int wc, int fr, int fq) const {
        const int row0 = u.pm * 256 + wr * 64 + fr;
#pragma unroll
        for (int bj = 0; bj < 2; ++bj) {
            const int col = bj * 128 + wc * 32 + 8 * fq;
#pragma unroll
            EPI_LOOP_ROWS {
                const int row = row0 + ai * 128 + m * 16; float* d = hidp + (((size_t)u.pn * 4 + u.z) * 1024 + row) * 256 + col;
                *(f32x4*)d = acc[ai][bj][m][0]; *(f32x4*)(d + 4) = acc[ai][bj][m][1];
            }
        }
    }
};

struct EpiGlu {
    static constexpr bool PERM = true;
    const bf16_t* ybp; bf16_t* yb;
    __device__ __forceinline__ void operator()(const f32x4 (&acc)[2][2][4][2], const pg8::Unit& u, int wr, int wc, int fr, int fq) const {
        const int row0 = u.pm * 256 + wr * 64 + fr;
#pragma unroll
        EPI_LOOP_ROWS {
            const int row = row0 + ai * 128 + m * 16;
#pragma unroll
            for (int bj = 0; bj < 2; ++bj) {
                const size_t off = (size_t)row * 512 + u.pn * 256 + bj * 128 + wc * 32 + 8 * fq;
                const u32x4 y = *(const u32x4*)(ybp + off);
                f32x4 v0 = acc[ai][bj][m][0], v1 = acc[ai][bj][m][1];
                v0[0] = bf_lo(y.x) * sigmoidf_(v0[0]); v0[1] = bf_hi(y.x) * sigmoidf_(v0[1]); v0[2] = bf_lo(y.y) * sigmoidf_(v0[2]); v0[3] = bf_hi(y.y) * sigmoidf_(v0[3]);
                v1[0] = bf_lo(y.z) * sigmoidf_(v1[0]); v1[1] = bf_hi(y.z) * sigmoidf_(v1[1]); v1[2] = bf_lo(y.w) * sigmoidf_(v1[2]); v1[3] = bf_hi(y.w) * sigmoidf_(v1[3]);
                *(u32x4*)(yb + off) = pack8(v0, v1);
            }
        }
    }
};

struct EpiMerge {
    static constexpr bool PERM = true;
    const bf16_t* proj; bf16_t* merged;
    __device__ __forceinline__ void operator()(const f32x4 (&acc)[2][2][4][2], const pg8::Unit& u, int wr, int wc, int fr, int fq) const {
        const int row0 = u.pm * 256 + wr * 64 + fr; const int gcol = u.z ? C_GB : C_GA;
#pragma unroll
        EPI_LOOP_ROWS {
            const int row = row0 + ai * 128 + m * 16;
#pragma unroll
            for (int bj = 0; bj < 2; ++bj) {
                const int col = u.pn * 256 + bj * 128 + wc * 32 + 8 * fq;
                const u32x4 gt = *(const u32x4*)(proj + (size_t)row * PP + gcol + col);
                f32x4 v0 = acc[ai][bj][m][0], v1 = acc[ai][bj][m][1];
                v0[0] *= bf_lo(gt.x); v0[1] *= bf_hi(gt.x); v0[2] *= bf_lo(gt.y); v0[3] *= bf_hi(gt.y);
                v1[0] *= bf_lo(gt.z); v1[1] *= bf_hi(gt.z); v1[2] *= bf_lo(gt.w); v1[3] *= bf_hi(gt.w);
                bf16_t* dst = merged + (size_t)row * DM + col;
                if (u.z) { const u32x4 o = *(const u32x4*)dst;
                    v0[0] += bf_lo(o.x); v0[1] += bf_hi(o.x); v0[2] += bf_lo(o.y); v0[3] += bf_hi(o.y); v1[0] += bf_lo(o.z); v1[1] += bf_hi(o.z); v1[2] += bf_lo(o.w); v1[3] += bf_hi(o.w); }
                *(u32x4*)dst = pack8(v0, v1);
            }
        }
    }
};

struct EpiRes {
    static constexpr bool PERM = true;
    const float* xin; float* xo; bf16_t* xb; float* rss;
    __device__ __forceinline__ void operator()(const f32x4 (&acc)[2][2][4][2], const pg8::Unit& u, int wr, int wc, int fr, int fq) const {
        const int row0 = u.pm * 256 + wr * 64 + fr;
#pragma unroll
        EPI_LOOP_ROWS {
            const int row = row0 + ai * 128 + m * 16; float ss = 0.f;
#pragma unroll
            for (int bj = 0; bj < 2; ++bj) {
                const size_t off = (size_t)row * DM + u.pn * 256 + bj * 128 + wc * 32 + 8 * fq;
                const f32x4 v0 = *(const f32x4*)(xin + off) + acc[ai][bj][m][0], v1 = *(const f32x4*)(xin + off + 4) + acc[ai][bj][m][1];
                *(f32x4*)(xo + off) = v0; *(f32x4*)(xo + off + 4) = v1;
                if (xb) *(u32x4*)(xb + off) = pack8(v0, v1);
                ss += (v0[0] * v0[0] + v0[1] * v0[1]) + (v0[2] * v0[2] + v0[3] * v0[3]) + (v1[0] * v1[0] + v1[1] * v1[1]) + (v1[2] * v1[2] + v1[3] * v1[3]);
            }
            ss += __shfl_xor(ss, 16); ss += __shfl_xor(ss, 32);
            if (fq == 0) atomicAdd(rss + row, ss);
        }
    }
};

struct EpiUp {
    static constexpr bool PERM = true;
    bf16_t* up; const float* rss; int rowbase;
    __device__ __forceinline__ void operator()(const f32x4 (&acc)[2][2][4][2], const pg8::Unit& u, int wr, int wc, int fr, int fq) const {
        const int row0 = u.pm * 256 + wr * 64 + fr;
#pragma unroll
        EPI_LOOP_ROWS {
            const int row = row0 + ai * 128 + m * 16; const float rs = rsqrtf(rss[row] * (1.f / DM) + EPS);
#pragma unroll
            for (int bj = 0; bj < 2; ++bj) {
                const size_t off = (size_t)(row - rowbase) * NUP + u.pn * 256 + bj * 128 + wc * 32 + 8 * fq;
                *(u32x4*)(up + off) = pack8(acc[ai][bj][m][0] * rs, acc[ai][bj][m][1] * rs);
            }
        }
    }
};

struct Args { const float* in[28]; float* out; unsigned char* ws; };
constexpr int NT = 512, NWV = 8;
constexpr int LDS_BYTES = 147456;

__device__ __forceinline__ float wave_sum(float v) {
#pragma unroll
    for (int o = 1; o < 64; o <<= 1) v += __shfl_xor(v, o);
    return v;
}

#define XB_TMO      128
#define XB_XCNT(j)  (256  + 64 * (j))
#define XB_XSUB(j)  (1280 + 64 * (j))
#define XB_XGEN(j)  (2304 + 64 * (j))
#define XB_TOP      3328
#define XB_TOPGEN   3392
#define XCD_BAR_WORDS 3456
#define XB_SPIN_CAP (1u << 18)

__device__ __forceinline__ unsigned xb_ld(unsigned* p)              { return __hip_atomic_load(p, __ATOMIC_RELAXED, __HIP_MEMORY_SCOPE_AGENT); }
__device__ __forceinline__ unsigned xb_add(unsigned* p, unsigned v) { return __hip_atomic_fetch_add(p, v, __ATOMIC_RELAXED, __HIP_MEMORY_SCOPE_AGENT); }
__device__ __forceinline__ unsigned xb_xcc_id() { return (unsigned)__builtin_amdgcn_s_getreg((3 << 11) | 20) & 0xFu; }
#define XB_SPIN(cond, bar) do { unsigned _sp = 0; while (cond) { __builtin_amdgcn_s_sleep(1); \
    if ((++_sp & 255u) == 0u) { if (xb_ld(&(bar)[XB_TMO])) break; if (_sp > XB_SPIN_CAP) { atomicAdd(&(bar)[XB_TMO], 1u); break; } } } } while (0)

struct XcdBarrier {
    unsigned* bar; unsigned x;
    volatile LAS unsigned* st;
};

__device__ __forceinline__ XcdBarrier xcd_barrier_post(unsigned* bar, volatile LAS unsigned* st) {
    XcdBarrier b; b.bar = bar; b.x = xb_xcc_id(); b.st = st;
    if (threadIdx.x == 0) (void)xb_add(&bar[XB_XCNT(b.x)], 1u);
    return b;
}
__device__ __forceinline__ void xcd_barrier_complete(unsigned* bar, unsigned x, unsigned& nloc, unsigned& nx) {
    const unsigned G = gridDim.x * gridDim.y * gridDim.z;
    unsigned sum, cnt, mine, sp = 0u;
    for (;;) {
        sum = 0u; cnt = 0u; mine = 0u;
#pragma unroll
        for (unsigned j = 0; j < 16; ++j) { const unsigned c = xb_ld(&bar[XB_XCNT(j)]); sum += c; cnt += (c > 0u) ? 1u : 0u; mine = (j == x) ? c : mine; }
        if (sum == G) break;
        __builtin_amdgcn_s_sleep(1);
        if ((++sp & 255u) == 0u) { if (xb_ld(&bar[XB_TMO])) break; if (sp > XB_SPIN_CAP) { atomicAdd(&bar[XB_TMO], 1u); break; } }
    }
    nloc = mine > 0u ? mine : 1u; nx = cnt > 0u ? cnt : 1u;
}

__device__ __forceinline__ void xcd_barrier(const XcdBarrier& b) {
    asm volatile("s_waitcnt vmcnt(0)" ::: "memory");
    __syncthreads();
    if (threadIdx.x == 0) {
        unsigned* bar = b.bar;
        __builtin_amdgcn_s_waitcnt(0);
        unsigned nloc = b.st[0], nx = b.st[1];
        if (nloc == 0u) { xcd_barrier_complete(bar, b.x, nloc, nx); b.st[0] = nloc; b.st[1] = nx; }
        const unsigned old = xb_add(&bar[XB_XSUB(b.x)], 1u);
        const unsigned gen = old / nloc;
        if (old + 1u == (gen + 1u) * nloc) {
            __builtin_amdgcn_fence(__ATOMIC_RELEASE, "agent");
            asm volatile("s_waitcnt vmcnt(0)" ::: "memory");
            const unsigned og = xb_add(&bar[XB_TOP], 1u);
            const unsigned tg = og / nx;
            if (og + 1u == (tg + 1u) * nx) xb_add(&bar[XB_TOPGEN], 1u);
            else XB_SPIN(xb_ld(&bar[XB_TOPGEN]) == tg, bar);
            __builtin_amdgcn_fence(__ATOMIC_ACQUIRE, "agent");
            xb_add(&bar[XB_XGEN(b.x)], 1u);
            asm volatile("s_waitcnt vmcnt(0)" ::: "memory");
        } else {
            XB_SPIN(xb_ld(&bar[XB_XGEN(b.x)]) == gen, bar);
            __builtin_amdgcn_fence(__ATOMIC_ACQUIRE, "agent");
            asm volatile("s_waitcnt vmcnt(0)" ::: "memory");
        }
    }
    __syncthreads();
}

__device__ __forceinline__ int colmap(int kind, int c) {
    if (kind == 1) return c < 1280 ? c : (c < 1304 ? C_NG + (c - 1280) : c - 24);
    if (kind == 2) { return c < DFF ? (c >> 7) * 256 + (c & 127) : ((c - DFF) >> 7) * 256 + 128 + ((c - DFF) & 127); }
    return c;
}
__device__ __forceinline__ void transpose_item(const float* W, int K, int N, bf16_t* WT, LAS float* scr, int kb, int nb, int lane, const float* kscale, int kind) {
    const int k0 = 64 * kb, n0 = 32 * nb;
#pragma unroll 8
    for (int i = 0; i < 32; ++i) { const int kk = 2 * i + (lane >> 5), n = n0 + (lane & 31); float v = (n < N) ? W[(size_t)(k0 + kk) * N + n] : 0.f; if (kscale) v *= kscale[k0 + kk]; scr[kk * 33 + (lane & 31)] = v; }
    asm volatile("s_waitcnt lgkmcnt(0)" ::: "memory");
    const int c = lane & 7;
#pragma unroll
    for (int j = 0; j < 4; ++j) { const int n = (lane >> 3) + 8 * j; const LAS float* s = scr + (8 * c) * 33 + n;
        if (n0 + n < N) { u32x4 o; o.x = cvt_pk_bf16(s[0 * 33], s[1 * 33]); o.y = cvt_pk_bf16(s[2 * 33], s[3 * 33]); o.z = cvt_pk_bf16(s[4 * 33], s[5 * 33]); o.w = cvt_pk_bf16(s[6 * 33], s[7 * 33]);
            *(u32x4*)(WT + (size_t)colmap(kind, n0 + n) * K + k0 + 8 * c) = o; } }
    asm volatile("s_waitcnt lgkmcnt(0)" ::: "memory");
}

#define EXP2(x) __builtin_amdgcn_exp2f(x)
#define MFMA16(a, b, c) __builtin_amdgcn_mfma_f32_16x16x32_bf16((a), (b), (c), 0, 0, 0)
__device__ __forceinline__ float dpp_x1(float v) { return __int_as_float(__builtin_amdgcn_update_dpp(0, __float_as_int(v), 0xB1, 0xF, 0xF, true)); }
__device__ __forceinline__ float dpp_x2(float v) { return __int_as_float(__builtin_amdgcn_update_dpp(0, __float_as_int(v), 0x4E, 0xF, 0xF, true)); }
struct KOp { bf16x8 a00, a01, a10, a11; };
struct VOp { bf16x8 v0, v1, v2, v3; };
__device__ __forceinline__ KOp ldk(const bf16_t* Kb, size_t pitch, int kb, int lane) {
    const int i = lane & 15, q = lane >> 4;
    const bf16_t* r0 = Kb + (size_t)(kb + 8 * (i >> 2) + (i & 3)) * pitch + 8 * q; const bf16_t* r1 = r0 + 4 * pitch;
    KOp k; k.a00 = *(const bf16x8*)r0; k.a01 = *(const bf16x8*)(r0 + 32); k.a10 = *(const bf16x8*)r1; k.a11 = *(const bf16x8*)(r1 + 32); return k;
}
__device__ __forceinline__ VOp ldv(const bf16_t* Vt, size_t vpitch, int kb, int lane) {
    const int i = lane & 15, q = lane >> 4; const size_t base = (vpitch == 64) ? (size_t)(kb >> 6) * 4096 + (kb & 63) : (size_t)kb;
    const bf16_t* r = Vt + base + (size_t)i * vpitch + 8 * q;
    VOp v; v.v0 = *(const bf16x8*)r; v.v1 = *(const bf16x8*)(r + 16 * vpitch); v.v2 = *(const bf16x8*)(r + 32 * vpitch); v.v3 = *(const bf16x8*)(r + 48 * vpitch); return v;
}
__device__ __forceinline__ void qk32(const KOp& k, const bf16x8& Bq0, const bf16x8& Bq1, f32x4& S0, f32x4& S1) {
    const f32x4 z = {0.f, 0.f, 0.f, 0.f};
    S0 = MFMA16(k.a00, Bq0, z); S0 = MFMA16(k.a01, Bq1, S0); S1 = MFMA16(k.a10, Bq0, z); S1 = MFMA16(k.a11, Bq1, S1);
}
__device__ __forceinline__ void pv32(const VOp& v, const bf16x8& P, f32x4 (&O)[4]) {
    O[0] = MFMA16(v.v0, P, O[0]); O[1] = MFMA16(v.v1, P, O[1]); O[2] = MFMA16(v.v2, P, O[2]); O[3] = MFMA16(v.v3, P, O[3]);
}
__device__ __forceinline__ bf16x8 packP(const f32x4& p0, const f32x4& p1) { u32x4 w = pack8(p0, p1); return __builtin_bit_cast(bf16x8, w); }

struct KbLin { int base; __device__ __forceinline__ int operator()(int i) const { return base + 32 * i; } };
struct KbLds { const LAS int* l; __device__ __forceinline__ int operator()(int i) const { return l[i]; } };

template <bool NEEDV, class KB, class Body>
__device__ __forceinline__ void pipe3(int n, const KB kbf, Body& body, const bf16_t* Kb, size_t kp, const bf16_t* Vt, size_t vp, int lane) {
    if (n <= 0) return;
    KOp k0, k1; VOp v;
    k0 = ldk(Kb, kp, kbf(0), lane);
    for (int i = 0; i < n; i += 2) {
        { const int kb = kbf(i); if (NEEDV) v = ldv(Vt, vp, kb, lane); k1 = ldk(Kb, kp, kbf(i + 1 < n ? i + 1 : n - 1), lane); body.run(kb, k0, v); }
        if (i + 1 >= n) break;
        { const int kb = kbf(i + 1); if (NEEDV) v = ldv(Vt, vp, kb, lane); k0 = ldk(Kb, kp, kbf(i + 2 < n ? i + 2 : n - 1), lane); body.run(kb, k1, v); }
    }
}

constexpr int AL_CKV = 81920  , CKV_HALF = 9216, CKV_BUF = 18432;
template <bool NEEDV, class Body>
__device__ __forceinline__ void cmp_shared(int nsteps, Body& body, const bf16_t* Kc, const bf16_t* Vc, LAS unsigned char* buf, int tid, int lane) {
    const int nch = (nsteps + 1) >> 1; if (nch <= 0) return;
    const int srow = tid >> 3, spc = tid & 7, i = lane & 15, q = lane >> 4;
    u32x4 rk = *(const u32x4*)(Kc + (size_t)srow * 64 + spc * 8), rv = rk;
    if (NEEDV) rv = *(const u32x4*)(Vc + (size_t)srow * 1024 + spc * 8);
    *(LAS u32x4*)(buf + srow * 144 + spc * 16) = rk; if (NEEDV) *(LAS u32x4*)(buf + CKV_HALF + srow * 144 + spc * 16) = rv;
    __syncthreads();
    for (int ch = 0; ch < nch; ++ch) {
        const LAS unsigned char* cur = buf + (ch & 1) * CKV_BUF; LAS unsigned char* nxt = buf + ((ch + 1) & 1) * CKV_BUF;
        const bool more = ch + 1 < nch;
        if (more) { rk = *(const u32x4*)(Kc + (size_t)(64 * (ch + 1) + srow) * 64 + spc * 8); if (NEEDV) rv = *(const u32x4*)(Vc + (size_t)srow * 1024 + 64 * (ch + 1) + spc * 8); }
#pragma unroll
        for (int h = 0; h < 2; ++h) {
            const int st = 2 * ch + h;
            if (st < nsteps) {
                const LAS unsigned char* kr = cur + (32 * h + 8 * (i >> 2) + (i & 3)) * 144 + 16 * q;
                KOp k; k.a00 = *(const LAS bf16x8*)kr; k.a01 = *(const LAS bf16x8*)(kr + 64); k.a10 = *(const LAS bf16x8*)(kr + 4 * 144); k.a11 = *(const LAS bf16x8*)(kr + 4 * 144 + 64);
                VOp v; if (NEEDV) { const LAS unsigned char* vr = cur + CKV_HALF + i * 144 + (32 * h + 8 * q) * 2;
                    v.v0 = *(const LAS bf16x8*)vr; v.v1 = *(const LAS bf16x8*)(vr + 16 * 144); v.v2 = *(const LAS bf16x8*)(vr + 32 * 144); v.v3 = *(const LAS bf16x8*)(vr + 48 * 144); }
                else { v.v0 = k.a00; v.v1 = k.a00; v.v2 = k.a00; v.v3 = k.a00; }
                body.run(32 * st, k, v);
            }
        }
        if (more) { *(LAS u32x4*)(nxt + srow * 144 + spc * 16) = rk; if (NEEDV) *(LAS u32x4*)(nxt + CKV_HALF + srow * 144 + spc * 16) = rv; }
        __syncthreads();
    }
}

struct BodyCmp1 {
    bf16x8 Bq[2][2]; int nv[2], q; float ml[2], ll[2];
    __device__ __forceinline__ void run(int kb, const KOp& k, const VOp&) {
#pragma unroll
        for (int cg = 0; cg < 2; ++cg) {
            f32x4 S0, S1; qk32(k, Bq[cg][0], Bq[cg][1], S0, S1);
            const int k0 = kb + 8 * q; float mloc = NEGF;
#pragma unroll
            for (int e = 0; e < 4; ++e) { if (k0 + e >= nv[cg]) S0[e] = NEGF; if (k0 + 4 + e >= nv[cg]) S1[e] = NEGF; mloc = fmaxf(mloc, fmaxf(S0[e], S1[e])); }
            const float mn = fmaxf(ml[cg], mloc); float ps = 0.f;
#pragma unroll
            for (int e = 0; e < 4; ++e) { ps += (k0 + e < nv[cg]) ? EXP2(S0[e] - mn) : 0.f; ps += (k0 + 4 + e < nv[cg]) ? EXP2(S1[e] - mn) : 0.f; }
            ll[cg] = ll[cg] * EXP2(ml[cg] - mn) + ps; ml[cg] = mn;
        }
    }
};
struct BodyCmp2 {
    bf16x8 Bq[2][2]; int nv[2], q, g, lane_; float mc[2], inv[2], carry[2]; LAS float* ia[2]; f32x4 O[2][4];
    __device__ __forceinline__ void run(int kb, const KOp& k, const VOp& v) {
#pragma unroll
        for (int cg = 0; cg < 2; ++cg) {
            f32x4 S0, S1; qk32(k, Bq[cg][0], Bq[cg][1], S0, S1);
            const int k0 = kb + 8 * q; f32x4 p0, p1;
#pragma unroll
            for (int e = 0; e < 4; ++e) { p0[e] = (k0 + e < nv[cg]) ? EXP2(S0[e] - mc[cg]) * inv[cg] : 0.f; p1[e] = (k0 + 4 + e < nv[cg]) ? EXP2(S1[e] - mc[cg]) * inv[cg] : 0.f; }
            f32x4 s0 = p0, s1 = p1;
#pragma unroll
            for (int e = 0; e < 4; ++e) { s0[e] += dpp_x1(s0[e]); s0[e] += dpp_x2(s0[e]); s1[e] += dpp_x1(s1[e]); s1[e] += dpp_x2(s1[e]); }
            const float bout = 0.5f * s1[3]; const float recv = __shfl(bout, (lane_ + 48) & 63); const float bin = (q == 0) ? carry[cg] : recv; carry[cg] = recv;
            if (g == 0) { const int j = k0 >> 2; ia[cg][j] = ((s0[0] + s0[1]) + (s0[2] + 0.5f * s0[3])) + bin; ia[cg][j + 1] = 0.5f * s0[3] + ((s1[0] + s1[1]) + (s1[2] + 0.5f * s1[3])); }
            pv32(v, packP(p0, p1), O[cg]);
        }
    }
};
struct BodyWin {
    bf16x8 Bq[2][2]; int q, tt[2]; float m[2], l[2]; f32x4 O[2][4];
    __device__ __forceinline__ void run(int kb, const KOp& k, const VOp& v) {
#pragma unroll
        for (int cg = 0; cg < 2; ++cg) {
            f32x4 S0, S1; qk32(k, Bq[cg][0], Bq[cg][1], S0, S1);
            const int k0 = kb + 8 * q; unsigned vm = 0u;
#pragma unroll
            for (int e = 0; e < 8; ++e) { const bool ok = (k0 + e <= tt[cg]) && (tt[cg] - (k0 + e) < 512); vm |= ok ? (1u << e) : 0u; }
            float mloc = NEGF;
#pragma unroll
            for (int e = 0; e < 4; ++e) { if (!((vm >> e) & 1u)) S0[e] = NEGF; if (!((vm >> (4 + e)) & 1u)) S1[e] = NEGF; mloc = fmaxf(mloc, fmaxf(S0[e], S1[e])); }
            mloc = fmaxf(mloc, __shfl_xor(mloc, 16)); mloc = fmaxf(mloc, __shfl_xor(mloc, 32));
            const float mn = fmaxf(m[cg], mloc), alpha = EXP2(m[cg] - mn); m[cg] = mn;
            f32x4 p0, p1; float ps = 0.f;
#pragma unroll
            for (int e = 0; e < 4; ++e) { p0[e] = ((vm >> e) & 1u) ? EXP2(S0[e] - mn) : 0.f; p1[e] = ((vm >> (4 + e)) & 1u) ? EXP2(S1[e] - mn) : 0.f; ps += p0[e] + p1[e]; }
            l[cg] = l[cg] * alpha + ps;
#pragma unroll
            for (int dt = 0; dt < 4; ++dt) O[cg][dt] = O[cg][dt] * alpha;
            pv32(v, packP(p0, p1), O[cg]);
        }
    }
};

struct AttnT { float fxs; unsigned long long* tsa; const bf16_t* proj; const bf16_t* kslc; const bf16_t* kwnc; const bf16_t* kcmp; const bf16_t* vcmpT; const bf16_t* vslT; const bf16_t* vwnT; bf16_t* ya; };

constexpr int AL_IMP = 0  , AL_OS = 0  , AL_TM = 67584  , AL_CNT = 69632  ,
              AL_OFF = 70656  , AL_UNITS = 71744  , AL_MM = 77888  , AL_LS = 78912  ;
constexpr int AL_Q = 81920  , QROWB = 528;
constexpr int OSP = 33;
constexpr float FXB = 67108864.0f;
typedef short s16x2 __attribute__((ext_vector_type(2)));
__device__ __forceinline__ int f2ord(float f) { const int b = __float_as_int(f); return b >= 0 ? b : b ^ 0x7fffffff; }
__device__ __forceinline__ float ord2f(int b) { return __int_as_float(b >= 0 ? b : b ^ 0x7fffffff); }

__device__ __forceinline__ void attn_wave_part1(const AttnT& T, int kh, int tq8, int lane, LAS float* imp  , LAS unsigned* tm, int wave, LAS unsigned char* lds, int tid) {
    const int col = lane & 15, q = lane >> 4, tk = col >> 2, g = col & 3;
    const int t0 = tq8 * 8, h = kh * 4 + g;
    bf16x8 Bq[2][2]; float g0[2], g2[2]; int tcg[2];
#pragma unroll
    for (int cg = 0; cg < 2; ++cg) { tcg[cg] = t0 + 4 * cg + tk; const bf16_t* prow = T.proj + (size_t)tcg[cg] * PP;
        Bq[cg][0] = *(const bf16x8*)(prow + C_Q + h * 64 + 8 * q); Bq[cg][1] = *(const bf16x8*)(prow + C_Q + h * 64 + 32 + 8 * q);
        g0[cg] = bf2f(prow[C_NG + h * 3 + 0]); g2[cg] = bf2f(prow[C_NG + h * 3 + 2]); }
    for (int i = lane; i < 8 * 264; i += 64) imp[i] = 0.f;
    {
        const bf16_t* Kc = T.kcmp + (size_t)kh * 1024 * 64; const bf16_t* Vc = T.vcmpT + (size_t)kh * 64 * 1024;
        const int tmax = (t0 | 63), nvmax = tmax >= 31 ? ((tmax - 31) >> 4) + 1 : 0, nsteps = (nvmax + 31) >> 5;
        BodyCmp1 b1;
#pragma unroll
        for (int cg = 0; cg < 2; ++cg) { b1.Bq[cg][0] = Bq[cg][0]; b1.Bq[cg][1] = Bq[cg][1]; b1.nv[cg] = tcg[cg] >= 31 ? ((tcg[cg] - 31) >> 4) + 1 : 0; b1.ml[cg] = NEGF; b1.ll[cg] = 0.f; }
        b1.q = q;
        cmp_shared<false>(nsteps, b1, Kc, Vc, lds + AL_CKV, tid, lane);
        BodyCmp2 b2; b2.q = q; b2.g = g; b2.lane_ = lane; b2.carry[0] = 0.f; b2.carry[1] = 0.f;
#pragma unroll
        for (int cg = 0; cg < 2; ++cg) {
            float mc = fmaxf(b1.ml[cg], __shfl_xor(b1.ml[cg], 16)); mc = fmaxf(mc, __shfl_xor(mc, 32));
            float lc = b1.ll[cg] * EXP2(b1.ml[cg] - mc); lc += __shfl_xor(lc, 16); lc += __shfl_xor(lc, 32);
            b2.Bq[cg][0] = Bq[cg][0]; b2.Bq[cg][1] = Bq[cg][1]; b2.nv[cg] = b1.nv[cg]; b2.mc[cg] = mc; b2.inv[cg] = 1.f / fmaxf(lc, 1e-30f); b2.ia[cg] = imp + (4 * cg + tk) * 264;
#pragma unroll
            for (int dt = 0; dt < 4; ++dt) b2.O[cg][dt] = (f32x4){0.f, 0.f, 0.f, 0.f};
        }
        asm volatile("s_waitcnt lgkmcnt(0)" ::: "memory");
        cmp_shared<true>(nsteps, b2, Kc, Vc, lds + AL_CKV, tid, lane);
        if (q == 0 && g == 0 && nsteps > 0) { b2.ia[0][8 * nsteps] = b2.carry[0]; b2.ia[1][8 * nsteps] = b2.carry[1]; }
#pragma unroll
        for (int cg = 0; cg < 2; ++cg) { bf16_t* yrow = T.ya + (size_t)tcg[cg] * 512 + h * 64 + 4 * q;
#pragma unroll
            for (int dt = 0; dt < 4; ++dt) { const f32x4 o = b2.O[cg][dt] * g0[cg]; u32x2 w; w.x = cvt_pk_bf16(o[0], o[1]); w.y = cvt_pk_bf16(o[2], o[3]); *(u32x2*)(yrow + 16 * dt) = w; } }
    }
    asm volatile("s_waitcnt lgkmcnt(0)" ::: "memory");
    for (int tk2 = 0; tk2 < 8; ++tk2) {
        const int tt = t0 + tk2, cur = tt >> 6, nvalid = cur + 1, KSEL = nvalid < 16 ? nvalid : 16;
        int bits[4];
#pragma unroll
        for (int s = 0; s < 4; ++s) { const int j = s * 64 + lane; const float v = imp[tk2 * 264 + j];
            bits[s] = (j == 0 || j == cur) ? 0x7F000000 : (j < nvalid ? __float_as_int(v) : -1); }
        int prefix = 0;
        for (int bit = 30; bit >= 0; --bit) { const int Tt = prefix | (1 << bit); int cnt = 0;
#pragma unroll
            for (int s = 0; s < 4; ++s) cnt += __popcll(__ballot(bits[s] >= Tt));
            if (cnt >= KSEL) prefix = Tt; }
        unsigned long long sel[4]; int need = KSEL;
#pragma unroll
        for (int s = 0; s < 4; ++s) { sel[s] = __ballot(bits[s] > prefix); need -= __popcll(sel[s]); }
#pragma unroll
        for (int s = 0; s < 4; ++s) { unsigned long long me = __ballot(bits[s] == prefix);
            while (me != 0ull && need > 0) { const unsigned long long low = me & (0ull - me); sel[s] |= low; me ^= low; --need; } }
        const int tbi = wave * 8 + tk2; const unsigned tbit = 1u << (tbi & 31);
#pragma unroll
        for (int s = 0; s < 4; ++s) if ((sel[s] >> lane) & 1ull) __hip_atomic_fetch_or(tm + (s * 64 + lane) * 2 + (tbi >> 5), tbit, __ATOMIC_RELAXED, __HIP_MEMORY_SCOPE_WORKGROUP);
    }
    {
        const bf16_t* Kw = T.kwnc + (size_t)kh * SEQ * 64; const bf16_t* Vw = T.vwnT + (size_t)kh * 256 * 4096;
        const int klo = (t0 - 511 > 0 ? t0 - 511 : 0) & ~31; const int n = ((t0 + 7 - klo) >> 5) + 1;
        BodyWin bo; bo.q = q;
#pragma unroll
        for (int cg = 0; cg < 2; ++cg) { bo.Bq[cg][0] = Bq[cg][0]; bo.Bq[cg][1] = Bq[cg][1]; bo.tt[cg] = tcg[cg]; bo.m[cg] = NEGF; bo.l[cg] = 0.f;
#pragma unroll
            for (int dt = 0; dt < 4; ++dt) bo.O[cg][dt] = (f32x4){0.f, 0.f, 0.f, 0.f}; }
        pipe3<true>(n, KbLin{klo}, bo, Kw, 64, Vw, 64, lane);
#pragma unroll
        for (int cg = 0; cg < 2; ++cg) { float l = bo.l[cg]; l += __shfl_xor(l, 16); l += __shfl_xor(l, 32);
            const float sc = g2[cg] / fmaxf(l, 1e-30f); bf16_t* yrow = T.ya + (size_t)tcg[cg] * 512 + h * 64 + 4 * q;
#pragma unroll
            for (int dt = 0; dt < 4; ++dt) { const u32x2 y = *(const u32x2*)(yrow + 16 * dt); const f32x4 o = bo.O[cg][dt] * sc;
                u32x2 w; w.x = cvt_pk_bf16(bf_lo(y.x) + o[0], bf_hi(y.x) + o[1]); w.y = cvt_pk_bf16(bf_lo(y.y) + o[2], bf_hi(y.y) + o[3]); *(u32x2*)(yrow + 16 * dt) = w; } }
    }
    asm volatile("s_waitcnt lgkmcnt(0)" ::: "memory");
}

struct UnitPre { int j; unsigned tlo, thi; bf16x8 q00, q01, q10, q11; KOp ka, kb; VOp va, vb; };
template <int PASS>
__device__ __forceinline__ UnitPre unit_load(const LAS unsigned char* qlds, const bf16_t* Ks, const bf16_t* Vs, int kh, int tile, const LAS u32x4* units, int u, int lane) {
    const int col = lane & 15, q = lane >> 4, slot = col >> 2, g = col & 3;
    const u32x4 d = units[u]; UnitPre P; P.j = __builtin_amdgcn_readfirstlane((int)d.x); P.tlo = (unsigned)__builtin_amdgcn_readfirstlane((int)d.y); P.thi = (unsigned)__builtin_amdgcn_readfirstlane((int)d.z);
    const unsigned t0b = (P.tlo >> (8 * slot)) & 0xffu, t1b = (P.thi >> (8 * slot)) & 0xffu;
    const LAS unsigned char* qr0 = qlds + (t0b == 0xffu ? 0 : (int)t0b) * QROWB + g * 128 + 16 * q;
    const LAS unsigned char* qr1 = qlds + (t1b == 0xffu ? 0 : (int)t1b) * QROWB + g * 128 + 16 * q;
    P.q00 = *(const LAS bf16x8*)qr0; P.q01 = *(const LAS bf16x8*)(qr0 + 64); P.q10 = *(const LAS bf16x8*)qr1; P.q11 = *(const LAS bf16x8*)(qr1 + 64);
    P.ka = ldk(Ks, 64, 64 * P.j, lane); P.kb = ldk(Ks, 64, 64 * P.j + 32, lane);
    if (PASS == 1) { if ((EXPV) == 2) { P.va.v0 = P.ka.a00; P.va.v1 = P.ka.a01; P.va.v2 = P.ka.a10; P.va.v3 = P.ka.a11; P.vb = P.va; } else { P.va = ldv(Vs, 64, 64 * P.j, lane); P.vb = ldv(Vs, 64, 64 * P.j + 32, lane); } }
    return P;
}
template <int PASS>
__device__ __forceinline__ void unit_group(const UnitPre& P, const bf16x8& q0, const bf16x8& q1, unsigned toks, int tile, LAS unsigned char* lds, float fxs, int lane) {
    const int col = lane & 15, q = lane >> 4, slot = col >> 2, g = col & 3;
    const int ti = (int)((toks >> (8 * slot)) & 0xffu);
    f32x4 S0a, S1a, S0b, S1b; qk32(P.ka, q0, q1, S0a, S1a); qk32(P.kb, q0, q1, S0b, S1b);
    const bool valid = ti != 0xff; const int row = (valid ? ti : 0) * 4 + g;
    const int lim = (P.j == tile) ? (valid ? ti : -1) - 8 * q : (valid ? 1000 : -1);
    LAS int* mm = (LAS int*)(lds + AL_MM); LAS float* ls = (LAS float*)(lds + AL_LS);
    if (PASS == 0) {
        float mloc = NEGF;
#pragma unroll
        for (int e = 0; e < 4; ++e) { mloc = fmaxf(mloc, e <= lim ? S0a[e] : NEGF); mloc = fmaxf(mloc, e + 4 <= lim ? S1a[e] : NEGF); mloc = fmaxf(mloc, e + 32 <= lim ? S0b[e] : NEGF); mloc = fmaxf(mloc, e + 36 <= lim ? S1b[e] : NEGF); }
        if ((EXPV) != 4) { mloc = fmaxf(mloc, __shfl_xor(mloc, 16)); mloc = fmaxf(mloc, __shfl_xor(mloc, 32)); }
        if (q == 0 && valid && (EXPV) != 3) __hip_atomic_fetch_max(mm + row, f2ord(mloc), __ATOMIC_RELAXED, __HIP_MEMORY_SCOPE_WORKGROUP);
    } else {
        const float m = ord2f(mm[row]);
        f32x4 p0a, p1a, p0b, p1b; float ps = 0.f;
#pragma unroll
        for (int e = 0; e < 4; ++e) { p0a[e] = e <= lim ? EXP2(S0a[e] - m) : 0.f; p1a[e] = e + 4 <= lim ? EXP2(S1a[e] - m) : 0.f; p0b[e] = e + 32 <= lim ? EXP2(S0b[e] - m) : 0.f; p1b[e] = e + 36 <= lim ? EXP2(S1b[e] - m) : 0.f;
            ps += (p0a[e] + p1a[e]) + (p0b[e] + p1b[e]); }
        ps += __shfl_xor(ps, 16); ps += __shfl_xor(ps, 32);
        if (q == 0 && valid) __hip_atomic_fetch_add(ls + row, ps, __ATOMIC_RELAXED, __HIP_MEMORY_SCOPE_WORKGROUP);
        f32x4 O[4];
#pragma unroll
        for (int dt = 0; dt < 4; ++dt) O[dt] = (f32x4){0.f, 0.f, 0.f, 0.f};
        pv32(P.va, packP(p0a, p1a), O); pv32(P.vb, packP(p0b, p1b), O);
        if (valid) { LAS unsigned long long* orow = (LAS unsigned long long*)(lds + AL_OS) + row * OSP + 2 * q;
#pragma unroll
            for (int dt = 0; dt < 4; ++dt) {
                const unsigned a0 = (unsigned)((int)rintf(O[dt][0] * fxs) + (1 << 26)), a1 = (unsigned)((int)rintf(O[dt][1] * fxs) + (1 << 26)), a2 = (unsigned)((int)rintf(O[dt][2] * fxs) + (1 << 26)), a3 = (unsigned)((int)rintf(O[dt][3] * fxs) + (1 << 26));
                __hip_atomic_fetch_add(orow + 8 * dt, (unsigned long long)a0 | ((unsigned long long)a1 << 32), __ATOMIC_RELAXED, __HIP_MEMORY_SCOPE_WORKGROUP);
                __hip_atomic_fetch_add(orow + 8 * dt + 1, (unsigned long long)a2 | ((unsigned long long)a3 << 32), __ATOMIC_RELAXED, __HIP_MEMORY_SCOPE_WORKGROUP); } }
    }
}
template <int PASS>
__device__ __forceinline__ void unit_compute(const UnitPre& P, int tile, LAS unsigned char* lds, float fxs, int lane) {
    unit_group<PASS>(P, P.q00, P.q01, P.tlo, tile, lds, fxs, lane);
    if (P.thi != 0xffffffffu) unit_group<PASS>(P, P.q10, P.q11, P.thi, tile, lds, fxs, lane);
}
template <int PASS>
__device__ __forceinline__ void unit_pass(const AttnT& T, int kh, int tile, int n, LAS unsigned char* lds, int wave, int lane) {
    const bf16_t* Ks = T.kslc + (size_t)kh * SEQ * 64; const bf16_t* Vs = T.vslT + (size_t)kh * 256 * 4096;
    const LAS u32x4* units = (const LAS u32x4*)(lds + AL_UNITS);
    int u = wave; if (u >= n) return;
    UnitPre A = unit_load<PASS>(lds + AL_Q, Ks, Vs, kh, tile, units, u, lane), B = A;
    for (; u < n; u += 16) {
        const int u1 = u + 8; if (u1 < n) B = unit_load<PASS>(lds + AL_Q, Ks, Vs, kh, tile, units, u1, lane);
        unit_compute<PASS>(A, tile, lds, T.fxs, lane);
        if (u1 >= n) break;
        const int u2 = u + 16; if (u2 < n) A = unit_load<PASS>(lds + AL_Q, Ks, Vs, kh, tile, units, u2, lane);
        unit_compute<PASS>(B, tile, lds, T.fxs, lane);
    }
}

__device__ __forceinline__ void attn_tile(const AttnT& T, int kh, int tile, LAS unsigned char* lds, int tid, int wave, int lane) {
    LAS unsigned* tm = (LAS unsigned*)(lds + AL_TM);
    for (int i = tid; i < 512; i += NT) tm[i] = 0u;
    __syncthreads();
    if ((TSK) >= 20 && blockIdx.x == 0 && threadIdx.x == 0) T.tsa[15] = __builtin_amdgcn_s_memrealtime();
    attn_wave_part1(T, kh, tile * 8 + wave, lane, (LAS float*)(lds + AL_IMP + wave * 8448), tm, wave, lds, tid);
    __threadfence_block(); __syncthreads();
    { const int ti = tid >> 3, part = tid & 7; const u32x4* src = (const u32x4*)(T.proj + (size_t)(tile * 64 + ti) * PP + C_Q + kh * 256 + part * 32); LAS u32x4* dst = (LAS u32x4*)(lds + AL_Q + ti * QROWB + part * 64);
      dst[0] = src[0]; dst[1] = src[1]; dst[2] = src[2]; dst[3] = src[3]; }
    ASTAMP(0);
    LAS int* cnt = (LAS int*)(lds + AL_CNT); LAS int* off = (LAS int*)(lds + AL_OFF); LAS u32x4* units = (LAS u32x4*)(lds + AL_UNITS);
    for (int i = tid; i < 256 * OSP; i += NT) ((LAS unsigned long long*)(lds + AL_OS))[i] = 0ull;
    if (tid < 256) { ((LAS int*)(lds + AL_MM))[tid] = f2ord(NEGF); ((LAS float*)(lds + AL_LS))[tid] = 0.f; cnt[tid] = (__popc(tm[2 * tid]) + __popc(tm[2 * tid + 1]) + 7) >> 3; }
    __syncthreads();
    if (tid < 64) {
        const int c0 = cnt[4 * tid], c1 = cnt[4 * tid + 1], c2 = cnt[4 * tid + 2], c3 = cnt[4 * tid + 3]; const int tot = (c0 + c1) + (c2 + c3); int inc = tot;
#pragma unroll
        for (int o = 1; o < 64; o <<= 1) { const int v = __shfl_up(inc, o); if (tid >= o) inc += v; }
        const int ex = inc - tot; off[4 * tid] = ex; off[4 * tid + 1] = ex + c0; off[4 * tid + 2] = ex + c0 + c1; off[4 * tid + 3] = ex + c0 + c1 + c2;
        if (tid == 63) off[256] = inc;
    }
    __syncthreads();
    if (tid < 256) { unsigned long long mask = (unsigned long long)tm[2 * tid] | ((unsigned long long)tm[2 * tid + 1] << 32); int o = off[tid];
        while (mask != 0ull) { unsigned tl = 0xffffffffu, th = 0xffffffffu;
#pragma unroll
            for (int k = 0; k < 4; ++k) if (mask != 0ull) { const unsigned ti = (unsigned)__builtin_ctzll(mask); mask &= mask - 1ull; tl = (tl & ~(0xffu << (8 * k))) | (ti << (8 * k)); }
#pragma unroll
            for (int k = 0; k < 4; ++k) if (mask != 0ull) { const unsigned ti = (unsigned)__builtin_ctzll(mask); mask &= mask - 1ull; th = (th & ~(0xffu << (8 * k))) | (ti << (8 * k)); }
            units[o++] = (u32x4){(unsigned)tid, tl, th, 0u}; } }
    __syncthreads();
    const int n = off[256];
    ASTAMP(1);
    unit_pass<0>(T, kh, tile, n, lds, wave, lane);
    if ((PROBE_REP) == 42) unit_pass<0>(T, kh, tile, n, lds, wave, lane);
    __syncthreads();
    ASTAMP(2);
    unit_pass<1>(T, kh, tile, n, lds, wave, lane);
    __syncthreads();
    ASTAMP(3);
    { const int ti = tid >> 3, part = tid & 7, g = part >> 1, d0 = 32 * (part & 1), row = ti * 4 + g, t = tile * 64 + ti, h = kh * 4 + g;
      const float l = ((const LAS float*)(lds + AL_LS))[row]; const float sc = bf2f(T.proj[(size_t)t * PP + C_NG + h * 3 + 1]) / fmaxf(l, 1e-30f);
      const LAS unsigned long long* orow = (const LAS unsigned long long*)(lds + AL_OS) + row * OSP + (d0 >> 1); u32x4* yp = (u32x4*)(T.ya + (size_t)t * 512 + h * 64 + d0);
      const int nsel = ((t >> 6) + 1) < 16 ? ((t >> 6) + 1) : 16; const unsigned bias = (unsigned)nsel << 26; const float sc2 = sc / T.fxs;
#pragma unroll
      for (int i = 0; i < 4; ++i) { const u32x4 y = yp[i]; const unsigned long long o0 = orow[4 * i], o1 = orow[4 * i + 1], o2 = orow[4 * i + 2], o3 = orow[4 * i + 3]; f32x4 a, b;
          a[0] = bf_lo(y.x) + (float)(int)((unsigned)o0 - bias) * sc2; a[1] = bf_hi(y.x) + (float)(int)((unsigned)(o0 >> 32) - bias) * sc2; a[2] = bf_lo(y.y) + (float)(int)((unsigned)o1 - bias) * sc2; a[3] = bf_hi(y.y) + (float)(int)((unsigned)(o1 >> 32) - bias) * sc2;
          b[0] = bf_lo(y.z) + (float)(int)((unsigned)o2 - bias) * sc2; b[1] = bf_hi(y.z) + (float)(int)((unsigned)(o2 >> 32) - bias) * sc2; b[2] = bf_lo(y.w) + (float)(int)((unsigned)o3 - bias) * sc2; b[3] = bf_hi(y.w) + (float)(int)((unsigned)(o3 >> 32) - bias) * sc2;
          yp[i] = pack8(a, b); } }
    __syncthreads();
    ASTAMP(4);
    if ((TSK) >= 20 && blockIdx.x == 0 && threadIdx.x == 0) T.tsa[5] += (unsigned long long)n;
}

struct SsmB { bf16x8 a[8]; };
__device__ __forceinline__ SsmB ssm_load_b(const unsigned char* ws, int g, int lane) {
    const int i = lane & 15, q = lane >> 4; SsmB B; const bf16x8 z = {0, 0, 0, 0, 0, 0, 0, 0};
    const bf16_t* t = (const bf16_t*)(ws + WS_BBAR) + ((size_t)(g * 128 + i) * 16 + 8 * (q & 1));
#pragma unroll
    for (int rt = 0; rt < 8; ++rt) B.a[rt] = (q < 2) ? *(const bf16x8*)(t + (size_t)rt * 16 * 16) : z;
    return B;
}
__device__ __forceinline__ void ssm_bu16(const bf16_t* proj, const SsmB& B, int tok0, int g, int lane, LAS float* bul) {
    const int i = lane & 15, q = lane >> 4; const bf16x8 z = {0, 0, 0, 0, 0, 0, 0, 0};
    const bf16x8 ub = (q < 2) ? *(const bf16x8*)(proj + (size_t)(tok0 + i) * PP + C_U + g * 16 + 8 * (q & 1)) : z;
    const f32x4 z4 = {0.f, 0.f, 0.f, 0.f};
#pragma unroll
    for (int rt = 0; rt < 8; ++rt) { const f32x4 acc = MFMA16(B.a[rt], ub, z4); *(LAS f32x4*)(bul + i * 132 + 16 * rt + 4 * q) = acc; }
    asm volatile("s_waitcnt lgkmcnt(0)" ::: "memory");
}
__device__ __forceinline__ f32x2 ssm_step(const f32x2 A, const f32x2 x, const f32x2 bu) { f32x2 r; r.x = A.x * x.x - A.y * x.y + bu.x; r.y = A.x * x.y + A.y * x.x + bu.y; return r; }
__device__ __forceinline__ void ssm_pass1(const unsigned char* ws, int c, int g, int lane, LAS float* bul) {
    const bf16_t* proj = (const bf16_t*)(ws + WS_PROJ);
    const SsmB B = ssm_load_b(ws, g, lane);
    const f32x2 A = ((const f32x2*)(ws + WS_ABAR))[g * 64 + lane];
    f32x2 x = {0.f, 0.f};
    for (int sub = 0; sub < 8; ++sub) {
        ssm_bu16(proj, B, c * 128 + sub * 16, g, lane, bul);
#pragma unroll
        for (int s = 0; s < 16; ++s) x = ssm_step(A, x, *(const LAS f32x2*)(bul + s * 132 + 2 * lane));
        asm volatile("s_waitcnt lgkmcnt(0)" ::: "memory");
    }
    ((f32x2*)(ws + WS_SBUF))[(size_t)(c * 32 + g) * 64 + lane] = x;
}
__device__ __forceinline__ void ssm_pass3(const Args& a, int c, int g, int lane, LAS float* bul, LAS unsigned char* xl  ) {
    const unsigned char* ws = a.ws; const bf16_t* proj = (const bf16_t*)(ws + WS_PROJ);
    const SsmB B = ssm_load_b(ws, g, lane);
    const f32x2 A = ((const f32x2*)(ws + WS_ABAR))[g * 64 + lane], A128 = ((const f32x2*)(ws + WS_A128))[g * 64 + lane];
    f32x2 x = {0.f, 0.f};
    { const f32x2* Sb = (const f32x2*)(ws + WS_SBUF) + g * 64 + lane;
      _Pragma("unroll 8") for (int cc = 0; cc < c; ++cc) { const f32x2 s = Sb[(size_t)cc * 32 * 64]; f32x2 r; r.x = A128.x * x.x - A128.y * x.y + s.x; r.y = A128.x * x.y + A128.y * x.x + s.y; x = r; } }
    const int hrow = lane & 15, q = lane >> 4; bf16x8 Cm[4];
    { const float* cre = a.in[14] + (size_t)(g * 16 + hrow) * 64; const float* cim = a.in[15] + (size_t)(g * 16 + hrow) * 64;
#pragma unroll
      for (int ks = 0; ks < 4; ++ks) { const f32x4 r = *(const f32x4*)(cre + 16 * ks + 4 * q), im = *(const f32x4*)(cim + 16 * ks + 4 * q);
          u32x4 w; w.x = cvt_pk_bf16(r[0], -im[0]); w.y = cvt_pk_bf16(r[1], -im[1]); w.z = cvt_pk_bf16(r[2], -im[2]); w.w = cvt_pk_bf16(r[3], -im[3]); Cm[ks] = __builtin_bit_cast(bf16x8, w); } }
    const f32x4 dsk = *(const f32x4*)(a.in[16] + g * 16 + 4 * q);
    bf16_t* ybp = (bf16_t*)((unsigned char*)a.out + OUT_YBP);
    for (int sub = 0; sub < 8; ++sub) {
        const int tok0 = c * 128 + sub * 16;
        ssm_bu16(proj, B, tok0, g, lane, bul);
#pragma unroll
        for (int s = 0; s < 16; ++s) { x = ssm_step(A, x, *(const LAS f32x2*)(bul + s * 132 + 2 * lane)); *(LAS unsigned*)(xl + s * 272 + lane * 4) = cvt_pk_bf16(x.x, x.y); }
        asm volatile("s_waitcnt lgkmcnt(0)" ::: "memory");
        f32x4 acc = {0.f, 0.f, 0.f, 0.f};
#pragma unroll
        for (int ks = 0; ks < 4; ++ks) { const bf16x8 b = *(const LAS bf16x8*)(xl + hrow * 272 + ks * 64 + q * 16); acc = MFMA16(Cm[ks], b, acc); }
        const u32x2 uw = *(const u32x2*)(proj + (size_t)(tok0 + hrow) * PP + C_U + g * 16 + 4 * q);
        const f32x4 uu = {bf_lo(uw.x), bf_hi(uw.x), bf_lo(uw.y), bf_hi(uw.y)};
        f32x4 y = acc + dsk * uu;
        u32x2 w; w.x = cvt_pk_bf16(gelu_tanh(y[0]), gelu_tanh(y[1])); w.y = cvt_pk_bf16(gelu_tanh(y[2]), gelu_tanh(y[3]));
        *(u32x2*)(ybp + (size_t)(tok0 + hrow) * 512 + g * 16 + 4 * q) = w;
        asm volatile("s_waitcnt lgkmcnt(0)" ::: "memory");
    }
}

__global__ void __launch_bounds__(NT, 2) fwd_mega(Args a) {
    extern __shared__ __attribute__((aligned(16))) unsigned char lds_raw[];
    cg::grid_group grid = cg::this_grid();
    LAS unsigned char* lds = (LAS unsigned char*)lds_raw;
    const int tid = threadIdx.x, lane = tid & 63, wave = __builtin_amdgcn_readfirstlane(tid >> 6);
    const int G = gridDim.x, bid = blockIdx.x;
    const int gw = bid * NWV + wave, NGW = G * NWV;
    const int gt = bid * NT + tid, NGT = G * NT;
    unsigned char* ws = a.ws;
    const float* x = a.in[0];
    STAMP(0);
    if ((TSK) >= 20 && blockIdx.x == 0 && threadIdx.x == 0) for (int i = 0; i < 16; ++i) ((unsigned long long*)(a.ws + 244 * 1024))[i] = 0ull;
    if (tid < 4) ((volatile LAS unsigned*)(lds + 131072 + 64))[tid] = 0u;
    if (bid == 0) for (int i = tid; i < XCD_BAR_WORDS; i += NT) ((unsigned*)(ws + WS_BAR))[i] = 0u;
    __syncthreads();

    {
        if (bid < 16) {
            LAS float* red = (LAS float*)lds;
            const int o = bid * 32 + (tid & 31), ksl = tid >> 5, which = o >> 8, colc = o & 255;
            const float* pe = a.in[which ? 7 : 4]; const float* w1 = a.in[which ? 8 : 5]; float s = 0.f;
            _Pragma("unroll 16") for (int k = ksl * 128; k < ksl * 128 + 128; ++k) s += pe[k] * w1[(size_t)k * 256 + colc];
            red[ksl * 32 + (tid & 31)] = s; __syncthreads();
            if (tid < 32) { float t = 0.f; for (int i = 0; i < 16; ++i) t += red[i * 32 + tid]; ((float*)(ws + WS_BIASPE))[o] = t; }
            __syncthreads();
        }
        LAS float* scr = (LAS float*)(lds + wave * 8448);
        constexpr int I_IN = 16 * 121, I_GLU = 8 * 16, I_PA = 8 * 32, I_OUT = 16 * 32, I_UP = 16 * 176, I_DN = 44 * 32, I_W1 = 32 * 8;
        constexpr int NITEMS = I_IN + I_GLU + 2 * I_PA + I_OUT + I_UP + I_DN + 2 * I_W1;
        for (int it = gw; it < NITEMS; it += NGW) {
            int r = it;
            if (r < I_IN) { transpose_item(a.in[3], 1024, DIN, (bf16_t*)(ws + WS_WIN), scr, r / 121, r % 121, lane, a.in[2], 1); continue; } r -= I_IN;
            if (r < I_GLU) { transpose_item(a.in[18], 512, 512, (bf16_t*)(ws + WS_WGLU), scr, r / 16, r % 16, lane, nullptr, 0); continue; } r -= I_GLU;
            if (r < I_PA) { transpose_item(a.in[19], 512, 1024, (bf16_t*)(ws + WS_WPA), scr, r / 32, r % 32, lane, nullptr, 0); continue; } r -= I_PA;
            if (r < I_PA) { transpose_item(a.in[20], 512, 1024, (bf16_t*)(ws + WS_WPB), scr, r / 32, r % 32, lane, nullptr, 0); continue; } r -= I_PA;
            if (r < I_OUT) { transpose_item(a.in[21], 1024, 1024, (bf16_t*)(ws + WS_WOUT), scr, r / 32, r % 32, lane, nullptr, 0); continue; } r -= I_OUT;
            if (r < I_UP) { transpose_item(a.in[23], 1024, NUP, (bf16_t*)(ws + WS_WUP), scr, r / 176, r % 176, lane, a.in[22], 2); continue; } r -= I_UP;
            if (r < I_DN) { transpose_item(a.in[26], DFF, 1024, (bf16_t*)(ws + WS_WDOWN), scr, r / 32, r % 32, lane, nullptr, 0); continue; } r -= I_DN;
            if (r < I_W1) { transpose_item(a.in[5], 2048, 256, (bf16_t*)(ws + WS_W1K), scr, r / 8, r % 8, lane, nullptr, 0); continue; } r -= I_W1;
            transpose_item(a.in[8], 2048, 256, (bf16_t*)(ws + WS_W1V), scr, r / 8, r % 8, lane, nullptr, 0);
        }
        { u32x4* p = (u32x4*)(ws + WS_WIN + (size_t)DIN * 1024 * 2); const int n = (4096 - DIN) * 1024 * 2 / 16; for (int i = gt; i < n; i += NGT) p[i] = (u32x4){0u, 0u, 0u, 0u}; }
        { u32x4* p = (u32x4*)(ws + WS_PROJ + (size_t)SEQ * PP * 2); const int n = 32 * PP * 2 / 16; for (int i = gt; i < n; i += NGT) p[i] = (u32x4){0u, 0u, 0u, 0u}; }
        for (int i = gt; i < 128 * 64 + 2048; i += NGT) {
            if (i < 128 * 64) { const int r = i >> 6, cidx = SEQ + (i & 63); ((bf16_t*)(ws + WS_VSLT))[(size_t)r * VTP + cidx] = 0; ((bf16_t*)(ws + WS_VWNT))[(size_t)r * VTP + cidx] = 0; }
            else { const int j = i - 128 * 64; ((bf16_t*)(ws + WS_VSLT))[(size_t)128 * VTP + j] = 0; ((bf16_t*)(ws + WS_VWNT))[(size_t)128 * VTP + j] = 0; }
        }
        for (int i = gt; i < SEQ; i += NGT) { ((float*)(ws + WS_RSS2))[i] = 0.f; ((float*)(ws + WS_RSS3))[i] = 0.f; }
        if (gt == 0) *(unsigned*)(ws + WS_VMAX) = 0u;
        { const int* pos = (const int*)a.in[1];
          for (int i = gt; i < SEQ * 8; i += NGT) { const int tt = i >> 3, fi = i & 7; const float invf = powf(500000.0f, -(float)(2 * fi) / 16.0f); const float ang = (float)pos[tt] * invf;
              float sn, cs; sincosf(ang, &sn, &cs); ((float*)(ws + WS_ROPEC))[i] = cs; ((float*)(ws + WS_ROPES))[i] = sn; } }
        for (int i = gt; i < 2048; i += NGT) { const int gg = i >> 6;
            const float dt = expf(a.in[17][gg]), ar = a.in[10][i], ai = a.in[11][i];
            const float e = expf(ar * dt), em1 = expm1f(ar * dt), th = ai * dt; float sn, cs; sincosf(th, &sn, &cs); const float sh = sinf(0.5f * th);
            const float Ax = e * cs, Ay = e * sn; const float nx = em1 * cs - 2.f * sh * sh, ny = e * sn;
            const float den = 1.f / (ar * ar + ai * ai); const float fx = (nx * ar + ny * ai) * den, fy = (ny * ar - nx * ai) * den;
            ((f32x2*)(ws + WS_ABAR))[i] = (f32x2){Ax, Ay};
            float px = Ax, py = Ay;
            for (int k = 0; k < 7; ++k) { const float qx = px * px - py * py, qy = 2.f * px * py; px = qx; py = qy; }
            ((f32x2*)(ws + WS_A128))[i] = (f32x2){px, py};
            const float* bre = a.in[12] + (size_t)i * 16; const float* bim = a.in[13] + (size_t)i * 16; const int pp = i & 63;
            bf16_t* Bo = (bf16_t*)(ws + WS_BBAR) + ((size_t)(gg * 128 + 2 * pp) * 16);
            for (int hh = 0; hh < 16; hh += 2) { *(unsigned*)(Bo + hh) = cvt_pk_bf16(fx * bre[hh] - fy * bim[hh], fx * bre[hh + 1] - fy * bim[hh + 1]);
                                                 *(unsigned*)(Bo + 16 + hh) = cvt_pk_bf16(fx * bim[hh] + fy * bre[hh], fx * bim[hh + 1] + fy * bre[hh + 1]); }
        }
        for (int r = gw; r < SEQ; r += NGW) {
            const f32x4* xr = (const f32x4*)(x + (size_t)r * DM) + lane; f32x4 v[4]; float s = 0.f;
#pragma unroll
            for (int j = 0; j < 4; ++j) { v[j] = xr[64 * j]; s += (v[j][0] * v[j][0] + v[j][1] * v[j][1]) + (v[j][2] * v[j][2] + v[j][3] * v[j][3]); }
            s = wave_sum(s);
            if (lane == 0) ((float*)(ws + WS_RSTD1))[r] = rsqrtf(s * (1.f / DM) + EPS);
            u32x2* o = (u32x2*)(ws + WS_XB + (size_t)r * DM * 2) + lane;
#pragma unroll
            for (int j = 0; j < 4; ++j) { u32x2 w; w.x = cvt_pk_bf16(v[j][0], v[j][1]); w.y = cvt_pk_bf16(v[j][2], v[j][3]); o[64 * j] = w; }
        }
    }
    grid.sync();
    STAMP(1);
    XcdBarrier xbar = xcd_barrier_post((unsigned*)(ws + WS_BAR), (volatile LAS unsigned*)(lds + 131072 + 64));

    REPS(1) {
        pg8::Gemm g{1024, 2048u, 128u, (unsigned)(1024) * 2u};
        SchedMN S{64, 16, 1, G, bid, 0, (const char*)(ws + WS_XB), nullptr, (const char*)(ws + WS_WIN), nullptr, (size_t)256 * 1024 * 2, (size_t)256 * 1024 * 2};
        EpiProj E{(bf16_t*)(ws + WS_PROJ), (bf16_t*)(ws + WS_VSLT), (bf16_t*)(ws + WS_VWNT), (bf16_t*)(ws + WS_KSL), (bf16_t*)(ws + WS_KWN), (const float*)(ws + WS_RSTD1), (const float*)(ws + WS_ROPEC), (const float*)(ws + WS_ROPES)};
        pg8::gemm_phase<EpiProj, SchedMN, true, true>(lds, g, S, E);
    }
    GSYNC();
    STAMP(2);

    {
        if (bid < 64) {
            pg8::Gemm g{512, (unsigned)(16 * PP * 2), (unsigned)(PP * 2), (unsigned)(2048) * 2u};
            SchedCmp S{bid, (const char*)(ws + WS_PROJ), (const char*)(ws + WS_W1K), (const char*)(ws + WS_W1V)};
            EpiCmp E{(float*)(ws + WS_XB)};
            pg8::gemm_phase<EpiCmp, SchedCmp, true, true>(lds, g, S, E);
        } else {
            LAS float* ubuf = (LAS float*)(lds + wave * 16384);
            for (int it = (bid - 64) * NWV + wave; it < 4096 * ((PROBE_REP) == 12 ? 2 : 1); it += (G - 64) * NWV) ssm_pass1(ws, (it & 4095) >> 5, it & 31, lane, ubuf);
        }
    }
    GSYNC();
    STAMP(3);

    REPS(3) {
        {
            const u32x4* vp = (const u32x4*)(ws + WS_VSLT); unsigned mx = 0u;
            for (int i = gt; i < 262144; i += NGT) { const u32x4 v = vp[i];
                mx = max(mx, max(max(v.x & 0x7fffu, (v.x >> 16) & 0x7fffu), max(v.y & 0x7fffu, (v.y >> 16) & 0x7fffu)));
                mx = max(mx, max(max(v.z & 0x7fffu, (v.z >> 16) & 0x7fffu), max(v.w & 0x7fffu, (v.w >> 16) & 0x7fffu))); }
#pragma unroll
            for (int o = 1; o < 64; o <<= 1) mx = max(mx, (unsigned)__shfl_xor((int)mx, o));
            LAS unsigned* red = (LAS unsigned*)(lds + 65536); if (lane == 0) red[wave] = mx; __syncthreads();
            if (tid == 0) { unsigned m8 = red[0]; for (int w = 1; w < NWV; ++w) m8 = max(m8, red[w]); atomicMax((unsigned*)(ws + WS_VMAX), m8); }
            __syncthreads();
        }
        const float* hidp = (const float*)(ws + WS_XB); LAS float* hrow = (LAS float*)(lds + wave * 1024);
        for (int r = gw; r < 4096; r += NGW) {
            const int z = r >> 10, n = r & 1023, which = z >> 1, kh = z & 1;
            float acc = 0.f;
            if (n < 1023) { const float* w2 = a.in[which ? 9 : 6];
                f32x4 hv = *(const f32x4*)((const float*)(ws + WS_BIASPE) + which * 256 + 4 * lane);
#pragma unroll
                for (int ks = 0; ks < 4; ++ks) hv += *(const f32x4*)(hidp + ((size_t)ks * 4096 + r) * 256 + 4 * lane);
                hv[0] = gelu_tanh(hv[0]); hv[1] = gelu_tanh(hv[1]); hv[2] = gelu_tanh(hv[2]); hv[3] = gelu_tanh(hv[3]);
                *(LAS f32x4*)(hrow + 4 * lane) = hv; asm volatile("s_waitcnt lgkmcnt(0)" ::: "memory");
                _Pragma("unroll 16") for (int k = 0; k < 256; k += 4) { const f32x4 h4 = *(const LAS f32x4*)(hrow + k);
                    acc += h4[0] * w2[k * 64 + lane]; acc += h4[1] * w2[(k + 1) * 64 + lane]; acc += h4[2] * w2[(k + 2) * 64 + lane]; acc += h4[3] * w2[(k + 3) * 64 + lane]; }
                asm volatile("s_waitcnt lgkmcnt(0)" ::: "memory"); }
            if (which == 0) {
                const float other = __shfl_xor(acc, 8); const int prow = 16 * n + 31; float o = acc;
                if (lane < 16 && n < 1023) { const float cs = ((const float*)(ws + WS_ROPEC))[prow * 8 + (lane & 7)], sn = ((const float*)(ws + WS_ROPES))[prow * 8 + (lane & 7)];
                    o = lane < 8 ? acc * cs - other * sn : acc * cs + other * sn; }
                ((bf16_t*)(ws + WS_KCMP))[((size_t)kh * 1024 + n) * 64 + lane] = (bf16_t)(cvt_pk_bf16(o, 0.f) & 0xffff);
            } else {
                ((bf16_t*)(ws + WS_VCMPT))[((size_t)kh * 64 + lane) * 1024 + n] = (bf16_t)(cvt_pk_bf16(acc, 0.f) & 0xffff);
            }
        }
    }
    GSYNC();
    STAMP(4);

    {
        AttnT T{0.f, (unsigned long long*)(ws + 244 * 1024), (const bf16_t*)(ws + WS_PROJ), (const bf16_t*)(ws + WS_KSL), (const bf16_t*)(ws + WS_KWN), (const bf16_t*)(ws + WS_KCMP), (const bf16_t*)(ws + WS_VCMPT), (const bf16_t*)(ws + WS_VSLT), (const bf16_t*)(ws + WS_VWNT), (bf16_t*)((unsigned char*)a.out + OUT_YA)};
        { const unsigned vb = __hip_atomic_load((unsigned*)(ws + WS_VMAX), __ATOMIC_RELAXED, __HIP_MEMORY_SCOPE_AGENT); const float vmax = fmaxf(__uint_as_float(vb << 16), 1e-30f); T.fxs = FXB / (64.0f * 1.01f * vmax); }
        LAS float* wl = (LAS float*)(lds + wave * 16384);
        for (int r2 = 0; r2 < ((PROBE_REP) == 4 ? 2 : 1); ++r2)
        for (int pr = bid; pr < 256; pr += G) {
            const int xcd = pr & 7, slot = pr >> 3, kh = xcd & 1, tl = 32 * (xcd >> 1) + slot;
_Pragma("nounroll")
            for (int k2 = 0; k2 < 2; ++k2) { int tk_ = threadIdx.x; asm volatile("" : "+v"(tk_)); attn_tile(T, kh, k2 ? 255 - tl : tl, lds, tk_, __builtin_amdgcn_readfirstlane(tk_ >> 6), tk_ & 63); }
        }
        if ((PROBE_REP) == 4) {
            AttnT T2 = T; T2.ya = (bf16_t*)(ws + WS_XB);
            for (int pr = bid; pr < 256; pr += G) { const int xcd = pr & 7, slot = pr >> 3, kh = xcd & 1, tl = 32 * (xcd >> 1) + slot;
                _Pragma("nounroll") for (int k2 = 0; k2 < 2; ++k2) attn_tile(T2, kh, k2 ? 255 - tl : tl, lds, tid, wave, lane); }
        }
        int tid2 = threadIdx.x; asm volatile("" : "+v"(tid2));
        const int lane2 = tid2 & 63, wave2 = __builtin_amdgcn_readfirstlane(tid2 >> 6), gw2 = bid * NWV + wave2;
        for (int it = gw2; it < 4096 * ((PROBE_REP) == 14 ? 2 : 1); it += NGW) ssm_pass3(a, (it & 4095) >> 5, it & 31, lane2, (LAS float*)(lds + wave2 * 16384), lds + wave2 * 16384 + 8448);
    }
    GSYNC();
    STAMP(5);

    REPS(5) {
        pg8::Gemm g{512, 1024u, 128u, (unsigned)(512) * 2u};
        SchedMN S{64, 2, 1, G, bid, 0, (const char*)a.out + OUT_YBP, nullptr, (const char*)(ws + WS_WGLU), nullptr, (size_t)256 * 512 * 2, (size_t)256 * 512 * 2};
        EpiGlu E{(const bf16_t*)((const unsigned char*)a.out + OUT_YBP), (bf16_t*)((unsigned char*)a.out + OUT_YB)};
        pg8::gemm_phase<EpiGlu, SchedMN, true, true>(lds, g, S, E);
    }
    GSYNC();
    STAMP(6);

    REPS(6) {
        pg8::Gemm g{512, 1024u, 128u, (unsigned)(512) * 2u};
        SchedMN S{64, 4, 2, G, bid, 0, (const char*)a.out + OUT_YA, (const char*)a.out + OUT_YB, (const char*)(ws + WS_WPA), (const char*)(ws + WS_WPB), (size_t)256 * 512 * 2, (size_t)256 * 512 * 2};
        EpiMerge E{(const bf16_t*)(ws + WS_PROJ), (bf16_t*)(ws + WS_MERGED)};
        pg8::gemm_phase<EpiMerge, SchedMN, true, true>(lds, g, S, E);
    }
    GSYNC();
    STAMP(7);

    {
        pg8::Gemm g{1024, 2048u, 128u, (unsigned)(1024) * 2u};
        SchedMN S{64, 4, 1, G, bid, 0, (const char*)(ws + WS_MERGED), nullptr, (const char*)(ws + WS_WOUT), nullptr, (size_t)256 * 1024 * 2, (size_t)256 * 1024 * 2};
        EpiRes E{x, a.out, (bf16_t*)(ws + WS_X1B), (float*)(ws + WS_RSS2)};
        pg8::gemm_phase<EpiRes, SchedMN, true, true>(lds, g, S, E);
    }
    GSYNC();
    STAMP(8);

    for (int half = 0; half < 2; ++half) {
        const int pm_off = half ? 31 : 0, nM = half ? 33 : 32, rowbase = pm_off * 256;
        REPS(8) {
            pg8::Gemm g{1024, 2048u, 128u, (unsigned)(1024) * 2u};
            SchedMN S{nM, 22, 1, G, bid, pm_off, (const char*)(ws + WS_X1B), nullptr, (const char*)(ws + WS_WUP), nullptr, (size_t)256 * 1024 * 2, (size_t)256 * 1024 * 2};
            EpiUp E{(bf16_t*)(ws + WS_UPRAW), (const float*)(ws + WS_RSS2), rowbase};
            pg8::gemm_phase<EpiUp, SchedMN, true, true>(lds, g, S, E);
        }
        GSYNC();
    STAMP(9);
        REPS(9) {
            const bf16_t* up = (const bf16_t*)(ws + WS_UPRAW); bf16_t* act = (bf16_t*)(ws + WS_ACT);
            const float* cw = a.in[24]; const float* cb = a.in[25];
            const int tlo = half ? 8192 : 0;
            for (int it = gt; it < 256 * 352; it += NGT) {
                const int cg8 = it % 352, tb = it / 352, c0 = cg8 * 8, tile = c0 >> 7, jj = c0 & 127;
                const int ucol = tile * 256 + jj;
                float wg[3][8], wv[3][8], bg[8], bv[8];
#pragma unroll
                for (int e = 0; e < 8; ++e) { bg[e] = cb[c0 + e]; bv[e] = cb[DFF + c0 + e];
#pragma unroll
                    for (int k = 0; k < 3; ++k) { wg[k][e] = cw[k * NUP + c0 + e]; wv[k][e] = cw[k * NUP + DFF + c0 + e]; } }
                const int ts = tlo + tb * 32;
                float g2[8], g1[8], v2[8], v1[8];
#pragma unroll
                for (int e = 0; e < 8; ++e) { g2[e] = g1[e] = v2[e] = v1[e] = 0.f; }
                if (ts >= 2) {
                    const u32x4 a2 = *(const u32x4*)(up + (size_t)(ts - 2 - rowbase) * NUP + ucol), b2 = *(const u32x4*)(up + (size_t)(ts - 2 - rowbase) * NUP + ucol + 128);
                    const u32x4 a1 = *(const u32x4*)(up + (size_t)(ts - 1 - rowbase) * NUP + ucol), b1 = *(const u32x4*)(up + (size_t)(ts - 1 - rowbase) * NUP + ucol + 128);
                    g2[0] = bf_lo(a2.x); g2[1] = bf_hi(a2.x); g2[2] = bf_lo(a2.y); g2[3] = bf_hi(a2.y); g2[4] = bf_lo(a2.z); g2[5] = bf_hi(a2.z); g2[6] = bf_lo(a2.w); g2[7] = bf_hi(a2.w);
                    v2[0] = bf_lo(b2.x); v2[1] = bf_hi(b2.x); v2[2] = bf_lo(b2.y); v2[3] = bf_hi(b2.y); v2[4] = bf_lo(b2.z); v2[5] = bf_hi(b2.z); v2[6] = bf_lo(b2.w); v2[7] = bf_hi(b2.w);
                    g1[0] = bf_lo(a1.x); g1[1] = bf_hi(a1.x); g1[2] = bf_lo(a1.y); g1[3] = bf_hi(a1.y); g1[4] = bf_lo(a1.z); g1[5] = bf_hi(a1.z); g1[6] = bf_lo(a1.w); g1[7] = bf_hi(a1.w);
                    v1[0] = bf_lo(b1.x); v1[1] = bf_hi(b1.x); v1[2] = bf_lo(b1.y); v1[3] = bf_hi(b1.y); v1[4] = bf_lo(b1.z); v1[5] = bf_hi(b1.z); v1[6] = bf_lo(b1.w); v1[7] = bf_hi(b1.w);
                }
                for (int s = 0; s < 32; ++s) {
                    const int tt = ts + s;
                    const u32x4 a0 = *(const u32x4*)(up + (size_t)(tt - rowbase) * NUP + ucol), b0 = *(const u32x4*)(up + (size_t)(tt - rowbase) * NUP + ucol + 128);
                    float gc[8], vc[8];
                    gc[0] = bf_lo(a0.x); gc[1] = bf_hi(a0.x); gc[2] = bf_lo(a0.y); gc[3] = bf_hi(a0.y); gc[4] = bf_lo(a0.z); gc[5] = bf_hi(a0.z); gc[6] = bf_lo(a0.w); gc[7] = bf_hi(a0.w);
                    vc[0] = bf_lo(b0.x); vc[1] = bf_hi(b0.x); vc[2] = bf_lo(b0.y); vc[3] = bf_hi(b0.y); vc[4] = bf_lo(b0.z); vc[5] = bf_hi(b0.z); vc[6] = bf_lo(b0.w); vc[7] = bf_hi(b0.w);
                    float o[8];
#pragma unroll
                    for (int e = 0; e < 8; ++e) { const float gg = bg[e] + wg[0][e] * g2[e] + wg[1][e] * g1[e] + wg[2][e] * gc[e]; const float vv = bv[e] + wv[0][e] * v2[e] + wv[1][e] * v1[e] + wv[2][e] * vc[e];
                        o[e] = gg * sigmoidf_(gg) * vv; g2[e] = g1[e]; g1[e] = gc[e]; v2[e] = v1[e]; v1[e] = vc[e]; }
                    u32x4 w; w.x = cvt_pk_bf16(o[0], o[1]); w.y = cvt_pk_bf16(o[2], o[3]); w.z = cvt_pk_bf16(o[4], o[5]); w.w = cvt_pk_bf16(o[6], o[7]);
                    *(u32x4*)(act + (size_t)tt * DFF + c0) = w;
                }
            }
        }
        GSYNC();
    STAMP(10);
    }

    {
        pg8::Gemm g{DFF, (unsigned)(DFF * 2), 128u, (unsigned)(DFF) * 2u};
        SchedMN S{64, 4, 1, G, bid, 0, (const char*)(ws + WS_ACT), nullptr, (const char*)(ws + WS_WDOWN), nullptr, (size_t)256 * DFF * 2, (size_t)256 * DFF * 2};
        EpiRes E{a.out, a.out, nullptr, (float*)(ws + WS_RSS3)};
        pg8::gemm_phase<EpiRes, SchedMN, true, true>(lds, g, S, E);
    }
    GSYNC();
    STAMP(11);

    {
        const float* gf = a.in[27];
        for (int r = gw; r < SEQ; r += NGW) {
            const float rs = rsqrtf(((const float*)(ws + WS_RSS3))[r] * (1.f / DM) + EPS);
            f32x4* xr = (f32x4*)(a.out + (size_t)r * DM) + lane; const f32x4* gr = (const f32x4*)gf + lane;
#pragma unroll
            for (int j = 0; j < 4; ++j) xr[64 * j] = xr[64 * j] * rs * gr[64 * j];
        }
    }
    if ((TSK) >= 0 && blockIdx.x == 0 && threadIdx.x == 0) {
        const unsigned long long tend = __builtin_amdgcn_s_memrealtime(); const unsigned long long* ts = (const unsigned long long*)(a.ws + 240 * 1024);
        const unsigned long long t1 = ((TSK) + 1 > 11) ? tend : ts[(TSK) + 1 > 11 ? 0 : (TSK) + 1];
        asm volatile("s_waitcnt vmcnt(0)" ::: "memory");
        a.out[0] = ((TSK) >= 20) ? (float)((const unsigned long long*)(a.ws + 244 * 1024))[(TSK) >= 20 ? (TSK) - 20 : 0] * ((TSK) == 25 ? 1.0f : 0.01f) : (float)(t1 - ts[(TSK) > 11 ? 11 : (TSK)]) * 0.01f;
    }
}

extern "C" void kernel_launch(void* const* d_in, const int* in_sizes, int n_in, void* d_out, int out_size, void* d_ws, size_t ws_size, hipStream_t stream) {
    static int grid = 0;
    if (grid == 0) {
        int dev = 0, cus = 0, per_cu = 0;
        (void)hipGetDevice(&dev); (void)hipDeviceGetAttribute(&cus, hipDeviceAttributeMultiprocessorCount, dev);
        (void)hipFuncSetAttribute((const void*)fwd_mega, hipFuncAttributeMaxDynamicSharedMemorySize, LDS_BYTES);
        (void)hipOccupancyMaxActiveBlocksPerMultiprocessor(&per_cu, (const void*)fwd_mega, NT, LDS_BYTES);
        if (per_cu < 1) { fprintf(stderr, "kernel_launch: occupancy query says %d blocks per CU\n", per_cu); per_cu = 1; }
        grid = cus;
        if (n_in != 28 || ws_size < 252 * MiB) fprintf(stderr, "kernel_launch: unexpected n_in %d / ws_size %zu\n", n_in, ws_size);
    }
    Args a{};
    for (int i = 0; i < 28; ++i) a.in[i] = (const float*)d_in[i];
    a.out = (float*)d_out; a.ws = (unsigned char*)d_ws;
    void* kargs[] = {&a};
    hipError_t e = hipLaunchCooperativeKernel((const void*)fwd_mega, dim3(grid), dim3(NT), kargs, LDS_BYTES, stream);
    if (e != hipSuccess) fprintf(stderr, "cooperative launch failed: %s (grid %d)\n", hipGetErrorString(e), grid);
}
```

```cpp
#include <hip/hip_runtime.h>
#include <hip/hip_cooperative_groups.h>
#include <cstdio>
#include <cstdint>
namespace cg = cooperative_groups;
#ifndef PROBE_REP
#define PROBE_REP -1
#endif
#ifndef EXPV
#define EXPV 0
#endif
#ifndef TSK
#define TSK -1
#endif
#define STAMP(i) do { if ((TSK) >= 0 && blockIdx.x == 0 && threadIdx.x == 0) ((unsigned long long*)(a.ws + 240 * 1024))[i] = __builtin_amdgcn_s_memrealtime(); } while (0)
#define ASTAMP(k) do { if ((TSK) >= 20 && blockIdx.x == 0 && threadIdx.x == 0) { const unsigned long long t_ = __builtin_amdgcn_s_memrealtime(); T.tsa[k] += t_ - T.tsa[15]; T.tsa[15] = t_; } } while (0)
#define REPS(k) _Pragma("nounroll") for (int rep_ = 0; rep_ < ((PROBE_REP) == (k) ? 2 : 1); ++rep_)
#define GSYNC() do { xcd_barrier(xbar); if ((PROBE_REP) == 100) xcd_barrier(xbar); } while (0)

#define LAS __attribute__((address_space(3)))
typedef unsigned short bf16_t;
typedef short bf16x8 __attribute__((ext_vector_type(8)));
typedef float f32x4 __attribute__((ext_vector_type(4)));
typedef float f32x2 __attribute__((ext_vector_type(2)));
typedef unsigned u32x4 __attribute__((ext_vector_type(4)));
typedef unsigned u32x2 __attribute__((ext_vector_type(2)));

constexpr int SEQ = 16384, DM = 1024, DIN = 3864, PP = 4096  , DFF = 2816, NUP = 5632;
constexpr int C_Q = 0, C_KC = 512, C_VC = 640, C_KSL = 768, C_VSL = 896, C_KWN = 1024, C_VWN = 1152, C_U = 1280, C_GA = 1792, C_GB = 2816, C_NG = 3840;
constexpr int VTP = SEQ + 64;
constexpr float EPS = 1e-6f;
constexpr float NEGF = -1e30f;

constexpr size_t MiB = 1u << 20;
constexpr size_t WS_RSTD1 = 0, WS_RSS2 = 64 * 1024, WS_RSS3 = 128 * 1024, WS_ROPEC = 256 * 1024, WS_ROPES = 768 * 1024;
constexpr size_t WS_ABAR = 1280 * 1024, WS_A128 = WS_ABAR + 16384, WS_BIASPE = WS_A128 + 16384, WS_BBAR = 1536 * 1024  ;
constexpr size_t WS_SBUF = 2 * MiB  , WS_HID = 4 * MiB  , WS_KCMP = 6 * MiB  , WS_VCMPT = 6 * MiB + 512 * 1024  ;
constexpr size_t WS_WUP = 8 * MiB, WS_WDOWN = 20 * MiB, WS_WIN = 26 * MiB, WS_WGLU = 34 * MiB, WS_WPA = 35 * MiB, WS_WPB = 36 * MiB, WS_WOUT = 37 * MiB, WS_W1K = 39 * MiB, WS_W1V = 40 * MiB;
constexpr size_t WS_XB = 41 * MiB, WS_MERGED = 41 * MiB, WS_PROJ = 73 * MiB, WS_VSLT = 202 * MiB + 512 * 1024, WS_VWNT = 207 * MiB;
constexpr size_t WS_X1B = 220 * MiB, WS_UPRAW = 26 * MiB, WS_ACT = 122 * MiB;
constexpr size_t WS_VMAX = 232 * 1024, WS_BAR = 192 * 1024, WS_KSL = 212 * MiB, WS_KWN = 216 * MiB;
constexpr size_t OUT_YA = 0, OUT_YBP = 16 * MiB, OUT_YB = 32 * MiB;
static_assert(WS_PROJ + (size_t)(SEQ + 32) * PP * 2 <= WS_VSLT, "proj");
static_assert(WS_VSLT + (size_t)128 * VTP * 2 + 4096 <= WS_VWNT && WS_VWNT + (size_t)128 * VTP * 2 + 4096 <= WS_X1B, "vt");
static_assert(WS_UPRAW + (size_t)33 * 256 * NUP * 2 <= WS_ACT && WS_ACT + (size_t)SEQ * DFF * 2 <= WS_X1B, "ffn");

__device__ __forceinline__ unsigned cvt_pk_bf16(float lo, float hi) { unsigned r; asm volatile("v_cvt_pk_bf16_f32 %0, %1, %2" : "=v"(r) : "v"(lo), "v"(hi)); return r; }
__device__ __forceinline__ float bf_lo(unsigned w) { return __uint_as_float(w << 16); }
__device__ __forceinline__ float bf_hi(unsigned w) { return __uint_as_float(w & 0xffff0000u); }
__device__ __forceinline__ float bf2f(bf16_t b) { return __uint_as_float((unsigned)b << 16); }
__device__ __forceinline__ float sigmoidf_(float v) { return 1.f / (1.f + __expf(-v)); }
__device__ __forceinline__ float gelu_tanh(float v) { const float z = 0.7978845608028654f * (v + 0.044715f * v * v * v); const float th = 1.f - 2.f / (__expf(2.f * z) + 1.f); return 0.5f * v * (1.f + th); }
__device__ __forceinline__ u32x4 pack8(f32x4 a, f32x4 b) { u32x4 w; w.x = cvt_pk_bf16(a[0], a[1]); w.y = cvt_pk_bf16(a[2], a[3]); w.z = cvt_pk_bf16(b[0], b[1]); w.w = cvt_pk_bf16(b[2], b[3]); return w; }

namespace pg8 {
#define PG8_LAS __attribute__((address_space(3)))
constexpr int BM = 256, BK = 64, HALF = 128, HTB = HALF * BK * 2, STAGE_BYTES = 8 * HTB, NXCD = 8, WGM = 8;
__host__ __device__ __forceinline__ int lds_byte(int r, int c) { const int st = (r >> 4) * 2 + (c >> 5), rr = r & 15, cc = c & 31, ob = rr * 64 + cc * 2; return st * 1024 + (ob ^ (((ob >> 9) & 1) << 5)); }
__host__ __device__ __forceinline__ void stage_rc(int b, int& R, int& C) { const int st = b / 1024, sb = b % 1024, swz = sb ^ (((sb >> 9) & 1) << 5); R = (st >> 1) * 16 + swz / 64; C = (st & 1) * 32 + (swz % 64) / 2; }
__host__ __device__ __forceinline__ int perm32(int rho) { const int n = rho >> 4, i = rho & 15; return 8 * (i >> 2) + 4 * n + (i & 3); }
struct Unit { int pm, pn, z; const char* A; const char* B; };
struct Gemm { int K; unsigned lda_b; unsigned kstepA; unsigned ldb_b; };
__device__ __forceinline__ bool tile_of(long L, int nM, int nN, int& pm, int& pn) {
    const int nwg = nM * nN; if (L >= nwg) return false;
    int wgid = (int)L; { const int q = nwg / NXCD, r = nwg % NXCD, xcd = wgid % NXCD, off = wgid / NXCD; wgid = (xcd < r ? xcd * (q + 1) : r * (q + 1) + (xcd - r) * q) + off; }
    const int nig = WGM * nN, gid = wgid / nig, fm = gid * WGM, gsz = (nM - fm) < WGM ? (nM - fm) : WGM;
    pm = fm + ((wgid % nig) % gsz); pn = (wgid % nig) / gsz; return true;
}
template <class Epi, class Sched, bool ALIGN_EPI = false, bool SP2 = false>
__device__ __forceinline__ void gemm_phase(PG8_LAS unsigned char* lds, const Gemm g, const Sched& S, const Epi& E) {
    int tid_ = threadIdx.x; asm volatile("" : "+v"(tid_));
    const int tid = tid_, wid = __builtin_amdgcn_readfirstlane(tid >> 6), lane = tid & 63, wr = wid >> 2, wc = wid & 3, fr = lane & 15, fq = lane >> 4;
    const int K = g.K, nt = K / BK;
    unsigned voffA[2], voffB[2];
#pragma unroll
    for (int i = 0; i < 2; ++i) { int R, C; stage_rc(tid * 16 + i * 8192, R, C); const int Rb = Epi::PERM ? ((R & ~31) + perm32(R & 31)) : R;
        voffA[i] = (unsigned)R * g.lda_b + (unsigned)C * 2u; voffB[i] = (unsigned)Rb * g.ldb_b + (unsigned)C * 2u; }
    const size_t kstepA = (size_t)g.kstepA, kstepB = (size_t)(BK * 2);
    const size_t hstepA = (size_t)HALF * g.lda_b, hstepB = (size_t)HALF * g.ldb_b;
    const unsigned ldsw = (unsigned)wid * 1024u;
    const int aoff = lds_byte(wr * 64 + fr, fq * 8), boff = lds_byte(wc * 32 + fr, fq * 8);
#define PG8_SA(b, h) (((b) * 2 + (h)) * HTB)
#define PG8_SB(b, h) ((4 + (b) * 2 + (h)) * HTB)
#define PG8_STAGE(bufoff, gbase, voff) do { _Pragma("unroll") for (int _i = 0; _i < 2; ++_i) \
        __builtin_amdgcn_global_load_lds((const unsigned*)((const char*)(gbase) + (voff)[_i]), (PG8_LAS unsigned*)(lds + (bufoff) + ldsw + _i * 8192), 16, 0, 0); } while (0)
#define PG8_LDA(dst, b, h) do { _Pragma("unroll") for (int m = 0; m < 4; ++m) _Pragma("unroll") for (int k = 0; k < 2; ++k) dst[m][k] = *(const PG8_LAS bf16x8*)(lds + PG8_SA(b, h) + aoff + m * 2048 + k * 1024); } while (0)
#define PG8_LDB(dst, b, h) do { _Pragma("unroll") for (int n = 0; n < 2; ++n) _Pragma("unroll") for (int k = 0; k < 2; ++k) dst[n][k] = *(const PG8_LAS bf16x8*)(lds + PG8_SB(b, h) + boff + n * 2048 + k * 1024); } while (0)
#define PG8_MMA(ai, bj, At, Bt) do { __builtin_amdgcn_s_setprio(1); _Pragma("unroll") for (int m = 0; m < 4; ++m) _Pragma("unroll") for (int n = 0; n < 2; ++n) _Pragma("unroll") for (int k = 0; k < 2; ++k) \
        acc[ai][bj][m][n] = __builtin_amdgcn_mfma_f32_16x16x32_bf16(Bt[n][k], At[m][k], acc[ai][bj][m][n], 0, 0, 0); __builtin_amdgcn_s_setprio(0); } while (0)
#define PG8_WAIT_V(n) asm volatile("s_waitcnt vmcnt(" #n ")" ::: "memory")
#define PG8_WAIT_L(n) asm volatile("s_waitcnt lgkmcnt(" #n ")" ::: "memory")
#define PG8_BAR __builtin_amdgcn_s_barrier()
#define PG8_SCHED __builtin_amdgcn_sched_barrier(0)
    Unit cur, nxt; int ui = 0;
    if (!S.next(0, cur)) return;
    f32x4 acc[2][2][4][2];
#pragma unroll
    for (int a = 0; a < 2; ++a)
#pragma unroll
        for (int b = 0; b < 2; ++b)
#pragma unroll
            for (int m = 0; m < 4; ++m)
#pragma unroll
                for (int n = 0; n < 2; ++n) acc[a][b][m][n] = (f32x4){0.f, 0.f, 0.f, 0.f};
    bf16x8 At[4][2], B0[2][2], B1[2][2];
    const char* cA = cur.A; const char* cB = cur.B;
    if constexpr (SP2) {
        PG8_STAGE(PG8_SB(0, 0), cB, voffB); PG8_STAGE(PG8_SB(0, 1), cB + hstepB, voffB); PG8_STAGE(PG8_SA(0, 0), cA, voffA); PG8_STAGE(PG8_SA(0, 1), cA + hstepA, voffA);
        if (wr == 1) PG8_BAR;
        PG8_WAIT_V(2); PG8_BAR;
        PG8_STAGE(PG8_SB(1, 0), cB + kstepB, voffB); PG8_STAGE(PG8_SA(1, 0), cA + kstepA, voffA); PG8_STAGE(PG8_SB(1, 1), cB + hstepB + kstepB, voffB);
        PG8_WAIT_V(6); PG8_BAR;
    } else {
        PG8_STAGE(PG8_SB(0, 0), cB, voffB); PG8_STAGE(PG8_SA(0, 0), cA, voffA); PG8_STAGE(PG8_SB(0, 1), cB + hstepB, voffB); PG8_STAGE(PG8_SA(0, 1), cA + hstepA, voffA);
        if (wr == 1) PG8_BAR;
        PG8_WAIT_V(4); PG8_BAR;
        PG8_STAGE(PG8_SB(1, 0), cB + kstepB, voffB); PG8_STAGE(PG8_SA(1, 0), cA + kstepA, voffA); PG8_STAGE(PG8_SB(1, 1), cB + hstepB + kstepB, voffB);
        PG8_WAIT_V(6); PG8_BAR;
    }
    for (;;) {
        const bool has_next = S.next(ui + 1, nxt);
        const char* nA = has_next ? nxt.A : cA; const char* nB = has_next ? nxt.B : cB;
        for (int t = 0; t < nt; t += 2) {
            const bool last = (t == nt - 2);
            const char* a1 = cA + (size_t)(t + 1) * kstepA;
            const char* a2 = last ? nA : cA + (size_t)(t + 2) * kstepA; const char* b2 = last ? nB : cB + (size_t)(t + 2) * kstepB;
            const char* a3 = a2 + kstepA; const char* b3 = b2 + kstepB;
            if constexpr (SP2) {
            PG8_LDB(B0, 0, 0); PG8_LDB(B1, 0, 1); PG8_SCHED; PG8_LDA(At, 0, 0); PG8_STAGE(PG8_SA(1, 1), a1 + hstepA, voffA);
            PG8_WAIT_V(8); PG8_WAIT_L(0); PG8_BAR; PG8_MMA(0, 0, At, B0); PG8_MMA(0, 1, At, B1); PG8_BAR; PG8_SCHED;
            PG8_LDA(At, 0, 1); PG8_STAGE(PG8_SB(0, 0), b2, voffB); PG8_STAGE(PG8_SB(0, 1), b2 + hstepB, voffB); PG8_STAGE(PG8_SA(0, 0), a2, voffA);
            PG8_WAIT_V(8); PG8_WAIT_L(0); PG8_BAR; PG8_MMA(1, 0, At, B0); PG8_MMA(1, 1, At, B1); PG8_BAR; PG8_SCHED;
            PG8_LDB(B0, 1, 0); PG8_LDB(B1, 1, 1); PG8_SCHED; PG8_LDA(At, 1, 0); PG8_STAGE(PG8_SA(0, 1), a2 + hstepA, voffA);
            PG8_WAIT_V(8); PG8_WAIT_L(0); PG8_BAR; PG8_MMA(0, 0, At, B0); PG8_MMA(0, 1, At, B1); PG8_BAR; PG8_SCHED;
            PG8_LDA(At, 1, 1); PG8_STAGE(PG8_SB(1, 0), b3, voffB); PG8_STAGE(PG8_SB(1, 1), b3 + hstepB, voffB); PG8_STAGE(PG8_SA(1, 0), a3, voffA);
            PG8_WAIT_V(8); PG8_WAIT_L(0); PG8_BAR; PG8_MMA(1, 0, At, B0); PG8_MMA(1, 1, At, B1); PG8_BAR; PG8_SCHED;
            } else {
            PG8_LDB(B0, 0, 0); PG8_SCHED; PG8_LDA(At, 0, 0); PG8_STAGE(PG8_SA(1, 1), a1 + hstepA, voffA);
            PG8_WAIT_L(8); PG8_BAR; PG8_WAIT_L(0); PG8_MMA(0, 0, At, B0); PG8_BAR; PG8_SCHED;
            PG8_LDB(B1, 0, 1); PG8_STAGE(PG8_SB(0, 0), b2, voffB);
            PG8_BAR; PG8_WAIT_L(0); PG8_MMA(0, 1, At, B1); PG8_BAR;
            PG8_LDA(At, 0, 1); PG8_STAGE(PG8_SA(0, 0), a2, voffA);
            PG8_BAR; PG8_WAIT_L(0); PG8_MMA(1, 0, At, B0); PG8_BAR; PG8_SCHED;
            PG8_STAGE(PG8_SB(0, 1), b2 + hstepB, voffB);
            PG8_WAIT_V(6); PG8_BAR; PG8_MMA(1, 1, At, B1); PG8_BAR;
            PG8_LDB(B0, 1, 0); PG8_SCHED; PG8_LDA(At, 1, 0); PG8_STAGE(PG8_SA(0, 1), a2 + hstepA, voffA);
            PG8_WAIT_L(8); PG8_BAR; PG8_WAIT_L(0); PG8_MMA(0, 0, At, B0); PG8_BAR; PG8_SCHED;
            PG8_LDB(B1, 1, 1); PG8_STAGE(PG8_SB(1, 0), b3, voffB);
            PG8_BAR; PG8_WAIT_L(0); PG8_MMA(0, 1, At, B1); PG8_BAR;
            PG8_LDA(At, 1, 1); PG8_STAGE(PG8_SA(1, 0), a3, voffA);
            PG8_BAR; PG8_WAIT_L(0); PG8_MMA(1, 0, At, B0); PG8_BAR; PG8_SCHED;
            PG8_STAGE(PG8_SB(1, 1), b3 + hstepB, voffB);
            PG8_WAIT_V(6); PG8_BAR; PG8_MMA(1, 1, At, B1); PG8_BAR;
            }
        }
        if constexpr (ALIGN_EPI) { if (wr == 0) PG8_BAR; }
        E(acc, cur, wr, wc, fr, fq);
        if (!has_next) break;
#pragma unroll
        for (int a = 0; a < 2; ++a)
#pragma unroll
            for (int b = 0; b < 2; ++b)
#pragma unroll
                for (int m = 0; m < 4; ++m)
#pragma unroll
                    for (int n = 0; n < 2; ++n) acc[a][b][m][n] = (f32x4){0.f, 0.f, 0.f, 0.f};
        cur = nxt; cA = nA; cB = nB; ++ui;
        if constexpr (ALIGN_EPI) { if (wr == 1) PG8_BAR; }
    }
    PG8_WAIT_V(0);
    if constexpr (!ALIGN_EPI) { if (wr == 0) PG8_BAR; }
    PG8_BAR;
#undef PG8_SA
#undef PG8_SB
#undef PG8_STAGE
#undef PG8_LDA
#undef PG8_LDB
#undef PG8_MMA
#undef PG8_WAIT_V
#undef PG8_WAIT_L
#undef PG8_BAR
#undef PG8_SCHED
}
}


struct SchedMN {
    int nM, nN, nz, G, c, pm_off; const char* A0; const char* A1; const char* B0; const char* B1; size_t a_tile, b_tile;
    __device__ __forceinline__ bool next(int i, pg8::Unit& u) const {
        int pm, pn; if (!pg8::tile_of((long)(i / nz) * G + c, nM, nN, pm, pn)) return false;
        u.z = i % nz; u.pm = pm + pm_off; u.pn = pn; u.A = (u.z ? A1 : A0) + (size_t)u.pm * a_tile; u.B = (u.z ? B1 : B0) + (size_t)pn * b_tile; return true;
    }
};
struct SchedCmp {
    int c; const char* proj; const char* w1k; const char* w1v;
    __device__ __forceinline__ bool next(int i, pg8::Unit& u) const {
        if (i > 0 || c >= 64) return false;
        const int ks = c & 3; u.pm = (c >> 2) & 3; u.z = c >> 4; u.pn = ks; const int which = u.z >> 1, kh = u.z & 1;
        u.A = proj + ((size_t)(16 * 256 * u.pm + 8 * ks) * PP + (which ? C_VC : C_KC) + kh * 64) * 2; u.B = (which ? w1v : w1k) + (size_t)ks * 512 * 2; return true;
    }
};

#define EPI_LOOP_ROWS for (int ai = 0; ai < 2; ++ai) _Pragma("unroll") for (int m = 0; m < 4; ++m)

struct EpiProj {
    static constexpr bool PERM = true;
    bf16_t* proj; bf16_t* vslt; bf16_t* vwnt; bf16_t* kslc; bf16_t* kwnc; const float* rstd; const float* ropec; const float* ropes;
    __device__ __forceinline__ void operator()(const f32x4 (&acc)[2][2][4][2], const pg8::Unit& u, int wr, int wc, int fr, int fq) const {
        const int pn = u.pn; const int row0 = u.pm * 256 + wr * 64 + fr;
        const bool sig = pn >= 7;
#pragma unroll
        EPI_LOOP_ROWS {
            const int row = row0 + ai * 128 + m * 16; const float rs = rstd[row];
            f32x4 c0 = {1.f, 1.f, 1.f, 1.f}, c1 = c0, s0 = {0.f, 0.f, 0.f, 0.f}, s1 = s0;
            if ((pn <= 1 || pn == 3 || pn == 4) && (wc & 1) == 0) { c0 = *(const f32x4*)(ropec + row * 8); c1 = *(const f32x4*)(ropec + row * 8 + 4); s0 = *(const f32x4*)(ropes + row * 8); s1 = *(const f32x4*)(ropes + row * 8 + 4); }
#pragma unroll
            for (int bj = 0; bj < 2; ++bj) {
                f32x4 v0 = acc[ai][bj][m][0] * rs, v1 = acc[ai][bj][m][1] * rs;
                const int colt = bj * 128 + wc * 32 + 8 * fq;
                const bool ropet = (pn <= 1) || ((pn == 3 || pn == 4) && bj == 0);
                if (ropet && (wc & 1) == 0) {
                    f32x4 p0, p1;
#pragma unroll
                    for (int e = 0; e < 4; ++e) { p0[e] = __shfl_xor(v0[e], 16); p1[e] = __shfl_xor(v1[e], 16); }
                    if (fq == 0) { v0 = v0 * c0 - p0 * s0; v1 = v1 * c1 - p1 * s1; }
                    else if (fq == 1) { v0 = v0 * c0 + p0 * s0; v1 = v1 * c1 + p1 * s1; }
                }
                if (pn <= 1) { v0 = v0 * (0.125f * 1.4426950408889634f); v1 = v1 * (0.125f * 1.4426950408889634f); }
                if (sig) {
#pragma unroll
                    for (int e = 0; e < 4; ++e) { v0[e] = sigmoidf_(v0[e]); v1[e] = sigmoidf_(v1[e]); }
                }
                const u32x4 w = pack8(v0, v1);
                if (!((pn == 3 || pn == 4))) *(u32x4*)(proj + (size_t)row * PP + pn * 256 + colt) = w;
                if ((pn == 3 || pn == 4) && bj == 0) { bf16_t* kc = (pn == 3) ? kslc : kwnc; *(u32x4*)(kc + ((size_t)(colt >> 6) * SEQ + row) * 64 + (colt & 63)) = w; }
                if ((pn == 3 || pn == 4) && bj == 1) {
                    bf16_t* vt = ((pn == 3) ? vslt : vwnt) + ((size_t)((colt - 128) >> 6) * 256 + (row >> 6)) * 4096 + (size_t)((colt - 128) & 63) * 64 + (row & 63);
                    vt[0 * 64] = (bf16_t)(w.x & 0xffff); vt[1 * 64] = (bf16_t)(w.x >> 16); vt[2 * 64] = (bf16_t)(w.y & 0xffff); vt[3 * 64] = (bf16_t)(w.y >> 16);
                    vt[4 * 64] = (bf16_t)(w.z & 0xffff); vt[5 * 64] = (bf16_t)(w.z >> 16); vt[6 * 64] = (bf16_t)(w.w & 0xffff); vt[7 * 64] = (bf16_t)(w.w >> 16);
                }
            }
        }
    }
};

struct EpiCmp {
    static constexpr bool PERM = true;
    float* hidp;
    __device__ __forceinline__ void operator()(const f32x4 (&acc)[2][2][4][2], const pg8::Unit& u, int wr, int wc, int fr, int fq) const {
        const int row0 = u.pm * 256 + wr * 64 + fr;
#pragma unroll
        for (int bj = 0; bj < 2; ++bj) {
            const int col = bj * 128 + wc * 32 + 8 * fq;
#pragma unroll
            EPI_LOOP_ROWS {
                const int row = row0 + ai * 128 + m * 16; float* d = hidp + (((size_t)u.pn * 4 + u.z) * 1024 + row) * 256 + col;
                *(f32x4*)d = acc[ai][bj][m][0]; *(f32x4*)(d + 4) = acc[ai][bj][m][1];
            }
        }
    }
};

struct EpiGlu {
    static constexpr bool PERM = true;
    const bf16_t* ybp; bf16_t* yb;
    __device__ __forceinline__ void operator()(const f32x4 (&acc)[2][2][4][2], const pg8::Unit& u, int wr, int wc, int fr, int fq) const {
        const int row0 = u.pm * 256 + wr * 64 + fr;
#pragma unroll
        EPI_LOOP_ROWS {
            const int row = row0 + ai * 128 + m * 16;
#pragma unroll
            for (int bj = 0; bj < 2; ++bj) {
                const size_t off = (size_t)row * 512 + u.pn * 256 + bj * 128 + wc * 32 + 8 * fq;
                const u32x4 y = *(const u32x4*)(ybp + off);
                f32x4 v0 = acc[ai][bj][m][0], v1 = acc[ai][bj][m][1];
                v0[0] = bf_lo(y.x) * sigmoidf_(v0[0]); v0[1] = bf_hi(y.x) * sigmoidf_(v0[1]); v0[2] = bf_lo(y.y) * sigmoidf_(v0[2]); v0[3] = bf_hi(y.y) * sigmoidf_(v0[3]);
                v1[0] = bf_lo(y.z) * sigmoidf_(v1[0]); v1[1] = bf_hi(y.z) * sigmoidf_(v1[1]); v1[2] = bf_lo(y.w) * sigmoidf_(v1[2]); v1[3] = bf_hi(y.w) * sigmoidf_(v1[3]);
                *(u32x4*)(yb + off) = pack8(v0, v1);
            }
        }
    }
};

struct EpiMerge {
    static constexpr bool PERM = true;
    const bf16_t* proj; bf16_t* merged;
    __device__ __forceinline__ void operator()(const f32x4 (&acc)[2][2][4][2], const pg8::Unit& u, int wr, int wc, int fr, int fq) const {
        const int row0 = u.pm * 256 + wr * 64 + fr; const int gcol = u.z ? C_GB : C_GA;
#pragma unroll
        EPI_LOOP_ROWS {
            const int row = row0 + ai * 128 + m * 16;
#pragma unroll
            for (int bj = 0; bj < 2; ++bj) {
                const int col = u.pn * 256 + bj * 128 + wc * 32 + 8 * fq;
                const u32x4 gt = *(const u32x4*)(proj + (size_t)row * PP + gcol + col);
                f32x4 v0 = acc[ai][bj][m][0], v1 = acc[ai][bj][m][1];
                v0[0] *= bf_lo(gt.x); v0[1] *= bf_hi(gt.x); v0[2] *= bf_lo(gt.y); v0[3] *= bf_hi(gt.y);
                v1[0] *= bf_lo(gt.z); v1[1] *= bf_hi(gt.z); v1[2] *= bf_lo(gt.w); v1[3] *= bf_hi(gt.w);
                bf16_t* dst = merged + (size_t)row * DM + col;
                if (u.z) { const u32x4 o = *(const u32x4*)dst;
                    v0[0] += bf_lo(o.x); v0[1] += bf_hi(o.x); v0[2] += bf_lo(o.y); v0[3] += bf_hi(o.y); v1[0] += bf_lo(o.z); v1[1] += bf_hi(o.z); v1[2] += bf_lo(o.w); v1[3] += bf_hi(o.w); }
                *(u32x4*)dst = pack8(v0, v1);
            }
        }
    }
};

struct EpiRes {
    static constexpr bool PERM = true;
    const float* xin; float* xo; bf16_t* xb; float* rss;
    __device__ __forceinline__ void operator()(const f32x4 (&acc)[2][2][4][2], const pg8::Unit& u, int wr, int wc, int fr, int fq) const {
        const int row0 = u.pm * 256 + wr * 64 + fr;
#pragma unroll
        EPI_LOOP_ROWS {
            const int row = row0 + ai * 128 + m * 16; float ss = 0.f;
#pragma unroll
            for (int bj = 0; bj < 2; ++bj) {
                const size_t off = (size_t)row * DM + u.pn * 256 + bj * 128 + wc * 32 + 8 * fq;
                const f32x4 v0 = *(const f32x4*)(xin + off) + acc[ai][bj][m][0], v1 = *(const f32x4*)(xin + off + 4) + acc[ai][bj][m][1];
                *(f32x4*)(xo + off) = v0; *(f32x4*)(xo + off + 4) = v1;
                if (xb) *(u32x4*)(xb + off) = pack8(v0, v1);
                ss += (v0[0] * v0[0] + v0[1] * v0[1]) + (v0[2] * v0[2] + v0[3] * v0[3]) + (v1[0] * v1[0] + v1[1] * v1[1]) + (v1[2] * v1[2] + v1[3] * v1[3]);
            }
            ss += __shfl_xor(ss, 16); ss += __shfl_xor(ss, 32);
            if (fq == 0) atomicAdd(rss + row, ss);
        }
    }
};

struct EpiUp {
    static constexpr bool PERM = true;
    bf16_t* up; const float* rss; int rowbase;
    __device__ __forceinline__ void operator()(const f32x4 (&acc)[2][2][4][2], const pg8::Unit& u, int wr, int wc, int fr, int fq) const {
        const int row0 = u.pm * 256 + wr * 64 + fr;
#pragma unroll
        EPI_LOOP_ROWS {
            const int row = row0 + ai * 128 + m * 16; const float rs = rsqrtf(rss[row] * (1.f / DM) + EPS);
#pragma unroll
            for (int bj = 0; bj < 2; ++bj) {
                const size_t off = (size_t)(row - rowbase) * NUP + u.pn * 256 + bj * 128 + wc * 32 + 8 * fq;
                *(u32x4*)(up + off) = pack8(acc[ai][bj][m][0] * rs, acc[ai][bj][m][1] * rs);
            }
        }
    }
};

struct Args { const float* in[28]; float* out; unsigned char* ws; };
constexpr int NT = 512, NWV = 8;
constexpr int LDS_BYTES = 147456;

__device__ __forceinline__ float wave_sum(float v) {
#pragma unroll
    for (int o = 1; o < 64; o <<= 1) v += __shfl_xor(v, o);
    return v;
}

#define XB_TMO      128
#define XB_XCNT(j)  (256  + 64 * (j))
#define XB_XSUB(j)  (1280 + 64 * (j))
#define XB_XGEN(j)  (2304 + 64 * (j))
#define XB_TOP      3328
#define XB_TOPGEN   3392
#define XCD_BAR_WORDS 3456
#define XB_SPIN_CAP (1u << 18)

__device__ __forceinline__ unsigned xb_ld(unsigned* p)              { return __hip_atomic_load(p, __ATOMIC_RELAXED, __HIP_MEMORY_SCOPE_AGENT); }
__device__ __forceinline__ unsigned xb_add(unsigned* p, unsigned v) { return __hip_atomic_fetch_add(p, v, __ATOMIC_RELAXED, __HIP_MEMORY_SCOPE_AGENT); }
__device__ __forceinline__ unsigned xb_xcc_id() { return (unsigned)__builtin_amdgcn_s_getreg((3 << 11) | 20) & 0xFu; }
#define XB_SPIN(cond, bar) do { unsigned _sp = 0; while (cond) { __builtin_amdgcn_s_sleep(1); \
    if ((++_sp & 255u) == 0u) { if (xb_ld(&(bar)[XB_TMO])) break; if (_sp > XB_SPIN_CAP) { atomicAdd(&(bar)[XB_TMO], 1u); break; } } } } while (0)

struct XcdBarrier {
    unsigned* bar; unsigned x;
    volatile LAS unsigned* st;
};

__device__ __forceinline__ XcdBarrier xcd_barrier_post(unsigned* bar, volatile LAS unsigned* st) {
    XcdBarrier b; b.bar = bar; b.x = xb_xcc_id(); b.st = st;
    if (threadIdx.x == 0) (void)xb_add(&bar[XB_XCNT(b.x)], 1u);
    return b;
}
__device__ __forceinline__ void xcd_barrier_complete(unsigned* bar, unsigned x, unsigned& nloc, unsigned& nx) {
    const unsigned G = gridDim.x * gridDim.y * gridDim.z;
    unsigned sum, cnt, mine, sp = 0u;
    for (;;) {
        sum = 0u; cnt = 0u; mine = 0u;
#pragma unroll
        for (unsigned j = 0; j < 16; ++j) { const unsigned c = xb_ld(&bar[XB_XCNT(j)]); sum += c; cnt += (c > 0u) ? 1u : 0u; mine = (j == x) ? c : mine; }
        if (sum == G) break;
        __builtin_amdgcn_s_sleep(1);
        if ((++sp & 255u) == 0u) { if (xb_ld(&bar[XB_TMO])) break; if (sp > XB_SPIN_CAP) { atomicAdd(&bar[XB_TMO], 1u); break; } }
    }
    nloc = mine > 0u ? mine : 1u; nx = cnt > 0u ? cnt : 1u;
}

__device__ __forceinline__ void xcd_barrier(const XcdBarrier& b) {
    asm volatile("s_waitcnt vmcnt(0)" ::: "memory");
    __syncthreads();
    if (threadIdx.x == 0) {
        unsigned* bar = b.bar;
        __builtin_amdgcn_s_waitcnt(0);
        unsigned nloc = b.st[0], nx = b.st[1];
        if (nloc == 0u) { xcd_barrier_complete(bar, b.x, nloc, nx); b.st[0] = nloc; b.st[1] = nx; }
        const unsigned old = xb_add(&bar[XB_XSUB(b.x)], 1u);
        const unsigned gen = old / nloc;
        if (old + 1u == (gen + 1u) * nloc) {
            __builtin_amdgcn_fence(__ATOMIC_RELEASE, "agent");
            asm volatile("s_waitcnt vmcnt(0)" ::: "memory");
            const unsigned og = xb_add(&bar[XB_TOP], 1u);
            const unsigned tg = og / nx;
            if (og + 1u == (tg + 1u) * nx) xb_add(&bar[XB_TOPGEN], 1u);
            else XB_SPIN(xb_ld(&bar[XB_TOPGEN]) == tg, bar);
            __builtin_amdgcn_fence(__ATOMIC_ACQUIRE, "agent");
            xb_add(&bar[XB_XGEN(b.x)], 1u);
            asm volatile("s_waitcnt vmcnt(0)" ::: "memory");
        } else {
            XB_SPIN(xb_ld(&bar[XB_XGEN(b.x)]) == gen, bar);
            __builtin_amdgcn_fence(__ATOMIC_ACQUIRE, "agent");
            asm volatile("s_waitcnt vmcnt(0)" ::: "memory");
        }
    }
    __syncthreads();
}

__device__ __forceinline__ int colmap(int kind, int c) {
    if (kind == 1) return c < 1280 ? c : (c < 1304 ? C_NG + (c - 1280) : c - 24);
    if (kind == 2) { return c < DFF ? (c >> 7) * 256 + (c & 127) : ((c - DFF) >> 7) * 256 + 128 + ((c - DFF) & 127); }
    return c;
}
__device__ __forceinline__ void transpose_item(const float* W, int K, int N, bf16_t* WT, LAS float* scr, int kb, int nb, int lane, const float* kscale, int kind) {
    const int k0 = 64 * kb, n0 = 32 * nb;
#pragma unroll 8
    for (int i = 0; i < 32; ++i) { const int kk = 2 * i + (lane >> 5), n = n0 + (lane & 31); float v = (n < N) ? W[(size_t)(k0 + kk) * N + n] : 0.f; if (kscale) v *= kscale[k0 + kk]; scr[kk * 33 + (lane & 31)] = v; }
    asm volatile("s_waitcnt lgkmcnt(0)" ::: "memory");
    const int c = lane & 7;
#pragma unroll
    for (int j = 0; j < 4; ++j) { const int n = (lane >> 3) + 8 * j; const LAS float* s = scr + (8 * c) * 33 + n;
        if (n0 + n < N) { u32x4 o; o.x = cvt_pk_bf16(s[0 * 33], s[1 * 33]); o.y = cvt_pk_bf16(s[2 * 33], s[3 * 33]); o.z = cvt_pk_bf16(s[4 * 33], s[5 * 33]); o.w = cvt_pk_bf16(s[6 * 33], s[7 * 33]);
            *(u32x4*)(WT + (size_t)colmap(kind, n0 + n) * K + k0 + 8 * c) = o; } }
    asm volatile("s_waitcnt lgkmcnt(0)" ::: "memory");
}

#define EXP2(x) __builtin_amdgcn_exp2f(x)
#define MFMA16(a, b, c) __builtin_amdgcn_mfma_f32_16x16x32_bf16((a), (b), (c), 0, 0, 0)
__device__ __forceinline__ float dpp_x1(float v) { return __int_as_float(__builtin_amdgcn_update_dpp(0, __float_as_int(v), 0xB1, 0xF, 0xF, true)); }
__device__ __forceinline__ float dpp_x2(float v) { return __int_as_float(__builtin_amdgcn_update_dpp(0, __float_as_int(v), 0x4E, 0xF, 0xF, true)); }
struct KOp { bf16x8 a00, a01, a10, a11; };
struct VOp { bf16x8 v0, v1, v2, v3; };
__device__ __forceinline__ KOp ldk(const bf16_t* Kb, size_t pitch, int kb, int lane) {
    const int i = lane & 15, q = lane >> 4;
    const bf16_t* r0 = Kb + (size_t)(kb + 8 * (i >> 2) + (i & 3)) * pitch + 8 * q; const bf16_t* r1 = r0 + 4 * pitch;
    KOp k; k.a00 = *(const bf16x8*)r0; k.a01 = *(const bf16x8*)(r0 + 32); k.a10 = *(const bf16x8*)r1; k.a11 = *(const bf16x8*)(r1 + 32); return k;
}
__device__ __forceinline__ VOp ldv(const bf16_t* Vt, size_t vpitch, int kb, int lane) {
    const int i = lane & 15, q = lane >> 4; const size_t base = (vpitch == 64) ? (size_t)(kb >> 6) * 4096 + (kb & 63) : (size_t)kb;
    const bf16_t* r = Vt + base + (size_t)i * vpitch + 8 * q;
    VOp v; v.v0 = *(const bf16x8*)r; v.v1 = *(const bf16x8*)(r + 16 * vpitch); v.v2 = *(const bf16x8*)(r + 32 * vpitch); v.v3 = *(const bf16x8*)(r + 48 * vpitch); return v;
}
__device__ __forceinline__ void qk32(const KOp& k, const bf16x8& Bq0, const bf16x8& Bq1, f32x4& S0, f32x4& S1) {
    const f32x4 z = {0.f, 0.f, 0.f, 0.f};
    S0 = MFMA16(k.a00, Bq0, z); S0 = MFMA16(k.a01, Bq1, S0); S1 = MFMA16(k.a10, Bq0, z); S1 = MFMA16(k.a11, Bq1, S1);
}
__device__ __forceinline__ void pv32(const VOp& v, const bf16x8& P, f32x4 (&O)[4]) {
    O[0] = MFMA16(v.v0, P, O[0]); O[1] = MFMA16(v.v1, P, O[1]); O[2] = MFMA16(v.v2, P, O[2]); O[3] = MFMA16(v.v3, P, O[3]);
}
__device__ __forceinline__ bf16x8 packP(const f32x4& p0, const f32x4& p1) { u32x4 w = pack8(p0, p1); return __builtin_bit_cast(bf16x8, w); }

struct KbLin { int base; __device__ __forceinline__ int operator()(int i) const { return base + 32 * i; } };
struct KbLds { const LAS int* l; __device__ __forceinline__ int operator()(int i) const { return l[i]; } };

template <bool NEEDV, class KB, class Body>
__device__ __forceinline__ void pipe3(int n, const KB kbf, Body& body, const bf16_t* Kb, size_t kp, const bf16_t* Vt, size_t vp, int lane) {
    if (n <= 0) return;
    KOp k0, k1; VOp v;
    k0 = ldk(Kb, kp, kbf(0), lane);
    for (int i = 0; i < n; i += 2) {
        { const int kb = kbf(i); if (NEEDV) v = ldv(Vt, vp, kb, lane); k1 = ldk(Kb, kp, kbf(i + 1 < n ? i + 1 : n - 1), lane); body.run(kb, k0, v); }
        if (i + 1 >= n) break;
        { const int kb = kbf(i + 1); if (NEEDV) v = ldv(Vt, vp, kb, lane); k0 = ldk(Kb, kp, kbf(i + 2 < n ? i + 2 : n - 1), lane); body.run(kb, k1, v); }
    }
}

constexpr int AL_CKV = 81920  , CKV_HALF = 9216, CKV_BUF = 18432;
template <bool NEEDV, class Body>
__device__ __forceinline__ void cmp_shared(int nsteps, Body& body, const bf16_t* Kc, const bf16_t* Vc, LAS unsigned char* buf, int tid, int lane, int kb0 = 0, int vrp = 1024, int vcs = 64, int vch0 = 0) {
    const int nch = (nsteps + 1) >> 1; if (nch <= 0) return;
    const int srow = tid >> 3, spc = tid & 7, i = lane & 15, q = lane >> 4;
    u32x4 rk = *(const u32x4*)(Kc + (size_t)(kb0 + srow) * 64 + spc * 8), rv = rk;
    if (NEEDV) rv = *(const u32x4*)(Vc + (size_t)srow * vrp + (size_t)vch0 * vcs + spc * 8);
    *(LAS u32x4*)(buf + srow * 144 + spc * 16) = rk; if (NEEDV) *(LAS u32x4*)(buf + CKV_HALF + srow * 144 + spc * 16) = rv;
    __syncthreads();
    for (int ch = 0; ch < nch; ++ch) {
        const LAS unsigned char* cur = buf + (ch & 1) * CKV_BUF; LAS unsigned char* nxt = buf + ((ch + 1) & 1) * CKV_BUF;
        const bool more = ch + 1 < nch;
        if (more) { rk = *(const u32x4*)(Kc + (size_t)(kb0 + 64 * (ch + 1) + srow) * 64 + spc * 8); if (NEEDV) rv = *(const u32x4*)(Vc + (size_t)srow * vrp + (size_t)(vch0 + ch + 1) * vcs + spc * 8); }
#pragma unroll
        for (int h = 0; h < 2; ++h) {
            const int st = 2 * ch + h;
            if (st < nsteps) {
                const LAS unsigned char* kr = cur + (32 * h + 8 * (i >> 2) + (i & 3)) * 144 + 16 * q;
                KOp k; k.a00 = *(const LAS bf16x8*)kr; k.a01 = *(const LAS bf16x8*)(kr + 64); k.a10 = *(const LAS bf16x8*)(kr + 4 * 144); k.a11 = *(const LAS bf16x8*)(kr + 4 * 144 + 64);
                VOp v; if (NEEDV) { const LAS unsigned char* vr = cur + CKV_HALF + i * 144 + (32 * h + 8 * q) * 2;
                    v.v0 = *(const LAS bf16x8*)vr; v.v1 = *(const LAS bf16x8*)(vr + 16 * 144); v.v2 = *(const LAS bf16x8*)(vr + 32 * 144); v.v3 = *(const LAS bf16x8*)(vr + 48 * 144); }
                else { v.v0 = k.a00; v.v1 = k.a00; v.v2 = k.a00; v.v3 = k.a00; }
                body.run(kb0 + 32 * st, k, v);
            }
        }
        if (more) { *(LAS u32x4*)(nxt + srow * 144 + spc * 16) = rk; if (NEEDV) *(LAS u32x4*)(nxt + CKV_HALF + srow * 144 + spc * 16) = rv; }
        __syncthreads();
    }
}

struct BodyCmp1 {
    bf16x8 Bq[2][2]; int nv[2], q; float ml[2], ll[2];
    __device__ __forceinline__ void run(int kb, const KOp& k, const VOp&) {
#pragma unroll
        for (int cg = 0; cg < 2; ++cg) {
            f32x4 S0, S1; qk32(k, Bq[cg][0], Bq[cg][1], S0, S1);
            const int k0 = kb + 8 * q; float mloc = NEGF;
#pragma unroll
            for (int e = 0; e < 4; ++e) { if (k0 + e >= nv[cg]) S0[e] = NEGF; if (k0 + 4 + e >= nv[cg]) S1[e] = NEGF; mloc = fmaxf(mloc, fmaxf(S0[e], S1[e])); }
            const float mn = fmaxf(ml[cg], mloc); float ps = 0.f;
#pragma unroll
            for (int e = 0; e < 4; ++e) { ps += (k0 + e < nv[cg]) ? EXP2(S0[e] - mn) : 0.f; ps += (k0 + 4 + e < nv[cg]) ? EXP2(S1[e] - mn) : 0.f; }
            ll[cg] = ll[cg] * EXP2(ml[cg] - mn) + ps; ml[cg] = mn;
        }
    }
};
struct BodyCmp2 {
    bf16x8 Bq[2][2]; int nv[2], q, g, lane_; float mc[2], inv[2], carry[2]; LAS float* ia[2]; f32x4 O[2][4];
    __device__ __forceinline__ void run(int kb, const KOp& k, const VOp& v) {
#pragma unroll
        for (int cg = 0; cg < 2; ++cg) {
            f32x4 S0, S1; qk32(k, Bq[cg][0], Bq[cg][1], S0, S1);
            const int k0 = kb + 8 * q; f32x4 p0, p1;
#pragma unroll
            for (int e = 0; e < 4; ++e) { p0[e] = (k0 + e < nv[cg]) ? EXP2(S0[e] - mc[cg]) * inv[cg] : 0.f; p1[e] = (k0 + 4 + e < nv[cg]) ? EXP2(S1[e] - mc[cg]) * inv[cg] : 0.f; }
            f32x4 s0 = p0, s1 = p1;
#pragma unroll
            for (int e = 0; e < 4; ++e) { s0[e] += dpp_x1(s0[e]); s0[e] += dpp_x2(s0[e]); s1[e] += dpp_x1(s1[e]); s1[e] += dpp_x2(s1[e]); }
            const float bout = 0.5f * s1[3]; const float recv = __shfl(bout, (lane_ + 48) & 63); const float bin = (q == 0) ? carry[cg] : recv; carry[cg] = recv;
            if (g == 0) { const int j = k0 >> 2; ia[cg][j] = ((s0[0] + s0[1]) + (s0[2] + 0.5f * s0[3])) + bin; ia[cg][j + 1] = 0.5f * s0[3] + ((s1[0] + s1[1]) + (s1[2] + 0.5f * s1[3])); }
            pv32(v, packP(p0, p1), O[cg]);
        }
    }
};
struct BodyWin {
    bf16x8 Bq[2][2]; int q, tt[2]; float m[2], l[2]; f32x4 O[2][4];
    __device__ __forceinline__ void run(int kb, const KOp& k, const VOp& v) {
#pragma unroll
        for (int cg = 0; cg < 2; ++cg) {
            f32x4 S0, S1; qk32(k, Bq[cg][0], Bq[cg][1], S0, S1);
            const int k0 = kb + 8 * q; unsigned vm = 0u;
#pragma unroll
            for (int e = 0; e < 8; ++e) { const bool ok = (k0 + e <= tt[cg]) && (tt[cg] - (k0 + e) < 512); vm |= ok ? (1u << e) : 0u; }
            float mloc = NEGF;
#pragma unroll
            for (int e = 0; e < 4; ++e) { if (!((vm >> e) & 1u)) S0[e] = NEGF; if (!((vm >> (4 + e)) & 1u)) S1[e] = NEGF; mloc = fmaxf(mloc, fmaxf(S0[e], S1[e])); }
            mloc = fmaxf(mloc, __shfl_xor(mloc, 16)); mloc = fmaxf(mloc, __shfl_xor(mloc, 32));
            const float mn = fmaxf(m[cg], mloc), alpha = EXP2(m[cg] - mn); m[cg] = mn;
            f32x4 p0, p1; float ps = 0.f;
#pragma unroll
            for (int e = 0; e < 4; ++e) { p0[e] = ((vm >> e) & 1u) ? EXP2(S0[e] - mn) : 0.f; p1[e] = ((vm >> (4 + e)) & 1u) ? EXP2(S1[e] - mn) : 0.f; ps += p0[e] + p1[e]; }
            l[cg] = l[cg] * alpha + ps;
#pragma unroll
            for (int dt = 0; dt < 4; ++dt) O[cg][dt] = O[cg][dt] * alpha;
            pv32(v, packP(p0, p1), O[cg]);
        }
    }
};

struct AttnT { float fxs; unsigned long long* tsa; const bf16_t* proj; const bf16_t* kslc; const bf16_t* kwnc; const bf16_t* kcmp; const bf16_t* vcmpT; const bf16_t* vslT; const bf16_t* vwnT; bf16_t* ya; };

constexpr int AL_IMP = 0  , AL_OS = 0  , AL_TM = 67584  , AL_CNT = 69632  ,
              AL_OFF = 70656  , AL_UNITS = 71744  , AL_MM = 77888  , AL_LS = 78912  ;
constexpr int AL_Q = 81920  , QROWB = 528;
constexpr int OSP = 33;
constexpr float FXB = 67108864.0f;
typedef short s16x2 __attribute__((ext_vector_type(2)));
__device__ __forceinline__ int f2ord(float f) { const int b = __float_as_int(f); return b >= 0 ? b : b ^ 0x7fffffff; }
__device__ __forceinline__ float ord2f(int b) { return __int_as_float(b >= 0 ? b : b ^ 0x7fffffff); }

__device__ __forceinline__ void attn_wave_part1(const AttnT& T, int kh, int tq8, int lane, LAS float* imp  , LAS unsigned* tm, int wave, LAS unsigned char* lds, int tid) {
    const int col = lane & 15, q = lane >> 4, tk = col >> 2, g = col & 3;
    const int t0 = tq8 * 8, h = kh * 4 + g;
    bf16x8 Bq[2][2]; float g0[2], g2[2]; int tcg[2];
#pragma unroll
    for (int cg = 0; cg < 2; ++cg) { tcg[cg] = t0 + 4 * cg + tk; const bf16_t* prow = T.proj + (size_t)tcg[cg] * PP;
        Bq[cg][0] = *(const bf16x8*)(prow + C_Q + h * 64 + 8 * q); Bq[cg][1] = *(const bf16x8*)(prow + C_Q + h * 64 + 32 + 8 * q);
        g0[cg] = bf2f(prow[C_NG + h * 3 + 0]); g2[cg] = bf2f(prow[C_NG + h * 3 + 2]); }
    for (int i = lane; i < 8 * 264; i += 64) imp[i] = 0.f;
    {
        const bf16_t* Kc = T.kcmp + (size_t)kh * 1024 * 64; const bf16_t* Vc = T.vcmpT + (size_t)kh * 64 * 1024;
        const int tmax = (t0 | 63), nvmax = tmax >= 31 ? ((tmax - 31) >> 4) + 1 : 0, nsteps = (nvmax + 31) >> 5;
        BodyCmp1 b1;
#pragma unroll
        for (int cg = 0; cg < 2; ++cg) { b1.Bq[cg][0] = Bq[cg][0]; b1.Bq[cg][1] = Bq[cg][1]; b1.nv[cg] = tcg[cg] >= 31 ? ((tcg[cg] - 31) >> 4) + 1 : 0; b1.ml[cg] = NEGF; b1.ll[cg] = 0.f; }
        b1.q = q;
        cmp_shared<false>(nsteps, b1, Kc, Vc, lds + AL_CKV, tid, lane);
        BodyCmp2 b2; b2.q = q; b2.g = g; b2.lane_ = lane; b2.carry[0] = 0.f; b2.carry[1] = 0.f;
#pragma unroll
        for (int cg = 0; cg < 2; ++cg) {
            float mc = fmaxf(b1.ml[cg], __shfl_xor(b1.ml[cg], 16)); mc = fmaxf(mc, __shfl_xor(mc, 32));
            float lc = b1.ll[cg] * EXP2(b1.ml[cg] - mc); lc += __shfl_xor(lc, 16); lc += __shfl_xor(lc, 32);
            b2.Bq[cg][0] = Bq[cg][0]; b2.Bq[cg][1] = Bq[cg][1]; b2.nv[cg] = b1.nv[cg]; b2.mc[cg] = mc; b2.inv[cg] = 1.f / fmaxf(lc, 1e-30f); b2.ia[cg] = imp + (4 * cg + tk) * 264;
#pragma unroll
            for (int dt = 0; dt < 4; ++dt) b2.O[cg][dt] = (f32x4){0.f, 0.f, 0.f, 0.f};
        }
        asm volatile("s_waitcnt lgkmcnt(0)" ::: "memory");
        cmp_shared<true>(nsteps, b2, Kc, Vc, lds + AL_CKV, tid, lane);
        if (q == 0 && g == 0 && nsteps > 0) { b2.ia[0][8 * nsteps] = b2.carry[0]; b2.ia[1][8 * nsteps] = b2.carry[1]; }
#pragma unroll
        for (int cg = 0; cg < 2; ++cg) { bf16_t* yrow = T.ya + (size_t)tcg[cg] * 512 + h * 64 + 4 * q;
#pragma unroll
            for (int dt = 0; dt < 4; ++dt) { const f32x4 o = b2.O[cg][dt] * g0[cg]; u32x2 w; w.x = cvt_pk_bf16(o[0], o[1]); w.y = cvt_pk_bf16(o[2], o[3]); *(u32x2*)(yrow + 16 * dt) = w; } }
    }
    asm volatile("s_waitcnt lgkmcnt(0)" ::: "memory");
    for (int tk2 = 0; tk2 < 8; ++tk2) {
        const int tt = t0 + tk2, cur = tt >> 6, nvalid = cur + 1, KSEL = nvalid < 16 ? nvalid : 16;
        int bits[4];
#pragma unroll
        for (int s = 0; s < 4; ++s) { const int j = s * 64 + lane; const float v = imp[tk2 * 264 + j];
            bits[s] = (j == 0 || j == cur) ? 0x7F000000 : (j < nvalid ? __float_as_int(v) : -1); }
        int prefix = 0;
        for (int bit = 30; bit >= 0; --bit) { const int Tt = prefix | (1 << bit); int cnt = 0;
#pragma unroll
            for (int s = 0; s < 4; ++s) cnt += __popcll(__ballot(bits[s] >= Tt));
            if (cnt >= KSEL) prefix = Tt; }
        unsigned long long sel[4]; int need = KSEL;
#pragma unroll
        for (int s = 0; s < 4; ++s) { sel[s] = __ballot(bits[s] > prefix); need -= __popcll(sel[s]); }
#pragma unroll
        for (int s = 0; s < 4; ++s) { unsigned long long me = __ballot(bits[s] == prefix);
            while (me != 0ull && need > 0) { const unsigned long long low = me & (0ull - me); sel[s] |= low; me ^= low; --need; } }
        const int tbi = wave * 8 + tk2; const unsigned tbit = 1u << (tbi & 31);
#pragma unroll
        for (int s = 0; s < 4; ++s) if ((sel[s] >> lane) & 1ull) __hip_atomic_fetch_or(tm + (s * 64 + lane) * 2 + (tbi >> 5), tbit, __ATOMIC_RELAXED, __HIP_MEMORY_SCOPE_WORKGROUP);
    }
    {
        const bf16_t* Kw = T.kwnc + (size_t)kh * SEQ * 64; const bf16_t* Vw = T.vwnT + (size_t)kh * 256 * 4096;
        const int tb = t0 & ~63; const int klo = (tb - 511 > 0 ? tb - 511 : 0) & ~63; const int n = ((tb + 63 - klo) >> 5) + 1;
        BodyWin bo; bo.q = q;
#pragma unroll
        for (int cg = 0; cg < 2; ++cg) { bo.Bq[cg][0] = Bq[cg][0]; bo.Bq[cg][1] = Bq[cg][1]; bo.tt[cg] = tcg[cg]; bo.m[cg] = NEGF; bo.l[cg] = 0.f;
#pragma unroll
            for (int dt = 0; dt < 4; ++dt) bo.O[cg][dt] = (f32x4){0.f, 0.f, 0.f, 0.f}; }
        cmp_shared<true>(n, bo, Kw, Vw, lds + AL_CKV, tid, lane, klo, 64, 4096, klo >> 6);
#pragma unroll
        for (int cg = 0; cg < 2; ++cg) { float l = bo.l[cg]; l += __shfl_xor(l, 16); l += __shfl_xor(l, 32);
            const float sc = g2[cg] / fmaxf(l, 1e-30f); bf16_t* yrow = T.ya + (size_t)tcg[cg] * 512 + h * 64 + 4 * q;
#pragma unroll
            for (int dt = 0; dt < 4; ++dt) { const u32x2 y = *(const u32x2*)(yrow + 16 * dt); const f32x4 o = bo.O[cg][dt] * sc;
                u32x2 w; w.x = cvt_pk_bf16(bf_lo(y.x) + o[0], bf_hi(y.x) + o[1]); w.y = cvt_pk_bf16(bf_lo(y.y) + o[2], bf_hi(y.y) + o[3]); *(u32x2*)(yrow + 16 * dt) = w; } }
    }
    asm volatile("s_waitcnt lgkmcnt(0)" ::: "memory");
}

struct UnitPre { int j; unsigned tlo, thi; bf16x8 q00, q01, q10, q11; KOp ka, kb; VOp va, vb; };
template <int PASS>
__device__ __forceinline__ UnitPre unit_load(const LAS unsigned char* qlds, const bf16_t* Ks, const bf16_t* Vs, int kh, int tile, const LAS u32x4* units, int u, int lane) {
    const int col = lane & 15, q = lane >> 4, slot = col >> 2, g = col & 3;
    const u32x4 d = units[u]; UnitPre P; P.j = __builtin_amdgcn_readfirstlane((int)d.x); P.tlo = (unsigned)__builtin_amdgcn_readfirstlane((int)d.y); P.thi = (unsigned)__builtin_amdgcn_readfirstlane((int)d.z);
    const unsigned t0b = (P.tlo >> (8 * slot)) & 0xffu, t1b = (P.thi >> (8 * slot)) & 0xffu;
    const LAS unsigned char* qr0 = qlds + (t0b == 0xffu ? 0 : (int)t0b) * QROWB + g * 128 + 16 * q;
    const LAS unsigned char* qr1 = qlds + (t1b == 0xffu ? 0 : (int)t1b) * QROWB + g * 128 + 16 * q;
    P.q00 = *(const LAS bf16x8*)qr0; P.q01 = *(const LAS bf16x8*)(qr0 + 64); P.q10 = *(const LAS bf16x8*)qr1; P.q11 = *(const LAS bf16x8*)(qr1 + 64);
    P.ka = ldk(Ks, 64, 64 * P.j, lane); P.kb = ldk(Ks, 64, 64 * P.j + 32, lane);
    if (PASS == 1) { if ((EXPV) == 2) { P.va.v0 = P.ka.a00; P.va.v1 = P.ka.a01; P.va.v2 = P.ka.a10; P.va.v3 = P.ka.a11; P.vb = P.va; } else { P.va = ldv(Vs, 64, 64 * P.j, lane); P.vb = ldv(Vs, 64, 64 * P.j + 32, lane); } }
    return P;
}
template <int PASS>
__device__ __forceinline__ void unit_group(const UnitPre& P, const bf16x8& q0, const bf16x8& q1, unsigned toks, int tile, LAS unsigned char* lds, float fxs, int lane) {
    const int col = lane & 15, q = lane >> 4, slot = col >> 2, g = col & 3;
    const int ti = (int)((toks >> (8 * slot)) & 0xffu);
    f32x4 S0a, S1a, S0b, S1b; qk32(P.ka, q0, q1, S0a, S1a); qk32(P.kb, q0, q1, S0b, S1b);
    const bool valid = ti != 0xff; const int row = (valid ? ti : 0) * 4 + g;
    const int lim = (P.j == tile) ? (valid ? ti : -1) - 8 * q : (valid ? 1000 : -1);
    LAS int* mm = (LAS int*)(lds + AL_MM); LAS float* ls = (LAS float*)(lds + AL_LS);
    if (PASS == 0) {
        float mloc = NEGF;
#pragma unroll
        for (int e = 0; e < 4; ++e) { mloc = fmaxf(mloc, e <= lim ? S0a[e] : NEGF); mloc = fmaxf(mloc, e + 4 <= lim ? S1a[e] : NEGF); mloc = fmaxf(mloc, e + 32 <= lim ? S0b[e] : NEGF); mloc = fmaxf(mloc, e + 36 <= lim ? S1b[e] : NEGF); }
        if ((EXPV) != 4) { mloc = fmaxf(mloc, __shfl_xor(mloc, 16)); mloc = fmaxf(mloc, __shfl_xor(mloc, 32)); }
        if (q == 0 && valid && (EXPV) != 3) __hip_atomic_fetch_max(mm + row, f2ord(mloc), __ATOMIC_RELAXED, __HIP_MEMORY_SCOPE_WORKGROUP);
    } else {
        const float m = ord2f(mm[row]);
        f32x4 p0a, p1a, p0b, p1b; float ps = 0.f;
#pragma unroll
        for (int e = 0; e < 4; ++e) { p0a[e] = e <= lim ? EXP2(S0a[e] - m) : 0.f; p1a[e] = e + 4 <= lim ? EXP2(S1a[e] - m) : 0.f; p0b[e] = e + 32 <= lim ? EXP2(S0b[e] - m) : 0.f; p1b[e] = e + 36 <= lim ? EXP2(S1b[e] - m) : 0.f;
            ps += (p0a[e] + p1a[e]) + (p0b[e] + p1b[e]); }
        ps += __shfl_xor(ps, 16); ps += __shfl_xor(ps, 32);
        if (q == 0 && valid) __hip_atomic_fetch_add(ls + row, ps, __ATOMIC_RELAXED, __HIP_MEMORY_SCOPE_WORKGROUP);
        f32x4 O[4];
#pragma unroll
        for (int dt = 0; dt < 4; ++dt) O[dt] = (f32x4){0.f, 0.f, 0.f, 0.f};
        pv32(P.va, packP(p0a, p1a), O); pv32(P.vb, packP(p0b, p1b), O);
        if (valid) { LAS unsigned long long* orow = (LAS unsigned long long*)(lds + AL_OS) + row * OSP + 2 * q;
#pragma unroll
            for (int dt = 0; dt < 4; ++dt) {
                const unsigned a0 = (unsigned)((int)rintf(O[dt][0] * fxs) + (1 << 26)), a1 = (unsigned)((int)rintf(O[dt][1] * fxs) + (1 << 26)), a2 = (unsigned)((int)rintf(O[dt][2] * fxs) + (1 << 26)), a3 = (unsigned)((int)rintf(O[dt][3] * fxs) + (1 << 26));
                __hip_atomic_fetch_add(orow + 8 * dt, (unsigned long long)a0 | ((unsigned long long)a1 << 32), __ATOMIC_RELAXED, __HIP_MEMORY_SCOPE_WORKGROUP);
                __hip_atomic_fetch_add(orow + 8 * dt + 1, (unsigned long long)a2 | ((unsigned long long)a3 << 32), __ATOMIC_RELAXED, __HIP_MEMORY_SCOPE_WORKGROUP); } }
    }
}
template <int PASS>
__device__ __forceinline__ void unit_compute(const UnitPre& P, int tile, LAS unsigned char* lds, float fxs, int lane) {
    unit_group<PASS>(P, P.q00, P.q01, P.tlo, tile, lds, fxs, lane);
    if (P.thi != 0xffffffffu) unit_group<PASS>(P, P.q10, P.q11, P.thi, tile, lds, fxs, lane);
}
template <int PASS>
__device__ __forceinline__ void unit_pass(const AttnT& T, int kh, int tile, int n, LAS unsigned char* lds, int wave, int lane) {
    const bf16_t* Ks = T.kslc + (size_t)kh * SEQ * 64; const bf16_t* Vs = T.vslT + (size_t)kh * 256 * 4096;
    const LAS u32x4* units = (const LAS u32x4*)(lds + AL_UNITS);
    int u = wave; if (u >= n) return;
    UnitPre A = unit_load<PASS>(lds + AL_Q, Ks, Vs, kh, tile, units, u, lane), B = A;
    for (; u < n; u += 16) {
        const int u1 = u + 8; if (u1 < n) B = unit_load<PASS>(lds + AL_Q, Ks, Vs, kh, tile, units, u1, lane);
        unit_compute<PASS>(A, tile, lds, T.fxs, lane);
        if (u1 >= n) break;
        const int u2 = u + 16; if (u2 < n) A = unit_load<PASS>(lds + AL_Q, Ks, Vs, kh, tile, units, u2, lane);
        unit_compute<PASS>(B, tile, lds, T.fxs, lane);
    }
}

__device__ __forceinline__ void attn_tile(const AttnT& T, int kh, int tile, LAS unsigned char* lds, int tid, int wave, int lane) {
    LAS unsigned* tm = (LAS unsigned*)(lds + AL_TM);
    for (int i = tid; i < 512; i += NT) tm[i] = 0u;
    __syncthreads();
    if ((TSK) >= 20 && blockIdx.x == 0 && threadIdx.x == 0) T.tsa[15] = __builtin_amdgcn_s_memrealtime();
    attn_wave_part1(T, kh, tile * 8 + wave, lane, (LAS float*)(lds + AL_IMP + wave * 8448), tm, wave, lds, tid);
    __threadfence_block(); __syncthreads();
    { const int ti = tid >> 3, part = tid & 7; const u32x4* src = (const u32x4*)(T.proj + (size_t)(tile * 64 + ti) * PP + C_Q + kh * 256 + part * 32); LAS u32x4* dst = (LAS u32x4*)(lds + AL_Q + ti * QROWB + part * 64);
      dst[0] = src[0]; dst[1] = src[1]; dst[2] = src[2]; dst[3] = src[3]; }
    ASTAMP(0);
    LAS int* cnt = (LAS int*)(lds + AL_CNT); LAS int* off = (LAS int*)(lds + AL_OFF); LAS u32x4* units = (LAS u32x4*)(lds + AL_UNITS);
    for (int i = tid; i < 256 * OSP; i += NT) ((LAS unsigned long long*)(lds + AL_OS))[i] = 0ull;
    if (tid < 256) { ((LAS int*)(lds + AL_MM))[tid] = f2ord(NEGF); ((LAS float*)(lds + AL_LS))[tid] = 0.f; cnt[tid] = (__popc(tm[2 * tid]) + __popc(tm[2 * tid + 1]) + 7) >> 3; }
    __syncthreads();
    if (tid < 64) {
        const int c0 = cnt[4 * tid], c1 = cnt[4 * tid + 1], c2 = cnt[4 * tid + 2], c3 = cnt[4 * tid + 3]; const int tot = (c0 + c1) + (c2 + c3); int inc = tot;
#pragma unroll
        for (int o = 1; o < 64; o <<= 1) { const int v = __shfl_up(inc, o); if (tid >= o) inc += v; }
        const int ex = inc - tot; off[4 * tid] = ex; off[4 * tid + 1] = ex + c0; off[4 * tid + 2] = ex + c0 + c1; off[4 * tid + 3] = ex + c0 + c1 + c2;
        if (tid == 63) off[256] = inc;
    }
    __syncthreads();
    if (tid < 256) { unsigned long long mask = (unsigned long long)tm[2 * tid] | ((unsigned long long)tm[2 * tid + 1] << 32); int o = off[tid];
        while (mask != 0ull) { unsigned tl = 0xffffffffu, th = 0xffffffffu;
#pragma unroll
            for (int k = 0; k < 4; ++k) if (mask != 0ull) { const unsigned ti = (unsigned)__builtin_ctzll(mask); mask &= mask - 1ull; tl = (tl & ~(0xffu << (8 * k))) | (ti << (8 * k)); }
#pragma unroll
            for (int k = 0; k < 4; ++k) if (mask != 0ull) { const unsigned ti = (unsigned)__builtin_ctzll(mask); mask &= mask - 1ull; th = (th & ~(0xffu << (8 * k))) | (ti << (8 * k)); }
            units[o++] = (u32x4){(unsigned)tid, tl, th, 0u}; } }
    __syncthreads();
    const int n = off[256];
    ASTAMP(1);
    unit_pass<0>(T, kh, tile, n, lds, wave, lane);
    if ((PROBE_REP) == 42) unit_pass<0>(T, kh, tile, n, lds, wave, lane);
    __syncthreads();
    ASTAMP(2);
    unit_pass<1>(T, kh, tile, n, lds, wave, lane);
    __syncthreads();
    ASTAMP(3);
    { const int ti = tid >> 3, part = tid & 7, g = part >> 1, d0 = 32 * (part & 1), row = ti * 4 + g, t = tile * 64 + ti, h = kh * 4 + g;
      const float l = ((const LAS float*)(lds + AL_LS))[row]; const float sc = bf2f(T.proj[(size_t)t * PP + C_NG + h * 3 + 1]) / fmaxf(l, 1e-30f);
      const LAS unsigned long long* orow = (const LAS unsigned long long*)(lds + AL_OS) + row * OSP + (d0 >> 1); u32x4* yp = (u32x4*)(T.ya + (size_t)t * 512 + h * 64 + d0);
      const int nsel = ((t >> 6) + 1) < 16 ? ((t >> 6) + 1) : 16; const unsigned bias = (unsigned)nsel << 26; const float sc2 = sc / T.fxs;
#pragma unroll
      for (int i = 0; i < 4; ++i) { const u32x4 y = yp[i]; const unsigned long long o0 = orow[4 * i], o1 = orow[4 * i + 1], o2 = orow[4 * i + 2], o3 = orow[4 * i + 3]; f32x4 a, b;
          a[0] = bf_lo(y.x) + (float)(int)((unsigned)o0 - bias) * sc2; a[1] = bf_hi(y.x) + (float)(int)((unsigned)(o0 >> 32) - bias) * sc2; a[2] = bf_lo(y.y) + (float)(int)((unsigned)o1 - bias) * sc2; a[3] = bf_hi(y.y) + (float)(int)((unsigned)(o1 >> 32) - bias) * sc2;
          b[0] = bf_lo(y.z) + (float)(int)((unsigned)o2 - bias) * sc2; b[1] = bf_hi(y.z) + (float)(int)((unsigned)(o2 >> 32) - bias) * sc2; b[2] = bf_lo(y.w) + (float)(int)((unsigned)o3 - bias) * sc2; b[3] = bf_hi(y.w) + (float)(int)((unsigned)(o3 >> 32) - bias) * sc2;
          yp[i] = pack8(a, b); } }
    __syncthreads();
    ASTAMP(4);
    if ((TSK) >= 20 && blockIdx.x == 0 && threadIdx.x == 0) T.tsa[5] += (unsigned long long)n;
}

struct SsmB { bf16x8 a[8]; };
__device__ __forceinline__ SsmB ssm_load_b(const unsigned char* ws, int g, int lane) {
    const int i = lane & 15, q = lane >> 4; SsmB B; const bf16x8 z = {0, 0, 0, 0, 0, 0, 0, 0};
    const bf16_t* t = (const bf16_t*)(ws + WS_BBAR) + ((size_t)(g * 128 + i) * 16 + 8 * (q & 1));
#pragma unroll
    for (int rt = 0; rt < 8; ++rt) B.a[rt] = (q < 2) ? *(const bf16x8*)(t + (size_t)rt * 16 * 16) : z;
    return B;
}
__device__ __forceinline__ void ssm_bu16(const bf16_t* proj, const SsmB& B, int tok0, int g, int lane, LAS float* bul) {
    const int i = lane & 15, q = lane >> 4; const bf16x8 z = {0, 0, 0, 0, 0, 0, 0, 0};
    const bf16x8 ub = (q < 2) ? *(const bf16x8*)(proj + (size_t)(tok0 + i) * PP + C_U + g * 16 + 8 * (q & 1)) : z;
    const f32x4 z4 = {0.f, 0.f, 0.f, 0.f};
#pragma unroll
    for (int rt = 0; rt < 8; ++rt) { const f32x4 acc = MFMA16(B.a[rt], ub, z4); *(LAS f32x4*)(bul + i * 132 + 16 * rt + 4 * q) = acc; }
    asm volatile("s_waitcnt lgkmcnt(0)" ::: "memory");
}
__device__ __forceinline__ f32x2 ssm_step(const f32x2 A, const f32x2 x, const f32x2 bu) { f32x2 r; r.x = A.x * x.x - A.y * x.y + bu.x; r.y = A.x * x.y + A.y * x.x + bu.y; return r; }
__device__ __forceinline__ void ssm_pass1(const unsigned char* ws, int c, int g, int lane, LAS float* bul) {
    const bf16_t* proj = (const bf16_t*)(ws + WS_PROJ);
    const SsmB B = ssm_load_b(ws, g, lane);
    const f32x2 A = ((const f32x2*)(ws + WS_ABAR))[g * 64 + lane];
    f32x2 x = {0.f, 0.f};
    for (int sub = 0; sub < 8; ++sub) {
        ssm_bu16(proj, B, c * 128 + sub * 16, g, lane, bul);
#pragma unroll
        for (int s = 0; s < 16; ++s) x = ssm_step(A, x, *(const LAS f32x2*)(bul + s * 132 + 2 * lane));
        asm volatile("s_waitcnt lgkmcnt(0)" ::: "memory");
    }
    ((f32x2*)(ws + WS_SBUF))[(size_t)(c * 32 + g) * 64 + lane] = x;
}
__device__ __forceinline__ void ssm_pass3(const Args& a, int c, int g, int lane, LAS float* bul, LAS unsigned char* xl  ) {
    const unsigned char* ws = a.ws; const bf16_t* proj = (const bf16_t*)(ws + WS_PROJ);
    const SsmB B = ssm_load_b(ws, g, lane);
    const f32x2 A = ((const f32x2*)(ws + WS_ABAR))[g * 64 + lane], A128 = ((const f32x2*)(ws + WS_A128))[g * 64 + lane];
    f32x2 x = {0.f, 0.f};
    { const f32x2* Sb = (const f32x2*)(ws + WS_SBUF) + g * 64 + lane;
      _Pragma("unroll 8") for (int cc = 0; cc < c; ++cc) { const f32x2 s = Sb[(size_t)cc * 32 * 64]; f32x2 r; r.x = A128.x * x.x - A128.y * x.y + s.x; r.y = A128.x * x.y + A128.y * x.x + s.y; x = r; } }
    const int hrow = lane & 15, q = lane >> 4; bf16x8 Cm[4];
    { const float* cre = a.in[14] + (size_t)(g * 16 + hrow) * 64; const float* cim = a.in[15] + (size_t)(g * 16 + hrow) * 64;
#pragma unroll
      for (int ks = 0; ks < 4; ++ks) { const f32x4 r = *(const f32x4*)(cre + 16 * ks + 4 * q), im = *(const f32x4*)(cim + 16 * ks + 4 * q);
          u32x4 w; w.x = cvt_pk_bf16(r[0], -im[0]); w.y = cvt_pk_bf16(r[1], -im[1]); w.z = cvt_pk_bf16(r[2], -im[2]); w.w = cvt_pk_bf16(r[3], -im[3]); Cm[ks] = __builtin_bit_cast(bf16x8, w); } }
    const f32x4 dsk = *(const f32x4*)(a.in[16] + g * 16 + 4 * q);
    bf16_t* ybp = (bf16_t*)((unsigned char*)a.out + OUT_YBP);
    for (int sub = 0; sub < 8; ++sub) {
        const int tok0 = c * 128 + sub * 16;
        ssm_bu16(proj, B, tok0, g, lane, bul);
#pragma unroll
        for (int s = 0; s < 16; ++s) { x = ssm_step(A, x, *(const LAS f32x2*)(bul + s * 132 + 2 * lane)); *(LAS unsigned*)(xl + s * 272 + lane * 4) = cvt_pk_bf16(x.x, x.y); }
        asm volatile("s_waitcnt lgkmcnt(0)" ::: "memory");
        f32x4 acc = {0.f, 0.f, 0.f, 0.f};
#pragma unroll
        for (int ks = 0; ks < 4; ++ks) { const bf16x8 b = *(const LAS bf16x8*)(xl + hrow * 272 + ks * 64 + q * 16); acc = MFMA16(Cm[ks], b, acc); }
        const u32x2 uw = *(const u32x2*)(proj + (size_t)(tok0 + hrow) * PP + C_U + g * 16 + 4 * q);
        const f32x4 uu = {bf_lo(uw.x), bf_hi(uw.x), bf_lo(uw.y), bf_hi(uw.y)};
        f32x4 y = acc + dsk * uu;
        u32x2 w; w.x = cvt_pk_bf16(gelu_tanh(y[0]), gelu_tanh(y[1])); w.y = cvt_pk_bf16(gelu_tanh(y[2]), gelu_tanh(y[3]));
        *(u32x2*)(ybp + (size_t)(tok0 + hrow) * 512 + g * 16 + 4 * q) = w;
        asm volatile("s_waitcnt lgkmcnt(0)" ::: "memory");
    }
}

__global__ void __launch_bounds__(NT, 2) fwd_mega(Args a) {
    extern __shared__ __attribute__((aligned(16))) unsigned char lds_raw[];
    cg::grid_group grid = cg::this_grid();
    LAS unsigned char* lds = (LAS unsigned char*)lds_raw;
    const int tid = threadIdx.x, lane = tid & 63, wave = __builtin_amdgcn_readfirstlane(tid >> 6);
    const int G = gridDim.x, bid = blockIdx.x;
    const int gw = bid * NWV + wave, NGW = G * NWV;
    const int gt = bid * NT + tid, NGT = G * NT;
    unsigned char* ws = a.ws;
    const float* x = a.in[0];
    STAMP(0);
    if ((TSK) >= 20 && blockIdx.x == 0 && threadIdx.x == 0) for (int i = 0; i < 16; ++i) ((unsigned long long*)(a.ws + 244 * 1024))[i] = 0ull;
    if (tid < 4) ((volatile LAS unsigned*)(lds + 131072 + 64))[tid] = 0u;
    if (bid == 0) for (int i = tid; i < XCD_BAR_WORDS; i += NT) ((unsigned*)(ws + WS_BAR))[i] = 0u;
    __syncthreads();

    {
        if (bid < 16) {
            LAS float* red = (LAS float*)lds;
            const int o = bid * 32 + (tid & 31), ksl = tid >> 5, which = o >> 8, colc = o & 255;
            const float* pe = a.in[which ? 7 : 4]; const float* w1 = a.in[which ? 8 : 5]; float s = 0.f;
            _Pragma("unroll 16") for (int k = ksl * 128; k < ksl * 128 + 128; ++k) s += pe[k] * w1[(size_t)k * 256 + colc];
            red[ksl * 32 + (tid & 31)] = s; __syncthreads();
            if (tid < 32) { float t = 0.f; for (int i = 0; i < 16; ++i) t += red[i * 32 + tid]; ((float*)(ws + WS_BIASPE))[o] = t; }
            __syncthreads();
        }
        LAS float* scr = (LAS float*)(lds + wave * 8448);
        constexpr int I_IN = 16 * 121, I_GLU = 8 * 16, I_PA = 8 * 32, I_OUT = 16 * 32, I_UP = 16 * 176, I_DN = 44 * 32, I_W1 = 32 * 8;
        constexpr int NITEMS = I_IN + I_GLU + 2 * I_PA + I_OUT + I_UP + I_DN + 2 * I_W1;
        for (int it = gw; it < NITEMS; it += NGW) {
            int r = it;
            if (r < I_IN) { transpose_item(a.in[3], 1024, DIN, (bf16_t*)(ws + WS_WIN), scr, r / 121, r % 121, lane, a.in[2], 1); continue; } r -= I_IN;
            if (r < I_GLU) { transpose_item(a.in[18], 512, 512, (bf16_t*)(ws + WS_WGLU), scr, r / 16, r % 16, lane, nullptr, 0); continue; } r -= I_GLU;
            if (r < I_PA) { transpose_item(a.in[19], 512, 1024, (bf16_t*)(ws + WS_WPA), scr, r / 32, r % 32, lane, nullptr, 0); continue; } r -= I_PA;
            if (r < I_PA) { transpose_item(a.in[20], 512, 1024, (bf16_t*)(ws + WS_WPB), scr, r / 32, r % 32, lane, nullptr, 0); continue; } r -= I_PA;
            if (r < I_OUT) { transpose_item(a.in[21], 1024, 1024, (bf16_t*)(ws + WS_WOUT), scr, r / 32, r % 32, lane, nullptr, 0); continue; } r -= I_OUT;
            if (r < I_UP) { transpose_item(a.in[23], 1024, NUP, (bf16_t*)(ws + WS_WUP), scr, r / 176, r % 176, lane, a.in[22], 2); continue; } r -= I_UP;
            if (r < I_DN) { transpose_item(a.in[26], DFF, 1024, (bf16_t*)(ws + WS_WDOWN), scr, r / 32, r % 32, lane, nullptr, 0); continue; } r -= I_DN;
            if (r < I_W1) { transpose_item(a.in[5], 2048, 256, (bf16_t*)(ws + WS_W1K), scr, r / 8, r % 8, lane, nullptr, 0); continue; } r -= I_W1;
            transpose_item(a.in[8], 2048, 256, (bf16_t*)(ws + WS_W1V), scr, r / 8, r % 8, lane, nullptr, 0);
        }
        { u32x4* p = (u32x4*)(ws + WS_WIN + (size_t)DIN * 1024 * 2); const int n = (4096 - DIN) * 1024 * 2 / 16; for (int i = gt; i < n; i += NGT) p[i] = (u32x4){0u, 0u, 0u, 0u}; }
        { u32x4* p = (u32x4*)(ws + WS_PROJ + (size_t)SEQ * PP * 2); const int n = 32 * PP * 2 / 16; for (int i = gt; i < n; i += NGT) p[i] = (u32x4){0u, 0u, 0u, 0u}; }
        for (int i = gt; i < 128 * 64 + 2048; i += NGT) {
            if (i < 128 * 64) { const int r = i >> 6, cidx = SEQ + (i & 63); ((bf16_t*)(ws + WS_VSLT))[(size_t)r * VTP + cidx] = 0; ((bf16_t*)(ws + WS_VWNT))[(size_t)r * VTP + cidx] = 0; }
            else { const int j = i - 128 * 64; ((bf16_t*)(ws + WS_VSLT))[(size_t)128 * VTP + j] = 0; ((bf16_t*)(ws + WS_VWNT))[(size_t)128 * VTP + j] = 0; }
        }
        for (int i = gt; i < SEQ; i += NGT) { ((float*)(ws + WS_RSS2))[i] = 0.f; ((float*)(ws + WS_RSS3))[i] = 0.f; }
        if (gt == 0) *(unsigned*)(ws + WS_VMAX) = 0u;
        { const int* pos = (const int*)a.in[1];
          for (int i = gt; i < SEQ * 8; i += NGT) { const int tt = i >> 3, fi = i & 7; const float invf = powf(500000.0f, -(float)(2 * fi) / 16.0f); const float ang = (float)pos[tt] * invf;
              float sn, cs; sincosf(ang, &sn, &cs); ((float*)(ws + WS_ROPEC))[i] = cs; ((float*)(ws + WS_ROPES))[i] = sn; } }
        for (int i = gt; i < 2048; i += NGT) { const int gg = i >> 6;
            const float dt = expf(a.in[17][gg]), ar = a.in[10][i], ai = a.in[11][i];
            const float e = expf(ar * dt), em1 = expm1f(ar * dt), th = ai * dt; float sn, cs; sincosf(th, &sn, &cs); const float sh = sinf(0.5f * th);
            const float Ax = e * cs, Ay = e * sn; const float nx = em1 * cs - 2.f * sh * sh, ny = e * sn;
            const float den = 1.f / (ar * ar + ai * ai); const float fx = (nx * ar + ny * ai) * den, fy = (ny * ar - nx * ai) * den;
            ((f32x2*)(ws + WS_ABAR))[i] = (f32x2){Ax, Ay};
            float px = Ax, py = Ay;
            for (int k = 0; k < 7; ++k) { const float qx = px * px - py * py, qy = 2.f * px * py; px = qx; py = qy; }
            ((f32x2*)(ws + WS_A128))[i] = (f32x2){px, py};
            const float* bre = a.in[12] + (size_t)i * 16; const float* bim = a.in[13] + (size_t)i * 16; const int pp = i & 63;
            bf16_t* Bo = (bf16_t*)(ws + WS_BBAR) + ((size_t)(gg * 128 + 2 * pp) * 16);
            for (int hh = 0; hh < 16; hh += 2) { *(unsigned*)(Bo + hh) = cvt_pk_bf16(fx * bre[hh] - fy * bim[hh], fx * bre[hh + 1] - fy * bim[hh + 1]);
                                                 *(unsigned*)(Bo + 16 + hh) = cvt_pk_bf16(fx * bim[hh] + fy * bre[hh], fx * bim[hh + 1] + fy * bre[hh + 1]); }
        }
        for (int r = gw; r < SEQ; r += NGW) {
            const f32x4* xr = (const f32x4*)(x + (size_t)r * DM) + lane; f32x4 v[4]; float s = 0.f;
#pragma unroll
            for (int j = 0; j < 4; ++j) { v[j] = xr[64 * j]; s += (v[j][0] * v[j][0] + v[j][1] * v[j][1]) + (v[j][2] * v[j][2] + v[j][3] * v[j][3]); }
            s = wave_sum(s);
            if (lane == 0) ((float*)(ws + WS_RSTD1))[r] = rsqrtf(s * (1.f / DM) + EPS);
            u32x2* o = (u32x2*)(ws + WS_XB + (size_t)r * DM * 2) + lane;
#pragma unroll
            for (int j = 0; j < 4; ++j) { u32x2 w; w.x = cvt_pk_bf16(v[j][0], v[j][1]); w.y = cvt_pk_bf16(v[j][2], v[j][3]); o[64 * j] = w; }
        }
    }
    grid.sync();
    STAMP(1);
    XcdBarrier xbar = xcd_barrier_post((unsigned*)(ws + WS_BAR), (volatile LAS unsigned*)(lds + 131072 + 64));

    REPS(1) {
        pg8::Gemm g{1024, 2048u, 128u, (unsigned)(1024) * 2u};
        SchedMN S{64, 16, 1, G, bid, 0, (const char*)(ws + WS_XB), nullptr, (const char*)(ws + WS_WIN), nullptr, (size_t)256 * 1024 * 2, (size_t)256 * 1024 * 2};
        EpiProj E{(bf16_t*)(ws + WS_PROJ), (bf16_t*)(ws + WS_VSLT), (bf16_t*)(ws + WS_VWNT), (bf16_t*)(ws + WS_KSL), (bf16_t*)(ws + WS_KWN), (const float*)(ws + WS_RSTD1), (const float*)(ws + WS_ROPEC), (const float*)(ws + WS_ROPES)};
        pg8::gemm_phase<EpiProj, SchedMN, true, true>(lds, g, S, E);
    }
    GSYNC();
    STAMP(2);

    {
        if (bid < 64) {
            pg8::Gemm g{512, (unsigned)(16 * PP * 2), (unsigned)(PP * 2), (unsigned)(2048) * 2u};
            SchedCmp S{bid, (const char*)(ws + WS_PROJ), (const char*)(ws + WS_W1K), (const char*)(ws + WS_W1V)};
            EpiCmp E{(float*)(ws + WS_XB)};
            pg8::gemm_phase<EpiCmp, SchedCmp, true, true>(lds, g, S, E);
        } else {
            LAS float* ubuf = (LAS float*)(lds + wave * 16384);
            for (int it = (bid - 64) * NWV + wave; it < 4096 * ((PROBE_REP) == 12 ? 2 : 1); it += (G - 64) * NWV) ssm_pass1(ws, (it & 4095) >> 5, it & 31, lane, ubuf);
        }
    }
    GSYNC();
    STAMP(3);

    REPS(3) {
        {
            const u32x4* vp = (const u32x4*)(ws + WS_VSLT); unsigned mx = 0u;
            for (int i = gt; i < 262144; i += NGT) { const u32x4 v = vp[i];
                mx = max(mx, max(max(v.x & 0x7fffu, (v.x >> 16) & 0x7fffu), max(v.y & 0x7fffu, (v.y >> 16) & 0x7fffu)));
                mx = max(mx, max(max(v.z & 0x7fffu, (v.z >> 16) & 0x7fffu), max(v.w & 0x7fffu, (v.w >> 16) & 0x7fffu))); }
#pragma unroll
            for (int o = 1; o < 64; o <<= 1) mx = max(mx, (unsigned)__shfl_xor((int)mx, o));
            LAS unsigned* red = (LAS unsigned*)(lds + 65536); if (lane == 0) red[wave] = mx; __syncthreads();
            if (tid == 0) { unsigned m8 = red[0]; for (int w = 1; w < NWV; ++w) m8 = max(m8, red[w]); atomicMax((unsigned*)(ws + WS_VMAX), m8); }
            __syncthreads();
        }
        const float* hidp = (const float*)(ws + WS_XB); LAS float* hrow = (LAS float*)(lds + wave * 1024);
        for (int r = gw; r < 4096; r += NGW) {
            const int z = r >> 10, n = r & 1023, which = z >> 1, kh = z & 1;
            float acc = 0.f;
            if (n < 1023) { const float* w2 = a.in[which ? 9 : 6];
                f32x4 hv = *(const f32x4*)((const float*)(ws + WS_BIASPE) + which * 256 + 4 * lane);
#pragma unroll
                for (int ks = 0; ks < 4; ++ks) hv += *(const f32x4*)(hidp + ((size_t)ks * 4096 + r) * 256 + 4 * lane);
                hv[0] = gelu_tanh(hv[0]); hv[1] = gelu_tanh(hv[1]); hv[2] = gelu_tanh(hv[2]); hv[3] = gelu_tanh(hv[3]);
                *(LAS f32x4*)(hrow + 4 * lane) = hv; asm volatile("s_waitcnt lgkmcnt(0)" ::: "memory");
                _Pragma("unroll 16") for (int k = 0; k < 256; k += 4) { const f32x4 h4 = *(const LAS f32x4*)(hrow + k);
                    acc += h4[0] * w2[k * 64 + lane]; acc += h4[1] * w2[(k + 1) * 64 + lane]; acc += h4[2] * w2[(k + 2) * 64 + lane]; acc += h4[3] * w2[(k + 3) * 64 + lane]; }
                asm volatile("s_waitcnt lgkmcnt(0)" ::: "memory"); }
            if (which == 0) {
                const float other = __shfl_xor(acc, 8); const int prow = 16 * n + 31; float o = acc;
                if (lane < 16 && n < 1023) { const float cs = ((const float*)(ws + WS_ROPEC))[prow * 8 + (lane & 7)], sn = ((const float*)(ws + WS_ROPES))[prow * 8 + (lane & 7)];
                    o = lane < 8 ? acc * cs - other * sn : acc * cs + other * sn; }
                ((bf16_t*)(ws + WS_KCMP))[((size_t)kh * 1024 + n) * 64 + lane] = (bf16_t)(cvt_pk_bf16(o, 0.f) & 0xffff);
            } else {
                ((bf16_t*)(ws + WS_VCMPT))[((size_t)kh * 64 + lane) * 1024 + n] = (bf16_t)(cvt_pk_bf16(acc, 0.f) & 0xffff);
            }
        }
    }
    GSYNC();
    STAMP(4);

    {
        AttnT T{0.f, (unsigned long long*)(ws + 244 * 1024), (const bf16_t*)(ws + WS_PROJ), (const bf16_t*)(ws + WS_KSL), (const bf16_t*)(ws + WS_KWN), (const bf16_t*)(ws + WS_KCMP), (const bf16_t*)(ws + WS_VCMPT), (const bf16_t*)(ws + WS_VSLT), (const bf16_t*)(ws + WS_VWNT), (bf16_t*)((unsigned char*)a.out + OUT_YA)};
        { const unsigned vb = __hip_atomic_load((unsigned*)(ws + WS_VMAX), __ATOMIC_RELAXED, __HIP_MEMORY_SCOPE_AGENT); const float vmax = fmaxf(__uint_as_float(vb << 16), 1e-30f); T.fxs = FXB / (64.0f * 1.01f * vmax); }
        LAS float* wl = (LAS float*)(lds + wave * 16384);
        for (int r2 = 0; r2 < ((PROBE_REP) == 4 ? 2 : 1); ++r2)
        for (int pr = bid; pr < 256; pr += G) {
            const int xcd = pr & 7, slot = pr >> 3, kh = xcd & 1, tl = 32 * (xcd >> 1) + slot;
_Pragma("nounroll")
            for (int k2 = 0; k2 < 2; ++k2) { int tk_ = threadIdx.x; asm volatile("" : "+v"(tk_)); attn_tile(T, kh, k2 ? 255 - tl : tl, lds, tk_, __builtin_amdgcn_readfirstlane(tk_ >> 6), tk_ & 63); }
        }
        if ((PROBE_REP) == 4) {
            AttnT T2 = T; T2.ya = (bf16_t*)(ws + WS_XB);
            for (int pr = bid; pr < 256; pr += G) { const int xcd = pr & 7, slot = pr >> 3, kh = xcd & 1, tl = 32 * (xcd >> 1) + slot;
                _Pragma("nounroll") for (int k2 = 0; k2 < 2; ++k2) attn_tile(T2, kh, k2 ? 255 - tl : tl, lds, tid, wave, lane); }
        }
        int tid2 = threadIdx.x; asm volatile("" : "+v"(tid2));
        const int lane2 = tid2 & 63, wave2 = __builtin_amdgcn_readfirstlane(tid2 >> 6), gw2 = bid * NWV + wave2;
        for (int it = gw2; it < 4096 * ((PROBE_REP) == 14 ? 2 : 1); it += NGW) ssm_pass3(a, (it & 4095) >> 5, it & 31, lane2, (LAS float*)(lds + wave2 * 16384), lds + wave2 * 16384 + 8448);
    }
    GSYNC();
    STAMP(5);

    REPS(5) {
        pg8::Gemm g{512, 1024u, 128u, (unsigned)(512) * 2u};
        SchedMN S{64, 2, 1, G, bid, 0, (const char*)a.out + OUT_YBP, nullptr, (const char*)(ws + WS_WGLU), nullptr, (size_t)256 * 512 * 2, (size_t)256 * 512 * 2};
        EpiGlu E{(const bf16_t*)((const unsigned char*)a.out + OUT_YBP), (bf16_t*)((unsigned char*)a.out + OUT_YB)};
        pg8::gemm_phase<EpiGlu, SchedMN, true, true>(lds, g, S, E);
    }
    GSYNC();
    STAMP(6);

    REPS(6) {
        pg8::Gemm g{512, 1024u, 128u, (unsigned)(512) * 2u};
        SchedMN S{64, 4, 2, G, bid, 0, (const char*)a.out + OUT_YA, (const char*)a.out + OUT_YB, (const char*)(ws + WS_WPA), (const char*)(ws + WS_WPB), (size_t)256 * 512 * 2, (size_t)256 * 512 * 2};
        EpiMerge E{(const bf16_t*)(ws + WS_PROJ), (bf16_t*)(ws + WS_MERGED)};
        pg8::gemm_phase<EpiMerge, SchedMN, true, true>(lds, g, S, E);
    }
    GSYNC();
    STAMP(7);

    {
        pg8::Gemm g{1024, 2048u, 128u, (unsigned)(1024) * 2u};
        SchedMN S{64, 4, 1, G, bid, 0, (const char*)(ws + WS_MERGED), nullptr, (const char*)(ws + WS_WOUT), nullptr, (size_t)256 * 1024 * 2, (size_t)256 * 1024 * 2};
        EpiRes E{x, a.out, (bf16_t*)(ws + WS_X1B), (float*)(ws + WS_RSS2)};
        pg8::gemm_phase<EpiRes, SchedMN, true, true>(lds, g, S, E);
    }
    GSYNC();
    STAMP(8);

    for (int half = 0; half < 2; ++half) {
        const int pm_off = half ? 31 : 0, nM = half ? 33 : 32, rowbase = pm_off * 256;
        REPS(8) {
            pg8::Gemm g{1024, 2048u, 128u, (unsigned)(1024) * 2u};
            SchedMN S{nM, 22, 1, G, bid, pm_off, (const char*)(ws + WS_X1B), nullptr, (const char*)(ws + WS_WUP), nullptr, (size_t)256 * 1024 * 2, (size_t)256 * 1024 * 2};
            EpiUp E{(bf16_t*)(ws + WS_UPRAW), (const float*)(ws + WS_RSS2), rowbase};
            pg8::gemm_phase<EpiUp, SchedMN, true, true>(lds, g, S, E);
        }
        GSYNC();
    STAMP(9);
        REPS(9) {
            const bf16_t* up = (const bf16_t*)(ws + WS_UPRAW); bf16_t* act = (bf16_t*)(ws + WS_ACT);
            const float* cw = a.in[24]; const float* cb = a.in[25];
            const int tlo = half ? 8192 : 0;
            for (int it = gt; it < 256 * 352; it += NGT) {
                const int cg8 = it % 352, tb = it / 352, c0 = cg8 * 8, tile = c0 >> 7, jj = c0 & 127;
                const int ucol = tile * 256 + jj;
                float wg[3][8], wv[3][8], bg[8], bv[8];
#pragma unroll
                for (int e = 0; e < 8; ++e) { bg[e] = cb[c0 + e]; bv[e] = cb[DFF + c0 + e];
#pragma unroll
                    for (int k = 0; k < 3; ++k) { wg[k][e] = cw[k * NUP + c0 + e]; wv[k][e] = cw[k * NUP + DFF + c0 + e]; } }
                const int ts = tlo + tb * 32;
                float g2[8], g1[8], v2[8], v1[8];
#pragma unroll
                for (int e = 0; e < 8; ++e) { g2[e] = g1[e] = v2[e] = v1[e] = 0.f; }
                if (ts >= 2) {
                    const u32x4 a2 = *(const u32x4*)(up + (size_t)(ts - 2 - rowbase) * NUP + ucol), b2 = *(const u32x4*)(up + (size_t)(ts - 2 - rowbase) * NUP + ucol + 128);
                    const u32x4 a1 = *(const u32x4*)(up + (size_t)(ts - 1 - rowbase) * NUP + ucol), b1 = *(const u32x4*)(up + (size_t)(ts - 1 - rowbase) * NUP + ucol + 128);
                    g2[0] = bf_lo(a2.x); g2[1] = bf_hi(a2.x); g2[2] = bf_lo(a2.y); g2[3] = bf_hi(a2.y); g2[4] = bf_lo(a2.z); g2[5] = bf_hi(a2.z); g2[6] = bf_lo(a2.w); g2[7] = bf_hi(a2.w);
                    v2[0] = bf_lo(b2.x); v2[1] = bf_hi(b2.x); v2[2] = bf_lo(b2.y); v2[3] = bf_hi(b2.y); v2[4] = bf_lo(b2.z); v2[5] = bf_hi(b2.z); v2[6] = bf_lo(b2.w); v2[7] = bf_hi(b2.w);
                    g1[0] = bf_lo(a1.x); g1[1] = bf_hi(a1.x); g1[2] = bf_lo(a1.y); g1[3] = bf_hi(a1.y); g1[4] = bf_lo(a1.z); g1[5] = bf_hi(a1.z); g1[6] = bf_lo(a1.w); g1[7] = bf_hi(a1.w);
                    v1[0] = bf_lo(b1.x); v1[1] = bf_hi(b1.x); v1[2] = bf_lo(b1.y); v1[3] = bf_hi(b1.y); v1[4] = bf_lo(b1.z); v1[5] = bf_hi(b1.z); v1[6] = bf_lo(b1.w); v1[7] = bf_hi(b1.w);
                }
                for (int s = 0; s < 32; ++s) {
                    const int tt = ts + s;
                    const u32x4 a0 = *(const u32x4*)(up + (size_t)(tt - rowbase) * NUP + ucol), b0 = *(const u32x4*)(up + (size_t)(tt - rowbase) * NUP + ucol + 128);
                    float gc[8], vc[8];
                    gc[0] = bf_lo(a0.x); gc[1] = bf_hi(a0.x); gc[2] = bf_lo(a0.y); gc[3] = bf_hi(a0.y); gc[4] = bf_lo(a0.z); gc[5] = bf_hi(a0.z); gc[6] = bf_lo(a0.w); gc[7] = bf_hi(a0.w);
                    vc[0] = bf_lo(b0.x); vc[1] = bf_hi(b0.x); vc[2] = bf_lo(b0.y); vc[3] = bf_hi(b0.y); vc[4] = bf_lo(b0.z); vc[5] = bf_hi(b0.z); vc[6] = bf_lo(b0.w); vc[7] = bf_hi(b0.w);
                    float o[8];
#pragma unroll
                    for (int e = 0; e < 8; ++e) { const float gg = bg[e] + wg[0][e] * g2[e] + wg[1][e] * g1[e] + wg[2][e] * gc[e]; const float vv = bv[e] + wv[0][e] * v2[e] + wv[1][e] * v1[e] + wv[2][e] * vc[e];
                        o[e] = gg * sigmoidf_(gg) * vv; g2[e] = g1[e]; g1[e] = gc[e]; v2[e] = v1[e]; v1[e] = vc[e]; }
                    u32x4 w; w.x = cvt_pk_bf16(o[0], o[1]); w.y = cvt_pk_bf16(o[2], o[3]); w.z = cvt_pk_bf16(o[4], o[5]); w.w = cvt_pk_bf16(o[6], o[7]);
                    *(u32x4*)(act + (size_t)tt * DFF + c0) = w;
                }
            }
        }
        GSYNC();
    STAMP(10);
    }

    {
        pg8::Gemm g{DFF, (unsigned)(DFF * 2), 128u, (unsigned)(DFF) * 2u};
        SchedMN S{64, 4, 1, G, bid, 0, (const char*)(ws + WS_ACT), nullptr, (const char*)(ws + WS_WDOWN), nullptr, (size_t)256 * DFF * 2, (size_t)256 * DFF * 2};
        EpiRes E{a.out, a.out, nullptr, (float*)(ws + WS_RSS3)};
        pg8::gemm_phase<EpiRes, SchedMN, true, true>(lds, g, S, E);
    }
    GSYNC();
    STAMP(11);

    {
        const float* gf = a.in[27];
        for (int r = gw; r < SEQ; r += NGW) {
            const float rs = rsqrtf(((const float*)(ws + WS_RSS3))[r] * (1.f / DM) + EPS);
            f32x4* xr = (f32x4*)(a.out + (size_t)r * DM) + lane; const f32x4* gr = (const f32x4*)gf + lane;
#pragma unroll
            for (int j = 0; j < 4; ++j) xr[64 * j] = xr[64 * j] * rs * gr[64 * j];
        }
    }
    if ((TSK) >= 0 && blockIdx.x == 0 && threadIdx.x == 0) {
        const unsigned long long tend = __builtin_amdgcn_s_memrealtime(); const unsigned long long* ts = (const unsigned long long*)(a.ws + 240 * 1024);
        const unsigned long long t1 = ((TSK) + 1 > 11) ? tend : ts[(TSK) + 1 > 11 ? 0 : (TSK) + 1];
        asm volatile("s_waitcnt vmcnt(0)" ::: "memory");
        a.out[0] = ((TSK) >= 20) ? (float)((const unsigned long long*)(a.ws + 244 * 1024))[(TSK) >= 20 ? (TSK) - 20 : 0] * ((TSK) == 25 ? 1.0f : 0.01f) : (float)(t1 - ts[(TSK) > 11 ? 11 : (TSK)]) * 0.01f;
    }
}

extern "C" void kernel_launch(void* const* d_in, const int* in_sizes, int n_in, void* d_out, int out_size, void* d_ws, size_t ws_size, hipStream_t stream) {
    static int grid = 0;
    if (grid == 0) {
        int dev = 0, cus = 0, per_cu = 0;
        (void)hipGetDevice(&dev); (void)hipDeviceGetAttribute(&cus, hipDeviceAttributeMultiprocessorCount, dev);
        (void)hipFuncSetAttribute((const void*)fwd_mega, hipFuncAttributeMaxDynamicSharedMemorySize, LDS_BYTES);
        (void)hipOccupancyMaxActiveBlocksPerMultiprocessor(&per_cu, (const void*)fwd_mega, NT, LDS_BYTES);
        if (per_cu < 1) { fprintf(stderr, "kernel_launch: occupancy query says %d blocks per CU\n", per_cu); per_cu = 1; }
        grid = cus;
        if (n_in != 28 || ws_size < 252 * MiB) fprintf(stderr, "kernel_launch: unexpected n_in %d / ws_size %zu\n", n_in, ws_size);
    }
    Args a{};
    for (int i = 0; i < 28; ++i) a.in[i] = (const float*)d_in[i];
    a.out = (float*)d_out; a.ws = (unsigned char*)d_ws;
    void* kargs[] = {&a};
    hipError_t e = hipLaunchCooperativeKernel((const void*)fwd_mega, dim3(grid), dim3(NT), kargs, LDS_BYTES, stream);
    if (e != hipSuccess) fprintf(stderr, "cooperative launch failed: %s (grid %d)\n", hipGetErrorString(e), grid);
}
```

```cpp
#include <hip/hip_runtime.h>
#include <hip/hip_cooperative_groups.h>
#include <cstdio>
#include <cstdint>
namespace cg = cooperative_groups;
#ifndef PROBE_REP
#define PROBE_REP -1
#endif
#ifndef EXPV
#define EXPV 0
#endif
#ifndef TSK
#define TSK -1
#endif
#define STAMP(i) do { if ((TSK) >= 0 && blockIdx.x == 0 && threadIdx.x == 0) ((unsigned long long*)(a.ws + 240 * 1024))[i] = __builtin_amdgcn_s_memrealtime(); } while (0)
#define ASTAMP(k) do { if ((TSK) >= 20 && blockIdx.x == 0 && threadIdx.x == 0) { const unsigned long long t_ = __builtin_amdgcn_s_memrealtime(); T.tsa[k] += t_ - T.tsa[15]; T.tsa[15] = t_; } } while (0)
#define REPS(k) _Pragma("nounroll") for (int rep_ = 0; rep_ < ((PROBE_REP) == (k) ? 2 : 1); ++rep_)
#define GSYNC() do { xcd_barrier(xbar); if ((PROBE_REP) == 100) xcd_barrier(xbar); } while (0)

#define LAS __attribute__((address_space(3)))
typedef unsigned short bf16_t;
typedef short bf16x8 __attribute__((ext_vector_type(8)));
typedef float f32x4 __attribute__((ext_vector_type(4)));
typedef float f32x2 __attribute__((ext_vector_type(2)));
typedef unsigned u32x4 __attribute__((ext_vector_type(4)));
typedef unsigned u32x2 __attribute__((ext_vector_type(2)));

constexpr int SEQ = 16384, DM = 1024, DIN = 3864, PP = 4096  , DFF = 2816, NUP = 5632;
constexpr int C_Q = 0, C_KC = 512, C_VC = 640, C_KSL = 768, C_VSL = 896, C_KWN = 1024, C_VWN = 1152, C_U = 1280, C_GA = 1792, C_GB = 2816, C_NG = 3840;
constexpr int VTP = SEQ + 64;
constexpr float EPS = 1e-6f;
constexpr float NEGF = -1e30f;

constexpr size_t MiB = 1u << 20;
constexpr size_t WS_RSTD1 = 0, WS_RSS2 = 64 * 1024, WS_RSS3 = 128 * 1024, WS_ROPEC = 256 * 1024, WS_ROPES = 768 * 1024;
constexpr size_t WS_ABAR = 1280 * 1024, WS_A128 = WS_ABAR + 16384, WS_BIASPE = WS_A128 + 16384, WS_BBAR = 1536 * 1024  ;
constexpr size_t WS_SBUF = 2 * MiB  , WS_HID = 4 * MiB  , WS_KCMP = 6 * MiB  , WS_VCMPT = 6 * MiB + 512 * 1024  ;
constexpr size_t WS_WUP = 8 * MiB, WS_WDOWN = 20 * MiB, WS_WIN = 26 * MiB, WS_WGLU = 34 * MiB, WS_WPA = 35 * MiB, WS_WPB = 36 * MiB, WS_WOUT = 37 * MiB, WS_W1K = 39 * MiB, WS_W1V = 40 * MiB;
constexpr size_t WS_XB = 41 * MiB, WS_MERGED = 41 * MiB, WS_PROJ = 73 * MiB, WS_VSLT = 202 * MiB + 512 * 1024, WS_VWNT = 207 * MiB;
constexpr size_t WS_X1B = 220 * MiB, WS_UPRAW = 26 * MiB, WS_ACT = 122 * MiB;
constexpr size_t WS_VMAX = 232 * 1024, WS_BAR = 192 * 1024, WS_KSL = 212 * MiB, WS_KWN = 216 * MiB;
constexpr size_t OUT_YA = 0, OUT_YBP = 16 * MiB, OUT_YB = 32 * MiB;
static_assert(WS_PROJ + (size_t)(SEQ + 32) * PP * 2 <= WS_VSLT, "proj");
static_assert(WS_VSLT + (size_t)128 * VTP * 2 + 4096 <= WS_VWNT && WS_VWNT + (size_t)128 * VTP * 2 + 4096 <= WS_X1B, "vt");
static_assert(WS_UPRAW + (size_t)33 * 256 * NUP * 2 <= WS_ACT && WS_ACT + (size_t)SEQ * DFF * 2 <= WS_X1B, "ffn");

__device__ __forceinline__ unsigned cvt_pk_bf16(float lo, float hi) { unsigned r; asm volatile("v_cvt_pk_bf16_f32 %0, %1, %2" : "=v"(r) : "v"(lo), "v"(hi)); return r; }
__device__ __forceinline__ float bf_lo(unsigned w) { return __uint_as_float(w << 16); }
__device__ __forceinline__ float bf_hi(unsigned w) { return __uint_as_float(w & 0xffff0000u); }
__device__ __forceinline__ float bf2f(bf16_t b) { return __uint_as_float((unsigned)b << 16); }
__device__ __forceinline__ float sigmoidf_(float v) { return 1.f / (1.f + __expf(-v)); }
__device__ __forceinline__ float gelu_tanh(float v) { const float z = 0.7978845608028654f * (v + 0.044715f * v * v * v); const float th = 1.f - 2.f / (__expf(2.f * z) + 1.f); return 0.5f * v * (1.f + th); }
__device__ __forceinline__ u32x4 pack8(f32x4 a, f32x4 b) { u32x4 w; w.x = cvt_pk_bf16(a[0], a[1]); w.y = cvt_pk_bf16(a[2], a[3]); w.z = cvt_pk_bf16(b[0], b[1]); w.w = cvt_pk_bf16(b[2], b[3]); return w; }

namespace pg8 {
#define PG8_LAS __attribute__((address_space(3)))
constexpr int BM = 256, BK = 64, HALF = 128, HTB = HALF * BK * 2, STAGE_BYTES = 8 * HTB, NXCD = 8, WGM = 8;
__host__ __device__ __forceinline__ int lds_byte(int r, int c) { const int st = (r >> 4) * 2 + (c >> 5), rr = r & 15, cc = c & 31, ob = rr * 64 + cc * 2; return st * 1024 + (ob ^ (((ob >> 9) & 1) << 5)); }
__host__ __device__ __forceinline__ void stage_rc(int b, int& R, int& C) { const int st = b / 1024, sb = b % 1024, swz = sb ^ (((sb >> 9) & 1) << 5); R = (st >> 1) * 16 + swz / 64; C = (st & 1) * 32 + (swz % 64) / 2; }
__host__ __device__ __forceinline__ int perm32(int rho) { const int n = rho >> 4, i = rho & 15; return 8 * (i >> 2) + 4 * n + (i & 3); }
struct Unit { int pm, pn, z; const char* A; const char* B; };
struct Gemm { int K; unsigned lda_b; unsigned kstepA; unsigned ldb_b; };
__device__ __forceinline__ bool tile_of(long L, int nM, int nN, int& pm, int& pn) {
    const int nwg = nM * nN; if (L >= nwg) return false;
    int wgid = (int)L; { const int q = nwg / NXCD, r = nwg % NXCD, xcd = wgid % NXCD, off = wgid / NXCD; wgid = (xcd < r ? xcd * (q + 1) : r * (q + 1) + (xcd - r) * q) + off; }
    const int nig = WGM * nN, gid = wgid / nig, fm = gid * WGM, gsz = (nM - fm) < WGM ? (nM - fm) : WGM;
    pm = fm + ((wgid % nig) % gsz); pn = (wgid % nig) / gsz; return true;
}
template <class Epi, class Sched, bool ALIGN_EPI = false, bool SP2 = false>
__device__ __forceinline__ void gemm_phase(PG8_LAS unsigned char* lds, const Gemm g, const Sched& S, const Epi& E) {
    int tid_ = threadIdx.x; asm volatile("" : "+v"(tid_));
    const int tid = tid_, wid = __builtin_amdgcn_readfirstlane(tid >> 6), lane = tid & 63, wr = wid >> 2, wc = wid & 3, fr = lane & 15, fq = lane >> 4;
    const int K = g.K, nt = K / BK;
    unsigned voffA[2], voffB[2];
#pragma unroll
    for (int i = 0; i < 2; ++i) { int R, C; stage_rc(tid * 16 + i * 8192, R, C); const int Rb = Epi::PERM ? ((R & ~31) + perm32(R & 31)) : R;
        voffA[i] = (unsigned)R * g.lda_b + (unsigned)C * 2u; voffB[i] = (unsigned)Rb * g.ldb_b + (unsigned)C * 2u; }
    const size_t kstepA = (size_t)g.kstepA, kstepB = (size_t)(BK * 2);
    const size_t hstepA = (size_t)HALF * g.lda_b, hstepB = (size_t)HALF * g.ldb_b;
    const unsigned ldsw = (unsigned)wid * 1024u;
    const int aoff = lds_byte(wr * 64 + fr, fq * 8), boff = lds_byte(wc * 32 + fr, fq * 8);
#define PG8_SA(b, h) (((b) * 2 + (h)) * HTB)
#define PG8_SB(b, h) ((4 + (b) * 2 + (h)) * HTB)
#define PG8_STAGE(bufoff, gbase, voff) do { _Pragma("unroll") for (int _i = 0; _i < 2; ++_i) \
        __builtin_amdgcn_global_load_lds((const unsigned*)((const char*)(gbase) + (voff)[_i]), (PG8_LAS unsigned*)(lds + (bufoff) + ldsw + _i * 8192), 16, 0, 0); } while (0)
#define PG8_LDA(dst, b, h) do { _Pragma("unroll") for (int m = 0; m < 4; ++m) _Pragma("unroll") for (int k = 0; k < 2; ++k) dst[m][k] = *(const PG8_LAS bf16x8*)(lds + PG8_SA(b, h) + aoff + m * 2048 + k * 1024); } while (0)
#define PG8_LDB(dst, b, h) do { _Pragma("unroll") for (int n = 0; n < 2; ++n) _Pragma("unroll") for (int k = 0; k < 2; ++k) dst[n][k] = *(const PG8_LAS bf16x8*)(lds + PG8_SB(b, h) + boff + n * 2048 + k * 1024); } while (0)
#define PG8_MMA(ai, bj, At, Bt) do { __builtin_amdgcn_s_setprio(1); _Pragma("unroll") for (int m = 0; m < 4; ++m) _Pragma("unroll") for (int n = 0; n < 2; ++n) _Pragma("unroll") for (int k = 0; k < 2; ++k) \
        acc[ai][bj][m][n] = __builtin_amdgcn_mfma_f32_16x16x32_bf16(Bt[n][k], At[m][k], acc[ai][bj][m][n], 0, 0, 0); __builtin_amdgcn_s_setprio(0); } while (0)
#define PG8_WAIT_V(n) asm volatile("s_waitcnt vmcnt(" #n ")" ::: "memory")
#define PG8_WAIT_L(n) asm volatile("s_waitcnt lgkmcnt(" #n ")" ::: "memory")
#define PG8_BAR __builtin_amdgcn_s_barrier()
#define PG8_SCHED __builtin_amdgcn_sched_barrier(0)
    Unit cur, nxt; int ui = 0;
    if (!S.next(0, cur)) return;
    f32x4 acc[2][2][4][2];
#pragma unroll
    for (int a = 0; a < 2; ++a)
#pragma unroll
        for (int b = 0; b < 2; ++b)
#pragma unroll
            for (int m = 0; m < 4; ++m)
#pragma unroll
                for (int n = 0; n < 2; ++n) acc[a][b][m][n] = (f32x4){0.f, 0.f, 0.f, 0.f};
    bf16x8 At[4][2], B0[2][2], B1[2][2];
    const char* cA = cur.A; const char* cB = cur.B;
    if constexpr (SP2) {
        PG8_STAGE(PG8_SB(0, 0), cB, voffB); PG8_STAGE(PG8_SB(0, 1), cB + hstepB, voffB); PG8_STAGE(PG8_SA(0, 0), cA, voffA); PG8_STAGE(PG8_SA(0, 1), cA + hstepA, voffA);
        if (wr == 1) PG8_BAR;
        PG8_WAIT_V(2); PG8_BAR;
        PG8_STAGE(PG8_SB(1, 0), cB + kstepB, voffB); PG8_STAGE(PG8_SA(1, 0), cA + kstepA, voffA); PG8_STAGE(PG8_SB(1, 1), cB + hstepB + kstepB, voffB);
        PG8_WAIT_V(6); PG8_BAR;
    } else {
        PG8_STAGE(PG8_SB(0, 0), cB, voffB); PG8_STAGE(PG8_SA(0, 0), cA, voffA); PG8_STAGE(PG8_SB(0, 1), cB + hstepB, voffB); PG8_STAGE(PG8_SA(0, 1), cA + hstepA, voffA);
        if (wr == 1) PG8_BAR;
        PG8_WAIT_V(4); PG8_BAR;
        PG8_STAGE(PG8_SB(1, 0), cB + kstepB, voffB); PG8_STAGE(PG8_SA(1, 0), cA + kstepA, voffA); PG8_STAGE(PG8_SB(1, 1), cB + hstepB + kstepB, voffB);
        PG8_WAIT_V(6); PG8_BAR;
    }
    for (;;) {
        const bool has_next = S.next(ui + 1, nxt);
        const char* nA = has_next ? nxt.A : cA; const char* nB = has_next ? nxt.B : cB;
        for (int t = 0; t < nt; t += 2) {
            const bool last = (t == nt - 2);
            const char* a1 = cA + (size_t)(t + 1) * kstepA;
            const char* a2 = last ? nA : cA + (size_t)(t + 2) * kstepA; const char* b2 = last ? nB : cB + (size_t)(t + 2) * kstepB;
            const char* a3 = a2 + kstepA; const char* b3 = b2 + kstepB;
            if constexpr (SP2) {
            PG8_LDB(B0, 0, 0); PG8_LDB(B1, 0, 1); PG8_SCHED; PG8_LDA(At, 0, 0); PG8_STAGE(PG8_SA(1, 1), a1 + hstepA, voffA);
            PG8_WAIT_V(8); PG8_WAIT_L(0); PG8_BAR; PG8_MMA(0, 0, At, B0); PG8_MMA(0, 1, At, B1); PG8_BAR; PG8_SCHED;
            PG8_LDA(At, 0, 1); PG8_STAGE(PG8_SB(0, 0), b2, voffB); PG8_STAGE(PG8_SB(0, 1), b2 + hstepB, voffB); PG8_STAGE(PG8_SA(0, 0), a2, voffA);
            PG8_WAIT_V(8); PG8_WAIT_L(0); PG8_BAR; PG8_MMA(1, 0, At, B0); PG8_MMA(1, 1, At, B1); PG8_BAR; PG8_SCHED;
            PG8_LDB(B0, 1, 0); PG8_LDB(B1, 1, 1); PG8_SCHED; PG8_LDA(At, 1, 0); PG8_STAGE(PG8_SA(0, 1), a2 + hstepA, voffA);
            PG8_WAIT_V(8); PG8_WAIT_L(0); PG8_BAR; PG8_MMA(0, 0, At, B0); PG8_MMA(0, 1, At, B1); PG8_BAR; PG8_SCHED;
            PG8_LDA(At, 1, 1); PG8_STAGE(PG8_SB(1, 0), b3, voffB); PG8_STAGE(PG8_SB(1, 1), b3 + hstepB, voffB); PG8_STAGE(PG8_SA(1, 0), a3, voffA);
            PG8_WAIT_V(8); PG8_WAIT_L(0); PG8_BAR; PG8_MMA(1, 0, At, B0); PG8_MMA(1, 1, At, B1); PG8_BAR; PG8_SCHED;
            } else {
            PG8_LDB(B0, 0, 0); PG8_SCHED; PG8_LDA(At, 0, 0); PG8_STAGE(PG8_SA(1, 1), a1 + hstepA, voffA);
            PG8_WAIT_L(8); PG8_BAR; PG8_WAIT_L(0); PG8_MMA(0, 0, At, B0); PG8_BAR; PG8_SCHED;
            PG8_LDB(B1, 0, 1); PG8_STAGE(PG8_SB(0, 0), b2, voffB);
            PG8_BAR; PG8_WAIT_L(0); PG8_MMA(0, 1, At, B1); PG8_BAR;
            PG8_LDA(At, 0, 1); PG8_STAGE(PG8_SA(0, 0), a2, voffA);
            PG8_BAR; PG8_WAIT_L(0); PG8_MMA(1, 0, At, B0); PG8_BAR; PG8_SCHED;
            PG8_STAGE(PG8_SB(0, 1), b2 + hstepB, voffB);
            PG8_WAIT_V(6); PG8_BAR; PG8_MMA(1, 1, At, B1); PG8_BAR;
            PG8_LDB(B0, 1, 0); PG8_SCHED; PG8_LDA(At, 1, 0); PG8_STAGE(PG8_SA(0, 1), a2 + hstepA, voffA);
            PG8_WAIT_L(8); PG8_BAR; PG8_WAIT_L(0); PG8_MMA(0, 0, At, B0); PG8_BAR; PG8_SCHED;
            PG8_LDB(B1, 1, 1); PG8_STAGE(PG8_SB(1, 0), b3, voffB);
            PG8_BAR; PG8_WAIT_L(0); PG8_MMA(0, 1, At, B1); PG8_BAR;
            PG8_LDA(At, 1, 1); PG8_STAGE(PG8_SA(1, 0), a3, voffA);
            PG8_BAR; PG8_WAIT_L(0); PG8_MMA(1, 0, At, B0); PG8_BAR; PG8_SCHED;
            PG8_STAGE(PG8_SB(1, 1), b3 + hstepB, voffB);
            PG8_WAIT_V(6); PG8_BAR; PG8_MMA(1, 1, At, B1); PG8_BAR;
            }
        }
        if constexpr (ALIGN_EPI) { if (wr == 0) PG8_BAR; }
        E(acc, cur, wr, wc, fr, fq);
        if (!has_next) break;
#pragma unroll
        for (int a = 0; a < 2; ++a)
#pragma unroll
            for (int b = 0; b < 2; ++b)
#pragma unroll
                for (int m = 0; m < 4; ++m)
#pragma unroll
                    for (int n = 0; n < 2; ++n) acc[a][b][m][n] = (f32x4){0.f, 0.f, 0.f, 0.f};
        cur = nxt; cA = nA; cB = nB; ++ui;
        if constexpr (ALIGN_EPI) { if (wr == 1) PG8_BAR; }
    }
    PG8_WAIT_V(0);
    if constexpr (!ALIGN_EPI) { if (wr == 0) PG8_BAR; }
    PG8_BAR;
#undef PG8_SA
#undef PG8_SB
#undef PG8_STAGE
#undef PG8_LDA
#undef PG8_LDB
#undef PG8_MMA
#undef PG8_WAIT_V
#undef PG8_WAIT_L
#undef PG8_BAR
#undef PG8_SCHED
}
}


struct SchedMN {
    int nM, nN, nz, G, c, pm_off; const char* A0; const char* A1; const char* B0; const char* B1; size_t a_tile, b_tile;
    __device__ __forceinline__ bool next(int i, pg8::Unit& u) const {
        int pm, pn; if (!pg8::tile_of((long)(i / nz) * G + c, nM, nN, pm, pn)) return false;
        u.z = i % nz; u.pm = pm + pm_off; u.pn = pn; u.A = (u.z ? A1 : A0) + (size_t)u.pm * a_tile; u.B = (u.z ? B1 : B0) + (size_t)pn * b_tile; return true;
    }
};
struct SchedCmp {
    int c; const char* proj; const char* w1k; const char* w1v;
    __device__ __forceinline__ bool next(int i, pg8::Unit& u) const {
        if (i > 0 || c >= 64) return false;
        const int ks = c & 3; u.pm = (c >> 2) & 3; u.z = c >> 4; u.pn = ks; const int which = u.z >> 1, kh = u.z & 1;
        u.A = proj + ((size_t)(16 * 256 * u.pm + 8 * ks) * PP + (which ? C_VC : C_KC) + kh * 64) * 2; u.B = (which ? w1v : w1k) + (size_t)ks * 512 * 2; return true;
    }
};

#define EPI_LOOP_ROWS for (int ai = 0; ai < 2; ++ai) _Pragma("unroll") for (int m = 0; m < 4; ++m)

struct EpiProj {
    static constexpr bool PERM = true;
    bf16_t* proj; bf16_t* vslt; bf16_t* vwnt; bf16_t* kslc; bf16_t* kwnc; const float* rstd; const float* ropec; const float* ropes;
    __device__ __forceinline__ void operator()(const f32x4 (&acc)[2][2][4][2], const pg8::Unit& u, int wr, int wc, int fr, int fq) const {
        const int pn = u.pn; const int row0 = u.pm * 256 + wr * 64 + fr;
        const bool sig = pn >= 7;
#pragma unroll
        EPI_LOOP_ROWS {
            const int row = row0 + ai * 128 + m * 16; const float rs = rstd[row];
            f32x4 c0 = {1.f, 1.f, 1.f, 1.f}, c1 = c0, s0 = {0.f, 0.f, 0.f, 0.f}, s1 = s0;
            if ((pn <= 1 || pn == 3 || pn == 4) && (wc & 1) == 0) { c0 = *(const f32x4*)(ropec + row * 8); c1 = *(const f32x4*)(ropec + row * 8 + 4); s0 = *(const f32x4*)(ropes + row * 8); s1 = *(const f32x4*)(ropes + row * 8 + 4); }
#pragma unroll
            for (int bj = 0; bj < 2; ++bj) {
                f32x4 v0 = acc[ai][bj][m][0] * rs, v1 = acc[ai][bj][m][1] * rs;
                const int colt = bj * 128 + wc * 32 + 8 * fq;
                const bool ropet = (pn <= 1) || ((pn == 3 || pn == 4) && bj == 0);
                if (ropet && (wc & 1) == 0) {
                    f32x4 p0, p1;
#pragma unroll
                    for (int e = 0; e < 4; ++e) { p0[e] = __shfl_xor(v0[e], 16); p1[e] = __shfl_xor(v1[e], 16); }
                    if (fq == 0) { v0 = v0 * c0 - p0 * s0; v1 = v1 * c1 - p1 * s1; }
                    else if (fq == 1) { v0 = v0 * c0 + p0 * s0; v1 = v1 * c1 + p1 * s1; }
                }
                if (pn <= 1) { v0 = v0 * (0.125f * 1.4426950408889634f); v1 = v1 * (0.125f * 1.4426950408889634f); }
                if (sig) {
#pragma unroll
                    for (int e = 0; e < 4; ++e) { v0[e] = sigmoidf_(v0[e]); v1[e] = sigmoidf_(v1[e]); }
                }
                const u32x4 w = pack8(v0, v1);
                if (!((pn == 3 || pn == 4))) *(u32x4*)(proj + (size_t)row * PP + pn * 256 + colt) = w;
                if ((pn == 3 || pn == 4) && bj == 0) { bf16_t* kc = (pn == 3) ? kslc : kwnc; *(u32x4*)(kc + ((size_t)(colt >> 6) * SEQ + row) * 64 + (colt & 63)) = w; }
                if ((pn == 3 || pn == 4) && bj == 1) {
                    bf16_t* vt = ((pn == 3) ? vslt : vwnt) + ((size_t)((colt - 128) >> 6) * 256 + (row >> 6)) * 4096 + (size_t)((colt - 128) & 63) * 64 + (row & 63);
                    vt[0 * 64] = (bf16_t)(w.x & 0xffff); vt[1 * 64] = (bf16_t)(w.x >> 16); vt[2 * 64] = (bf16_t)(w.y & 0xffff); vt[3 * 64] = (bf16_t)(w.y >> 16);
                    vt[4 * 64] = (bf16_t)(w.z & 0xffff); vt[5 * 64] = (bf16_t)(w.z >> 16); vt[6 * 64] = (bf16_t)(w.w & 0xffff); vt[7 * 64] = (bf16_t)(w.w >> 16);
                }
            }
        }
    }
};

struct EpiCmp {
    static constexpr bool PERM = true;
    float* hidp;
    __device__ __forceinline__ void operator()(const f32x4 (&acc)[2][2][4][2], const pg8::Unit& u, int wr, int wc, int fr, int fq) const {
        const int row0 = u.pm * 256 + wr * 64 + fr;
#pragma unroll
        for (int bj = 0; bj < 2; ++bj) {
            const int col = bj * 128 + wc * 32 + 8 * fq;
#pragma unroll
            EPI_LOOP_ROWS {
                const int row = row0 + ai * 128 + m * 16; float* d = hidp + (((size_t)u.pn * 4 + u.z) * 1024 + row) * 256 + col;
                *(f32x4*)d = acc[ai][bj][m][0]; *(f32x4*)(d + 4) = acc[ai][bj][m][1];
            }
        }
    }
};

struct EpiGlu {
    static constexpr bool PERM = true;
    const bf16_t* ybp; bf16_t* yb;
    __device__ __forceinline__ void operator()(const f32x4 (&acc)[2][2][4][2], const pg8::Unit& u, int wr, int wc, int fr, int fq) const {
        const int row0 = u.pm * 256 + wr * 64 + fr;
#pragma unroll
        EPI_LOOP_ROWS {
            const int row = row0 + ai * 128 + m * 16;
#pragma unroll
            for (int bj = 0; bj < 2; ++bj) {
                const size_t off = (size_t)row * 512 + u.pn * 256 + bj * 128 + wc * 32 + 8 * fq;
                const u32x4 y = *(const u32x4*)(ybp + off);
                f32x4 v0 = acc[ai][bj][m][0], v1 = acc[ai][bj][m][1];
                v0[0] = bf_lo(y.x) * sigmoidf_(v0[0]); v0[1] = bf_hi(y.x) * sigmoidf_(v0[1]); v0[2] = bf_lo(y.y) * sigmoidf_(v0[2]); v0[3] = bf_hi(y.y) * sigmoidf_(v0[3]);
                v1[0] = bf_lo(y.z) * sigmoidf_(v1[0]); v1[1] = bf_hi(y.z) * sigmoidf_(v1[1]); v1[2] = bf_lo(y.w) * sigmoidf_(v1[2]); v1[3] = bf_hi(y.w) * sigmoidf_(v1[3]);
                *(u32x4*)(yb + off) = pack8(v0, v1);
            }
        }
    }
};

struct EpiMerge {
    static constexpr bool PERM = true;
    const bf16_t* proj; bf16_t* merged;
    __device__ __forceinline__ void operator()(const f32x4 (&acc)[2][2][4][2], const pg8::Unit& u, int wr, int wc, int fr, int fq) const {
        const int row0 = u.pm * 256 + wr * 64 + fr; const int gcol = u.z ? C_GB : C_GA;
#pragma unroll
        EPI_LOOP_ROWS {
            const int row = row0 + ai * 128 + m * 16;
#pragma unroll
            for (int bj = 0; bj < 2; ++bj) {
                const int col = u.pn * 256 + bj * 128 + wc * 32 + 8 * fq;
                const u32x4 gt = *(const u32x4*)(proj + (size_t)row * PP + gcol + col);
                f32x4 v0 = acc[ai][bj][m][0], v1 = acc[ai][bj][m][1];
                v0[0] *= bf_lo(gt.x); v0[1] *= bf_hi(gt.x); v0[2] *= bf_lo(gt.y); v0[3] *= bf_hi(gt.y);
                v1[0] *= bf_lo(gt.z); v1[1] *= bf_hi(gt.z); v1[2] *= bf_lo(gt.w); v1[3] *= bf_hi(gt.w);
                bf16_t* dst = merged + (size_t)row * DM + col;
                if (u.z) { const u32x4 o = *(const u32x4*)dst;
                    v0[0] += bf_lo(o.x); v0[1] += bf_hi(o.x); v0[2] += bf_lo(o.y); v0[3] += bf_hi(o.y); v1[0] += bf_lo(o.z); v1[1] += bf_hi(o.z); v1[2] += bf_lo(o.w); v1[3] += bf_hi(o.w); }
                *(u32x4*)dst = pack8(v0, v1);
            }
        }
    }
};

struct EpiRes {
    static constexpr bool PERM = true;
    const float* xin; float* xo; bf16_t* xb; float* rss;
    __device__ __forceinline__ void operator()(const f32x4 (&acc)[2][2][4][2], const pg8::Unit& u, int wr, int wc, int fr, int fq) const {
        const int row0 = u.pm * 256 + wr * 64 + fr;
#pragma unroll
        EPI_LOOP_ROWS {
            const int row = row0 + ai * 128 + m * 16; float ss = 0.f;
#pragma unroll
            for (int bj = 0; bj < 2; ++bj) {
                const size_t off = (size_t)row * DM + u.pn * 256 + bj * 128 + wc * 32 + 8 * fq;
                const f32x4 v0 = *(const f32x4*)(xin + off) + acc[ai][bj][m][0], v1 = *(const f32x4*)(xin + off + 4) + acc[ai][bj][m][1];
                *(f32x4*)(xo + off) = v0; *(f32x4*)(xo + off + 4) = v1;
                if (xb) *(u32x4*)(xb + off) = pack8(v0, v1);
                ss += (v0[0] * v0[0] + v0[1] * v0[1]) + (v0[2] * v0[2] + v0[3] * v0[3]) + (v1[0] * v1[0] + v1[1] * v1[1]) + (v1[2] * v1[2] + v1[3] * v1[3]);
            }
            ss += __shfl_xor(ss, 16); ss += __shfl_xor(ss, 32);
            if (fq == 0) atomicAdd(rss + row, ss);
        }
    }
};

struct EpiUp {
    static constexpr bool PERM = true;
    bf16_t* up; const float* rss; int rowbase;
    __device__ __forceinline__ void operator()(const f32x4 (&acc)[2][2][4][2], const pg8::Unit& u, int wr, int wc, int fr, int fq) const {
        const int row0 = u.pm * 256 + wr * 64 + fr;
#pragma unroll
        EPI_LOOP_ROWS {
            const int row = row0 + ai * 128 + m * 16; const float rs = rsqrtf(rss[row] * (1.f / DM) + EPS);
#pragma unroll
            for (int bj = 0; bj < 2; ++bj) {
                const size_t off = (size_t)(row - rowbase) * NUP + u.pn * 256 + bj * 128 + wc * 32 + 8 * fq;
                *(u32x4*)(up + off) = pack8(acc[ai][bj][m][0] * rs, acc[ai][bj][m][1] * rs);
            }
        }
    }
};

struct Args { const float* in[28]; float* out; unsigned char* ws; };
constexpr int NT = 512, NWV = 8;
constexpr int LDS_BYTES = 147456;

__device__ __forceinline__ float wave_sum(float v) {
#pragma unroll
    for (int o = 1; o < 64; o <<= 1) v += __shfl_xor(v, o);
    return v;
}

#define XB_TMO      128
#define XB_XCNT(j)  (256  + 64 * (j))
#define XB_XSUB(j)  (1280 + 64 * (j))
#define XB_XGEN(j)  (2304 + 64 * (j))
#define XB_TOP      3328
#define XB_TOPGEN   3392
#define XCD_BAR_WORDS 3456
#define XB_SPIN_CAP (1u << 18)

__device__ __forceinline__ unsigned xb_ld(unsigned* p)              { return __hip_atomic_load(p, __ATOMIC_RELAXED, __HIP_MEMORY_SCOPE_AGENT); }
__device__ __forceinline__ unsigned xb_add(unsigned* p, unsigned v) { return __hip_atomic_fetch_add(p, v, __ATOMIC_RELAXED, __HIP_MEMORY_SCOPE_AGENT); }
__device__ __forceinline__ unsigned xb_xcc_id() { return (unsigned)__builtin_amdgcn_s_getreg((3 << 11) | 20) & 0xFu; }
#define XB_SPIN(cond, bar) do { unsigned _sp = 0; while (cond) { __builtin_amdgcn_s_sleep(1); \
    if ((++_sp & 255u) == 0u) { if (xb_ld(&(bar)[XB_TMO])) break; if (_sp > XB_SPIN_CAP) { atomicAdd(&(bar)[XB_TMO], 1u); break; } } } } while (0)

struct XcdBarrier {
    unsigned* bar; unsigned x;
    volatile LAS unsigned* st;
};

__device__ __forceinline__ XcdBarrier xcd_barrier_post(unsigned* bar, volatile LAS unsigned* st) {
    XcdBarrier b; b.bar = bar; b.x = xb_xcc_id(); b.st = st;
    if (threadIdx.x == 0) (void)xb_add(&bar[XB_XCNT(b.x)], 1u);
    return b;
}
__device__ __forceinline__ void xcd_barrier_complete(unsigned* bar, unsigned x, unsigned& nloc, unsigned& nx) {
    const unsigned G = gridDim.x * gridDim.y * gridDim.z;
    unsigned sum, cnt, mine, sp = 0u;
    for (;;) {
        sum = 0u; cnt = 0u; mine = 0u;
#pragma unroll
        for (unsigned j = 0; j < 16; ++j) { const unsigned c = xb_ld(&bar[XB_XCNT(j)]); sum += c; cnt += (c > 0u) ? 1u : 0u; mine = (j == x) ? c : mine; }
        if (sum == G) break;
        __builtin_amdgcn_s_sleep(1);
        if ((++sp & 255u) == 0u) { if (xb_ld(&bar[XB_TMO])) break; if (sp > XB_SPIN_CAP) { atomicAdd(&bar[XB_TMO], 1u); break; } }
    }
    nloc = mine > 0u ? mine : 1u; nx = cnt > 0u ? cnt : 1u;
}

__device__ __forceinline__ void xcd_barrier(const XcdBarrier& b) {
    asm volatile("s_waitcnt vmcnt(0)" ::: "memory");
    __syncthreads();
    if (threadIdx.x == 0) {
        unsigned* bar = b.bar;
        __builtin_amdgcn_s_waitcnt(0);
        unsigned nloc = b.st[0], nx = b.st[1];
        if (nloc == 0u) { xcd_barrier_complete(bar, b.x, nloc, nx); b.st[0] = nloc; b.st[1] = nx; }
        const unsigned old = xb_add(&bar[XB_XSUB(b.x)], 1u);
        const unsigned gen = old / nloc;
        if (old + 1u == (gen + 1u) * nloc) {
            __builtin_amdgcn_fence(__ATOMIC_RELEASE, "agent");
            asm volatile("s_waitcnt vmcnt(0)" ::: "memory");
            const unsigned og = xb_add(&bar[XB_TOP], 1u);
            const unsigned tg = og / nx;
            if (og + 1u == (tg + 1u) * nx) xb_add(&bar[XB_TOPGEN], 1u);
            else XB_SPIN(xb_ld(&bar[XB_TOPGEN]) == tg, bar);
            __builtin_amdgcn_fence(__ATOMIC_ACQUIRE, "agent");
            xb_add(&bar[XB_XGEN(b.x)], 1u);
            asm volatile("s_waitcnt vmcnt(0)" ::: "memory");
        } else {
            XB_SPIN(xb_ld(&bar[XB_XGEN(b.x)]) == gen, bar);
            __builtin_amdgcn_fence(__ATOMIC_ACQUIRE, "agent");
            asm volatile("s_waitcnt vmcnt(0)" ::: "memory");
        }
    }
    __syncthreads();
}

__device__ __forceinline__ int colmap(int kind, int c) {
    if (kind == 1) return c < 1280 ? c : (c < 1304 ? C_NG + (c - 1280) : c - 24);
    if (kind == 2) { return c < DFF ? (c >> 7) * 256 + (c & 127) : ((c - DFF) >> 7) * 256 + 128 + ((c - DFF) & 127); }
    return c;
}
__device__ __forceinline__ void transpose_item(const float* W, int K, int N, bf16_t* WT, LAS float* scr, int kb, int nb, int lane, const float* kscale, int kind) {
    const int k0 = 64 * kb, n0 = 32 * nb;
#pragma unroll
    for (int i = 0; i < 8; ++i) { const int kk = 8 * i + (lane >> 3), nq = (lane & 7) * 4, n = n0 + nq;
        f32x4 v = (n < N) ? *(const f32x4*)(W + (size_t)(k0 + kk) * N + n) : (f32x4){0.f, 0.f, 0.f, 0.f}; if (kscale) v = v * kscale[k0 + kk];
        LAS float* d = scr + kk * 33 + nq; d[0] = v[0]; d[1] = v[1]; d[2] = v[2]; d[3] = v[3]; }
    asm volatile("s_waitcnt lgkmcnt(0)" ::: "memory");
    const int c = lane & 7;
#pragma unroll
    for (int j = 0; j < 4; ++j) { const int n = (lane >> 3) + 8 * j; const LAS float* s = scr + (8 * c) * 33 + n;
        if (n0 + n < N) { u32x4 o; o.x = cvt_pk_bf16(s[0 * 33], s[1 * 33]); o.y = cvt_pk_bf16(s[2 * 33], s[3 * 33]); o.z = cvt_pk_bf16(s[4 * 33], s[5 * 33]); o.w = cvt_pk_bf16(s[6 * 33], s[7 * 33]);
            *(u32x4*)(WT + (size_t)colmap(kind, n0 + n) * K + k0 + 8 * c) = o; } }
    asm volatile("s_waitcnt lgkmcnt(0)" ::: "memory");
}

#define EXP2(x) __builtin_amdgcn_exp2f(x)
#define MFMA16(a, b, c) __builtin_amdgcn_mfma_f32_16x16x32_bf16((a), (b), (c), 0, 0, 0)
__device__ __forceinline__ float dpp_x1(float v) { return __int_as_float(__builtin_amdgcn_update_dpp(0, __float_as_int(v), 0xB1, 0xF, 0xF, true)); }
__device__ __forceinline__ float dpp_x2(float v) { return __int_as_float(__builtin_amdgcn_update_dpp(0, __float_as_int(v), 0x4E, 0xF, 0xF, true)); }
struct KOp { bf16x8 a00, a01, a10, a11; };
struct VOp { bf16x8 v0, v1, v2, v3; };
__device__ __forceinline__ KOp ldk(const bf16_t* Kb, size_t pitch, int kb, int lane) {
    const int i = lane & 15, q = lane >> 4;
    const bf16_t* r0 = Kb + (size_t)(kb + 8 * (i >> 2) + (i & 3)) * pitch + 8 * q; const bf16_t* r1 = r0 + 4 * pitch;
    KOp k; k.a00 = *(const bf16x8*)r0; k.a01 = *(const bf16x8*)(r0 + 32); k.a10 = *(const bf16x8*)r1; k.a11 = *(const bf16x8*)(r1 + 32); return k;
}
__device__ __forceinline__ VOp ldv(const bf16_t* Vt, size_t vpitch, int kb, int lane) {
    const int i = lane & 15, q = lane >> 4; const size_t base = (vpitch == 64) ? (size_t)(kb >> 6) * 4096 + (kb & 63) : (size_t)kb;
    const bf16_t* r = Vt + base + (size_t)i * vpitch + 8 * q;
    VOp v; v.v0 = *(const bf16x8*)r; v.v1 = *(const bf16x8*)(r + 16 * vpitch); v.v2 = *(const bf16x8*)(r + 32 * vpitch); v.v3 = *(const bf16x8*)(r + 48 * vpitch); return v;
}
__device__ __forceinline__ void qk32(const KOp& k, const bf16x8& Bq0, const bf16x8& Bq1, f32x4& S0, f32x4& S1) {
    const f32x4 z = {0.f, 0.f, 0.f, 0.f};
    S0 = MFMA16(k.a00, Bq0, z); S0 = MFMA16(k.a01, Bq1, S0); S1 = MFMA16(k.a10, Bq0, z); S1 = MFMA16(k.a11, Bq1, S1);
}
__device__ __forceinline__ void pv32(const VOp& v, const bf16x8& P, f32x4 (&O)[4]) {
    O[0] = MFMA16(v.v0, P, O[0]); O[1] = MFMA16(v.v1, P, O[1]); O[2] = MFMA16(v.v2, P, O[2]); O[3] = MFMA16(v.v3, P, O[3]);
}
__device__ __forceinline__ bf16x8 packP(const f32x4& p0, const f32x4& p1) { u32x4 w = pack8(p0, p1); return __builtin_bit_cast(bf16x8, w); }

struct KbLin { int base; __device__ __forceinline__ int operator()(int i) const { return base + 32 * i; } };
struct KbLds { const LAS int* l; __device__ __forceinline__ int operator()(int i) const { return l[i]; } };

template <bool NEEDV, class KB, class Body>
__device__ __forceinline__ void pipe3(int n, const KB kbf, Body& body, const bf16_t* Kb, size_t kp, const bf16_t* Vt, size_t vp, int lane) {
    if (n <= 0) return;
    KOp k0, k1; VOp v;
    k0 = ldk(Kb, kp, kbf(0), lane);
    for (int i = 0; i < n; i += 2) {
        { const int kb = kbf(i); if (NEEDV) v = ldv(Vt, vp, kb, lane); k1 = ldk(Kb, kp, kbf(i + 1 < n ? i + 1 : n - 1), lane); body.run(kb, k0, v); }
        if (i + 1 >= n) break;
        { const int kb = kbf(i + 1); if (NEEDV) v = ldv(Vt, vp, kb, lane); k0 = ldk(Kb, kp, kbf(i + 2 < n ? i + 2 : n - 1), lane); body.run(kb, k1, v); }
    }
}

constexpr int AL_CKV = 81920  , CKV_HALF = 9216, CKV_BUF = 18432;
template <bool NEEDV, class Body>
__device__ __forceinline__ void cmp_shared(int nsteps, Body& body, const bf16_t* Kc, const bf16_t* Vc, LAS unsigned char* buf, int tid, int lane, int kb0 = 0, int vrp = 1024, int vcs = 64, int vch0 = 0) {
    const int nch = (nsteps + 1) >> 1; if (nch <= 0) return;
    const int srow = tid >> 3, spc = tid & 7, i = lane & 15, q = lane >> 4;
    u32x4 rk = *(const u32x4*)(Kc + (size_t)(kb0 + srow) * 64 + spc * 8), rv = rk;
    if (NEEDV) rv = *(const u32x4*)(Vc + (size_t)srow * vrp + (size_t)vch0 * vcs + spc * 8);
    *(LAS u32x4*)(buf + srow * 144 + spc * 16) = rk; if (NEEDV) *(LAS u32x4*)(buf + CKV_HALF + srow * 144 + spc * 16) = rv;
    __syncthreads();
    for (int ch = 0; ch < nch; ++ch) {
        const LAS unsigned char* cur = buf + (ch & 1) * CKV_BUF; LAS unsigned char* nxt = buf + ((ch + 1) & 1) * CKV_BUF;
        const bool more = ch + 1 < nch;
        if (more) { rk = *(const u32x4*)(Kc + (size_t)(kb0 + 64 * (ch + 1) + srow) * 64 + spc * 8); if (NEEDV) rv = *(const u32x4*)(Vc + (size_t)srow * vrp + (size_t)(vch0 + ch + 1) * vcs + spc * 8); }
#pragma unroll
        for (int h = 0; h < 2; ++h) {
            const int st = 2 * ch + h;
            if (st < nsteps) {
                const LAS unsigned char* kr = cur + (32 * h + 8 * (i >> 2) + (i & 3)) * 144 + 16 * q;
                KOp k; k.a00 = *(const LAS bf16x8*)kr; k.a01 = *(const LAS bf16x8*)(kr + 64); k.a10 = *(const LAS bf16x8*)(kr + 4 * 144); k.a11 = *(const LAS bf16x8*)(kr + 4 * 144 + 64);
                VOp v; if (NEEDV) { const LAS unsigned char* vr = cur + CKV_HALF + i * 144 + (32 * h + 8 * q) * 2;
                    v.v0 = *(const LAS bf16x8*)vr; v.v1 = *(const LAS bf16x8*)(vr + 16 * 144); v.v2 = *(const LAS bf16x8*)(vr + 32 * 144); v.v3 = *(const LAS bf16x8*)(vr + 48 * 144); }
                else { v.v0 = k.a00; v.v1 = k.a00; v.v2 = k.a00; v.v3 = k.a00; }
                body.run(kb0 + 32 * st, k, v);
            }
        }
        if (more) { *(LAS u32x4*)(nxt + srow * 144 + spc * 16) = rk; if (NEEDV) *(LAS u32x4*)(nxt + CKV_HALF + srow * 144 + spc * 16) = rv; }
        __syncthreads();
    }
}

struct BodyCmp1 {
    bf16x8 Bq[2][2]; int nv[2], q; float ml[2], ll[2];
    __device__ __forceinline__ void run(int kb, const KOp& k, const VOp&) {
#pragma unroll
        for (int cg = 0; cg < 2; ++cg) {
            f32x4 S0, S1; qk32(k, Bq[cg][0], Bq[cg][1], S0, S1);
            const int k0 = kb + 8 * q; float mloc = NEGF;
#pragma unroll
            for (int e = 0; e < 4; ++e) { if (k0 + e >= nv[cg]) S0[e] = NEGF; if (k0 + 4 + e >= nv[cg]) S1[e] = NEGF; mloc = fmaxf(mloc, fmaxf(S0[e], S1[e])); }
            const float mn = fmaxf(ml[cg], mloc); float ps = 0.f;
#pragma unroll
            for (int e = 0; e < 4; ++e) { ps += (k0 + e < nv[cg]) ? EXP2(S0[e] - mn) : 0.f; ps += (k0 + 4 + e < nv[cg]) ? EXP2(S1[e] - mn) : 0.f; }
            ll[cg] = ll[cg] * EXP2(ml[cg] - mn) + ps; ml[cg] = mn;
        }
    }
};
struct BodyCmp2 {
    bf16x8 Bq[2][2]; int nv[2], q, g, lane_; float mc[2], inv[2], carry[2]; LAS float* ia[2]; f32x4 O[2][4];
    __device__ __forceinline__ void run(int kb, const KOp& k, const VOp& v) {
#pragma unroll
        for (int cg = 0; cg < 2; ++cg) {
            f32x4 S0, S1; qk32(k, Bq[cg][0], Bq[cg][1], S0, S1);
            const int k0 = kb + 8 * q; f32x4 p0, p1;
#pragma unroll
            for (int e = 0; e < 4; ++e) { p0[e] = (k0 + e < nv[cg]) ? EXP2(S0[e] - mc[cg]) * inv[cg] : 0.f; p1[e] = (k0 + 4 + e < nv[cg]) ? EXP2(S1[e] - mc[cg]) * inv[cg] : 0.f; }
            f32x4 s0 = p0, s1 = p1;
#pragma unroll
            for (int e = 0; e < 4; ++e) { s0[e] += dpp_x1(s0[e]); s0[e] += dpp_x2(s0[e]); s1[e] += dpp_x1(s1[e]); s1[e] += dpp_x2(s1[e]); }
            const float bout = 0.5f * s1[3]; const float recv = __shfl(bout, (lane_ + 48) & 63); const float bin = (q == 0) ? carry[cg] : recv; carry[cg] = recv;
            if (g == 0) { const int j = k0 >> 2; ia[cg][j] = ((s0[0] + s0[1]) + (s0[2] + 0.5f * s0[3])) + bin; ia[cg][j + 1] = 0.5f * s0[3] + ((s1[0] + s1[1]) + (s1[2] + 0.5f * s1[3])); }
            pv32(v, packP(p0, p1), O[cg]);
        }
    }
};
struct BodyWin {
    bf16x8 Bq[2][2]; int q, tt[2]; float m[2], l[2]; f32x4 O[2][4];
    __device__ __forceinline__ void run(int kb, const KOp& k, const VOp& v) {
#pragma unroll
        for (int cg = 0; cg < 2; ++cg) {
            f32x4 S0, S1; qk32(k, Bq[cg][0], Bq[cg][1], S0, S1);
            const int k0 = kb + 8 * q; unsigned vm = 0u;
#pragma unroll
            for (int e = 0; e < 8; ++e) { const bool ok = (k0 + e <= tt[cg]) && (tt[cg] - (k0 + e) < 512); vm |= ok ? (1u << e) : 0u; }
            float mloc = NEGF;
#pragma unroll
            for (int e = 0; e < 4; ++e) { if (!((vm >> e) & 1u)) S0[e] = NEGF; if (!((vm >> (4 + e)) & 1u)) S1[e] = NEGF; mloc = fmaxf(mloc, fmaxf(S0[e], S1[e])); }
            mloc = fmaxf(mloc, __shfl_xor(mloc, 16)); mloc = fmaxf(mloc, __shfl_xor(mloc, 32));
            const float mn = fmaxf(m[cg], mloc), alpha = EXP2(m[cg] - mn); m[cg] = mn;
            f32x4 p0, p1; float ps = 0.f;
#pragma unroll
            for (int e = 0; e < 4; ++e) { p0[e] = ((vm >> e) & 1u) ? EXP2(S0[e] - mn) : 0.f; p1[e] = ((vm >> (4 + e)) & 1u) ? EXP2(S1[e] - mn) : 0.f; ps += p0[e] + p1[e]; }
            l[cg] = l[cg] * alpha + ps;
#pragma unroll
            for (int dt = 0; dt < 4; ++dt) O[cg][dt] = O[cg][dt] * alpha;
            pv32(v, packP(p0, p1), O[cg]);
        }
    }
};

struct AttnT { float fxs; unsigned long long* tsa; const bf16_t* proj; const bf16_t* kslc; const bf16_t* kwnc; const bf16_t* kcmp; const bf16_t* vcmpT; const bf16_t* vslT; const bf16_t* vwnT; bf16_t* ya; };

constexpr int AL_IMP = 0  , AL_OS = 0  , AL_TM = 67584  , AL_CNT = 69632  ,
              AL_OFF = 70656  , AL_UNITS = 71744  , AL_MM = 77888  , AL_LS = 78912  ;
constexpr int AL_Q = 81920  , QROWB = 528;
constexpr int OSP = 33;
constexpr float FXB = 67108864.0f;
typedef short s16x2 __attribute__((ext_vector_type(2)));
__device__ __forceinline__ int f2ord(float f) { const int b = __float_as_int(f); return b >= 0 ? b : b ^ 0x7fffffff; }
__device__ __forceinline__ float ord2f(int b) { return __int_as_float(b >= 0 ? b : b ^ 0x7fffffff); }

__device__ __forceinline__ void attn_wave_part1(const AttnT& T, int kh, int tq8, int lane, LAS float* imp  , LAS unsigned* tm, int wave, LAS unsigned char* lds, int tid) {
    const int col = lane & 15, q = lane >> 4, tk = col >> 2, g = col & 3;
    const int t0 = tq8 * 8, h = kh * 4 + g;
    bf16x8 Bq[2][2]; float g0[2], g2[2]; int tcg[2];
#pragma unroll
    for (int cg = 0; cg < 2; ++cg) { tcg[cg] = t0 + 4 * cg + tk; const bf16_t* prow = T.proj + (size_t)tcg[cg] * PP;
        Bq[cg][0] = *(const bf16x8*)(prow + C_Q + h * 64 + 8 * q); Bq[cg][1] = *(const bf16x8*)(prow + C_Q + h * 64 + 32 + 8 * q);
        g0[cg] = bf2f(prow[C_NG + h * 3 + 0]); g2[cg] = bf2f(prow[C_NG + h * 3 + 2]); }
    for (int i = lane; i < 8 * 264; i += 64) imp[i] = 0.f;
    {
        const bf16_t* Kc = T.kcmp + (size_t)kh * 1024 * 64; const bf16_t* Vc = T.vcmpT + (size_t)kh * 64 * 1024;
        const int tmax = (t0 | 63), nvmax = tmax >= 31 ? ((tmax - 31) >> 4) + 1 : 0, nsteps = (nvmax + 31) >> 5;
        BodyCmp1 b1;
#pragma unroll
        for (int cg = 0; cg < 2; ++cg) { b1.Bq[cg][0] = Bq[cg][0]; b1.Bq[cg][1] = Bq[cg][1]; b1.nv[cg] = tcg[cg] >= 31 ? ((tcg[cg] - 31) >> 4) + 1 : 0; b1.ml[cg] = NEGF; b1.ll[cg] = 0.f; }
        b1.q = q;
        cmp_shared<false>(nsteps, b1, Kc, Vc, lds + AL_CKV, tid, lane);
        BodyCmp2 b2; b2.q = q; b2.g = g; b2.lane_ = lane; b2.carry[0] = 0.f; b2.carry[1] = 0.f;
#pragma unroll
        for (int cg = 0; cg < 2; ++cg) {
            float mc = fmaxf(b1.ml[cg], __shfl_xor(b1.ml[cg], 16)); mc = fmaxf(mc, __shfl_xor(mc, 32));
            float lc = b1.ll[cg] * EXP2(b1.ml[cg] - mc); lc += __shfl_xor(lc, 16); lc += __shfl_xor(lc, 32);
            b2.Bq[cg][0] = Bq[cg][0]; b2.Bq[cg][1] = Bq[cg][1]; b2.nv[cg] = b1.nv[cg]; b2.mc[cg] = mc; b2.inv[cg] = 1.f / fmaxf(lc, 1e-30f); b2.ia[cg] = imp + (4 * cg + tk) * 264;
#pragma unroll
            for (int dt = 0; dt < 4; ++dt) b2.O[cg][dt] = (f32x4){0.f, 0.f, 0.f, 0.f};
        }
        asm volatile("s_waitcnt lgkmcnt(0)" ::: "memory");
        cmp_shared<true>(nsteps, b2, Kc, Vc, lds + AL_CKV, tid, lane);
        if (q == 0 && g == 0 && nsteps > 0) { b2.ia[0][8 * nsteps] = b2.carry[0]; b2.ia[1][8 * nsteps] = b2.carry[1]; }
#pragma unroll
        for (int cg = 0; cg < 2; ++cg) { bf16_t* yrow = T.ya + (size_t)tcg[cg] * 512 + h * 64 + 4 * q;
#pragma unroll
            for (int dt = 0; dt < 4; ++dt) { const f32x4 o = b2.O[cg][dt] * g0[cg]; u32x2 w; w.x = cvt_pk_bf16(o[0], o[1]); w.y = cvt_pk_bf16(o[2], o[3]); *(u32x2*)(yrow + 16 * dt) = w; } }
    }
    asm volatile("s_waitcnt lgkmcnt(0)" ::: "memory");
    for (int tk2 = 0; tk2 < 8; ++tk2) {
        const int tt = t0 + tk2, cur = tt >> 6, nvalid = cur + 1, KSEL = nvalid < 16 ? nvalid : 16;
        int bits[4];
#pragma unroll
        for (int s = 0; s < 4; ++s) { const int j = s * 64 + lane; const float v = imp[tk2 * 264 + j];
            bits[s] = (j == 0 || j == cur) ? 0x7F000000 : (j < nvalid ? __float_as_int(v) : -1); }
        int prefix = 0;
        for (int bit = 30; bit >= 0; --bit) { const int Tt = prefix | (1 << bit); int cnt = 0;
#pragma unroll
            for (int s = 0; s < 4; ++s) cnt += __popcll(__ballot(bits[s] >= Tt));
            if (cnt >= KSEL) prefix = Tt; }
        unsigned long long sel[4]; int need = KSEL;
#pragma unroll
        for (int s = 0; s < 4; ++s) { sel[s] = __ballot(bits[s] > prefix); need -= __popcll(sel[s]); }
#pragma unroll
        for (int s = 0; s < 4; ++s) { unsigned long long me = __ballot(bits[s] == prefix);
            while (me != 0ull && need > 0) { const unsigned long long low = me & (0ull - me); sel[s] |= low; me ^= low; --need; } }
        const int tbi = wave * 8 + tk2; const unsigned tbit = 1u << (tbi & 31);
#pragma unroll
        for (int s = 0; s < 4; ++s) if ((sel[s] >> lane) & 1ull) __hip_atomic_fetch_or(tm + (s * 64 + lane) * 2 + (tbi >> 5), tbit, __ATOMIC_RELAXED, __HIP_MEMORY_SCOPE_WORKGROUP);
    }
    {
        const bf16_t* Kw = T.kwnc + (size_t)kh * SEQ * 64; const bf16_t* Vw = T.vwnT + (size_t)kh * 256 * 4096;
        const int tb = t0 & ~63; const int klo = (tb - 511 > 0 ? tb - 511 : 0) & ~63; const int n = ((tb + 63 - klo) >> 5) + 1;
        BodyWin bo; bo.q = q;
#pragma unroll
        for (int cg = 0; cg < 2; ++cg) { bo.Bq[cg][0] = Bq[cg][0]; bo.Bq[cg][1] = Bq[cg][1]; bo.tt[cg] = tcg[cg]; bo.m[cg] = NEGF; bo.l[cg] = 0.f;
#pragma unroll
            for (int dt = 0; dt < 4; ++dt) bo.O[cg][dt] = (f32x4){0.f, 0.f, 0.f, 0.f}; }
        cmp_shared<true>(n, bo, Kw, Vw, lds + AL_CKV, tid, lane, klo, 64, 4096, klo >> 6);
#pragma unroll
        for (int cg = 0; cg < 2; ++cg) { float l = bo.l[cg]; l += __shfl_xor(l, 16); l += __shfl_xor(l, 32);
            const float sc = g2[cg] / fmaxf(l, 1e-30f); bf16_t* yrow = T.ya + (size_t)tcg[cg] * 512 + h * 64 + 4 * q;
#pragma unroll
            for (int dt = 0; dt < 4; ++dt) { const u32x2 y = *(const u32x2*)(yrow + 16 * dt); const f32x4 o = bo.O[cg][dt] * sc;
                u32x2 w; w.x = cvt_pk_bf16(bf_lo(y.x) + o[0], bf_hi(y.x) + o[1]); w.y = cvt_pk_bf16(bf_lo(y.y) + o[2], bf_hi(y.y) + o[3]); *(u32x2*)(yrow + 16 * dt) = w; } }
    }
    asm volatile("s_waitcnt lgkmcnt(0)" ::: "memory");
}

struct UnitPre { int j; unsigned tlo, thi; bf16x8 q00, q01, q10, q11; KOp ka, kb; VOp va, vb; };
template <int PASS>
__device__ __forceinline__ UnitPre unit_load(const LAS unsigned char* qlds, const bf16_t* Ks, const bf16_t* Vs, int kh, int tile, const LAS u32x4* units, int u, int lane) {
    const int col = lane & 15, q = lane >> 4, slot = col >> 2, g = col & 3;
    const u32x4 d = units[u]; UnitPre P; P.j = __builtin_amdgcn_readfirstlane((int)d.x); P.tlo = (unsigned)__builtin_amdgcn_readfirstlane((int)d.y); P.thi = (unsigned)__builtin_amdgcn_readfirstlane((int)d.z);
    const unsigned t0b = (P.tlo >> (8 * slot)) & 0xffu, t1b = (P.thi >> (8 * slot)) & 0xffu;
    const LAS unsigned char* qr0 = qlds + (t0b == 0xffu ? 0 : (int)t0b) * QROWB + g * 128 + 16 * q;
    const LAS unsigned char* qr1 = qlds + (t1b == 0xffu ? 0 : (int)t1b) * QROWB + g * 128 + 16 * q;
    P.q00 = *(const LAS bf16x8*)qr0; P.q01 = *(const LAS bf16x8*)(qr0 + 64); P.q10 = *(const LAS bf16x8*)qr1; P.q11 = *(const LAS bf16x8*)(qr1 + 64);
    P.ka = ldk(Ks, 64, 64 * P.j, lane); P.kb = ldk(Ks, 64, 64 * P.j + 32, lane);
    if (PASS == 1) { if ((EXPV) == 2) { P.va.v0 = P.ka.a00; P.va.v1 = P.ka.a01; P.va.v2 = P.ka.a10; P.va.v3 = P.ka.a11; P.vb = P.va; } else { P.va = ldv(Vs, 64, 64 * P.j, lane); P.vb = ldv(Vs, 64, 64 * P.j + 32, lane); } }
    return P;
}
template <int PASS>
__device__ __forceinline__ void unit_group(const UnitPre& P, const bf16x8& q0, const bf16x8& q1, unsigned toks, int tile, LAS unsigned char* lds, float fxs, int lane) {
    const int col = lane & 15, q = lane >> 4, slot = col >> 2, g = col & 3;
    const int ti = (int)((toks >> (8 * slot)) & 0xffu);
    f32x4 S0a, S1a, S0b, S1b; qk32(P.ka, q0, q1, S0a, S1a); qk32(P.kb, q0, q1, S0b, S1b);
    const bool valid = ti != 0xff; const int row = (valid ? ti : 0) * 4 + g;
    const int lim = (P.j == tile) ? (valid ? ti : -1) - 8 * q : (valid ? 1000 : -1);
    LAS int* mm = (LAS int*)(lds + AL_MM); LAS float* ls = (LAS float*)(lds + AL_LS);
    if (PASS == 0) {
        float mloc = NEGF;
#pragma unroll
        for (int e = 0; e < 4; ++e) { mloc = fmaxf(mloc, e <= lim ? S0a[e] : NEGF); mloc = fmaxf(mloc, e + 4 <= lim ? S1a[e] : NEGF); mloc = fmaxf(mloc, e + 32 <= lim ? S0b[e] : NEGF); mloc = fmaxf(mloc, e + 36 <= lim ? S1b[e] : NEGF); }
        if ((EXPV) != 4) { mloc = fmaxf(mloc, __shfl_xor(mloc, 16)); mloc = fmaxf(mloc, __shfl_xor(mloc, 32)); }
        if (q == 0 && valid && (EXPV) != 3) __hip_atomic_fetch_max(mm + row, f2ord(mloc), __ATOMIC_RELAXED, __HIP_MEMORY_SCOPE_WORKGROUP);
    } else {
        const float m = ord2f(mm[row]);
        f32x4 p0a, p1a, p0b, p1b; float ps = 0.f;
#pragma unroll
        for (int e = 0; e < 4; ++e) { p0a[e] = e <= lim ? EXP2(S0a[e] - m) : 0.f; p1a[e] = e + 4 <= lim ? EXP2(S1a[e] - m) : 0.f; p0b[e] = e + 32 <= lim ? EXP2(S0b[e] - m) : 0.f; p1b[e] = e + 36 <= lim ? EXP2(S1b[e] - m) : 0.f;
            ps += (p0a[e] + p1a[e]) + (p0b[e] + p1b[e]); }
        ps += __shfl_xor(ps, 16); ps += __shfl_xor(ps, 32);
        if (q == 0 && valid) __hip_atomic_fetch_add(ls + row, ps, __ATOMIC_RELAXED, __HIP_MEMORY_SCOPE_WORKGROUP);
        f32x4 O[4];
#pragma unroll
        for (int dt = 0; dt < 4; ++dt) O[dt] = (f32x4){0.f, 0.f, 0.f, 0.f};
        pv32(P.va, packP(p0a, p1a), O); pv32(P.vb, packP(p0b, p1b), O);
        if (valid) { LAS unsigned long long* orow = (LAS unsigned long long*)(lds + AL_OS) + row * OSP + 2 * q;
#pragma unroll
            for (int dt = 0; dt < 4; ++dt) {
                const unsigned a0 = (unsigned)((int)rintf(O[dt][0] * fxs) + (1 << 26)), a1 = (unsigned)((int)rintf(O[dt][1] * fxs) + (1 << 26)), a2 = (unsigned)((int)rintf(O[dt][2] * fxs) + (1 << 26)), a3 = (unsigned)((int)rintf(O[dt][3] * fxs) + (1 << 26));
                __hip_atomic_fetch_add(orow + 8 * dt, (unsigned long long)a0 | ((unsigned long long)a1 << 32), __ATOMIC_RELAXED, __HIP_MEMORY_SCOPE_WORKGROUP);
                __hip_atomic_fetch_add(orow + 8 * dt + 1, (unsigned long long)a2 | ((unsigned long long)a3 << 32), __ATOMIC_RELAXED, __HIP_MEMORY_SCOPE_WORKGROUP); } }
    }
}
template <int PASS>
__device__ __forceinline__ void unit_compute(const UnitPre& P, int tile, LAS unsigned char* lds, float fxs, int lane) {
    unit_group<PASS>(P, P.q00, P.q01, P.tlo, tile, lds, fxs, lane);
    if (P.thi != 0xffffffffu) unit_group<PASS>(P, P.q10, P.q11, P.thi, tile, lds, fxs, lane);
}
template <int PASS>
__device__ __forceinline__ void unit_pass(const AttnT& T, int kh, int tile, int n, LAS unsigned char* lds, int wave, int lane) {
    const bf16_t* Ks = T.kslc + (size_t)kh * SEQ * 64; const bf16_t* Vs = T.vslT + (size_t)kh * 256 * 4096;
    const LAS u32x4* units = (const LAS u32x4*)(lds + AL_UNITS);
    int u = wave; if (u >= n) return;
    UnitPre A = unit_load<PASS>(lds + AL_Q, Ks, Vs, kh, tile, units, u, lane), B = A;
    for (; u < n; u += 16) {
        const int u1 = u + 8; if (u1 < n) B = unit_load<PASS>(lds + AL_Q, Ks, Vs, kh, tile, units, u1, lane);
        unit_compute<PASS>(A, tile, lds, T.fxs, lane);
        if (u1 >= n) break;
        const int u2 = u + 16; if (u2 < n) A = unit_load<PASS>(lds + AL_Q, Ks, Vs, kh, tile, units, u2, lane);
        unit_compute<PASS>(B, tile, lds, T.fxs, lane);
    }
}

__device__ __forceinline__ void attn_tile(const AttnT& T, int kh, int tile, LAS unsigned char* lds, int tid, int wave, int lane) {
    LAS unsigned* tm = (LAS unsigned*)(lds + AL_TM);
    for (int i = tid; i < 512; i += NT) tm[i] = 0u;
    __syncthreads();
    if ((TSK) >= 20 && blockIdx.x == 0 && threadIdx.x == 0) T.tsa[15] = __builtin_amdgcn_s_memrealtime();
    attn_wave_part1(T, kh, tile * 8 + wave, lane, (LAS float*)(lds + AL_IMP + wave * 8448), tm, wave, lds, tid);
    __threadfence_block(); __syncthreads();
    { const int ti = tid >> 3, part = tid & 7; const u32x4* src = (const u32x4*)(T.proj + (size_t)(tile * 64 + ti) * PP + C_Q + kh * 256 + part * 32); LAS u32x4* dst = (LAS u32x4*)(lds + AL_Q + ti * QROWB + part * 64);
      dst[0] = src[0]; dst[1] = src[1]; dst[2] = src[2]; dst[3] = src[3]; }
    ASTAMP(0);
    LAS int* cnt = (LAS int*)(lds + AL_CNT); LAS int* off = (LAS int*)(lds + AL_OFF); LAS u32x4* units = (LAS u32x4*)(lds + AL_UNITS);
    for (int i = tid; i < 256 * OSP; i += NT) ((LAS unsigned long long*)(lds + AL_OS))[i] = 0ull;
    if (tid < 256) { ((LAS int*)(lds + AL_MM))[tid] = f2ord(NEGF); ((LAS float*)(lds + AL_LS))[tid] = 0.f; cnt[tid] = (__popc(tm[2 * tid]) + __popc(tm[2 * tid + 1]) + 7) >> 3; }
    __syncthreads();
    if (tid < 64) {
        const int c0 = cnt[4 * tid], c1 = cnt[4 * tid + 1], c2 = cnt[4 * tid + 2], c3 = cnt[4 * tid + 3]; const int tot = (c0 + c1) + (c2 + c3); int inc = tot;
#pragma unroll
        for (int o = 1; o < 64; o <<= 1) { const int v = __shfl_up(inc, o); if (tid >= o) inc += v; }
        const int ex = inc - tot; off[4 * tid] = ex; off[4 * tid + 1] = ex + c0; off[4 * tid + 2] = ex + c0 + c1; off[4 * tid + 3] = ex + c0 + c1 + c2;
        if (tid == 63) off[256] = inc;
    }
    __syncthreads();
    if (tid < 256) { unsigned long long mask = (unsigned long long)tm[2 * tid] | ((unsigned long long)tm[2 * tid + 1] << 32); int o = off[tid];
        while (mask != 0ull) { unsigned tl = 0xffffffffu, th = 0xffffffffu;
#pragma unroll
            for (int k = 0; k < 4; ++k) if (mask != 0ull) { const unsigned ti = (unsigned)__builtin_ctzll(mask); mask &= mask - 1ull; tl = (tl & ~(0xffu << (8 * k))) | (ti << (8 * k)); }
#pragma unroll
            for (int k = 0; k < 4; ++k) if (mask != 0ull) { const unsigned ti = (unsigned)__builtin_ctzll(mask); mask &= mask - 1ull; th = (th & ~(0xffu << (8 * k))) | (ti << (8 * k)); }
            units[o++] = (u32x4){(unsigned)tid, tl, th, 0u}; } }
    __syncthreads();
    const int n = off[256];
    ASTAMP(1);
    unit_pass<0>(T, kh, tile, n, lds, wave, lane);
    if ((PROBE_REP) == 42) unit_pass<0>(T, kh, tile, n, lds, wave, lane);
    __syncthreads();
    ASTAMP(2);
    unit_pass<1>(T, kh, tile, n, lds, wave, lane);
    __syncthreads();
    ASTAMP(3);
    { const int ti = tid >> 3, part = tid & 7, g = part >> 1, d0 = 32 * (part & 1), row = ti * 4 + g, t = tile * 64 + ti, h = kh * 4 + g;
      const float l = ((const LAS float*)(lds + AL_LS))[row]; const float sc = bf2f(T.proj[(size_t)t * PP + C_NG + h * 3 + 1]) / fmaxf(l, 1e-30f);
      const LAS unsigned long long* orow = (const LAS unsigned long long*)(lds + AL_OS) + row * OSP + (d0 >> 1); u32x4* yp = (u32x4*)(T.ya + (size_t)t * 512 + h * 64 + d0);
      const int nsel = ((t >> 6) + 1) < 16 ? ((t >> 6) + 1) : 16; const unsigned bias = (unsigned)nsel << 26; const float sc2 = sc / T.fxs;
#pragma unroll
      for (int i = 0; i < 4; ++i) { const u32x4 y = yp[i]; const unsigned long long o0 = orow[4 * i], o1 = orow[4 * i + 1], o2 = orow[4 * i + 2], o3 = orow[4 * i + 3]; f32x4 a, b;
          a[0] = bf_lo(y.x) + (float)(int)((unsigned)o0 - bias) * sc2; a[1] = bf_hi(y.x) + (float)(int)((unsigned)(o0 >> 32) - bias) * sc2; a[2] = bf_lo(y.y) + (float)(int)((unsigned)o1 - bias) * sc2; a[3] = bf_hi(y.y) + (float)(int)((unsigned)(o1 >> 32) - bias) * sc2;
          b[0] = bf_lo(y.z) + (float)(int)((unsigned)o2 - bias) * sc2; b[1] = bf_hi(y.z) + (float)(int)((unsigned)(o2 >> 32) - bias) * sc2; b[2] = bf_lo(y.w) + (float)(int)((unsigned)o3 - bias) * sc2; b[3] = bf_hi(y.w) + (float)(int)((unsigned)(o3 >> 32) - bias) * sc2;
          yp[i] = pack8(a, b); } }
    __syncthreads();
    ASTAMP(4);
    if ((TSK) >= 20 && blockIdx.x == 0 && threadIdx.x == 0) T.tsa[5] += (unsigned long long)n;
}

struct SsmB { bf16x8 a[8]; };
__device__ __forceinline__ SsmB ssm_load_b(const unsigned char* ws, int g, int lane) {
    const int i = lane & 15, q = lane >> 4; SsmB B; const bf16x8 z = {0, 0, 0, 0, 0, 0, 0, 0};
    const bf16_t* t = (const bf16_t*)(ws + WS_BBAR) + ((size_t)(g * 128 + i) * 16 + 8 * (q & 1));
#pragma unroll
    for (int rt = 0; rt < 8; ++rt) B.a[rt] = (q < 2) ? *(const bf16x8*)(t + (size_t)rt * 16 * 16) : z;
    return B;
}
__device__ __forceinline__ void ssm_bu16(const bf16_t* proj, const SsmB& B, int tok0, int g, int lane, LAS float* bul) {
    const int i = lane & 15, q = lane >> 4; const bf16x8 z = {0, 0, 0, 0, 0, 0, 0, 0};
    const bf16x8 ub = (q < 2) ? *(const bf16x8*)(proj + (size_t)(tok0 + i) * PP + C_U + g * 16 + 8 * (q & 1)) : z;
    const f32x4 z4 = {0.f, 0.f, 0.f, 0.f};
#pragma unroll
    for (int rt = 0; rt < 8; ++rt) { const f32x4 acc = MFMA16(B.a[rt], ub, z4); *(LAS f32x4*)(bul + i * 132 + 16 * rt + 4 * q) = acc; }
    asm volatile("s_waitcnt lgkmcnt(0)" ::: "memory");
}
__device__ __forceinline__ f32x2 ssm_step(const f32x2 A, const f32x2 x, const f32x2 bu) { f32x2 r; r.x = A.x * x.x - A.y * x.y + bu.x; r.y = A.x * x.y + A.y * x.x + bu.y; return r; }
__device__ __forceinline__ void ssm_pass1(const unsigned char* ws, int c, int g, int lane, LAS float* bul) {
    const bf16_t* proj = (const bf16_t*)(ws + WS_PROJ);
    const SsmB B = ssm_load_b(ws, g, lane);
    const f32x2 A = ((const f32x2*)(ws + WS_ABAR))[g * 64 + lane];
    f32x2 x = {0.f, 0.f};
    for (int sub = 0; sub < 8; ++sub) {
        ssm_bu16(proj, B, c * 128 + sub * 16, g, lane, bul);
#pragma unroll
        for (int s = 0; s < 16; ++s) x = ssm_step(A, x, *(const LAS f32x2*)(bul + s * 132 + 2 * lane));
        asm volatile("s_waitcnt lgkmcnt(0)" ::: "memory");
    }
    ((f32x2*)(ws + WS_SBUF))[(size_t)(c * 32 + g) * 64 + lane] = x;
}
__device__ __forceinline__ void ssm_pass3(const Args& a, int c, int g, int lane, LAS float* bul, LAS unsigned char* xl  ) {
    const unsigned char* ws = a.ws; const bf16_t* proj = (const bf16_t*)(ws + WS_PROJ);
    const SsmB B = ssm_load_b(ws, g, lane);
    const f32x2 A = ((const f32x2*)(ws + WS_ABAR))[g * 64 + lane], A128 = ((const f32x2*)(ws + WS_A128))[g * 64 + lane];
    f32x2 x = {0.f, 0.f};
    { const f32x2* Sb = (const f32x2*)(ws + WS_SBUF) + g * 64 + lane;
      _Pragma("unroll 8") for (int cc = 0; cc < c; ++cc) { const f32x2 s = Sb[(size_t)cc * 32 * 64]; f32x2 r; r.x = A128.x * x.x - A128.y * x.y + s.x; r.y = A128.x * x.y + A128.y * x.x + s.y; x = r; } }
    const int hrow = lane & 15, q = lane >> 4; bf16x8 Cm[4];
    { const float* cre = a.in[14] + (size_t)(g * 16 + hrow) * 64; const float* cim = a.in[15] + (size_t)(g * 16 + hrow) * 64;
#pragma unroll
      for (int ks = 0; ks < 4; ++ks) { const f32x4 r = *(const f32x4*)(cre + 16 * ks + 4 * q), im = *(const f32x4*)(cim + 16 * ks + 4 * q);
          u32x4 w; w.x = cvt_pk_bf16(r[0], -im[0]); w.y = cvt_pk_bf16(r[1], -im[1]); w.z = cvt_pk_bf16(r[2], -im[2]); w.w = cvt_pk_bf16(r[3], -im[3]); Cm[ks] = __builtin_bit_cast(bf16x8, w); } }
    const f32x4 dsk = *(const f32x4*)(a.in[16] + g * 16 + 4 * q);
    bf16_t* ybp = (bf16_t*)((unsigned char*)a.out + OUT_YBP);
    for (int sub = 0; sub < 8; ++sub) {
        const int tok0 = c * 128 + sub * 16;
        ssm_bu16(proj, B, tok0, g, lane, bul);
#pragma unroll
        for (int s = 0; s < 16; ++s) { x = ssm_step(A, x, *(const LAS f32x2*)(bul + s * 132 + 2 * lane)); *(LAS unsigned*)(xl + s * 272 + lane * 4) = cvt_pk_bf16(x.x, x.y); }
        asm volatile("s_waitcnt lgkmcnt(0)" ::: "memory");
        f32x4 acc = {0.f, 0.f, 0.f, 0.f};
#pragma unroll
        for (int ks = 0; ks < 4; ++ks) { const bf16x8 b = *(const LAS bf16x8*)(xl + hrow * 272 + ks * 64 + q * 16); acc = MFMA16(Cm[ks], b, acc); }
        const u32x2 uw = *(const u32x2*)(proj + (size_t)(tok0 + hrow) * PP + C_U + g * 16 + 4 * q);
        const f32x4 uu = {bf_lo(uw.x), bf_hi(uw.x), bf_lo(uw.y), bf_hi(uw.y)};
        f32x4 y = acc + dsk * uu;
        u32x2 w; w.x = cvt_pk_bf16(gelu_tanh(y[0]), gelu_tanh(y[1])); w.y = cvt_pk_bf16(gelu_tanh(y[2]), gelu_tanh(y[3]));
        *(u32x2*)(ybp + (size_t)(tok0 + hrow) * 512 + g * 16 + 4 * q) = w;
        asm volatile("s_waitcnt lgkmcnt(0)" ::: "memory");
    }
}

__global__ void __launch_bounds__(NT, 2) fwd_mega(Args a) {
    extern __shared__ __attribute__((aligned(16))) unsigned char lds_raw[];
    cg::grid_group grid = cg::this_grid();
    LAS unsigned char* lds = (LAS unsigned char*)lds_raw;
    const int tid = threadIdx.x, lane = tid & 63, wave = __builtin_amdgcn_readfirstlane(tid >> 6);
    const int G = gridDim.x, bid = blockIdx.x;
    const int gw = bid * NWV + wave, NGW = G * NWV;
    const int gt = bid * NT + tid, NGT = G * NT;
    unsigned char* ws = a.ws;
    const float* x = a.in[0];
    STAMP(0);
    if ((TSK) >= 20 && blockIdx.x == 0 && threadIdx.x == 0) for (int i = 0; i < 16; ++i) ((unsigned long long*)(a.ws + 244 * 1024))[i] = 0ull;
    if (tid < 4) ((volatile LAS unsigned*)(lds + 131072 + 64))[tid] = 0u;
    if (bid == 0) for (int i = tid; i < XCD_BAR_WORDS; i += NT) ((unsigned*)(ws + WS_BAR))[i] = 0u;
    __syncthreads();

    {
        const int bb_ = G >= 256 ? 240 : 0;
        if (bid >= bb_ && bid < bb_ + 16) {
            LAS float* red = (LAS float*)lds;
            const int o = (bid - bb_) * 32 + (tid & 31), ksl = tid >> 5, which = o >> 8, colc = o & 255;
            const float* pe = a.in[which ? 7 : 4]; const float* w1 = a.in[which ? 8 : 5]; float s = 0.f;
            _Pragma("unroll 16") for (int k = ksl * 128; k < ksl * 128 + 128; ++k) s += pe[k] * w1[(size_t)k * 256 + colc];
            red[ksl * 32 + (tid & 31)] = s; __syncthreads();
            if (tid < 32) { float t = 0.f; for (int i = 0; i < 16; ++i) t += red[i * 32 + tid]; ((float*)(ws + WS_BIASPE))[o] = t; }
            __syncthreads();
        }
        LAS float* scr = (LAS float*)(lds + wave * 8448);
        constexpr int I_IN = 16 * 121, I_GLU = 8 * 16, I_PA = 8 * 32, I_OUT = 16 * 32, I_UP = 16 * 176, I_DN = 44 * 32, I_W1 = 32 * 8;
        constexpr int NITEMS = I_IN + I_GLU + 2 * I_PA + I_OUT + I_UP + I_DN + 2 * I_W1;
        for (int it = gw; it < NITEMS; it += NGW) {
            int r = it;
            if (r < I_IN) { transpose_item(a.in[3], 1024, DIN, (bf16_t*)(ws + WS_WIN), scr, r / 121, r % 121, lane, a.in[2], 1); continue; } r -= I_IN;
            if (r < I_GLU) { transpose_item(a.in[18], 512, 512, (bf16_t*)(ws + WS_WGLU), scr, r / 16, r % 16, lane, nullptr, 0); continue; } r -= I_GLU;
            if (r < I_PA) { transpose_item(a.in[19], 512, 1024, (bf16_t*)(ws + WS_WPA), scr, r / 32, r % 32, lane, nullptr, 0); continue; } r -= I_PA;
            if (r < I_PA) { transpose_item(a.in[20], 512, 1024, (bf16_t*)(ws + WS_WPB), scr, r / 32, r % 32, lane, nullptr, 0); continue; } r -= I_PA;
            if (r < I_OUT) { transpose_item(a.in[21], 1024, 1024, (bf16_t*)(ws + WS_WOUT), scr, r / 32, r % 32, lane, nullptr, 0); continue; } r -= I_OUT;
            if (r < I_UP) { transpose_item(a.in[23], 1024, NUP, (bf16_t*)(ws + WS_WUP), scr, r / 176, r % 176, lane, a.in[22], 2); continue; } r -= I_UP;
            if (r < I_DN) { transpose_item(a.in[26], DFF, 1024, (bf16_t*)(ws + WS_WDOWN), scr, r / 32, r % 32, lane, nullptr, 0); continue; } r -= I_DN;
            if (r < I_W1) { transpose_item(a.in[5], 2048, 256, (bf16_t*)(ws + WS_W1K), scr, r / 8, r % 8, lane, nullptr, 0); continue; } r -= I_W1;
            transpose_item(a.in[8], 2048, 256, (bf16_t*)(ws + WS_W1V), scr, r / 8, r % 8, lane, nullptr, 0);
        }
        { u32x4* p = (u32x4*)(ws + WS_WIN + (size_t)DIN * 1024 * 2); const int n = (4096 - DIN) * 1024 * 2 / 16; for (int i = gt; i < n; i += NGT) p[i] = (u32x4){0u, 0u, 0u, 0u}; }
        { u32x4* p = (u32x4*)(ws + WS_PROJ + (size_t)SEQ * PP * 2); const int n = 32 * PP * 2 / 16; for (int i = gt; i < n; i += NGT) p[i] = (u32x4){0u, 0u, 0u, 0u}; }
        for (int i = gt; i < 128 * 64 + 2048; i += NGT) {
            if (i < 128 * 64) { const int r = i >> 6, cidx = SEQ + (i & 63); ((bf16_t*)(ws + WS_VSLT))[(size_t)r * VTP + cidx] = 0; ((bf16_t*)(ws + WS_VWNT))[(size_t)r * VTP + cidx] = 0; }
            else { const int j = i - 128 * 64; ((bf16_t*)(ws + WS_VSLT))[(size_t)128 * VTP + j] = 0; ((bf16_t*)(ws + WS_VWNT))[(size_t)128 * VTP + j] = 0; }
        }
        for (int i = gt; i < SEQ; i += NGT) { ((float*)(ws + WS_RSS2))[i] = 0.f; ((float*)(ws + WS_RSS3))[i] = 0.f; }
        if (gt == 0) *(unsigned*)(ws + WS_VMAX) = 0u;
        { const int* pos = (const int*)a.in[1];
          for (int i = gt; i < SEQ * 8; i += NGT) { const int tt = i >> 3, fi = i & 7; const float invf = powf(500000.0f, -(float)(2 * fi) / 16.0f); const float ang = (float)pos[tt] * invf;
              float sn, cs; sincosf(ang, &sn, &cs); ((float*)(ws + WS_ROPEC))[i] = cs; ((float*)(ws + WS_ROPES))[i] = sn; } }
        const int sb_ = G >= 256 ? 210 : 0;
        for (int i = (bid - sb_) * NT + tid; bid >= sb_ && i < 2048; i += NGT) { const int gg = i >> 6;
            const float dt = expf(a.in[17][gg]), ar = a.in[10][i], ai = a.in[11][i];
            const float e = expf(ar * dt), em1 = expm1f(ar * dt), th = ai * dt; float sn, cs; sincosf(th, &sn, &cs); const float sh = sinf(0.5f * th);
            const float Ax = e * cs, Ay = e * sn; const float nx = em1 * cs - 2.f * sh * sh, ny = e * sn;
            const float den = 1.f / (ar * ar + ai * ai); const float fx = (nx * ar + ny * ai) * den, fy = (ny * ar - nx * ai) * den;
            ((f32x2*)(ws + WS_ABAR))[i] = (f32x2){Ax, Ay};
            float px = Ax, py = Ay;
            for (int k = 0; k < 7; ++k) { const float qx = px * px - py * py, qy = 2.f * px * py; px = qx; py = qy; }
            ((f32x2*)(ws + WS_A128))[i] = (f32x2){px, py};
            const float* bre = a.in[12] + (size_t)i * 16; const float* bim = a.in[13] + (size_t)i * 16; const int pp = i & 63;
            bf16_t* Bo = (bf16_t*)(ws + WS_BBAR) + ((size_t)(gg * 128 + 2 * pp) * 16);
            for (int hh = 0; hh < 16; hh += 2) { *(unsigned*)(Bo + hh) = cvt_pk_bf16(fx * bre[hh] - fy * bim[hh], fx * bre[hh + 1] - fy * bim[hh + 1]);
                                                 *(unsigned*)(Bo + 16 + hh) = cvt_pk_bf16(fx * bim[hh] + fy * bre[hh], fx * bim[hh + 1] + fy * bre[hh + 1]); }
        }
        for (int r = gw; r < SEQ; r += NGW) {
            const f32x4* xr = (const f32x4*)(x + (size_t)r * DM) + lane; f32x4 v[4]; float s = 0.f;
#pragma unroll
            for (int j = 0; j < 4; ++j) { v[j] = xr[64 * j]; s += (v[j][0] * v[j][0] + v[j][1] * v[j][1]) + (v[j][2] * v[j][2] + v[j][3] * v[j][3]); }
            s = wave_sum(s);
            if (lane == 0) ((float*)(ws + WS_RSTD1))[r] = rsqrtf(s * (1.f / DM) + EPS);
            u32x2* o = (u32x2*)(ws + WS_XB + (size_t)r * DM * 2) + lane;
#pragma unroll
            for (int j = 0; j < 4; ++j) { u32x2 w; w.x = cvt_pk_bf16(v[j][0], v[j][1]); w.y = cvt_pk_bf16(v[j][2], v[j][3]); o[64 * j] = w; }
        }
    }
    grid.sync();
    STAMP(1);
    XcdBarrier xbar = xcd_barrier_post((unsigned*)(ws + WS_BAR), (volatile LAS unsigned*)(lds + 131072 + 64));

    REPS(1) {
        pg8::Gemm g{1024, 2048u, 128u, (unsigned)(1024) * 2u};
        SchedMN S{64, 16, 1, G, bid, 0, (const char*)(ws + WS_XB), nullptr, (const char*)(ws + WS_WIN), nullptr, (size_t)256 * 1024 * 2, (size_t)256 * 1024 * 2};
        EpiProj E{(bf16_t*)(ws + WS_PROJ), (bf16_t*)(ws + WS_VSLT), (bf16_t*)(ws + WS_VWNT), (bf16_t*)(ws + WS_KSL), (bf16_t*)(ws + WS_KWN), (const float*)(ws + WS_RSTD1), (const float*)(ws + WS_ROPEC), (const float*)(ws + WS_ROPES)};
        pg8::gemm_phase<EpiProj, SchedMN, true, true>(lds, g, S, E);
    }
    GSYNC();
    STAMP(2);

    {
        if (bid < 64) {
            pg8::Gemm g{512, (unsigned)(16 * PP * 2), (unsigned)(PP * 2), (unsigned)(2048) * 2u};
            SchedCmp S{bid, (const char*)(ws + WS_PROJ), (const char*)(ws + WS_W1K), (const char*)(ws + WS_W1V)};
            EpiCmp E{(float*)(ws + WS_XB)};
            pg8::gemm_phase<EpiCmp, SchedCmp, true, true>(lds, g, S, E);
        } else {
            LAS float* ubuf = (LAS float*)(lds + wave * 16384);
            for (int it = (bid - 64) * NWV + wave; it < 4096 * ((PROBE_REP) == 12 ? 2 : 1); it += (G - 64) * NWV) ssm_pass1(ws, (it & 4095) >> 5, it & 31, lane, ubuf);
        }
    }
    GSYNC();
    STAMP(3);

    REPS(3) {
        {
            const u32x4* vp = (const u32x4*)(ws + WS_VSLT); unsigned mx = 0u;
            for (int i = gt; i < 262144; i += NGT) { const u32x4 v = vp[i];
                mx = max(mx, max(max(v.x & 0x7fffu, (v.x >> 16) & 0x7fffu), max(v.y & 0x7fffu, (v.y >> 16) & 0x7fffu)));
                mx = max(mx, max(max(v.z & 0x7fffu, (v.z >> 16) & 0x7fffu), max(v.w & 0x7fffu, (v.w >> 16) & 0x7fffu))); }
#pragma unroll
            for (int o = 1; o < 64; o <<= 1) mx = max(mx, (unsigned)__shfl_xor((int)mx, o));
            LAS unsigned* red = (LAS unsigned*)(lds + 65536); if (lane == 0) red[wave] = mx; __syncthreads();
            if (tid == 0) { unsigned m8 = red[0]; for (int w = 1; w < NWV; ++w) m8 = max(m8, red[w]); atomicMax((unsigned*)(ws + WS_VMAX), m8); }
            __syncthreads();
        }
        const float* hidp = (const float*)(ws + WS_XB); LAS float* hrow = (LAS float*)(lds + wave * 1024);
        for (int r = gw; r < 4096; r += NGW) {
            const int z = r >> 10, n = r & 1023, which = z >> 1, kh = z & 1;
            float acc = 0.f;
            if (n < 1023) { const float* w2 = a.in[which ? 9 : 6];
                f32x4 hv = *(const f32x4*)((const float*)(ws + WS_BIASPE) + which * 256 + 4 * lane);
#pragma unroll
                for (int ks = 0; ks < 4; ++ks) hv += *(const f32x4*)(hidp + ((size_t)ks * 4096 + r) * 256 + 4 * lane);
                hv[0] = gelu_tanh(hv[0]); hv[1] = gelu_tanh(hv[1]); hv[2] = gelu_tanh(hv[2]); hv[3] = gelu_tanh(hv[3]);
                *(LAS f32x4*)(hrow + 4 * lane) = hv; asm volatile("s_waitcnt lgkmcnt(0)" ::: "memory");
                _Pragma("unroll 16") for (int k = 0; k < 256; k += 4) { const f32x4 h4 = *(const LAS f32x4*)(hrow + k);
                    acc += h4[0] * w2[k * 64 + lane]; acc += h4[1] * w2[(k + 1) * 64 + lane]; acc += h4[2] * w2[(k + 2) * 64 + lane]; acc += h4[3] * w2[(k + 3) * 64 + lane]; }
                asm volatile("s_waitcnt lgkmcnt(0)" ::: "memory"); }
            if (which == 0) {
                const float other = __shfl_xor(acc, 8); const int prow = 16 * n + 31; float o = acc;
                if (lane < 16 && n < 1023) { const float cs = ((const float*)(ws + WS_ROPEC))[prow * 8 + (lane & 7)], sn = ((const float*)(ws + WS_ROPES))[prow * 8 + (lane & 7)];
                    o = lane < 8 ? acc * cs - other * sn : acc * cs + other * sn; }
                ((bf16_t*)(ws + WS_KCMP))[((size_t)kh * 1024 + n) * 64 + lane] = (bf16_t)(cvt_pk_bf16(o, 0.f) & 0xffff);
            } else {
                ((bf16_t*)(ws + WS_VCMPT))[((size_t)kh * 64 + lane) * 1024 + n] = (bf16_t)(cvt_pk_bf16(acc, 0.f) & 0xffff);
            }
        }
    }
    GSYNC();
    STAMP(4);

    {
        AttnT T{0.f, (unsigned long long*)(ws + 244 * 1024), (const bf16_t*)(ws + WS_PROJ), (const bf16_t*)(ws + WS_KSL), (const bf16_t*)(ws + WS_KWN), (const bf16_t*)(ws + WS_KCMP), (const bf16_t*)(ws + WS_VCMPT), (const bf16_t*)(ws + WS_VSLT), (const bf16_t*)(ws + WS_VWNT), (bf16_t*)((unsigned char*)a.out + OUT_YA)};
        { const unsigned vb = __hip_atomic_load((unsigned*)(ws + WS_VMAX), __ATOMIC_RELAXED, __HIP_MEMORY_SCOPE_AGENT); const float vmax = fmaxf(__uint_as_float(vb << 16), 1e-30f); T.fxs = FXB / (64.0f * 1.01f * vmax); }
        LAS float* wl = (LAS float*)(lds + wave * 16384);
        for (int r2 = 0; r2 < ((PROBE_REP) == 4 ? 2 : 1); ++r2)
        for (int pr = bid; pr < 256; pr += G) {
            const int xcd = pr & 7, slot = pr >> 3, kh = xcd & 1, tl = 32 * (xcd >> 1) + slot;
_Pragma("nounroll")
            for (int k2 = 0; k2 < 2; ++k2) { int tk_ = threadIdx.x; asm volatile("" : "+v"(tk_)); attn_tile(T, kh, k2 ? 255 - tl : tl, lds, tk_, __builtin_amdgcn_readfirstlane(tk_ >> 6), tk_ & 63); }
        }
        if ((PROBE_REP) == 4) {
            AttnT T2 = T; T2.ya = (bf16_t*)(ws + WS_XB);
            for (int pr = bid; pr < 256; pr += G) { const int xcd = pr & 7, slot = pr >> 3, kh = xcd & 1, tl = 32 * (xcd >> 1) + slot;
                _Pragma("nounroll") for (int k2 = 0; k2 < 2; ++k2) attn_tile(T2, kh, k2 ? 255 - tl : tl, lds, tid, wave, lane); }
        }
        int tid2 = threadIdx.x; asm volatile("" : "+v"(tid2));
        const int lane2 = tid2 & 63, wave2 = __builtin_amdgcn_readfirstlane(tid2 >> 6), gw2 = bid * NWV + wave2;
        for (int it = gw2; it < 4096 * ((PROBE_REP) == 14 ? 2 : 1); it += NGW) ssm_pass3(a, (it & 4095) >> 5, it & 31, lane2, (LAS float*)(lds + wave2 * 16384), lds + wave2 * 16384 + 8448);
    }
    GSYNC();
    STAMP(5);

    REPS(5) {
        pg8::Gemm g{512, 1024u, 128u, (unsigned)(512) * 2u};
        SchedMN S{64, 2, 1, G, bid, 0, (const char*)a.out + OUT_YBP, nullptr, (const char*)(ws + WS_WGLU), nullptr, (size_t)256 * 512 * 2, (size_t)256 * 512 * 2};
        EpiGlu E{(const bf16_t*)((const unsigned char*)a.out + OUT_YBP), (bf16_t*)((unsigned char*)a.out + OUT_YB)};
        pg8::gemm_phase<EpiGlu, SchedMN, true, true>(lds, g, S, E);
    }
    GSYNC();
    STAMP(6);

    REPS(6) {
        pg8::Gemm g{512, 1024u, 128u, (unsigned)(512) * 2u};
        SchedMN S{64, 4, 2, G, bid, 0, (const char*)a.out + OUT_YA, (const char*)a.out + OUT_YB, (const char*)(ws + WS_WPA), (const char*)(ws + WS_WPB), (size_t)256 * 512 * 2, (size_t)256 * 512 * 2};
        EpiMerge E{(const bf16_t*)(ws + WS_PROJ), (bf16_t*)(ws + WS_MERGED)};
        pg8::gemm_phase<EpiMerge, SchedMN, true, true>(lds, g, S, E);
    }
    GSYNC();
    STAMP(7);

    {
        pg8::Gemm g{1024, 2048u, 128u, (unsigned)(1024) * 2u};
        SchedMN S{64, 4, 1, G, bid, 0, (const char*)(ws + WS_MERGED), nullptr, (const char*)(ws + WS_WOUT), nullptr, (size_t)256 * 1024 * 2, (size_t)256 * 1024 * 2};
        EpiRes E{x, a.out, (bf16_t*)(ws + WS_X1B), (float*)(ws + WS_RSS2)};
        pg8::gemm_phase<EpiRes, SchedMN, true, true>(lds, g, S, E);
    }
    GSYNC();
    STAMP(8);

    for (int half = 0; half < 2; ++half) {
        const int pm_off = half ? 31 : 0, nM = half ? 33 : 32, rowbase = pm_off * 256;
        REPS(8) {
            pg8::Gemm g{1024, 2048u, 128u, (unsigned)(1024) * 2u};
            SchedMN S{nM, 22, 1, G, bid, pm_off, (const char*)(ws + WS_X1B), nullptr, (const char*)(ws + WS_WUP), nullptr, (size_t)256 * 1024 * 2, (size_t)256 * 1024 * 2};
            EpiUp E{(bf16_t*)(ws + WS_UPRAW), (const float*)(ws + WS_RSS2), rowbase};
            pg8::gemm_phase<EpiUp, SchedMN, true, true>(lds, g, S, E);
        }
        GSYNC();
    STAMP(9);
        REPS(9) {
            const bf16_t* up = (const bf16_t*)(ws + WS_UPRAW); bf16_t* act = (bf16_t*)(ws + WS_ACT);
            const float* cw = a.in[24]; const float* cb = a.in[25];
            const int tlo = half ? 8192 : 0;
            for (int it = gt; it < 256 * 352; it += NGT) {
                const int cg8 = it % 352, tb = it / 352, c0 = cg8 * 8, tile = c0 >> 7, jj = c0 & 127;
                const int ucol = tile * 256 + jj;
                float wg[3][8], wv[3][8], bg[8], bv[8];
#pragma unroll
                for (int e = 0; e < 8; ++e) { bg[e] = cb[c0 + e]; bv[e] = cb[DFF + c0 + e];
#pragma unroll
                    for (int k = 0; k < 3; ++k) { wg[k][e] = cw[k * NUP + c0 + e]; wv[k][e] = cw[k * NUP + DFF + c0 + e]; } }
                const int ts = tlo + tb * 32;
                float g2[8], g1[8], v2[8], v1[8];
#pragma unroll
                for (int e = 0; e < 8; ++e) { g2[e] = g1[e] = v2[e] = v1[e] = 0.f; }
                if (ts >= 2) {
                    const u32x4 a2 = *(const u32x4*)(up + (size_t)(ts - 2 - rowbase) * NUP + ucol), b2 = *(const u32x4*)(up + (size_t)(ts - 2 - rowbase) * NUP + ucol + 128);
                    const u32x4 a1 = *(const u32x4*)(up + (size_t)(ts - 1 - rowbase) * NUP + ucol), b1 = *(const u32x4*)(up + (size_t)(ts - 1 - rowbase) * NUP + ucol + 128);
                    g2[0] = bf_lo(a2.x); g2[1] = bf_hi(a2.x); g2[2] = bf_lo(a2.y); g2[3] = bf_hi(a2.y); g2[4] = bf_lo(a2.z); g2[5] = bf_hi(a2.z); g2[6] = bf_lo(a2.w); g2[7] = bf_hi(a2.w);
                    v2[0] = bf_lo(b2.x); v2[1] = bf_hi(b2.x); v2[2] = bf_lo(b2.y); v2[3] = bf_hi(b2.y); v2[4] = bf_lo(b2.z); v2[5] = bf_hi(b2.z); v2[6] = bf_lo(b2.w); v2[7] = bf_hi(b2.w);
                    g1[0] = bf_lo(a1.x); g1[1] = bf_hi(a1.x); g1[2] = bf_lo(a1.y); g1[3] = bf_hi(a1.y); g1[4] = bf_lo(a1.z); g1[5] = bf_hi(a1.z); g1[6] = bf_lo(a1.w); g1[7] = bf_hi(a1.w);
                    v1[0] = bf_lo(b1.x); v1[1] = bf_hi(b1.x); v1[2] = bf_lo(b1.y); v1[3] = bf_hi(b1.y); v1[4] = bf_lo(b1.z); v1[5] = bf_hi(b1.z); v1[6] = bf_lo(b1.w); v1[7] = bf_hi(b1.w);
                }
                for (int s = 0; s < 32; ++s) {
                    const int tt = ts + s;
                    const u32x4 a0 = *(const u32x4*)(up + (size_t)(tt - rowbase) * NUP + ucol), b0 = *(const u32x4*)(up + (size_t)(tt - rowbase) * NUP + ucol + 128);
                    float gc[8], vc[8];
                    gc[0] = bf_lo(a0.x); gc[1] = bf_hi(a0.x); gc[2] = bf_lo(a0.y); gc[3] = bf_hi(a0.y); gc[4] = bf_lo(a0.z); gc[5] = bf_hi(a0.z); gc[6] = bf_lo(a0.w); gc[7] = bf_hi(a0.w);
                    vc[0] = bf_lo(b0.x); vc[1] = bf_hi(b0.x); vc[2] = bf_lo(b0.y); vc[3] = bf_hi(b0.y); vc[4] = bf_lo(b0.z); vc[5] = bf_hi(b0.z); vc[6] = bf_lo(b0.w); vc[7] = bf_hi(b0.w);
                    float o[8];
#pragma unroll
                    for (int e = 0; e < 8; ++e) { const float gg = bg[e] + wg[0][e] * g2[e] + wg[1][e] * g1[e] + wg[2][e] * gc[e]; const float vv = bv[e] + wv[0][e] * v2[e] + wv[1][e] * v1[e] + wv[2][e] * vc[e];
                        o[e] = gg * sigmoidf_(gg) * vv; g2[e] = g1[e]; g1[e] = gc[e]; v2[e] = v1[e]; v1[e] = vc[e]; }
                    u32x4 w; w.x = cvt_pk_bf16(o[0], o[1]); w.y = cvt_pk_bf16(o[2], o[3]); w.z = cvt_pk_bf16(o[4], o[5]); w.w = cvt_pk_bf16(o[6], o[7]);
                    *(u32x4*)(act + (size_t)tt * DFF + c0) = w;
                }
            }
        }
        GSYNC();
    STAMP(10);
    }

    {
        pg8::Gemm g{DFF, (unsigned)(DFF * 2), 128u, (unsigned)(DFF) * 2u};
        SchedMN S{64, 4, 1, G, bid, 0, (const char*)(ws + WS_ACT), nullptr, (const char*)(ws + WS_WDOWN), nullptr, (size_t)256 * DFF * 2, (size_t)256 * DFF * 2};
        EpiRes E{a.out, a.out, nullptr, (float*)(ws + WS_RSS3)};
        pg8::gemm_phase<EpiRes, SchedMN, true, true>(lds, g, S, E);
    }
    GSYNC();
    STAMP(11);

    {
        const float* gf = a.in[27];
        for (int r = gw; r < SEQ; r += NGW) {
            const float rs = rsqrtf(((const float*)(ws + WS_RSS3))[r] * (1.f / DM) + EPS);
            f32x4* xr = (f32x4*)(a.out + (size_t)r * DM) + lane; const f32x4* gr = (const f32x4*)gf + lane;
#pragma unroll
            for (int j = 0; j < 4; ++j) xr[64 * j] = xr[64 * j] * rs * gr[64 * j];
        }
    }
    if ((TSK) >= 0 && blockIdx.x == 0 && threadIdx.x == 0) {
        const unsigned long long tend = __builtin_amdgcn_s_memrealtime(); const unsigned long long* ts = (const unsigned long long*)(a.ws + 240 * 1024);
        const unsigned long long t1 = ((TSK) + 1 > 11) ? tend : ts[(TSK) + 1 > 11 ? 0 : (TSK) + 1];
        asm volatile("s_waitcnt vmcnt(0)" ::: "memory");
        a.out[0] = ((TSK) >= 20) ? (float)((const unsigned long long*)(a.ws + 244 * 1024))[(TSK) >= 20 ? (TSK) - 20 : 0] * ((TSK) == 25 ? 1.0f : 0.01f) : (float)(t1 - ts[(TSK) > 11 ? 11 : (TSK)]) * 0.01f;
    }
}

extern "C" void kernel_launch(void* const* d_in, const int* in_sizes, int n_in, void* d_out, int out_size, void* d_ws, size_t ws_size, hipStream_t stream) {
    static int grid = 0;
    if (grid == 0) {
        int dev = 0, cus = 0, per_cu = 0;
        (void)hipGetDevice(&dev); (void)hipDeviceGetAttribute(&cus, hipDeviceAttributeMultiprocessorCount, dev);
        (void)hipFuncSetAttribute((const void*)fwd_mega, hipFuncAttributeMaxDynamicSharedMemorySize, LDS_BYTES);
        (void)hipOccupancyMaxActiveBlocksPerMultiprocessor(&per_cu, (const void*)fwd_mega, NT, LDS_BYTES);
        if (per_cu < 1) { fprintf(stderr, "kernel_launch: occupancy query says %d blocks per CU\n", per_cu); per_cu = 1; }
        grid = cus;
        if (n_in != 28 || ws_size < 252 * MiB) fprintf(stderr, "kernel_launch: unexpected n_in %d / ws_size %zu\n", n_in, ws_size);
    }
    Args a{};
    for (int i = 0; i < 28; ++i) a.in[i] = (const float*)d_in[i];
    a.out = (float*)d_out; a.ws = (unsigned char*)d_ws;
    void* kargs[] = {&a};
    hipError_t e = hipLaunchCooperativeKernel((const void*)fwd_mega, dim3(grid), dim3(NT), kargs, LDS_BYTES, stream);
    if (e != hipSuccess) fprintf(stderr, "cooperative launch failed: %s (grid %d)\n", hipGetErrorString(e), grid);
}
```

```cpp
#include <hip/hip_runtime.h>
#include <hip/hip_cooperative_groups.h>
#include <cstdio>
#include <cstdint>
namespace cg = cooperative_groups;
#ifndef PROBE_REP
#define PROBE_REP -1
#endif
#ifndef EXPV
#define EXPV 0
#endif
#ifndef TSK
#define TSK -1
#endif
#define STAMP(i) do { if ((TSK) >= 0 && blockIdx.x == 0 && threadIdx.x == 0) ((unsigned long long*)(a.ws + 240 * 1024))[i] = __builtin_amdgcn_s_memrealtime(); } while (0)
#define ASTAMP(k) do { if ((TSK) >= 20 && blockIdx.x == 0 && threadIdx.x == 0) { const unsigned long long t_ = __builtin_amdgcn_s_memrealtime(); T.tsa[k] += t_ - T.tsa[15]; T.tsa[15] = t_; } } while (0)
#define REPS(k) _Pragma("nounroll") for (int rep_ = 0; rep_ < ((PROBE_REP) == (k) ? 2 : 1); ++rep_)
#define GSYNC() do { xcd_barrier(xbar); if ((PROBE_REP) == 100) xcd_barrier(xbar); } while (0)

#define LAS __attribute__((address_space(3)))
typedef unsigned short bf16_t;
typedef short bf16x8 __attribute__((ext_vector_type(8)));
typedef float f32x4 __attribute__((ext_vector_type(4)));
typedef float f32x2 __attribute__((ext_vector_type(2)));
typedef unsigned u32x4 __attribute__((ext_vector_type(4)));
typedef unsigned u32x2 __attribute__((ext_vector_type(2)));

constexpr int SEQ = 16384, DM = 1024, DIN = 3864, PP = 4096  , DFF = 2816, NUP = 5632;
constexpr int C_Q = 0, C_KC = 512, C_VC = 640, C_KSL = 768, C_VSL = 896, C_KWN = 1024, C_VWN = 1152, C_U = 1280, C_GA = 1792, C_GB = 2816, C_NG = 3840;
constexpr int VTP = SEQ + 64;
constexpr float EPS = 1e-6f;
constexpr float NEGF = -1e30f;

constexpr size_t MiB = 1u << 20;
constexpr size_t WS_RSTD1 = 0, WS_RSS2 = 64 * 1024, WS_RSS3 = 128 * 1024, WS_ROPEC = 256 * 1024, WS_ROPES = 768 * 1024;
constexpr size_t WS_ABAR = 1280 * 1024, WS_A128 = WS_ABAR + 16384, WS_BIASPE = WS_A128 + 16384, WS_BBAR = 1536 * 1024  ;
constexpr size_t WS_SBUF = 2 * MiB  , WS_HID = 4 * MiB  , WS_KCMP = 6 * MiB  , WS_VCMPT = 6 * MiB + 512 * 1024  ;
constexpr size_t WS_WUP = 8 * MiB, WS_WDOWN = 20 * MiB, WS_WIN = 26 * MiB, WS_WGLU = 34 * MiB, WS_WPA = 35 * MiB, WS_WPB = 36 * MiB, WS_WOUT = 37 * MiB, WS_W1K = 39 * MiB, WS_W1V = 40 * MiB;
constexpr size_t WS_XB = 41 * MiB, WS_MERGED = 41 * MiB, WS_PROJ = 73 * MiB, WS_VSLT = 202 * MiB + 512 * 1024, WS_VWNT = 207 * MiB;
constexpr size_t WS_X1B = 220 * MiB, WS_UPRAW = 26 * MiB, WS_ACT = 122 * MiB;
constexpr size_t WS_VMAX = 232 * 1024, WS_BAR = 192 * 1024, WS_KSL = 212 * MiB, WS_KWN = 216 * MiB;
constexpr size_t OUT_YA = 0, OUT_YBP = 16 * MiB, OUT_YB = 32 * MiB;
static_assert(WS_PROJ + (size_t)(SEQ + 32) * PP * 2 <= WS_VSLT, "proj");
static_assert(WS_VSLT + (size_t)128 * VTP * 2 + 4096 <= WS_VWNT && WS_VWNT + (size_t)128 * VTP * 2 + 4096 <= WS_X1B, "vt");
static_assert(WS_UPRAW + (size_t)33 * 256 * NUP * 2 <= WS_ACT && WS_ACT + (size_t)SEQ * DFF * 2 <= WS_X1B, "ffn");

__device__ __forceinline__ unsigned cvt_pk_bf16(float lo, float hi) { unsigned r; asm volatile("v_cvt_pk_bf16_f32 %0, %1, %2" : "=v"(r) : "v"(lo), "v"(hi)); return r; }
__device__ __forceinline__ float bf_lo(unsigned w) { return __uint_as_float(w << 16); }
__device__ __forceinline__ float bf_hi(unsigned w) { return __uint_as_float(w & 0xffff0000u); }
__device__ __forceinline__ float bf2f(bf16_t b) { return __uint_as_float((unsigned)b << 16); }
__device__ __forceinline__ float sigmoidf_(float v) { return 1.f / (1.f + __expf(-v)); }
__device__ __forceinline__ float gelu_tanh(float v) { const float z = 0.7978845608028654f * (v + 0.044715f * v * v * v); const float th = 1.f - 2.f / (__expf(2.f * z) + 1.f); return 0.5f * v * (1.f + th); }
__device__ __forceinline__ u32x4 pack8(f32x4 a, f32x4 b) { u32x4 w; w.x = cvt_pk_bf16(a[0], a[1]); w.y = cvt_pk_bf16(a[2], a[3]); w.z = cvt_pk_bf16(b[0], b[1]); w.w = cvt_pk_bf16(b[2], b[3]); return w; }

namespace pg8 {
#define PG8_LAS __attribute__((address_space(3)))
constexpr int BM = 256, BK = 64, HALF = 128, HTB = HALF * BK * 2, STAGE_BYTES = 8 * HTB, NXCD = 8, WGM = 8;
__host__ __device__ __forceinline__ int lds_byte(int r, int c) { const int st = (r >> 4) * 2 + (c >> 5), rr = r & 15, cc = c & 31, ob = rr * 64 + cc * 2; return st * 1024 + (ob ^ (((ob >> 9) & 1) << 5)); }
__host__ __device__ __forceinline__ void stage_rc(int b, int& R, int& C) { const int st = b / 1024, sb = b % 1024, swz = sb ^ (((sb >> 9) & 1) << 5); R = (st >> 1) * 16 + swz / 64; C = (st & 1) * 32 + (swz % 64) / 2; }
__host__ __device__ __forceinline__ int perm32(int rho) { const int n = rho >> 4, i = rho & 15; return 8 * (i >> 2) + 4 * n + (i & 3); }
struct Unit { int pm, pn, z; const char* A; const char* B; };
struct Gemm { int K; unsigned lda_b; unsigned kstepA; unsigned ldb_b; };
__device__ __forceinline__ bool tile_of(long L, int nM, int nN, int& pm, int& pn) {
    const int nwg = nM * nN; if (L >= nwg) return false;
    int wgid = (int)L; { const int q = nwg / NXCD, r = nwg % NXCD, xcd = wgid % NXCD, off = wgid / NXCD; wgid = (xcd < r ? xcd * (q + 1) : r * (q + 1) + (xcd - r) * q) + off; }
    const int nig = WGM * nN, gid = wgid / nig, fm = gid * WGM, gsz = (nM - fm) < WGM ? (nM - fm) : WGM;
    pm = fm + ((wgid % nig) % gsz); pn = (wgid % nig) / gsz; return true;
}
template <class Epi, class Sched, bool ALIGN_EPI = false, bool SP2 = false>
__device__ __forceinline__ void gemm_phase(PG8_LAS unsigned char* lds, const Gemm g, const Sched& S, const Epi& E) {
    int tid_ = threadIdx.x; asm volatile("" : "+v"(tid_));
    const int tid = tid_, wid = __builtin_amdgcn_readfirstlane(tid >> 6), lane = tid & 63, wr = wid >> 2, wc = wid & 3, fr = lane & 15, fq = lane >> 4;
    const int K = g.K, nt = K / BK;
    unsigned voffA[2], voffB[2];
#pragma unroll
    for (int i = 0; i < 2; ++i) { int R, C; stage_rc(tid * 16 + i * 8192, R, C); const int Rb = Epi::PERM ? ((R & ~31) + perm32(R & 31)) : R;
        voffA[i] = (unsigned)R * g.lda_b + (unsigned)C * 2u; voffB[i] = (unsigned)Rb * g.ldb_b + (unsigned)C * 2u; }
    const size_t kstepA = (size_t)g.kstepA, kstepB = (size_t)(BK * 2);
    const size_t hstepA = (size_t)HALF * g.lda_b, hstepB = (size_t)HALF * g.ldb_b;
    const unsigned ldsw = (unsigned)wid * 1024u;
    const int aoff = lds_byte(wr * 64 + fr, fq * 8), boff = lds_byte(wc * 32 + fr, fq * 8);
#define PG8_SA(b, h) (((b) * 2 + (h)) * HTB)
#define PG8_SB(b, h) ((4 + (b) * 2 + (h)) * HTB)
#define PG8_STAGE(bufoff, gbase, voff) do { _Pragma("unroll") for (int _i = 0; _i < 2; ++_i) \
        __builtin_amdgcn_global_load_lds((const unsigned*)((const char*)(gbase) + (voff)[_i]), (PG8_LAS unsigned*)(lds + (bufoff) + ldsw + _i * 8192), 16, 0, 0); } while (0)
#define PG8_LDA(dst, b, h) do { _Pragma("unroll") for (int m = 0; m < 4; ++m) _Pragma("unroll") for (int k = 0; k < 2; ++k) dst[m][k] = *(const PG8_LAS bf16x8*)(lds + PG8_SA(b, h) + aoff + m * 2048 + k * 1024); } while (0)
#define PG8_LDB(dst, b, h) do { _Pragma("unroll") for (int n = 0; n < 2; ++n) _Pragma("unroll") for (int k = 0; k < 2; ++k) dst[n][k] = *(const PG8_LAS bf16x8*)(lds + PG8_SB(b, h) + boff + n * 2048 + k * 1024); } while (0)
#define PG8_MMA(ai, bj, At, Bt) do { __builtin_amdgcn_s_setprio(1); _Pragma("unroll") for (int m = 0; m < 4; ++m) _Pragma("unroll") for (int n = 0; n < 2; ++n) _Pragma("unroll") for (int k = 0; k < 2; ++k) \
        acc[ai][bj][m][n] = __builtin_amdgcn_mfma_f32_16x16x32_bf16(Bt[n][k], At[m][k], acc[ai][bj][m][n], 0, 0, 0); __builtin_amdgcn_s_setprio(0); } while (0)
#define PG8_WAIT_V(n) asm volatile("s_waitcnt vmcnt(" #n ")" ::: "memory")
#define PG8_WAIT_L(n) asm volatile("s_waitcnt lgkmcnt(" #n ")" ::: "memory")
#define PG8_BAR __builtin_amdgcn_s_barrier()
#define PG8_SCHED __builtin_amdgcn_sched_barrier(0)
    Unit cur, nxt; int ui = 0;
    if (!S.next(0, cur)) return;
    f32x4 acc[2][2][4][2];
#pragma unroll
    for (int a = 0; a < 2; ++a)
#pragma unroll
        for (int b = 0; b < 2; ++b)
#pragma unroll
            for (int m = 0; m < 4; ++m)
#pragma unroll
                for (int n = 0; n < 2; ++n) acc[a][b][m][n] = (f32x4){0.f, 0.f, 0.f, 0.f};
    bf16x8 At[4][2], B0[2][2], B1[2][2];
    const char* cA = cur.A; const char* cB = cur.B;
    if constexpr (SP2) {
        PG8_STAGE(PG8_SB(0, 0), cB, voffB); PG8_STAGE(PG8_SB(0, 1), cB + hstepB, voffB); PG8_STAGE(PG8_SA(0, 0), cA, voffA); PG8_STAGE(PG8_SA(0, 1), cA + hstepA, voffA);
        if (wr == 1) PG8_BAR;
        PG8_WAIT_V(2); PG8_BAR;
        PG8_STAGE(PG8_SB(1, 0), cB + kstepB, voffB); PG8_STAGE(PG8_SA(1, 0), cA + kstepA, voffA); PG8_STAGE(PG8_SB(1, 1), cB + hstepB + kstepB, voffB);
        PG8_WAIT_V(6); PG8_BAR;
    } else {
        PG8_STAGE(PG8_SB(0, 0), cB, voffB); PG8_STAGE(PG8_SA(0, 0), cA, voffA); PG8_STAGE(PG8_SB(0, 1), cB + hstepB, voffB); PG8_STAGE(PG8_SA(0, 1), cA + hstepA, voffA);
        if (wr == 1) PG8_BAR;
        PG8_WAIT_V(4); PG8_BAR;
        PG8_STAGE(PG8_SB(1, 0), cB + kstepB, voffB); PG8_STAGE(PG8_SA(1, 0), cA + kstepA, voffA); PG8_STAGE(PG8_SB(1, 1), cB + hstepB + kstepB, voffB);
        PG8_WAIT_V(6); PG8_BAR;
    }
    for (;;) {
        const bool has_next = S.next(ui + 1, nxt);
        const char* nA = has_next ? nxt.A : cA; const char* nB = has_next ? nxt.B : cB;
        for (int t = 0; t < nt; t += 2) {
            const bool last = (t == nt - 2);
            const char* a1 = cA + (size_t)(t + 1) * kstepA;
            const char* a2 = last ? nA : cA + (size_t)(t + 2) * kstepA; const char* b2 = last ? nB : cB + (size_t)(t + 2) * kstepB;
            const char* a3 = a2 + kstepA; const char* b3 = b2 + kstepB;
            if constexpr (SP2) {
            PG8_LDB(B0, 0, 0); PG8_LDB(B1, 0, 1); PG8_SCHED; PG8_LDA(At, 0, 0); PG8_STAGE(PG8_SA(1, 1), a1 + hstepA, voffA);
            PG8_WAIT_V(8); PG8_WAIT_L(0); PG8_BAR; PG8_MMA(0, 0, At, B0); PG8_MMA(0, 1, At, B1); PG8_BAR; PG8_SCHED;
            PG8_LDA(At, 0, 1); PG8_STAGE(PG8_SB(0, 0), b2, voffB); PG8_STAGE(PG8_SB(0, 1), b2 + hstepB, voffB); PG8_STAGE(PG8_SA(0, 0), a2, voffA);
            PG8_WAIT_V(8); PG8_WAIT_L(0); PG8_BAR; PG8_MMA(1, 0, At, B0); PG8_MMA(1, 1, At, B1); PG8_BAR; PG8_SCHED;
            PG8_LDB(B0, 1, 0); PG8_LDB(B1, 1, 1); PG8_SCHED; PG8_LDA(At, 1, 0); PG8_STAGE(PG8_SA(0, 1), a2 + hstepA, voffA);
            PG8_WAIT_V(8); PG8_WAIT_L(0); PG8_BAR; PG8_MMA(0, 0, At, B0); PG8_MMA(0, 1, At, B1); PG8_BAR; PG8_SCHED;
            PG8_LDA(At, 1, 1); PG8_STAGE(PG8_SB(1, 0), b3, voffB); PG8_STAGE(PG8_SB(1, 1), b3 + hstepB, voffB); PG8_STAGE(PG8_SA(1, 0), a3, voffA);
            PG8_WAIT_V(8); PG8_WAIT_L(0); PG8_BAR; PG8_MMA(1, 0, At, B0); PG8_MMA(1, 1, At, B1); PG8_BAR; PG8_SCHED;
            } else {
            PG8_LDB(B0, 0, 0); PG8_SCHED; PG8_LDA(At, 0, 0); PG8_STAGE(PG8_SA(1, 1), a1 + hstepA, voffA);
            PG8_WAIT_L(8); PG8_BAR; PG8_WAIT_L(0); PG8_MMA(0, 0, At, B0); PG8_BAR; PG8_SCHED;
            PG8_LDB(B1, 0, 1); PG8_STAGE(PG8_SB(0, 0), b2, voffB);
            PG8_BAR; PG8_WAIT_L(0); PG8_MMA(0, 1, At, B1); PG8_BAR;
            PG8_LDA(At, 0, 1); PG8_STAGE(PG8_SA(0, 0), a2, voffA);
            PG8_BAR; PG8_WAIT_L(0); PG8_MMA(1, 0, At, B0); PG8_BAR; PG8_SCHED;
            PG8_STAGE(PG8_SB(0, 1), b2 + hstepB, voffB);
            PG8_WAIT_V(6); PG8_BAR; PG8_MMA(1, 1, At, B1); PG8_BAR;
            PG8_LDB(B0, 1, 0); PG8_SCHED; PG8_LDA(At, 1, 0); PG8_STAGE(PG8_SA(0, 1), a2 + hstepA, voffA);
            PG8_WAIT_L(8); PG8_BAR; PG8_WAIT_L(0); PG8_MMA(0, 0, At, B0); PG8_BAR; PG8_SCHED;
            PG8_LDB(B1, 1, 1); PG8_STAGE(PG8_SB(1, 0), b3, voffB);
            PG8_BAR; PG8_WAIT_L(0); PG8_MMA(0, 1, At, B1); PG8_BAR;
            PG8_LDA(At, 1, 1); PG8_STAGE(PG8_SA(1, 0), a3, voffA);
            PG8_BAR; PG8_WAIT_L(0); PG8_MMA(1, 0, At, B0); PG8_BAR; PG8_SCHED;
            PG8_STAGE(PG8_SB(1, 1), b3 + hstepB, voffB);
            PG8_WAIT_V(6); PG8_BAR; PG8_MMA(1, 1, At, B1); PG8_BAR;
            }
        }
        if constexpr (ALIGN_EPI) { if (wr == 0) PG8_BAR; }
        E(acc, cur, wr, wc, fr, fq);
        if (!has_next) break;
#pragma unroll
        for (int a = 0; a < 2; ++a)
#pragma unroll
            for (int b = 0; b < 2; ++b)
#pragma unroll
                for (int m = 0; m < 4; ++m)
#pragma unroll
                    for (int n = 0; n < 2; ++n) acc[a][b][m][n] = (f32x4){0.f, 0.f, 0.f, 0.f};
        cur = nxt; cA = nA; cB = nB; ++ui;
        if constexpr (ALIGN_EPI) { if (wr == 1) PG8_BAR; }
    }
    PG8_WAIT_V(0);
    if constexpr (!ALIGN_EPI) { if (wr == 0) PG8_BAR; }
    PG8_BAR;
#undef PG8_SA
#undef PG8_SB
#undef PG8_STAGE
#undef PG8_LDA
#undef PG8_LDB
#undef PG8_MMA
#undef PG8_WAIT_V
#undef PG8_WAIT_L
#undef PG8_BAR
#undef PG8_SCHED
}
}


struct SchedMN {
    int nM, nN, nz, G, c, pm_off; const char* A0; const char* A1; const char* B0; const char* B1; size_t a_tile, b_tile;
    __device__ __forceinline__ bool next(int i, pg8::Unit& u) const {
        int pm, pn; if (!pg8::tile_of((long)(i / nz) * G + c, nM, nN, pm, pn)) return false;
        u.z = i % nz; u.pm = pm + pm_off; u.pn = pn; u.A = (u.z ? A1 : A0) + (size_t)u.pm * a_tile; u.B = (u.z ? B1 : B0) + (size_t)pn * b_tile; return true;
    }
};
struct SchedCmp {
    int c; const char* proj; const char* w1k; const char* w1v;
    __device__ __forceinline__ bool next(int i, pg8::Unit& u) const {
        if (i > 0 || c >= 64) return false;
        const int ks = c & 3; u.pm = (c >> 2) & 3; u.z = c >> 4; u.pn = ks; const int which = u.z >> 1, kh = u.z & 1;
        u.A = proj + ((size_t)(16 * 256 * u.pm + 8 * ks) * PP + (which ? C_VC : C_KC) + kh * 64) * 2; u.B = (which ? w1v : w1k) + (size_t)ks * 512 * 2; return true;
    }
};

#define EPI_LOOP_ROWS for (int ai = 0; ai < 2; ++ai) _Pragma("unroll") for (int m = 0; m < 4; ++m)

struct EpiProj {
    static constexpr bool PERM = true;
    bf16_t* proj; bf16_t* vslt; bf16_t* vwnt; bf16_t* kslc; bf16_t* kwnc; const float* rstd; const float* ropec; const float* ropes;
    __device__ __forceinline__ void operator()(const f32x4 (&acc)[2][2][4][2], const pg8::Unit& u, int wr, int wc, int fr, int fq) const {
        const int pn = u.pn; const int row0 = u.pm * 256 + wr * 64 + fr;
        const bool sig = pn >= 7;
#pragma unroll
        EPI_LOOP_ROWS {
            const int row = row0 + ai * 128 + m * 16; const float rs = rstd[row];
            f32x4 c0 = {1.f, 1.f, 1.f, 1.f}, c1 = c0, s0 = {0.f, 0.f, 0.f, 0.f}, s1 = s0;
            if ((pn <= 1 || pn == 3 || pn == 4) && (wc & 1) == 0) { c0 = *(const f32x4*)(ropec + row * 8); c1 = *(const f32x4*)(ropec + row * 8 + 4); s0 = *(const f32x4*)(ropes + row * 8); s1 = *(const f32x4*)(ropes + row * 8 + 4); }
#pragma unroll
            for (int bj = 0; bj < 2; ++bj) {
                f32x4 v0 = acc[ai][bj][m][0] * rs, v1 = acc[ai][bj][m][1] * rs;
                const int colt = bj * 128 + wc * 32 + 8 * fq;
                const bool ropet = (pn <= 1) || ((pn == 3 || pn == 4) && bj == 0);
                if (ropet && (wc & 1) == 0) {
                    f32x4 p0, p1;
#pragma unroll
                    for (int e = 0; e < 4; ++e) { p0[e] = __shfl_xor(v0[e], 16); p1[e] = __shfl_xor(v1[e], 16); }
                    if (fq == 0) { v0 = v0 * c0 - p0 * s0; v1 = v1 * c1 - p1 * s1; }
                    else if (fq == 1) { v0 = v0 * c0 + p0 * s0; v1 = v1 * c1 + p1 * s1; }
                }
                if (pn <= 1) { v0 = v0 * (0.125f * 1.4426950408889634f); v1 = v1 * (0.125f * 1.4426950408889634f); }
                if (sig) {
#pragma unroll
                    for (int e = 0; e < 4; ++e) { v0[e] = sigmoidf_(v0[e]); v1[e] = sigmoidf_(v1[e]); }
                }
                const u32x4 w = pack8(v0, v1);
                if (!((pn == 3 || pn == 4))) *(u32x4*)(proj + (size_t)row * PP + pn * 256 + colt) = w;
                if ((pn == 3 || pn == 4) && bj == 0) { bf16_t* kc = (pn == 3) ? kslc : kwnc; *(u32x4*)(kc + ((size_t)(colt >> 6) * SEQ + row) * 64 + (colt & 63)) = w; }
                if ((pn == 3 || pn == 4) && bj == 1) {
                    bf16_t* vt = ((pn == 3) ? vslt : vwnt) + ((size_t)((colt - 128) >> 6) * 256 + (row >> 6)) * 4096 + (size_t)((colt - 128) & 63) * 64 + (row & 63);
                    vt[0 * 64] = (bf16_t)(w.x & 0xffff); vt[1 * 64] = (bf16_t)(w.x >> 16); vt[2 * 64] = (bf16_t)(w.y & 0xffff); vt[3 * 64] = (bf16_t)(w.y >> 16);
                    vt[4 * 64] = (bf16_t)(w.z & 0xffff); vt[5 * 64] = (bf16_t)(w.z >> 16); vt[6 * 64] = (bf16_t)(w.w & 0xffff); vt[7 * 64] = (bf16_t)(w.w >> 16);
                }
            }
        }
    }
};

struct EpiCmp {
    static constexpr bool PERM = true;
    float* hidp;
    __device__ __forceinline__ void operator()(const f32x4 (&acc)[2][2][4][2], const pg8::Unit& u, int wr, int wc, int fr, int fq) const {
        const int row0 = u.pm * 256 + wr * 64 + fr;
#pragma unroll
        for (int bj = 0; bj < 2; ++bj) {
            const int col = bj * 128 + wc * 32 + 8 * fq;
#pragma unroll
            EPI_LOOP_ROWS {
                const int row = row0 + ai * 128 + m * 16; float* d = hidp + (((size_t)u.pn * 4 + u.z) * 1024 + row) * 256 + col;
                *(f32x4*)d = acc[ai][bj][m][0]; *(f32x4*)(d + 4) = acc[ai][bj][m][1];
            }
        }
    }
};

struct EpiGlu {
    static constexpr bool PERM = true;
    const bf16_t* ybp; bf16_t* yb;
    __device__ __forceinline__ void operator()(const f32x4 (&acc)[2][2][4][2], const pg8::Unit& u, int wr, int wc, int fr, int fq) const {
        const int row0 = u.pm * 256 + wr * 64 + fr;
#pragma unroll
        EPI_LOOP_ROWS {
            const int row = row0 + ai * 128 + m * 16;
#pragma unroll
            for (int bj = 0; bj < 2; ++bj) {
                const size_t off = (size_t)row * 512 + u.pn * 256 + bj * 128 + wc * 32 + 8 * fq;
                const u32x4 y = *(const u32x4*)(ybp + off);
                f32x4 v0 = acc[ai][bj][m][0], v1 = acc[ai][bj][m][1];
                v0[0] = bf_lo(y.x) * sigmoidf_(v0[0]); v0[1] = bf_hi(y.x) * sigmoidf_(v0[1]); v0[2] = bf_lo(y.y) * sigmoidf_(v0[2]); v0[3] = bf_hi(y.y) * sigmoidf_(v0[3]);
                v1[0] = bf_lo(y.z) * sigmoidf_(v1[0]); v1[1] = bf_hi(y.z) * sigmoidf_(v1[1]); v1[2] = bf_lo(y.w) * sigmoidf_(v1[2]); v1[3] = bf_hi(y.w) * sigmoidf_(v1[3]);
                *(u32x4*)(yb + off) = pack8(v0, v1);
            }
        }
    }
};

struct EpiMerge {
    static constexpr bool PERM = true;
    const bf16_t* proj; bf16_t* merged;
    __device__ __forceinline__ void operator()(const f32x4 (&acc)[2][2][4][2], const pg8::Unit& u, int wr, int wc, int fr, int fq) const {
        const int row0 = u.pm * 256 + wr * 64 + fr; const int gcol = u.z ? C_GB : C_GA;
#pragma unroll
        EPI_LOOP_ROWS {
            const int row = row0 + ai * 128 + m * 16;
#pragma unroll
            for (int bj = 0; bj < 2; ++bj) {
                const int col = u.pn * 256 + bj * 128 + wc * 32 + 8 * fq;
                const u32x4 gt = *(const u32x4*)(proj + (size_t)row * PP + gcol + col);
                f32x4 v0 = acc[ai][bj][m][0], v1 = acc[ai][bj][m][1];
                v0[0] *= bf_lo(gt.x); v0[1] *= bf_hi(gt.x); v0[2] *= bf_lo(gt.y); v0[3] *= bf_hi(gt.y);
                v1[0] *= bf_lo(gt.z); v1[1] *= bf_hi(gt.z); v1[2] *= bf_lo(gt.w); v1[3] *= bf_hi(gt.w);
                bf16_t* dst = merged + (size_t)row * DM + col;
                if (u.z) { const u32x4 o = *(const u32x4*)dst;
                    v0[0] += bf_lo(o.x); v0[1] += bf_hi(o.x); v0[2] += bf_lo(o.y); v0[3] += bf_hi(o.y); v1[0] += bf_lo(o.z); v1[1] += bf_hi(o.z); v1[2] += bf_lo(o.w); v1[3] += bf_hi(o.w); }
                *(u32x4*)dst = pack8(v0, v1);
            }
        }
    }
};

struct EpiRes {
    static constexpr bool PERM = true;
    const float* xin; float* xo; bf16_t* xb; float* rss;
    __device__ __forceinline__ void operator()(const f32x4 (&acc)[2][2][4][2], const pg8::Unit& u, int wr, int wc, int fr, int fq) const {
        const int row0 = u.pm * 256 + wr * 64 + fr;
#pragma unroll
        EPI_LOOP_ROWS {
            const int row = row0 + ai * 128 + m * 16; float ss = 0.f;
#pragma unroll
            for (int bj = 0; bj < 2; ++bj) {
                const size_t off = (size_t)row * DM + u.pn * 256 + bj * 128 + wc * 32 + 8 * fq;
                const f32x4 v0 = *(const f32x4*)(xin + off) + acc[ai][bj][m][0], v1 = *(const f32x4*)(xin + off + 4) + acc[ai][bj][m][1];
                *(f32x4*)(xo + off) = v0; *(f32x4*)(xo + off + 4) = v1;
                if (xb) *(u32x4*)(xb + off) = pack8(v0, v1);
                ss += (v0[0] * v0[0] + v0[1] * v0[1]) + (v0[2] * v0[2] + v0[3] * v0[3]) + (v1[0] * v1[0] + v1[1] * v1[1]) + (v1[2] * v1[2] + v1[3] * v1[3]);
            }
            ss += __shfl_xor(ss, 16); ss += __shfl_xor(ss, 32);
            if (fq == 0) atomicAdd(rss + row, ss);
        }
    }
};

struct EpiUp {
    static constexpr bool PERM = true;
    bf16_t* up; const float* rss; int rowbase;
    __device__ __forceinline__ void operator()(const f32x4 (&acc)[2][2][4][2], const pg8::Unit& u, int wr, int wc, int fr, int fq) const {
        const int row0 = u.pm * 256 + wr * 64 + fr;
#pragma unroll
        EPI_LOOP_ROWS {
            const int row = row0 + ai * 128 + m * 16; const float rs = rsqrtf(rss[row] * (1.f / DM) + EPS);
#pragma unroll
            for (int bj = 0; bj < 2; ++bj) {
                const size_t off = (size_t)(row - rowbase) * NUP + u.pn * 256 + bj * 128 + wc * 32 + 8 * fq;
                *(u32x4*)(up + off) = pack8(acc[ai][bj][m][0] * rs, acc[ai][bj][m][1] * rs);
            }
        }
    }
};

struct Args { const float* in[28]; float* out; unsigned char* ws; };
constexpr int NT = 512, NWV = 8;
constexpr int LDS_BYTES = 147456;

__device__ __forceinline__ float wave_sum(float v) {
#pragma unroll
    for (int o = 1; o < 64; o <<= 1) v += __shfl_xor(v, o);
    return v;
}

#define XB_TMO      128
#define XB_XCNT(j)  (256  + 64 * (j))
#define XB_XSUB(j)  (1280 + 64 * (j))
#define XB_XGEN(j)  (2304 + 64 * (j))
#define XB_TOP      3328
#define XB_TOPGEN   3392
#define XCD_BAR_WORDS 3456
#define XB_SPIN_CAP (1u << 18)

__device__ __forceinline__ unsigned xb_ld(unsigned* p)              { return __hip_atomic_load(p, __ATOMIC_RELAXED, __HIP_MEMORY_SCOPE_AGENT); }
__device__ __forceinline__ unsigned xb_add(unsigned* p, unsigned v) { return __hip_atomic_fetch_add(p, v, __ATOMIC_RELAXED, __HIP_MEMORY_SCOPE_AGENT); }
__device__ __forceinline__ unsigned xb_xcc_id() { return (unsigned)__builtin_amdgcn_s_getreg((3 << 11) | 20) & 0xFu; }
#define XB_SPIN(cond, bar) do { unsigned _sp = 0; while (cond) { __builtin_amdgcn_s_sleep(1); \
    if ((++_sp & 255u) == 0u) { if (xb_ld(&(bar)[XB_TMO])) break; if (_sp > XB_SPIN_CAP) { atomicAdd(&(bar)[XB_TMO], 1u); break; } } } } while (0)

struct XcdBarrier {
    unsigned* bar; unsigned x;
    volatile LAS unsigned* st;
};

__device__ __forceinline__ XcdBarrier xcd_barrier_post(unsigned* bar, volatile LAS unsigned* st) {
    XcdBarrier b; b.bar = bar; b.x = xb_xcc_id(); b.st = st;
    if (threadIdx.x == 0) (void)xb_add(&bar[XB_XCNT(b.x)], 1u);
    return b;
}
__device__ __forceinline__ void xcd_barrier_complete(unsigned* bar, unsigned x, unsigned& nloc, unsigned& nx) {
    const unsigned G = gridDim.x * gridDim.y * gridDim.z;
    unsigned sum, cnt, mine, sp = 0u;
    for (;;) {
        sum = 0u; cnt = 0u; mine = 0u;
#pragma unroll
        for (unsigned j = 0; j < 16; ++j) { const unsigned c = xb_ld(&bar[XB_XCNT(j)]); sum += c; cnt += (c > 0u) ? 1u : 0u; mine = (j == x) ? c : mine; }
        if (sum == G) break;
        __builtin_amdgcn_s_sleep(1);
        if ((++sp & 255u) == 0u) { if (xb_ld(&bar[XB_TMO])) break; if (sp > XB_SPIN_CAP) { atomicAdd(&bar[XB_TMO], 1u); break; } }
    }
    nloc = mine > 0u ? mine : 1u; nx = cnt > 0u ? cnt : 1u;
}

__device__ __forceinline__ void xcd_barrier(const XcdBarrier& b) {
    asm volatile("s_waitcnt vmcnt(0)" ::: "memory");
    __syncthreads();
    if (threadIdx.x == 0) {
        unsigned* bar = b.bar;
        __builtin_amdgcn_s_waitcnt(0);
        unsigned nloc = b.st[0], nx = b.st[1];
        if (nloc == 0u) { xcd_barrier_complete(bar, b.x, nloc, nx); b.st[0] = nloc; b.st[1] = nx; }
        const unsigned old = xb_add(&bar[XB_XSUB(b.x)], 1u);
        const unsigned gen = old / nloc;
        if (old + 1u == (gen + 1u) * nloc) {
            __builtin_amdgcn_fence(__ATOMIC_RELEASE, "agent");
            asm volatile("s_waitcnt vmcnt(0)" ::: "memory");
            const unsigned og = xb_add(&bar[XB_TOP], 1u);
            const unsigned tg = og / nx;
            if (og + 1u == (tg + 1u) * nx) xb_add(&bar[XB_TOPGEN], 1u);
            else XB_SPIN(xb_ld(&bar[XB_TOPGEN]) == tg, bar);
            __builtin_amdgcn_fence(__ATOMIC_ACQUIRE, "agent");
            xb_add(&bar[XB_XGEN(b.x)], 1u);
            asm volatile("s_waitcnt vmcnt(0)" ::: "memory");
        } else {
            XB_SPIN(xb_ld(&bar[XB_XGEN(b.x)]) == gen, bar);
            __builtin_amdgcn_fence(__ATOMIC_ACQUIRE, "agent");
            asm volatile("s_waitcnt vmcnt(0)" ::: "memory");
        }
    }
    __syncthreads();
}

__device__ __forceinline__ int colmap(int kind, int c) {
    if (kind == 1) return c < 1280 ? c : (c < 1304 ? C_NG + (c - 1280) : c - 24);
    if (kind == 2) { return c < DFF ? (c >> 7) * 256 + (c & 127) : ((c - DFF) >> 7) * 256 + 128 + ((c - DFF) & 127); }
    return c;
}
__device__ __forceinline__ void transpose_item(const float* W, int K, int N, bf16_t* WT, LAS float* scr, int kb, int nb, int lane, const float* kscale, int kind) {
    const int k0 = 64 * kb, n0 = 32 * nb;
#pragma unroll
    for (int i = 0; i < 8; ++i) { const int kk = 8 * i + (lane >> 3), nq = (lane & 7) * 4, n = n0 + nq;
        f32x4 v = (n < N) ? *(const f32x4*)(W + (size_t)(k0 + kk) * N + n) : (f32x4){0.f, 0.f, 0.f, 0.f}; if (kscale) v = v * kscale[k0 + kk];
        LAS float* d = scr + kk * 33 + nq; d[0] = v[0]; d[1] = v[1]; d[2] = v[2]; d[3] = v[3]; }
    asm volatile("s_waitcnt lgkmcnt(0)" ::: "memory");
    const int c = lane & 7;
#pragma unroll
    for (int j = 0; j < 4; ++j) { const int n = (lane >> 3) + 8 * j; const LAS float* s = scr + (8 * c) * 33 + n;
        if (n0 + n < N) { u32x4 o; o.x = cvt_pk_bf16(s[0 * 33], s[1 * 33]); o.y = cvt_pk_bf16(s[2 * 33], s[3 * 33]); o.z = cvt_pk_bf16(s[4 * 33], s[5 * 33]); o.w = cvt_pk_bf16(s[6 * 33], s[7 * 33]);
            *(u32x4*)(WT + (size_t)colmap(kind, n0 + n) * K + k0 + 8 * c) = o; } }
    asm volatile("s_waitcnt lgkmcnt(0)" ::: "memory");
}

#define EXP2(x) __builtin_amdgcn_exp2f(x)
#define MFMA16(a, b, c) __builtin_amdgcn_mfma_f32_16x16x32_bf16((a), (b), (c), 0, 0, 0)
__device__ __forceinline__ float dpp_x1(float v) { return __int_as_float(__builtin_amdgcn_update_dpp(0, __float_as_int(v), 0xB1, 0xF, 0xF, true)); }
__device__ __forceinline__ float dpp_x2(float v) { return __int_as_float(__builtin_amdgcn_update_dpp(0, __float_as_int(v), 0x4E, 0xF, 0xF, true)); }
struct KOp { bf16x8 a00, a01, a10, a11; };
struct VOp { bf16x8 v0, v1, v2, v3; };
__device__ __forceinline__ KOp ldk(const bf16_t* Kb, size_t pitch, int kb, int lane) {
    const int i = lane & 15, q = lane >> 4;
    const bf16_t* r0 = Kb + (size_t)(kb + 8 * (i >> 2) + (i & 3)) * pitch + 8 * q; const bf16_t* r1 = r0 + 4 * pitch;
    KOp k; k.a00 = *(const bf16x8*)r0; k.a01 = *(const bf16x8*)(r0 + 32); k.a10 = *(const bf16x8*)r1; k.a11 = *(const bf16x8*)(r1 + 32); return k;
}
__device__ __forceinline__ VOp ldv(const bf16_t* Vt, size_t vpitch, int kb, int lane) {
    const int i = lane & 15, q = lane >> 4; const size_t base = (vpitch == 64) ? (size_t)(kb >> 6) * 4096 + (kb & 63) : (size_t)kb;
    const bf16_t* r = Vt + base + (size_t)i * vpitch + 8 * q;
    VOp v; v.v0 = *(const bf16x8*)r; v.v1 = *(const bf16x8*)(r + 16 * vpitch); v.v2 = *(const bf16x8*)(r + 32 * vpitch); v.v3 = *(const bf16x8*)(r + 48 * vpitch); return v;
}
__device__ __forceinline__ void qk32(const KOp& k, const bf16x8& Bq0, const bf16x8& Bq1, f32x4& S0, f32x4& S1) {
    const f32x4 z = {0.f, 0.f, 0.f, 0.f};
    S0 = MFMA16(k.a00, Bq0, z); S0 = MFMA16(k.a01, Bq1, S0); S1 = MFMA16(k.a10, Bq0, z); S1 = MFMA16(k.a11, Bq1, S1);
}
__device__ __forceinline__ void pv32(const VOp& v, const bf16x8& P, f32x4 (&O)[4]) {
    O[0] = MFMA16(v.v0, P, O[0]); O[1] = MFMA16(v.v1, P, O[1]); O[2] = MFMA16(v.v2, P, O[2]); O[3] = MFMA16(v.v3, P, O[3]);
}
__device__ __forceinline__ bf16x8 packP(const f32x4& p0, const f32x4& p1) { u32x4 w = pack8(p0, p1); return __builtin_bit_cast(bf16x8, w); }

struct KbLin { int base; __device__ __forceinline__ int operator()(int i) const { return base + 32 * i; } };
struct KbLds { const LAS int* l; __device__ __forceinline__ int operator()(int i) const { return l[i]; } };

template <bool NEEDV, class KB, class Body>
__device__ __forceinline__ void pipe3(int n, const KB kbf, Body& body, const bf16_t* Kb, size_t kp, const bf16_t* Vt, size_t vp, int lane) {
    if (n <= 0) return;
    KOp k0, k1; VOp v;
    k0 = ldk(Kb, kp, kbf(0), lane);
    for (int i = 0; i < n; i += 2) {
        { const int kb = kbf(i); if (NEEDV) v = ldv(Vt, vp, kb, lane); k1 = ldk(Kb, kp, kbf(i + 1 < n ? i + 1 : n - 1), lane); body.run(kb, k0, v); }
        if (i + 1 >= n) break;
        { const int kb = kbf(i + 1); if (NEEDV) v = ldv(Vt, vp, kb, lane); k0 = ldk(Kb, kp, kbf(i + 2 < n ? i + 2 : n - 1), lane); body.run(kb, k1, v); }
    }
}

constexpr int AL_CKV = 81920  , CKV_HALF = 9216, CKV_BUF = 18432;
template <bool NEEDV, class Body>
__device__ __forceinline__ void cmp_shared(int nsteps, Body& body, const bf16_t* Kc, const bf16_t* Vc, LAS unsigned char* buf, int tid, int lane, int kb0 = 0, int vrp = 1024, int vcs = 64, int vch0 = 0) {
    const int nch = (nsteps + 1) >> 1; if (nch <= 0) return;
    const int srow = tid >> 3, spc = tid & 7, i = lane & 15, q = lane >> 4;
    u32x4 rk = *(const u32x4*)(Kc + (size_t)(kb0 + srow) * 64 + spc * 8), rv = rk;
    if (NEEDV) rv = *(const u32x4*)(Vc + (size_t)srow * vrp + (size_t)vch0 * vcs + spc * 8);
    *(LAS u32x4*)(buf + srow * 144 + spc * 16) = rk; if (NEEDV) *(LAS u32x4*)(buf + CKV_HALF + srow * 144 + spc * 16) = rv;
    __syncthreads();
    for (int ch = 0; ch < nch; ++ch) {
        const LAS unsigned char* cur = buf + (ch & 1) * CKV_BUF; LAS unsigned char* nxt = buf + ((ch + 1) & 1) * CKV_BUF;
        const bool more = ch + 1 < nch;
        if (more) { rk = *(const u32x4*)(Kc + (size_t)(kb0 + 64 * (ch + 1) + srow) * 64 + spc * 8); if (NEEDV) rv = *(const u32x4*)(Vc + (size_t)srow * vrp + (size_t)(vch0 + ch + 1) * vcs + spc * 8); }
#pragma unroll
        for (int h = 0; h < 2; ++h) {
            const int st = 2 * ch + h;
            if (st < nsteps) {
                const LAS unsigned char* kr = cur + (32 * h + 8 * (i >> 2) + (i & 3)) * 144 + 16 * q;
                KOp k; k.a00 = *(const LAS bf16x8*)kr; k.a01 = *(const LAS bf16x8*)(kr + 64); k.a10 = *(const LAS bf16x8*)(kr + 4 * 144); k.a11 = *(const LAS bf16x8*)(kr + 4 * 144 + 64);
                VOp v; if (NEEDV) { const LAS unsigned char* vr = cur + CKV_HALF + i * 144 + (32 * h + 8 * q) * 2;
                    v.v0 = *(const LAS bf16x8*)vr; v.v1 = *(const LAS bf16x8*)(vr + 16 * 144); v.v2 = *(const LAS bf16x8*)(vr + 32 * 144); v.v3 = *(const LAS bf16x8*)(vr + 48 * 144); }
                else { v.v0 = k.a00; v.v1 = k.a00; v.v2 = k.a00; v.v3 = k.a00; }
                body.run(kb0 + 32 * st, k, v);
            }
        }
        if (more) { *(LAS u32x4*)(nxt + srow * 144 + spc * 16) = rk; if (NEEDV) *(LAS u32x4*)(nxt + CKV_HALF + srow * 144 + spc * 16) = rv; }
        __syncthreads();
    }
}

struct BodyCmp1 {
    bf16x8 Bq[2][2]; int nv[2], q; float ml[2], ll[2];
    __device__ __forceinline__ void run(int kb, const KOp& k, const VOp&) {
#pragma unroll
        for (int cg = 0; cg < 2; ++cg) {
            f32x4 S0, S1; qk32(k, Bq[cg][0], Bq[cg][1], S0, S1);
            const int k0 = kb + 8 * q; float mloc = NEGF;
#pragma unroll
            for (int e = 0; e < 4; ++e) { if (k0 + e >= nv[cg]) S0[e] = NEGF; if (k0 + 4 + e >= nv[cg]) S1[e] = NEGF; mloc = fmaxf(mloc, fmaxf(S0[e], S1[e])); }
            const float mn = fmaxf(ml[cg], mloc); float ps = 0.f;
#pragma unroll
            for (int e = 0; e < 4; ++e) { ps += (k0 + e < nv[cg]) ? EXP2(S0[e] - mn) : 0.f; ps += (k0 + 4 + e < nv[cg]) ? EXP2(S1[e] - mn) : 0.f; }
            ll[cg] = ll[cg] * EXP2(ml[cg] - mn) + ps; ml[cg] = mn;
        }
    }
};
struct BodyCmp2 {
    bf16x8 Bq[2][2]; int nv[2], q, g, lane_; float mc[2], inv[2], carry[2]; LAS float* ia[2]; f32x4 O[2][4];
    __device__ __forceinline__ void run(int kb, const KOp& k, const VOp& v) {
#pragma unroll
        for (int cg = 0; cg < 2; ++cg) {
            f32x4 S0, S1; qk32(k, Bq[cg][0], Bq[cg][1], S0, S1);
            const int k0 = kb + 8 * q; f32x4 p0, p1;
#pragma unroll
            for (int e = 0; e < 4; ++e) { p0[e] = (k0 + e < nv[cg]) ? EXP2(S0[e] - mc[cg]) * inv[cg] : 0.f; p1[e] = (k0 + 4 + e < nv[cg]) ? EXP2(S1[e] - mc[cg]) * inv[cg] : 0.f; }
            f32x4 s0 = p0, s1 = p1;
#pragma unroll
            for (int e = 0; e < 4; ++e) { s0[e] += dpp_x1(s0[e]); s0[e] += dpp_x2(s0[e]); s1[e] += dpp_x1(s1[e]); s1[e] += dpp_x2(s1[e]); }
            const float bout = 0.5f * s1[3]; const float recv = __shfl(bout, (lane_ + 48) & 63); const float bin = (q == 0) ? carry[cg] : recv; carry[cg] = recv;
            if (g == 0) { const int j = k0 >> 2; ia[cg][j] = ((s0[0] + s0[1]) + (s0[2] + 0.5f * s0[3])) + bin; ia[cg][j + 1] = 0.5f * s0[3] + ((s1[0] + s1[1]) + (s1[2] + 0.5f * s1[3])); }
            pv32(v, packP(p0, p1), O[cg]);
        }
    }
};
struct BodyWin {
    bf16x8 Bq[2][2]; int q, tt[2]; float m[2], l[2]; f32x4 O[2][4];
    __device__ __forceinline__ void run(int kb, const KOp& k, const VOp& v) {
#pragma unroll
        for (int cg = 0; cg < 2; ++cg) {
            f32x4 S0, S1; qk32(k, Bq[cg][0], Bq[cg][1], S0, S1);
            const int k0 = kb + 8 * q; unsigned vm = 0u;
#pragma unroll
            for (int e = 0; e < 8; ++e) { const bool ok = (k0 + e <= tt[cg]) && (tt[cg] - (k0 + e) < 512); vm |= ok ? (1u << e) : 0u; }
            float mloc = NEGF;
#pragma unroll
            for (int e = 0; e < 4; ++e) { if (!((vm >> e) & 1u)) S0[e] = NEGF; if (!((vm >> (4 + e)) & 1u)) S1[e] = NEGF; mloc = fmaxf(mloc, fmaxf(S0[e], S1[e])); }
            mloc = fmaxf(mloc, __shfl_xor(mloc, 16)); mloc = fmaxf(mloc, __shfl_xor(mloc, 32));
            const float mn = fmaxf(m[cg], mloc), alpha = EXP2(m[cg] - mn); m[cg] = mn;
            f32x4 p0, p1; float ps = 0.f;
#pragma unroll
            for (int e = 0; e < 4; ++e) { p0[e] = ((vm >> e) & 1u) ? EXP2(S0[e] - mn) : 0.f; p1[e] = ((vm >> (4 + e)) & 1u) ? EXP2(S1[e] - mn) : 0.f; ps += p0[e] + p1[e]; }
            l[cg] = l[cg] * alpha + ps;
#pragma unroll
            for (int dt = 0; dt < 4; ++dt) O[cg][dt] = O[cg][dt] * alpha;
            pv32(v, packP(p0, p1), O[cg]);
        }
    }
};

struct AttnT { float fxs; unsigned long long* tsa; const bf16_t* proj; const bf16_t* kslc; const bf16_t* kwnc; const bf16_t* kcmp; const bf16_t* vcmpT; const bf16_t* vslT; const bf16_t* vwnT; bf16_t* ya; };

constexpr int AL_IMP = 0  , AL_OS = 0  , AL_TM = 67584  , AL_CNT = 69632  ,
              AL_OFF = 70656  , AL_UNITS = 71744  , AL_MM = 77888  , AL_LS = 78912  ;
constexpr int AL_Q = 81920  , QROWB = 528;
constexpr int OSP = 33;
constexpr float FXB = 67108864.0f;
typedef short s16x2 __attribute__((ext_vector_type(2)));
__device__ __forceinline__ int f2ord(float f) { const int b = __float_as_int(f); return b >= 0 ? b : b ^ 0x7fffffff; }
__device__ __forceinline__ float ord2f(int b) { return __int_as_float(b >= 0 ? b : b ^ 0x7fffffff); }

__device__ __forceinline__ void attn_wave_part1(const AttnT& T, int kh, int tq8, int lane, LAS float* imp  , LAS unsigned* tm, int wave, LAS unsigned char* lds, int tid) {
    const int col = lane & 15, q = lane >> 4, tk = col >> 2, g = col & 3;
    const int t0 = tq8 * 8, h = kh * 4 + g;
    bf16x8 Bq[2][2]; float g0[2], g2[2]; int tcg[2];
#pragma unroll
    for (int cg = 0; cg < 2; ++cg) { tcg[cg] = t0 + 4 * cg + tk; const bf16_t* prow = T.proj + (size_t)tcg[cg] * PP;
        Bq[cg][0] = *(const bf16x8*)(prow + C_Q + h * 64 + 8 * q); Bq[cg][1] = *(const bf16x8*)(prow + C_Q + h * 64 + 32 + 8 * q);
        g0[cg] = bf2f(prow[C_NG + h * 3 + 0]); g2[cg] = bf2f(prow[C_NG + h * 3 + 2]); }
    for (int i = lane; i < 8 * 264; i += 64) imp[i] = 0.f;
    {
        const bf16_t* Kc = T.kcmp + (size_t)kh * 1024 * 64; const bf16_t* Vc = T.vcmpT + (size_t)kh * 64 * 1024;
        const int tmax = (t0 | 63), nvmax = tmax >= 31 ? ((tmax - 31) >> 4) + 1 : 0, nsteps = (nvmax + 31) >> 5;
        BodyCmp1 b1;
#pragma unroll
        for (int cg = 0; cg < 2; ++cg) { b1.Bq[cg][0] = Bq[cg][0]; b1.Bq[cg][1] = Bq[cg][1]; b1.nv[cg] = tcg[cg] >= 31 ? ((tcg[cg] - 31) >> 4) + 1 : 0; b1.ml[cg] = NEGF; b1.ll[cg] = 0.f; }
        b1.q = q;
        cmp_shared<false>(nsteps, b1, Kc, Vc, lds + AL_CKV, tid, lane);
        BodyCmp2 b2; b2.q = q; b2.g = g; b2.lane_ = lane; b2.carry[0] = 0.f; b2.carry[1] = 0.f;
#pragma unroll
        for (int cg = 0; cg < 2; ++cg) {
            float mc = fmaxf(b1.ml[cg], __shfl_xor(b1.ml[cg], 16)); mc = fmaxf(mc, __shfl_xor(mc, 32));
            float lc = b1.ll[cg] * EXP2(b1.ml[cg] - mc); lc += __shfl_xor(lc, 16); lc += __shfl_xor(lc, 32);
            b2.Bq[cg][0] = Bq[cg][0]; b2.Bq[cg][1] = Bq[cg][1]; b2.nv[cg] = b1.nv[cg]; b2.mc[cg] = mc; b2.inv[cg] = 1.f / fmaxf(lc, 1e-30f); b2.ia[cg] = imp + (4 * cg + tk) * 264;
#pragma unroll
            for (int dt = 0; dt < 4; ++dt) b2.O[cg][dt] = (f32x4){0.f, 0.f, 0.f, 0.f};
        }
        asm volatile("s_waitcnt lgkmcnt(0)" ::: "memory");
        cmp_shared<true>(nsteps, b2, Kc, Vc, lds + AL_CKV, tid, lane);
        if (q == 0 && g == 0 && nsteps > 0) { b2.ia[0][8 * nsteps] = b2.carry[0]; b2.ia[1][8 * nsteps] = b2.carry[1]; }
#pragma unroll
        for (int cg = 0; cg < 2; ++cg) { bf16_t* yrow = T.ya + (size_t)tcg[cg] * 512 + h * 64 + 4 * q;
#pragma unroll
            for (int dt = 0; dt < 4; ++dt) { const f32x4 o = b2.O[cg][dt] * g0[cg]; u32x2 w; w.x = cvt_pk_bf16(o[0], o[1]); w.y = cvt_pk_bf16(o[2], o[3]); *(u32x2*)(yrow + 16 * dt) = w; } }
    }
    asm volatile("s_waitcnt lgkmcnt(0)" ::: "memory");
    for (int tk2 = 0; tk2 < 8; ++tk2) {
        const int tt = t0 + tk2, cur = tt >> 6, nvalid = cur + 1, KSEL = nvalid < 16 ? nvalid : 16;
        int bits[4];
#pragma unroll
        for (int s = 0; s < 4; ++s) { const int j = s * 64 + lane; const float v = imp[tk2 * 264 + j];
            bits[s] = (j == 0 || j == cur) ? 0x7F000000 : (j < nvalid ? __float_as_int(v) : -1); }
        int prefix = 0;
        for (int bit = 30; bit >= 0; --bit) { const int Tt = prefix | (1 << bit); int cnt = 0;
#pragma unroll
            for (int s = 0; s < 4; ++s) cnt += __popcll(__ballot(bits[s] >= Tt));
            if (cnt >= KSEL) prefix = Tt; }
        unsigned long long sel[4]; int need = KSEL;
#pragma unroll
        for (int s = 0; s < 4; ++s) { sel[s] = __ballot(bits[s] > prefix); need -= __popcll(sel[s]); }
#pragma unroll
        for (int s = 0; s < 4; ++s) { unsigned long long me = __ballot(bits[s] == prefix);
            while (me != 0ull && need > 0) { const unsigned long long low = me & (0ull - me); sel[s] |= low; me ^= low; --need; } }
        const int tbi = wave * 8 + tk2; const unsigned tbit = 1u << (tbi & 31);
#pragma unroll
        for (int s = 0; s < 4; ++s) if ((sel[s] >> lane) & 1ull) __hip_atomic_fetch_or(tm + (s * 64 + lane) * 2 + (tbi >> 5), tbit, __ATOMIC_RELAXED, __HIP_MEMORY_SCOPE_WORKGROUP);
    }
    {
        const bf16_t* Kw = T.kwnc + (size_t)kh * SEQ * 64; const bf16_t* Vw = T.vwnT + (size_t)kh * 256 * 4096;
        const int tb = t0 & ~63; const int klo = (tb - 511 > 0 ? tb - 511 : 0) & ~63; const int n = ((tb + 63 - klo) >> 5) + 1;
        BodyWin bo; bo.q = q;
#pragma unroll
        for (int cg = 0; cg < 2; ++cg) { bo.Bq[cg][0] = Bq[cg][0]; bo.Bq[cg][1] = Bq[cg][1]; bo.tt[cg] = tcg[cg]; bo.m[cg] = NEGF; bo.l[cg] = 0.f;
#pragma unroll
            for (int dt = 0; dt < 4; ++dt) bo.O[cg][dt] = (f32x4){0.f, 0.f, 0.f, 0.f}; }
        cmp_shared<true>(n, bo, Kw, Vw, lds + AL_CKV, tid, lane, klo, 64, 4096, klo >> 6);
#pragma unroll
        for (int cg = 0; cg < 2; ++cg) { float l = bo.l[cg]; l += __shfl_xor(l, 16); l += __shfl_xor(l, 32);
            const float sc = g2[cg] / fmaxf(l, 1e-30f); bf16_t* yrow = T.ya + (size_t)tcg[cg] * 512 + h * 64 + 4 * q;
#pragma unroll
            for (int dt = 0; dt < 4; ++dt) { const u32x2 y = *(const u32x2*)(yrow + 16 * dt); const f32x4 o = bo.O[cg][dt] * sc;
                u32x2 w; w.x = cvt_pk_bf16(bf_lo(y.x) + o[0], bf_hi(y.x) + o[1]); w.y = cvt_pk_bf16(bf_lo(y.y) + o[2], bf_hi(y.y) + o[3]); *(u32x2*)(yrow + 16 * dt) = w; } }
    }
    asm volatile("s_waitcnt lgkmcnt(0)" ::: "memory");
}

struct UnitPre { int j; unsigned tlo, thi; bf16x8 q00, q01, q10, q11; KOp ka, kb; VOp va, vb; };
template <int PASS>
__device__ __forceinline__ UnitPre unit_load(const LAS unsigned char* qlds, const bf16_t* Ks, const bf16_t* Vs, int kh, int tile, const LAS u32x4* units, int u, int lane) {
    const int col = lane & 15, q = lane >> 4, slot = col >> 2, g = col & 3;
    const u32x4 d = units[u]; UnitPre P; P.j = __builtin_amdgcn_readfirstlane((int)d.x); P.tlo = (unsigned)__builtin_amdgcn_readfirstlane((int)d.y); P.thi = (unsigned)__builtin_amdgcn_readfirstlane((int)d.z);
    const unsigned t0b = (P.tlo >> (8 * slot)) & 0xffu, t1b = (P.thi >> (8 * slot)) & 0xffu;
    const LAS unsigned char* qr0 = qlds + (t0b == 0xffu ? 0 : (int)t0b) * QROWB + g * 128 + 16 * q;
    const LAS unsigned char* qr1 = qlds + (t1b == 0xffu ? 0 : (int)t1b) * QROWB + g * 128 + 16 * q;
    P.q00 = *(const LAS bf16x8*)qr0; P.q01 = *(const LAS bf16x8*)(qr0 + 64); P.q10 = *(const LAS bf16x8*)qr1; P.q11 = *(const LAS bf16x8*)(qr1 + 64);
    P.ka = ldk(Ks, 64, 64 * P.j, lane); P.kb = ldk(Ks, 64, 64 * P.j + 32, lane);
    if (PASS == 1) { if ((EXPV) == 2) { P.va.v0 = P.ka.a00; P.va.v1 = P.ka.a01; P.va.v2 = P.ka.a10; P.va.v3 = P.ka.a11; P.vb = P.va; } else { P.va = ldv(Vs, 64, 64 * P.j, lane); P.vb = ldv(Vs, 64, 64 * P.j + 32, lane); } }
    return P;
}
template <int PASS>
__device__ __forceinline__ void unit_group(const UnitPre& P, const bf16x8& q0, const bf16x8& q1, unsigned toks, int tile, LAS unsigned char* lds, float fxs, int lane) {
    const int col = lane & 15, q = lane >> 4, slot = col >> 2, g = col & 3;
    const int ti = (int)((toks >> (8 * slot)) & 0xffu);
    f32x4 S0a, S1a, S0b, S1b; qk32(P.ka, q0, q1, S0a, S1a); qk32(P.kb, q0, q1, S0b, S1b);
    const bool valid = ti != 0xff; const int row = (valid ? ti : 0) * 4 + g;
    const int lim = (P.j == tile) ? (valid ? ti : -1) - 8 * q : (valid ? 1000 : -1);
    LAS int* mm = (LAS int*)(lds + AL_MM); LAS float* ls = (LAS float*)(lds + AL_LS);
    if (PASS == 0) {
        float mloc = NEGF;
#pragma unroll
        for (int e = 0; e < 4; ++e) { mloc = fmaxf(mloc, e <= lim ? S0a[e] : NEGF); mloc = fmaxf(mloc, e + 4 <= lim ? S1a[e] : NEGF); mloc = fmaxf(mloc, e + 32 <= lim ? S0b[e] : NEGF); mloc = fmaxf(mloc, e + 36 <= lim ? S1b[e] : NEGF); }
        if ((EXPV) != 4) { mloc = fmaxf(mloc, __shfl_xor(mloc, 16)); mloc = fmaxf(mloc, __shfl_xor(mloc, 32)); }
        if (q == 0 && valid && (EXPV) != 3) __hip_atomic_fetch_max(mm + row, f2ord(mloc), __ATOMIC_RELAXED, __HIP_MEMORY_SCOPE_WORKGROUP);
    } else {
        const float m = ord2f(mm[row]);
        f32x4 p0a, p1a, p0b, p1b; float ps = 0.f;
#pragma unroll
        for (int e = 0; e < 4; ++e) { p0a[e] = e <= lim ? EXP2(S0a[e] - m) : 0.f; p1a[e] = e + 4 <= lim ? EXP2(S1a[e] - m) : 0.f; p0b[e] = e + 32 <= lim ? EXP2(S0b[e] - m) : 0.f; p1b[e] = e + 36 <= lim ? EXP2(S1b[e] - m) : 0.f;
            ps += (p0a[e] + p1a[e]) + (p0b[e] + p1b[e]); }
        ps += __shfl_xor(ps, 16); ps += __shfl_xor(ps, 32);
        if (q == 0 && valid) __hip_atomic_fetch_add(ls + row, ps, __ATOMIC_RELAXED, __HIP_MEMORY_SCOPE_WORKGROUP);
        f32x4 O[4];
#pragma unroll
        for (int dt = 0; dt < 4; ++dt) O[dt] = (f32x4){0.f, 0.f, 0.f, 0.f};
        pv32(P.va, packP(p0a, p1a), O); pv32(P.vb, packP(p0b, p1b), O);
        if (valid) { LAS unsigned long long* orow = (LAS unsigned long long*)(lds + AL_OS) + row * OSP + 2 * q;
#pragma unroll
            for (int dt = 0; dt < 4; ++dt) {
                const unsigned a0 = (unsigned)((int)rintf(O[dt][0] * fxs) + (1 << 26)), a1 = (unsigned)((int)rintf(O[dt][1] * fxs) + (1 << 26)), a2 = (unsigned)((int)rintf(O[dt][2] * fxs) + (1 << 26)), a3 = (unsigned)((int)rintf(O[dt][3] * fxs) + (1 << 26));
                __hip_atomic_fetch_add(orow + 8 * dt, (unsigned long long)a0 | ((unsigned long long)a1 << 32), __ATOMIC_RELAXED, __HIP_MEMORY_SCOPE_WORKGROUP);
                __hip_atomic_fetch_add(orow + 8 * dt + 1, (unsigned long long)a2 | ((unsigned long long)a3 << 32), __ATOMIC_RELAXED, __HIP_MEMORY_SCOPE_WORKGROUP); } }
    }
}
template <int PASS>
__device__ __forceinline__ void unit_compute(const UnitPre& P, int tile, LAS unsigned char* lds, float fxs, int lane) {
    unit_group<PASS>(P, P.q00, P.q01, P.tlo, tile, lds, fxs, lane);
    if (P.thi != 0xffffffffu) unit_group<PASS>(P, P.q10, P.q11, P.thi, tile, lds, fxs, lane);
}
template <int PASS>
__device__ __forceinline__ void unit_pass(const AttnT& T, int kh, int tile, int n, LAS unsigned char* lds, int wave, int lane) {
    const bf16_t* Ks = T.kslc + (size_t)kh * SEQ * 64; const bf16_t* Vs = T.vslT + (size_t)kh * 256 * 4096;
    const LAS u32x4* units = (const LAS u32x4*)(lds + AL_UNITS);
    int u = wave; if (u >= n) return;
    UnitPre A = unit_load<PASS>(lds + AL_Q, Ks, Vs, kh, tile, units, u, lane), B = A;
    for (; u < n; u += 16) {
        const int u1 = u + 8; if (u1 < n) B = unit_load<PASS>(lds + AL_Q, Ks, Vs, kh, tile, units, u1, lane);
        unit_compute<PASS>(A, tile, lds, T.fxs, lane);
        if (u1 >= n) break;
        const int u2 = u + 16; if (u2 < n) A = unit_load<PASS>(lds + AL_Q, Ks, Vs, kh, tile, units, u2, lane);
        unit_compute<PASS>(B, tile, lds, T.fxs, lane);
    }
}

__device__ __forceinline__ void attn_tile(const AttnT& T, int kh, int tile, LAS unsigned char* lds, int tid, int wave, int lane) {
    LAS unsigned* tm = (LAS unsigned*)(lds + AL_TM);
    for (int i = tid; i < 512; i += NT) tm[i] = 0u;
    __syncthreads();
    if ((TSK) >= 20 && blockIdx.x == 0 && threadIdx.x == 0) T.tsa[15] = __builtin_amdgcn_s_memrealtime();
    attn_wave_part1(T, kh, tile * 8 + wave, lane, (LAS float*)(lds + AL_IMP + wave * 8448), tm, wave, lds, tid);
    __threadfence_block(); __syncthreads();
    { const int ti = tid >> 3, part = tid & 7; const u32x4* src = (const u32x4*)(T.proj + (size_t)(tile * 64 + ti) * PP + C_Q + kh * 256 + part * 32); LAS u32x4* dst = (LAS u32x4*)(lds + AL_Q + ti * QROWB + part * 64);
      dst[0] = src[0]; dst[1] = src[1]; dst[2] = src[2]; dst[3] = src[3]; }
    ASTAMP(0);
    LAS int* cnt = (LAS int*)(lds + AL_CNT); LAS int* off = (LAS int*)(lds + AL_OFF); LAS u32x4* units = (LAS u32x4*)(lds + AL_UNITS);
    for (int i = tid; i < 256 * OSP; i += NT) ((LAS unsigned long long*)(lds + AL_OS))[i] = 0ull;
    if (tid < 256) { ((LAS int*)(lds + AL_MM))[tid] = f2ord(NEGF); ((LAS float*)(lds + AL_LS))[tid] = 0.f; cnt[tid] = (__popc(tm[2 * tid]) + __popc(tm[2 * tid + 1]) + 7) >> 3; }
    __syncthreads();
    if (tid < 64) {
        const int c0 = cnt[4 * tid], c1 = cnt[4 * tid + 1], c2 = cnt[4 * tid + 2], c3 = cnt[4 * tid + 3]; const int tot = (c0 + c1) + (c2 + c3); int inc = tot;
#pragma unroll
        for (int o = 1; o < 64; o <<= 1) { const int v = __shfl_up(inc, o); if (tid >= o) inc += v; }
        const int ex = inc - tot; off[4 * tid] = ex; off[4 * tid + 1] = ex + c0; off[4 * tid + 2] = ex + c0 + c1; off[4 * tid + 3] = ex + c0 + c1 + c2;
        if (tid == 63) off[256] = inc;
    }
    __syncthreads();
    if (tid < 256) { unsigned long long mask = (unsigned long long)tm[2 * tid] | ((unsigned long long)tm[2 * tid + 1] << 32); int o = off[tid];
        while (mask != 0ull) { unsigned tl = 0xffffffffu, th = 0xffffffffu;
#pragma unroll
            for (int k = 0; k < 4; ++k) if (mask != 0ull) { const unsigned ti = (unsigned)__builtin_ctzll(mask); mask &= mask - 1ull; tl = (tl & ~(0xffu << (8 * k))) | (ti << (8 * k)); }
#pragma unroll
            for (int k = 0; k < 4; ++k) if (mask != 0ull) { const unsigned ti = (unsigned)__builtin_ctzll(mask); mask &= mask - 1ull; th = (th & ~(0xffu << (8 * k))) | (ti << (8 * k)); }
            units[o++] = (u32x4){(unsigned)tid, tl, th, 0u}; } }
    __syncthreads();
    const int n = off[256];
    ASTAMP(1);
    unit_pass<0>(T, kh, tile, n, lds, wave, lane);
    if ((PROBE_REP) == 42) unit_pass<0>(T, kh, tile, n, lds, wave, lane);
    __syncthreads();
    ASTAMP(2);
    unit_pass<1>(T, kh, tile, n, lds, wave, lane);
    __syncthreads();
    ASTAMP(3);
    { const int ti = tid >> 3, part = tid & 7, g = part >> 1, d0 = 32 * (part & 1), row = ti * 4 + g, t = tile * 64 + ti, h = kh * 4 + g;
      const float l = ((const LAS float*)(lds + AL_LS))[row]; const float sc = bf2f(T.proj[(size_t)t * PP + C_NG + h * 3 + 1]) / fmaxf(l, 1e-30f);
      const LAS unsigned long long* orow = (const LAS unsigned long long*)(lds + AL_OS) + row * OSP + (d0 >> 1); u32x4* yp = (u32x4*)(T.ya + (size_t)t * 512 + h * 64 + d0);
      const int nsel = ((t >> 6) + 1) < 16 ? ((t >> 6) + 1) : 16; const unsigned bias = (unsigned)nsel << 26; const float sc2 = sc / T.fxs;
#pragma unroll
      for (int i = 0; i < 4; ++i) { const u32x4 y = yp[i]; const unsigned long long o0 = orow[4 * i], o1 = orow[4 * i + 1], o2 = orow[4 * i + 2], o3 = orow[4 * i + 3]; f32x4 a, b;
          a[0] = bf_lo(y.x) + (float)(int)((unsigned)o0 - bias) * sc2; a[1] = bf_hi(y.x) + (float)(int)((unsigned)(o0 >> 32) - bias) * sc2; a[2] = bf_lo(y.y) + (float)(int)((unsigned)o1 - bias) * sc2; a[3] = bf_hi(y.y) + (float)(int)((unsigned)(o1 >> 32) - bias) * sc2;
          b[0] = bf_lo(y.z) + (float)(int)((unsigned)o2 - bias) * sc2; b[1] = bf_hi(y.z) + (float)(int)((unsigned)(o2 >> 32) - bias) * sc2; b[2] = bf_lo(y.w) + (float)(int)((unsigned)o3 - bias) * sc2; b[3] = bf_hi(y.w) + (float)(int)((unsigned)(o3 >> 32) - bias) * sc2;
          yp[i] = pack8(a, b); } }
    __syncthreads();
    ASTAMP(4);
    if ((TSK) >= 20 && blockIdx.x == 0 && threadIdx.x == 0) T.tsa[5] += (unsigned long long)n;
}

struct SsmB { bf16x8 a[8]; };
__device__ __forceinline__ SsmB ssm_load_b(const unsigned char* ws, int g, int lane) {
    const int i = lane & 15, q = lane >> 4; SsmB B; const bf16x8 z = {0, 0, 0, 0, 0, 0, 0, 0};
    const bf16_t* t = (const bf16_t*)(ws + WS_BBAR) + ((size_t)(g * 128 + i) * 16 + 8 * (q & 1));
#pragma unroll
    for (int rt = 0; rt < 8; ++rt) B.a[rt] = (q < 2) ? *(const bf16x8*)(t + (size_t)rt * 16 * 16) : z;
    return B;
}
__device__ __forceinline__ void ssm_bu16(const bf16x8& ub, const SsmB& B, int lane, LAS float* bul) {
    const int i = lane & 15, q = lane >> 4;
    const f32x4 z4 = {0.f, 0.f, 0.f, 0.f};
#pragma unroll
    for (int rt = 0; rt < 8; ++rt) { const f32x4 acc = MFMA16(B.a[rt], ub, z4); *(LAS f32x4*)(bul + i * 132 + 16 * rt + 4 * q) = acc; }
    asm volatile("s_waitcnt lgkmcnt(0)" ::: "memory");
}
struct SsmU { bf16x8 ub[8]; };
__device__ __forceinline__ SsmU ssm_load_u8(const bf16_t* proj, int c, int g, int lane) {
    const int i = lane & 15, q = lane >> 4; const bf16x8 z = {0, 0, 0, 0, 0, 0, 0, 0}; SsmU U;
#pragma unroll
    for (int sub = 0; sub < 8; ++sub) U.ub[sub] = (q < 2) ? *(const bf16x8*)(proj + (size_t)(c * 128 + sub * 16 + i) * PP + C_U + g * 16 + 8 * (q & 1)) : z;
    return U;
}
__device__ __forceinline__ f32x2 ssm_step(const f32x2 A, const f32x2 x, const f32x2 bu) { f32x2 r; r.x = A.x * x.x - A.y * x.y + bu.x; r.y = A.x * x.y + A.y * x.x + bu.y; return r; }
__device__ __forceinline__ void ssm_pass1(const unsigned char* ws, int c, int g, int lane, LAS float* bul) {
    const bf16_t* proj = (const bf16_t*)(ws + WS_PROJ);
    const SsmB B = ssm_load_b(ws, g, lane);
    const f32x2 A = ((const f32x2*)(ws + WS_ABAR))[g * 64 + lane];
    const SsmU U = ssm_load_u8(proj, c, g, lane);
    f32x2 x = {0.f, 0.f};
#pragma unroll
    for (int sub = 0; sub < 8; ++sub) {
        ssm_bu16(U.ub[sub], B, lane, bul);
#pragma unroll
        for (int s = 0; s < 16; ++s) x = ssm_step(A, x, *(const LAS f32x2*)(bul + s * 132 + 2 * lane));
        asm volatile("s_waitcnt lgkmcnt(0)" ::: "memory");
    }
    ((f32x2*)(ws + WS_SBUF))[(size_t)(c * 32 + g) * 64 + lane] = x;
}
__device__ __forceinline__ void ssm_pass3(const Args& a, int c, int g, int lane, LAS float* bul, LAS unsigned char* xl  ) {
    const unsigned char* ws = a.ws; const bf16_t* proj = (const bf16_t*)(ws + WS_PROJ);
    const SsmB B = ssm_load_b(ws, g, lane);
    const f32x2 A = ((const f32x2*)(ws + WS_ABAR))[g * 64 + lane], A128 = ((const f32x2*)(ws + WS_A128))[g * 64 + lane];
    const SsmU U = ssm_load_u8(proj, c, g, lane);
    u32x2 uwv[8];
#pragma unroll
    for (int sub = 0; sub < 8; ++sub) uwv[sub] = *(const u32x2*)(proj + (size_t)(c * 128 + sub * 16 + (lane & 15)) * PP + C_U + g * 16 + 4 * (lane >> 4));
    f32x2 x = {0.f, 0.f};
    { const f32x2* Sb = (const f32x2*)(ws + WS_SBUF) + g * 64 + lane;
      _Pragma("unroll 8") for (int cc = 0; cc < c; ++cc) { const f32x2 s = Sb[(size_t)cc * 32 * 64]; f32x2 r; r.x = A128.x * x.x - A128.y * x.y + s.x; r.y = A128.x * x.y + A128.y * x.x + s.y; x = r; } }
    const int hrow = lane & 15, q = lane >> 4; bf16x8 Cm[4];
    { const float* cre = a.in[14] + (size_t)(g * 16 + hrow) * 64; const float* cim = a.in[15] + (size_t)(g * 16 + hrow) * 64;
#pragma unroll
      for (int ks = 0; ks < 4; ++ks) { const f32x4 r = *(const f32x4*)(cre + 16 * ks + 4 * q), im = *(const f32x4*)(cim + 16 * ks + 4 * q);
          u32x4 w; w.x = cvt_pk_bf16(r[0], -im[0]); w.y = cvt_pk_bf16(r[1], -im[1]); w.z = cvt_pk_bf16(r[2], -im[2]); w.w = cvt_pk_bf16(r[3], -im[3]); Cm[ks] = __builtin_bit_cast(bf16x8, w); } }
    const f32x4 dsk = *(const f32x4*)(a.in[16] + g * 16 + 4 * q);
    bf16_t* ybp = (bf16_t*)((unsigned char*)a.out + OUT_YBP);
#pragma unroll
    for (int sub = 0; sub < 8; ++sub) {
        const int tok0 = c * 128 + sub * 16;
        ssm_bu16(U.ub[sub], B, lane, bul);
#pragma unroll
        for (int s = 0; s < 16; ++s) { x = ssm_step(A, x, *(const LAS f32x2*)(bul + s * 132 + 2 * lane)); *(LAS unsigned*)(xl + s * 272 + lane * 4) = cvt_pk_bf16(x.x, x.y); }
        asm volatile("s_waitcnt lgkmcnt(0)" ::: "memory");
        f32x4 acc = {0.f, 0.f, 0.f, 0.f};
#pragma unroll
        for (int ks = 0; ks < 4; ++ks) { const bf16x8 b = *(const LAS bf16x8*)(xl + hrow * 272 + ks * 64 + q * 16); acc = MFMA16(Cm[ks], b, acc); }
        const u32x2 uw = uwv[sub];
        const f32x4 uu = {bf_lo(uw.x), bf_hi(uw.x), bf_lo(uw.y), bf_hi(uw.y)};
        f32x4 y = acc + dsk * uu;
        u32x2 w; w.x = cvt_pk_bf16(gelu_tanh(y[0]), gelu_tanh(y[1])); w.y = cvt_pk_bf16(gelu_tanh(y[2]), gelu_tanh(y[3]));
        *(u32x2*)(ybp + (size_t)(tok0 + hrow) * 512 + g * 16 + 4 * q) = w;
        asm volatile("s_waitcnt lgkmcnt(0)" ::: "memory");
    }
}

__global__ void __launch_bounds__(NT, 2) fwd_mega(Args a) {
    extern __shared__ __attribute__((aligned(16))) unsigned char lds_raw[];
    cg::grid_group grid = cg::this_grid();
    LAS unsigned char* lds = (LAS unsigned char*)lds_raw;
    const int tid = threadIdx.x, lane = tid & 63, wave = __builtin_amdgcn_readfirstlane(tid >> 6);
    const int G = gridDim.x, bid = blockIdx.x;
    const int gw = bid * NWV + wave, NGW = G * NWV;
    const int gt = bid * NT + tid, NGT = G * NT;
    unsigned char* ws = a.ws;
    const float* x = a.in[0];
    STAMP(0);
    if ((TSK) >= 20 && blockIdx.x == 0 && threadIdx.x == 0) for (int i = 0; i < 16; ++i) ((unsigned long long*)(a.ws + 244 * 1024))[i] = 0ull;
    if (tid < 4) ((volatile LAS unsigned*)(lds + 131072 + 64))[tid] = 0u;
    if (bid == 0) for (int i = tid; i < XCD_BAR_WORDS; i += NT) ((unsigned*)(ws + WS_BAR))[i] = 0u;
    __syncthreads();

    {
        const int bb_ = G >= 256 ? 240 : 0;
        if (bid >= bb_ && bid < bb_ + 16) {
            LAS float* red = (LAS float*)lds;
            const int o = (bid - bb_) * 32 + (tid & 31), ksl = tid >> 5, which = o >> 8, colc = o & 255;
            const float* pe = a.in[which ? 7 : 4]; const float* w1 = a.in[which ? 8 : 5]; float s = 0.f;
            _Pragma("unroll 16") for (int k = ksl * 128; k < ksl * 128 + 128; ++k) s += pe[k] * w1[(size_t)k * 256 + colc];
            red[ksl * 32 + (tid & 31)] = s; __syncthreads();
            if (tid < 32) { float t = 0.f; for (int i = 0; i < 16; ++i) t += red[i * 32 + tid]; ((float*)(ws + WS_BIASPE))[o] = t; }
            __syncthreads();
        }
        LAS float* scr = (LAS float*)(lds + wave * 8448);
        constexpr int I_IN = 16 * 121, I_GLU = 8 * 16, I_PA = 8 * 32, I_OUT = 16 * 32, I_UP = 16 * 176, I_DN = 44 * 32, I_W1 = 32 * 8;
        constexpr int NITEMS = I_IN + I_GLU + 2 * I_PA + I_OUT + I_UP + I_DN + 2 * I_W1;
        for (int it = gw; it < NITEMS; it += NGW) {
            int r = it;
            if (r < I_IN) { transpose_item(a.in[3], 1024, DIN, (bf16_t*)(ws + WS_WIN), scr, r / 121, r % 121, lane, a.in[2], 1); continue; } r -= I_IN;
            if (r < I_GLU) { transpose_item(a.in[18], 512, 512, (bf16_t*)(ws + WS_WGLU), scr, r / 16, r % 16, lane, nullptr, 0); continue; } r -= I_GLU;
            if (r < I_PA) { transpose_item(a.in[19], 512, 1024, (bf16_t*)(ws + WS_WPA), scr, r / 32, r % 32, lane, nullptr, 0); continue; } r -= I_PA;
            if (r < I_PA) { transpose_item(a.in[20], 512, 1024, (bf16_t*)(ws + WS_WPB), scr, r / 32, r % 32, lane, nullptr, 0); continue; } r -= I_PA;
            if (r < I_OUT) { transpose_item(a.in[21], 1024, 1024, (bf16_t*)(ws + WS_WOUT), scr, r / 32, r % 32, lane, nullptr, 0); continue; } r -= I_OUT;
            if (r < I_UP) { transpose_item(a.in[23], 1024, NUP, (bf16_t*)(ws + WS_WUP), scr, r / 176, r % 176, lane, a.in[22], 2); continue; } r -= I_UP;
            if (r < I_DN) { transpose_item(a.in[26], DFF, 1024, (bf16_t*)(ws + WS_WDOWN), scr, r / 32, r % 32, lane, nullptr, 0); continue; } r -= I_DN;
            if (r < I_W1) { transpose_item(a.in[5], 2048, 256, (bf16_t*)(ws + WS_W1K), scr, r / 8, r % 8, lane, nullptr, 0); continue; } r -= I_W1;
            transpose_item(a.in[8], 2048, 256, (bf16_t*)(ws + WS_W1V), scr, r / 8, r % 8, lane, nullptr, 0);
        }
        { u32x4* p = (u32x4*)(ws + WS_WIN + (size_t)DIN * 1024 * 2); const int n = (4096 - DIN) * 1024 * 2 / 16; for (int i = gt; i < n; i += NGT) p[i] = (u32x4){0u, 0u, 0u, 0u}; }
        { u32x4* p = (u32x4*)(ws + WS_PROJ + (size_t)SEQ * PP * 2); const int n = 32 * PP * 2 / 16; for (int i = gt; i < n; i += NGT) p[i] = (u32x4){0u, 0u, 0u, 0u}; }
        for (int i = gt; i < 128 * 64 + 2048; i += NGT) {
            if (i < 128 * 64) { const int r = i >> 6, cidx = SEQ + (i & 63); ((bf16_t*)(ws + WS_VSLT))[(size_t)r * VTP + cidx] = 0; ((bf16_t*)(ws + WS_VWNT))[(size_t)r * VTP + cidx] = 0; }
            else { const int j = i - 128 * 64; ((bf16_t*)(ws + WS_VSLT))[(size_t)128 * VTP + j] = 0; ((bf16_t*)(ws + WS_VWNT))[(size_t)128 * VTP + j] = 0; }
        }
        for (int i = gt; i < SEQ; i += NGT) { ((float*)(ws + WS_RSS2))[i] = 0.f; ((float*)(ws + WS_RSS3))[i] = 0.f; }
        if (gt == 0) *(unsigned*)(ws + WS_VMAX) = 0u;
        { const int* pos = (const int*)a.in[1];
          for (int i = gt; i < SEQ * 8; i += NGT) { const int tt = i >> 3, fi = i & 7; const float invf = powf(500000.0f, -(float)(2 * fi) / 16.0f); const float ang = (float)pos[tt] * invf;
              float sn, cs; sincosf(ang, &sn, &cs); ((float*)(ws + WS_ROPEC))[i] = cs; ((float*)(ws + WS_ROPES))[i] = sn; } }
        const int sb_ = G >= 256 ? 210 : 0;
        for (int i = (bid - sb_) * NT + tid; bid >= sb_ && i < 2048; i += NGT) { const int gg = i >> 6;
            const float dt = expf(a.in[17][gg]), ar = a.in[10][i], ai = a.in[11][i];
            const float e = expf(ar * dt), em1 = expm1f(ar * dt), th = ai * dt; float sn, cs; sincosf(th, &sn, &cs); const float sh = sinf(0.5f * th);
            const float Ax = e * cs, Ay = e * sn; const float nx = em1 * cs - 2.f * sh * sh, ny = e * sn;
            const float den = 1.f / (ar * ar + ai * ai); const float fx = (nx * ar + ny * ai) * den, fy = (ny * ar - nx * ai) * den;
            ((f32x2*)(ws + WS_ABAR))[i] = (f32x2){Ax, Ay};
            float px = Ax, py = Ay;
            for (int k = 0; k < 7; ++k) { const float qx = px * px - py * py, qy = 2.f * px * py; px = qx; py = qy; }
            ((f32x2*)(ws + WS_A128))[i] = (f32x2){px, py};
            const float* bre = a.in[12] + (size_t)i * 16; const float* bim = a.in[13] + (size_t)i * 16; const int pp = i & 63;
            bf16_t* Bo = (bf16_t*)(ws + WS_BBAR) + ((size_t)(gg * 128 + 2 * pp) * 16);
            for (int hh = 0; hh < 16; hh += 2) { *(unsigned*)(Bo + hh) = cvt_pk_bf16(fx * bre[hh] - fy * bim[hh], fx * bre[hh + 1] - fy * bim[hh + 1]);
                                                 *(unsigned*)(Bo + 16 + hh) = cvt_pk_bf16(fx * bim[hh] + fy * bre[hh], fx * bim[hh + 1] + fy * bre[hh + 1]); }
        }
        for (int r = gw; r < SEQ; r += NGW) {
            const f32x4* xr = (const f32x4*)(x + (size_t)r * DM) + lane; f32x4 v[4]; float s = 0.f;
#pragma unroll
            for (int j = 0; j < 4; ++j) { v[j] = xr[64 * j]; s += (v[j][0] * v[j][0] + v[j][1] * v[j][1]) + (v[j][2] * v[j][2] + v[j][3] * v[j][3]); }
            s = wave_sum(s);
            if (lane == 0) ((float*)(ws + WS_RSTD1))[r] = rsqrtf(s * (1.f / DM) + EPS);
            u32x2* o = (u32x2*)(ws + WS_XB + (size_t)r * DM * 2) + lane;
#pragma unroll
            for (int j = 0; j < 4; ++j) { u32x2 w; w.x = cvt_pk_bf16(v[j][0], v[j][1]); w.y = cvt_pk_bf16(v[j][2], v[j][3]); o[64 * j] = w; }
        }
    }
    grid.sync();
    STAMP(1);
    XcdBarrier xbar = xcd_barrier_post((unsigned*)(ws + WS_BAR), (volatile LAS unsigned*)(lds + 131072 + 64));

    REPS(1) {
        pg8::Gemm g{1024, 2048u, 128u, (unsigned)(1024) * 2u};
        SchedMN S{64, 16, 1, G, bid, 0, (const char*)(ws + WS_XB), nullptr, (const char*)(ws + WS_WIN), nullptr, (size_t)256 * 1024 * 2, (size_t)256 * 1024 * 2};
        EpiProj E{(bf16_t*)(ws + WS_PROJ), (bf16_t*)(ws + WS_VSLT), (bf16_t*)(ws + WS_VWNT), (bf16_t*)(ws + WS_KSL), (bf16_t*)(ws + WS_KWN), (const float*)(ws + WS_RSTD1), (const float*)(ws + WS_ROPEC), (const float*)(ws + WS_ROPES)};
        pg8::gemm_phase<EpiProj, SchedMN, true, true>(lds, g, S, E);
    }
    GSYNC();
    STAMP(2);

    {
        if (bid < 64) {
            pg8::Gemm g{512, (unsigned)(16 * PP * 2), (unsigned)(PP * 2), (unsigned)(2048) * 2u};
            SchedCmp S{bid, (const char*)(ws + WS_PROJ), (const char*)(ws + WS_W1K), (const char*)(ws + WS_W1V)};
            EpiCmp E{(float*)(ws + WS_XB)};
            pg8::gemm_phase<EpiCmp, SchedCmp, true, true>(lds, g, S, E);
        } else {
            LAS float* ubuf = (LAS float*)(lds + wave * 16384);
            for (int it = (bid - 64) * NWV + wave; it < 4096 * ((PROBE_REP) == 12 ? 2 : 1); it += (G - 64) * NWV) ssm_pass1(ws, (it & 4095) >> 5, it & 31, lane, ubuf);
        }
    }
    GSYNC();
    STAMP(3);

    REPS(3) {
        {
            const u32x4* vp = (const u32x4*)(ws + WS_VSLT); unsigned mx = 0u;
            for (int i = gt; i < 262144; i += NGT) { const u32x4 v = vp[i];
                mx = max(mx, max(max(v.x & 0x7fffu, (v.x >> 16) & 0x7fffu), max(v.y & 0x7fffu, (v.y >> 16) & 0x7fffu)));
                mx = max(mx, max(max(v.z & 0x7fffu, (v.z >> 16) & 0x7fffu), max(v.w & 0x7fffu, (v.w >> 16) & 0x7fffu))); }
#pragma unroll
            for (int o = 1; o < 64; o <<= 1) mx = max(mx, (unsigned)__shfl_xor((int)mx, o));
            LAS unsigned* red = (LAS unsigned*)(lds + 65536); if (lane == 0) red[wave] = mx; __syncthreads();
            if (tid == 0) { unsigned m8 = red[0]; for (int w = 1; w < NWV; ++w) m8 = max(m8, red[w]); atomicMax((unsigned*)(ws + WS_VMAX), m8); }
            __syncthreads();
        }
        const float* hidp = (const float*)(ws + WS_XB); LAS float* hrow = (LAS float*)(lds + wave * 1024);
        for (int r = gw; r < 4096; r += NGW) {
            const int z = r >> 10, n = r & 1023, which = z >> 1, kh = z & 1;
            float acc = 0.f;
            if (n < 1023) { const float* w2 = a.in[which ? 9 : 6];
                f32x4 hv = *(const f32x4*)((const float*)(ws + WS_BIASPE) + which * 256 + 4 * lane);
#pragma unroll
                for (int ks = 0; ks < 4; ++ks) hv += *(const f32x4*)(hidp + ((size_t)ks * 4096 + r) * 256 + 4 * lane);
                hv[0] = gelu_tanh(hv[0]); hv[1] = gelu_tanh(hv[1]); hv[2] = gelu_tanh(hv[2]); hv[3] = gelu_tanh(hv[3]);
                *(LAS f32x4*)(hrow + 4 * lane) = hv; asm volatile("s_waitcnt lgkmcnt(0)" ::: "memory");
                _Pragma("unroll 16") for (int k = 0; k < 256; k += 4) { const f32x4 h4 = *(const LAS f32x4*)(hrow + k);
                    acc += h4[0] * w2[k * 64 + lane]; acc += h4[1] * w2[(k + 1) * 64 + lane]; acc += h4[2] * w2[(k + 2) * 64 + lane]; acc += h4[3] * w2[(k + 3) * 64 + lane]; }
                asm volatile("s_waitcnt lgkmcnt(0)" ::: "memory"); }
            if (which == 0) {
                const float other = __shfl_xor(acc, 8); const int prow = 16 * n + 31; float o = acc;
                if (lane < 16 && n < 1023) { const float cs = ((const float*)(ws + WS_ROPEC))[prow * 8 + (lane & 7)], sn = ((const float*)(ws + WS_ROPES))[prow * 8 + (lane & 7)];
                    o = lane < 8 ? acc * cs - other * sn : acc * cs + other * sn; }
                ((bf16_t*)(ws + WS_KCMP))[((size_t)kh * 1024 + n) * 64 + lane] = (bf16_t)(cvt_pk_bf16(o, 0.f) & 0xffff);
            } else {
                ((bf16_t*)(ws + WS_VCMPT))[((size_t)kh * 64 + lane) * 1024 + n] = (bf16_t)(cvt_pk_bf16(acc, 0.f) & 0xffff);
            }
        }
    }
    GSYNC();
    STAMP(4);

    {
        AttnT T{0.f, (unsigned long long*)(ws + 244 * 1024), (const bf16_t*)(ws + WS_PROJ), (const bf16_t*)(ws + WS_KSL), (const bf16_t*)(ws + WS_KWN), (const bf16_t*)(ws + WS_KCMP), (const bf16_t*)(ws + WS_VCMPT), (const bf16_t*)(ws + WS_VSLT), (const bf16_t*)(ws + WS_VWNT), (bf16_t*)((unsigned char*)a.out + OUT_YA)};
        { const unsigned vb = __hip_atomic_load((unsigned*)(ws + WS_VMAX), __ATOMIC_RELAXED, __HIP_MEMORY_SCOPE_AGENT); const float vmax = fmaxf(__uint_as_float(vb << 16), 1e-30f); T.fxs = FXB / (64.0f * 1.01f * vmax); }
        LAS float* wl = (LAS float*)(lds + wave * 16384);
        for (int r2 = 0; r2 < ((PROBE_REP) == 4 ? 2 : 1); ++r2)
        for (int pr = bid; pr < 256; pr += G) {
            const int xcd = pr & 7, slot = pr >> 3, kh = xcd & 1, tl = 32 * (xcd >> 1) + slot;
_Pragma("nounroll")
            for (int k2 = 0; k2 < 2; ++k2) { int tk_ = threadIdx.x; asm volatile("" : "+v"(tk_)); attn_tile(T, kh, k2 ? 255 - tl : tl, lds, tk_, __builtin_amdgcn_readfirstlane(tk_ >> 6), tk_ & 63); }
        }
        if ((PROBE_REP) == 4) {
            AttnT T2 = T; T2.ya = (bf16_t*)(ws + WS_XB);
            for (int pr = bid; pr < 256; pr += G) { const int xcd = pr & 7, slot = pr >> 3, kh = xcd & 1, tl = 32 * (xcd >> 1) + slot;
                _Pragma("nounroll") for (int k2 = 0; k2 < 2; ++k2) attn_tile(T2, kh, k2 ? 255 - tl : tl, lds, tid, wave, lane); }
        }
        int tid2 = threadIdx.x; asm volatile("" : "+v"(tid2));
        const int lane2 = tid2 & 63, wave2 = __builtin_amdgcn_readfirstlane(tid2 >> 6), gw2 = bid * NWV + wave2;
        for (int it = gw2; it < 4096 * ((PROBE_REP) == 14 ? 2 : 1); it += NGW) ssm_pass3(a, (it & 4095) >> 5, it & 31, lane2, (LAS float*)(lds + wave2 * 16384), lds + wave2 * 16384 + 8448);
    }
    GSYNC();
    STAMP(5);

    REPS(5) {
        pg8::Gemm g{512, 1024u, 128u, (unsigned)(512) * 2u};
        SchedMN S{64, 2, 1, G, bid, 0, (const char*)a.out + OUT_YBP, nullptr, (const char*)(ws + WS_WGLU), nullptr, (size_t)256 * 512 * 2, (size_t)256 * 512 * 2};
        EpiGlu E{(const bf16_t*)((const unsigned char*)a.out + OUT_YBP), (bf16_t*)((unsigned char*)a.out + OUT_YB)};
        pg8::gemm_phase<EpiGlu, SchedMN, true, true>(lds, g, S, E);
    }
    GSYNC();
    STAMP(6);

    REPS(6) {
        pg8::Gemm g{512, 1024u, 128u, (unsigned)(512) * 2u};
        SchedMN S{64, 4, 2, G, bid, 0, (const char*)a.out + OUT_YA, (const char*)a.out + OUT_YB, (const char*)(ws + WS_WPA), (const char*)(ws + WS_WPB), (size_t)256 * 512 * 2, (size_t)256 * 512 * 2};
        EpiMerge E{(const bf16_t*)(ws + WS_PROJ), (bf16_t*)(ws + WS_MERGED)};
        pg8::gemm_phase<EpiMerge, SchedMN, true, true>(lds, g, S, E);
    }
    GSYNC();
    STAMP(7);

    {
        pg8::Gemm g{1024, 2048u, 128u, (unsigned)(1024) * 2u};
        SchedMN S{64, 4, 1, G, bid, 0, (const char*)(ws + WS_MERGED), nullptr, (const char*)(ws + WS_WOUT), nullptr, (size_t)256 * 1024 * 2, (size_t)256 * 1024 * 2};
        EpiRes E{x, a.out, (bf16_t*)(ws + WS_X1B), (float*)(ws + WS_RSS2)};
        pg8::gemm_phase<EpiRes, SchedMN, true, true>(lds, g, S, E);
    }
    GSYNC();
    STAMP(8);

    for (int half = 0; half < 2; ++half) {
        const int pm_off = half ? 31 : 0, nM = half ? 33 : 32, rowbase = pm_off * 256;
        REPS(8) {
            pg8::Gemm g{1024, 2048u, 128u, (unsigned)(1024) * 2u};
            SchedMN S{nM, 22, 1, G, bid, pm_off, (const char*)(ws + WS_X1B), nullptr, (const char*)(ws + WS_WUP), nullptr, (size_t)256 * 1024 * 2, (size_t)256 * 1024 * 2};
            EpiUp E{(bf16_t*)(ws + WS_UPRAW), (const float*)(ws + WS_RSS2), rowbase};
            pg8::gemm_phase<EpiUp, SchedMN, true, true>(lds, g, S, E);
        }
        GSYNC();
    STAMP(9);
        REPS(9) {
            const bf16_t* up = (const bf16_t*)(ws + WS_UPRAW); bf16_t* act = (bf16_t*)(ws + WS_ACT);
            const float* cw = a.in[24]; const float* cb = a.in[25];
            const int tlo = half ? 8192 : 0;
            for (int it = gt; it < 256 * 352; it += NGT) {
                const int cg8 = it % 352, tb = it / 352, c0 = cg8 * 8, tile = c0 >> 7, jj = c0 & 127;
                const int ucol = tile * 256 + jj;
                float wg[3][8], wv[3][8], bg[8], bv[8];
#pragma unroll
                for (int e = 0; e < 8; ++e) { bg[e] = cb[c0 + e]; bv[e] = cb[DFF + c0 + e];
#pragma unroll
                    for (int k = 0; k < 3; ++k) { wg[k][e] = cw[k * NUP + c0 + e]; wv[k][e] = cw[k * NUP + DFF + c0 + e]; } }
                const int ts = tlo + tb * 32;
                float g2[8], g1[8], v2[8], v1[8];
#pragma unroll
                for (int e = 0; e < 8; ++e) { g2[e] = g1[e] = v2[e] = v1[e] = 0.f; }
                if (ts >= 2) {
                    const u32x4 a2 = *(const u32x4*)(up + (size_t)(ts - 2 - rowbase) * NUP + ucol), b2 = *(const u32x4*)(up + (size_t)(ts - 2 - rowbase) * NUP + ucol + 128);
                    const u32x4 a1 = *(const u32x4*)(up + (size_t)(ts - 1 - rowbase) * NUP + ucol), b1 = *(const u32x4*)(up + (size_t)(ts - 1 - rowbase) * NUP + ucol + 128);
                    g2[0] = bf_lo(a2.x); g2[1] = bf_hi(a2.x); g2[2] = bf_lo(a2.y); g2[3] = bf_hi(a2.y); g2[4] = bf_lo(a2.z); g2[5] = bf_hi(a2.z); g2[6] = bf_lo(a2.w); g2[7] = bf_hi(a2.w);
                    v2[0] = bf_lo(b2.x); v2[1] = bf_hi(b2.x); v2[2] = bf_lo(b2.y); v2[3] = bf_hi(b2.y); v2[4] = bf_lo(b2.z); v2[5] = bf_hi(b2.z); v2[6] = bf_lo(b2.w); v2[7] = bf_hi(b2.w);
                    g1[0] = bf_lo(a1.x); g1[1] = bf_hi(a1.x); g1[2] = bf_lo(a1.y); g1[3] = bf_hi(a1.y); g1[4] = bf_lo(a1.z); g1[5] = bf_hi(a1.z); g1[6] = bf_lo(a1.w); g1[7] = bf_hi(a1.w);
                    v1[0] = bf_lo(b1.x); v1[1] = bf_hi(b1.x); v1[2] = bf_lo(b1.y); v1[3] = bf_hi(b1.y); v1[4] = bf_lo(b1.z); v1[5] = bf_hi(b1.z); v1[6] = bf_lo(b1.w); v1[7] = bf_hi(b1.w);
                }
                for (int s = 0; s < 32; ++s) {
                    const int tt = ts + s;
                    const u32x4 a0 = *(const u32x4*)(up + (size_t)(tt - rowbase) * NUP + ucol), b0 = *(const u32x4*)(up + (size_t)(tt - rowbase) * NUP + ucol + 128);
                    float gc[8], vc[8];
                    gc[0] = bf_lo(a0.x); gc[1] = bf_hi(a0.x); gc[2] = bf_lo(a0.y); gc[3] = bf_hi(a0.y); gc[4] = bf_lo(a0.z); gc[5] = bf_hi(a0.z); gc[6] = bf_lo(a0.w); gc[7] = bf_hi(a0.w);
                    vc[0] = bf_lo(b0.x); vc[1] = bf_hi(b0.x); vc[2] = bf_lo(b0.y); vc[3] = bf_hi(b0.y); vc[4] = bf_lo(b0.z); vc[5] = bf_hi(b0.z); vc[6] = bf_lo(b0.w); vc[7] = bf_hi(b0.w);
                    float o[8];
#pragma unroll
                    for (int e = 0; e < 8; ++e) { const float gg = bg[e] + wg[0][e] * g2[e] + wg[1][e] * g1[e] + wg[2][e] * gc[e]; const float vv = bv[e] + wv[0][e] * v2[e] + wv[1][e] * v1[e] + wv[2][e] * vc[e];
                        o[e] = gg * sigmoidf_(gg) * vv; g2[e] = g1[e]; g1[e] = gc[e]; v2[e] = v1[e]; v1[e] = vc[e]; }
                    u32x4 w; w.x = cvt_pk_bf16(o[0], o[1]); w.y = cvt_pk_bf16(o[2], o[3]); w.z = cvt_pk_bf16(o[4], o[5]); w.w = cvt_pk_bf16(o[6], o[7]);
                    *(u32x4*)(act + (size_t)tt * DFF + c0) = w;
                }
            }
        }
        GSYNC();
    STAMP(10);
    }

    {
        pg8::Gemm g{DFF, (unsigned)(DFF * 2), 128u, (unsigned)(DFF) * 2u};
        SchedMN S{64, 4, 1, G, bid, 0, (const char*)(ws + WS_ACT), nullptr, (const char*)(ws + WS_WDOWN), nullptr, (size_t)256 * DFF * 2, (size_t)256 * DFF * 2};
        EpiRes E{a.out, a.out, nullptr, (float*)(ws + WS_RSS3)};
        pg8::gemm_phase<EpiRes, SchedMN, true, true>(lds, g, S, E);
    }
    GSYNC();
    STAMP(11);

    {
        const float* gf = a.in[27];
        for (int r = gw; r < SEQ; r += NGW) {
            const float rs = rsqrtf(((const float*)(ws + WS_RSS3))[r] * (1.f / DM) + EPS);
            f32x4* xr = (f32x4*)(a.out + (size_t)r * DM) + lane; const f32x4* gr = (const f32x4*)gf + lane;
#pragma unroll
            for (int j = 0; j < 4; ++j) xr[64 * j] = xr[64 * j] * rs * gr[64 * j];
        }
    }
    if ((TSK) >= 0 && blockIdx.x == 0 && threadIdx.x == 0) {
        const unsigned long long tend = __builtin_amdgcn_s_memrealtime(); const unsigned long long* ts = (const unsigned long long*)(a.ws + 240 * 1024);
        const unsigned long long t1 = ((TSK) + 1 > 11) ? tend : ts[(TSK) + 1 > 11 ? 0 : (TSK) + 1];
        asm volatile("s_waitcnt vmcnt(0)" ::: "memory");
        a.out[0] = ((TSK) >= 20) ? (float)((const unsigned long long*)(a.ws + 244 * 1024))[(TSK) >= 20 ? (TSK) - 20 : 0] * ((TSK) == 25 ? 1.0f : 0.01f) : (float)(t1 - ts[(TSK) > 11 ? 11 : (TSK)]) * 0.01f;
    }
}

extern "C" void kernel_launch(void* const* d_in, const int* in_sizes, int n_in, void* d_out, int out_size, void* d_ws, size_t ws_size, hipStream_t stream) {
    static int grid = 0;
    if (grid == 0) {
        int dev = 0, cus = 0, per_cu = 0;
        (void)hipGetDevice(&dev); (void)hipDeviceGetAttribute(&cus, hipDeviceAttributeMultiprocessorCount, dev);
        (void)hipFuncSetAttribute((const void*)fwd_mega, hipFuncAttributeMaxDynamicSharedMemorySize, LDS_BYTES);
        (void)hipOccupancyMaxActiveBlocksPerMultiprocessor(&per_cu, (const void*)fwd_mega, NT, LDS_BYTES);
        if (per_cu < 1) { fprintf(stderr, "kernel_launch: occupancy query says %d blocks per CU\n", per_cu); per_cu = 1; }
        grid = cus;
        if (n_in != 28 || ws_size < 252 * MiB) fprintf(stderr, "kernel_launch: unexpected n_in %d / ws_size %zu\n", n_in, ws_size);
    }
    Args a{};
    for (int i = 0; i < 28; ++i) a.in[i] = (const float*)d_in[i];
    a.out = (float*)d_out; a.ws = (unsigned char*)d_ws;
    void* kargs[] = {&a};
    hipError_t e = hipLaunchCooperativeKernel((const void*)fwd_mega, dim3(grid), dim3(NT), kargs, LDS_BYTES, stream);
    if (e != hipSuccess) fprintf(stderr, "cooperative launch failed: %s (grid %d)\n", hipGetErrorString(e), grid);
}
```

```cpp
#include <hip/hip_runtime.h>
#include <hip/hip_cooperative_groups.h>
#include <cstdio>
#include <cstdint>
namespace cg = cooperative_groups;
#ifndef PROBE_REP
#define PROBE_REP -1
#endif
#ifndef EXPV
#define EXPV 0
#endif
#ifndef TSK
#define TSK -1
#endif
#define STAMP(i) do { if ((TSK) >= 0 && blockIdx.x == 0 && threadIdx.x == 0) ((unsigned long long*)(a.ws + 240 * 1024))[i] = __builtin_amdgcn_s_memrealtime(); } while (0)
#define ASTAMP(k) do { if ((TSK) >= 20 && blockIdx.x == 0 && threadIdx.x == 0) { const unsigned long long t_ = __builtin_amdgcn_s_memrealtime(); T.tsa[k] += t_ - T.tsa[15]; T.tsa[15] = t_; } } while (0)
#define REPS(k) _Pragma("nounroll") for (int rep_ = 0; rep_ < ((PROBE_REP) == (k) ? 2 : 1); ++rep_)
#define GSYNC() do { xcd_barrier(xbar); if ((PROBE_REP) == 100) xcd_barrier(xbar); } while (0)

#define LAS __attribute__((address_space(3)))
typedef unsigned short bf16_t;
typedef short bf16x8 __attribute__((ext_vector_type(8)));
typedef float f32x4 __attribute__((ext_vector_type(4)));
typedef float f32x2 __attribute__((ext_vector_type(2)));
typedef unsigned u32x4 __attribute__((ext_vector_type(4)));
typedef unsigned u32x2 __attribute__((ext_vector_type(2)));

constexpr int SEQ = 16384, DM = 1024, DIN = 3864, PP = 4096  , DFF = 2816, NUP = 5632;
constexpr int C_Q = 0, C_KC = 512, C_VC = 640, C_KSL = 768, C_VSL = 896, C_KWN = 1024, C_VWN = 1152, C_U = 1280, C_GA = 1792, C_GB = 2816, C_NG = 3840;
constexpr int VTP = SEQ + 64;
constexpr float EPS = 1e-6f;
constexpr float NEGF = -1e30f;

constexpr size_t MiB = 1u << 20;
constexpr size_t WS_RSTD1 = 0, WS_RSS2 = 64 * 1024, WS_RSS3 = 128 * 1024, WS_ROPEC = 256 * 1024, WS_ROPES = 768 * 1024;
constexpr size_t WS_ABAR = 1280 * 1024, WS_A128 = WS_ABAR + 16384, WS_BIASPE = WS_A128 + 16384, WS_BBAR = 1536 * 1024  ;
constexpr size_t WS_SBUF = 2 * MiB  , WS_HID = 4 * MiB  , WS_KCMP = 6 * MiB  , WS_VCMPT = 6 * MiB + 512 * 1024  ;
constexpr size_t WS_WUP = 8 * MiB, WS_WDOWN = 20 * MiB, WS_WIN = 26 * MiB, WS_WGLU = 34 * MiB, WS_WPA = 35 * MiB, WS_WPB = 36 * MiB, WS_WOUT = 37 * MiB, WS_W1K = 39 * MiB, WS_W1V = 40 * MiB;
constexpr size_t WS_XB = 41 * MiB, WS_MERGED = 41 * MiB, WS_PROJ = 73 * MiB, WS_VSLT = 202 * MiB + 512 * 1024, WS_VWNT = 207 * MiB;
constexpr size_t WS_X1B = 220 * MiB, WS_UPRAW = 26 * MiB, WS_ACT = 122 * MiB;
constexpr size_t WS_VMAX = 232 * 1024, WS_BAR = 192 * 1024, WS_KSL = 212 * MiB, WS_KWN = 216 * MiB;
constexpr size_t OUT_YA = 0, OUT_YBP = 16 * MiB, OUT_YB = 32 * MiB;
static_assert(WS_PROJ + (size_t)(SEQ + 32) * PP * 2 <= WS_VSLT, "proj");
static_assert(WS_VSLT + (size_t)128 * VTP * 2 + 4096 <= WS_VWNT && WS_VWNT + (size_t)128 * VTP * 2 + 4096 <= WS_X1B, "vt");
static_assert(WS_UPRAW + (size_t)33 * 256 * NUP * 2 <= WS_ACT && WS_ACT + (size_t)SEQ * DFF * 2 <= WS_X1B, "ffn");

__device__ __forceinline__ unsigned cvt_pk_bf16(float lo, float hi) { unsigned r; asm volatile("v_cvt_pk_bf16_f32 %0, %1, %2" : "=v"(r) : "v"(lo), "v"(hi)); return r; }
__device__ __forceinline__ float bf_lo(unsigned w) { return __uint_as_float(w << 16); }
__device__ __forceinline__ float bf_hi(unsigned w) { return __uint_as_float(w & 0xffff0000u); }
__device__ __forceinline__ float bf2f(bf16_t b) { return __uint_as_float((unsigned)b << 16); }
__device__ __forceinline__ float sigmoidf_(float v) { return 1.f / (1.f + __expf(-v)); }
__device__ __forceinline__ float gelu_tanh(float v) { const float z = 0.7978845608028654f * (v + 0.044715f * v * v * v); const float th = 1.f - 2.f / (__expf(2.f * z) + 1.f); return 0.5f * v * (1.f + th); }
__device__ __forceinline__ u32x4 pack8(f32x4 a, f32x4 b) { u32x4 w; w.x = cvt_pk_bf16(a[0], a[1]); w.y = cvt_pk_bf16(a[2], a[3]); w.z = cvt_pk_bf16(b[0], b[1]); w.w = cvt_pk_bf16(b[2], b[3]); return w; }

namespace pg8 {
#define PG8_LAS __attribute__((address_space(3)))
constexpr int BM = 256, BK = 64, HALF = 128, HTB = HALF * BK * 2, STAGE_BYTES = 8 * HTB, NXCD = 8, WGM = 8;
__host__ __device__ __forceinline__ int lds_byte(int r, int c) { const int st = (r >> 4) * 2 + (c >> 5), rr = r & 15, cc = c & 31, ob = rr * 64 + cc * 2; return st * 1024 + (ob ^ (((ob >> 9) & 1) << 5)); }
__host__ __device__ __forceinline__ void stage_rc(int b, int& R, int& C) { const int st = b / 1024, sb = b % 1024, swz = sb ^ (((sb >> 9) & 1) << 5); R = (st >> 1) * 16 + swz / 64; C = (st & 1) * 32 + (swz % 64) / 2; }
__host__ __device__ __forceinline__ int perm32(int rho) { const int n = rho >> 4, i = rho & 15; return 8 * (i >> 2) + 4 * n + (i & 3); }
struct Unit { int pm, pn, z; const char* A; const char* B; };
struct Gemm { int K; unsigned lda_b; unsigned kstepA; unsigned ldb_b; };
__device__ __forceinline__ bool tile_of(long L, int nM, int nN, int& pm, int& pn) {
    const int nwg = nM * nN; if (L >= nwg) return false;
    int wgid = (int)L; { const int q = nwg / NXCD, r = nwg % NXCD, xcd = wgid % NXCD, off = wgid / NXCD; wgid = (xcd < r ? xcd * (q + 1) : r * (q + 1) + (xcd - r) * q) + off; }
    const int nig = WGM * nN, gid = wgid / nig, fm = gid * WGM, gsz = (nM - fm) < WGM ? (nM - fm) : WGM;
    pm = fm + ((wgid % nig) % gsz); pn = (wgid % nig) / gsz; return true;
}
template <class Epi, class Sched, bool ALIGN_EPI = false, bool SP2 = false>
__device__ __forceinline__ void gemm_phase(PG8_LAS unsigned char* lds, const Gemm g, const Sched& S, const Epi& E) {
    int tid_ = threadIdx.x; asm volatile("" : "+v"(tid_));
    const int tid = tid_, wid = __builtin_amdgcn_readfirstlane(tid >> 6), lane = tid & 63, wr = wid >> 2, wc = wid & 3, fr = lane & 15, fq = lane >> 4;
    const int K = g.K, nt = K / BK;
    unsigned voffA[2], voffB[2];
#pragma unroll
    for (int i = 0; i < 2; ++i) { int R, C; stage_rc(tid * 16 + i * 8192, R, C); const int Rb = Epi::PERM ? ((R & ~31) + perm32(R & 31)) : R;
        voffA[i] = (unsigned)R * g.lda_b + (unsigned)C * 2u; voffB[i] = (unsigned)Rb * g.ldb_b + (unsigned)C * 2u; }
    const size_t kstepA = (size_t)g.kstepA, kstepB = (size_t)(BK * 2);
    const size_t hstepA = (size_t)HALF * g.lda_b, hstepB = (size_t)HALF * g.ldb_b;
    const unsigned ldsw = (unsigned)wid * 1024u;
    const int aoff = lds_byte(wr * 64 + fr, fq * 8), boff = lds_byte(wc * 32 + fr, fq * 8);
#define PG8_SA(b, h) (((b) * 2 + (h)) * HTB)
#define PG8_SB(b, h) ((4 + (b) * 2 + (h)) * HTB)
#define PG8_STAGE(bufoff, gbase, voff) do { _Pragma("unroll") for (int _i = 0; _i < 2; ++_i) \
        __builtin_amdgcn_global_load_lds((const unsigned*)((const char*)(gbase) + (voff)[_i]), (PG8_LAS unsigned*)(lds + (bufoff) + ldsw + _i * 8192), 16, 0, 0); } while (0)
#define PG8_LDA(dst, b, h) do { _Pragma("unroll") for (int m = 0; m < 4; ++m) _Pragma("unroll") for (int k = 0; k < 2; ++k) dst[m][k] = *(const PG8_LAS bf16x8*)(lds + PG8_SA(b, h) + aoff + m * 2048 + k * 1024); } while (0)
#define PG8_LDB(dst, b, h) do { _Pragma("unroll") for (int n = 0; n < 2; ++n) _Pragma("unroll") for (int k = 0; k < 2; ++k) dst[n][k] = *(const PG8_LAS bf16x8*)(lds + PG8_SB(b, h) + boff + n * 2048 + k * 1024); } while (0)
#define PG8_MMA(ai, bj, At, Bt) do { __builtin_amdgcn_s_setprio(1); _Pragma("unroll") for (int m = 0; m < 4; ++m) _Pragma("unroll") for (int n = 0; n < 2; ++n) _Pragma("unroll") for (int k = 0; k < 2; ++k) \
        acc[ai][bj][m][n] = __builtin_amdgcn_mfma_f32_16x16x32_bf16(Bt[n][k], At[m][k], acc[ai][bj][m][n], 0, 0, 0); __builtin_amdgcn_s_setprio(0); } while (0)
#define PG8_WAIT_V(n) asm volatile("s_waitcnt vmcnt(" #n ")" ::: "memory")
#define PG8_WAIT_L(n) asm volatile("s_waitcnt lgkmcnt(" #n ")" ::: "memory")
#define PG8_BAR __builtin_amdgcn_s_barrier()
#define PG8_SCHED __builtin_amdgcn_sched_barrier(0)
    Unit cur, nxt; int ui = 0;
    if (!S.next(0, cur)) return;
    f32x4 acc[2][2][4][2];
#pragma unroll
    for (int a = 0; a < 2; ++a)
#pragma unroll
        for (int b = 0; b < 2; ++b)
#pragma unroll
            for (int m = 0; m < 4; ++m)
#pragma unroll
                for (int n = 0; n < 2; ++n) acc[a][b][m][n] = (f32x4){0.f, 0.f, 0.f, 0.f};
    bf16x8 At[4][2], B0[2][2], B1[2][2];
    const char* cA = cur.A; const char* cB = cur.B;
    if constexpr (SP2) {
        PG8_STAGE(PG8_SB(0, 0), cB, voffB); PG8_STAGE(PG8_SB(0, 1), cB + hstepB, voffB); PG8_STAGE(PG8_SA(0, 0), cA, voffA); PG8_STAGE(PG8_SA(0, 1), cA + hstepA, voffA);
        if (wr == 1) PG8_BAR;
        PG8_WAIT_V(2); PG8_BAR;
        PG8_STAGE(PG8_SB(1, 0), cB + kstepB, voffB); PG8_STAGE(PG8_SA(1, 0), cA + kstepA, voffA); PG8_STAGE(PG8_SB(1, 1), cB + hstepB + kstepB, voffB);
        PG8_WAIT_V(6); PG8_BAR;
    } else {
        PG8_STAGE(PG8_SB(0, 0), cB, voffB); PG8_STAGE(PG8_SA(0, 0), cA, voffA); PG8_STAGE(PG8_SB(0, 1), cB + hstepB, voffB); PG8_STAGE(PG8_SA(0, 1), cA + hstepA, voffA);
        if (wr == 1) PG8_BAR;
        PG8_WAIT_V(4); PG8_BAR;
        PG8_STAGE(PG8_SB(1, 0), cB + kstepB, voffB); PG8_STAGE(PG8_SA(1, 0), cA + kstepA, voffA); PG8_STAGE(PG8_SB(1, 1), cB + hstepB + kstepB, voffB);
        PG8_WAIT_V(6); PG8_BAR;
    }
    for (;;) {
        const bool has_next = S.next(ui + 1, nxt);
        const char* nA = has_next ? nxt.A : cA; const char* nB = has_next ? nxt.B : cB;
        for (int t = 0; t < nt; t += 2) {
            const bool last = (t == nt - 2);
            const char* a1 = cA + (size_t)(t + 1) * kstepA;
            const char* a2 = last ? nA : cA + (size_t)(t + 2) * kstepA; const char* b2 = last ? nB : cB + (size_t)(t + 2) * kstepB;
            const char* a3 = a2 + kstepA; const char* b3 = b2 + kstepB;
            if constexpr (SP2) {
            PG8_LDB(B0, 0, 0); PG8_LDB(B1, 0, 1); PG8_SCHED; PG8_LDA(At, 0, 0); PG8_STAGE(PG8_SA(1, 1), a1 + hstepA, voffA);
            PG8_WAIT_V(8); PG8_WAIT_L(0); PG8_BAR; PG8_MMA(0, 0, At, B0); PG8_MMA(0, 1, At, B1); PG8_BAR; PG8_SCHED;
            PG8_LDA(At, 0, 1); PG8_STAGE(PG8_SB(0, 0), b2, voffB); PG8_STAGE(PG8_SB(0, 1), b2 + hstepB, voffB); PG8_STAGE(PG8_SA(0, 0), a2, voffA);
            PG8_WAIT_V(8); PG8_WAIT_L(0); PG8_BAR; PG8_MMA(1, 0, At, B0); PG8_MMA(1, 1, At, B1); PG8_BAR; PG8_SCHED;
            PG8_LDB(B0, 1, 0); PG8_LDB(B1, 1, 1); PG8_SCHED; PG8_LDA(At, 1, 0); PG8_STAGE(PG8_SA(0, 1), a2 + hstepA, voffA);
            PG8_WAIT_V(8); PG8_WAIT_L(0); PG8_BAR; PG8_MMA(0, 0, At, B0); PG8_MMA(0, 1, At, B1); PG8_BAR; PG8_SCHED;
            PG8_LDA(At, 1, 1); PG8_STAGE(PG8_SB(1, 0), b3, voffB); PG8_STAGE(PG8_SB(1, 1), b3 + hstepB, voffB); PG8_STAGE(PG8_SA(1, 0), a3, voffA);
            PG8_WAIT_V(8); PG8_WAIT_L(0); PG8_BAR; PG8_MMA(1, 0, At, B0); PG8_MMA(1, 1, At, B1); PG8_BAR; PG8_SCHED;
            } else {
            PG8_LDB(B0, 0, 0); PG8_SCHED; PG8_LDA(At, 0, 0); PG8_STAGE(PG8_SA(1, 1), a1 + hstepA, voffA);
            PG8_WAIT_L(8); PG8_BAR; PG8_WAIT_L(0); PG8_MMA(0, 0, At, B0); PG8_BAR; PG8_SCHED;
            PG8_LDB(B1, 0, 1); PG8_STAGE(PG8_SB(0, 0), b2, voffB);
            PG8_BAR; PG8_WAIT_L(0); PG8_MMA(0, 1, At, B1); PG8_BAR;
            PG8_LDA(At, 0, 1); PG8_STAGE(PG8_SA(0, 0), a2, voffA);
            PG8_BAR; PG8_WAIT_L(0); PG8_MMA(1, 0, At, B0); PG8_BAR; PG8_SCHED;
            PG8_STAGE(PG8_SB(0, 1), b2 + hstepB, voffB);
            PG8_WAIT_V(6); PG8_BAR; PG8_MMA(1, 1, At, B1); PG8_BAR;
            PG8_LDB(B0, 1, 0); PG8_SCHED; PG8_LDA(At, 1, 0); PG8_STAGE(PG8_SA(0, 1), a2 + hstepA, voffA);
            PG8_WAIT_L(8); PG8_BAR; PG8_WAIT_L(0); PG8_MMA(0, 0, At, B0); PG8_BAR; PG8_SCHED;
            PG8_LDB(B1, 1, 1); PG8_STAGE(PG8_SB(1, 0), b3, voffB);
            PG8_BAR; PG8_WAIT_L(0); PG8_MMA(0, 1, At, B1); PG8_BAR;
            PG8_LDA(At, 1, 1); PG8_STAGE(PG8_SA(1, 0), a3, voffA);
            PG8_BAR; PG8_WAIT_L(0); PG8_MMA(1, 0, At, B0); PG8_BAR; PG8_SCHED;
            PG8_STAGE(PG8_SB(1, 1), b3 + hstepB, voffB);
            PG8_WAIT_V(6); PG8_BAR; PG8_MMA(1, 1, At, B1); PG8_BAR;
            }
        }
        if constexpr (ALIGN_EPI) { if (wr == 0) PG8_BAR; }
        E(acc, cur, wr, wc, fr, fq);
        if (!has_next) break;
#pragma unroll
        for (int a = 0; a < 2; ++a)
#pragma unroll
            for (int b = 0; b < 2; ++b)
#pragma unroll
                for (int m = 0; m < 4; ++m)
#pragma unroll
                    for (int n = 0; n < 2; ++n) acc[a][b][m][n] = (f32x4){0.f, 0.f, 0.f, 0.f};
        cur = nxt; cA = nA; cB = nB; ++ui;
        if constexpr (ALIGN_EPI) { if (wr == 1) PG8_BAR; }
    }
    PG8_WAIT_V(0);
    if constexpr (!ALIGN_EPI) { if (wr == 0) PG8_BAR; }
    PG8_BAR;
#undef PG8_SA
#undef PG8_SB
#undef PG8_STAGE
#undef PG8_LDA
#undef PG8_LDB
#undef PG8_MMA
#undef PG8_WAIT_V
#undef PG8_WAIT_L
#undef PG8_BAR
#undef PG8_SCHED
}
}


struct SchedMN {
    int nM, nN, nz, G, c, pm_off; const char* A0; const char* A1; const char* B0; const char* B1; size_t a_tile, b_tile;
    __device__ __forceinline__ bool next(int i, pg8::Unit& u) const {
        int pm, pn; if (!pg8::tile_of((long)(i / nz) * G + c, nM, nN, pm, pn)) return false;
        u.z = i % nz; u.pm = pm + pm_off; u.pn = pn; u.A = (u.z ? A1 : A0) + (size_t)u.pm * a_tile; u.B = (u.z ? B1 : B0) + (size_t)pn * b_tile; return true;
    }
};
struct SchedCmp {
    int c; const char* proj; const char* w1k; const char* w1v;
    __device__ __forceinline__ bool next(int i, pg8::Unit& u) const {
        if (i > 0 || c >= 64) return false;
        const int ks = c & 3; u.pm = (c >> 2) & 3; u.z = c >> 4; u.pn = ks; const int which = u.z >> 1, kh = u.z & 1;
        u.A = proj + ((size_t)(16 * 256 * u.pm + 8 * ks) * PP + (which ? C_VC : C_KC) + kh * 64) * 2; u.B = (which ? w1v : w1k) + (size_t)ks * 512 * 2; return true;
    }
};

#define EPI_LOOP_ROWS for (int ai = 0; ai < 2; ++ai) _Pragma("unroll") for (int m = 0; m < 4; ++m)

struct EpiProj {
    static constexpr bool PERM = true;
    bf16_t* proj; bf16_t* vslt; bf16_t* vwnt; bf16_t* kslc; bf16_t* kwnc; const float* rstd; const float* ropec; const float* ropes;
    __device__ __forceinline__ void operator()(const f32x4 (&acc)[2][2][4][2], const pg8::Unit& u, int wr, int wc, int fr, int fq) const {
        const int pn = u.pn; const int row0 = u.pm * 256 + wr * 64 + fr;
        const bool sig = pn >= 7;
#pragma unroll
        EPI_LOOP_ROWS {
            const int row = row0 + ai * 128 + m * 16; const float rs = rstd[row];
            f32x4 c0 = {1.f, 1.f, 1.f, 1.f}, c1 = c0, s0 = {0.f, 0.f, 0.f, 0.f}, s1 = s0;
            if ((pn <= 1 || pn == 3 || pn == 4) && (wc & 1) == 0) { c0 = *(const f32x4*)(ropec + row * 8); c1 = *(const f32x4*)(ropec + row * 8 + 4); s0 = *(const f32x4*)(ropes + row * 8); s1 = *(const f32x4*)(ropes + row * 8 + 4); }
#pragma unroll
            for (int bj = 0; bj < 2; ++bj) {
                f32x4 v0 = acc[ai][bj][m][0] * rs, v1 = acc[ai][bj][m][1] * rs;
                const int colt = bj * 128 + wc * 32 + 8 * fq;
                const bool ropet = (pn <= 1) || ((pn == 3 || pn == 4) && bj == 0);
                if (ropet && (wc & 1) == 0) {
                    f32x4 p0, p1;
#pragma unroll
                    for (int e = 0; e < 4; ++e) { p0[e] = __shfl_xor(v0[e], 16); p1[e] = __shfl_xor(v1[e], 16); }
                    if (fq == 0) { v0 = v0 * c0 - p0 * s0; v1 = v1 * c1 - p1 * s1; }
                    else if (fq == 1) { v0 = v0 * c0 + p0 * s0; v1 = v1 * c1 + p1 * s1; }
                }
                if (pn <= 1) { v0 = v0 * (0.125f * 1.4426950408889634f); v1 = v1 * (0.125f * 1.4426950408889634f); }
                if (sig) {
#pragma unroll
                    for (int e = 0; e < 4; ++e) { v0[e] = sigmoidf_(v0[e]); v1[e] = sigmoidf_(v1[e]); }
                }
                const u32x4 w = pack8(v0, v1);
                if (!((pn == 3 || pn == 4))) *(u32x4*)(proj + (size_t)row * PP + pn * 256 + colt) = w;
                if ((pn == 3 || pn == 4) && bj == 0) { bf16_t* kc = (pn == 3) ? kslc : kwnc; *(u32x4*)(kc + ((size_t)(colt >> 6) * SEQ + row) * 64 + (colt & 63)) = w; }
                if ((pn == 3 || pn == 4) && bj == 1) {
                    bf16_t* vt = ((pn == 3) ? vslt : vwnt) + ((size_t)((colt - 128) >> 6) * 256 + (row >> 6)) * 4096 + (size_t)((colt - 128) & 63) * 64 + (row & 63);
                    vt[0 * 64] = (bf16_t)(w.x & 0xffff); vt[1 * 64] = (bf16_t)(w.x >> 16); vt[2 * 64] = (bf16_t)(w.y & 0xffff); vt[3 * 64] = (bf16_t)(w.y >> 16);
                    vt[4 * 64] = (bf16_t)(w.z & 0xffff); vt[5 * 64] = (bf16_t)(w.z >> 16); vt[6 * 64] = (bf16_t)(w.w & 0xffff); vt[7 * 64] = (bf16_t)(w.w >> 16);
                }
            }
        }
    }
};

struct EpiCmp {
    static constexpr bool PERM = true;
    float* hidp;
    __device__ __forceinline__ void operator()(const f32x4 (&acc)[2][2][4][2], const pg8::Unit& u, int wr, int wc, int fr, int fq) const {
        const int row0 = u.pm * 256 + wr * 64 + fr;
#pragma unroll
        for (int bj = 0; bj < 2; ++bj) {
            const int col = bj * 128 + wc * 32 + 8 * fq;
#pragma unroll
            EPI_LOOP_ROWS {
                const int row = row0 + ai * 128 + m * 16; float* d = hidp + (((size_t)u.pn * 4 + u.z) * 1024 + row) * 256 + col;
                *(f32x4*)d = acc[ai][bj][m][0]; *(f32x4*)(d + 4) = acc[ai][bj][m][1];
            }
        }
    }
};

struct EpiGlu {
    static constexpr bool PERM = true;
    const bf16_t* ybp; bf16_t* yb;
    __device__ __forceinline__ void operator()(const f32x4 (&acc)[2][2][4][2], const pg8::Unit& u, int wr, int wc, int fr, int fq) const {
        const int row0 = u.pm * 256 + wr * 64 + fr;
#pragma unroll
        EPI_LOOP_ROWS {
            const int row = row0 + ai * 128 + m * 16;
#pragma unroll
            for (int bj = 0; bj < 2; ++bj) {
                const size_t off = (size_t)row * 512 + u.pn * 256 + bj * 128 + wc * 32 + 8 * fq;
                const u32x4 y = *(const u32x4*)(ybp + off);
                f32x4 v0 = acc[ai][bj][m][0], v1 = acc[ai][bj][m][1];
                v0[0] = bf_lo(y.x) * sigmoidf_(v0[0]); v0[1] = bf_hi(y.x) * sigmoidf_(v0[1]); v0[2] = bf_lo(y.y) * sigmoidf_(v0[2]); v0[3] = bf_hi(y.y) * sigmoidf_(v0[3]);
                v1[0] = bf_lo(y.z) * sigmoidf_(v1[0]); v1[1] = bf_hi(y.z) * sigmoidf_(v1[1]); v1[2] = bf_lo(y.w) * sigmoidf_(v1[2]); v1[3] = bf_hi(y.w) * sigmoidf_(v1[3]);
                *(u32x4*)(yb + off) = pack8(v0, v1);
            }
        }
    }
};

struct EpiMerge {
    static constexpr bool PERM = true;
    const bf16_t* proj; bf16_t* merged;
    __device__ __forceinline__ void operator()(const f32x4 (&acc)[2][2][4][2], const pg8::Unit& u, int wr, int wc, int fr, int fq) const {
        const int row0 = u.pm * 256 + wr * 64 + fr; const int gcol = u.z ? C_GB : C_GA;
#pragma unroll
        EPI_LOOP_ROWS {
            const int row = row0 + ai * 128 + m * 16;
#pragma unroll
            for (int bj = 0; bj < 2; ++bj) {
                const int col = u.pn * 256 + bj * 128 + wc * 32 + 8 * fq;
                const u32x4 gt = *(const u32x4*)(proj + (size_t)row * PP + gcol + col);
                f32x4 v0 = acc[ai][bj][m][0], v1 = acc[ai][bj][m][1];
                v0[0] *= bf_lo(gt.x); v0[1] *= bf_hi(gt.x); v0[2] *= bf_lo(gt.y); v0[3] *= bf_hi(gt.y);
                v1[0] *= bf_lo(gt.z); v1[1] *= bf_hi(gt.z); v1[2] *= bf_lo(gt.w); v1[3] *= bf_hi(gt.w);
                bf16_t* dst = merged + (size_t)row * DM + col;
                if (u.z) { const u32x4 o = *(const u32x4*)dst;
                    v0[0] += bf_lo(o.x); v0[1] += bf_hi(o.x); v0[2] += bf_lo(o.y); v0[3] += bf_hi(o.y); v1[0] += bf_lo(o.z); v1[1] += bf_hi(o.z); v1[2] += bf_lo(o.w); v1[3] += bf_hi(o.w); }
                *(u32x4*)dst = pack8(v0, v1);
            }
        }
    }
};

struct EpiRes {
    static constexpr bool PERM = true;
    const float* xin; float* xo; bf16_t* xb; float* rss;
    __device__ __forceinline__ void operator()(const f32x4 (&acc)[2][2][4][2], const pg8::Unit& u, int wr, int wc, int fr, int fq) const {
        const int row0 = u.pm * 256 + wr * 64 + fr;
#pragma unroll
        EPI_LOOP_ROWS {
            const int row = row0 + ai * 128 + m * 16; float ss = 0.f;
#pragma unroll
            for (int bj = 0; bj < 2; ++bj) {
                const size_t off = (size_t)row * DM + u.pn * 256 + bj * 128 + wc * 32 + 8 * fq;
                const f32x4 v0 = *(const f32x4*)(xin + off) + acc[ai][bj][m][0], v1 = *(const f32x4*)(xin + off + 4) + acc[ai][bj][m][1];
                *(f32x4*)(xo + off) = v0; *(f32x4*)(xo + off + 4) = v1;
                if (xb) *(u32x4*)(xb + off) = pack8(v0, v1);
                ss += (v0[0] * v0[0] + v0[1] * v0[1]) + (v0[2] * v0[2] + v0[3] * v0[3]) + (v1[0] * v1[0] + v1[1] * v1[1]) + (v1[2] * v1[2] + v1[3] * v1[3]);
            }
            ss += __shfl_xor(ss, 16); ss += __shfl_xor(ss, 32);
            if (fq == 0) atomicAdd(rss + row, ss);
        }
    }
};

struct EpiUp {
    static constexpr bool PERM = true;
    bf16_t* up; const float* rss; int rowbase;
    __device__ __forceinline__ void operator()(const f32x4 (&acc)[2][2][4][2], const pg8::Unit& u, int wr, int wc, int fr, int fq) const {
        const int row0 = u.pm * 256 + wr * 64 + fr;
#pragma unroll
        EPI_LOOP_ROWS {
            const int row = row0 + ai * 128 + m * 16; const float rs = rsqrtf(rss[row] * (1.f / DM) + EPS);
#pragma unroll
            for (int bj = 0; bj < 2; ++bj) {
                const size_t off = (size_t)(row - rowbase) * NUP + u.pn * 256 + bj * 128 + wc * 32 + 8 * fq;
                *(u32x4*)(up + off) = pack8(acc[ai][bj][m][0] * rs, acc[ai][bj][m][1] * rs);
            }
        }
    }
};

struct Args { const float* in[28]; float* out; unsigned char* ws; };
constexpr int NT = 512, NWV = 8;
constexpr int LDS_BYTES = 147456;

__device__ __forceinline__ float wave_sum(float v) {
#pragma unroll
    for (int o = 1; o < 64; o <<= 1) v += __shfl_xor(v, o);
    return v;
}

#define XB_TMO      128
#define XB_XCNT(j)  (256  + 64 * (j))
#define XB_XSUB(j)  (1280 + 64 * (j))
#define XB_XGEN(j)  (2304 + 64 * (j))
#define XB_TOP      3328
#define XB_TOPGEN   3392
#define XCD_BAR_WORDS 3456
#define XB_SPIN_CAP (1u << 18)

__device__ __forceinline__ unsigned xb_ld(unsigned* p)              { return __hip_atomic_load(p, __ATOMIC_RELAXED, __HIP_MEMORY_SCOPE_AGENT); }
__device__ __forceinline__ unsigned xb_add(unsigned* p, unsigned v) { return __hip_atomic_fetch_add(p, v, __ATOMIC_RELAXED, __HIP_MEMORY_SCOPE_AGENT); }
__device__ __forceinline__ unsigned xb_xcc_id() { return (unsigned)__builtin_amdgcn_s_getreg((3 << 11) | 20) & 0xFu; }
#define XB_SPIN(cond, bar) do { unsigned _sp = 0; while (cond) { __builtin_amdgcn_s_sleep(1); \
    if ((++_sp & 255u) == 0u) { if (xb_ld(&(bar)[XB_TMO])) break; if (_sp > XB_SPIN_CAP) { atomicAdd(&(bar)[XB_TMO], 1u); break; } } } } while (0)

struct XcdBarrier {
    unsigned* bar; unsigned x;
    volatile LAS unsigned* st;
};

__device__ __forceinline__ XcdBarrier xcd_barrier_post(unsigned* bar, volatile LAS unsigned* st) {
    XcdBarrier b; b.bar = bar; b.x = xb_xcc_id(); b.st = st;
    if (threadIdx.x == 0) (void)xb_add(&bar[XB_XCNT(b.x)], 1u);
    return b;
}
__device__ __forceinline__ void xcd_barrier_complete(unsigned* bar, unsigned x, unsigned& nloc, unsigned& nx) {
    const unsigned G = gridDim.x * gridDim.y * gridDim.z;
    unsigned sum, cnt, mine, sp = 0u;
    for (;;) {
        sum = 0u; cnt = 0u; mine = 0u;
#pragma unroll
        for (unsigned j = 0; j < 16; ++j) { const unsigned c = xb_ld(&bar[XB_XCNT(j)]); sum += c; cnt += (c > 0u) ? 1u : 0u; mine = (j == x) ? c : mine; }
        if (sum == G) break;
        __builtin_amdgcn_s_sleep(1);
        if ((++sp & 255u) == 0u) { if (xb_ld(&bar[XB_TMO])) break; if (sp > XB_SPIN_CAP) { atomicAdd(&bar[XB_TMO], 1u); break; } }
    }
    nloc = mine > 0u ? mine : 1u; nx = cnt > 0u ? cnt : 1u;
}

__device__ __forceinline__ void xcd_barrier(const XcdBarrier& b) {
    asm volatile("s_waitcnt vmcnt(0)" ::: "memory");
    __syncthreads();
    if (threadIdx.x == 0) {
        unsigned* bar = b.bar;
        __builtin_amdgcn_s_waitcnt(0);
        unsigned nloc = b.st[0], nx = b.st[1];
        if (nloc == 0u) { xcd_barrier_complete(bar, b.x, nloc, nx); b.st[0] = nloc; b.st[1] = nx; }
        const unsigned old = xb_add(&bar[XB_XSUB(b.x)], 1u);
        const unsigned gen = old / nloc;
        if (old + 1u == (gen + 1u) * nloc) {
            __builtin_amdgcn_fence(__ATOMIC_RELEASE, "agent");
            asm volatile("s_waitcnt vmcnt(0)" ::: "memory");
            const unsigned og = xb_add(&bar[XB_TOP], 1u);
            const unsigned tg = og / nx;
            if (og + 1u == (tg + 1u) * nx) xb_add(&bar[XB_TOPGEN], 1u);
            else XB_SPIN(xb_ld(&bar[XB_TOPGEN]) == tg, bar);
            __builtin_amdgcn_fence(__ATOMIC_ACQUIRE, "agent");
            xb_add(&bar[XB_XGEN(b.x)], 1u);
            asm volatile("s_waitcnt vmcnt(0)" ::: "memory");
        } else {
            XB_SPIN(xb_ld(&bar[XB_XGEN(b.x)]) == gen, bar);
            __builtin_amdgcn_fence(__ATOMIC_ACQUIRE, "agent");
            asm volatile("s_waitcnt vmcnt(0)" ::: "memory");
        }
    }
    __syncthreads();
}

__device__ __forceinline__ int colmap(int kind, int c) {
    if (kind == 1) return c < 1280 ? c : (c < 1304 ? C_NG + (c - 1280) : c - 24);
    if (kind == 2) { return c < DFF ? (c >> 7) * 256 + (c & 127) : ((c - DFF) >> 7) * 256 + 128 + ((c - DFF) & 127); }
    return c;
}
__device__ __forceinline__ void transpose_item(const float* W, int K, int N, bf16_t* WT, LAS float* scr, int kb, int nb, int lane, const float* kscale, int kind) {
    const int k0 = 64 * kb, n0 = 32 * nb;
#pragma unroll
    for (int i = 0; i < 8; ++i) { const int kk = 8 * i + (lane >> 3), nq = (lane & 7) * 4, n = n0 + nq;
        f32x4 v = (n < N) ? *(const f32x4*)(W + (size_t)(k0 + kk) * N + n) : (f32x4){0.f, 0.f, 0.f, 0.f}; if (kscale) v = v * kscale[k0 + kk];
        LAS float* d = scr + kk * 33 + nq; d[0] = v[0]; d[1] = v[1]; d[2] = v[2]; d[3] = v[3]; }
    asm volatile("s_waitcnt lgkmcnt(0)" ::: "memory");
    const int c = lane & 7;
#pragma unroll
    for (int j = 0; j < 4; ++j) { const int n = (lane >> 3) + 8 * j; const LAS float* s = scr + (8 * c) * 33 + n;
        if (n0 + n < N) { u32x4 o; o.x = cvt_pk_bf16(s[0 * 33], s[1 * 33]); o.y = cvt_pk_bf16(s[2 * 33], s[3 * 33]); o.z = cvt_pk_bf16(s[4 * 33], s[5 * 33]); o.w = cvt_pk_bf16(s[6 * 33], s[7 * 33]);
            *(u32x4*)(WT + (size_t)colmap(kind, n0 + n) * K + k0 + 8 * c) = o; } }
    asm volatile("s_waitcnt lgkmcnt(0)" ::: "memory");
}

#define EXP2(x) __builtin_amdgcn_exp2f(x)
#define MFMA16(a, b, c) __builtin_amdgcn_mfma_f32_16x16x32_bf16((a), (b), (c), 0, 0, 0)
__device__ __forceinline__ float dpp_x1(float v) { return __int_as_float(__builtin_amdgcn_update_dpp(0, __float_as_int(v), 0xB1, 0xF, 0xF, true)); }
__device__ __forceinline__ float dpp_x2(float v) { return __int_as_float(__builtin_amdgcn_update_dpp(0, __float_as_int(v), 0x4E, 0xF, 0xF, true)); }
struct KOp { bf16x8 a00, a01, a10, a11; };
struct VOp { bf16x8 v0, v1, v2, v3; };
__device__ __forceinline__ KOp ldk(const bf16_t* Kb, size_t pitch, int kb, int lane) {
    const int i = lane & 15, q = lane >> 4;
    const bf16_t* r0 = Kb + (size_t)(kb + 8 * (i >> 2) + (i & 3)) * pitch + 8 * q; const bf16_t* r1 = r0 + 4 * pitch;
    KOp k; k.a00 = *(const bf16x8*)r0; k.a01 = *(const bf16x8*)(r0 + 32); k.a10 = *(const bf16x8*)r1; k.a11 = *(const bf16x8*)(r1 + 32); return k;
}
__device__ __forceinline__ VOp ldv(const bf16_t* Vt, size_t vpitch, int kb, int lane) {
    const int i = lane & 15, q = lane >> 4; const size_t base = (vpitch == 64) ? (size_t)(kb >> 6) * 4096 + (kb & 63) : (size_t)kb;
    const bf16_t* r = Vt + base + (size_t)i * vpitch + 8 * q;
    VOp v; v.v0 = *(const bf16x8*)r; v.v1 = *(const bf16x8*)(r + 16 * vpitch); v.v2 = *(const bf16x8*)(r + 32 * vpitch); v.v3 = *(const bf16x8*)(r + 48 * vpitch); return v;
}
__device__ __forceinline__ void qk32(const KOp& k, const bf16x8& Bq0, const bf16x8& Bq1, f32x4& S0, f32x4& S1) {
    const f32x4 z = {0.f, 0.f, 0.f, 0.f};
    S0 = MFMA16(k.a00, Bq0, z); S0 = MFMA16(k.a01, Bq1, S0); S1 = MFMA16(k.a10, Bq0, z); S1 = MFMA16(k.a11, Bq1, S1);
}
__device__ __forceinline__ void pv32(const VOp& v, const bf16x8& P, f32x4 (&O)[4]) {
    O[0] = MFMA16(v.v0, P, O[0]); O[1] = MFMA16(v.v1, P, O[1]); O[2] = MFMA16(v.v2, P, O[2]); O[3] = MFMA16(v.v3, P, O[3]);
}
__device__ __forceinline__ bf16x8 packP(const f32x4& p0, const f32x4& p1) { u32x4 w = pack8(p0, p1); return __builtin_bit_cast(bf16x8, w); }

struct KbLin { int base; __device__ __forceinline__ int operator()(int i) const { return base + 32 * i; } };
struct KbLds { const LAS int* l; __device__ __forceinline__ int operator()(int i) const { return l[i]; } };

template <bool NEEDV, class KB, class Body>
__device__ __forceinline__ void pipe3(int n, const KB kbf, Body& body, const bf16_t* Kb, size_t kp, const bf16_t* Vt, size_t vp, int lane) {
    if (n <= 0) return;
    KOp k0, k1; VOp v;
    k0 = ldk(Kb, kp, kbf(0), lane);
    for (int i = 0; i < n; i += 2) {
        { const int kb = kbf(i); if (NEEDV) v = ldv(Vt, vp, kb, lane); k1 = ldk(Kb, kp, kbf(i + 1 < n ? i + 1 : n - 1), lane); body.run(kb, k0, v); }
        if (i + 1 >= n) break;
        { const int kb = kbf(i + 1); if (NEEDV) v = ldv(Vt, vp, kb, lane); k0 = ldk(Kb, kp, kbf(i + 2 < n ? i + 2 : n - 1), lane); body.run(kb, k1, v); }
    }
}

constexpr int AL_CKV = 81920  , CKV_HALF = 9216, CKV_BUF = 18432;
template <bool NEEDV, class Body>
__device__ __forceinline__ void cmp_shared(int nsteps, Body& body, const bf16_t* Kc, const bf16_t* Vc, LAS unsigned char* buf, int tid, int lane, int kb0 = 0, int vrp = 1024, int vcs = 64, int vch0 = 0) {
    const int nch = (nsteps + 1) >> 1; if (nch <= 0) return;
    const int srow = tid >> 3, spc = tid & 7, i = lane & 15, q = lane >> 4;
    u32x4 rk = *(const u32x4*)(Kc + (size_t)(kb0 + srow) * 64 + spc * 8), rv = rk;
    if (NEEDV) rv = *(const u32x4*)(Vc + (size_t)srow * vrp + (size_t)vch0 * vcs + spc * 8);
    *(LAS u32x4*)(buf + srow * 144 + spc * 16) = rk; if (NEEDV) *(LAS u32x4*)(buf + CKV_HALF + srow * 144 + spc * 16) = rv;
    __syncthreads();
    for (int ch = 0; ch < nch; ++ch) {
        const LAS unsigned char* cur = buf + (ch & 1) * CKV_BUF; LAS unsigned char* nxt = buf + ((ch + 1) & 1) * CKV_BUF;
        const bool more = ch + 1 < nch;
        if (more) { rk = *(const u32x4*)(Kc + (size_t)(kb0 + 64 * (ch + 1) + srow) * 64 + spc * 8); if (NEEDV) rv = *(const u32x4*)(Vc + (size_t)srow * vrp + (size_t)(vch0 + ch + 1) * vcs + spc * 8); }
#pragma unroll
        for (int h = 0; h < 2; ++h) {
            const int st = 2 * ch + h;
            if (st < nsteps) {
                const LAS unsigned char* kr = cur + (32 * h + 8 * (i >> 2) + (i & 3)) * 144 + 16 * q;
                KOp k; k.a00 = *(const LAS bf16x8*)kr; k.a01 = *(const LAS bf16x8*)(kr + 64); k.a10 = *(const LAS bf16x8*)(kr + 4 * 144); k.a11 = *(const LAS bf16x8*)(kr + 4 * 144 + 64);
                VOp v; if (NEEDV) { const LAS unsigned char* vr = cur + CKV_HALF + i * 144 + (32 * h + 8 * q) * 2;
                    v.v0 = *(const LAS bf16x8*)vr; v.v1 = *(const LAS bf16x8*)(vr + 16 * 144); v.v2 = *(const LAS bf16x8*)(vr + 32 * 144); v.v3 = *(const LAS bf16x8*)(vr + 48 * 144); }
                else { v.v0 = k.a00; v.v1 = k.a00; v.v2 = k.a00; v.v3 = k.a00; }
                body.run(kb0 + 32 * st, k, v);
            }
        }
        if (more) { *(LAS u32x4*)(nxt + srow * 144 + spc * 16) = rk; if (NEEDV) *(LAS u32x4*)(nxt + CKV_HALF + srow * 144 + spc * 16) = rv; }
        __syncthreads();
    }
}

struct BodyCmp1 {
    bf16x8 Bq[2][2]; int nv[2], q; float ml[2], ll[2];
    __device__ __forceinline__ void run(int kb, const KOp& k, const VOp&) {
#pragma unroll
        for (int cg = 0; cg < 2; ++cg) {
            f32x4 S0, S1; qk32(k, Bq[cg][0], Bq[cg][1], S0, S1);
            const int k0 = kb + 8 * q; float mloc = NEGF;
#pragma unroll
            for (int e = 0; e < 4; ++e) { if (k0 + e >= nv[cg]) S0[e] = NEGF; if (k0 + 4 + e >= nv[cg]) S1[e] = NEGF; mloc = fmaxf(mloc, fmaxf(S0[e], S1[e])); }
            const float mn = fmaxf(ml[cg], mloc); float ps = 0.f;
#pragma unroll
            for (int e = 0; e < 4; ++e) { ps += (k0 + e < nv[cg]) ? EXP2(S0[e] - mn) : 0.f; ps += (k0 + 4 + e < nv[cg]) ? EXP2(S1[e] - mn) : 0.f; }
            ll[cg] = ll[cg] * EXP2(ml[cg] - mn) + ps; ml[cg] = mn;
        }
    }
};
struct BodyCmp2 {
    bf16x8 Bq[2][2]; int nv[2], q, g, lane_; float mc[2], inv[2], carry[2]; LAS float* ia[2]; f32x4 O[2][4];
    __device__ __forceinline__ void run(int kb, const KOp& k, const VOp& v) {
#pragma unroll
        for (int cg = 0; cg < 2; ++cg) {
            f32x4 S0, S1; qk32(k, Bq[cg][0], Bq[cg][1], S0, S1);
            const int k0 = kb + 8 * q; f32x4 p0, p1;
#pragma unroll
            for (int e = 0; e < 4; ++e) { p0[e] = (k0 + e < nv[cg]) ? EXP2(S0[e] - mc[cg]) * inv[cg] : 0.f; p1[e] = (k0 + 4 + e < nv[cg]) ? EXP2(S1[e] - mc[cg]) * inv[cg] : 0.f; }
            f32x4 s0 = p0, s1 = p1;
#pragma unroll
            for (int e = 0; e < 4; ++e) { s0[e] += dpp_x1(s0[e]); s0[e] += dpp_x2(s0[e]); s1[e] += dpp_x1(s1[e]); s1[e] += dpp_x2(s1[e]); }
            const float bout = 0.5f * s1[3]; const float recv = __shfl(bout, (lane_ + 48) & 63); const float bin = (q == 0) ? carry[cg] : recv; carry[cg] = recv;
            if (g == 0) { const int j = k0 >> 2; ia[cg][j] = ((s0[0] + s0[1]) + (s0[2] + 0.5f * s0[3])) + bin; ia[cg][j + 1] = 0.5f * s0[3] + ((s1[0] + s1[1]) + (s1[2] + 0.5f * s1[3])); }
            pv32(v, packP(p0, p1), O[cg]);
        }
    }
};
struct BodyWin {
    bf16x8 Bq[2][2]; int q, tt[2]; float m[2], l[2]; f32x4 O[2][4];
    __device__ __forceinline__ void run(int kb, const KOp& k, const VOp& v) {
#pragma unroll
        for (int cg = 0; cg < 2; ++cg) {
            f32x4 S0, S1; qk32(k, Bq[cg][0], Bq[cg][1], S0, S1);
            const int k0 = kb + 8 * q; unsigned vm = 0u;
#pragma unroll
            for (int e = 0; e < 8; ++e) { const bool ok = (k0 + e <= tt[cg]) && (tt[cg] - (k0 + e) < 512); vm |= ok ? (1u << e) : 0u; }
            float mloc = NEGF;
#pragma unroll
            for (int e = 0; e < 4; ++e) { if (!((vm >> e) & 1u)) S0[e] = NEGF; if (!((vm >> (4 + e)) & 1u)) S1[e] = NEGF; mloc = fmaxf(mloc, fmaxf(S0[e], S1[e])); }
            mloc = fmaxf(mloc, __shfl_xor(mloc, 16)); mloc = fmaxf(mloc, __shfl_xor(mloc, 32));
            const float mn = fmaxf(m[cg], mloc), alpha = EXP2(m[cg] - mn); m[cg] = mn;
            f32x4 p0, p1; float ps = 0.f;
#pragma unroll
            for (int e = 0; e < 4; ++e) { p0[e] = ((vm >> e) & 1u) ? EXP2(S0[e] - mn) : 0.f; p1[e] = ((vm >> (4 + e)) & 1u) ? EXP2(S1[e] - mn) : 0.f; ps += p0[e] + p1[e]; }
            l[cg] = l[cg] * alpha + ps;
#pragma unroll
            for (int dt = 0; dt < 4; ++dt) O[cg][dt] = O[cg][dt] * alpha;
            pv32(v, packP(p0, p1), O[cg]);
        }
    }
};

struct AttnT { float fxs; unsigned long long* tsa; const bf16_t* proj; const bf16_t* kslc; const bf16_t* kwnc; const bf16_t* kcmp; const bf16_t* vcmpT; const bf16_t* vslT; const bf16_t* vwnT; bf16_t* ya; };

constexpr int AL_IMP = 0  , AL_OS = 0  , AL_TM = 67584  , AL_CNT = 69632  ,
              AL_OFF = 70656  , AL_UNITS = 71744  , AL_MM = 77888  , AL_LS = 78912  ;
constexpr int AL_Q = 81920  , QROWB = 528;
constexpr int OSP = 33;
constexpr float FXB = 67108864.0f;
typedef short s16x2 __attribute__((ext_vector_type(2)));
__device__ __forceinline__ int f2ord(float f) { const int b = __float_as_int(f); return b >= 0 ? b : b ^ 0x7fffffff; }
__device__ __forceinline__ float ord2f(int b) { return __int_as_float(b >= 0 ? b : b ^ 0x7fffffff); }

__device__ __forceinline__ void attn_wave_part1(const AttnT& T, int kh, int tq8, int lane, LAS float* imp  , LAS unsigned* tm, int wave, LAS unsigned char* lds, int tid) {
    const int col = lane & 15, q = lane >> 4, tk = col >> 2, g = col & 3;
    const int t0 = tq8 * 8, h = kh * 4 + g;
    bf16x8 Bq[2][2]; float g0[2], g2[2]; int tcg[2];
#pragma unroll
    for (int cg = 0; cg < 2; ++cg) { tcg[cg] = t0 + 4 * cg + tk; const bf16_t* prow = T.proj + (size_t)tcg[cg] * PP;
        Bq[cg][0] = *(const bf16x8*)(prow + C_Q + h * 64 + 8 * q); Bq[cg][1] = *(const bf16x8*)(prow + C_Q + h * 64 + 32 + 8 * q);
        g0[cg] = bf2f(prow[C_NG + h * 3 + 0]); g2[cg] = bf2f(prow[C_NG + h * 3 + 2]); }
    for (int i = lane; i < 8 * 264; i += 64) imp[i] = 0.f;
    {
        const bf16_t* Kc = T.kcmp + (size_t)kh * 1024 * 64; const bf16_t* Vc = T.vcmpT + (size_t)kh * 64 * 1024;
        const int tmax = (t0 | 63), nvmax = tmax >= 31 ? ((tmax - 31) >> 4) + 1 : 0, nsteps = (nvmax + 31) >> 5;
        BodyCmp1 b1;
#pragma unroll
        for (int cg = 0; cg < 2; ++cg) { b1.Bq[cg][0] = Bq[cg][0]; b1.Bq[cg][1] = Bq[cg][1]; b1.nv[cg] = tcg[cg] >= 31 ? ((tcg[cg] - 31) >> 4) + 1 : 0; b1.ml[cg] = NEGF; b1.ll[cg] = 0.f; }
        b1.q = q;
        cmp_shared<false>(nsteps, b1, Kc, Vc, lds + AL_CKV, tid, lane);
        BodyCmp2 b2; b2.q = q; b2.g = g; b2.lane_ = lane; b2.carry[0] = 0.f; b2.carry[1] = 0.f;
#pragma unroll
        for (int cg = 0; cg < 2; ++cg) {
            float mc = fmaxf(b1.ml[cg], __shfl_xor(b1.ml[cg], 16)); mc = fmaxf(mc, __shfl_xor(mc, 32));
            float lc = b1.ll[cg] * EXP2(b1.ml[cg] - mc); lc += __shfl_xor(lc, 16); lc += __shfl_xor(lc, 32);
            b2.Bq[cg][0] = Bq[cg][0]; b2.Bq[cg][1] = Bq[cg][1]; b2.nv[cg] = b1.nv[cg]; b2.mc[cg] = mc; b2.inv[cg] = 1.f / fmaxf(lc, 1e-30f); b2.ia[cg] = imp + (4 * cg + tk) * 264;
#pragma unroll
            for (int dt = 0; dt < 4; ++dt) b2.O[cg][dt] = (f32x4){0.f, 0.f, 0.f, 0.f};
        }
        asm volatile("s_waitcnt lgkmcnt(0)" ::: "memory");
        cmp_shared<true>(nsteps, b2, Kc, Vc, lds + AL_CKV, tid, lane);
        if (q == 0 && g == 0 && nsteps > 0) { b2.ia[0][8 * nsteps] = b2.carry[0]; b2.ia[1][8 * nsteps] = b2.carry[1]; }
#pragma unroll
        for (int cg = 0; cg < 2; ++cg) { bf16_t* yrow = T.ya + (size_t)tcg[cg] * 512 + h * 64 + 4 * q;
#pragma unroll
            for (int dt = 0; dt < 4; ++dt) { const f32x4 o = b2.O[cg][dt] * g0[cg]; u32x2 w; w.x = cvt_pk_bf16(o[0], o[1]); w.y = cvt_pk_bf16(o[2], o[3]); *(u32x2*)(yrow + 16 * dt) = w; } }
    }
    asm volatile("s_waitcnt lgkmcnt(0)" ::: "memory");
    for (int tk2 = 0; tk2 < 8; ++tk2) {
        const int tt = t0 + tk2, cur = tt >> 6, nvalid = cur + 1, KSEL = nvalid < 16 ? nvalid : 16;
        int bits[4];
#pragma unroll
        for (int s = 0; s < 4; ++s) { const int j = s * 64 + lane; const float v = imp[tk2 * 264 + j];
            bits[s] = (j == 0 || j == cur) ? 0x7F000000 : (j < nvalid ? __float_as_int(v) : -1); }
        int prefix = 0;
        for (int bit = 30; bit >= 0; --bit) { const int Tt = prefix | (1 << bit); int cnt = 0;
#pragma unroll
            for (int s = 0; s < 4; ++s) cnt += __popcll(__ballot(bits[s] >= Tt));
            if (cnt >= KSEL) prefix = Tt; }
        unsigned long long sel[4]; int need = KSEL;
#pragma unroll
        for (int s = 0; s < 4; ++s) { sel[s] = __ballot(bits[s] > prefix); need -= __popcll(sel[s]); }
#pragma unroll
        for (int s = 0; s < 4; ++s) { unsigned long long me = __ballot(bits[s] == prefix);
            while (me != 0ull && need > 0) { const unsigned long long low = me & (0ull - me); sel[s] |= low; me ^= low; --need; } }
        const int tbi = wave * 8 + tk2; const unsigned tbit = 1u << (tbi & 31);
#pragma unroll
        for (int s = 0; s < 4; ++s) if ((sel[s] >> lane) & 1ull) __hip_atomic_fetch_or(tm + (s * 64 + lane) * 2 + (tbi >> 5), tbit, __ATOMIC_RELAXED, __HIP_MEMORY_SCOPE_WORKGROUP);
    }
    {
        const bf16_t* Kw = T.kwnc + (size_t)kh * SEQ * 64; const bf16_t* Vw = T.vwnT + (size_t)kh * 256 * 4096;
        const int tb = t0 & ~63; const int klo = (tb - 511 > 0 ? tb - 511 : 0) & ~63; const int n = ((tb + 63 - klo) >> 5) + 1;
        BodyWin bo; bo.q = q;
#pragma unroll
        for (int cg = 0; cg < 2; ++cg) { bo.Bq[cg][0] = Bq[cg][0]; bo.Bq[cg][1] = Bq[cg][1]; bo.tt[cg] = tcg[cg]; bo.m[cg] = NEGF; bo.l[cg] = 0.f;
#pragma unroll
            for (int dt = 0; dt < 4; ++dt) bo.O[cg][dt] = (f32x4){0.f, 0.f, 0.f, 0.f}; }
        cmp_shared<true>(n, bo, Kw, Vw, lds + AL_CKV, tid, lane, klo, 64, 4096, klo >> 6);
#pragma unroll
        for (int cg = 0; cg < 2; ++cg) { float l = bo.l[cg]; l += __shfl_xor(l, 16); l += __shfl_xor(l, 32);
            const float sc = g2[cg] / fmaxf(l, 1e-30f); bf16_t* yrow = T.ya + (size_t)tcg[cg] * 512 + h * 64 + 4 * q;
#pragma unroll
            for (int dt = 0; dt < 4; ++dt) { const u32x2 y = *(const u32x2*)(yrow + 16 * dt); const f32x4 o = bo.O[cg][dt] * sc;
                u32x2 w; w.x = cvt_pk_bf16(bf_lo(y.x) + o[0], bf_hi(y.x) + o[1]); w.y = cvt_pk_bf16(bf_lo(y.y) + o[2], bf_hi(y.y) + o[3]); *(u32x2*)(yrow + 16 * dt) = w; } }
    }
    asm volatile("s_waitcnt lgkmcnt(0)" ::: "memory");
}

struct UnitPre { int j; unsigned tlo, thi; bf16x8 q00, q01, q10, q11; KOp ka, kb; VOp va, vb; };
template <int PASS>
__device__ __forceinline__ UnitPre unit_load(const LAS unsigned char* qlds, const bf16_t* Ks, const bf16_t* Vs, int kh, int tile, const LAS u32x4* units, int u, int lane) {
    const int col = lane & 15, q = lane >> 4, slot = col >> 2, g = col & 3;
    const u32x4 d = units[u]; UnitPre P; P.j = __builtin_amdgcn_readfirstlane((int)d.x); P.tlo = (unsigned)__builtin_amdgcn_readfirstlane((int)d.y); P.thi = (unsigned)__builtin_amdgcn_readfirstlane((int)d.z);
    const unsigned t0b = (P.tlo >> (8 * slot)) & 0xffu, t1b = (P.thi >> (8 * slot)) & 0xffu;
    const LAS unsigned char* qr0 = qlds + (t0b == 0xffu ? 0 : (int)t0b) * QROWB + g * 128 + 16 * q;
    const LAS unsigned char* qr1 = qlds + (t1b == 0xffu ? 0 : (int)t1b) * QROWB + g * 128 + 16 * q;
    P.q00 = *(const LAS bf16x8*)qr0; P.q01 = *(const LAS bf16x8*)(qr0 + 64); P.q10 = *(const LAS bf16x8*)qr1; P.q11 = *(const LAS bf16x8*)(qr1 + 64);
    P.ka = ldk(Ks, 64, 64 * P.j, lane); P.kb = ldk(Ks, 64, 64 * P.j + 32, lane);
    if (PASS == 1) { if ((EXPV) == 2) { P.va.v0 = P.ka.a00; P.va.v1 = P.ka.a01; P.va.v2 = P.ka.a10; P.va.v3 = P.ka.a11; P.vb = P.va; } else { P.va = ldv(Vs, 64, 64 * P.j, lane); P.vb = ldv(Vs, 64, 64 * P.j + 32, lane); } }
    return P;
}
template <int PASS>
__device__ __forceinline__ void unit_group(const UnitPre& P, const bf16x8& q0, const bf16x8& q1, unsigned toks, int tile, LAS unsigned char* lds, float fxs, int lane) {
    const int col = lane & 15, q = lane >> 4, slot = col >> 2, g = col & 3;
    const int ti = (int)((toks >> (8 * slot)) & 0xffu);
    f32x4 S0a, S1a, S0b, S1b; qk32(P.ka, q0, q1, S0a, S1a); qk32(P.kb, q0, q1, S0b, S1b);
    const bool valid = ti != 0xff; const int row = (valid ? ti : 0) * 4 + g;
    const int lim = (P.j == tile) ? (valid ? ti : -1) - 8 * q : (valid ? 1000 : -1);
    LAS int* mm = (LAS int*)(lds + AL_MM); LAS float* ls = (LAS float*)(lds + AL_LS);
    if (PASS == 0) {
        float mloc = NEGF;
#pragma unroll
        for (int e = 0; e < 4; ++e) { mloc = fmaxf(mloc, e <= lim ? S0a[e] : NEGF); mloc = fmaxf(mloc, e + 4 <= lim ? S1a[e] : NEGF); mloc = fmaxf(mloc, e + 32 <= lim ? S0b[e] : NEGF); mloc = fmaxf(mloc, e + 36 <= lim ? S1b[e] : NEGF); }
        if ((EXPV) != 4) { mloc = fmaxf(mloc, __shfl_xor(mloc, 16)); mloc = fmaxf(mloc, __shfl_xor(mloc, 32)); }
        if (q == 0 && valid && (EXPV) != 3) __hip_atomic_fetch_max(mm + row, f2ord(mloc), __ATOMIC_RELAXED, __HIP_MEMORY_SCOPE_WORKGROUP);
    } else {
        const float m = ord2f(mm[row]);
        f32x4 p0a, p1a, p0b, p1b; float ps = 0.f;
#pragma unroll
        for (int e = 0; e < 4; ++e) { p0a[e] = e <= lim ? EXP2(S0a[e] - m) : 0.f; p1a[e] = e + 4 <= lim ? EXP2(S1a[e] - m) : 0.f; p0b[e] = e + 32 <= lim ? EXP2(S0b[e] - m) : 0.f; p1b[e] = e + 36 <= lim ? EXP2(S1b[e] - m) : 0.f;
            ps += (p0a[e] + p1a[e]) + (p0b[e] + p1b[e]); }
        ps += __shfl_xor(ps, 16); ps += __shfl_xor(ps, 32);
        if (q == 0 && valid) __hip_atomic_fetch_add(ls + row, ps, __ATOMIC_RELAXED, __HIP_MEMORY_SCOPE_WORKGROUP);
        f32x4 O[4];
#pragma unroll
        for (int dt = 0; dt < 4; ++dt) O[dt] = (f32x4){0.f, 0.f, 0.f, 0.f};
        pv32(P.va, packP(p0a, p1a), O); pv32(P.vb, packP(p0b, p1b), O);
        if (valid) { LAS unsigned long long* orow = (LAS unsigned long long*)(lds + AL_OS) + row * OSP + 2 * q;
#pragma unroll
            for (int dt = 0; dt < 4; ++dt) {
                const unsigned a0 = (unsigned)((int)rintf(O[dt][0] * fxs) + (1 << 26)), a1 = (unsigned)((int)rintf(O[dt][1] * fxs) + (1 << 26)), a2 = (unsigned)((int)rintf(O[dt][2] * fxs) + (1 << 26)), a3 = (unsigned)((int)rintf(O[dt][3] * fxs) + (1 << 26));
                __hip_atomic_fetch_add(orow + 8 * dt, (unsigned long long)a0 | ((unsigned long long)a1 << 32), __ATOMIC_RELAXED, __HIP_MEMORY_SCOPE_WORKGROUP);
                __hip_atomic_fetch_add(orow + 8 * dt + 1, (unsigned long long)a2 | ((unsigned long long)a3 << 32), __ATOMIC_RELAXED, __HIP_MEMORY_SCOPE_WORKGROUP); } }
    }
}
template <int PASS>
__device__ __forceinline__ void unit_compute(const UnitPre& P, int tile, LAS unsigned char* lds, float fxs, int lane) {
    unit_group<PASS>(P, P.q00, P.q01, P.tlo, tile, lds, fxs, lane);
    if (P.thi != 0xffffffffu) unit_group<PASS>(P, P.q10, P.q11, P.thi, tile, lds, fxs, lane);
}
template <int PASS>
__device__ __forceinline__ void unit_pass(const AttnT& T, int kh, int tile, int n, LAS unsigned char* lds, int wave, int lane) {
    const bf16_t* Ks = T.kslc + (size_t)kh * SEQ * 64; const bf16_t* Vs = T.vslT + (size_t)kh * 256 * 4096;
    const LAS u32x4* units = (const LAS u32x4*)(lds + AL_UNITS);
    int u = wave; if (u >= n) return;
    UnitPre A = unit_load<PASS>(lds + AL_Q, Ks, Vs, kh, tile, units, u, lane), B = A;
    for (; u < n; u += 16) {
        const int u1 = u + 8; if (u1 < n) B = unit_load<PASS>(lds + AL_Q, Ks, Vs, kh, tile, units, u1, lane);
        unit_compute<PASS>(A, tile, lds, T.fxs, lane);
        if (u1 >= n) break;
        const int u2 = u + 16; if (u2 < n) A = unit_load<PASS>(lds + AL_Q, Ks, Vs, kh, tile, units, u2, lane);
        unit_compute<PASS>(B, tile, lds, T.fxs, lane);
    }
}

__device__ __forceinline__ void attn_tile(const AttnT& T, int kh, int tile, LAS unsigned char* lds, int tid, int wave, int lane) {
    LAS unsigned* tm = (LAS unsigned*)(lds + AL_TM);
    for (int i = tid; i < 512; i += NT) tm[i] = 0u;
    __syncthreads();
    if ((TSK) >= 20 && blockIdx.x == 0 && threadIdx.x == 0) T.tsa[15] = __builtin_amdgcn_s_memrealtime();
    attn_wave_part1(T, kh, tile * 8 + wave, lane, (LAS float*)(lds + AL_IMP + wave * 8448), tm, wave, lds, tid);
    __threadfence_block(); __syncthreads();
    { const int ti = tid >> 3, part = tid & 7; const u32x4* src = (const u32x4*)(T.proj + (size_t)(tile * 64 + ti) * PP + C_Q + kh * 256 + part * 32); LAS u32x4* dst = (LAS u32x4*)(lds + AL_Q + ti * QROWB + part * 64);
      dst[0] = src[0]; dst[1] = src[1]; dst[2] = src[2]; dst[3] = src[3]; }
    ASTAMP(0);
    LAS int* cnt = (LAS int*)(lds + AL_CNT); LAS int* off = (LAS int*)(lds + AL_OFF); LAS u32x4* units = (LAS u32x4*)(lds + AL_UNITS);
    for (int i = tid; i < 256 * OSP; i += NT) ((LAS unsigned long long*)(lds + AL_OS))[i] = 0ull;
    if (tid < 256) { ((LAS int*)(lds + AL_MM))[tid] = f2ord(NEGF); ((LAS float*)(lds + AL_LS))[tid] = 0.f; cnt[tid] = (__popc(tm[2 * tid]) + __popc(tm[2 * tid + 1]) + 7) >> 3; }
    __syncthreads();
    if (tid < 64) {
        const int c0 = cnt[4 * tid], c1 = cnt[4 * tid + 1], c2 = cnt[4 * tid + 2], c3 = cnt[4 * tid + 3]; const int tot = (c0 + c1) + (c2 + c3); int inc = tot;
#pragma unroll
        for (int o = 1; o < 64; o <<= 1) { const int v = __shfl_up(inc, o); if (tid >= o) inc += v; }
        const int ex = inc - tot; off[4 * tid] = ex; off[4 * tid + 1] = ex + c0; off[4 * tid + 2] = ex + c0 + c1; off[4 * tid + 3] = ex + c0 + c1 + c2;
        if (tid == 63) off[256] = inc;
    }
    __syncthreads();
    if (tid < 256) { unsigned long long mask = (unsigned long long)tm[2 * tid] | ((unsigned long long)tm[2 * tid + 1] << 32); int o = off[tid];
        while (mask != 0ull) { unsigned tl = 0xffffffffu, th = 0xffffffffu;
#pragma unroll
            for (int k = 0; k < 4; ++k) if (mask != 0ull) { const unsigned ti = (unsigned)__builtin_ctzll(mask); mask &= mask - 1ull; tl = (tl & ~(0xffu << (8 * k))) | (ti << (8 * k)); }
#pragma unroll
            for (int k = 0; k < 4; ++k) if (mask != 0ull) { const unsigned ti = (unsigned)__builtin_ctzll(mask); mask &= mask - 1ull; th = (th & ~(0xffu << (8 * k))) | (ti << (8 * k)); }
            units[o++] = (u32x4){(unsigned)tid, tl, th, 0u}; } }
    __syncthreads();
    const int n = off[256];
    ASTAMP(1);
    unit_pass<0>(T, kh, tile, n, lds, wave, lane);
    if ((PROBE_REP) == 42) unit_pass<0>(T, kh, tile, n, lds, wave, lane);
    __syncthreads();
    ASTAMP(2);
    unit_pass<1>(T, kh, tile, n, lds, wave, lane);
    __syncthreads();
    ASTAMP(3);
    { const int ti = tid >> 3, part = tid & 7, g = part >> 1, d0 = 32 * (part & 1), row = ti * 4 + g, t = tile * 64 + ti, h = kh * 4 + g;
      const float l = ((const LAS float*)(lds + AL_LS))[row]; const float sc = bf2f(T.proj[(size_t)t * PP + C_NG + h * 3 + 1]) / fmaxf(l, 1e-30f);
      const LAS unsigned long long* orow = (const LAS unsigned long long*)(lds + AL_OS) + row * OSP + (d0 >> 1); u32x4* yp = (u32x4*)(T.ya + (size_t)t * 512 + h * 64 + d0);
      const int nsel = ((t >> 6) + 1) < 16 ? ((t >> 6) + 1) : 16; const unsigned bias = (unsigned)nsel << 26; const float sc2 = sc / T.fxs;
#pragma unroll
      for (int i = 0; i < 4; ++i) { const u32x4 y = yp[i]; const unsigned long long o0 = orow[4 * i], o1 = orow[4 * i + 1], o2 = orow[4 * i + 2], o3 = orow[4 * i + 3]; f32x4 a, b;
          a[0] = bf_lo(y.x) + (float)(int)((unsigned)o0 - bias) * sc2; a[1] = bf_hi(y.x) + (float)(int)((unsigned)(o0 >> 32) - bias) * sc2; a[2] = bf_lo(y.y) + (float)(int)((unsigned)o1 - bias) * sc2; a[3] = bf_hi(y.y) + (float)(int)((unsigned)(o1 >> 32) - bias) * sc2;
          b[0] = bf_lo(y.z) + (float)(int)((unsigned)o2 - bias) * sc2; b[1] = bf_hi(y.z) + (float)(int)((unsigned)(o2 >> 32) - bias) * sc2; b[2] = bf_lo(y.w) + (float)(int)((unsigned)o3 - bias) * sc2; b[3] = bf_hi(y.w) + (float)(int)((unsigned)(o3 >> 32) - bias) * sc2;
          yp[i] = pack8(a, b); } }
    __syncthreads();
    ASTAMP(4);
    if ((TSK) >= 20 && blockIdx.x == 0 && threadIdx.x == 0) T.tsa[5] += (unsigned long long)n;
}

struct SsmB { bf16x8 a[8]; };
__device__ __forceinline__ SsmB ssm_load_b(const unsigned char* ws, int g, int lane) {
    const int i = lane & 15, q = lane >> 4; SsmB B; const bf16x8 z = {0, 0, 0, 0, 0, 0, 0, 0};
    const bf16_t* t = (const bf16_t*)(ws + WS_BBAR) + ((size_t)(g * 128 + i) * 16 + 8 * (q & 1));
#pragma unroll
    for (int rt = 0; rt < 8; ++rt) B.a[rt] = (q < 2) ? *(const bf16x8*)(t + (size_t)rt * 16 * 16) : z;
    return B;
}
__device__ __forceinline__ void ssm_bu16(const bf16x8& ub, const SsmB& B, int lane, LAS float* bul) {
    const int i = lane & 15, q = lane >> 4;
    const f32x4 z4 = {0.f, 0.f, 0.f, 0.f};
#pragma unroll
    for (int rt = 0; rt < 8; ++rt) { const f32x4 acc = MFMA16(B.a[rt], ub, z4); *(LAS f32x4*)(bul + i * 132 + 16 * rt + 4 * q) = acc; }
    asm volatile("s_waitcnt lgkmcnt(0)" ::: "memory");
}
struct SsmU { bf16x8 ub[8]; };
__device__ __forceinline__ SsmU ssm_load_u8(const bf16_t* proj, int c, int g, int lane) {
    const int i = lane & 15, q = lane >> 4; const bf16x8 z = {0, 0, 0, 0, 0, 0, 0, 0}; SsmU U;
#pragma unroll
    for (int sub = 0; sub < 8; ++sub) U.ub[sub] = (q < 2) ? *(const bf16x8*)(proj + (size_t)(c * 128 + sub * 16 + i) * PP + C_U + g * 16 + 8 * (q & 1)) : z;
    return U;
}
__device__ __forceinline__ f32x2 ssm_step(const f32x2 A, const f32x2 x, const f32x2 bu) { f32x2 r; r.x = A.x * x.x - A.y * x.y + bu.x; r.y = A.x * x.y + A.y * x.x + bu.y; return r; }
__device__ __forceinline__ void ssm_pass1(const unsigned char* ws, int c, int g, int lane, LAS float* bul) {
    const bf16_t* proj = (const bf16_t*)(ws + WS_PROJ);
    const SsmB B = ssm_load_b(ws, g, lane);
    const f32x2 A = ((const f32x2*)(ws + WS_ABAR))[g * 64 + lane];
    const SsmU U = ssm_load_u8(proj, c, g, lane);
    f32x2 x = {0.f, 0.f};
#pragma unroll
    for (int sub = 0; sub < 8; ++sub) {
        ssm_bu16(U.ub[sub], B, lane, bul);
#pragma unroll
        for (int s = 0; s < 16; ++s) x = ssm_step(A, x, *(const LAS f32x2*)(bul + s * 132 + 2 * lane));
        asm volatile("s_waitcnt lgkmcnt(0)" ::: "memory");
    }
    ((f32x2*)(ws + WS_SBUF))[(size_t)(c * 32 + g) * 64 + lane] = x;
}
__device__ __forceinline__ void ssm_pass3(const Args& a, int c, int g, int lane, LAS float* bul, LAS unsigned char* xl  ) {
    const unsigned char* ws = a.ws; const bf16_t* proj = (const bf16_t*)(ws + WS_PROJ);
    const SsmB B = ssm_load_b(ws, g, lane);
    const f32x2 A = ((const f32x2*)(ws + WS_ABAR))[g * 64 + lane], A128 = ((const f32x2*)(ws + WS_A128))[g * 64 + lane];
    const SsmU U = ssm_load_u8(proj, c, g, lane);
    u32x2 uwv[8];
#pragma unroll
    for (int sub = 0; sub < 8; ++sub) uwv[sub] = *(const u32x2*)(proj + (size_t)(c * 128 + sub * 16 + (lane & 15)) * PP + C_U + g * 16 + 4 * (lane >> 4));
    f32x2 x = {0.f, 0.f};
    { const f32x2* Sb = (const f32x2*)(ws + WS_SBUF) + g * 64 + lane;
      _Pragma("unroll 8") for (int cc = 0; cc < c; ++cc) { const f32x2 s = Sb[(size_t)cc * 32 * 64]; f32x2 r; r.x = A128.x * x.x - A128.y * x.y + s.x; r.y = A128.x * x.y + A128.y * x.x + s.y; x = r; } }
    const int hrow = lane & 15, q = lane >> 4; bf16x8 Cm[4];
    { const float* cre = a.in[14] + (size_t)(g * 16 + hrow) * 64; const float* cim = a.in[15] + (size_t)(g * 16 + hrow) * 64;
#pragma unroll
      for (int ks = 0; ks < 4; ++ks) { const f32x4 r = *(const f32x4*)(cre + 16 * ks + 4 * q), im = *(const f32x4*)(cim + 16 * ks + 4 * q);
          u32x4 w; w.x = cvt_pk_bf16(r[0], -im[0]); w.y = cvt_pk_bf16(r[1], -im[1]); w.z = cvt_pk_bf16(r[2], -im[2]); w.w = cvt_pk_bf16(r[3], -im[3]); Cm[ks] = __builtin_bit_cast(bf16x8, w); } }
    const f32x4 dsk = *(const f32x4*)(a.in[16] + g * 16 + 4 * q);
    bf16_t* ybp = (bf16_t*)((unsigned char*)a.out + OUT_YBP);
#pragma unroll
    for (int sub = 0; sub < 8; ++sub) {
        const int tok0 = c * 128 + sub * 16;
        ssm_bu16(U.ub[sub], B, lane, bul);
#pragma unroll
        for (int s = 0; s < 16; ++s) { x = ssm_step(A, x, *(const LAS f32x2*)(bul + s * 132 + 2 * lane)); *(LAS unsigned*)(xl + s * 272 + lane * 4) = cvt_pk_bf16(x.x, x.y); }
        asm volatile("s_waitcnt lgkmcnt(0)" ::: "memory");
        f32x4 acc = {0.f, 0.f, 0.f, 0.f};
#pragma unroll
        for (int ks = 0; ks < 4; ++ks) { const bf16x8 b = *(const LAS bf16x8*)(xl + hrow * 272 + ks * 64 + q * 16); acc = MFMA16(Cm[ks], b, acc); }
        const u32x2 uw = uwv[sub];
        const f32x4 uu = {bf_lo(uw.x), bf_hi(uw.x), bf_lo(uw.y), bf_hi(uw.y)};
        f32x4 y = acc + dsk * uu;
        u32x2 w; w.x = cvt_pk_bf16(gelu_tanh(y[0]), gelu_tanh(y[1])); w.y = cvt_pk_bf16(gelu_tanh(y[2]), gelu_tanh(y[3]));
        *(u32x2*)(ybp + (size_t)(tok0 + hrow) * 512 + g * 16 + 4 * q) = w;
        asm volatile("s_waitcnt lgkmcnt(0)" ::: "memory");
    }
}

__global__ void __launch_bounds__(NT, 2) fwd_mega(Args a) {
    extern __shared__ __attribute__((aligned(16))) unsigned char lds_raw[];
    cg::grid_group grid = cg::this_grid();
    LAS unsigned char* lds = (LAS unsigned char*)lds_raw;
    const int tid = threadIdx.x, lane = tid & 63, wave = __builtin_amdgcn_readfirstlane(tid >> 6);
    const int G = gridDim.x, bid = blockIdx.x;
    const int gw = bid * NWV + wave, NGW = G * NWV;
    const int gt = bid * NT + tid, NGT = G * NT;
    unsigned char* ws = a.ws;
    const float* x = a.in[0];
    STAMP(0);
    if ((TSK) >= 20 && blockIdx.x == 0 && threadIdx.x == 0) for (int i = 0; i < 16; ++i) ((unsigned long long*)(a.ws + 244 * 1024))[i] = 0ull;
    if (tid < 4) ((volatile LAS unsigned*)(lds + 131072 + 64))[tid] = 0u;
    if (bid == 0) for (int i = tid; i < XCD_BAR_WORDS; i += NT) ((unsigned*)(ws + WS_BAR))[i] = 0u;
    __syncthreads();

    {
        const int bb_ = G >= 256 ? 240 : 0;
        if (bid >= bb_ && bid < bb_ + 16) {
            LAS float* red = (LAS float*)lds;
            const int o = (bid - bb_) * 32 + (tid & 31), ksl = tid >> 5, which = o >> 8, colc = o & 255;
            const float* pe = a.in[which ? 7 : 4]; const float* w1 = a.in[which ? 8 : 5]; float s = 0.f;
            _Pragma("unroll 16") for (int k = ksl * 128; k < ksl * 128 + 128; ++k) s += pe[k] * w1[(size_t)k * 256 + colc];
            red[ksl * 32 + (tid & 31)] = s; __syncthreads();
            if (tid < 32) { float t = 0.f; for (int i = 0; i < 16; ++i) t += red[i * 32 + tid]; ((float*)(ws + WS_BIASPE))[o] = t; }
            __syncthreads();
        }
        LAS float* scr = (LAS float*)(lds + wave * 8448);
        constexpr int I_IN = 16 * 121, I_GLU = 8 * 16, I_PA = 8 * 32, I_OUT = 16 * 32, I_UP = 16 * 176, I_DN = 44 * 32, I_W1 = 32 * 8;
        constexpr int NITEMS = I_IN + I_GLU + 2 * I_PA + I_OUT + I_UP + I_DN + 2 * I_W1;
        for (int it = gw; it < NITEMS; it += NGW) {
            int r = it;
            if (r < I_IN) { transpose_item(a.in[3], 1024, DIN, (bf16_t*)(ws + WS_WIN), scr, r / 121, r % 121, lane, a.in[2], 1); continue; } r -= I_IN;
            if (r < I_GLU) { transpose_item(a.in[18], 512, 512, (bf16_t*)(ws + WS_WGLU), scr, r / 16, r % 16, lane, nullptr, 0); continue; } r -= I_GLU;
            if (r < I_PA) { transpose_item(a.in[19], 512, 1024, (bf16_t*)(ws + WS_WPA), scr, r / 32, r % 32, lane, nullptr, 0); continue; } r -= I_PA;
            if (r < I_PA) { transpose_item(a.in[20], 512, 1024, (bf16_t*)(ws + WS_WPB), scr, r / 32, r % 32, lane, nullptr, 0); continue; } r -= I_PA;
            if (r < I_OUT) { transpose_item(a.in[21], 1024, 1024, (bf16_t*)(ws + WS_WOUT), scr, r / 32, r % 32, lane, nullptr, 0); continue; } r -= I_OUT;
            if (r < I_UP) { transpose_item(a.in[23], 1024, NUP, (bf16_t*)(ws + WS_WUP), scr, r / 176, r % 176, lane, a.in[22], 2); continue; } r -= I_UP;
            if (r < I_DN) { transpose_item(a.in[26], DFF, 1024, (bf16_t*)(ws + WS_WDOWN), scr, r / 32, r % 32, lane, nullptr, 0); continue; } r -= I_DN;
            if (r < I_W1) { transpose_item(a.in[5], 2048, 256, (bf16_t*)(ws + WS_W1K), scr, r / 8, r % 8, lane, nullptr, 0); continue; } r -= I_W1;
            transpose_item(a.in[8], 2048, 256, (bf16_t*)(ws + WS_W1V), scr, r / 8, r % 8, lane, nullptr, 0);
        }
        { u32x4* p = (u32x4*)(ws + WS_WIN + (size_t)DIN * 1024 * 2); const int n = (4096 - DIN) * 1024 * 2 / 16; for (int i = gt; i < n; i += NGT) p[i] = (u32x4){0u, 0u, 0u, 0u}; }
        { u32x4* p = (u32x4*)(ws + WS_PROJ + (size_t)SEQ * PP * 2); const int n = 32 * PP * 2 / 16; for (int i = gt; i < n; i += NGT) p[i] = (u32x4){0u, 0u, 0u, 0u}; }
        for (int i = gt; i < 128 * 64 + 2048; i += NGT) {
            if (i < 128 * 64) { const int r = i >> 6, cidx = SEQ + (i & 63); ((bf16_t*)(ws + WS_VSLT))[(size_t)r * VTP + cidx] = 0; ((bf16_t*)(ws + WS_VWNT))[(size_t)r * VTP + cidx] = 0; }
            else { const int j = i - 128 * 64; ((bf16_t*)(ws + WS_VSLT))[(size_t)128 * VTP + j] = 0; ((bf16_t*)(ws + WS_VWNT))[(size_t)128 * VTP + j] = 0; }
        }
        for (int i = gt; i < SEQ; i += NGT) { ((float*)(ws + WS_RSS2))[i] = 0.f; ((float*)(ws + WS_RSS3))[i] = 0.f; }
        if (gt == 0) *(unsigned*)(ws + WS_VMAX) = 0u;
        { const int* pos = (const int*)a.in[1];
          for (int i = gt; i < SEQ * 8; i += NGT) { const int tt = i >> 3, fi = i & 7; const float invf = powf(500000.0f, -(float)(2 * fi) / 16.0f); const float ang = (float)pos[tt] * invf;
              float sn, cs; sincosf(ang, &sn, &cs); ((float*)(ws + WS_ROPEC))[i] = cs; ((float*)(ws + WS_ROPES))[i] = sn; } }
        const int sb_ = G >= 256 ? 210 : 0;
        for (int i = (bid - sb_) * NT + tid; bid >= sb_ && i < 2048; i += NGT) { const int gg = i >> 6;
            const float dt = expf(a.in[17][gg]), ar = a.in[10][i], ai = a.in[11][i];
            const float e = expf(ar * dt), em1 = expm1f(ar * dt), th = ai * dt; float sn, cs; sincosf(th, &sn, &cs); const float sh = sinf(0.5f * th);
            const float Ax = e * cs, Ay = e * sn; const float nx = em1 * cs - 2.f * sh * sh, ny = e * sn;
            const float den = 1.f / (ar * ar + ai * ai); const float fx = (nx * ar + ny * ai) * den, fy = (ny * ar - nx * ai) * den;
            ((f32x2*)(ws + WS_ABAR))[i] = (f32x2){Ax, Ay};
            float px = Ax, py = Ay;
            for (int k = 0; k < 7; ++k) { const float qx = px * px - py * py, qy = 2.f * px * py; px = qx; py = qy; }
            ((f32x2*)(ws + WS_A128))[i] = (f32x2){px, py};
            const float* bre = a.in[12] + (size_t)i * 16; const float* bim = a.in[13] + (size_t)i * 16; const int pp = i & 63;
            bf16_t* Bo = (bf16_t*)(ws + WS_BBAR) + ((size_t)(gg * 128 + 2 * pp) * 16);
            for (int hh = 0; hh < 16; hh += 2) { *(unsigned*)(Bo + hh) = cvt_pk_bf16(fx * bre[hh] - fy * bim[hh], fx * bre[hh + 1] - fy * bim[hh + 1]);
                                                 *(unsigned*)(Bo + 16 + hh) = cvt_pk_bf16(fx * bim[hh] + fy * bre[hh], fx * bim[hh + 1] + fy * bre[hh + 1]); }
        }
        for (int r = gw; r < SEQ; r += NGW) {
            const f32x4* xr = (const f32x4*)(x + (size_t)r * DM) + lane; f32x4 v[4]; float s = 0.f;
#pragma unroll
            for (int j = 0; j < 4; ++j) { v[j] = xr[64 * j]; s += (v[j][0] * v[j][0] + v[j][1] * v[j][1]) + (v[j][2] * v[j][2] + v[j][3] * v[j][3]); }
            s = wave_sum(s);
            if (lane == 0) ((float*)(ws + WS_RSTD1))[r] = rsqrtf(s * (1.f / DM) + EPS);
            u32x2* o = (u32x2*)(ws + WS_XB + (size_t)r * DM * 2) + lane;
#pragma unroll
            for (int j = 0; j < 4; ++j) { u32x2 w; w.x = cvt_pk_bf16(v[j][0], v[j][1]); w.y = cvt_pk_bf16(v[j][2], v[j][3]); o[64 * j] = w; }
        }
    }
    grid.sync();
    STAMP(1);
    XcdBarrier xbar = xcd_barrier_post((unsigned*)(ws + WS_BAR), (volatile LAS unsigned*)(lds + 131072 + 64));

    REPS(1) {
        pg8::Gemm g{1024, 2048u, 128u, (unsigned)(1024) * 2u};
        SchedMN S{64, 16, 1, G, bid, 0, (const char*)(ws + WS_XB), nullptr, (const char*)(ws + WS_WIN), nullptr, (size_t)256 * 1024 * 2, (size_t)256 * 1024 * 2};
        EpiProj E{(bf16_t*)(ws + WS_PROJ), (bf16_t*)(ws + WS_VSLT), (bf16_t*)(ws + WS_VWNT), (bf16_t*)(ws + WS_KSL), (bf16_t*)(ws + WS_KWN), (const float*)(ws + WS_RSTD1), (const float*)(ws + WS_ROPEC), (const float*)(ws + WS_ROPES)};
        pg8::gemm_phase<EpiProj, SchedMN, true, true>(lds, g, S, E);
    }
    GSYNC();
    STAMP(2);

    {
        if (bid < 64) {
            pg8::Gemm g{512, (unsigned)(16 * PP * 2), (unsigned)(PP * 2), (unsigned)(2048) * 2u};
            SchedCmp S{bid, (const char*)(ws + WS_PROJ), (const char*)(ws + WS_W1K), (const char*)(ws + WS_W1V)};
            EpiCmp E{(float*)(ws + WS_XB)};
            pg8::gemm_phase<EpiCmp, SchedCmp, true, true>(lds, g, S, E);
        } else {
            LAS float* ubuf = (LAS float*)(lds + wave * 16384);
            for (int it = (bid - 64) * NWV + wave; it < 4096 * ((PROBE_REP) == 12 ? 2 : 1); it += (G - 64) * NWV) ssm_pass1(ws, (it & 4095) >> 5, it & 31, lane, ubuf);
        }
    }
    GSYNC();
    STAMP(3);

    REPS(3) {
        {
            const u32x4* vp = (const u32x4*)(ws + WS_VSLT); unsigned mx = 0u;
            for (int i = gt; i < 262144; i += NGT) { const u32x4 v = vp[i];
                mx = max(mx, max(max(v.x & 0x7fffu, (v.x >> 16) & 0x7fffu), max(v.y & 0x7fffu, (v.y >> 16) & 0x7fffu)));
                mx = max(mx, max(max(v.z & 0x7fffu, (v.z >> 16) & 0x7fffu), max(v.w & 0x7fffu, (v.w >> 16) & 0x7fffu))); }
#pragma unroll
            for (int o = 1; o < 64; o <<= 1) mx = max(mx, (unsigned)__shfl_xor((int)mx, o));
            LAS unsigned* red = (LAS unsigned*)(lds + 65536); if (lane == 0) red[wave] = mx; __syncthreads();
            if (tid == 0) { unsigned m8 = red[0]; for (int w = 1; w < NWV; ++w) m8 = max(m8, red[w]); atomicMax((unsigned*)(ws + WS_VMAX), m8); }
            __syncthreads();
        }
        const float* hidp = (const float*)(ws + WS_XB); LAS float* hrow = (LAS float*)(lds + wave * 1024);
        for (int r = gw; r < 4096; r += NGW) {
            const int z = r >> 10, n = r & 1023, which = z >> 1, kh = z & 1;
            float acc = 0.f;
            if (n < 1023) { const float* w2 = a.in[which ? 9 : 6];
                f32x4 hv = *(const f32x4*)((const float*)(ws + WS_BIASPE) + which * 256 + 4 * lane);
#pragma unroll
                for (int ks = 0; ks < 4; ++ks) hv += *(const f32x4*)(hidp + ((size_t)ks * 4096 + r) * 256 + 4 * lane);
                hv[0] = gelu_tanh(hv[0]); hv[1] = gelu_tanh(hv[1]); hv[2] = gelu_tanh(hv[2]); hv[3] = gelu_tanh(hv[3]);
                *(LAS f32x4*)(hrow + 4 * lane) = hv; asm volatile("s_waitcnt lgkmcnt(0)" ::: "memory");
                _Pragma("unroll 16") for (int k = 0; k < 256; k += 4) { const f32x4 h4 = *(const LAS f32x4*)(hrow + k);
                    acc += h4[0] * w2[k * 64 + lane]; acc += h4[1] * w2[(k + 1) * 64 + lane]; acc += h4[2] * w2[(k + 2) * 64 + lane]; acc += h4[3] * w2[(k + 3) * 64 + lane]; }
                asm volatile("s_waitcnt lgkmcnt(0)" ::: "memory"); }
            if (which == 0) {
                const float other = __shfl_xor(acc, 8); const int prow = 16 * n + 31; float o = acc;
                if (lane < 16 && n < 1023) { const float cs = ((const float*)(ws + WS_ROPEC))[prow * 8 + (lane & 7)], sn = ((const float*)(ws + WS_ROPES))[prow * 8 + (lane & 7)];
                    o = lane < 8 ? acc * cs - other * sn : acc * cs + other * sn; }
                ((bf16_t*)(ws + WS_KCMP))[((size_t)kh * 1024 + n) * 64 + lane] = (bf16_t)(cvt_pk_bf16(o, 0.f) & 0xffff);
            } else {
                ((bf16_t*)(ws + WS_VCMPT))[((size_t)kh * 64 + lane) * 1024 + n] = (bf16_t)(cvt_pk_bf16(acc, 0.f) & 0xffff);
            }
        }
    }
    GSYNC();
    STAMP(4);

    {
        AttnT T{0.f, (unsigned long long*)(ws + 244 * 1024), (const bf16_t*)(ws + WS_PROJ), (const bf16_t*)(ws + WS_KSL), (const bf16_t*)(ws + WS_KWN), (const bf16_t*)(ws + WS_KCMP), (const bf16_t*)(ws + WS_VCMPT), (const bf16_t*)(ws + WS_VSLT), (const bf16_t*)(ws + WS_VWNT), (bf16_t*)((unsigned char*)a.out + OUT_YA)};
        { const unsigned vb = __hip_atomic_load((unsigned*)(ws + WS_VMAX), __ATOMIC_RELAXED, __HIP_MEMORY_SCOPE_AGENT); const float vmax = fmaxf(__uint_as_float(vb << 16), 1e-30f); T.fxs = FXB / (64.0f * 1.01f * vmax); }
        LAS float* wl = (LAS float*)(lds + wave * 16384);
        for (int r2 = 0; r2 < ((PROBE_REP) == 4 ? 2 : 1); ++r2)
        for (int pr = bid; pr < 256; pr += G) {
            const int xcd = pr & 7, slot = pr >> 3, kh = xcd & 1, tl = 32 * (xcd >> 1) + slot;
_Pragma("nounroll")
            for (int k2 = 0; k2 < 2; ++k2) { int tk_ = threadIdx.x; asm volatile("" : "+v"(tk_)); attn_tile(T, kh, k2 ? 255 - tl : tl, lds, tk_, __builtin_amdgcn_readfirstlane(tk_ >> 6), tk_ & 63); }
        }
        if ((PROBE_REP) == 4) {
            AttnT T2 = T; T2.ya = (bf16_t*)(ws + WS_XB);
            for (int pr = bid; pr < 256; pr += G) { const int xcd = pr & 7, slot = pr >> 3, kh = xcd & 1, tl = 32 * (xcd >> 1) + slot;
                _Pragma("nounroll") for (int k2 = 0; k2 < 2; ++k2) attn_tile(T2, kh, k2 ? 255 - tl : tl, lds, tid, wave, lane); }
        }
        int tid2 = threadIdx.x; asm volatile("" : "+v"(tid2));
        const int lane2 = tid2 & 63, wave2 = __builtin_amdgcn_readfirstlane(tid2 >> 6), gw2 = bid * NWV + wave2;
        for (int it = gw2; it < 4096 * ((PROBE_REP) == 14 ? 2 : 1); it += NGW) ssm_pass3(a, (it & 4095) >> 5, it & 31, lane2, (LAS float*)(lds + wave2 * 16384), lds + wave2 * 16384 + 8448);
    }
    GSYNC();
    STAMP(5);

    REPS(5) {
        pg8::Gemm g{512, 1024u, 128u, (unsigned)(512) * 2u};
        SchedMN S{64, 2, 1, G, bid, 0, (const char*)a.out + OUT_YBP, nullptr, (const char*)(ws + WS_WGLU), nullptr, (size_t)256 * 512 * 2, (size_t)256 * 512 * 2};
        EpiGlu E{(const bf16_t*)((const unsigned char*)a.out + OUT_YBP), (bf16_t*)((unsigned char*)a.out + OUT_YB)};
        pg8::gemm_phase<EpiGlu, SchedMN, true, true>(lds, g, S, E);
    }
    GSYNC();
    STAMP(6);

    REPS(6) {
        pg8::Gemm g{512, 1024u, 128u, (unsigned)(512) * 2u};
        SchedMN S{64, 4, 2, G, bid, 0, (const char*)a.out + OUT_YA, (const char*)a.out + OUT_YB, (const char*)(ws + WS_WPA), (const char*)(ws + WS_WPB), (size_t)256 * 512 * 2, (size_t)256 * 512 * 2};
        EpiMerge E{(const bf16_t*)(ws + WS_PROJ), (bf16_t*)(ws + WS_MERGED)};
        pg8::gemm_phase<EpiMerge, SchedMN, true, true>(lds, g, S, E);
    }
    GSYNC();
    STAMP(7);

    {
        pg8::Gemm g{1024, 2048u, 128u, (unsigned)(1024) * 2u};
        SchedMN S{64, 4, 1, G, bid, 0, (const char*)(ws + WS_MERGED), nullptr, (const char*)(ws + WS_WOUT), nullptr, (size_t)256 * 1024 * 2, (size_t)256 * 1024 * 2};
        EpiRes E{x, a.out, (bf16_t*)(ws + WS_X1B), (float*)(ws + WS_RSS2)};
        pg8::gemm_phase<EpiRes, SchedMN, true, true>(lds, g, S, E);
    }
    GSYNC();
    STAMP(8);

    for (int half = 0; half < 2; ++half) {
        const int pm_off = half ? 31 : 0, nM = half ? 33 : 32, rowbase = pm_off * 256;
        REPS(8) {
            pg8::Gemm g{1024, 2048u, 128u, (unsigned)(1024) * 2u};
            SchedMN S{nM, 22, 1, G, bid, pm_off, (const char*)(ws + WS_X1B), nullptr, (const char*)(ws + WS_WUP), nullptr, (size_t)256 * 1024 * 2, (size_t)256 * 1024 * 2};
            EpiUp E{(bf16_t*)(ws + WS_UPRAW), (const float*)(ws + WS_RSS2), rowbase};
            pg8::gemm_phase<EpiUp, SchedMN, true, true>(lds, g, S, E);
        }
        GSYNC();
    STAMP(9);
        REPS(9) {
            const bf16_t* up = (const bf16_t*)(ws + WS_UPRAW); bf16_t* act = (bf16_t*)(ws + WS_ACT);
            const float* cw = a.in[24]; const float* cb = a.in[25];
            const int tlo = half ? 8192 : 0;
            for (int it = gt; it < 256 * 352; it += NGT) {
                const int cg8 = it % 352, tb = it / 352, c0 = cg8 * 8, tile = c0 >> 7, jj = c0 & 127;
                const int ucol = tile * 256 + jj;
                float wg[3][8], wv[3][8], bg[8], bv[8];
#pragma unroll
                for (int e = 0; e < 8; ++e) { bg[e] = cb[c0 + e]; bv[e] = cb[DFF + c0 + e];
#pragma unroll
                    for (int k = 0; k < 3; ++k) { wg[k][e] = cw[k * NUP + c0 + e]; wv[k][e] = cw[k * NUP + DFF + c0 + e]; } }
                const int ts = tlo + tb * 32;
                float g2[8], g1[8], v2[8], v1[8];
#pragma unroll
                for (int e = 0; e < 8; ++e) { g2[e] = g1[e] = v2[e] = v1[e] = 0.f; }
                if (ts >= 2) {
                    const u32x4 a2 = *(const u32x4*)(up + (size_t)(ts - 2 - rowbase) * NUP + ucol), b2 = *(const u32x4*)(up + (size_t)(ts - 2 - rowbase) * NUP + ucol + 128);
                    const u32x4 a1 = *(const u32x4*)(up + (size_t)(ts - 1 - rowbase) * NUP + ucol), b1 = *(const u32x4*)(up + (size_t)(ts - 1 - rowbase) * NUP + ucol + 128);
                    g2[0] = bf_lo(a2.x); g2[1] = bf_hi(a2.x); g2[2] = bf_lo(a2.y); g2[3] = bf_hi(a2.y); g2[4] = bf_lo(a2.z); g2[5] = bf_hi(a2.z); g2[6] = bf_lo(a2.w); g2[7] = bf_hi(a2.w);
                    v2[0] = bf_lo(b2.x); v2[1] = bf_hi(b2.x); v2[2] = bf_lo(b2.y); v2[3] = bf_hi(b2.y); v2[4] = bf_lo(b2.z); v2[5] = bf_hi(b2.z); v2[6] = bf_lo(b2.w); v2[7] = bf_hi(b2.w);
                    g1[0] = bf_lo(a1.x); g1[1] = bf_hi(a1.x); g1[2] = bf_lo(a1.y); g1[3] = bf_hi(a1.y); g1[4] = bf_lo(a1.z); g1[5] = bf_hi(a1.z); g1[6] = bf_lo(a1.w); g1[7] = bf_hi(a1.w);
                    v1[0] = bf_lo(b1.x); v1[1] = bf_hi(b1.x); v1[2] = bf_lo(b1.y); v1[3] = bf_hi(b1.y); v1[4] = bf_lo(b1.z); v1[5] = bf_hi(b1.z); v1[6] = bf_lo(b1.w); v1[7] = bf_hi(b1.w);
                }
_Pragma("unroll 8")
                for (int s = 0; s < 32; ++s) {
                    const int tt = ts + s;
                    const u32x4 a0 = *(const u32x4*)(up + (size_t)(tt - rowbase) * NUP + ucol), b0 = *(const u32x4*)(up + (size_t)(tt - rowbase) * NUP + ucol + 128);
                    float gc[8], vc[8];
                    gc[0] = bf_lo(a0.x); gc[1] = bf_hi(a0.x); gc[2] = bf_lo(a0.y); gc[3] = bf_hi(a0.y); gc[4] = bf_lo(a0.z); gc[5] = bf_hi(a0.z); gc[6] = bf_lo(a0.w); gc[7] = bf_hi(a0.w);
                    vc[0] = bf_lo(b0.x); vc[1] = bf_hi(b0.x); vc[2] = bf_lo(b0.y); vc[3] = bf_hi(b0.y); vc[4] = bf_lo(b0.z); vc[5] = bf_hi(b0.z); vc[6] = bf_lo(b0.w); vc[7] = bf_hi(b0.w);
                    float o[8];
#pragma unroll
                    for (int e = 0; e < 8; ++e) { const float gg = bg[e] + wg[0][e] * g2[e] + wg[1][e] * g1[e] + wg[2][e] * gc[e]; const float vv = bv[e] + wv[0][e] * v2[e] + wv[1][e] * v1[e] + wv[2][e] * vc[e];
                        o[e] = gg * sigmoidf_(gg) * vv; g2[e] = g1[e]; g1[e] = gc[e]; v2[e] = v1[e]; v1[e] = vc[e]; }
                    u32x4 w; w.x = cvt_pk_bf16(o[0], o[1]); w.y = cvt_pk_bf16(o[2], o[3]); w.z = cvt_pk_bf16(o[4], o[5]); w.w = cvt_pk_bf16(o[6], o[7]);
                    *(u32x4*)(act + (size_t)tt * DFF + c0) = w;
                }
            }
        }
        GSYNC();
    STAMP(10);
    }

    {
        pg8::Gemm g{DFF, (unsigned)(DFF * 2), 128u, (unsigned)(DFF) * 2u};
        SchedMN S{64, 4, 1, G, bid, 0, (const char*)(ws + WS_ACT), nullptr, (const char*)(ws + WS_WDOWN), nullptr, (size_t)256 * DFF * 2, (size_t)256 * DFF * 2};
        EpiRes E{a.out, a.out, nullptr, (float*)(ws + WS_RSS3)};
        pg8::gemm_phase<EpiRes, SchedMN, true, true>(lds, g, S, E);
    }
    GSYNC();
    STAMP(11);

    {
        const float* gf = a.in[27];
        for (int r = gw; r < SEQ; r += NGW) {
            const float rs = rsqrtf(((const float*)(ws + WS_RSS3))[r] * (1.f / DM) + EPS);
            f32x4* xr = (f32x4*)(a.out + (size_t)r * DM) + lane; const f32x4* gr = (const f32x4*)gf + lane;
#pragma unroll
            for (int j = 0; j < 4; ++j) xr[64 * j] = xr[64 * j] * rs * gr[64 * j];
        }
    }
    if ((TSK) >= 0 && blockIdx.x == 0 && threadIdx.x == 0) {
        const unsigned long long tend = __builtin_amdgcn_s_memrealtime(); const unsigned long long* ts = (const unsigned long long*)(a.ws + 240 * 1024);
        const unsigned long long t1 = ((TSK) + 1 > 11) ? tend : ts[(TSK) + 1 > 11 ? 0 : (TSK) + 1];
        asm volatile("s_waitcnt vmcnt(0)" ::: "memory");
        a.out[0] = ((TSK) >= 20) ? (float)((const unsigned long long*)(a.ws + 244 * 1024))[(TSK) >= 20 ? (TSK) - 20 : 0] * ((TSK) == 25 ? 1.0f : 0.01f) : (float)(t1 - ts[(TSK) > 11 ? 11 : (TSK)]) * 0.01f;
    }
}

extern "C" void kernel_launch(void* const* d_in, const int* in_sizes, int n_in, void* d_out, int out_size, void* d_ws, size_t ws_size, hipStream_t stream) {
    static int grid = 0;
    if (grid == 0) {
        int dev = 0, cus = 0, per_cu = 0;
        (void)hipGetDevice(&dev); (void)hipDeviceGetAttribute(&cus, hipDeviceAttributeMultiprocessorCount, dev);
        (void)hipFuncSetAttribute((const void*)fwd_mega, hipFuncAttributeMaxDynamicSharedMemorySize, LDS_BYTES);
        (void)hipOccupancyMaxActiveBlocksPerMultiprocessor(&per_cu, (const void*)fwd_mega, NT, LDS_BYTES);
        if (per_cu < 1) { fprintf(stderr, "kernel_launch: occupancy query says %d blocks per CU\n", per_cu); per_cu = 1; }
        grid = cus;
        if (n_in != 28 || ws_size < 252 * MiB) fprintf(stderr, "kernel_launch: unexpected n_in %d / ws_size %zu\n", n_in, ws_size);
    }
    Args a{};
    for (int i = 0; i < 28; ++i) a.in[i] = (const float*)d_in[i];
    a.out = (float*)d_out; a.ws = (unsigned char*)d_ws;
    void* kargs[] = {&a};
    hipError_t e = hipLaunchCooperativeKernel((const void*)fwd_mega, dim3(grid), dim3(NT), kargs, LDS_BYTES, stream);
    if (e != hipSuccess) fprintf(stderr, "cooperative launch failed: %s (grid %d)\n", hipGetErrorString(e), grid);
}
```

```cpp
#include <hip/hip_runtime.h>
#include <hip/hip_cooperative_groups.h>
#include <cstdio>
#include <cstdint>
namespace cg = cooperative_groups;
#ifndef PROBE_REP
#define PROBE_REP -1
#endif
#ifndef EXPV
#define EXPV 0
#endif
#ifndef TSK
#define TSK -1
#endif
#define STAMP(i) do { if ((TSK) >= 0 && blockIdx.x == 0 && threadIdx.x == 0) ((unsigned long long*)(a.ws + 240 * 1024))[i] = __builtin_amdgcn_s_memrealtime(); } while (0)
#define ASTAMP(k) do { if ((TSK) >= 20 && blockIdx.x == 0 && threadIdx.x == 0) { const unsigned long long t_ = __builtin_amdgcn_s_memrealtime(); T.tsa[k] += t_ - T.tsa[15]; T.tsa[15] = t_; } } while (0)
#define REPS(k) _Pragma("nounroll") for (int rep_ = 0; rep_ < ((PROBE_REP) == (k) ? 2 : 1); ++rep_)
#define GSYNC() do { xcd_barrier(xbar); if ((PROBE_REP) == 100) xcd_barrier(xbar); } while (0)

#define LAS __attribute__((address_space(3)))
typedef unsigned short bf16_t;
typedef short bf16x8 __attribute__((ext_vector_type(8)));
typedef float f32x4 __attribute__((ext_vector_type(4)));
typedef float f32x2 __attribute__((ext_vector_type(2)));
typedef unsigned u32x4 __attribute__((ext_vector_type(4)));
typedef unsigned u32x2 __attribute__((ext_vector_type(2)));

constexpr int SEQ = 16384, DM = 1024, DIN = 3864, PP = 4096  , DFF = 2816, NUP = 5632;
constexpr int C_Q = 0, C_KC = 512, C_VC = 640, C_KSL = 768, C_VSL = 896, C_KWN = 1024, C_VWN = 1152, C_U = 1280, C_GA = 1792, C_GB = 2816, C_NG = 3840;
constexpr int VTP = SEQ + 64;
constexpr float EPS = 1e-6f;
constexpr float NEGF = -1e30f;

constexpr size_t MiB = 1u << 20;
constexpr size_t WS_RSTD1 = 0, WS_RSS2 = 64 * 1024, WS_RSS3 = 128 * 1024, WS_ROPEC = 256 * 1024, WS_ROPES = 768 * 1024;
constexpr size_t WS_ABAR = 1280 * 1024, WS_A128 = WS_ABAR + 16384, WS_BIASPE = WS_A128 + 16384, WS_BBAR = 1536 * 1024  ;
constexpr size_t WS_SBUF = 2 * MiB  , WS_HID = 4 * MiB  , WS_KCMP = 6 * MiB  , WS_VCMPT = 6 * MiB + 512 * 1024  ;
constexpr size_t WS_WUP = 8 * MiB, WS_WDOWN = 20 * MiB, WS_WIN = 26 * MiB, WS_WGLU = 34 * MiB, WS_WPA = 35 * MiB, WS_WPB = 36 * MiB, WS_WOUT = 37 * MiB, WS_W1K = 39 * MiB, WS_W1V = 40 * MiB;
constexpr size_t WS_XB = 41 * MiB, WS_MERGED = 41 * MiB, WS_PROJ = 73 * MiB, WS_VSLT = 202 * MiB + 512 * 1024, WS_VWNT = 207 * MiB;
constexpr size_t WS_X1B = 220 * MiB, WS_UPRAW = 26 * MiB, WS_ACT = 122 * MiB;
constexpr size_t WS_VMAX = 232 * 1024, WS_BAR = 192 * 1024, WS_KSL = 212 * MiB, WS_KWN = 216 * MiB;
constexpr size_t OUT_YA = 0, OUT_YBP = 16 * MiB, OUT_YB = 32 * MiB;
static_assert(WS_PROJ + (size_t)(SEQ + 32) * PP * 2 <= WS_VSLT, "proj");
static_assert(WS_VSLT + (size_t)128 * VTP * 2 + 4096 <= WS_VWNT && WS_VWNT + (size_t)128 * VTP * 2 + 4096 <= WS_X1B, "vt");
static_assert(WS_UPRAW + (size_t)33 * 256 * NUP * 2 <= WS_ACT && WS_ACT + (size_t)SEQ * DFF * 2 <= WS_X1B, "ffn");

__device__ __forceinline__ unsigned cvt_pk_bf16(float lo, float hi) { unsigned r; asm volatile("v_cvt_pk_bf16_f32 %0, %1, %2" : "=v"(r) : "v"(lo), "v"(hi)); return r; }
__device__ __forceinline__ float bf_lo(unsigned w) { return __uint_as_float(w << 16); }
__device__ __forceinline__ float bf_hi(unsigned w) { return __uint_as_float(w & 0xffff0000u); }
__device__ __forceinline__ float bf2f(bf16_t b) { return __uint_as_float((unsigned)b << 16); }
__device__ __forceinline__ float sigmoidf_(float v) { return 1.f / (1.f + __expf(-v)); }
__device__ __forceinline__ float gelu_tanh(float v) { const float z = 0.7978845608028654f * (v + 0.044715f * v * v * v); const float th = 1.f - 2.f / (__expf(2.f * z) + 1.f); return 0.5f * v * (1.f + th); }
__device__ __forceinline__ u32x4 pack8(f32x4 a, f32x4 b) { u32x4 w; w.x = cvt_pk_bf16(a[0], a[1]); w.y = cvt_pk_bf16(a[2], a[3]); w.z = cvt_pk_bf16(b[0], b[1]); w.w = cvt_pk_bf16(b[2], b[3]); return w; }

namespace pg8 {
#define PG8_LAS __attribute__((address_space(3)))
constexpr int BM = 256, BK = 64, HALF = 128, HTB = HALF * BK * 2, STAGE_BYTES = 8 * HTB, NXCD = 8, WGM = 8;
__host__ __device__ __forceinline__ int lds_byte(int r, int c) { const int st = (r >> 4) * 2 + (c >> 5), rr = r & 15, cc = c & 31, ob = rr * 64 + cc * 2; return st * 1024 + (ob ^ (((ob >> 9) & 1) << 5)); }
__host__ __device__ __forceinline__ void stage_rc(int b, int& R, int& C) { const int st = b / 1024, sb = b % 1024, swz = sb ^ (((sb >> 9) & 1) << 5); R = (st >> 1) * 16 + swz / 64; C = (st & 1) * 32 + (swz % 64) / 2; }
__host__ __device__ __forceinline__ int perm32(int rho) { const int n = rho >> 4, i = rho & 15; return 8 * (i >> 2) + 4 * n + (i & 3); }
struct Unit { int pm, pn, z; const char* A; const char* B; };
struct Gemm { int K; unsigned lda_b; unsigned kstepA; unsigned ldb_b; };
__device__ __forceinline__ bool tile_of(long L, int nM, int nN, int& pm, int& pn) {
    const int nwg = nM * nN; if (L >= nwg) return false;
    int wgid = (int)L; { const int q = nwg / NXCD, r = nwg % NXCD, xcd = wgid % NXCD, off = wgid / NXCD; wgid = (xcd < r ? xcd * (q + 1) : r * (q + 1) + (xcd - r) * q) + off; }
    const int nig = WGM * nN, gid = wgid / nig, fm = gid * WGM, gsz = (nM - fm) < WGM ? (nM - fm) : WGM;
    pm = fm + ((wgid % nig) % gsz); pn = (wgid % nig) / gsz; return true;
}
template <class Epi, class Sched, bool ALIGN_EPI = false, bool SP2 = false>
__device__ __forceinline__ void gemm_phase(PG8_LAS unsigned char* lds, const Gemm g, const Sched& S, const Epi& E) {
    int tid_ = threadIdx.x; asm volatile("" : "+v"(tid_));
    const int tid = tid_, wid = __builtin_amdgcn_readfirstlane(tid >> 6), lane = tid & 63, wr = wid >> 2, wc = wid & 3, fr = lane & 15, fq = lane >> 4;
    const int K = g.K, nt = K / BK;
    unsigned voffA[2], voffB[2];
#pragma unroll
    for (int i = 0; i < 2; ++i) { int R, C; stage_rc(tid * 16 + i * 8192, R, C); const int Rb = Epi::PERM ? ((R & ~31) + perm32(R & 31)) : R;
        voffA[i] = (unsigned)R * g.lda_b + (unsigned)C * 2u; voffB[i] = (unsigned)Rb * g.ldb_b + (unsigned)C * 2u; }
    const size_t kstepA = (size_t)g.kstepA, kstepB = (size_t)(BK * 2);
    const size_t hstepA = (size_t)HALF * g.lda_b, hstepB = (size_t)HALF * g.ldb_b;
    const unsigned ldsw = (unsigned)wid * 1024u;
    const int aoff = lds_byte(wr * 64 + fr, fq * 8), boff = lds_byte(wc * 32 + fr, fq * 8);
#define PG8_SA(b, h) (((b) * 2 + (h)) * HTB)
#define PG8_SB(b, h) ((4 + (b) * 2 + (h)) * HTB)
#define PG8_STAGE(bufoff, gbase, voff) do { _Pragma("unroll") for (int _i = 0; _i < 2; ++_i) \
        __builtin_amdgcn_global_load_lds((const unsigned*)((const char*)(gbase) + (voff)[_i]), (PG8_LAS unsigned*)(lds + (bufoff) + ldsw + _i * 8192), 16, 0, 0); } while (0)
#define PG8_LDA(dst, b, h) do { _Pragma("unroll") for (int m = 0; m < 4; ++m) _Pragma("unroll") for (int k = 0; k < 2; ++k) dst[m][k] = *(const PG8_LAS bf16x8*)(lds + PG8_SA(b, h) + aoff + m * 2048 + k * 1024); } while (0)
#define PG8_LDB(dst, b, h) do { _Pragma("unroll") for (int n = 0; n < 2; ++n) _Pragma("unroll") for (int k = 0; k < 2; ++k) dst[n][k] = *(const PG8_LAS bf16x8*)(lds + PG8_SB(b, h) + boff + n * 2048 + k * 1024); } while (0)
#define PG8_MMA(ai, bj, At, Bt) do { __builtin_amdgcn_s_setprio(1); _Pragma("unroll") for (int m = 0; m < 4; ++m) _Pragma("unroll") for (int n = 0; n < 2; ++n) _Pragma("unroll") for (int k = 0; k < 2; ++k) \
        acc[ai][bj][m][n] = __builtin_amdgcn_mfma_f32_16x16x32_bf16(Bt[n][k], At[m][k], acc[ai][bj][m][n], 0, 0, 0); __builtin_amdgcn_s_setprio(0); } while (0)
#define PG8_WAIT_V(n) asm volatile("s_waitcnt vmcnt(" #n ")" ::: "memory")
#define PG8_WAIT_L(n) asm volatile("s_waitcnt lgkmcnt(" #n ")" ::: "memory")
#define PG8_BAR __builtin_amdgcn_s_barrier()
#define PG8_SCHED __builtin_amdgcn_sched_barrier(0)
    Unit cur, nxt; int ui = 0;
    if (!S.next(0, cur)) return;
    f32x4 acc[2][2][4][2];
#pragma unroll
    for (int a = 0; a < 2; ++a)
#pragma unroll
        for (int b = 0; b < 2; ++b)
#pragma unroll
            for (int m = 0; m < 4; ++m)
#pragma unroll
                for (int n = 0; n < 2; ++n) acc[a][b][m][n] = (f32x4){0.f, 0.f, 0.f, 0.f};
    bf16x8 At[4][2], B0[2][2], B1[2][2];
    const char* cA = cur.A; const char* cB = cur.B;
    if constexpr (SP2) {
        PG8_STAGE(PG8_SB(0, 0), cB, voffB); PG8_STAGE(PG8_SB(0, 1), cB + hstepB, voffB); PG8_STAGE(PG8_SA(0, 0), cA, voffA); PG8_STAGE(PG8_SA(0, 1), cA + hstepA, voffA);
        if (wr == 1) PG8_BAR;
        PG8_WAIT_V(2); PG8_BAR;
        PG8_STAGE(PG8_SB(1, 0), cB + kstepB, voffB); PG8_STAGE(PG8_SA(1, 0), cA + kstepA, voffA); PG8_STAGE(PG8_SB(1, 1), cB + hstepB + kstepB, voffB);
        PG8_WAIT_V(6); PG8_BAR;
    } else {
        PG8_STAGE(PG8_SB(0, 0), cB, voffB); PG8_STAGE(PG8_SA(0, 0), cA, voffA); PG8_STAGE(PG8_SB(0, 1), cB + hstepB, voffB); PG8_STAGE(PG8_SA(0, 1), cA + hstepA, voffA);
        if (wr == 1) PG8_BAR;
        PG8_WAIT_V(4); PG8_BAR;
        PG8_STAGE(PG8_SB(1, 0), cB + kstepB, voffB); PG8_STAGE(PG8_SA(1, 0), cA + kstepA, voffA); PG8_STAGE(PG8_SB(1, 1), cB + hstepB + kstepB, voffB);
        PG8_WAIT_V(6); PG8_BAR;
    }
    for (;;) {
        const bool has_next = S.next(ui + 1, nxt);
        const char* nA = has_next ? nxt.A : cA; const char* nB = has_next ? nxt.B : cB;
        for (int t = 0; t < nt; t += 2) {
            const bool last = (t == nt - 2);
            const char* a1 = cA + (size_t)(t + 1) * kstepA;
            const char* a2 = last ? nA : cA + (size_t)(t + 2) * kstepA; const char* b2 = last ? nB : cB + (size_t)(t + 2) * kstepB;
            const char* a3 = a2 + kstepA; const char* b3 = b2 + kstepB;
            if constexpr (SP2) {
            PG8_LDB(B0, 0, 0); PG8_LDB(B1, 0, 1); PG8_SCHED; PG8_LDA(At, 0, 0); PG8_STAGE(PG8_SA(1, 1), a1 + hstepA, voffA);
            PG8_WAIT_V(8); PG8_WAIT_L(0); PG8_BAR; PG8_MMA(0, 0, At, B0); PG8_MMA(0, 1, At, B1); PG8_BAR; PG8_SCHED;
            PG8_LDA(At, 0, 1); PG8_STAGE(PG8_SB(0, 0), b2, voffB); PG8_STAGE(PG8_SB(0, 1), b2 + hstepB, voffB); PG8_STAGE(PG8_SA(0, 0), a2, voffA);
            PG8_WAIT_V(8); PG8_WAIT_L(0); PG8_BAR; PG8_MMA(1, 0, At, B0); PG8_MMA(1, 1, At, B1); PG8_BAR; PG8_SCHED;
            PG8_LDB(B0, 1, 0); PG8_LDB(B1, 1, 1); PG8_SCHED; PG8_LDA(At, 1, 0); PG8_STAGE(PG8_SA(0, 1), a2 + hstepA, voffA);
            PG8_WAIT_V(8); PG8_WAIT_L(0); PG8_BAR; PG8_MMA(0, 0, At, B0); PG8_MMA(0, 1, At, B1); PG8_BAR; PG8_SCHED;
            PG8_LDA(At, 1, 1); PG8_STAGE(PG8_SB(1, 0), b3, voffB); PG8_STAGE(PG8_SB(1, 1), b3 + hstepB, voffB); PG8_STAGE(PG8_SA(1, 0), a3, voffA);
            PG8_WAIT_V(8); PG8_WAIT_L(0); PG8_BAR; PG8_MMA(1, 0, At, B0); PG8_MMA(1, 1, At, B1); PG8_BAR; PG8_SCHED;
            } else {
            PG8_LDB(B0, 0, 0); PG8_SCHED; PG8_LDA(At, 0, 0); PG8_STAGE(PG8_SA(1, 1), a1 + hstepA, voffA);
            PG8_WAIT_L(8); PG8_BAR; PG8_WAIT_L(0); PG8_MMA(0, 0, At, B0); PG8_BAR; PG8_SCHED;
            PG8_LDB(B1, 0, 1); PG8_STAGE(PG8_SB(0, 0), b2, voffB);
            PG8_BAR; PG8_WAIT_L(0); PG8_MMA(0, 1, At, B1); PG8_BAR;
            PG8_LDA(At, 0, 1); PG8_STAGE(PG8_SA(0, 0), a2, voffA);
            PG8_BAR; PG8_WAIT_L(0); PG8_MMA(1, 0, At, B0); PG8_BAR; PG8_SCHED;
            PG8_STAGE(PG8_SB(0, 1), b2 + hstepB, voffB);
            PG8_WAIT_V(6); PG8_BAR; PG8_MMA(1, 1, At, B1); PG8_BAR;
            PG8_LDB(B0, 1, 0); PG8_SCHED; PG8_LDA(At, 1, 0); PG8_STAGE(PG8_SA(0, 1), a2 + hstepA, voffA);
            PG8_WAIT_L(8); PG8_BAR; PG8_WAIT_L(0); PG8_MMA(0, 0, At, B0); PG8_BAR; PG8_SCHED;
            PG8_LDB(B1, 1, 1); PG8_STAGE(PG8_SB(1, 0), b3, voffB);
            PG8_BAR; PG8_WAIT_L(0); PG8_MMA(0, 1, At, B1); PG8_BAR;
            PG8_LDA(At, 1, 1); PG8_STAGE(PG8_SA(1, 0), a3, voffA);
            PG8_BAR; PG8_WAIT_L(0); PG8_MMA(1, 0, At, B0); PG8_BAR; PG8_SCHED;
            PG8_STAGE(PG8_SB(1, 1), b3 + hstepB, voffB);
            PG8_WAIT_V(6); PG8_BAR; PG8_MMA(1, 1, At, B1); PG8_BAR;
            }
        }
        if constexpr (ALIGN_EPI) { if (wr == 0) PG8_BAR; }
        E(acc, cur, wr, wc, fr, fq);
        if (!has_next) break;
#pragma unroll
        for (int a = 0; a < 2; ++a)
#pragma unroll
            for (int b = 0; b < 2; ++b)
#pragma unroll
                for (int m = 0; m < 4; ++m)
#pragma unroll
                    for (int n = 0; n < 2; ++n) acc[a][b][m][n] = (f32x4){0.f, 0.f, 0.f, 0.f};
        cur = nxt; cA = nA; cB = nB; ++ui;
        if constexpr (ALIGN_EPI) { if (wr == 1) PG8_BAR; }
    }
    PG8_WAIT_V(0);
    if constexpr (!ALIGN_EPI) { if (wr == 0) PG8_BAR; }
    PG8_BAR;
#undef PG8_SA
#undef PG8_SB
#undef PG8_STAGE
#undef PG8_LDA
#undef PG8_LDB
#undef PG8_MMA
#undef PG8_WAIT_V
#undef PG8_WAIT_L
#undef PG8_BAR
#undef PG8_SCHED
}
}


struct SchedMN {
    int nM, nN, nz, G, c, pm_off; const char* A0; const char* A1; const char* B0; const char* B1; size_t a_tile, b_tile;
    __device__ __forceinline__ bool next(int i, pg8::Unit& u) const {
        int pm, pn; if (!pg8::tile_of((long)(i / nz) * G + c, nM, nN, pm, pn)) return false;
        u.z = i % nz; u.pm = pm + pm_off; u.pn = pn; u.A = (u.z ? A1 : A0) + (size_t)u.pm * a_tile; u.B = (u.z ? B1 : B0) + (size_t)pn * b_tile; return true;
    }
};
struct SchedCmp {
    int c; const char* proj; const char* w1k; const char* w1v;
    __device__ __forceinline__ bool next(int i, pg8::Unit& u) const {
        if (i > 0 || c >= 64) return false;
        const int ks = c & 3; u.pm = (c >> 2) & 3; u.z = c >> 4; u.pn = ks; const int which = u.z >> 1, kh = u.z & 1;
        u.A = proj + ((size_t)(16 * 256 * u.pm + 8 * ks) * PP + (which ? C_VC : C_KC) + kh * 64) * 2; u.B = (which ? w1v : w1k) + (size_t)ks * 512 * 2; return true;
    }
};

#define EPI_LOOP_ROWS for (int ai = 0; ai < 2; ++ai) _Pragma("unroll") for (int m = 0; m < 4; ++m)

struct EpiProj {
    static constexpr bool PERM = true;
    bf16_t* proj; bf16_t* vslt; bf16_t* vwnt; bf16_t* kslc; bf16_t* kwnc; const float* rstd; const float* ropec; const float* ropes;
    __device__ __forceinline__ void operator()(const f32x4 (&acc)[2][2][4][2], const pg8::Unit& u, int wr, int wc, int fr, int fq) const {
        const int pn = u.pn; const int row0 = u.pm * 256 + wr * 64 + fr;
        const bool sig = pn >= 7;
#pragma unroll
        EPI_LOOP_ROWS {
            const int row = row0 + ai * 128 + m * 16; const float rs = rstd[row];
            f32x4 c0 = {1.f, 1.f, 1.f, 1.f}, c1 = c0, s0 = {0.f, 0.f, 0.f, 0.f}, s1 = s0;
            if ((pn <= 1 || pn == 3 || pn == 4) && (wc & 1) == 0) { c0 = *(const f32x4*)(ropec + row * 8); c1 = *(const f32x4*)(ropec + row * 8 + 4); s0 = *(const f32x4*)(ropes + row * 8); s1 = *(const f32x4*)(ropes + row * 8 + 4); }
#pragma unroll
            for (int bj = 0; bj < 2; ++bj) {
                f32x4 v0 = acc[ai][bj][m][0] * rs, v1 = acc[ai][bj][m][1] * rs;
                const int colt = bj * 128 + wc * 32 + 8 * fq;
                const bool ropet = (pn <= 1) || ((pn == 3 || pn == 4) && bj == 0);
                if (ropet && (wc & 1) == 0) {
                    f32x4 p0, p1;
#pragma unroll
                    for (int e = 0; e < 4; ++e) { p0[e] = __shfl_xor(v0[e], 16); p1[e] = __shfl_xor(v1[e], 16); }
                    if (fq == 0) { v0 = v0 * c0 - p0 * s0; v1 = v1 * c1 - p1 * s1; }
                    else if (fq == 1) { v0 = v0 * c0 + p0 * s0; v1 = v1 * c1 + p1 * s1; }
                }
                if (pn <= 1) { v0 = v0 * (0.125f * 1.4426950408889634f); v1 = v1 * (0.125f * 1.4426950408889634f); }
                if (sig) {
#pragma unroll
                    for (int e = 0; e < 4; ++e) { v0[e] = sigmoidf_(v0[e]); v1[e] = sigmoidf_(v1[e]); }
                }
                const u32x4 w = pack8(v0, v1);
                if (!((pn == 3 || pn == 4))) *(u32x4*)(proj + (size_t)row * PP + pn * 256 + colt) = w;
                if ((pn == 3 || pn == 4) && bj == 0) { bf16_t* kc = (pn == 3) ? kslc : kwnc; *(u32x4*)(kc + ((size_t)(colt >> 6) * SEQ + row) * 64 + (colt & 63)) = w; }
                if ((pn == 3 || pn == 4) && bj == 1) {
                    bf16_t* vt = ((pn == 3) ? vslt : vwnt) + ((size_t)((colt - 128) >> 6) * 256 + (row >> 6)) * 4096 + (size_t)((colt - 128) & 63) * 64 + (row & 63);
                    vt[0 * 64] = (bf16_t)(w.x & 0xffff); vt[1 * 64] = (bf16_t)(w.x >> 16); vt[2 * 64] = (bf16_t)(w.y & 0xffff); vt[3 * 64] = (bf16_t)(w.y >> 16);
                    vt[4 * 64] = (bf16_t)(w.z & 0xffff); vt[5 * 64] = (bf16_t)(w.z >> 16); vt[6 * 64] = (bf16_t)(w.w & 0xffff); vt[7 * 64] = (bf16_t)(w.w >> 16);
                }
            }
        }
    }
};

struct EpiCmp {
    static constexpr bool PERM = true;
    float* hidp;
    __device__ __forceinline__ void operator()(const f32x4 (&acc)[2][2][4][2], const pg8::Unit& u, int wr, int wc, int fr, int fq) const {
        const int row0 = u.pm * 256 + wr * 64 + fr;
#pragma unroll
        for (int bj = 0; bj < 2; ++bj) {
            const int col = bj * 128 + wc * 32 + 8 * fq;
#pragma unroll
            EPI_LOOP_ROWS {
                const int row = row0 + ai * 128 + m * 16; float* d = hidp + (((size_t)u.pn * 4 + u.z) * 1024 + row) * 256 + col;
                *(f32x4*)d = acc[ai][bj][m][0]; *(f32x4*)(d + 4) = acc[ai][bj][m][1];
            }
        }
    }
};

struct EpiGlu {
    static constexpr bool PERM = true;
    const bf16_t* ybp; bf16_t* yb;
    __device__ __forceinline__ void operator()(const f32x4 (&acc)[2][2][4][2], const pg8::Unit& u, int wr, int wc, int fr, int fq) const {
        const int row0 = u.pm * 256 + wr * 64 + fr;
#pragma unroll
        EPI_LOOP_ROWS {
            const int row = row0 + ai * 128 + m * 16;
#pragma unroll
            for (int bj = 0; bj < 2; ++bj) {
                const size_t off = (size_t)row * 512 + u.pn * 256 + bj * 128 + wc * 32 + 8 * fq;
                const u32x4 y = *(const u32x4*)(ybp + off);
                f32x4 v0 = acc[ai][bj][m][0], v1 = acc[ai][bj][m][1];
                v0[0] = bf_lo(y.x) * sigmoidf_(v0[0]); v0[1] = bf_hi(y.x) * sigmoidf_(v0[1]); v0[2] = bf_lo(y.y) * sigmoidf_(v0[2]); v0[3] = bf_hi(y.y) * sigmoidf_(v0[3]);
                v1[0] = bf_lo(y.z) * sigmoidf_(v1[0]); v1[1] = bf_hi(y.z) * sigmoidf_(v1[1]); v1[2] = bf_lo(y.w) * sigmoidf_(v1[2]); v1[3] = bf_hi(y.w) * sigmoidf_(v1[3]);
                *(u32x4*)(yb + off) = pack8(v0, v1);
            }
        }
    }
};

struct EpiMerge {
    static constexpr bool PERM = true;
    const bf16_t* proj; bf16_t* merged;
    __device__ __forceinline__ void operator()(const f32x4 (&acc)[2][2][4][2], const pg8::Unit& u, int wr, int wc, int fr, int fq) const {
        const int row0 = u.pm * 256 + wr * 64 + fr; const int gcol = u.z ? C_GB : C_GA;
#pragma unroll
        EPI_LOOP_ROWS {
            const int row = row0 + ai * 128 + m * 16;
#pragma unroll
            for (int bj = 0; bj < 2; ++bj) {
                const int col = u.pn * 256 + bj * 128 + wc * 32 + 8 * fq;
                const u32x4 gt = *(const u32x4*)(proj + (size_t)row * PP + gcol + col);
                f32x4 v0 = acc[ai][bj][m][0], v1 = acc[ai][bj][m][1];
                v0[0] *= bf_lo(gt.x); v0[1] *= bf_hi(gt.x); v0[2] *= bf_lo(gt.y); v0[3] *= bf_hi(gt.y);
                v1[0] *= bf_lo(gt.z); v1[1] *= bf_hi(gt.z); v1[2] *= bf_lo(gt.w); v1[3] *= bf_hi(gt.w);
                bf16_t* dst = merged + (size_t)row * DM + col;
                if (u.z) { const u32x4 o = *(const u32x4*)dst;
                    v0[0] += bf_lo(o.x); v0[1] += bf_hi(o.x); v0[2] += bf_lo(o.y); v0[3] += bf_hi(o.y); v1[0] += bf_lo(o.z); v1[1] += bf_hi(o.z); v1[2] += bf_lo(o.w); v1[3] += bf_hi(o.w); }
                *(u32x4*)dst = pack8(v0, v1);
            }
        }
    }
};

struct EpiRes {
    static constexpr bool PERM = true;
    const float* xin; float* xo; bf16_t* xb; float* rss;
    __device__ __forceinline__ void operator()(const f32x4 (&acc)[2][2][4][2], const pg8::Unit& u, int wr, int wc, int fr, int fq) const {
        const int row0 = u.pm * 256 + wr * 64 + fr;
#pragma unroll
        EPI_LOOP_ROWS {
            const int row = row0 + ai * 128 + m * 16; float ss = 0.f;
#pragma unroll
            for (int bj = 0; bj < 2; ++bj) {
                const size_t off = (size_t)row * DM + u.pn * 256 + bj * 128 + wc * 32 + 8 * fq;
                const f32x4 v0 = *(const f32x4*)(xin + off) + acc[ai][bj][m][0], v1 = *(const f32x4*)(xin + off + 4) + acc[ai][bj][m][1];
                *(f32x4*)(xo + off) = v0; *(f32x4*)(xo + off + 4) = v1;
                if (xb) *(u32x4*)(xb + off) = pack8(v0, v1);
                ss += (v0[0] * v0[0] + v0[1] * v0[1]) + (v0[2] * v0[2] + v0[3] * v0[3]) + (v1[0] * v1[0] + v1[1] * v1[1]) + (v1[2] * v1[2] + v1[3] * v1[3]);
            }
            ss += __shfl_xor(ss, 16); ss += __shfl_xor(ss, 32);
            if (fq == 0) atomicAdd(rss + row, ss);
        }
    }
};

struct EpiUp {
    static constexpr bool PERM = true;
    bf16_t* up; const float* rss; int rowbase;
    __device__ __forceinline__ void operator()(const f32x4 (&acc)[2][2][4][2], const pg8::Unit& u, int wr, int wc, int fr, int fq) const {
        const int row0 = u.pm * 256 + wr * 64 + fr;
#pragma unroll
        EPI_LOOP_ROWS {
            const int row = row0 + ai * 128 + m * 16; const float rs = rsqrtf(rss[row] * (1.f / DM) + EPS);
#pragma unroll
            for (int bj = 0; bj < 2; ++bj) {
                const size_t off = (size_t)(row - rowbase) * NUP + u.pn * 256 + bj * 128 + wc * 32 + 8 * fq;
                *(u32x4*)(up + off) = pack8(acc[ai][bj][m][0] * rs, acc[ai][bj][m][1] * rs);
            }
        }
    }
};

struct Args { const float* in[28]; float* out; unsigned char* ws; };
constexpr int NT = 512, NWV = 8;
constexpr int LDS_BYTES = 147456;

__device__ __forceinline__ float wave_sum(float v) {
#pragma unroll
    for (int o = 1; o < 64; o <<= 1) v += __shfl_xor(v, o);
    return v;
}

#define XB_TMO      128
#define XB_XCNT(j)  (256  + 64 * (j))
#define XB_XSUB(j)  (1280 + 64 * (j))
#define XB_XGEN(j)  (2304 + 64 * (j))
#define XB_TOP      3328
#define XB_TOPGEN   3392
#define XCD_BAR_WORDS 3456
#define XB_SPIN_CAP (1u << 18)

__device__ __forceinline__ unsigned xb_ld(unsigned* p)              { return __hip_atomic_load(p, __ATOMIC_RELAXED, __HIP_MEMORY_SCOPE_AGENT); }
__device__ __forceinline__ unsigned xb_add(unsigned* p, unsigned v) { return __hip_atomic_fetch_add(p, v, __ATOMIC_RELAXED, __HIP_MEMORY_SCOPE_AGENT); }
__device__ __forceinline__ unsigned xb_xcc_id() { return (unsigned)__builtin_amdgcn_s_getreg((3 << 11) | 20) & 0xFu; }
#define XB_SPIN(cond, bar) do { unsigned _sp = 0; while (cond) { __builtin_amdgcn_s_sleep(1); \
    if ((++_sp & 255u) == 0u) { if (xb_ld(&(bar)[XB_TMO])) break; if (_sp > XB_SPIN_CAP) { atomicAdd(&(bar)[XB_TMO], 1u); break; } } } } while (0)

struct XcdBarrier {
    unsigned* bar; unsigned x;
    volatile LAS unsigned* st;
};

__device__ __forceinline__ XcdBarrier xcd_barrier_post(unsigned* bar, volatile LAS unsigned* st) {
    XcdBarrier b; b.bar = bar; b.x = xb_xcc_id(); b.st = st;
    if (threadIdx.x == 0) (void)xb_add(&bar[XB_XCNT(b.x)], 1u);
    return b;
}
__device__ __forceinline__ void xcd_barrier_complete(unsigned* bar, unsigned x, unsigned& nloc, unsigned& nx) {
    const unsigned G = gridDim.x * gridDim.y * gridDim.z;
    unsigned sum, cnt, mine, sp = 0u;
    for (;;) {
        sum = 0u; cnt = 0u; mine = 0u;
#pragma unroll
        for (unsigned j = 0; j < 16; ++j) { const unsigned c = xb_ld(&bar[XB_XCNT(j)]); sum += c; cnt += (c > 0u) ? 1u : 0u; mine = (j == x) ? c : mine; }
        if (sum == G) break;
        __builtin_amdgcn_s_sleep(1);
        if ((++sp & 255u) == 0u) { if (xb_ld(&bar[XB_TMO])) break; if (sp > XB_SPIN_CAP) { atomicAdd(&bar[XB_TMO], 1u); break; } }
    }
    nloc = mine > 0u ? mine : 1u; nx = cnt > 0u ? cnt : 1u;
}

__device__ __forceinline__ void xcd_barrier(const XcdBarrier& b) {
    asm volatile("s_waitcnt vmcnt(0)" ::: "memory");
    __syncthreads();
    if (threadIdx.x == 0) {
        unsigned* bar = b.bar;
        __builtin_amdgcn_s_waitcnt(0);
        unsigned nloc = b.st[0], nx = b.st[1];
        if (nloc == 0u) { xcd_barrier_complete(bar, b.x, nloc, nx); b.st[0] = nloc; b.st[1] = nx; }
        const unsigned old = xb_add(&bar[XB_XSUB(b.x)], 1u);
        const unsigned gen = old / nloc;
        if (old + 1u == (gen + 1u) * nloc) {
            __builtin_amdgcn_fence(__ATOMIC_RELEASE, "agent");
            asm volatile("s_waitcnt vmcnt(0)" ::: "memory");
            const unsigned og = xb_add(&bar[XB_TOP], 1u);
            const unsigned tg = og / nx;
            if (og + 1u == (tg + 1u) * nx) xb_add(&bar[XB_TOPGEN], 1u);
            else XB_SPIN(xb_ld(&bar[XB_TOPGEN]) == tg, bar);
            __builtin_amdgcn_fence(__ATOMIC_ACQUIRE, "agent");
            xb_add(&bar[XB_XGEN(b.x)], 1u);
            asm volatile("s_waitcnt vmcnt(0)" ::: "memory");
        } else {
            XB_SPIN(xb_ld(&bar[XB_XGEN(b.x)]) == gen, bar);
            __builtin_amdgcn_fence(__ATOMIC_ACQUIRE, "agent");
            asm volatile("s_waitcnt vmcnt(0)" ::: "memory");
        }
    }
    __syncthreads();
}

__device__ __forceinline__ int colmap(int kind, int c) {
    if (kind == 1) return c < 1280 ? c : (c < 1304 ? C_NG + (c - 1280) : c - 24);
    if (kind == 2) { return c < DFF ? (c >> 7) * 256 + (c & 127) : ((c - DFF) >> 7) * 256 + 128 + ((c - DFF) & 127); }
    return c;
}
__device__ __forceinline__ void transpose_item(const float* W, int K, int N, bf16_t* WT, LAS float* scr, int kb, int nb, int lane, const float* kscale, int kind) {
    const int k0 = 64 * kb, n0 = 32 * nb;
#pragma unroll
    for (int i = 0; i < 8; ++i) { const int kk = 8 * i + (lane >> 3), nq = (lane & 7) * 4, n = n0 + nq;
        f32x4 v = (n < N) ? *(const f32x4*)(W + (size_t)(k0 + kk) * N + n) : (f32x4){0.f, 0.f, 0.f, 0.f}; if (kscale) v = v * kscale[k0 + kk];
        LAS float* d = scr + kk * 33 + nq; d[0] = v[0]; d[1] = v[1]; d[2] = v[2]; d[3] = v[3]; }
    asm volatile("s_waitcnt lgkmcnt(0)" ::: "memory");
    const int c = lane & 7;
#pragma unroll
    for (int j = 0; j < 4; ++j) { const int n = (lane >> 3) + 8 * j; const LAS float* s = scr + (8 * c) * 33 + n;
        if (n0 + n < N) { u32x4 o; o.x = cvt_pk_bf16(s[0 * 33], s[1 * 33]); o.y = cvt_pk_bf16(s[2 * 33], s[3 * 33]); o.z = cvt_pk_bf16(s[4 * 33], s[5 * 33]); o.w = cvt_pk_bf16(s[6 * 33], s[7 * 33]);
            *(u32x4*)(WT + (size_t)colmap(kind, n0 + n) * K + k0 + 8 * c) = o; } }
    asm volatile("s_waitcnt lgkmcnt(0)" ::: "memory");
}

#define EXP2(x) __builtin_amdgcn_exp2f(x)
#define MFMA16(a, b, c) __builtin_amdgcn_mfma_f32_16x16x32_bf16((a), (b), (c), 0, 0, 0)
__device__ __forceinline__ float dpp_x1(float v) { return __int_as_float(__builtin_amdgcn_update_dpp(0, __float_as_int(v), 0xB1, 0xF, 0xF, true)); }
__device__ __forceinline__ float dpp_x2(float v) { return __int_as_float(__builtin_amdgcn_update_dpp(0, __float_as_int(v), 0x4E, 0xF, 0xF, true)); }
struct KOp { bf16x8 a00, a01, a10, a11; };
struct VOp { bf16x8 v0, v1, v2, v3; };
__device__ __forceinline__ KOp ldk(const bf16_t* Kb, size_t pitch, int kb, int lane) {
    const int i = lane & 15, q = lane >> 4;
    const bf16_t* r0 = Kb + (size_t)(kb + 8 * (i >> 2) + (i & 3)) * pitch + 8 * q; const bf16_t* r1 = r0 + 4 * pitch;
    KOp k; k.a00 = *(const bf16x8*)r0; k.a01 = *(const bf16x8*)(r0 + 32); k.a10 = *(const bf16x8*)r1; k.a11 = *(const bf16x8*)(r1 + 32); return k;
}
__device__ __forceinline__ VOp ldv(const bf16_t* Vt, size_t vpitch, int kb, int lane) {
    const int i = lane & 15, q = lane >> 4; const size_t base = (vpitch == 64) ? (size_t)(kb >> 6) * 4096 + (kb & 63) : (size_t)kb;
    const bf16_t* r = Vt + base + (size_t)i * vpitch + 8 * q;
    VOp v; v.v0 = *(const bf16x8*)r; v.v1 = *(const bf16x8*)(r + 16 * vpitch); v.v2 = *(const bf16x8*)(r + 32 * vpitch); v.v3 = *(const bf16x8*)(r + 48 * vpitch); return v;
}
__device__ __forceinline__ void qk32(const KOp& k, const bf16x8& Bq0, const bf16x8& Bq1, f32x4& S0, f32x4& S1) {
    const f32x4 z = {0.f, 0.f, 0.f, 0.f};
    S0 = MFMA16(k.a00, Bq0, z); S0 = MFMA16(k.a01, Bq1, S0); S1 = MFMA16(k.a10, Bq0, z); S1 = MFMA16(k.a11, Bq1, S1);
}
__device__ __forceinline__ void pv32(const VOp& v, const bf16x8& P, f32x4 (&O)[4]) {
    O[0] = MFMA16(v.v0, P, O[0]); O[1] = MFMA16(v.v1, P, O[1]); O[2] = MFMA16(v.v2, P, O[2]); O[3] = MFMA16(v.v3, P, O[3]);
}
__device__ __forceinline__ bf16x8 packP(const f32x4& p0, const f32x4& p1) { u32x4 w = pack8(p0, p1); return __builtin_bit_cast(bf16x8, w); }

struct KbLin { int base; __device__ __forceinline__ int operator()(int i) const { return base + 32 * i; } };
struct KbLds { const LAS int* l; __device__ __forceinline__ int operator()(int i) const { return l[i]; } };

template <bool NEEDV, class KB, class Body>
__device__ __forceinline__ void pipe3(int n, const KB kbf, Body& body, const bf16_t* Kb, size_t kp, const bf16_t* Vt, size_t vp, int lane) {
    if (n <= 0) return;
    KOp k0, k1; VOp v;
    k0 = ldk(Kb, kp, kbf(0), lane);
    for (int i = 0; i < n; i += 2) {
        { const int kb = kbf(i); if (NEEDV) v = ldv(Vt, vp, kb, lane); k1 = ldk(Kb, kp, kbf(i + 1 < n ? i + 1 : n - 1), lane); body.run(kb, k0, v); }
        if (i + 1 >= n) break;
        { const int kb = kbf(i + 1); if (NEEDV) v = ldv(Vt, vp, kb, lane); k0 = ldk(Kb, kp, kbf(i + 2 < n ? i + 2 : n - 1), lane); body.run(kb, k1, v); }
    }
}

constexpr int AL_CKV = 81920  , CKV_HALF = 9216, CKV_BUF = 18432;
template <bool NEEDV, class Body>
__device__ __forceinline__ void cmp_shared(int nsteps, Body& body, const bf16_t* Kc, const bf16_t* Vc, LAS unsigned char* buf, int tid, int lane, int kb0 = 0, int vrp = 1024, int vcs = 64, int vch0 = 0) {
    const int nch = (nsteps + 1) >> 1; if (nch <= 0) return;
    const int srow = tid >> 3, spc = tid & 7, i = lane & 15, q = lane >> 4;
    u32x4 rk = *(const u32x4*)(Kc + (size_t)(kb0 + srow) * 64 + spc * 8), rv = rk;
    if (NEEDV) rv = *(const u32x4*)(Vc + (size_t)srow * vrp + (size_t)vch0 * vcs + spc * 8);
    *(LAS u32x4*)(buf + srow * 144 + spc * 16) = rk; if (NEEDV) *(LAS u32x4*)(buf + CKV_HALF + srow * 144 + spc * 16) = rv;
    __syncthreads();
    for (int ch = 0; ch < nch; ++ch) {
        const LAS unsigned char* cur = buf + (ch & 1) * CKV_BUF; LAS unsigned char* nxt = buf + ((ch + 1) & 1) * CKV_BUF;
        const bool more = ch + 1 < nch;
        if (more) { rk = *(const u32x4*)(Kc + (size_t)(kb0 + 64 * (ch + 1) + srow) * 64 + spc * 8); if (NEEDV) rv = *(const u32x4*)(Vc + (size_t)srow * vrp + (size_t)(vch0 + ch + 1) * vcs + spc * 8); }
#pragma unroll
        for (int h = 0; h < 2; ++h) {
            const int st = 2 * ch + h;
            if (st < nsteps) {
                const LAS unsigned char* kr = cur + (32 * h + 8 * (i >> 2) + (i & 3)) * 144 + 16 * q;
                KOp k; k.a00 = *(const LAS bf16x8*)kr; k.a01 = *(const LAS bf16x8*)(kr + 64); k.a10 = *(const LAS bf16x8*)(kr + 4 * 144); k.a11 = *(const LAS bf16x8*)(kr + 4 * 144 + 64);
                VOp v; if (NEEDV) { const LAS unsigned char* vr = cur + CKV_HALF + i * 144 + (32 * h + 8 * q) * 2;
                    v.v0 = *(const LAS bf16x8*)vr; v.v1 = *(const LAS bf16x8*)(vr + 16 * 144); v.v2 = *(const LAS bf16x8*)(vr + 32 * 144); v.v3 = *(const LAS bf16x8*)(vr + 48 * 144); }
                else { v.v0 = k.a00; v.v1 = k.a00; v.v2 = k.a00; v.v3 = k.a00; }
                body.run(kb0 + 32 * st, k, v);
            }
        }
        if (more) { *(LAS u32x4*)(nxt + srow * 144 + spc * 16) = rk; if (NEEDV) *(LAS u32x4*)(nxt + CKV_HALF + srow * 144 + spc * 16) = rv; }
        __syncthreads();
    }
}

struct BodyCmp1 {
    bf16x8 Bq[2][2]; int nv[2], q; float ml[2], ll[2];
    __device__ __forceinline__ void run(int kb, const KOp& k, const VOp&) {
#pragma unroll
        for (int cg = 0; cg < 2; ++cg) {
            f32x4 S0, S1; qk32(k, Bq[cg][0], Bq[cg][1], S0, S1);
            const int k0 = kb + 8 * q; float mloc = NEGF;
#pragma unroll
            for (int e = 0; e < 4; ++e) { if (k0 + e >= nv[cg]) S0[e] = NEGF; if (k0 + 4 + e >= nv[cg]) S1[e] = NEGF; mloc = fmaxf(mloc, fmaxf(S0[e], S1[e])); }
            const float mn = fmaxf(ml[cg], mloc); float ps = 0.f;
#pragma unroll
            for (int e = 0; e < 4; ++e) { ps += (k0 + e < nv[cg]) ? EXP2(S0[e] - mn) : 0.f; ps += (k0 + 4 + e < nv[cg]) ? EXP2(S1[e] - mn) : 0.f; }
            ll[cg] = ll[cg] * EXP2(ml[cg] - mn) + ps; ml[cg] = mn;
        }
    }
};
struct BodyCmp2 {
    bf16x8 Bq[2][2]; int nv[2], q, g, lane_; float mc[2], inv[2], carry[2]; LAS float* ia[2]; f32x4 O[2][4];
    __device__ __forceinline__ void run(int kb, const KOp& k, const VOp& v) {
#pragma unroll
        for (int cg = 0; cg < 2; ++cg) {
            f32x4 S0, S1; qk32(k, Bq[cg][0], Bq[cg][1], S0, S1);
            const int k0 = kb + 8 * q; f32x4 p0, p1;
#pragma unroll
            for (int e = 0; e < 4; ++e) { p0[e] = (k0 + e < nv[cg]) ? EXP2(S0[e] - mc[cg]) * inv[cg] : 0.f; p1[e] = (k0 + 4 + e < nv[cg]) ? EXP2(S1[e] - mc[cg]) * inv[cg] : 0.f; }
            f32x4 s0 = p0, s1 = p1;
#pragma unroll
            for (int e = 0; e < 4; ++e) { s0[e] += dpp_x1(s0[e]); s0[e] += dpp_x2(s0[e]); s1[e] += dpp_x1(s1[e]); s1[e] += dpp_x2(s1[e]); }
            const float bout = 0.5f * s1[3]; const float recv = __shfl(bout, (lane_ + 48) & 63); const float bin = (q == 0) ? carry[cg] : recv; carry[cg] = recv;
            if (g == 0) { const int j = k0 >> 2; ia[cg][j] = ((s0[0] + s0[1]) + (s0[2] + 0.5f * s0[3])) + bin; ia[cg][j + 1] = 0.5f * s0[3] + ((s1[0] + s1[1]) + (s1[2] + 0.5f * s1[3])); }
            pv32(v, packP(p0, p1), O[cg]);
        }
    }
};
struct BodyWin {
    bf16x8 Bq[2][2]; int q, tt[2]; float m[2], l[2]; f32x4 O[2][4];
    __device__ __forceinline__ void run(int kb, const KOp& k, const VOp& v) {
#pragma unroll
        for (int cg = 0; cg < 2; ++cg) {
            f32x4 S0, S1; qk32(k, Bq[cg][0], Bq[cg][1], S0, S1);
            const int k0 = kb + 8 * q; unsigned vm = 0u;
#pragma unroll
            for (int e = 0; e < 8; ++e) { const bool ok = (k0 + e <= tt[cg]) && (tt[cg] - (k0 + e) < 512); vm |= ok ? (1u << e) : 0u; }
            float mloc = NEGF;
#pragma unroll
            for (int e = 0; e < 4; ++e) { if (!((vm >> e) & 1u)) S0[e] = NEGF; if (!((vm >> (4 + e)) & 1u)) S1[e] = NEGF; mloc = fmaxf(mloc, fmaxf(S0[e], S1[e])); }
            mloc = fmaxf(mloc, __shfl_xor(mloc, 16)); mloc = fmaxf(mloc, __shfl_xor(mloc, 32));
            const float mn = fmaxf(m[cg], mloc), alpha = EXP2(m[cg] - mn); m[cg] = mn;
            f32x4 p0, p1; float ps = 0.f;
#pragma unroll
            for (int e = 0; e < 4; ++e) { p0[e] = ((vm >> e) & 1u) ? EXP2(S0[e] - mn) : 0.f; p1[e] = ((vm >> (4 + e)) & 1u) ? EXP2(S1[e] - mn) : 0.f; ps += p0[e] + p1[e]; }
            l[cg] = l[cg] * alpha + ps;
#pragma unroll
            for (int dt = 0; dt < 4; ++dt) O[cg][dt] = O[cg][dt] * alpha;
            pv32(v, packP(p0, p1), O[cg]);
        }
    }
};

struct AttnT { float fxs; unsigned long long* tsa; const bf16_t* proj; const bf16_t* kslc; const bf16_t* kwnc; const bf16_t* kcmp; const bf16_t* vcmpT; const bf16_t* vslT; const bf16_t* vwnT; bf16_t* ya; };

constexpr int AL_IMP = 0  , AL_OS = 0  , AL_TM = 67584  , AL_CNT = 69632  ,
              AL_OFF = 70656  , AL_UNITS = 71744  , AL_MM = 77888  , AL_LS = 78912  ;
constexpr int AL_Q = 81920  , QROWB = 528;
constexpr int OSP = 33;
constexpr float FXB = 67108864.0f;
typedef short s16x2 __attribute__((ext_vector_type(2)));
__device__ __forceinline__ int f2ord(float f) { const int b = __float_as_int(f); return b >= 0 ? b : b ^ 0x7fffffff; }
__device__ __forceinline__ float ord2f(int b) { return __int_as_float(b >= 0 ? b : b ^ 0x7fffffff); }

__device__ __forceinline__ void attn_wave_part1(const AttnT& T, int kh, int tq8, int lane, LAS float* imp  , LAS unsigned* tm, int wave, LAS unsigned char* lds, int tid) {
    const int col = lane & 15, q = lane >> 4, tk = col >> 2, g = col & 3;
    const int t0 = tq8 * 8, h = kh * 4 + g;
    bf16x8 Bq[2][2]; float g0[2], g2[2]; int tcg[2];
#pragma unroll
    for (int cg = 0; cg < 2; ++cg) { tcg[cg] = t0 + 4 * cg + tk; const bf16_t* prow = T.proj + (size_t)tcg[cg] * PP;
        Bq[cg][0] = *(const bf16x8*)(prow + C_Q + h * 64 + 8 * q); Bq[cg][1] = *(const bf16x8*)(prow + C_Q + h * 64 + 32 + 8 * q);
        g0[cg] = bf2f(prow[C_NG + h * 3 + 0]); g2[cg] = bf2f(prow[C_NG + h * 3 + 2]); }
    for (int i = lane; i < 8 * 264; i += 64) imp[i] = 0.f;
    {
        const bf16_t* Kc = T.kcmp + (size_t)kh * 1024 * 64; const bf16_t* Vc = T.vcmpT + (size_t)kh * 64 * 1024;
        const int tmax = (t0 | 63), nvmax = tmax >= 31 ? ((tmax - 31) >> 4) + 1 : 0, nsteps = (nvmax + 31) >> 5;
        BodyCmp1 b1;
#pragma unroll
        for (int cg = 0; cg < 2; ++cg) { b1.Bq[cg][0] = Bq[cg][0]; b1.Bq[cg][1] = Bq[cg][1]; b1.nv[cg] = tcg[cg] >= 31 ? ((tcg[cg] - 31) >> 4) + 1 : 0; b1.ml[cg] = NEGF; b1.ll[cg] = 0.f; }
        b1.q = q;
        cmp_shared<false>(nsteps, b1, Kc, Vc, lds + AL_CKV, tid, lane);
        BodyCmp2 b2; b2.q = q; b2.g = g; b2.lane_ = lane; b2.carry[0] = 0.f; b2.carry[1] = 0.f;
#pragma unroll
        for (int cg = 0; cg < 2; ++cg) {
            float mc = fmaxf(b1.ml[cg], __shfl_xor(b1.ml[cg], 16)); mc = fmaxf(mc, __shfl_xor(mc, 32));
            float lc = b1.ll[cg] * EXP2(b1.ml[cg] - mc); lc += __shfl_xor(lc, 16); lc += __shfl_xor(lc, 32);
            b2.Bq[cg][0] = Bq[cg][0]; b2.Bq[cg][1] = Bq[cg][1]; b2.nv[cg] = b1.nv[cg]; b2.mc[cg] = mc; b2.inv[cg] = 1.f / fmaxf(lc, 1e-30f); b2.ia[cg] = imp + (4 * cg + tk) * 264;
#pragma unroll
            for (int dt = 0; dt < 4; ++dt) b2.O[cg][dt] = (f32x4){0.f, 0.f, 0.f, 0.f};
        }
        asm volatile("s_waitcnt lgkmcnt(0)" ::: "memory");
        cmp_shared<true>(nsteps, b2, Kc, Vc, lds + AL_CKV, tid, lane);
        if (q == 0 && g == 0 && nsteps > 0) { b2.ia[0][8 * nsteps] = b2.carry[0]; b2.ia[1][8 * nsteps] = b2.carry[1]; }
#pragma unroll
        for (int cg = 0; cg < 2; ++cg) { bf16_t* yrow = T.ya + (size_t)tcg[cg] * 512 + h * 64 + 4 * q;
#pragma unroll
            for (int dt = 0; dt < 4; ++dt) { const f32x4 o = b2.O[cg][dt] * g0[cg]; u32x2 w; w.x = cvt_pk_bf16(o[0], o[1]); w.y = cvt_pk_bf16(o[2], o[3]); *(u32x2*)(yrow + 16 * dt) = w; } }
    }
    asm volatile("s_waitcnt lgkmcnt(0)" ::: "memory");
    for (int tk2 = 0; tk2 < 8; ++tk2) {
        const int tt = t0 + tk2, cur = tt >> 6, nvalid = cur + 1, KSEL = nvalid < 16 ? nvalid : 16;
        int bits[4];
#pragma unroll
        for (int s = 0; s < 4; ++s) { const int j = s * 64 + lane; const float v = imp[tk2 * 264 + j];
            bits[s] = (j == 0 || j == cur) ? 0x7F000000 : (j < nvalid ? __float_as_int(v) : -1); }
        int prefix = 0;
        for (int bit = 30; bit >= 0; --bit) { const int Tt = prefix | (1 << bit); int cnt = 0;
#pragma unroll
            for (int s = 0; s < 4; ++s) cnt += __popcll(__ballot(bits[s] >= Tt));
            if (cnt >= KSEL) prefix = Tt; }
        unsigned long long sel[4]; int need = KSEL;
#pragma unroll
        for (int s = 0; s < 4; ++s) { sel[s] = __ballot(bits[s] > prefix); need -= __popcll(sel[s]); }
#pragma unroll
        for (int s = 0; s < 4; ++s) { unsigned long long me = __ballot(bits[s] == prefix);
            while (me != 0ull && need > 0) { const unsigned long long low = me & (0ull - me); sel[s] |= low; me ^= low; --need; } }
        const int tbi = wave * 8 + tk2; const unsigned tbit = 1u << (tbi & 31);
#pragma unroll
        for (int s = 0; s < 4; ++s) if ((sel[s] >> lane) & 1ull) __hip_atomic_fetch_or(tm + (s * 64 + lane) * 2 + (tbi >> 5), tbit, __ATOMIC_RELAXED, __HIP_MEMORY_SCOPE_WORKGROUP);
    }
    {
        const bf16_t* Kw = T.kwnc + (size_t)kh * SEQ * 64; const bf16_t* Vw = T.vwnT + (size_t)kh * 256 * 4096;
        const int tb = t0 & ~63; const int klo = (tb - 511 > 0 ? tb - 511 : 0) & ~63; const int n = ((tb + 63 - klo) >> 5) + 1;
        BodyWin bo; bo.q = q;
#pragma unroll
        for (int cg = 0; cg < 2; ++cg) { bo.Bq[cg][0] = Bq[cg][0]; bo.Bq[cg][1] = Bq[cg][1]; bo.tt[cg] = tcg[cg]; bo.m[cg] = NEGF; bo.l[cg] = 0.f;
#pragma unroll
            for (int dt = 0; dt < 4; ++dt) bo.O[cg][dt] = (f32x4){0.f, 0.f, 0.f, 0.f}; }
        cmp_shared<true>(n, bo, Kw, Vw, lds + AL_CKV, tid, lane, klo, 64, 4096, klo >> 6);
#pragma unroll
        for (int cg = 0; cg < 2; ++cg) { float l = bo.l[cg]; l += __shfl_xor(l, 16); l += __shfl_xor(l, 32);
            const float sc = g2[cg] / fmaxf(l, 1e-30f); bf16_t* yrow = T.ya + (size_t)tcg[cg] * 512 + h * 64 + 4 * q;
#pragma unroll
            for (int dt = 0; dt < 4; ++dt) { const u32x2 y = *(const u32x2*)(yrow + 16 * dt); const f32x4 o = bo.O[cg][dt] * sc;
                u32x2 w; w.x = cvt_pk_bf16(bf_lo(y.x) + o[0], bf_hi(y.x) + o[1]); w.y = cvt_pk_bf16(bf_lo(y.y) + o[2], bf_hi(y.y) + o[3]); *(u32x2*)(yrow + 16 * dt) = w; } }
    }
    asm volatile("s_waitcnt lgkmcnt(0)" ::: "memory");
}

struct UnitPre { int j; unsigned tlo, thi; bf16x8 q00, q01, q10, q11; KOp ka, kb; VOp va, vb; };
template <int PASS>
__device__ __forceinline__ UnitPre unit_load(const LAS unsigned char* qlds, const bf16_t* Ks, const bf16_t* Vs, int kh, int tile, const LAS u32x4* units, int u, int lane) {
    const int col = lane & 15, q = lane >> 4, slot = col >> 2, g = col & 3;
    const u32x4 d = units[u]; UnitPre P; P.j = __builtin_amdgcn_readfirstlane((int)d.x); P.tlo = (unsigned)__builtin_amdgcn_readfirstlane((int)d.y); P.thi = (unsigned)__builtin_amdgcn_readfirstlane((int)d.z);
    const unsigned t0b = (P.tlo >> (8 * slot)) & 0xffu, t1b = (P.thi >> (8 * slot)) & 0xffu;
    const LAS unsigned char* qr0 = qlds + (t0b == 0xffu ? 0 : (int)t0b) * QROWB + g * 128 + 16 * q;
    const LAS unsigned char* qr1 = qlds + (t1b == 0xffu ? 0 : (int)t1b) * QROWB + g * 128 + 16 * q;
    P.q00 = *(const LAS bf16x8*)qr0; P.q01 = *(const LAS bf16x8*)(qr0 + 64); P.q10 = *(const LAS bf16x8*)qr1; P.q11 = *(const LAS bf16x8*)(qr1 + 64);
    P.ka = ldk(Ks, 64, 64 * P.j, lane); P.kb = ldk(Ks, 64, 64 * P.j + 32, lane);
    if (PASS == 1) { if ((EXPV) == 2) { P.va.v0 = P.ka.a00; P.va.v1 = P.ka.a01; P.va.v2 = P.ka.a10; P.va.v3 = P.ka.a11; P.vb = P.va; } else { P.va = ldv(Vs, 64, 64 * P.j, lane); P.vb = ldv(Vs, 64, 64 * P.j + 32, lane); } }
    return P;
}
template <int PASS>
__device__ __forceinline__ void unit_group(const UnitPre& P, const bf16x8& q0, const bf16x8& q1, unsigned toks, int tile, LAS unsigned char* lds, float fxs, int lane) {
    const int col = lane & 15, q = lane >> 4, slot = col >> 2, g = col & 3;
    const int ti = (int)((toks >> (8 * slot)) & 0xffu);
    f32x4 S0a, S1a, S0b, S1b; qk32(P.ka, q0, q1, S0a, S1a); qk32(P.kb, q0, q1, S0b, S1b);
    const bool valid = ti != 0xff; const int row = (valid ? ti : 0) * 4 + g;
    const int lim = (P.j == tile) ? (valid ? ti : -1) - 8 * q : (valid ? 1000 : -1);
    LAS int* mm = (LAS int*)(lds + AL_MM); LAS float* ls = (LAS float*)(lds + AL_LS);
    if (PASS == 0) {
        float mloc = NEGF;
#pragma unroll
        for (int e = 0; e < 4; ++e) { mloc = fmaxf(mloc, e <= lim ? S0a[e] : NEGF); mloc = fmaxf(mloc, e + 4 <= lim ? S1a[e] : NEGF); mloc = fmaxf(mloc, e + 32 <= lim ? S0b[e] : NEGF); mloc = fmaxf(mloc, e + 36 <= lim ? S1b[e] : NEGF); }
        if ((EXPV) != 4) { mloc = fmaxf(mloc, __shfl_xor(mloc, 16)); mloc = fmaxf(mloc, __shfl_xor(mloc, 32)); }
        if (q == 0 && valid && (EXPV) != 3) __hip_atomic_fetch_max(mm + row, f2ord(mloc), __ATOMIC_RELAXED, __HIP_MEMORY_SCOPE_WORKGROUP);
    } else {
        const float m = ord2f(mm[row]);
        f32x4 p0a, p1a, p0b, p1b; float ps = 0.f;
#pragma unroll
        for (int e = 0; e < 4; ++e) { p0a[e] = e <= lim ? EXP2(S0a[e] - m) : 0.f; p1a[e] = e + 4 <= lim ? EXP2(S1a[e] - m) : 0.f; p0b[e] = e + 32 <= lim ? EXP2(S0b[e] - m) : 0.f; p1b[e] = e + 36 <= lim ? EXP2(S1b[e] - m) : 0.f;
            ps += (p0a[e] + p1a[e]) + (p0b[e] + p1b[e]); }
        ps += __shfl_xor(ps, 16); ps += __shfl_xor(ps, 32);
        if (q == 0 && valid) __hip_atomic_fetch_add(ls + row, ps, __ATOMIC_RELAXED, __HIP_MEMORY_SCOPE_WORKGROUP);
        f32x4 O[4];
#pragma unroll
        for (int dt = 0; dt < 4; ++dt) O[dt] = (f32x4){0.f, 0.f, 0.f, 0.f};
        pv32(P.va, packP(p0a, p1a), O); pv32(P.vb, packP(p0b, p1b), O);
        if (valid) { LAS unsigned long long* orow = (LAS unsigned long long*)(lds + AL_OS) + row * OSP + 2 * q;
#pragma unroll
            for (int dt = 0; dt < 4; ++dt) {
                const unsigned a0 = (unsigned)((int)rintf(O[dt][0] * fxs) + (1 << 26)), a1 = (unsigned)((int)rintf(O[dt][1] * fxs) + (1 << 26)), a2 = (unsigned)((int)rintf(O[dt][2] * fxs) + (1 << 26)), a3 = (unsigned)((int)rintf(O[dt][3] * fxs) + (1 << 26));
                __hip_atomic_fetch_add(orow + 8 * dt, (unsigned long long)a0 | ((unsigned long long)a1 << 32), __ATOMIC_RELAXED, __HIP_MEMORY_SCOPE_WORKGROUP);
                __hip_atomic_fetch_add(orow + 8 * dt + 1, (unsigned long long)a2 | ((unsigned long long)a3 << 32), __ATOMIC_RELAXED, __HIP_MEMORY_SCOPE_WORKGROUP); } }
    }
}
template <int PASS>
__device__ __forceinline__ void unit_compute(const UnitPre& P, int tile, LAS unsigned char* lds, float fxs, int lane) {
    unit_group<PASS>(P, P.q00, P.q01, P.tlo, tile, lds, fxs, lane);
    if (P.thi != 0xffffffffu) unit_group<PASS>(P, P.q10, P.q11, P.thi, tile, lds, fxs, lane);
}
template <int PASS>
__device__ __forceinline__ void unit_pass(const AttnT& T, int kh, int tile, int n, LAS unsigned char* lds, int wave, int lane) {
    const bf16_t* Ks = T.kslc + (size_t)kh * SEQ * 64; const bf16_t* Vs = T.vslT + (size_t)kh * 256 * 4096;
    const LAS u32x4* units = (const LAS u32x4*)(lds + AL_UNITS);
    int u = wave; if (u >= n) return;
    UnitPre A = unit_load<PASS>(lds + AL_Q, Ks, Vs, kh, tile, units, u, lane), B = A;
    for (; u < n; u += 16) {
        const int u1 = u + 8; if (u1 < n) B = unit_load<PASS>(lds + AL_Q, Ks, Vs, kh, tile, units, u1, lane);
        unit_compute<PASS>(A, tile, lds, T.fxs, lane);
        if (u1 >= n) break;
        const int u2 = u + 16; if (u2 < n) A = unit_load<PASS>(lds + AL_Q, Ks, Vs, kh, tile, units, u2, lane);
        unit_compute<PASS>(B, tile, lds, T.fxs, lane);
    }
}

__device__ __forceinline__ void attn_tile(const AttnT& T, int kh, int tile, LAS unsigned char* lds, int tid, int wave, int lane) {
    LAS unsigned* tm = (LAS unsigned*)(lds + AL_TM);
    for (int i = tid; i < 512; i += NT) tm[i] = 0u;
    __syncthreads();
    if ((TSK) >= 20 && blockIdx.x == 0 && threadIdx.x == 0) T.tsa[15] = __builtin_amdgcn_s_memrealtime();
    attn_wave_part1(T, kh, tile * 8 + wave, lane, (LAS float*)(lds + AL_IMP + wave * 8448), tm, wave, lds, tid);
    __threadfence_block(); __syncthreads();
    { const int ti = tid >> 3, part = tid & 7; const u32x4* src = (const u32x4*)(T.proj + (size_t)(tile * 64 + ti) * PP + C_Q + kh * 256 + part * 32); LAS u32x4* dst = (LAS u32x4*)(lds + AL_Q + ti * QROWB + part * 64);
      dst[0] = src[0]; dst[1] = src[1]; dst[2] = src[2]; dst[3] = src[3]; }
    ASTAMP(0);
    LAS int* cnt = (LAS int*)(lds + AL_CNT); LAS int* off = (LAS int*)(lds + AL_OFF); LAS u32x4* units = (LAS u32x4*)(lds + AL_UNITS);
    for (int i = tid; i < 256 * OSP; i += NT) ((LAS unsigned long long*)(lds + AL_OS))[i] = 0ull;
    if (tid < 256) { ((LAS int*)(lds + AL_MM))[tid] = f2ord(NEGF); ((LAS float*)(lds + AL_LS))[tid] = 0.f; cnt[tid] = (__popc(tm[2 * tid]) + __popc(tm[2 * tid + 1]) + 7) >> 3; }
    __syncthreads();
    if (tid < 64) {
        const int c0 = cnt[4 * tid], c1 = cnt[4 * tid + 1], c2 = cnt[4 * tid + 2], c3 = cnt[4 * tid + 3]; const int tot = (c0 + c1) + (c2 + c3); int inc = tot;
#pragma unroll
        for (int o = 1; o < 64; o <<= 1) { const int v = __shfl_up(inc, o); if (tid >= o) inc += v; }
        const int ex = inc - tot; off[4 * tid] = ex; off[4 * tid + 1] = ex + c0; off[4 * tid + 2] = ex + c0 + c1; off[4 * tid + 3] = ex + c0 + c1 + c2;
        if (tid == 63) off[256] = inc;
    }
    __syncthreads();
    if (tid < 256) { unsigned long long mask = (unsigned long long)tm[2 * tid] | ((unsigned long long)tm[2 * tid + 1] << 32); int o = off[tid];
        while (mask != 0ull) { unsigned tl = 0xffffffffu, th = 0xffffffffu;
#pragma unroll
            for (int k = 0; k < 4; ++k) if (mask != 0ull) { const unsigned ti = (unsigned)__builtin_ctzll(mask); mask &= mask - 1ull; tl = (tl & ~(0xffu << (8 * k))) | (ti << (8 * k)); }
#pragma unroll
            for (int k = 0; k < 4; ++k) if (mask != 0ull) { const unsigned ti = (unsigned)__builtin_ctzll(mask); mask &= mask - 1ull; th = (th & ~(0xffu << (8 * k))) | (ti << (8 * k)); }
            units[o++] = (u32x4){(unsigned)tid, tl, th, 0u}; } }
    __syncthreads();
    const int n = off[256];
    ASTAMP(1);
    unit_pass<0>(T, kh, tile, n, lds, wave, lane);
    if ((PROBE_REP) == 42) unit_pass<0>(T, kh, tile, n, lds, wave, lane);
    __syncthreads();
    ASTAMP(2);
    unit_pass<1>(T, kh, tile, n, lds, wave, lane);
    __syncthreads();
    ASTAMP(3);
    { const int ti = tid >> 3, part = tid & 7, g = part >> 1, d0 = 32 * (part & 1), row = ti * 4 + g, t = tile * 64 + ti, h = kh * 4 + g;
      const float l = ((const LAS float*)(lds + AL_LS))[row]; const float sc = bf2f(T.proj[(size_t)t * PP + C_NG + h * 3 + 1]) / fmaxf(l, 1e-30f);
      const LAS unsigned long long* orow = (const LAS unsigned long long*)(lds + AL_OS) + row * OSP + (d0 >> 1); u32x4* yp = (u32x4*)(T.ya + (size_t)t * 512 + h * 64 + d0);
      const int nsel = ((t >> 6) + 1) < 16 ? ((t >> 6) + 1) : 16; const unsigned bias = (unsigned)nsel << 26; const float sc2 = sc / T.fxs;
#pragma unroll
      for (int i = 0; i < 4; ++i) { const u32x4 y = yp[i]; const unsigned long long o0 = orow[4 * i], o1 = orow[4 * i + 1], o2 = orow[4 * i + 2], o3 = orow[4 * i + 3]; f32x4 a, b;
          a[0] = bf_lo(y.x) + (float)(int)((unsigned)o0 - bias) * sc2; a[1] = bf_hi(y.x) + (float)(int)((unsigned)(o0 >> 32) - bias) * sc2; a[2] = bf_lo(y.y) + (float)(int)((unsigned)o1 - bias) * sc2; a[3] = bf_hi(y.y) + (float)(int)((unsigned)(o1 >> 32) - bias) * sc2;
          b[0] = bf_lo(y.z) + (float)(int)((unsigned)o2 - bias) * sc2; b[1] = bf_hi(y.z) + (float)(int)((unsigned)(o2 >> 32) - bias) * sc2; b[2] = bf_lo(y.w) + (float)(int)((unsigned)o3 - bias) * sc2; b[3] = bf_hi(y.w) + (float)(int)((unsigned)(o3 >> 32) - bias) * sc2;
          yp[i] = pack8(a, b); } }
    __syncthreads();
    ASTAMP(4);
    if ((TSK) >= 20 && blockIdx.x == 0 && threadIdx.x == 0) T.tsa[5] += (unsigned long long)n;
}

struct SsmB { bf16x8 a[8]; };
__device__ __forceinline__ SsmB ssm_load_b(const unsigned char* ws, int g, int lane) {
    const int i = lane & 15, q = lane >> 4; SsmB B; const bf16x8 z = {0, 0, 0, 0, 0, 0, 0, 0};
    const bf16_t* t = (const bf16_t*)(ws + WS_BBAR) + ((size_t)(g * 128 + i) * 16 + 8 * (q & 1));
#pragma unroll
    for (int rt = 0; rt < 8; ++rt) B.a[rt] = (q < 2) ? *(const bf16x8*)(t + (size_t)rt * 16 * 16) : z;
    return B;
}
__device__ __forceinline__ void ssm_bu16(const bf16x8& ub, const SsmB& B, int lane, LAS float* bul) {
    const int i = lane & 15, q = lane >> 4;
    const f32x4 z4 = {0.f, 0.f, 0.f, 0.f};
#pragma unroll
    for (int rt = 0; rt < 8; ++rt) { const f32x4 acc = MFMA16(B.a[rt], ub, z4); *(LAS f32x4*)(bul + i * 132 + 16 * rt + 4 * q) = acc; }
    asm volatile("s_waitcnt lgkmcnt(0)" ::: "memory");
}
struct SsmU { bf16x8 ub[8]; };
__device__ __forceinline__ SsmU ssm_load_u8(const bf16_t* proj, int c, int g, int lane) {
    const int i = lane & 15, q = lane >> 4; const bf16x8 z = {0, 0, 0, 0, 0, 0, 0, 0}; SsmU U;
#pragma unroll
    for (int sub = 0; sub < 8; ++sub) U.ub[sub] = (q < 2) ? *(const bf16x8*)(proj + (size_t)(c * 128 + sub * 16 + i) * PP + C_U + g * 16 + 8 * (q & 1)) : z;
    return U;
}
__device__ __forceinline__ f32x2 ssm_step(const f32x2 A, const f32x2 x, const f32x2 bu) { f32x2 r; r.x = A.x * x.x - A.y * x.y + bu.x; r.y = A.x * x.y + A.y * x.x + bu.y; return r; }
__device__ __forceinline__ void ssm_pass1(const unsigned char* ws, int c, int g, int lane, LAS float* bul) {
    const bf16_t* proj = (const bf16_t*)(ws + WS_PROJ);
    const SsmB B = ssm_load_b(ws, g, lane);
    const f32x2 A = ((const f32x2*)(ws + WS_ABAR))[g * 64 + lane];
    const SsmU U = ssm_load_u8(proj, c, g, lane);
    f32x2 x = {0.f, 0.f};
#pragma unroll
    for (int sub = 0; sub < 8; ++sub) {
        ssm_bu16(U.ub[sub], B, lane, bul);
#pragma unroll
        for (int s = 0; s < 16; ++s) x = ssm_step(A, x, *(const LAS f32x2*)(bul + s * 132 + 2 * lane));
        asm volatile("s_waitcnt lgkmcnt(0)" ::: "memory");
    }
    ((f32x2*)(ws + WS_SBUF))[(size_t)(c * 32 + g) * 64 + lane] = x;
}
__device__ __forceinline__ void ssm_pass3(const Args& a, int c, int g, int lane, LAS float* bul, LAS unsigned char* xl  ) {
    const unsigned char* ws = a.ws; const bf16_t* proj = (const bf16_t*)(ws + WS_PROJ);
    const SsmB B = ssm_load_b(ws, g, lane);
    const f32x2 A = ((const f32x2*)(ws + WS_ABAR))[g * 64 + lane], A128 = ((const f32x2*)(ws + WS_A128))[g * 64 + lane];
    const SsmU U = ssm_load_u8(proj, c, g, lane);
    u32x2 uwv[8];
#pragma unroll
    for (int sub = 0; sub < 8; ++sub) uwv[sub] = *(const u32x2*)(proj + (size_t)(c * 128 + sub * 16 + (lane & 15)) * PP + C_U + g * 16 + 4 * (lane >> 4));
    f32x2 x = {0.f, 0.f};
    { const f32x2* Sb = (const f32x2*)(ws + WS_SBUF) + g * 64 + lane;
      _Pragma("unroll 8") for (int cc = 0; cc < c; ++cc) { const f32x2 s = Sb[(size_t)cc * 32 * 64]; f32x2 r; r.x = A128.x * x.x - A128.y * x.y + s.x; r.y = A128.x * x.y + A128.y * x.x + s.y; x = r; } }
    const int hrow = lane & 15, q = lane >> 4; bf16x8 Cm[4];
    { const float* cre = a.in[14] + (size_t)(g * 16 + hrow) * 64; const float* cim = a.in[15] + (size_t)(g * 16 + hrow) * 64;
#pragma unroll
      for (int ks = 0; ks < 4; ++ks) { const f32x4 r = *(const f32x4*)(cre + 16 * ks + 4 * q), im = *(const f32x4*)(cim + 16 * ks + 4 * q);
          u32x4 w; w.x = cvt_pk_bf16(r[0], -im[0]); w.y = cvt_pk_bf16(r[1], -im[1]); w.z = cvt_pk_bf16(r[2], -im[2]); w.w = cvt_pk_bf16(r[3], -im[3]); Cm[ks] = __builtin_bit_cast(bf16x8, w); } }
    const f32x4 dsk = *(const f32x4*)(a.in[16] + g * 16 + 4 * q);
    bf16_t* ybp = (bf16_t*)((unsigned char*)a.out + OUT_YBP);
#pragma unroll
    for (int sub = 0; sub < 8; ++sub) {
        const int tok0 = c * 128 + sub * 16;
        ssm_bu16(U.ub[sub], B, lane, bul);
#pragma unroll
        for (int s = 0; s < 16; ++s) { x = ssm_step(A, x, *(const LAS f32x2*)(bul + s * 132 + 2 * lane)); *(LAS unsigned*)(xl + s * 272 + lane * 4) = cvt_pk_bf16(x.x, x.y); }
        asm volatile("s_waitcnt lgkmcnt(0)" ::: "memory");
        f32x4 acc = {0.f, 0.f, 0.f, 0.f};
#pragma unroll
        for (int ks = 0; ks < 4; ++ks) { const bf16x8 b = *(const LAS bf16x8*)(xl + hrow * 272 + ks * 64 + q * 16); acc = MFMA16(Cm[ks], b, acc); }
        const u32x2 uw = uwv[sub];
        const f32x4 uu = {bf_lo(uw.x), bf_hi(uw.x), bf_lo(uw.y), bf_hi(uw.y)};
        f32x4 y = acc + dsk * uu;
        u32x2 w; w.x = cvt_pk_bf16(gelu_tanh(y[0]), gelu_tanh(y[1])); w.y = cvt_pk_bf16(gelu_tanh(y[2]), gelu_tanh(y[3]));
        *(u32x2*)(ybp + (size_t)(tok0 + hrow) * 512 + g * 16 + 4 * q) = w;
        asm volatile("s_waitcnt lgkmcnt(0)" ::: "memory");
    }
}

__global__ void __launch_bounds__(NT, 2) fwd_mega(Args a) {
    extern __shared__ __attribute__((aligned(16))) unsigned char lds_raw[];
    cg::grid_group grid = cg::this_grid();
    LAS unsigned char* lds = (LAS unsigned char*)lds_raw;
    const int tid = threadIdx.x, lane = tid & 63, wave = __builtin_amdgcn_readfirstlane(tid >> 6);
    const int G = gridDim.x, bid = blockIdx.x;
    const int gw = bid * NWV + wave, NGW = G * NWV;
    const int gt = bid * NT + tid, NGT = G * NT;
    unsigned char* ws = a.ws;
    const float* x = a.in[0];
    STAMP(0);
    if ((TSK) >= 20 && blockIdx.x == 0 && threadIdx.x == 0) for (int i = 0; i < 16; ++i) ((unsigned long long*)(a.ws + 244 * 1024))[i] = 0ull;
    if (tid < 4) ((volatile LAS unsigned*)(lds + 131072 + 64))[tid] = 0u;
    __syncthreads();
    XcdBarrier xbar = xcd_barrier_post((unsigned*)(ws + WS_BAR), (volatile LAS unsigned*)(lds + 131072 + 64));

    {
        const int bb_ = G >= 256 ? 240 : 0;
        if (bid >= bb_ && bid < bb_ + 16) {
            LAS float* red = (LAS float*)lds;
            const int o = (bid - bb_) * 32 + (tid & 31), ksl = tid >> 5, which = o >> 8, colc = o & 255;
            const float* pe = a.in[which ? 7 : 4]; const float* w1 = a.in[which ? 8 : 5]; float s = 0.f;
            _Pragma("unroll 16") for (int k = ksl * 128; k < ksl * 128 + 128; ++k) s += pe[k] * w1[(size_t)k * 256 + colc];
            red[ksl * 32 + (tid & 31)] = s; __syncthreads();
            if (tid < 32) { float t = 0.f; for (int i = 0; i < 16; ++i) t += red[i * 32 + tid]; ((float*)(ws + WS_BIASPE))[o] = t; }
            __syncthreads();
        }
        LAS float* scr = (LAS float*)(lds + wave * 8448);
        constexpr int I_IN = 16 * 121, I_GLU = 8 * 16, I_PA = 8 * 32, I_OUT = 16 * 32, I_UP = 16 * 176, I_DN = 44 * 32, I_W1 = 32 * 8;
        constexpr int NITEMS = I_IN + I_GLU + 2 * I_PA + I_OUT + I_UP + I_DN + 2 * I_W1;
        for (int it = gw; it < NITEMS; it += NGW) {
            int r = it;
            if (r < I_IN) { transpose_item(a.in[3], 1024, DIN, (bf16_t*)(ws + WS_WIN), scr, r / 121, r % 121, lane, a.in[2], 1); continue; } r -= I_IN;
            if (r < I_GLU) { transpose_item(a.in[18], 512, 512, (bf16_t*)(ws + WS_WGLU), scr, r / 16, r % 16, lane, nullptr, 0); continue; } r -= I_GLU;
            if (r < I_PA) { transpose_item(a.in[19], 512, 1024, (bf16_t*)(ws + WS_WPA), scr, r / 32, r % 32, lane, nullptr, 0); continue; } r -= I_PA;
            if (r < I_PA) { transpose_item(a.in[20], 512, 1024, (bf16_t*)(ws + WS_WPB), scr, r / 32, r % 32, lane, nullptr, 0); continue; } r -= I_PA;
            if (r < I_OUT) { transpose_item(a.in[21], 1024, 1024, (bf16_t*)(ws + WS_WOUT), scr, r / 32, r % 32, lane, nullptr, 0); continue; } r -= I_OUT;
            if (r < I_UP) { transpose_item(a.in[23], 1024, NUP, (bf16_t*)(ws + WS_WUP), scr, r / 176, r % 176, lane, a.in[22], 2); continue; } r -= I_UP;
            if (r < I_DN) { transpose_item(a.in[26], DFF, 1024, (bf16_t*)(ws + WS_WDOWN), scr, r / 32, r % 32, lane, nullptr, 0); continue; } r -= I_DN;
            if (r < I_W1) { transpose_item(a.in[5], 2048, 256, (bf16_t*)(ws + WS_W1K), scr, r / 8, r % 8, lane, nullptr, 0); continue; } r -= I_W1;
            transpose_item(a.in[8], 2048, 256, (bf16_t*)(ws + WS_W1V), scr, r / 8, r % 8, lane, nullptr, 0);
        }
        { u32x4* p = (u32x4*)(ws + WS_WIN + (size_t)DIN * 1024 * 2); const int n = (4096 - DIN) * 1024 * 2 / 16; for (int i = gt; i < n; i += NGT) p[i] = (u32x4){0u, 0u, 0u, 0u}; }
        { u32x4* p = (u32x4*)(ws + WS_PROJ + (size_t)SEQ * PP * 2); const int n = 32 * PP * 2 / 16; for (int i = gt; i < n; i += NGT) p[i] = (u32x4){0u, 0u, 0u, 0u}; }
        for (int i = gt; i < 128 * 64 + 2048; i += NGT) {
            if (i < 128 * 64) { const int r = i >> 6, cidx = SEQ + (i & 63); ((bf16_t*)(ws + WS_VSLT))[(size_t)r * VTP + cidx] = 0; ((bf16_t*)(ws + WS_VWNT))[(size_t)r * VTP + cidx] = 0; }
            else { const int j = i - 128 * 64; ((bf16_t*)(ws + WS_VSLT))[(size_t)128 * VTP + j] = 0; ((bf16_t*)(ws + WS_VWNT))[(size_t)128 * VTP + j] = 0; }
        }
        for (int i = gt; i < SEQ; i += NGT) { ((float*)(ws + WS_RSS2))[i] = 0.f; ((float*)(ws + WS_RSS3))[i] = 0.f; }
        if (gt == 0) *(unsigned*)(ws + WS_VMAX) = 0u;
        { const int* pos = (const int*)a.in[1];
          for (int i = gt; i < SEQ * 8; i += NGT) { const int tt = i >> 3, fi = i & 7; const float invf = powf(500000.0f, -(float)(2 * fi) / 16.0f); const float ang = (float)pos[tt] * invf;
              float sn, cs; sincosf(ang, &sn, &cs); ((float*)(ws + WS_ROPEC))[i] = cs; ((float*)(ws + WS_ROPES))[i] = sn; } }
        const int sb_ = G >= 256 ? 210 : 0;
        for (int i = (bid - sb_) * NT + tid; bid >= sb_ && i < 2048; i += NGT) { const int gg = i >> 6;
            const float dt = expf(a.in[17][gg]), ar = a.in[10][i], ai = a.in[11][i];
            const float e = expf(ar * dt), em1 = expm1f(ar * dt), th = ai * dt; float sn, cs; sincosf(th, &sn, &cs); const float sh = sinf(0.5f * th);
            const float Ax = e * cs, Ay = e * sn; const float nx = em1 * cs - 2.f * sh * sh, ny = e * sn;
            const float den = 1.f / (ar * ar + ai * ai); const float fx = (nx * ar + ny * ai) * den, fy = (ny * ar - nx * ai) * den;
            ((f32x2*)(ws + WS_ABAR))[i] = (f32x2){Ax, Ay};
            float px = Ax, py = Ay;
            for (int k = 0; k < 7; ++k) { const float qx = px * px - py * py, qy = 2.f * px * py; px = qx; py = qy; }
            ((f32x2*)(ws + WS_A128))[i] = (f32x2){px, py};
            const float* bre = a.in[12] + (size_t)i * 16; const float* bim = a.in[13] + (size_t)i * 16; const int pp = i & 63;
            bf16_t* Bo = (bf16_t*)(ws + WS_BBAR) + ((size_t)(gg * 128 + 2 * pp) * 16);
            for (int hh = 0; hh < 16; hh += 2) { *(unsigned*)(Bo + hh) = cvt_pk_bf16(fx * bre[hh] - fy * bim[hh], fx * bre[hh + 1] - fy * bim[hh + 1]);
                                                 *(unsigned*)(Bo + 16 + hh) = cvt_pk_bf16(fx * bim[hh] + fy * bre[hh], fx * bim[hh + 1] + fy * bre[hh + 1]); }
        }
        for (int r = gw; r < SEQ; r += NGW) {
            const f32x4* xr = (const f32x4*)(x + (size_t)r * DM) + lane; f32x4 v[4]; float s = 0.f;
#pragma unroll
            for (int j = 0; j < 4; ++j) { v[j] = xr[64 * j]; s += (v[j][0] * v[j][0] + v[j][1] * v[j][1]) + (v[j][2] * v[j][2] + v[j][3] * v[j][3]); }
            s = wave_sum(s);
            if (lane == 0) ((float*)(ws + WS_RSTD1))[r] = rsqrtf(s * (1.f / DM) + EPS);
            u32x2* o = (u32x2*)(ws + WS_XB + (size_t)r * DM * 2) + lane;
#pragma unroll
            for (int j = 0; j < 4; ++j) { u32x2 w; w.x = cvt_pk_bf16(v[j][0], v[j][1]); w.y = cvt_pk_bf16(v[j][2], v[j][3]); o[64 * j] = w; }
        }
    }
    if (a.ws == nullptr) grid.sync();
    xcd_barrier(xbar);
    STAMP(1);

    REPS(1) {
        pg8::Gemm g{1024, 2048u, 128u, (unsigned)(1024) * 2u};
        SchedMN S{64, 16, 1, G, bid, 0, (const char*)(ws + WS_XB), nullptr, (const char*)(ws + WS_WIN), nullptr, (size_t)256 * 1024 * 2, (size_t)256 * 1024 * 2};
        EpiProj E{(bf16_t*)(ws + WS_PROJ), (bf16_t*)(ws + WS_VSLT), (bf16_t*)(ws + WS_VWNT), (bf16_t*)(ws + WS_KSL), (bf16_t*)(ws + WS_KWN), (const float*)(ws + WS_RSTD1), (const float*)(ws + WS_ROPEC), (const float*)(ws + WS_ROPES)};
        pg8::gemm_phase<EpiProj, SchedMN, true, true>(lds, g, S, E);
    }
    GSYNC();
    STAMP(2);

    {
        if (bid < 64) {
            pg8::Gemm g{512, (unsigned)(16 * PP * 2), (unsigned)(PP * 2), (unsigned)(2048) * 2u};
            SchedCmp S{bid, (const char*)(ws + WS_PROJ), (const char*)(ws + WS_W1K), (const char*)(ws + WS_W1V)};
            EpiCmp E{(float*)(ws + WS_XB)};
            pg8::gemm_phase<EpiCmp, SchedCmp, true, true>(lds, g, S, E);
        } else {
            LAS float* ubuf = (LAS float*)(lds + wave * 16384);
            for (int it = (bid - 64) * NWV + wave; it < 4096 * ((PROBE_REP) == 12 ? 2 : 1); it += (G - 64) * NWV) ssm_pass1(ws, (it & 4095) >> 5, it & 31, lane, ubuf);
        }
    }
    GSYNC();
    STAMP(3);

    REPS(3) {
        {
            const u32x4* vp = (const u32x4*)(ws + WS_VSLT); unsigned mx = 0u;
            for (int i = gt; i < 262144; i += NGT) { const u32x4 v = vp[i];
                mx = max(mx, max(max(v.x & 0x7fffu, (v.x >> 16) & 0x7fffu), max(v.y & 0x7fffu, (v.y >> 16) & 0x7fffu)));
                mx = max(mx, max(max(v.z & 0x7fffu, (v.z >> 16) & 0x7fffu), max(v.w & 0x7fffu, (v.w >> 16) & 0x7fffu))); }
#pragma unroll
            for (int o = 1; o < 64; o <<= 1) mx = max(mx, (unsigned)__shfl_xor((int)mx, o));
            LAS unsigned* red = (LAS unsigned*)(lds + 65536); if (lane == 0) red[wave] = mx; __syncthreads();
            if (tid == 0) { unsigned m8 = red[0]; for (int w = 1; w < NWV; ++w) m8 = max(m8, red[w]); atomicMax((unsigned*)(ws + WS_VMAX), m8); }
            __syncthreads();
        }
        const float* hidp = (const float*)(ws + WS_XB); LAS float* hrow = (LAS float*)(lds + wave * 1024);
        for (int r = gw; r < 4096; r += NGW) {
            const int z = r >> 10, n = r & 1023, which = z >> 1, kh = z & 1;
            float acc = 0.f;
            if (n < 1023) { const float* w2 = a.in[which ? 9 : 6];
                f32x4 hv = *(const f32x4*)((const float*)(ws + WS_BIASPE) + which * 256 + 4 * lane);
#pragma unroll
                for (int ks = 0; ks < 4; ++ks) hv += *(const f32x4*)(hidp + ((size_t)ks * 4096 + r) * 256 + 4 * lane);
                hv[0] = gelu_tanh(hv[0]); hv[1] = gelu_tanh(hv[1]); hv[2] = gelu_tanh(hv[2]); hv[3] = gelu_tanh(hv[3]);
                *(LAS f32x4*)(hrow + 4 * lane) = hv; asm volatile("s_waitcnt lgkmcnt(0)" ::: "memory");
                _Pragma("unroll 16") for (int k = 0; k < 256; k += 4) { const f32x4 h4 = *(const LAS f32x4*)(hrow + k);
                    acc += h4[0] * w2[k * 64 + lane]; acc += h4[1] * w2[(k + 1) * 64 + lane]; acc += h4[2] * w2[(k + 2) * 64 + lane]; acc += h4[3] * w2[(k + 3) * 64 + lane]; }
                asm volatile("s_waitcnt lgkmcnt(0)" ::: "memory"); }
            if (which == 0) {
                const float other = __shfl_xor(acc, 8); const int prow = 16 * n + 31; float o = acc;
                if (lane < 16 && n < 1023) { const float cs = ((const float*)(ws + WS_ROPEC))[prow * 8 + (lane & 7)], sn = ((const float*)(ws + WS_ROPES))[prow * 8 + (lane & 7)];
                    o = lane < 8 ? acc * cs - other * sn : acc * cs + other * sn; }
                ((bf16_t*)(ws + WS_KCMP))[((size_t)kh * 1024 + n) * 64 + lane] = (bf16_t)(cvt_pk_bf16(o, 0.f) & 0xffff);
            } else {
                ((bf16_t*)(ws + WS_VCMPT))[((size_t)kh * 64 + lane) * 1024 + n] = (bf16_t)(cvt_pk_bf16(acc, 0.f) & 0xffff);
            }
        }
    }
    GSYNC();
    STAMP(4);

    {
        AttnT T{0.f, (unsigned long long*)(ws + 244 * 1024), (const bf16_t*)(ws + WS_PROJ), (const bf16_t*)(ws + WS_KSL), (const bf16_t*)(ws + WS_KWN), (const bf16_t*)(ws + WS_KCMP), (const bf16_t*)(ws + WS_VCMPT), (const bf16_t*)(ws + WS_VSLT), (const bf16_t*)(ws + WS_VWNT), (bf16_t*)((unsigned char*)a.out + OUT_YA)};
        { const unsigned vb = __hip_atomic_load((unsigned*)(ws + WS_VMAX), __ATOMIC_RELAXED, __HIP_MEMORY_SCOPE_AGENT); const float vmax = fmaxf(__uint_as_float(vb << 16), 1e-30f); T.fxs = FXB / (64.0f * 1.01f * vmax); }
        LAS float* wl = (LAS float*)(lds + wave * 16384);
        for (int r2 = 0; r2 < ((PROBE_REP) == 4 ? 2 : 1); ++r2)
        for (int pr = bid; pr < 256; pr += G) {
            const int xcd = pr & 7, slot = pr >> 3, kh = xcd & 1, tl = 32 * (xcd >> 1) + slot;
_Pragma("nounroll")
            for (int k2 = 0; k2 < 2; ++k2) { int tk_ = threadIdx.x; asm volatile("" : "+v"(tk_)); attn_tile(T, kh, k2 ? 255 - tl : tl, lds, tk_, __builtin_amdgcn_readfirstlane(tk_ >> 6), tk_ & 63); }
        }
        if ((PROBE_REP) == 4) {
            AttnT T2 = T; T2.ya = (bf16_t*)(ws + WS_XB);
            for (int pr = bid; pr < 256; pr += G) { const int xcd = pr & 7, slot = pr >> 3, kh = xcd & 1, tl = 32 * (xcd >> 1) + slot;
                _Pragma("nounroll") for (int k2 = 0; k2 < 2; ++k2) attn_tile(T2, kh, k2 ? 255 - tl : tl, lds, tid, wave, lane); }
        }
        int tid2 = threadIdx.x; asm volatile("" : "+v"(tid2));
        const int lane2 = tid2 & 63, wave2 = __builtin_amdgcn_readfirstlane(tid2 >> 6), gw2 = bid * NWV + wave2;
        for (int it = gw2; it < 4096 * ((PROBE_REP) == 14 ? 2 : 1); it += NGW) ssm_pass3(a, (it & 4095) >> 5, it & 31, lane2, (LAS float*)(lds + wave2 * 16384), lds + wave2 * 16384 + 8448);
    }
    GSYNC();
    STAMP(5);

    REPS(5) {
        pg8::Gemm g{512, 1024u, 128u, (unsigned)(512) * 2u};
        SchedMN S{64, 2, 1, G, bid, 0, (const char*)a.out + OUT_YBP, nullptr, (const char*)(ws + WS_WGLU), nullptr, (size_t)256 * 512 * 2, (size_t)256 * 512 * 2};
        EpiGlu E{(const bf16_t*)((const unsigned char*)a.out + OUT_YBP), (bf16_t*)((unsigned char*)a.out + OUT_YB)};
        pg8::gemm_phase<EpiGlu, SchedMN, true, true>(lds, g, S, E);
    }
    GSYNC();
    STAMP(6);

    REPS(6) {
        pg8::Gemm g{512, 1024u, 128u, (unsigned)(512) * 2u};
        SchedMN S{64, 4, 2, G, bid, 0, (const char*)a.out + OUT_YA, (const char*)a.out + OUT_YB, (const char*)(ws + WS_WPA), (const char*)(ws + WS_WPB), (size_t)256 * 512 * 2, (size_t)256 * 512 * 2};
        EpiMerge E{(const bf16_t*)(ws + WS_PROJ), (bf16_t*)(ws + WS_MERGED)};
        pg8::gemm_phase<EpiMerge, SchedMN, true, true>(lds, g, S, E);
    }
    GSYNC();
    STAMP(7);

    {
        pg8::Gemm g{1024, 2048u, 128u, (unsigned)(1024) * 2u};
        SchedMN S{64, 4, 1, G, bid, 0, (const char*)(ws + WS_MERGED), nullptr, (const char*)(ws + WS_WOUT), nullptr, (size_t)256 * 1024 * 2, (size_t)256 * 1024 * 2};
        EpiRes E{x, a.out, (bf16_t*)(ws + WS_X1B), (float*)(ws + WS_RSS2)};
        pg8::gemm_phase<EpiRes, SchedMN, true, true>(lds, g, S, E);
    }
    GSYNC();
    STAMP(8);

    for (int half = 0; half < 2; ++half) {
        const int pm_off = half ? 31 : 0, nM = half ? 33 : 32, rowbase = pm_off * 256;
        REPS(8) {
            pg8::Gemm g{1024, 2048u, 128u, (unsigned)(1024) * 2u};
            SchedMN S{nM, 22, 1, G, bid, pm_off, (const char*)(ws + WS_X1B), nullptr, (const char*)(ws + WS_WUP), nullptr, (size_t)256 * 1024 * 2, (size_t)256 * 1024 * 2};
            EpiUp E{(bf16_t*)(ws + WS_UPRAW), (const float*)(ws + WS_RSS2), rowbase};
            pg8::gemm_phase<EpiUp, SchedMN, true, true>(lds, g, S, E);
        }
        GSYNC();
    STAMP(9);
        REPS(9) {
            const bf16_t* up = (const bf16_t*)(ws + WS_UPRAW); bf16_t* act = (bf16_t*)(ws + WS_ACT);
            const float* cw = a.in[24]; const float* cb = a.in[25];
            const int tlo = half ? 8192 : 0;
            for (int it = gt; it < 256 * 352; it += NGT) {
                const int cg8 = it % 352, tb = it / 352, c0 = cg8 * 8, tile = c0 >> 7, jj = c0 & 127;
                const int ucol = tile * 256 + jj;
                float wg[3][8], wv[3][8], bg[8], bv[8];
#pragma unroll
                for (int e = 0; e < 8; ++e) { bg[e] = cb[c0 + e]; bv[e] = cb[DFF + c0 + e];
#pragma unroll
                    for (int k = 0; k < 3; ++k) { wg[k][e] = cw[k * NUP + c0 + e]; wv[k][e] = cw[k * NUP + DFF + c0 + e]; } }
                const int ts = tlo + tb * 32;
                float g2[8], g1[8], v2[8], v1[8];
#pragma unroll
                for (int e = 0; e < 8; ++e) { g2[e] = g1[e] = v2[e] = v1[e] = 0.f; }
                if (ts >= 2) {
                    const u32x4 a2 = *(const u32x4*)(up + (size_t)(ts - 2 - rowbase) * NUP + ucol), b2 = *(const u32x4*)(up + (size_t)(ts - 2 - rowbase) * NUP + ucol + 128);
                    const u32x4 a1 = *(const u32x4*)(up + (size_t)(ts - 1 - rowbase) * NUP + ucol), b1 = *(const u32x4*)(up + (size_t)(ts - 1 - rowbase) * NUP + ucol + 128);
                    g2[0] = bf_lo(a2.x); g2[1] = bf_hi(a2.x); g2[2] = bf_lo(a2.y); g2[3] = bf_hi(a2.y); g2[4] = bf_lo(a2.z); g2[5] = bf_hi(a2.z); g2[6] = bf_lo(a2.w); g2[7] = bf_hi(a2.w);
                    v2[0] = bf_lo(b2.x); v2[1] = bf_hi(b2.x); v2[2] = bf_lo(b2.y); v2[3] = bf_hi(b2.y); v2[4] = bf_lo(b2.z); v2[5] = bf_hi(b2.z); v2[6] = bf_lo(b2.w); v2[7] = bf_hi(b2.w);
                    g1[0] = bf_lo(a1.x); g1[1] = bf_hi(a1.x); g1[2] = bf_lo(a1.y); g1[3] = bf_hi(a1.y); g1[4] = bf_lo(a1.z); g1[5] = bf_hi(a1.z); g1[6] = bf_lo(a1.w); g1[7] = bf_hi(a1.w);
                    v1[0] = bf_lo(b1.x); v1[1] = bf_hi(b1.x); v1[2] = bf_lo(b1.y); v1[3] = bf_hi(b1.y); v1[4] = bf_lo(b1.z); v1[5] = bf_hi(b1.z); v1[6] = bf_lo(b1.w); v1[7] = bf_hi(b1.w);
                }
_Pragma("unroll 8")
                for (int s = 0; s < 32; ++s) {
                    const int tt = ts + s;
                    const u32x4 a0 = *(const u32x4*)(up + (size_t)(tt - rowbase) * NUP + ucol), b0 = *(const u32x4*)(up + (size_t)(tt - rowbase) * NUP + ucol + 128);
                    float gc[8], vc[8];
                    gc[0] = bf_lo(a0.x); gc[1] = bf_hi(a0.x); gc[2] = bf_lo(a0.y); gc[3] = bf_hi(a0.y); gc[4] = bf_lo(a0.z); gc[5] = bf_hi(a0.z); gc[6] = bf_lo(a0.w); gc[7] = bf_hi(a0.w);
                    vc[0] = bf_lo(b0.x); vc[1] = bf_hi(b0.x); vc[2] = bf_lo(b0.y); vc[3] = bf_hi(b0.y); vc[4] = bf_lo(b0.z); vc[5] = bf_hi(b0.z); vc[6] = bf_lo(b0.w); vc[7] = bf_hi(b0.w);
                    float o[8];
#pragma unroll
                    for (int e = 0; e < 8; ++e) { const float gg = bg[e] + wg[0][e] * g2[e] + wg[1][e] * g1[e] + wg[2][e] * gc[e]; const float vv = bv[e] + wv[0][e] * v2[e] + wv[1][e] * v1[e] + wv[2][e] * vc[e];
                        o[e] = gg * sigmoidf_(gg) * vv; g2[e] = g1[e]; g1[e] = gc[e]; v2[e] = v1[e]; v1[e] = vc[e]; }
                    u32x4 w; w.x = cvt_pk_bf16(o[0], o[1]); w.y = cvt_pk_bf16(o[2], o[3]); w.z = cvt_pk_bf16(o[4], o[5]); w.w = cvt_pk_bf16(o[6], o[7]);
                    *(u32x4*)(act + (size_t)tt * DFF + c0) = w;
                }
            }
        }
        GSYNC();
    STAMP(10);
    }

    {
        pg8::Gemm g{DFF, (unsigned)(DFF * 2), 128u, (unsigned)(DFF) * 2u};
        SchedMN S{64, 4, 1, G, bid, 0, (const char*)(ws + WS_ACT), nullptr, (const char*)(ws + WS_WDOWN), nullptr, (size_t)256 * DFF * 2, (size_t)256 * DFF * 2};
        EpiRes E{a.out, a.out, nullptr, (float*)(ws + WS_RSS3)};
        pg8::gemm_phase<EpiRes, SchedMN, true, true>(lds, g, S, E);
    }
    GSYNC();
    STAMP(11);

    {
        const float* gf = a.in[27];
        for (int r = gw; r < SEQ; r += NGW) {
            const float rs = rsqrtf(((const float*)(ws + WS_RSS3))[r] * (1.f / DM) + EPS);
            f32x4* xr = (f32x4*)(a.out + (size_t)r * DM) + lane; const f32x4* gr = (const f32x4*)gf + lane;
#pragma unroll
            for (int j = 0; j < 4; ++j) xr[64 * j] = xr[64 * j] * rs * gr[64 * j];
        }
    }
    if ((TSK) >= 0 && blockIdx.x == 0 && threadIdx.x == 0) {
        const unsigned long long tend = __builtin_amdgcn_s_memrealtime(); const unsigned long long* ts = (const unsigned long long*)(a.ws + 240 * 1024);
        const unsigned long long t1 = ((TSK) + 1 > 11) ? tend : ts[(TSK) + 1 > 11 ? 0 : (TSK) + 1];
        asm volatile("s_waitcnt vmcnt(0)" ::: "memory");
        a.out[0] = ((TSK) >= 20) ? (float)((const unsigned long long*)(a.ws + 244 * 1024))[(TSK) >= 20 ? (TSK) - 20 : 0] * ((TSK) == 25 ? 1.0f : 0.01f) : (float)(t1 - ts[(TSK) > 11 ? 11 : (TSK)]) * 0.01f;
    }
}

extern "C" void kernel_launch(void* const* d_in, const int* in_sizes, int n_in, void* d_out, int out_size, void* d_ws, size_t ws_size, hipStream_t stream) {
    static int grid = 0;
    if (grid == 0) {
        int dev = 0, cus = 0, per_cu = 0;
        (void)hipGetDevice(&dev); (void)hipDeviceGetAttribute(&cus, hipDeviceAttributeMultiprocessorCount, dev);
        (void)hipFuncSetAttribute((const void*)fwd_mega, hipFuncAttributeMaxDynamicSharedMemorySize, LDS_BYTES);
        (void)hipOccupancyMaxActiveBlocksPerMultiprocessor(&per_cu, (const void*)fwd_mega, NT, LDS_BYTES);
        if (per_cu < 1) { fprintf(stderr, "kernel_launch: occupancy query says %d blocks per CU\n", per_cu); per_cu = 1; }
        grid = cus;
        if (n_in != 28 || ws_size < 252 * MiB) fprintf(stderr, "kernel_launch: unexpected n_in %d / ws_size %zu\n", n_in, ws_size);
    }
    Args a{};
    for (int i = 0; i < 28; ++i) a.in[i] = (const float*)d_in[i];
    a.out = (float*)d_out; a.ws = (unsigned char*)d_ws;
    (void)hipMemsetAsync((char*)d_ws + WS_BAR, 0, XCD_BAR_WORDS * 4, stream);
    void* kargs[] = {&a};
    hipError_t e = hipLaunchCooperativeKernel((const void*)fwd_mega, dim3(grid), dim3(NT), kargs, LDS_BYTES, stream);
    if (e != hipSuccess) fprintf(stderr, "cooperative launch failed: %s (grid %d)\n", hipGetErrorString(e), grid);
}
```
